# Optimizing an MI355X kernel written in HIP

```python
import math
import jax, jax.numpy as jnp
from jax import lax
import numpy as np

D_MODEL = 1024
BATCH = 8
SEQ = 2048
DEPTH = 4
DEC_BATCH = 128
DEC_SEQ = 1
PAST_LEN = 16384
PAGE_SIZE = 128

HEAD_DIM = 64
A_WIDTH = 3 * D_MODEL // 8
B_WIDTH = 3 * D_MODEL // 8
C_WIDTH = D_MODEL - A_WIDTH - B_WIDTH
H_A = A_WIDTH // HEAD_DIM
H_B = B_WIDTH // HEAD_DIM
H_C = C_WIDTH // HEAD_DIM
CONV_W = 4
CHUNK = 64
W_LORA = 64
A_LORA = 64
G_LORA = 128
V_LORA = 32
A_COLS = 4 * A_WIDTH + 2 * H_A
B_COLS = 3 * B_WIDTH + W_LORA + A_LORA + G_LORA
C_COLS = 4 * C_WIDTH
IN_COLS = A_COLS + B_COLS + C_COLS
D_FF = -(-8 * D_MODEL // (3 * 256)) * 256
RMS_EPS = 1e-6
RWKV_LN_EPS = 64e-5

kernel_name = 'hybrid_gdn_rwkv7_hgrn2_decode_step'


def rmsnorm(x, w):
    xf = x.astype(jnp.float32)
    y = xf * lax.rsqrt(jnp.mean(xf * xf, -1, keepdims=True) + RMS_EPS)
    return (y * w.astype(jnp.float32)).astype(x.dtype)


def gated_rmsnorm(o, w, z):
    return o * lax.rsqrt(jnp.mean(o * o, -1, keepdims=True) + RMS_EPS) * w.astype(jnp.float32) * jax.nn.silu(z)


def l2norm(x):
    return x * lax.rsqrt(jnp.sum(x * x, -1, keepdims=True) + 1e-6)


def split_heads(x, n):
    return x.reshape(x.shape[:-1] + (n, x.shape[-1] // n))


def merge_heads(x):
    return x.reshape(x.shape[:-2] + (x.shape[-2] * x.shape[-1],))


def masked_exp(mask, d):
    return jnp.where(mask, jnp.exp(jnp.where(mask, d, 0.0)), 0.0)


def causal_conv(x, buf, w):
    t = x.shape[1]
    xc = jnp.concatenate([buf, x], axis=1)
    y = xc[:, 0:t] * w[0]
    for j in range(1, CONV_W):
        y = y + xc[:, j:j + t] * w[j]
    return y, xc[:, t:]


def to_chunks(x, c):
    b, t = x.shape[:2]
    n = -(-t // c)
    x = jnp.pad(x, [(0, 0), (0, n * c - t)] + [(0, 0)] * (x.ndim - 2))
    x = x.reshape((b, n, c) + x.shape[2:])
    return jnp.swapaxes(jnp.moveaxis(x, 1, 0), 2, 3)


def from_chunks(o, t):
    o = jnp.moveaxis(jnp.swapaxes(o, 2, 3), 0, 1)
    return o.reshape((o.shape[0], o.shape[1] * o.shape[2]) + o.shape[3:])[:, :t]


def gdn_chunked(q, k, v, g, beta, s0):
    t = q.shape[1]
    c = min(CHUNK, t)
    dv = v.shape[-1]
    qc, kc, vc, gc, bc = (to_chunks(a, c) for a in (q, k, v, g, beta))
    gcum = jnp.cumsum(gc, axis=-1)
    causal = jnp.tril(jnp.ones((c, c), bool))
    strict = jnp.tril(jnp.ones((c, c), bool), -1)
    decay_in = masked_exp(causal, gcum[..., :, None] - gcum[..., None, :])
    m = jnp.where(strict, bc[..., :, None] * jnp.einsum('nbhid,nbhjd->nbhij', kc, kc) * decay_in, 0.0)
    a_mat = m + jnp.eye(c, dtype=m.dtype)
    rhs = jnp.concatenate([vc * bc[..., None], kc * (bc * jnp.exp(gcum))[..., None]], axis=-1)
    sol = lax.linalg.triangular_solve(a_mat, rhs, left_side=True, lower=True, unit_diagonal=True)
    u, w = sol[..., :dv], sol[..., dv:]
    qk = jnp.einsum('nbhid,nbhjd->nbhij', qc, kc) * decay_in
    q_dec = qc * jnp.exp(gcum)[..., None]
    k_dec = kc * jnp.exp(gcum[..., -1:] - gcum)[..., None]
    g_last = jnp.exp(gcum[..., -1])

    def step(s, xs):
        u_i, w_i, qk_i, qd_i, kd_i, gl_i = xs
        v_new = u_i - jnp.einsum('bhck,bhkv->bhcv', w_i, s)
        o = jnp.einsum('bhck,bhkv->bhcv', qd_i, s) + jnp.einsum('bhij,bhjv->bhiv', qk_i, v_new)
        s = s * gl_i[..., None, None] + jnp.einsum('bhck,bhcv->bhkv', kd_i, v_new)
        return s, o

    s, o = lax.scan(step, s0, (u, w, qk, q_dec, k_dec, g_last))
    return from_chunks(o, t), s


def hgrn_chunked(q, k, i, log_f, s0):
    t = q.shape[1]
    c = min(CHUNK, t)
    qc, kc, ic, fc = (to_chunks(a, c) for a in (q, k, i, log_f))
    bcum = jnp.cumsum(fc, axis=-2)
    causal = jnp.tril(jnp.ones((c, c), bool))[..., None]

    def step(s, xs):
        q_i, k_i, v_i, b_i = xs
        dec = masked_exp(causal, b_i[..., :, None, :] - b_i[..., None, :, :])
        att = jnp.einsum('bhid,bhjd,bhijd->bhij', q_i, k_i, dec)
        o = jnp.einsum('bhid,bhdv->bhiv', q_i * jnp.exp(b_i), s) + jnp.einsum('bhij,bhjv->bhiv', att, v_i)
        bl = b_i[..., -1, :]
        s = jnp.exp(bl)[..., None] * s + jnp.einsum('bhcd,bhcv->bhdv', k_i * jnp.exp(bl[..., None, :] - b_i), v_i)
        return s, o

    s, o = lax.scan(step, s0, (qc, kc, ic, bcum))
    return from_chunks(o, t), s


def rwkv7_scan(r, decay, k, v, kk, a, s0):
    def step(s, xs):
        r_t, w_t, k_t, v_t, kk_t, a_t = xs
        sa = jnp.einsum('bhvk,bhk->bhv', s, -kk_t)
        s = s * w_t[:, :, None, :] + sa[..., None] * (kk_t * a_t)[:, :, None, :] + v_t[..., None] * k_t[:, :, None, :]
        return s, jnp.einsum('bhvk,bhk->bhv', s, r_t)

    xs = tuple(jnp.moveaxis(a_, 1, 0) for a_ in (r, decay, k, v, kk, a))
    s, y = lax.scan(step, s0, xs)
    return jnp.moveaxis(y, 0, 1), s


def gdn_mixer(p, s0, conv_buf, P, l):
    qkv, z, b, a = jnp.split(p, [3 * A_WIDTH, 4 * A_WIDTH, 4 * A_WIDTH + H_A], axis=-1)
    qkv, new_buf = causal_conv(qkv, conv_buf.astype(jnp.float32), P['gdn_conv_w'][l].astype(jnp.float32))
    qkv = jax.nn.silu(qkv)
    q, k, v = (split_heads(t_, H_A) for t_ in jnp.split(qkv, 3, axis=-1))
    q = l2norm(q) * HEAD_DIM ** -0.5
    k = l2norm(k)
    beta = jax.nn.sigmoid(b)
    g = -jnp.exp(P['gdn_a_log'][l].astype(jnp.float32)) * jax.nn.softplus(a + P['gdn_dt_bias'][l])
    o, s = gdn_chunked(q, k, v, g, beta, s0.astype(jnp.float32))
    o = gated_rmsnorm(o, P['gdn_norm_w'][l], split_heads(z, H_A))
    return merge_heads(o), s, new_buf


def rwkv_mixer(p, s0, shift_buf, v_first, P, l):
    prev = jnp.concatenate([shift_buf.astype(jnp.float32)[:, None], p[:, :-1]], axis=1)
    xs = p + (prev - p) * P['rwkv_mu'][l]
    new_shift = p[:, -1]
    r, k, v, wd, ad, gd = jnp.split(
        xs, [B_WIDTH, 2 * B_WIDTH, 3 * B_WIDTH, 3 * B_WIDTH + W_LORA, 3 * B_WIDTH + W_LORA + A_LORA], axis=-1)
    w_log = -jax.nn.softplus(-(P['rwkv_w0'][l] + jnp.einsum('btr,rc->btc', jnp.tanh(wd), P['rwkv_w2'][l]))) - 0.5
    decay = jnp.exp(-jnp.exp(w_log))
    a = jax.nn.sigmoid(P['rwkv_a0'][l] + jnp.einsum('btr,rc->btc', ad, P['rwkv_a2'][l]))
    g = jnp.einsum('btr,rc->btc', jax.nn.sigmoid(gd), P['rwkv_g2'][l])
    if l == 0:
        v_first = v
    else:
        mixv = jax.nn.sigmoid(P['rwkv_v0'][l - 1] + jnp.einsum(
            'btr,rc->btc', jnp.einsum('btc,cr->btr', v, P['rwkv_v1'][l - 1]), P['rwkv_v2'][l - 1]))
        v = v + (v_first - v) * mixv
    kk = l2norm(split_heads(k * P['rwkv_k_k'][l], H_B))
    k = k * (1.0 + (a - 1.0) * P['rwkv_k_a'][l])
    rh, kh, vh, ah, dh = (split_heads(t_, H_B) for t_ in (r, k, v, a, decay))
    y, s = rwkv7_scan(rh, dh, kh, vh, kk, ah, s0.astype(jnp.float32))
    mu = jnp.mean(y, -1, keepdims=True)
    yc = y - mu
    y = yc * lax.rsqrt(jnp.mean(yc * yc, -1, keepdims=True) + RWKV_LN_EPS)
    y = merge_heads(y) * P['rwkv_ln_w'][l] + P['rwkv_ln_b'][l]
    bonus = jnp.sum(rh * kh * P['rwkv_r_k'][l], -1, keepdims=True) * vh
    y = (y + merge_heads(bonus)) * g
    return y, s, new_shift, v_first


def hgrn_mixer(p, s0, lb, P, l):
    q, f, i, g = jnp.split(p, 4, axis=-1)
    q = jax.nn.silu(q) * HEAD_DIM ** -0.5
    k = (1.0 - lb) * jax.nn.sigmoid(-f)
    log_f = jnp.log1p(-k)
    o, s = hgrn_chunked(split_heads(q, H_C), split_heads(k, H_C), split_heads(i, H_C),
                        split_heads(log_f, H_C), s0.astype(jnp.float32))
    o = gated_rmsnorm(o, P['hgrn_norm_w'][l], split_heads(g, H_C))
    return merge_heads(o), s


def trunk(x, states, P, lb):
    st_gdn, st_conv, st_rwkv, st_shift, st_hgrn = states
    new = ([], [], [], [], [])
    v_first = None
    for l in range(DEPTH):
        h = rmsnorm(x, P['norm_mix'][l])
        p = jnp.einsum('btd,de->bte', h, P['w_in'][l]).astype(jnp.float32)
        p_a = p[..., :A_COLS]
        p_b = p[..., A_COLS:A_COLS + B_COLS]
        p_c = p[..., A_COLS + B_COLS:]
        y_a, s_a, c_a = gdn_mixer(p_a, st_gdn[l], st_conv[l], P, l)
        y_b, s_b, sh_b, v_first = rwkv_mixer(p_b, st_rwkv[l], st_shift[l], v_first, P, l)
        y_c, s_c = hgrn_mixer(p_c, st_hgrn[l], lb[l], P, l)
        mix = jnp.concatenate([y_a, y_b, y_c], axis=-1).astype(x.dtype)
        x = x + jnp.einsum('bte,ed->btd', mix, P['w_out'][l])
        h = rmsnorm(x, P['norm_ffn'][l])
        u = jax.nn.silu(jnp.einsum('btd,df->btf', h, P['w_gate'][l])) * jnp.einsum('btd,df->btf', h, P['w_up'][l])
        x = x + jnp.einsum('btf,fd->btd', u, P['w_down'][l])
        for lst, s in zip(new, (s_a, c_a, s_b, sh_b, s_c)):
            lst.append(s)
    y = rmsnorm(x, P['norm_final'])
    return y, tuple(jnp.stack(lst).astype(x.dtype) for lst in new)


def setup_inputs(seed: int = 0) -> dict:
    key = jax.random.key(seed)
    ks = jax.random.split(key, 40)
    cnt = iter(range(40))

    def nrm(shape, s):
        return jax.random.normal(ks[next(cnt)], shape, jnp.float32) * s

    def uni(shape, lo, hi):
        return jax.random.uniform(ks[next(cnt)], shape, jnp.float32, lo, hi)

    L = DEPTH
    dt = jnp.exp(uni((L, H_A), math.log(1e-3), math.log(1e-1)))
    return {
        'x_prompt': nrm((BATCH, SEQ, D_MODEL), 1.0),
        'x_sample': nrm((DEC_BATCH, DEC_SEQ, D_MODEL), 1.0),
        'state_gdn': nrm((L, DEC_BATCH, H_A, HEAD_DIM, HEAD_DIM), 0.3),
        'state_gdn_conv': nrm((L, DEC_BATCH, CONV_W - 1, 3 * A_WIDTH), 1.0),
        'state_rwkv': nrm((L, DEC_BATCH, H_B, HEAD_DIM, HEAD_DIM), 0.3),
        'state_rwkv_shift': nrm((L, DEC_BATCH, B_COLS), 1.0),
        'state_hgrn': nrm((L, DEC_BATCH, H_C, HEAD_DIM, HEAD_DIM), 0.3),
        'norm_mix': 1.0 + nrm((L, D_MODEL), 0.02),
        'w_in': nrm((L, D_MODEL, IN_COLS), D_MODEL ** -0.5),
        'w_out': nrm((L, D_MODEL, D_MODEL), 0.5 * D_MODEL ** -0.5),
        'gdn_conv_w': nrm((L, CONV_W, 3 * A_WIDTH), CONV_W ** -0.5),
        'gdn_a_log': jnp.log(uni((L, H_A), 1.0, 16.0)),
        'gdn_dt_bias': dt + jnp.log(-jnp.expm1(-dt)),
        'gdn_norm_w': 1.0 + nrm((L, HEAD_DIM), 0.02),
        'rwkv_mu': uni((L, B_COLS), 0.0, 1.0),
        'rwkv_w0': uni((L, B_WIDTH), -6.0, -1.0),
        'rwkv_w2': nrm((L, W_LORA, B_WIDTH), 0.1),
        'rwkv_a0': nrm((L, B_WIDTH), 0.1),
        'rwkv_a2': nrm((L, A_LORA, B_WIDTH), 0.1),
        'rwkv_g2': nrm((L, G_LORA, B_WIDTH), G_LORA ** -0.5),
        'rwkv_v0': 1.0 + nrm((L - 1, B_WIDTH), 0.1),
        'rwkv_v1': nrm((L - 1, B_WIDTH, V_LORA), B_WIDTH ** -0.5),
        'rwkv_v2': nrm((L - 1, V_LORA, B_WIDTH), 0.1),
        'rwkv_k_k': 0.85 + nrm((L, B_WIDTH), 0.02),
        'rwkv_k_a': 1.0 + nrm((L, B_WIDTH), 0.02),
        'rwkv_r_k': nrm((L, H_B, HEAD_DIM), 0.1),
        'rwkv_ln_w': 1.0 + nrm((L, B_WIDTH), 0.02),
        'rwkv_ln_b': nrm((L, B_WIDTH), 0.01),
        'hgrn_lower_bounds': nrm((L, C_WIDTH), 1.0),
        'hgrn_norm_w': 1.0 + nrm((L, HEAD_DIM), 0.02),
        'norm_ffn': 1.0 + nrm((L, D_MODEL), 0.02),
        'w_gate': nrm((L, D_MODEL, D_FF), D_MODEL ** -0.5),
        'w_up': nrm((L, D_MODEL, D_FF), D_MODEL ** -0.5),
        'w_down': nrm((L, D_FF, D_MODEL), 0.5 * D_FF ** -0.5),
        'norm_final': 1.0 + nrm((D_MODEL,), 0.02),
    }


def reference(x_prompt, x_sample, state_gdn, state_gdn_conv, state_rwkv, state_rwkv_shift, state_hgrn,
              norm_mix, w_in, w_out, gdn_conv_w, gdn_a_log, gdn_dt_bias, gdn_norm_w,
              rwkv_mu, rwkv_w0, rwkv_w2, rwkv_a0, rwkv_a2, rwkv_g2, rwkv_v0, rwkv_v1, rwkv_v2,
              rwkv_k_k, rwkv_k_a, rwkv_r_k, rwkv_ln_w, rwkv_ln_b,
              hgrn_lower_bounds, hgrn_norm_w, norm_ffn, w_gate, w_up, w_down, norm_final):
    P = {
        'norm_mix': norm_mix, 'w_in': w_in, 'w_out': w_out,
        'gdn_conv_w': gdn_conv_w, 'gdn_a_log': gdn_a_log, 'gdn_dt_bias': gdn_dt_bias, 'gdn_norm_w': gdn_norm_w,
        'rwkv_mu': rwkv_mu, 'rwkv_w0': rwkv_w0, 'rwkv_w2': rwkv_w2, 'rwkv_a0': rwkv_a0, 'rwkv_a2': rwkv_a2,
        'rwkv_g2': rwkv_g2, 'rwkv_v0': rwkv_v0, 'rwkv_v1': rwkv_v1, 'rwkv_v2': rwkv_v2,
        'rwkv_k_k': rwkv_k_k, 'rwkv_k_a': rwkv_k_a, 'rwkv_r_k': rwkv_r_k,
        'rwkv_ln_w': rwkv_ln_w, 'rwkv_ln_b': rwkv_ln_b,
        'hgrn_norm_w': hgrn_norm_w, 'norm_ffn': norm_ffn,
        'w_gate': w_gate, 'w_up': w_up, 'w_down': w_down, 'norm_final': norm_final,
    }
    sm = jax.nn.softmax(hgrn_lower_bounds.astype(jnp.float32), axis=0)
    lb = jnp.cumsum(sm, axis=0) - sm[0:1]

    b = x_prompt.shape[0]
    init_prompt = (
        jnp.zeros((DEPTH, b, H_A, HEAD_DIM, HEAD_DIM), jnp.float32),
        jnp.zeros((DEPTH, b, CONV_W - 1, 3 * A_WIDTH), jnp.float32),
        jnp.zeros((DEPTH, b, H_B, HEAD_DIM, HEAD_DIM), jnp.float32),
        jnp.zeros((DEPTH, b, B_COLS), jnp.float32),
        jnp.zeros((DEPTH, b, H_C, HEAD_DIM, HEAD_DIM), jnp.float32),
    )
    y_prompt, (gdn_p, conv_p, rwkv_p, shift_p, hgrn_p) = trunk(x_prompt, init_prompt, P, lb)
    y_sample, (gdn_s, conv_s, rwkv_s, shift_s, hgrn_s) = trunk(
        x_sample, (state_gdn, state_gdn_conv, state_rwkv, state_rwkv_shift, state_hgrn), P, lb)
    return (y_prompt, y_sample, gdn_p, gdn_s, conv_p, conv_s, rwkv_p, rwkv_s, shift_p, shift_s, hgrn_p, hgrn_s)
```

```cpp
#include <hip/hip_runtime.h>
#include <hip/hip_cooperative_groups.h>
#include <cstdio>
namespace cg = cooperative_groups;

typedef unsigned short bf16_t;
typedef short bf16x8 __attribute__((ext_vector_type(8)));
typedef float f32x4 __attribute__((ext_vector_type(4)));
typedef unsigned u32x4 __attribute__((ext_vector_type(4)));
typedef unsigned u32x2 __attribute__((ext_vector_type(2)));

constexpr int D = 1024, NTP = 16384, NTS = 128, NTOK = 16512, TSEQ = 2048, NLAYER = 4;
constexpr int IN_COLS = 3980, PSTR = 3984, DFF = 2816;
constexpr int PB = 1548, PC = 2956;

enum { I_XP = 0, I_XS, I_SGDN, I_SCONV, I_SRWKV, I_SSHIFT, I_SHGRN, I_NORM_MIX, I_WIN, I_WOUT, I_CONVW, I_ALOG, I_DTB, I_GNW,
       I_MU, I_W0, I_W2, I_A0, I_A2, I_G2, I_V0, I_V1, I_V2, I_KK, I_KA, I_RK, I_LNW, I_LNB, I_HLB, I_HNW, I_NORM_FFN,
       I_WG, I_WU, I_WD, I_NORM_FINAL, N_IN };

constexpr size_t O_YP = 0, O_YS = 16777216, O_GDN_P = 16908288, O_GDN_S = 17694720, O_CONV_P = 30277632, O_CONV_S = 30388224,
                 O_RWKV_P = 32157696, O_RWKV_S = 32944128, O_SHIFT_P = 45527040, O_SHIFT_S = 45572096, O_HGRN_P = 46292992,
                 O_HGRN_S = 46817280;

constexpr size_t SZ_WTIN = (size_t)4096 * 1024 * 2, SZ_WTOUT = (size_t)1024 * 1024 * 2, SZ_WTGU = (size_t)5632 * 1024 * 2,
                 SZ_WTDN = (size_t)1024 * 2816 * 2, SZ_P = (size_t)NTOK * PSTR * 2, SZ_ACT = (size_t)NTOK * 1024 * 2,
                 SZ_T384 = (size_t)NTOK * 384 * 2, SZ_T8F = (size_t)NTOK * 8 * 4, SZ_T256 = (size_t)NTOK * 256 * 2,
                 SZ_T384F = (size_t)NTOK * 384 * 4;
constexpr size_t OFF_WTIN = 0, OFF_WTOUT = OFF_WTIN + SZ_WTIN, OFF_WTGU = OFF_WTOUT + SZ_WTOUT, OFF_WTDN = OFF_WTGU + SZ_WTGU,
                 OFF_P = OFF_WTDN + SZ_WTDN, OFF_ACT = OFF_P + SZ_P, OFF_GQ = OFF_ACT + SZ_ACT, OFF_GK = OFF_GQ + SZ_T384,
                 OFF_GV = OFF_GK + SZ_T384, OFF_GDEC = OFF_GV + SZ_T384, OFF_GBETA = OFF_GDEC + SZ_T8F, OFF_HQ = OFF_GBETA + SZ_T8F,
                 OFF_HK = OFF_HQ + SZ_T256, OFF_RR = OFF_HK + SZ_T256, OFF_RK = OFF_RR + SZ_T384, OFF_RV = OFF_RK + SZ_T384,
                 OFF_RKK = OFF_RV + SZ_T384, OFF_RB = OFF_RKK + SZ_T384, OFF_RG = OFF_RB + SZ_T384, OFF_RW = OFF_RG + SZ_T384,
                 OFF_VF = OFF_RW + SZ_T384F, WS_NEED = OFF_VF + SZ_T384;

struct Params {
  const float* in[N_IN];
  float* out;
  unsigned char* ws;
};

#define WSP(T, off) ((T*)(P.ws + (off)))

__device__ __forceinline__ int otid() { int t = __builtin_amdgcn_workitem_id_x(); asm volatile("" : "+v"(t)); return t; }
__device__ __forceinline__ int obid() { int b = __builtin_amdgcn_workgroup_id_x(); asm volatile("" : "+s"(b)); return b; }
__device__ __forceinline__ float bf2f(bf16_t h) { return __uint_as_float(((unsigned)h) << 16); }
__device__ __forceinline__ unsigned pk2(float lo, float hi) { unsigned r; asm("v_cvt_pk_bf16_f32 %0, %1, %2" : "=v"(r) : "v"(lo), "v"(hi)); return r; }
__device__ __forceinline__ bf16_t f2bf(float f) { return (bf16_t)(pk2(f, 0.f) & 0xffffu); }
__device__ __forceinline__ float sigm(float x) { return 1.f / (1.f + __expf(-x)); }
__device__ __forceinline__ float silu(float x) { return x / (1.f + __expf(-x)); }
__device__ __forceinline__ float softplus(float x) { return x > 20.f ? x : log1pf(__expf(x)); }
__device__ __forceinline__ float wave_sum(float v) {
#pragma unroll
  for (int o = 32; o > 0; o >>= 1) v += __shfl_xor(v, o);
  return v;
}
template <int CTRL> __device__ __forceinline__ float dppf(float x) {
  return __builtin_bit_cast(float, __builtin_amdgcn_mov_dpp(__builtin_bit_cast(int, x), CTRL, 0xf, 0xf, true));
}
__device__ __forceinline__ float reduce8(float x) { x += dppf<0xB1>(x); x += dppf<0x4E>(x); x += dppf<0x141>(x); return x; }

__device__ __forceinline__ const float* xin_row(const Params& P, int l, int row) {
  if (l > 0) return P.out + (size_t)row * D;
  return row < NTP ? P.in[I_XP] + (size_t)row * D : P.in[I_XS] + (size_t)(row - NTP) * D;
}

__device__ __forceinline__ int gu_row(int c, int up) { return (c >> 6) * 128 + ((c >> 5) & 1) * 64 + up * 32 + (c & 31); }
__device__ void xpose_tile(unsigned char* smem, const float* __restrict__ W, int N, int kt, int ntl, bf16_t* __restrict__ dst, int dstK, int mode) {
  float (*tile)[65] = (float (*)[65])smem;
  const int tid = otid();
  __syncthreads();
#pragma unroll 4
  for (int i = 0; i < 16; ++i) {
    const int k = i * 4 + (tid >> 6), n = tid & 63, gn = ntl * 64 + n;
    tile[k][n] = gn < N ? W[(size_t)(kt * 64 + k) * N + gn] : 0.f;
  }
  __syncthreads();
#pragma unroll 4
  for (int i = 0; i < 16; ++i) {
    const int n = i * 4 + (tid >> 6), k = tid & 63, gn = ntl * 64 + n;
    const int drow = mode == 0 ? gn : gu_row(gn, mode - 1);
    dst[(size_t)drow * dstK + kt * 64 + k] = f2bf(tile[k][n]);
  }
}
__device__ void wconv_phase(const Params& P, unsigned char* smem, int l) {
  for (int job = obid(); job < 3392; job += gridDim.x) {
    if (job < 1024) xpose_tile(smem, P.in[I_WIN] + (size_t)l * 1024 * IN_COLS, IN_COLS, job & 15, job >> 4, WSP(bf16_t, OFF_WTIN), 1024, 0);
    else if (job < 1280) { const int j = job - 1024; xpose_tile(smem, P.in[I_WOUT] + (size_t)l * 1024 * 1024, 1024, j & 15, j >> 4, WSP(bf16_t, OFF_WTOUT), 1024, 0); }
    else if (job < 1984) { const int j = job - 1280; xpose_tile(smem, P.in[I_WG] + (size_t)l * 1024 * DFF, DFF, j & 15, j >> 4, WSP(bf16_t, OFF_WTGU), 1024, 1); }
    else if (job < 2688) { const int j = job - 1984; xpose_tile(smem, P.in[I_WU] + (size_t)l * 1024 * DFF, DFF, j & 15, j >> 4, WSP(bf16_t, OFF_WTGU), 1024, 2); }
    else { const int j = job - 2688; xpose_tile(smem, P.in[I_WD] + (size_t)l * DFF * 1024, 1024, j % 44, j / 44, WSP(bf16_t, OFF_WTDN), DFF, 0); }
  }
}

__device__ void norm_phase(const Params& P, int l_in, const float* __restrict__ w) {
  bf16_t* act = WSP(bf16_t, OFF_ACT);
  const int lane = otid() & 63, wid = otid() >> 6;
  for (int row = obid() * 4 + wid; row < NTOK; row += gridDim.x * 4) {
    const float* xr = xin_row(P, l_in, row);
    f32x4 v[4]; float ss = 0.f;
#pragma unroll
    for (int i = 0; i < 4; ++i) { v[i] = *(const f32x4*)(xr + i * 256 + lane * 4); ss += v[i][0] * v[i][0] + v[i][1] * v[i][1] + v[i][2] * v[i][2] + v[i][3] * v[i][3]; }
    ss = wave_sum(ss);
    const float rstd = rsqrtf(ss * (1.f / 1024.f) + 1e-6f);
#pragma unroll
    for (int i = 0; i < 4; ++i) {
      const f32x4 wv = *(const f32x4*)(w + i * 256 + lane * 4);
      u32x2 o; o[0] = pk2(v[i][0] * rstd * wv[0], v[i][1] * rstd * wv[1]); o[1] = pk2(v[i][2] * rstd * wv[2], v[i][3] * rstd * wv[3]);
      *(u32x2*)(act + (size_t)row * 1024 + i * 256 + lane * 4) = o;
    }
  }
}
__device__ void final_norm_phase(const Params& P) {
  const float* w = P.in[I_NORM_FINAL];
  const int lane = otid() & 63, wid = otid() >> 6;
  for (int row = obid() * 4 + wid; row < NTOK; row += gridDim.x * 4) {
    float* xr = P.out + (size_t)row * D;
    f32x4 v[4]; float ss = 0.f;
#pragma unroll
    for (int i = 0; i < 4; ++i) { v[i] = *(const f32x4*)(xr + i * 256 + lane * 4); ss += v[i][0] * v[i][0] + v[i][1] * v[i][1] + v[i][2] * v[i][2] + v[i][3] * v[i][3]; }
    ss = wave_sum(ss);
    const float rstd = rsqrtf(ss * (1.f / 1024.f) + 1e-6f);
#pragma unroll
    for (int i = 0; i < 4; ++i) {
      const f32x4 wv = *(const f32x4*)(w + i * 256 + lane * 4);
      f32x4 o; o[0] = v[i][0] * rstd * wv[0]; o[1] = v[i][1] * rstd * wv[1]; o[2] = v[i][2] * rstd * wv[2]; o[3] = v[i][3] * rstd * wv[3];
      *(f32x4*)(xr + i * 256 + lane * 4) = o;
    }
  }
}

enum { EPI_P = 0, EPI_RES = 1, EPI_SWIGLU = 2 };
template <int EPI>
__device__ void gemm_phase(const Params& P, unsigned char* smem, const bf16_t* __restrict__ A, int lda, const bf16_t* __restrict__ Bt, int K, int nN, int l) {
  const int tid = otid(), lane = tid & 63, wid = tid >> 6, wr = wid >> 1, wc = wid & 1, fr = lane & 15, fq = lane >> 4;
  const int ntiles = 129 * nN, nk = K >> 6;
  const int r0s = tid >> 3, cs = tid & 7;
  const int swz = (fr >> 1) & 7;
  for (int tile = obid(); tile < ntiles; tile += gridDim.x) {
    const int mt = tile / nN, nt = tile - mt * nN;
    const bf16_t* Ag = A + (size_t)(mt * 128 + r0s) * lda + cs * 8;
    const bf16_t* Bg = Bt + (size_t)(nt * 128 + r0s) * K + cs * 8;
    f32x4 acc[4][4];
#pragma unroll
    for (int m = 0; m < 4; ++m)
#pragma unroll
      for (int n = 0; n < 4; ++n) acc[m][n] = (f32x4){0.f, 0.f, 0.f, 0.f};
    u32x4 ra[4], rb[4];
#pragma unroll
    for (int i = 0; i < 4; ++i) { ra[i] = *(const u32x4*)(Ag + (size_t)i * 32 * lda); rb[i] = *(const u32x4*)(Bg + (size_t)i * 32 * K); }
#pragma unroll
    for (int i = 0; i < 4; ++i) {
      const int row = r0s + i * 32; const int off = row * 128 + ((cs ^ ((row >> 1) & 7)) << 4);
      *(u32x4*)(smem + off) = ra[i]; *(u32x4*)(smem + 16384 + off) = rb[i];
    }
    __syncthreads();
    for (int kt = 0; kt < nk; ++kt) {
      const bool nxt = kt + 1 < nk;
      if (nxt) {
#pragma unroll
        for (int i = 0; i < 4; ++i) { ra[i] = *(const u32x4*)(Ag + (size_t)i * 32 * lda + (kt + 1) * 64); rb[i] = *(const u32x4*)(Bg + (size_t)i * 32 * K + (kt + 1) * 64); }
      }
      const unsigned char* sA = smem + (kt & 1) * 32768;
      const unsigned char* sB = sA + 16384;
#pragma unroll
      for (int kk = 0; kk < 2; ++kk) {
        bf16x8 af[4], bfg[4];
        const int coff = ((kk * 4 + fq) ^ swz) << 4;
#pragma unroll
        for (int m = 0; m < 4; ++m) af[m] = *(const bf16x8*)(sA + (wr * 64 + m * 16 + fr) * 128 + coff);
#pragma unroll
        for (int n = 0; n < 4; ++n) bfg[n] = *(const bf16x8*)(sB + (wc * 64 + n * 16 + fr) * 128 + coff);
#pragma unroll
        for (int m = 0; m < 4; ++m)
#pragma unroll
          for (int n = 0; n < 4; ++n) acc[m][n] = __builtin_amdgcn_mfma_f32_16x16x32_bf16(bfg[n], af[m], acc[m][n], 0, 0, 0);
      }
      if (nxt) {
        unsigned char* dA = smem + ((kt + 1) & 1) * 32768;
#pragma unroll
        for (int i = 0; i < 4; ++i) {
          const int row = r0s + i * 32; const int off = row * 128 + ((cs ^ ((row >> 1) & 7)) << 4);
          *(u32x4*)(dA + off) = ra[i]; *(u32x4*)(dA + 16384 + off) = rb[i];
        }
      }
      __syncthreads();
    }
#pragma unroll
    for (int m = 0; m < 4; ++m) {
      const int row = mt * 128 + wr * 64 + m * 16 + fr;
      if (EPI == EPI_P) {
        bf16_t* pr = WSP(bf16_t, OFF_P) + (size_t)row * PSTR;
#pragma unroll
        for (int n = 0; n < 4; ++n) {
          const int col = nt * 128 + wc * 64 + n * 16 + fq * 4;
          if (col < IN_COLS) { u32x2 o; o[0] = pk2(acc[m][n][0], acc[m][n][1]); o[1] = pk2(acc[m][n][2], acc[m][n][3]); *(u32x2*)(pr + col) = o; }
        }
      } else if (EPI == EPI_RES) {
        const float* xi = xin_row(P, l, row);
        float* xo = P.out + (size_t)row * D;
#pragma unroll
        for (int n = 0; n < 4; ++n) {
          const int col = nt * 128 + wc * 64 + n * 16 + fq * 4;
          const f32x4 xv = *(const f32x4*)(xi + col);
          *(f32x4*)(xo + col) = xv + acc[m][n];
        }
      } else {
        bf16_t* ur = WSP(bf16_t, OFF_P) + (size_t)row * DFF;
#pragma unroll
        for (int n = 0; n < 2; ++n) {
          const int col = nt * 64 + wc * 32 + n * 16 + fq * 4;
          float r[4];
#pragma unroll
          for (int j = 0; j < 4; ++j) r[j] = silu(acc[m][n][j]) * acc[m][n + 2][j];
          u32x2 o; o[0] = pk2(r[0], r[1]); o[1] = pk2(r[2], r[3]);
          *(u32x2*)(ur + col) = o;
        }
      }
    }
  }
}

__device__ __forceinline__ float lbval(const Params& P, int l, int c) {
  const float* hb = P.in[I_HLB];
  const float a0 = hb[c], a1 = hb[256 + c], a2 = hb[512 + c], a3 = hb[768 + c];
  const float m = fmaxf(fmaxf(a0, a1), fmaxf(a2, a3));
  const float e0 = __expf(a0 - m), e1 = __expf(a1 - m), e2 = __expf(a2 - m), e3 = __expf(a3 - m);
  const float inv = 1.f / (e0 + e1 + e2 + e3);
  float s = 0.f;
  if (l >= 1) s += e1; if (l >= 2) s += e2; if (l >= 3) s += e3;
  return s * inv;
}

__device__ __forceinline__ void gdn_conv_emit(const Params& P, int g, int lane, int row, float s) {
  const int h = g % 6;
  if (g < 12) {
    const float ss = wave_sum(s * s);
    const float o = s * rsqrtf(ss + 1e-6f) * (g < 6 ? 0.125f : 1.f);
    (g < 6 ? WSP(bf16_t, OFF_GQ) : WSP(bf16_t, OFF_GK))[(size_t)row * 384 + h * 64 + lane] = f2bf(o);
  } else {
    WSP(bf16_t, OFF_GV)[(size_t)row * 384 + h * 64 + lane] = f2bf(s);
  }
}
__device__ __forceinline__ void gdn_gate_emit(const Params& P, int l, int h, int row) {
  const bf16_t* pr = WSP(bf16_t, OFF_P) + (size_t)row * PSTR;
  const float braw = bf2f(pr[1536 + h]), araw = bf2f(pr[1542 + h]);
  const float gg = -__expf(P.in[I_ALOG][l * 6 + h]) * softplus(araw + P.in[I_DTB][l * 6 + h]);
  WSP(float, OFF_GDEC)[(size_t)row * 8 + h] = __expf(gg);
  WSP(float, OFF_GBETA)[(size_t)row * 8 + h] = sigm(braw);
}
__device__ void prep_gdn_prompt(const Params& P, int l, int ci) {
  const int lane = otid() & 63, wid = otid() >> 6;
  const int r0 = ci * 32, b = r0 / TSEQ, t0 = r0 % TSEQ;
  const bf16_t* p = WSP(bf16_t, OFF_P);
  for (int g = wid; g < 18; g += 4) {
    const int col = g * 64 + lane;
    const float* cw = P.in[I_CONVW] + (size_t)l * 4 * 1152 + col;
    const float c0 = cw[0], c1 = cw[1152], c2 = cw[2304], c3 = cw[3456];
    float x3 = 0.f, x2 = 0.f, x1 = 0.f;
    if (t0 > 0) { x3 = bf2f(p[(size_t)(r0 - 3) * PSTR + col]); x2 = bf2f(p[(size_t)(r0 - 2) * PSTR + col]); x1 = bf2f(p[(size_t)(r0 - 1) * PSTR + col]); }
    for (int t = 0; t < 32; ++t) {
      const float x0 = bf2f(p[(size_t)(r0 + t) * PSTR + col]);
      const float y = c0 * x3 + c1 * x2 + c2 * x1 + c3 * x0;
      gdn_conv_emit(P, g, lane, r0 + t, silu(y));
      x3 = x2; x2 = x1; x1 = x0;
    }
    if (t0 + 32 == TSEQ) {
      float* cp = P.out + O_CONV_P + (size_t)(l * 8 + b) * 3 * 1152 + col;
      cp[0] = x3; cp[1152] = x2; cp[2304] = x1;
    }
    if (g < 6 && lane < 32) gdn_gate_emit(P, l, g, r0 + lane);
  }
}
__device__ void prep_gdn_sample(const Params& P, int l, int si) {
  const int lane = otid() & 63, wid = otid() >> 6;
  const bf16_t* p = WSP(bf16_t, OFF_P);
  for (int u = wid; u < 8 * 18; u += 4) {
    const int s = si * 8 + u / 18, g = u % 18, col = g * 64 + lane, row = NTP + s;
    const float* cw = P.in[I_CONVW] + (size_t)l * 4 * 1152 + col;
    const float c0 = cw[0], c1 = cw[1152], c2 = cw[2304], c3 = cw[3456];
    const float* cb = P.in[I_SCONV] + (size_t)(l * 128 + s) * 3 * 1152 + col;
    const float x3 = cb[0], x2 = cb[1152], x1 = cb[2304];
    const float x0 = bf2f(p[(size_t)row * PSTR + col]);
    const float y = c0 * x3 + c1 * x2 + c2 * x1 + c3 * x0;
    gdn_conv_emit(P, g, lane, row, silu(y));
    float* cp = P.out + O_CONV_S + (size_t)(l * 128 + s) * 3 * 1152 + col;
    cp[0] = x2; cp[1152] = x1; cp[2304] = x0;
    if (g < 6 && lane == 0) gdn_gate_emit(P, l, g, row);
  }
}
__device__ void prep_hgrn(const Params& P, int l, int ti) {
  const int c = otid();
  const float oml = 1.f - lbval(P, l, c);
  const bf16_t* p = WSP(bf16_t, OFF_P);
  bf16_t* hq = WSP(bf16_t, OFF_HQ); bf16_t* hk = WSP(bf16_t, OFF_HK);
  for (int t = 0; t < 64; ++t) {
    const int row = ti * 64 + t;
    const float q = bf2f(p[(size_t)row * PSTR + PC + c]), f = bf2f(p[(size_t)row * PSTR + PC + 256 + c]);
    hq[(size_t)row * 256 + c] = f2bf(silu(q) * 0.125f);
    hk[(size_t)row * 256 + c] = f2bf(oml * sigm(-f));
  }
}
__device__ __forceinline__ float rwkv_xs(const Params& P, int l, int row, int col) {
  const bf16_t* p = WSP(bf16_t, OFF_P);
  const float pv = bf2f(p[(size_t)row * PSTR + PB + col]);
  float prev;
  if (row >= NTP) prev = P.in[I_SSHIFT][(size_t)(l * 128 + (row - NTP)) * 1408 + col];
  else if ((row & (TSEQ - 1)) == 0) prev = 0.f;
  else prev = bf2f(p[(size_t)(row - 1) * PSTR + PB + col]);
  return pv + (prev - pv) * P.in[I_MU][l * 1408 + col];
}
__device__ void prep_rwkv(const Params& P, unsigned char* smem, int l, int ti) {
  float* sWd = (float*)smem;
  float* sAd = sWd + 16 * 64;
  float* sGd = sAd + 16 * 64;
  float* sV = sGd + 16 * 128;
  float* sVlo = sV + 16 * 384;
  const int tid = otid(), lane = tid & 63;
  const int r0 = ti * 16;
  __syncthreads();
  for (int idx = tid; idx < 16 * 256; idx += 256) {
    const int tok = idx >> 8, j = idx & 255;
    const float x = rwkv_xs(P, l, r0 + tok, 1152 + j);
    if (j < 64) sWd[tok * 64 + j] = tanhf(x);
    else if (j < 128) sAd[tok * 64 + (j - 64)] = x;
    else sGd[tok * 128 + (j - 128)] = sigm(x);
  }
  for (int idx = tid; idx < 16 * 384; idx += 256) {
    const int tok = idx / 384, c = idx - tok * 384;
    sV[idx] = rwkv_xs(P, l, r0 + tok, 768 + c);
  }
  __syncthreads();
  if (l > 0) {
    const float* v1 = P.in[I_V1] + (size_t)(l - 1) * 384 * 32;
#pragma unroll
    for (int it = 0; it < 2; ++it) {
      const int id = tid + it * 256, j = id & 31, tok = id >> 5;
      float a = 0.f;
#pragma unroll 4
      for (int c = 0; c < 384; ++c) a += sV[tok * 384 + c] * v1[c * 32 + j];
      sVlo[tok * 32 + j] = a;
    }
    __syncthreads();
  }
  const float* w2 = P.in[I_W2] + (size_t)l * 64 * 384;
  const float* a2 = P.in[I_A2] + (size_t)l * 64 * 384;
  const float* g2 = P.in[I_G2] + (size_t)l * 128 * 384;
#pragma unroll 1
  for (int it = 0; it < 6; ++it) {
    const int id = tid + it * 256, c = id % 384, tg = id / 384;
    float aw[4], aa[4], ag[4], av[4];
#pragma unroll
    for (int k = 0; k < 4; ++k) { aw[k] = 0.f; aa[k] = 0.f; ag[k] = 0.f; av[k] = 0.f; }
#pragma unroll 1
    for (int r = 0; r < 64; r += 4) {
      float wv[4], avv[4];
#pragma unroll
      for (int i = 0; i < 4; ++i) { wv[i] = w2[(r + i) * 384 + c]; avv[i] = a2[(r + i) * 384 + c]; }
#pragma unroll
      for (int k = 0; k < 4; ++k) {
        const f32x4 x = *(const f32x4*)(sWd + (tg * 4 + k) * 64 + r);
        const f32x4 y = *(const f32x4*)(sAd + (tg * 4 + k) * 64 + r);
        aw[k] += x[0] * wv[0] + x[1] * wv[1] + x[2] * wv[2] + x[3] * wv[3];
        aa[k] += y[0] * avv[0] + y[1] * avv[1] + y[2] * avv[2] + y[3] * avv[3];
      }
    }
#pragma unroll 1
    for (int r = 0; r < 128; r += 4) {
      float gv[4];
#pragma unroll
      for (int i = 0; i < 4; ++i) gv[i] = g2[(r + i) * 384 + c];
#pragma unroll
      for (int k = 0; k < 4; ++k) {
        const f32x4 x = *(const f32x4*)(sGd + (tg * 4 + k) * 128 + r);
        ag[k] += x[0] * gv[0] + x[1] * gv[1] + x[2] * gv[2] + x[3] * gv[3];
      }
    }
    if (l > 0) {
      const float* v2 = P.in[I_V2] + (size_t)(l - 1) * 32 * 384;
#pragma unroll 1
      for (int r = 0; r < 32; r += 4) {
        float vv[4];
#pragma unroll
        for (int i = 0; i < 4; ++i) vv[i] = v2[(r + i) * 384 + c];
#pragma unroll
        for (int k = 0; k < 4; ++k) {
          const f32x4 x = *(const f32x4*)(sVlo + (tg * 4 + k) * 32 + r);
          av[k] += x[0] * vv[0] + x[1] * vv[1] + x[2] * vv[2] + x[3] * vv[3];
        }
      }
    }
    const float w0 = P.in[I_W0][l * 384 + c], a0 = P.in[I_A0][l * 384 + c], kkw = P.in[I_KK][l * 384 + c], kaw = P.in[I_KA][l * 384 + c];
    const float v0 = l > 0 ? P.in[I_V0][(l - 1) * 384 + c] : 0.f;
    bf16_t* vf = WSP(bf16_t, OFF_VF);
#pragma unroll
    for (int k = 0; k < 4; ++k) {
      const int tok = tg * 4 + k, row = r0 + tok;
      const float rr = rwkv_xs(P, l, row, c), kraw = rwkv_xs(P, l, row, 384 + c), vraw = sV[tok * 384 + c];
      const float wl = -softplus(-(w0 + aw[k])) - 0.5f;
      const float dec = __expf(-__expf(wl));
      const float a = sigm(a0 + aa[k]);
      float vv = vraw;
      if (l > 0) { const float mixv = sigm(v0 + av[k]); vv = vraw + (bf2f(vf[(size_t)row * 384 + c]) - vraw) * mixv; }
      else vf[(size_t)row * 384 + c] = f2bf(vraw);
      const float kkr = kraw * kkw;
      const float ss = wave_sum(kkr * kkr);
      const float kk = kkr * rsqrtf(ss + 1e-6f);
      const float kn = kraw * (1.f + (a - 1.f) * kaw);
      const size_t o = (size_t)row * 384 + c;
      WSP(bf16_t, OFF_RR)[o] = f2bf(rr); WSP(bf16_t, OFF_RK)[o] = f2bf(kn); WSP(bf16_t, OFF_RV)[o] = f2bf(vv);
      WSP(bf16_t, OFF_RKK)[o] = f2bf(kk); WSP(bf16_t, OFF_RB)[o] = f2bf(kk * a); WSP(bf16_t, OFF_RG)[o] = f2bf(ag[k]);
      WSP(float, OFF_RW)[o] = dec;
    }
  }
  const bf16_t* p = WSP(bf16_t, OFF_P);
  if (r0 >= NTP) {
    for (int idx = tid; idx < 16 * 1408; idx += 256) {
      const int tok = idx / 1408, col = idx - tok * 1408, s = r0 - NTP + tok;
      P.out[O_SHIFT_S + (size_t)(l * 128 + s) * 1408 + col] = bf2f(p[(size_t)(r0 + tok) * PSTR + PB + col]);
    }
  } else if (((r0 + 16) & (TSEQ - 1)) == 0) {
    const int b = r0 / TSEQ;
    for (int col = tid; col < 1408; col += 256) P.out[O_SHIFT_P + (size_t)(l * 8 + b) * 1408 + col] = bf2f(p[(size_t)(r0 + 15) * PSTR + PB + col]);
  }
}
__device__ void prep_phase(const Params& P, unsigned char* smem, int l) {
  for (int it = obid(); it < 1818; it += gridDim.x) {
    if (it < 1032) prep_rwkv(P, smem, l, it);
    else if (it < 1544) prep_gdn_prompt(P, l, it - 1032);
    else if (it < 1560) prep_gdn_sample(P, l, it - 1544);
    else prep_hgrn(P, l, it - 1560);
  }
}

template <int KIND> struct ScanCfg { static constexpr int STRIDE = KIND == 0 ? 164 : (KIND == 1 ? 352 : 160); };

__device__ __forceinline__ f32x4 unpack4(u32x2 w) {
  f32x4 f; f[0] = __uint_as_float(w[0] << 16); f[1] = __uint_as_float(w[0] & 0xffff0000u);
  f[2] = __uint_as_float(w[1] << 16); f[3] = __uint_as_float(w[1] & 0xffff0000u); return f;
}
template <int KIND> struct ScanPre { u32x2 a, b, c, d, v; f32x4 w; float g; };

template <int KIND>
__device__ __forceinline__ void scan_load(const Params& P, ScanPre<KIND>& r, int h, int half, int rowbase, int nvalid) {
  const int tid = otid();
  const int s = tid >> 4, j4 = (tid & 15) * 4;
  const int s2 = (tid >> 3) & 15, j2 = (tid & 7) * 4;
  const u32x2 z2 = {0u, 0u};
  const bool ok = s < nvalid, ok2 = (tid < 128) && (s2 < nvalid);
  if (KIND == 0) {
    const size_t o = (size_t)(rowbase + s) * 384 + h * 64 + j4;
    r.a = ok ? *(const u32x2*)(WSP(bf16_t, OFF_GK) + o) : z2;
    r.b = ok ? *(const u32x2*)(WSP(bf16_t, OFF_GQ) + o) : z2;
    r.v = ok2 ? *(const u32x2*)(WSP(bf16_t, OFF_GV) + (size_t)(rowbase + s2) * 384 + h * 64 + half * 32 + j2) : z2;
    const int sg = (tid >> 1) & 15;
    r.g = (tid < 32 && sg < nvalid) ? ((tid & 1) ? WSP(float, OFF_GBETA) : WSP(float, OFF_GDEC))[(size_t)(rowbase + sg) * 8 + h] : 0.f;
  } else if (KIND == 1) {
    const size_t o = (size_t)(rowbase + s) * 384 + h * 64 + j4;
    r.a = ok ? *(const u32x2*)(WSP(bf16_t, OFF_RR) + o) : z2;
    r.w = ok ? *(const f32x4*)(WSP(float, OFF_RW) + o) : (f32x4){0.f, 0.f, 0.f, 0.f};
    r.b = ok ? *(const u32x2*)(WSP(bf16_t, OFF_RK) + o) : z2;
    r.c = ok ? *(const u32x2*)(WSP(bf16_t, OFF_RKK) + o) : z2;
    r.d = ok ? *(const u32x2*)(WSP(bf16_t, OFF_RB) + o) : z2;
    r.v = ok2 ? *(const u32x2*)(WSP(bf16_t, OFF_RV) + (size_t)(rowbase + s2) * 384 + h * 64 + half * 32 + j2) : z2;
  } else {
    const size_t o = (size_t)(rowbase + s) * 256 + h * 64 + j4;
    r.a = ok ? *(const u32x2*)(WSP(bf16_t, OFF_HQ) + o) : z2;
    r.b = ok ? *(const u32x2*)(WSP(bf16_t, OFF_HK) + o) : z2;
    r.v = ok2 ? *(const u32x2*)(WSP(bf16_t, OFF_P) + (size_t)(rowbase + s2) * PSTR + PC + 512 + h * 64 + half * 32 + j2) : z2;
  }
}
template <int KIND>
__device__ __forceinline__ void scan_store(const ScanPre<KIND>& r, float* buf) {
  constexpr int STRIDE = ScanCfg<KIND>::STRIDE;
  const int tid = otid();
  const int s = tid >> 4, j4 = (tid & 15) * 4;
  const int s2 = (tid >> 3) & 15, j2 = (tid & 7) * 4;
  float* bs = buf + s * STRIDE + j4;
  if (KIND == 0) {
    *(f32x4*)(bs) = unpack4(r.a); *(f32x4*)(bs + 64) = unpack4(r.b);
    if (tid < 128) *(f32x4*)(buf + s2 * STRIDE + 128 + j2) = unpack4(r.v);
    if (tid < 32) buf[((tid >> 1) & 15) * STRIDE + 160 + (tid & 1)] = r.g;
  } else if (KIND == 1) {
    *(f32x4*)(bs) = unpack4(r.a); *(f32x4*)(bs + 64) = r.w; *(f32x4*)(bs + 128) = unpack4(r.b);
    *(f32x4*)(bs + 192) = unpack4(r.c); *(f32x4*)(bs + 256) = unpack4(r.d);
    if (tid < 128) *(f32x4*)(buf + s2 * STRIDE + 320 + j2) = unpack4(r.v);
  } else {
    *(f32x4*)(bs) = unpack4(r.a); *(f32x4*)(bs + 64) = unpack4(r.b);
    if (tid < 128) *(f32x4*)(buf + s2 * STRIDE + 128 + j2) = unpack4(r.v);
  }
}

template <int KIND>
__device__ void scan_task(const Params& P, unsigned char* smem, int l, int seq, int h, int half) {
  constexpr int STRIDE = ScanCfg<KIND>::STRIDE, NEL = 16 * STRIDE;
  constexpr int NH = KIND == 2 ? 4 : 6;
  float* buf = (float*)smem;
  float* obuf = buf + 2 * NEL;
  const int tid = otid(), lane = tid & 63, wid = tid >> 6;
  const int col_l = lane >> 3, sub = lane & 7, cl = wid * 8 + col_l, col = half * 32 + cl, e0 = sub * 8;
  const bool sample = seq >= 8;
  const int R0 = sample ? NTP + (seq - 8) : seq * TSEQ, T = sample ? 1 : TSEQ;
  const int ocol = (KIND == 0 ? 0 : (KIND == 1 ? 384 : 768)) + h * 64 + half * 32;
  const size_t O_P = KIND == 0 ? O_GDN_P : (KIND == 1 ? O_RWKV_P : O_HGRN_P);
  const size_t O_S = KIND == 0 ? O_GDN_S : (KIND == 1 ? O_RWKV_S : O_HGRN_S);
  const int I_ST = KIND == 0 ? I_SGDN : (KIND == 1 ? I_SRWKV : I_SHGRN);
  float S[8];
  if (sample) {
    const float* st = P.in[I_ST] + ((size_t)(l * 128 + (seq - 8)) * NH + h) * 4096;
#pragma unroll
    for (int i = 0; i < 8; ++i) S[i] = KIND == 1 ? st[col * 64 + e0 + i] : st[(e0 + i) * 64 + col];
  } else {
#pragma unroll
    for (int i = 0; i < 8; ++i) S[i] = 0.f;
  }
  ScanPre<KIND> pre;
  __syncthreads();
  scan_load<KIND>(P, pre, h, half, R0, T);
  scan_store<KIND>(pre, buf);
  __syncthreads();
  const int nchunks = (T + 15) >> 4;
  bf16_t* oraw = WSP(bf16_t, OFF_P);
  for (int c = 0; c < nchunks; ++c) {
    const int t0 = c * 16, n = (T - t0) < 16 ? (T - t0) : 16;
    const bool has_next = c + 1 < nchunks;
    if (has_next) scan_load<KIND>(P, pre, h, half, R0 + t0 + 16, T - t0 - 16);
    const float* b = buf + (c & 1) * NEL;
    float* ob = obuf + (c & 1) * 512;
    for (int s = 0; s < n; ++s) {
      const float* bs = b + s * STRIDE;
      float o;
      if (KIND == 0) {
        const f32x4 k0 = *(const f32x4*)(bs + e0), k1 = *(const f32x4*)(bs + e0 + 4);
        const f32x4 q0 = *(const f32x4*)(bs + 64 + e0), q1 = *(const f32x4*)(bs + 64 + e0 + 4);
        const float vv = bs[128 + cl], dec = bs[160], beta = bs[161];
        const float kf[8] = {k0[0], k0[1], k0[2], k0[3], k1[0], k1[1], k1[2], k1[3]};
        const float qf[8] = {q0[0], q0[1], q0[2], q0[3], q1[0], q1[1], q1[2], q1[3]};
        float ks = 0.f;
#pragma unroll
        for (int i = 0; i < 8; ++i) ks += kf[i] * S[i];
        ks = reduce8(ks);
        const float vn = beta * (vv - dec * ks);
        o = 0.f;
#pragma unroll
        for (int i = 0; i < 8; ++i) { S[i] = dec * S[i] + kf[i] * vn; o += qf[i] * S[i]; }
        o = reduce8(o);
      } else if (KIND == 1) {
        const f32x4 r0 = *(const f32x4*)(bs + e0), r1 = *(const f32x4*)(bs + e0 + 4);
        const f32x4 w0 = *(const f32x4*)(bs + 64 + e0), w1 = *(const f32x4*)(bs + 64 + e0 + 4);
        const f32x4 k0 = *(const f32x4*)(bs + 128 + e0), k1 = *(const f32x4*)(bs + 128 + e0 + 4);
        const f32x4 c0 = *(const f32x4*)(bs + 192 + e0), c1 = *(const f32x4*)(bs + 192 + e0 + 4);
        const f32x4 b0 = *(const f32x4*)(bs + 256 + e0), b1 = *(const f32x4*)(bs + 256 + e0 + 4);
        const float vv = bs[320 + cl];
        const float rf[8] = {r0[0], r0[1], r0[2], r0[3], r1[0], r1[1], r1[2], r1[3]};
        const float wf[8] = {w0[0], w0[1], w0[2], w0[3], w1[0], w1[1], w1[2], w1[3]};
        const float kf[8] = {k0[0], k0[1], k0[2], k0[3], k1[0], k1[1], k1[2], k1[3]};
        const float cf[8] = {c0[0], c0[1], c0[2], c0[3], c1[0], c1[1], c1[2], c1[3]};
        const float bf[8] = {b0[0], b0[1], b0[2], b0[3], b1[0], b1[1], b1[2], b1[3]};
        float sa = 0.f;
#pragma unroll
        for (int i = 0; i < 8; ++i) sa += S[i] * cf[i];
        sa = -reduce8(sa);
        o = 0.f;
#pragma unroll
        for (int i = 0; i < 8; ++i) { S[i] = S[i] * wf[i] + sa * bf[i] + vv * kf[i]; o += S[i] * rf[i]; }
        o = reduce8(o);
      } else {
        const f32x4 q0 = *(const f32x4*)(bs + e0), q1 = *(const f32x4*)(bs + e0 + 4);
        const f32x4 k0 = *(const f32x4*)(bs + 64 + e0), k1 = *(const f32x4*)(bs + 64 + e0 + 4);
        const float iv = bs[128 + cl];
        const float qf[8] = {q0[0], q0[1], q0[2], q0[3], q1[0], q1[1], q1[2], q1[3]};
        const float kf[8] = {k0[0], k0[1], k0[2], k0[3], k1[0], k1[1], k1[2], k1[3]};
        o = 0.f;
#pragma unroll
        for (int i = 0; i < 8; ++i) { S[i] = S[i] + kf[i] * (iv - S[i]); o += qf[i] * S[i]; }
        o = reduce8(o);
      }
      if (sub == 0) ob[s * 32 + cl] = o;
    }
    if (has_next) scan_store<KIND>(pre, buf + ((c + 1) & 1) * NEL);
    __syncthreads();
#pragma unroll
    for (int i = 0; i < 2; ++i) {
      const int idx = tid + i * 256, s = idx >> 5, cc = idx & 31;
      if (s < n) oraw[(size_t)(R0 + t0 + s) * PSTR + ocol + cc] = f2bf(ob[idx]);
    }
  }
  float* so = P.out + (sample ? O_S + ((size_t)(l * 128 + (seq - 8)) * NH + h) * 4096 : O_P + ((size_t)(l * 8 + seq) * NH + h) * 4096);
#pragma unroll
  for (int i = 0; i < 8; ++i) { if (KIND == 1) so[col * 64 + e0 + i] = S[i]; else so[(e0 + i) * 64 + col] = S[i]; }
}

__device__ void scan_long(const Params& P, unsigned char* smem, int l, int lt) {
  if (lt < 96) { const int half = lt & 1, bh = lt >> 1; scan_task<1>(P, smem, l, bh / 6, bh % 6, half); }
  else if (lt < 192) { const int x = lt - 96, half = x & 1, bh = x >> 1; scan_task<0>(P, smem, l, bh / 6, bh % 6, half); }
  else { const int x = lt - 192, half = x & 1, bh = x >> 1; scan_task<2>(P, smem, l, bh / 4, bh % 4, half); }
}
__device__ void scan_short(const Params& P, unsigned char* smem, int l, int st) {
  const int s = st >> 4, hh = st & 15;
  for (int half = 0; half < 2; ++half) {
    if (hh < 6) scan_task<0>(P, smem, l, 8 + s, hh, half);
    else if (hh < 12) scan_task<1>(P, smem, l, 8 + s, hh - 6, half);
    else scan_task<2>(P, smem, l, 8 + s, hh - 12, half);
  }
}
__device__ void scan_phase(const Params& P, unsigned char* smem, int l) {
  const int G = gridDim.x, bid = obid();
  if (G >= 512) {
    if (bid < 256) scan_long(P, smem, l, bid);
    else for (int st = bid - 256; st < 2048; st += G - 256) scan_short(P, smem, l, st);
  } else {
    for (int lt = bid; lt < 256; lt += G) scan_long(P, smem, l, lt);
    for (int st = bid; st < 2048; st += G) scan_short(P, smem, l, st);
  }
}

__device__ void post_phase(const Params& P, int l) {
  const int lane = otid() & 63, wid = otid() >> 6;
  const bf16_t* p = WSP(bf16_t, OFF_P);
  bf16_t* act = WSP(bf16_t, OFF_ACT);
  const float gnw = P.in[I_GNW][l * 64 + lane], hnw = P.in[I_HNW][l * 64 + lane];
  for (int u = obid() * 4 + wid; u < NTOK * 16; u += gridDim.x * 4) {
    const int row = u >> 4, hh = u & 15;
    const float o = bf2f(p[(size_t)row * PSTR + hh * 64 + lane]);
    float out;
    if (hh < 6) {
      const float z = bf2f(p[(size_t)row * PSTR + 1152 + hh * 64 + lane]);
      const float ms = wave_sum(o * o) * (1.f / 64.f);
      out = o * rsqrtf(ms + 1e-6f) * gnw * silu(z);
    } else if (hh < 12) {
      const int h = hh - 6; const size_t idx = (size_t)row * 384 + h * 64 + lane;
      const float mu = wave_sum(o) * (1.f / 64.f);
      const float yc = o - mu;
      const float var = wave_sum(yc * yc) * (1.f / 64.f);
      const float y = yc * rsqrtf(var + 64e-5f) * P.in[I_LNW][l * 384 + h * 64 + lane] + P.in[I_LNB][l * 384 + h * 64 + lane];
      const float r = bf2f(WSP(bf16_t, OFF_RR)[idx]), k = bf2f(WSP(bf16_t, OFF_RK)[idx]), v = bf2f(WSP(bf16_t, OFF_RV)[idx]), g = bf2f(WSP(bf16_t, OFF_RG)[idx]);
      const float rk = wave_sum(r * k * P.in[I_RK][l * 384 + h * 64 + lane]);
      out = (y + rk * v) * g;
    } else {
      const int h = hh - 12;
      const float z = bf2f(p[(size_t)row * PSTR + PC + 768 + h * 64 + lane]);
      const float ms = wave_sum(o * o) * (1.f / 64.f);
      out = o * rsqrtf(ms + 1e-6f) * hnw * silu(z);
    }
    act[(size_t)row * 1024 + hh * 64 + lane] = f2bf(out);
  }
}

__global__ void __launch_bounds__(256, 2) hybrid_fwd(Params P) {
  cg::grid_group grid = cg::this_grid();
  __shared__ __attribute__((aligned(16))) unsigned char smem[65536];
  for (int l = 0; l < NLAYER; ++l) {
    wconv_phase(P, smem, l);
    norm_phase(P, l, P.in[I_NORM_MIX] + l * D);
    grid.sync();
    gemm_phase<EPI_P>(P, smem, WSP(bf16_t, OFF_ACT), 1024, WSP(bf16_t, OFF_WTIN), 1024, 32, l);
    grid.sync();
    prep_phase(P, smem, l);
    grid.sync();
    scan_phase(P, smem, l);
    grid.sync();
    post_phase(P, l);
    grid.sync();
    gemm_phase<EPI_RES>(P, smem, WSP(bf16_t, OFF_ACT), 1024, WSP(bf16_t, OFF_WTOUT), 1024, 8, l);
    grid.sync();
    norm_phase(P, 1, P.in[I_NORM_FFN] + l * D);
    grid.sync();
    gemm_phase<EPI_SWIGLU>(P, smem, WSP(bf16_t, OFF_ACT), 1024, WSP(bf16_t, OFF_WTGU), 1024, 44, 1);
    grid.sync();
    gemm_phase<EPI_RES>(P, smem, WSP(bf16_t, OFF_P), DFF, WSP(bf16_t, OFF_WTDN), DFF, 8, 1);
    grid.sync();
  }
  final_norm_phase(P);
}

extern "C" void kernel_launch(void* const* d_in, const int* in_sizes, int n_in,
                              void* d_out, int out_size, void* d_ws, size_t ws_size,
                              hipStream_t stream) {
  static int grid_blocks = 0;
  if (!grid_blocks) {
    int dev = 0, cus = 0, per_cu = 0;
    (void)hipGetDevice(&dev);
    (void)hipDeviceGetAttribute(&cus, hipDeviceAttributeMultiprocessorCount, dev);
    (void)hipOccupancyMaxActiveBlocksPerMultiprocessor(&per_cu, hybrid_fwd, 256, 0);
    if (per_cu > 2) per_cu = 2;
    if (per_cu < 1) per_cu = 1;
    grid_blocks = cus * per_cu;
  }
  if (ws_size < WS_NEED) { fprintf(stderr, "workspace too small: %zu < %zu\n", ws_size, (size_t)WS_NEED); return; }
  Params p{};
  for (int i = 0; i < N_IN; ++i) p.in[i] = (const float*)d_in[i];
  p.out = (float*)d_out;
  p.ws = (unsigned char*)d_ws;
  void* args[] = {&p};
  hipError_t e = hipLaunchCooperativeKernel((void*)hybrid_fwd, dim3(grid_blocks), dim3(256), args, 0, stream);
  if (e != hipSuccess) fprintf(stderr, "cooperative launch failed: %s (grid %d)\n", hipGetErrorString(e), grid_blocks);
}
```

```cpp
#include <hip/hip_runtime.h>
#include <hip/hip_cooperative_groups.h>
#include <cstdio>
namespace cg = cooperative_groups;

typedef unsigned short bf16_t;
typedef short bf16x8 __attribute__((ext_vector_type(8)));
typedef float f32x4 __attribute__((ext_vector_type(4)));
typedef unsigned u32x4 __attribute__((ext_vector_type(4)));
typedef unsigned u32x2 __attribute__((ext_vector_type(2)));

constexpr int D = 1024, NTP = 16384, NTS = 128, NTOK = 16512, TSEQ = 2048, NLAYER = 4;
constexpr int IN_COLS = 3980, PSTR = 3984, DFF = 2816;
constexpr int PB = 1548, PC = 2956;

enum { I_XP = 0, I_XS, I_SGDN, I_SCONV, I_SRWKV, I_SSHIFT, I_SHGRN, I_NORM_MIX, I_WIN, I_WOUT, I_CONVW, I_ALOG, I_DTB, I_GNW,
       I_MU, I_W0, I_W2, I_A0, I_A2, I_G2, I_V0, I_V1, I_V2, I_KK, I_KA, I_RK, I_LNW, I_LNB, I_HLB, I_HNW, I_NORM_FFN,
       I_WG, I_WU, I_WD, I_NORM_FINAL, N_IN };

constexpr size_t O_YP = 0, O_YS = 16777216, O_GDN_P = 16908288, O_GDN_S = 17694720, O_CONV_P = 30277632, O_CONV_S = 30388224,
                 O_RWKV_P = 32157696, O_RWKV_S = 32944128, O_SHIFT_P = 45527040, O_SHIFT_S = 45572096, O_HGRN_P = 46292992,
                 O_HGRN_S = 46817280;

constexpr size_t SZ_WTIN = (size_t)4096 * 1024 * 2, SZ_WTOUT = (size_t)1024 * 1024 * 2, SZ_WTGU = (size_t)5632 * 1024 * 2,
                 SZ_WTDN = (size_t)1024 * 2816 * 2, SZ_P = (size_t)NTOK * PSTR * 2, SZ_ACT = (size_t)NTOK * 1024 * 2,
                 SZ_T384 = (size_t)NTOK * 384 * 2, SZ_T8F = (size_t)NTOK * 8 * 4, SZ_T256 = (size_t)NTOK * 256 * 2,
                 SZ_T384F = (size_t)NTOK * 384 * 4;
constexpr size_t OFF_WTIN = 0, OFF_WTOUT = OFF_WTIN + SZ_WTIN, OFF_WTGU = OFF_WTOUT + SZ_WTOUT, OFF_WTDN = OFF_WTGU + SZ_WTGU,
                 OFF_P = OFF_WTDN + SZ_WTDN, OFF_ACT = OFF_P + SZ_P, OFF_GQ = OFF_ACT + SZ_ACT, OFF_GK = OFF_GQ + SZ_T384,
                 OFF_GV = OFF_GK + SZ_T384, OFF_GDEC = OFF_GV + SZ_T384, OFF_GBETA = OFF_GDEC + SZ_T8F, OFF_HQ = OFF_GBETA + SZ_T8F,
                 OFF_HK = OFF_HQ + SZ_T256, OFF_RR = OFF_HK + SZ_T256, OFF_RK = OFF_RR + SZ_T384, OFF_RV = OFF_RK + SZ_T384,
                 OFF_RKK = OFF_RV + SZ_T384, OFF_RB = OFF_RKK + SZ_T384, OFF_RG = OFF_RB + SZ_T384, OFF_RW = OFF_RG + SZ_T384,
                 OFF_VF = OFF_RW + SZ_T384F, OFF_LORA = OFF_VF + SZ_T384, WS_NEED = OFF_LORA + 245760;
constexpr int W2T = 0, A2T = 24576, G2T = 49152, V1T = 98304, V2T = 110592;

struct Params {
  const float* in[N_IN];
  float* out;
  unsigned char* ws;
};

#define WSP(T, off) ((T*)(P.ws + (off)))

__device__ __forceinline__ int otid() { int t = __builtin_amdgcn_workitem_id_x(); asm volatile("" : "+v"(t)); return t; }
__device__ __forceinline__ int obid() { int b = __builtin_amdgcn_workgroup_id_x(); asm volatile("" : "+s"(b)); return b; }
__device__ __forceinline__ float bf2f(bf16_t h) { return __uint_as_float(((unsigned)h) << 16); }
typedef float f32x2_t __attribute__((ext_vector_type(2)));
typedef __bf16 bf16x2_t __attribute__((ext_vector_type(2)));
__device__ __forceinline__ unsigned pk2(float lo, float hi) {
  const f32x2_t v = {lo, hi};
  return __builtin_bit_cast(unsigned, __builtin_convertvector(v, bf16x2_t));
}
__device__ __forceinline__ bf16_t f2bf(float f) { return (bf16_t)(pk2(f, 0.f) & 0xffffu); }
__device__ __forceinline__ float sigm(float x) { return 1.f / (1.f + __expf(-x)); }
__device__ __forceinline__ float silu(float x) { return x / (1.f + __expf(-x)); }
__device__ __forceinline__ float softplus(float x) { return x > 20.f ? x : log1pf(__expf(x)); }
template <int CTRL> __device__ __forceinline__ float dppf(float x) {
  return __builtin_bit_cast(float, __builtin_amdgcn_mov_dpp(__builtin_bit_cast(int, x), CTRL, 0xf, 0xf, true));
}
__device__ __forceinline__ float wave_sum(float v) {
  v += dppf<0xB1>(v); v += dppf<0x4E>(v); v += dppf<0x141>(v); v += dppf<0x140>(v);
  const int iv = __builtin_bit_cast(int, v);
  const float s0 = __builtin_bit_cast(float, __builtin_amdgcn_readlane(iv, 0)), s1 = __builtin_bit_cast(float, __builtin_amdgcn_readlane(iv, 16));
  const float s2 = __builtin_bit_cast(float, __builtin_amdgcn_readlane(iv, 32)), s3 = __builtin_bit_cast(float, __builtin_amdgcn_readlane(iv, 48));
  return (s0 + s1) + (s2 + s3);
}
__device__ __forceinline__ float reduce8(float x) { x += dppf<0xB1>(x); x += dppf<0x4E>(x); x += dppf<0x141>(x); return x; }

__device__ __forceinline__ f32x4 unpack4(u32x2 w) {
  f32x4 f; f[0] = __uint_as_float(w[0] << 16); f[1] = __uint_as_float(w[0] & 0xffff0000u);
  f[2] = __uint_as_float(w[1] << 16); f[3] = __uint_as_float(w[1] & 0xffff0000u); return f;
}
__device__ __forceinline__ bf16x8 pack8(f32x4 a, f32x4 b) {
  u32x4 u; u[0] = pk2(a[0], a[1]); u[1] = pk2(a[2], a[3]); u[2] = pk2(b[0], b[1]); u[3] = pk2(b[2], b[3]);
  return __builtin_bit_cast(bf16x8, u);
}
__device__ __forceinline__ u32x2 pack4(f32x4 a) { u32x2 u; u[0] = pk2(a[0], a[1]); u[1] = pk2(a[2], a[3]); return u; }
__device__ __forceinline__ const float* xin_row(const Params& P, int l, int row) {
  if (l > 0) return P.out + (size_t)row * D;
  return row < NTP ? P.in[I_XP] + (size_t)row * D : P.in[I_XS] + (size_t)(row - NTP) * D;
}

__device__ __forceinline__ int gu_row(int c, int up) { return (c >> 6) * 128 + ((c >> 5) & 1) * 64 + up * 32 + (c & 31); }
__device__ void xpose_tile(unsigned char* smem, const float* __restrict__ W, int N, int kt, int ntl, bf16_t* __restrict__ dst, int dstK, int mode) {
  float (*tile)[65] = (float (*)[65])smem;
  const int tid = otid();
  __syncthreads();
#pragma unroll 4
  for (int i = 0; i < 16; ++i) {
    const int k = i * 4 + (tid >> 6), n = tid & 63, gn = ntl * 64 + n;
    tile[k][n] = gn < N ? W[(size_t)(kt * 64 + k) * N + gn] : 0.f;
  }
  __syncthreads();
#pragma unroll 4
  for (int i = 0; i < 16; ++i) {
    const int n = i * 4 + (tid >> 6), k = tid & 63, gn = ntl * 64 + n;
    const int drow = mode == 0 ? gn : gu_row(gn, mode - 1);
    dst[(size_t)drow * dstK + kt * 64 + k] = f2bf(tile[k][n]);
  }
}
__device__ void wconv_phase(const Params& P, unsigned char* smem, int l) {
  for (int job = obid(); job < 3392; job += gridDim.x) {
    if (job < 1024) xpose_tile(smem, P.in[I_WIN] + (size_t)l * 1024 * IN_COLS, IN_COLS, job & 15, job >> 4, WSP(bf16_t, OFF_WTIN), 1024, 0);
    else if (job < 1280) { const int j = job - 1024; xpose_tile(smem, P.in[I_WOUT] + (size_t)l * 1024 * 1024, 1024, j & 15, j >> 4, WSP(bf16_t, OFF_WTOUT), 1024, 0); }
    else if (job < 1984) { const int j = job - 1280; xpose_tile(smem, P.in[I_WG] + (size_t)l * 1024 * DFF, DFF, j & 15, j >> 4, WSP(bf16_t, OFF_WTGU), 1024, 1); }
    else if (job < 2688) { const int j = job - 1984; xpose_tile(smem, P.in[I_WU] + (size_t)l * 1024 * DFF, DFF, j & 15, j >> 4, WSP(bf16_t, OFF_WTGU), 1024, 2); }
    else { const int j = job - 2688; xpose_tile(smem, P.in[I_WD] + (size_t)l * DFF * 1024, 1024, j % 44, j / 44, WSP(bf16_t, OFF_WTDN), DFF, 0); }
  }
  bf16_t* lw = WSP(bf16_t, OFF_LORA);
  for (int idx = obid() * 256 + otid(); idx < 122880; idx += gridDim.x * 256) {
    float v = 0.f;
    if (idx < A2T) { const int n = idx >> 6, k = idx & 63; v = P.in[I_W2][(size_t)l * 64 * 384 + k * 384 + n]; }
    else if (idx < G2T) { const int i = idx - A2T, n = i >> 6, k = i & 63; v = P.in[I_A2][(size_t)l * 64 * 384 + k * 384 + n]; }
    else if (idx < V1T) { const int i = idx - G2T, n = i >> 7, k = i & 127; v = P.in[I_G2][(size_t)l * 128 * 384 + k * 384 + n]; }
    else if (idx < V2T) { if (l > 0) { const int i = idx - V1T, n = i / 384, k = i - n * 384; v = P.in[I_V1][(size_t)(l - 1) * 384 * 32 + k * 32 + n]; } }
    else { if (l > 0) { const int i = idx - V2T, n = i >> 5, k = i & 31; v = P.in[I_V2][(size_t)(l - 1) * 32 * 384 + k * 384 + n]; } }
    lw[idx] = f2bf(v);
  }
}

__device__ void norm_phase(const Params& P, int l_in, const float* __restrict__ w) {
  bf16_t* act = WSP(bf16_t, OFF_ACT);
  const int lane = otid() & 63, wid = otid() >> 6;
  for (int row = obid() * 4 + wid; row < NTOK; row += gridDim.x * 4) {
    const float* xr = xin_row(P, l_in, row);
    f32x4 v[4]; float ss = 0.f;
#pragma unroll
    for (int i = 0; i < 4; ++i) { v[i] = *(const f32x4*)(xr + i * 256 + lane * 4); ss += v[i][0] * v[i][0] + v[i][1] * v[i][1] + v[i][2] * v[i][2] + v[i][3] * v[i][3]; }
    ss = wave_sum(ss);
    const float rstd = rsqrtf(ss * (1.f / 1024.f) + 1e-6f);
#pragma unroll
    for (int i = 0; i < 4; ++i) {
      const f32x4 wv = *(const f32x4*)(w + i * 256 + lane * 4);
      u32x2 o; o[0] = pk2(v[i][0] * rstd * wv[0], v[i][1] * rstd * wv[1]); o[1] = pk2(v[i][2] * rstd * wv[2], v[i][3] * rstd * wv[3]);
      *(u32x2*)(act + (size_t)row * 1024 + i * 256 + lane * 4) = o;
    }
  }
}
__device__ void final_norm_phase(const Params& P) {
  const float* w = P.in[I_NORM_FINAL];
  const int lane = otid() & 63, wid = otid() >> 6;
  for (int row = obid() * 4 + wid; row < NTOK; row += gridDim.x * 4) {
    float* xr = P.out + (size_t)row * D;
    f32x4 v[4]; float ss = 0.f;
#pragma unroll
    for (int i = 0; i < 4; ++i) { v[i] = *(const f32x4*)(xr + i * 256 + lane * 4); ss += v[i][0] * v[i][0] + v[i][1] * v[i][1] + v[i][2] * v[i][2] + v[i][3] * v[i][3]; }
    ss = wave_sum(ss);
    const float rstd = rsqrtf(ss * (1.f / 1024.f) + 1e-6f);
#pragma unroll
    for (int i = 0; i < 4; ++i) {
      const f32x4 wv = *(const f32x4*)(w + i * 256 + lane * 4);
      f32x4 o; o[0] = v[i][0] * rstd * wv[0]; o[1] = v[i][1] * rstd * wv[1]; o[2] = v[i][2] * rstd * wv[2]; o[3] = v[i][3] * rstd * wv[3];
      *(f32x4*)(xr + i * 256 + lane * 4) = o;
    }
  }
}

enum { EPI_P = 0, EPI_RES = 1, EPI_SWIGLU = 2 };
template <int EPI>
__device__ void gemm_phase(const Params& P, unsigned char* smem, const bf16_t* __restrict__ A, int lda, const bf16_t* __restrict__ Bt, int K, int nN, int l) {
  const int tid = otid(), lane = tid & 63, wid = tid >> 6, wr = wid >> 1, wc = wid & 1, fr = lane & 15, fq = lane >> 4;
  const int ntiles = 129 * nN, nk = K >> 6;
  const int r0s = tid >> 3, cs = tid & 7;
  const int swz = (fr >> 1) & 7;
  for (int tile = obid(); tile < ntiles; tile += gridDim.x) {
    const int mt = tile / nN, nt = tile - mt * nN;
    const bf16_t* Ag = A + (size_t)(mt * 128 + r0s) * lda + cs * 8;
    const bf16_t* Bg = Bt + (size_t)(nt * 128 + r0s) * K + cs * 8;
    f32x4 acc[4][4];
#pragma unroll
    for (int m = 0; m < 4; ++m)
#pragma unroll
      for (int n = 0; n < 4; ++n) acc[m][n] = (f32x4){0.f, 0.f, 0.f, 0.f};
    u32x4 ra[4], rb[4];
#pragma unroll
    for (int i = 0; i < 4; ++i) { ra[i] = *(const u32x4*)(Ag + (size_t)i * 32 * lda); rb[i] = *(const u32x4*)(Bg + (size_t)i * 32 * K); }
#pragma unroll
    for (int i = 0; i < 4; ++i) {
      const int row = r0s + i * 32; const int off = row * 128 + ((cs ^ ((row >> 1) & 7)) << 4);
      *(u32x4*)(smem + off) = ra[i]; *(u32x4*)(smem + 16384 + off) = rb[i];
    }
    __syncthreads();
    for (int kt = 0; kt < nk; ++kt) {
      const bool nxt = kt + 1 < nk;
      if (nxt) {
#pragma unroll
        for (int i = 0; i < 4; ++i) { ra[i] = *(const u32x4*)(Ag + (size_t)i * 32 * lda + (kt + 1) * 64); rb[i] = *(const u32x4*)(Bg + (size_t)i * 32 * K + (kt + 1) * 64); }
      }
      const unsigned char* sA = smem + (kt & 1) * 32768;
      const unsigned char* sB = sA + 16384;
#pragma unroll
      for (int kk = 0; kk < 2; ++kk) {
        bf16x8 af[4], bfg[4];
        const int coff = ((kk * 4 + fq) ^ swz) << 4;
#pragma unroll
        for (int m = 0; m < 4; ++m) af[m] = *(const bf16x8*)(sA + (wr * 64 + m * 16 + fr) * 128 + coff);
#pragma unroll
        for (int n = 0; n < 4; ++n) bfg[n] = *(const bf16x8*)(sB + (wc * 64 + n * 16 + fr) * 128 + coff);
#pragma unroll
        for (int m = 0; m < 4; ++m)
#pragma unroll
          for (int n = 0; n < 4; ++n) acc[m][n] = __builtin_amdgcn_mfma_f32_16x16x32_bf16(bfg[n], af[m], acc[m][n], 0, 0, 0);
      }
      if (nxt) {
        unsigned char* dA = smem + ((kt + 1) & 1) * 32768;
#pragma unroll
        for (int i = 0; i < 4; ++i) {
          const int row = r0s + i * 32; const int off = row * 128 + ((cs ^ ((row >> 1) & 7)) << 4);
          *(u32x4*)(dA + off) = ra[i]; *(u32x4*)(dA + 16384 + off) = rb[i];
        }
      }
      __syncthreads();
    }
#pragma unroll
    for (int m = 0; m < 4; ++m) {
      const int row = mt * 128 + wr * 64 + m * 16 + fr;
      if (EPI == EPI_P) {
        bf16_t* pr = WSP(bf16_t, OFF_P) + (size_t)row * PSTR;
#pragma unroll
        for (int n = 0; n < 4; ++n) {
          const int col = nt * 128 + wc * 64 + n * 16 + fq * 4;
          if (col < IN_COLS) { u32x2 o; o[0] = pk2(acc[m][n][0], acc[m][n][1]); o[1] = pk2(acc[m][n][2], acc[m][n][3]); *(u32x2*)(pr + col) = o; }
        }
      } else if (EPI == EPI_RES) {
        const float* xi = xin_row(P, l, row);
        float* xo = P.out + (size_t)row * D;
#pragma unroll
        for (int n = 0; n < 4; ++n) {
          const int col = nt * 128 + wc * 64 + n * 16 + fq * 4;
          const f32x4 xv = *(const f32x4*)(xi + col);
          *(f32x4*)(xo + col) = xv + acc[m][n];
        }
      } else {
        bf16_t* ur = WSP(bf16_t, OFF_P) + (size_t)row * DFF;
#pragma unroll
        for (int n = 0; n < 2; ++n) {
          const int col = nt * 64 + wc * 32 + n * 16 + fq * 4;
          float r[4];
#pragma unroll
          for (int j = 0; j < 4; ++j) r[j] = silu(acc[m][n][j]) * acc[m][n + 2][j];
          u32x2 o; o[0] = pk2(r[0], r[1]); o[1] = pk2(r[2], r[3]);
          *(u32x2*)(ur + col) = o;
        }
      }
    }
  }
}

__device__ __forceinline__ float lbval(const Params& P, int l, int c) {
  const float* hb = P.in[I_HLB];
  const float a0 = hb[c], a1 = hb[256 + c], a2 = hb[512 + c], a3 = hb[768 + c];
  const float m = fmaxf(fmaxf(a0, a1), fmaxf(a2, a3));
  const float e0 = __expf(a0 - m), e1 = __expf(a1 - m), e2 = __expf(a2 - m), e3 = __expf(a3 - m);
  const float inv = 1.f / (e0 + e1 + e2 + e3);
  float s = 0.f;
  if (l >= 1) s += e1; if (l >= 2) s += e2; if (l >= 3) s += e3;
  return s * inv;
}

__device__ __forceinline__ void gdn_conv_emit(const Params& P, int g, int lane, int row, float s) {
  const int h = g % 6;
  if (g < 12) {
    const float ss = wave_sum(s * s);
    const float o = s * rsqrtf(ss + 1e-6f) * (g < 6 ? 0.125f : 1.f);
    (g < 6 ? WSP(bf16_t, OFF_GQ) : WSP(bf16_t, OFF_GK))[(size_t)row * 384 + h * 64 + lane] = f2bf(o);
  } else {
    WSP(bf16_t, OFF_GV)[(size_t)row * 384 + h * 64 + lane] = f2bf(s);
  }
}
__device__ __forceinline__ void gdn_gate_emit(const Params& P, int l, int h, int row) {
  const bf16_t* pr = WSP(bf16_t, OFF_P) + (size_t)row * PSTR;
  const float braw = bf2f(pr[1536 + h]), araw = bf2f(pr[1542 + h]);
  const float gg = -__expf(P.in[I_ALOG][l * 6 + h]) * softplus(araw + P.in[I_DTB][l * 6 + h]);
  WSP(float, OFF_GDEC)[(size_t)row * 8 + h] = __expf(gg);
  WSP(float, OFF_GBETA)[(size_t)row * 8 + h] = sigm(braw);
}
__device__ void prep_gdn_prompt(const Params& P, int l, int ci) {
  const int lane = otid() & 63, wid = otid() >> 6;
  const int r0 = ci * 32, b = r0 / TSEQ, t0 = r0 % TSEQ;
  const bf16_t* p = WSP(bf16_t, OFF_P);
  for (int g = wid; g < 18; g += 4) {
    const int col = g * 64 + lane;
    const float* cw = P.in[I_CONVW] + (size_t)l * 4 * 1152 + col;
    const float c0 = cw[0], c1 = cw[1152], c2 = cw[2304], c3 = cw[3456];
    float x3 = 0.f, x2 = 0.f, x1 = 0.f;
    if (t0 > 0) { x3 = bf2f(p[(size_t)(r0 - 3) * PSTR + col]); x2 = bf2f(p[(size_t)(r0 - 2) * PSTR + col]); x1 = bf2f(p[(size_t)(r0 - 1) * PSTR + col]); }
    for (int t = 0; t < 32; ++t) {
      const float x0 = bf2f(p[(size_t)(r0 + t) * PSTR + col]);
      const float y = c0 * x3 + c1 * x2 + c2 * x1 + c3 * x0;
      gdn_conv_emit(P, g, lane, r0 + t, silu(y));
      x3 = x2; x2 = x1; x1 = x0;
    }
    if (t0 + 32 == TSEQ) {
      float* cp = P.out + O_CONV_P + (size_t)(l * 8 + b) * 3 * 1152 + col;
      cp[0] = x3; cp[1152] = x2; cp[2304] = x1;
    }
    if (g < 6 && lane < 32) gdn_gate_emit(P, l, g, r0 + lane);
  }
}
__device__ void prep_gdn_sample(const Params& P, int l, int si) {
  const int lane = otid() & 63, wid = otid() >> 6;
  const bf16_t* p = WSP(bf16_t, OFF_P);
  for (int u = wid; u < 8 * 18; u += 4) {
    const int s = si * 8 + u / 18, g = u % 18, col = g * 64 + lane, row = NTP + s;
    const float* cw = P.in[I_CONVW] + (size_t)l * 4 * 1152 + col;
    const float c0 = cw[0], c1 = cw[1152], c2 = cw[2304], c3 = cw[3456];
    const float* cb = P.in[I_SCONV] + (size_t)(l * 128 + s) * 3 * 1152 + col;
    const float x3 = cb[0], x2 = cb[1152], x1 = cb[2304];
    const float x0 = bf2f(p[(size_t)row * PSTR + col]);
    const float y = c0 * x3 + c1 * x2 + c2 * x1 + c3 * x0;
    gdn_conv_emit(P, g, lane, row, silu(y));
    float* cp = P.out + O_CONV_S + (size_t)(l * 128 + s) * 3 * 1152 + col;
    cp[0] = x2; cp[1152] = x1; cp[2304] = x0;
    if (g < 6 && lane == 0) gdn_gate_emit(P, l, g, row);
  }
}
__device__ void prep_hgrn(const Params& P, int l, int ti) {
  const int c = otid();
  const float oml = 1.f - lbval(P, l, c);
  const bf16_t* p = WSP(bf16_t, OFF_P);
  bf16_t* hq = WSP(bf16_t, OFF_HQ); bf16_t* hk = WSP(bf16_t, OFF_HK);
  for (int t = 0; t < 64; ++t) {
    const int row = ti * 64 + t;
    const float q = bf2f(p[(size_t)row * PSTR + PC + c]), f = bf2f(p[(size_t)row * PSTR + PC + 256 + c]);
    hq[(size_t)row * 256 + c] = f2bf(silu(q) * 0.125f);
    hk[(size_t)row * 256 + c] = f2bf(oml * sigm(-f));
  }
}
__device__ __forceinline__ f32x4 xs4(const Params& P, int l, int row, int col0) {
  const bf16_t* p = WSP(bf16_t, OFF_P);
  const f32x4 pv = unpack4(*(const u32x2*)(p + (size_t)row * PSTR + PB + col0));
  f32x4 prev = (f32x4){0.f, 0.f, 0.f, 0.f};
  if (row >= NTP) prev = *(const f32x4*)(P.in[I_SSHIFT] + (size_t)(l * 128 + (row - NTP)) * 1408 + col0);
  else if ((row & (TSEQ - 1)) != 0) prev = unpack4(*(const u32x2*)(p + (size_t)(row - 1) * PSTR + PB + col0));
  const f32x4 mu = *(const f32x4*)(P.in[I_MU] + l * 1408 + col0);
  return pv + (prev - pv) * mu;
}
__device__ __forceinline__ float tanh_fast(float x) { return 1.f - 2.f / (__expf(2.f * x) + 1.f); }

__device__ void prep_rwkv_unit(const Params& P, int l, int mt, int hh) {
  const int lane = otid() & 63, fr = lane & 15, fq = lane >> 4;
  const int row = mt * 16 + fr, cb = hh * 192;
  const bf16_t* lw = WSP(bf16_t, OFF_LORA);
  const size_t ro = (size_t)row * 384;
  f32x4 acc[12];
#pragma unroll
  for (int nf = 0; nf < 12; ++nf) acc[nf] = (f32x4){0.f, 0.f, 0.f, 0.f};
#pragma unroll
  for (int ks = 0; ks < 2; ++ks) {
    f32x4 x0 = xs4(P, l, row, 1152 + ks * 32 + fq * 8), x1 = xs4(P, l, row, 1152 + ks * 32 + fq * 8 + 4);
#pragma unroll
    for (int j = 0; j < 4; ++j) { x0[j] = tanh_fast(x0[j]); x1[j] = tanh_fast(x1[j]); }
    const bf16x8 A = pack8(x0, x1);
#pragma unroll
    for (int nf = 0; nf < 12; ++nf) {
      const bf16x8 B = *(const bf16x8*)(lw + W2T + (cb + nf * 16 + fr) * 64 + ks * 32 + fq * 8);
      acc[nf] = __builtin_amdgcn_mfma_f32_16x16x32_bf16(B, A, acc[nf], 0, 0, 0);
    }
  }
#pragma unroll
  for (int nf = 0; nf < 12; ++nf) {
    const int c = cb + nf * 16 + fq * 4;
    const f32x4 w0 = *(const f32x4*)(P.in[I_W0] + l * 384 + c);
    f32x4 d;
#pragma unroll
    for (int j = 0; j < 4; ++j) {
      const float x = -(w0[j] + acc[nf][j]);
      const float sp = x > 15.f ? x : __logf(1.f + __expf(x));
      d[j] = __expf(-__expf(-sp - 0.5f));
    }
    *(f32x4*)(WSP(float, OFF_RW) + ro + c) = d;
  }
#pragma unroll
  for (int nf = 0; nf < 12; ++nf) acc[nf] = (f32x4){0.f, 0.f, 0.f, 0.f};
#pragma unroll
  for (int ks = 0; ks < 2; ++ks) {
    const bf16x8 A = pack8(xs4(P, l, row, 1216 + ks * 32 + fq * 8), xs4(P, l, row, 1216 + ks * 32 + fq * 8 + 4));
#pragma unroll
    for (int nf = 0; nf < 12; ++nf) {
      const bf16x8 B = *(const bf16x8*)(lw + A2T + (cb + nf * 16 + fr) * 64 + ks * 32 + fq * 8);
      acc[nf] = __builtin_amdgcn_mfma_f32_16x16x32_bf16(B, A, acc[nf], 0, 0, 0);
    }
  }
#pragma unroll
  for (int hl = 0; hl < 3; ++hl) {
    f32x4 kr[4], kkr[4];
    float ss = 0.f;
#pragma unroll
    for (int q = 0; q < 4; ++q) {
      const int c = cb + (hl * 4 + q) * 16 + fq * 4;
      kr[q] = xs4(P, l, row, 384 + c);
      kkr[q] = kr[q] * *(const f32x4*)(P.in[I_KK] + l * 384 + c);
      ss += kkr[q][0] * kkr[q][0] + kkr[q][1] * kkr[q][1] + kkr[q][2] * kkr[q][2] + kkr[q][3] * kkr[q][3];
    }
    ss += __shfl_xor(ss, 16); ss += __shfl_xor(ss, 32);
    const float rn = rsqrtf(ss + 1e-6f);
#pragma unroll
    for (int q = 0; q < 4; ++q) {
      const int nf = hl * 4 + q, c = cb + nf * 16 + fq * 4;
      const f32x4 a0 = *(const f32x4*)(P.in[I_A0] + l * 384 + c), ka = *(const f32x4*)(P.in[I_KA] + l * 384 + c);
      f32x4 kn, kk, kb;
#pragma unroll
      for (int j = 0; j < 4; ++j) {
        const float a = sigm(a0[j] + acc[nf][j]);
        kk[j] = kkr[q][j] * rn; kb[j] = kk[j] * a; kn[j] = kr[q][j] * (1.f + (a - 1.f) * ka[j]);
      }
      *(u32x2*)(WSP(bf16_t, OFF_RK) + ro + c) = pack4(kn);
      *(u32x2*)(WSP(bf16_t, OFF_RKK) + ro + c) = pack4(kk);
      *(u32x2*)(WSP(bf16_t, OFF_RB) + ro + c) = pack4(kb);
      *(u32x2*)(WSP(bf16_t, OFF_RR) + ro + c) = pack4(xs4(P, l, row, c));
    }
  }
#pragma unroll
  for (int nf = 0; nf < 12; ++nf) acc[nf] = (f32x4){0.f, 0.f, 0.f, 0.f};
#pragma unroll
  for (int ks = 0; ks < 4; ++ks) {
    f32x4 x0 = xs4(P, l, row, 1280 + ks * 32 + fq * 8), x1 = xs4(P, l, row, 1280 + ks * 32 + fq * 8 + 4);
#pragma unroll
    for (int j = 0; j < 4; ++j) { x0[j] = sigm(x0[j]); x1[j] = sigm(x1[j]); }
    const bf16x8 A = pack8(x0, x1);
#pragma unroll
    for (int nf = 0; nf < 12; ++nf) {
      const bf16x8 B = *(const bf16x8*)(lw + G2T + (cb + nf * 16 + fr) * 128 + ks * 32 + fq * 8);
      acc[nf] = __builtin_amdgcn_mfma_f32_16x16x32_bf16(B, A, acc[nf], 0, 0, 0);
    }
  }
#pragma unroll
  for (int nf = 0; nf < 12; ++nf) *(u32x2*)(WSP(bf16_t, OFF_RG) + ro + cb + nf * 16 + fq * 4) = pack4(acc[nf]);
  if (l == 0) {
#pragma unroll
    for (int nf = 0; nf < 12; ++nf) {
      const int c = cb + nf * 16 + fq * 4;
      const u32x2 o = pack4(xs4(P, l, row, 768 + c));
      *(u32x2*)(WSP(bf16_t, OFF_RV) + ro + c) = o;
      *(u32x2*)(WSP(bf16_t, OFF_VF) + ro + c) = o;
    }
  } else {
    f32x4 lo0 = (f32x4){0.f, 0.f, 0.f, 0.f}, lo1 = lo0;
#pragma unroll 4
    for (int ks = 0; ks < 12; ++ks) {
      const bf16x8 A = pack8(xs4(P, l, row, 768 + ks * 32 + fq * 8), xs4(P, l, row, 768 + ks * 32 + fq * 8 + 4));
      const bf16x8 B0 = *(const bf16x8*)(lw + V1T + fr * 384 + ks * 32 + fq * 8);
      const bf16x8 B1 = *(const bf16x8*)(lw + V1T + (16 + fr) * 384 + ks * 32 + fq * 8);
      lo0 = __builtin_amdgcn_mfma_f32_16x16x32_bf16(B0, A, lo0, 0, 0, 0);
      lo1 = __builtin_amdgcn_mfma_f32_16x16x32_bf16(B1, A, lo1, 0, 0, 0);
    }
    const bf16x8 A2 = pack8(lo0, lo1);
#pragma unroll
    for (int nf = 0; nf < 12; ++nf) {
      const int c = cb + nf * 16 + fq * 4;
      const bf16_t* vr = lw + V2T + (cb + nf * 16 + fr) * 32;
      u32x4 bw; { const u32x2 b0 = *(const u32x2*)(vr + fq * 4), b1 = *(const u32x2*)(vr + 16 + fq * 4); bw[0] = b0[0]; bw[1] = b0[1]; bw[2] = b1[0]; bw[3] = b1[1]; }
      const f32x4 mv = __builtin_amdgcn_mfma_f32_16x16x32_bf16(__builtin_bit_cast(bf16x8, bw), A2, (f32x4){0.f, 0.f, 0.f, 0.f}, 0, 0, 0);
      const f32x4 v0 = *(const f32x4*)(P.in[I_V0] + (l - 1) * 384 + c);
      const f32x4 v = xs4(P, l, row, 768 + c), vf = unpack4(*(const u32x2*)(WSP(bf16_t, OFF_VF) + ro + c));
      f32x4 o;
#pragma unroll
      for (int j = 0; j < 4; ++j) o[j] = v[j] + (vf[j] - v[j]) * sigm(v0[j] + mv[j]);
      *(u32x2*)(WSP(bf16_t, OFF_RV) + ro + c) = pack4(o);
    }
  }
}
__device__ void prep_phase(const Params& P, unsigned char* smem, int l) {
  for (int it = obid(); it < 1302; it += gridDim.x) {
    if (it < 516) { const int wid = otid() >> 6; prep_rwkv_unit(P, l, it * 2 + (wid >> 1), wid & 1); }
    else if (it < 1028) prep_gdn_prompt(P, l, it - 516);
    else if (it < 1044) prep_gdn_sample(P, l, it - 1028);
    else prep_hgrn(P, l, it - 1044);
  }
  const bf16_t* p = WSP(bf16_t, OFF_P);
  for (int idx = obid() * 256 + otid(); idx < 136 * 1408; idx += gridDim.x * 256) {
    const int q = idx / 1408, col = idx - q * 1408;
    if (q < 8) P.out[O_SHIFT_P + (size_t)(l * 8 + q) * 1408 + col] = bf2f(p[(size_t)(q * TSEQ + TSEQ - 1) * PSTR + PB + col]);
    else P.out[O_SHIFT_S + (size_t)(l * 128 + (q - 8)) * 1408 + col] = bf2f(p[(size_t)(NTP + q - 8) * PSTR + PB + col]);
  }
}

template <int KIND> struct ScanCfg { static constexpr int STRIDE = KIND == 0 ? 164 : (KIND == 1 ? 352 : 160); };

template <int KIND> struct ScanPre { u32x2 a, b, c, d, v; f32x4 w; float g; };

template <int KIND>
__device__ __forceinline__ void scan_load(const Params& P, ScanPre<KIND>& r, int h, int half, int rowbase, int nvalid) {
  const int tid = otid();
  const int s = tid >> 4, j4 = (tid & 15) * 4;
  const int s2 = (tid >> 3) & 15, j2 = (tid & 7) * 4;
  const u32x2 z2 = {0u, 0u};
  const bool ok = s < nvalid, ok2 = (tid < 128) && (s2 < nvalid);
  if (KIND == 0) {
    const size_t o = (size_t)(rowbase + s) * 384 + h * 64 + j4;
    r.a = ok ? *(const u32x2*)(WSP(bf16_t, OFF_GK) + o) : z2;
    r.b = ok ? *(const u32x2*)(WSP(bf16_t, OFF_GQ) + o) : z2;
    r.v = ok2 ? *(const u32x2*)(WSP(bf16_t, OFF_GV) + (size_t)(rowbase + s2) * 384 + h * 64 + half * 32 + j2) : z2;
    const int sg = (tid >> 1) & 15;
    r.g = (tid < 32 && sg < nvalid) ? ((tid & 1) ? WSP(float, OFF_GBETA) : WSP(float, OFF_GDEC))[(size_t)(rowbase + sg) * 8 + h] : 0.f;
  } else if (KIND == 1) {
    const size_t o = (size_t)(rowbase + s) * 384 + h * 64 + j4;
    r.a = ok ? *(const u32x2*)(WSP(bf16_t, OFF_RR) + o) : z2;
    r.w = ok ? *(const f32x4*)(WSP(float, OFF_RW) + o) : (f32x4){0.f, 0.f, 0.f, 0.f};
    r.b = ok ? *(const u32x2*)(WSP(bf16_t, OFF_RK) + o) : z2;
    r.c = ok ? *(const u32x2*)(WSP(bf16_t, OFF_RKK) + o) : z2;
    r.d = ok ? *(const u32x2*)(WSP(bf16_t, OFF_RB) + o) : z2;
    r.v = ok2 ? *(const u32x2*)(WSP(bf16_t, OFF_RV) + (size_t)(rowbase + s2) * 384 + h * 64 + half * 32 + j2) : z2;
  } else {
    const size_t o = (size_t)(rowbase + s) * 256 + h * 64 + j4;
    r.a = ok ? *(const u32x2*)(WSP(bf16_t, OFF_HQ) + o) : z2;
    r.b = ok ? *(const u32x2*)(WSP(bf16_t, OFF_HK) + o) : z2;
    r.v = ok2 ? *(const u32x2*)(WSP(bf16_t, OFF_P) + (size_t)(rowbase + s2) * PSTR + PC + 512 + h * 64 + half * 32 + j2) : z2;
  }
}
template <int KIND>
__device__ __forceinline__ void scan_store(const ScanPre<KIND>& r, float* buf) {
  constexpr int STRIDE = ScanCfg<KIND>::STRIDE;
  const int tid = otid();
  const int s = tid >> 4, j4 = (tid & 15) * 4;
  const int s2 = (tid >> 3) & 15, j2 = (tid & 7) * 4;
  float* bs = buf + s * STRIDE + j4;
  if (KIND == 0) {
    *(f32x4*)(bs) = unpack4(r.a); *(f32x4*)(bs + 64) = unpack4(r.b);
    if (tid < 128) *(f32x4*)(buf + s2 * STRIDE + 128 + j2) = unpack4(r.v);
    if (tid < 32) buf[((tid >> 1) & 15) * STRIDE + 160 + (tid & 1)] = r.g;
  } else if (KIND == 1) {
    *(f32x4*)(bs) = unpack4(r.a); *(f32x4*)(bs + 64) = r.w; *(f32x4*)(bs + 128) = unpack4(r.b);
    *(f32x4*)(bs + 192) = unpack4(r.c); *(f32x4*)(bs + 256) = unpack4(r.d);
    if (tid < 128) *(f32x4*)(buf + s2 * STRIDE + 320 + j2) = unpack4(r.v);
  } else {
    *(f32x4*)(bs) = unpack4(r.a); *(f32x4*)(bs + 64) = unpack4(r.b);
    if (tid < 128) *(f32x4*)(buf + s2 * STRIDE + 128 + j2) = unpack4(r.v);
  }
}

template <int KIND>
__device__ void scan_task(const Params& P, unsigned char* smem, int l, int seq, int h, int half) {
  constexpr int STRIDE = ScanCfg<KIND>::STRIDE, NEL = 16 * STRIDE;
  constexpr int NH = KIND == 2 ? 4 : 6;
  float* buf = (float*)smem;
  float* obuf = buf + 2 * NEL;
  const int tid = otid(), lane = tid & 63, wid = tid >> 6;
  const int col_l = lane >> 3, sub = lane & 7, cl = wid * 8 + col_l, col = half * 32 + cl, e0 = sub * 8;
  const bool sample = seq >= 8;
  const int R0 = sample ? NTP + (seq - 8) : seq * TSEQ, T = sample ? 1 : TSEQ;
  const int ocol = (KIND == 0 ? 0 : (KIND == 1 ? 384 : 768)) + h * 64 + half * 32;
  const size_t O_P = KIND == 0 ? O_GDN_P : (KIND == 1 ? O_RWKV_P : O_HGRN_P);
  const size_t O_S = KIND == 0 ? O_GDN_S : (KIND == 1 ? O_RWKV_S : O_HGRN_S);
  const int I_ST = KIND == 0 ? I_SGDN : (KIND == 1 ? I_SRWKV : I_SHGRN);
  float S[8];
  if (sample) {
    const float* st = P.in[I_ST] + ((size_t)(l * 128 + (seq - 8)) * NH + h) * 4096;
#pragma unroll
    for (int i = 0; i < 8; ++i) S[i] = KIND == 1 ? st[col * 64 + e0 + i] : st[(e0 + i) * 64 + col];
  } else {
#pragma unroll
    for (int i = 0; i < 8; ++i) S[i] = 0.f;
  }
  ScanPre<KIND> pre;
  __syncthreads();
  scan_load<KIND>(P, pre, h, half, R0, T);
  scan_store<KIND>(pre, buf);
  __syncthreads();
  const int nchunks = (T + 15) >> 4;
  bf16_t* oraw = WSP(bf16_t, OFF_P);
  for (int c = 0; c < nchunks; ++c) {
    const int t0 = c * 16, n = (T - t0) < 16 ? (T - t0) : 16;
    const bool has_next = c + 1 < nchunks;
    if (has_next) scan_load<KIND>(P, pre, h, half, R0 + t0 + 16, T - t0 - 16);
    const float* b = buf + (c & 1) * NEL;
    float* ob = obuf + (c & 1) * 512;
    for (int s = 0; s < n; ++s) {
      const float* bs = b + s * STRIDE;
      float o;
      if (KIND == 0) {
        const f32x4 k0 = *(const f32x4*)(bs + e0), k1 = *(const f32x4*)(bs + e0 + 4);
        const f32x4 q0 = *(const f32x4*)(bs + 64 + e0), q1 = *(const f32x4*)(bs + 64 + e0 + 4);
        const float vv = bs[128 + cl], dec = bs[160], beta = bs[161];
        const float kf[8] = {k0[0], k0[1], k0[2], k0[3], k1[0], k1[1], k1[2], k1[3]};
        const float qf[8] = {q0[0], q0[1], q0[2], q0[3], q1[0], q1[1], q1[2], q1[3]};
        float ks = 0.f;
#pragma unroll
        for (int i = 0; i < 8; ++i) ks += kf[i] * S[i];
        ks = reduce8(ks);
        const float vn = beta * (vv - dec * ks);
        o = 0.f;
#pragma unroll
        for (int i = 0; i < 8; ++i) { S[i] = dec * S[i] + kf[i] * vn; o += qf[i] * S[i]; }
        o = reduce8(o);
      } else if (KIND == 1) {
        const f32x4 r0 = *(const f32x4*)(bs + e0), r1 = *(const f32x4*)(bs + e0 + 4);
        const f32x4 w0 = *(const f32x4*)(bs + 64 + e0), w1 = *(const f32x4*)(bs + 64 + e0 + 4);
        const f32x4 k0 = *(const f32x4*)(bs + 128 + e0), k1 = *(const f32x4*)(bs + 128 + e0 + 4);
        const f32x4 c0 = *(const f32x4*)(bs + 192 + e0), c1 = *(const f32x4*)(bs + 192 + e0 + 4);
        const f32x4 b0 = *(const f32x4*)(bs + 256 + e0), b1 = *(const f32x4*)(bs + 256 + e0 + 4);
        const float vv = bs[320 + cl];
        const float rf[8] = {r0[0], r0[1], r0[2], r0[3], r1[0], r1[1], r1[2], r1[3]};
        const float wf[8] = {w0[0], w0[1], w0[2], w0[3], w1[0], w1[1], w1[2], w1[3]};
        const float kf[8] = {k0[0], k0[1], k0[2], k0[3], k1[0], k1[1], k1[2], k1[3]};
        const float cf[8] = {c0[0], c0[1], c0[2], c0[3], c1[0], c1[1], c1[2], c1[3]};
        const float bf[8] = {b0[0], b0[1], b0[2], b0[3], b1[0], b1[1], b1[2], b1[3]};
        float sa = 0.f;
#pragma unroll
        for (int i = 0; i < 8; ++i) sa += S[i] * cf[i];
        sa = -reduce8(sa);
        o = 0.f;
#pragma unroll
        for (int i = 0; i < 8; ++i) { S[i] = S[i] * wf[i] + sa * bf[i] + vv * kf[i]; o += S[i] * rf[i]; }
        o = reduce8(o);
      } else {
        const f32x4 q0 = *(const f32x4*)(bs + e0), q1 = *(const f32x4*)(bs + e0 + 4);
        const f32x4 k0 = *(const f32x4*)(bs + 64 + e0), k1 = *(const f32x4*)(bs + 64 + e0 + 4);
        const float iv = bs[128 + cl];
        const float qf[8] = {q0[0], q0[1], q0[2], q0[3], q1[0], q1[1], q1[2], q1[3]};
        const float kf[8] = {k0[0], k0[1], k0[2], k0[3], k1[0], k1[1], k1[2], k1[3]};
        o = 0.f;
#pragma unroll
        for (int i = 0; i < 8; ++i) { S[i] = S[i] + kf[i] * (iv - S[i]); o += qf[i] * S[i]; }
        o = reduce8(o);
      }
      if (sub == 0) ob[s * 32 + cl] = o;
    }
    if (has_next) scan_store<KIND>(pre, buf + ((c + 1) & 1) * NEL);
    __syncthreads();
#pragma unroll
    for (int i = 0; i < 2; ++i) {
      const int idx = tid + i * 256, s = idx >> 5, cc = idx & 31;
      if (s < n) oraw[(size_t)(R0 + t0 + s) * PSTR + ocol + cc] = f2bf(ob[idx]);
    }
  }
  float* so = P.out + (sample ? O_S + ((size_t)(l * 128 + (seq - 8)) * NH + h) * 4096 : O_P + ((size_t)(l * 8 + seq) * NH + h) * 4096);
#pragma unroll
  for (int i = 0; i < 8; ++i) { if (KIND == 1) so[col * 64 + e0 + i] = S[i]; else so[(e0 + i) * 64 + col] = S[i]; }
}

__device__ void scan_long(const Params& P, unsigned char* smem, int l, int lt) {
  if (lt < 96) { const int half = lt & 1, bh = lt >> 1; scan_task<1>(P, smem, l, bh / 6, bh % 6, half); }
  else if (lt < 192) { const int x = lt - 96, half = x & 1, bh = x >> 1; scan_task<0>(P, smem, l, bh / 6, bh % 6, half); }
  else { const int x = lt - 192, half = x & 1, bh = x >> 1; scan_task<2>(P, smem, l, bh / 4, bh % 4, half); }
}
__device__ void scan_short(const Params& P, unsigned char* smem, int l, int st) {
  const int s = st >> 4, hh = st & 15;
  for (int half = 0; half < 2; ++half) {
    if (hh < 6) scan_task<0>(P, smem, l, 8 + s, hh, half);
    else if (hh < 12) scan_task<1>(P, smem, l, 8 + s, hh - 6, half);
    else scan_task<2>(P, smem, l, 8 + s, hh - 12, half);
  }
}
__device__ void scan_phase(const Params& P, unsigned char* smem, int l) {
  const int G = gridDim.x, bid = obid();
  if (G >= 512) {
    if (bid < 256) scan_long(P, smem, l, bid);
    else for (int st = bid - 256; st < 2048; st += G - 256) scan_short(P, smem, l, st);
  } else {
    for (int lt = bid; lt < 256; lt += G) scan_long(P, smem, l, lt);
    for (int st = bid; st < 2048; st += G) scan_short(P, smem, l, st);
  }
}

__device__ void post_phase(const Params& P, int l) {
  const int lane = otid() & 63, wid = otid() >> 6;
  const bf16_t* p = WSP(bf16_t, OFF_P);
  bf16_t* act = WSP(bf16_t, OFF_ACT);
  const float gnw = P.in[I_GNW][l * 64 + lane], hnw = P.in[I_HNW][l * 64 + lane];
  for (int u = obid() * 4 + wid; u < NTOK * 16; u += gridDim.x * 4) {
    const int row = u >> 4, hh = u & 15;
    const float o = bf2f(p[(size_t)row * PSTR + hh * 64 + lane]);
    float out;
    if (hh < 6) {
      const float z = bf2f(p[(size_t)row * PSTR + 1152 + hh * 64 + lane]);
      const float ms = wave_sum(o * o) * (1.f / 64.f);
      out = o * rsqrtf(ms + 1e-6f) * gnw * silu(z);
    } else if (hh < 12) {
      const int h = hh - 6; const size_t idx = (size_t)row * 384 + h * 64 + lane;
      const float mu = wave_sum(o) * (1.f / 64.f);
      const float yc = o - mu;
      const float var = wave_sum(yc * yc) * (1.f / 64.f);
      const float y = yc * rsqrtf(var + 64e-5f) * P.in[I_LNW][l * 384 + h * 64 + lane] + P.in[I_LNB][l * 384 + h * 64 + lane];
      const float r = bf2f(WSP(bf16_t, OFF_RR)[idx]), k = bf2f(WSP(bf16_t, OFF_RK)[idx]), v = bf2f(WSP(bf16_t, OFF_RV)[idx]), g = bf2f(WSP(bf16_t, OFF_RG)[idx]);
      const float rk = wave_sum(r * k * P.in[I_RK][l * 384 + h * 64 + lane]);
      out = (y + rk * v) * g;
    } else {
      const int h = hh - 12;
      const float z = bf2f(p[(size_t)row * PSTR + PC + 768 + h * 64 + lane]);
      const float ms = wave_sum(o * o) * (1.f / 64.f);
      out = o * rsqrtf(ms + 1e-6f) * hnw * silu(z);
    }
    act[(size_t)row * 1024 + hh * 64 + lane] = f2bf(out);
  }
}

__global__ void __launch_bounds__(256, 2) hybrid_fwd(Params P) {
  cg::grid_group grid = cg::this_grid();
  __shared__ __attribute__((aligned(16))) unsigned char smem[65536];
  for (int l = 0; l < NLAYER; ++l) {
    wconv_phase(P, smem, l);
    norm_phase(P, l, P.in[I_NORM_MIX] + l * D);
    grid.sync();
    gemm_phase<EPI_P>(P, smem, WSP(bf16_t, OFF_ACT), 1024, WSP(bf16_t, OFF_WTIN), 1024, 32, l);
    grid.sync();
    prep_phase(P, smem, l);
    grid.sync();
    scan_phase(P, smem, l);
    grid.sync();
    post_phase(P, l);
    grid.sync();
    gemm_phase<EPI_RES>(P, smem, WSP(bf16_t, OFF_ACT), 1024, WSP(bf16_t, OFF_WTOUT), 1024, 8, l);
    grid.sync();
    norm_phase(P, 1, P.in[I_NORM_FFN] + l * D);
    grid.sync();
    gemm_phase<EPI_SWIGLU>(P, smem, WSP(bf16_t, OFF_ACT), 1024, WSP(bf16_t, OFF_WTGU), 1024, 44, 1);
    grid.sync();
    gemm_phase<EPI_RES>(P, smem, WSP(bf16_t, OFF_P), DFF, WSP(bf16_t, OFF_WTDN), DFF, 8, 1);
    grid.sync();
  }
  final_norm_phase(P);
}

extern "C" void kernel_launch(void* const* d_in, const int* in_sizes, int n_in,
                              void* d_out, int out_size, void* d_ws, size_t ws_size,
                              hipStream_t stream) {
  static int grid_blocks = 0;
  if (!grid_blocks) {
    int dev = 0, cus = 0, per_cu = 0;
    (void)hipGetDevice(&dev);
    (void)hipDeviceGetAttribute(&cus, hipDeviceAttributeMultiprocessorCount, dev);
    (void)hipOccupancyMaxActiveBlocksPerMultiprocessor(&per_cu, hybrid_fwd, 256, 0);
    if (per_cu > 2) per_cu = 2;
    if (per_cu < 1) per_cu = 1;
    grid_blocks = cus * per_cu;
  }
  if (ws_size < WS_NEED) { fprintf(stderr, "workspace too small: %zu < %zu\n", ws_size, (size_t)WS_NEED); return; }
  Params p{};
  for (int i = 0; i < N_IN; ++i) p.in[i] = (const float*)d_in[i];
  p.out = (float*)d_out;
  p.ws = (unsigned char*)d_ws;
  void* args[] = {&p};
  hipError_t e = hipLaunchCooperativeKernel((void*)hybrid_fwd, dim3(grid_blocks), dim3(256), args, 0, stream);
  if (e != hipSuccess) fprintf(stderr, "cooperative launch failed: %s (grid %d)\n", hipGetErrorString(e), grid_blocks);
}
```

```cpp
#include <hip/hip_runtime.h>
#include <hip/hip_cooperative_groups.h>
#include <cstdio>
namespace cg = cooperative_groups;

typedef unsigned short bf16_t;
typedef short bf16x8 __attribute__((ext_vector_type(8)));
typedef float f32x4 __attribute__((ext_vector_type(4)));
typedef unsigned u32x4 __attribute__((ext_vector_type(4)));
typedef unsigned u32x2 __attribute__((ext_vector_type(2)));

constexpr int D = 1024, NTP = 16384, NTS = 128, NTOK = 16512, TSEQ = 2048, NLAYER = 4;
constexpr int IN_COLS = 3980, PSTR = 3984, DFF = 2816;
constexpr int PB = 1548, PC = 2956;

enum { I_XP = 0, I_XS, I_SGDN, I_SCONV, I_SRWKV, I_SSHIFT, I_SHGRN, I_NORM_MIX, I_WIN, I_WOUT, I_CONVW, I_ALOG, I_DTB, I_GNW,
       I_MU, I_W0, I_W2, I_A0, I_A2, I_G2, I_V0, I_V1, I_V2, I_KK, I_KA, I_RK, I_LNW, I_LNB, I_HLB, I_HNW, I_NORM_FFN,
       I_WG, I_WU, I_WD, I_NORM_FINAL, N_IN };

constexpr size_t O_YP = 0, O_YS = 16777216, O_GDN_P = 16908288, O_GDN_S = 17694720, O_CONV_P = 30277632, O_CONV_S = 30388224,
                 O_RWKV_P = 32157696, O_RWKV_S = 32944128, O_SHIFT_P = 45527040, O_SHIFT_S = 45572096, O_HGRN_P = 46292992,
                 O_HGRN_S = 46817280;

constexpr size_t SZ_WTIN = (size_t)4096 * 1024 * 2, SZ_WTOUT = (size_t)1024 * 1024 * 2, SZ_WTGU = (size_t)5632 * 1024 * 2,
                 SZ_WTDN = (size_t)1024 * 2816 * 2, SZ_P = (size_t)NTOK * PSTR * 2, SZ_ACT = (size_t)NTOK * 1024 * 2,
                 SZ_T384 = (size_t)NTOK * 384 * 2, SZ_T8F = (size_t)NTOK * 8 * 4, SZ_T256 = (size_t)NTOK * 256 * 2,
                 SZ_T384F = (size_t)NTOK * 384 * 4;
constexpr size_t OFF_WTIN = 0, OFF_WTOUT = OFF_WTIN + SZ_WTIN, OFF_WTGU = OFF_WTOUT + SZ_WTOUT, OFF_WTDN = OFF_WTGU + SZ_WTGU,
                 OFF_P = OFF_WTDN + SZ_WTDN, OFF_ACT = OFF_P + SZ_P, OFF_GQ = OFF_ACT + SZ_ACT, OFF_GK = OFF_GQ + SZ_T384,
                 OFF_GV = OFF_GK + SZ_T384, OFF_GDEC = OFF_GV + SZ_T384, OFF_GBETA = OFF_GDEC + SZ_T8F, OFF_HQ = OFF_GBETA + SZ_T8F,
                 OFF_HK = OFF_HQ + SZ_T256, OFF_RR = OFF_HK + SZ_T256, OFF_RK = OFF_RR + SZ_T384, OFF_RV = OFF_RK + SZ_T384,
                 OFF_RKK = OFF_RV + SZ_T384, OFF_RB = OFF_RKK + SZ_T384, OFF_RG = OFF_RB + SZ_T384, OFF_RW = OFF_RG + SZ_T384,
                 OFF_VF = OFF_RW + SZ_T384F, OFF_LORA = OFF_VF + SZ_T384, OFF_BAR = OFF_LORA + 245760, WS_NEED = OFF_BAR + 16384;
constexpr int W2T = 0, A2T = 24576, G2T = 49152, V1T = 98304, V2T = 110592;

struct Params {
  const float* in[N_IN];
  float* out;
  unsigned char* ws;
};

#define WSP(T, off) ((T*)(P.ws + (off)))

__device__ __forceinline__ int otid() { int t = __builtin_amdgcn_workitem_id_x(); asm volatile("" : "+v"(t)); return t; }
__device__ __forceinline__ int obid() { int b = __builtin_amdgcn_workgroup_id_x(); asm volatile("" : "+s"(b)); return b; }
__device__ __forceinline__ float bf2f(bf16_t h) { return __uint_as_float(((unsigned)h) << 16); }
typedef float f32x2_t __attribute__((ext_vector_type(2)));
typedef __bf16 bf16x2_t __attribute__((ext_vector_type(2)));
__device__ __forceinline__ unsigned pk2(float lo, float hi) {
  const f32x2_t v = {lo, hi};
  return __builtin_bit_cast(unsigned, __builtin_convertvector(v, bf16x2_t));
}
__device__ __forceinline__ bf16_t f2bf(float f) { return (bf16_t)(pk2(f, 0.f) & 0xffffu); }
__device__ __forceinline__ float sigm(float x) { return 1.f / (1.f + __expf(-x)); }
__device__ __forceinline__ float silu(float x) { return x / (1.f + __expf(-x)); }
__device__ __forceinline__ float softplus(float x) { return x > 20.f ? x : log1pf(__expf(x)); }
template <int CTRL> __device__ __forceinline__ float dppf(float x) {
  return __builtin_bit_cast(float, __builtin_amdgcn_mov_dpp(__builtin_bit_cast(int, x), CTRL, 0xf, 0xf, true));
}
__device__ __forceinline__ float wave_sum(float v) {
  v += dppf<0xB1>(v); v += dppf<0x4E>(v); v += dppf<0x141>(v); v += dppf<0x140>(v);
  const int iv = __builtin_bit_cast(int, v);
  const float s0 = __builtin_bit_cast(float, __builtin_amdgcn_readlane(iv, 0)), s1 = __builtin_bit_cast(float, __builtin_amdgcn_readlane(iv, 16));
  const float s2 = __builtin_bit_cast(float, __builtin_amdgcn_readlane(iv, 32)), s3 = __builtin_bit_cast(float, __builtin_amdgcn_readlane(iv, 48));
  return (s0 + s1) + (s2 + s3);
}
__device__ __forceinline__ float reduce8(float x) { x += dppf<0xB1>(x); x += dppf<0x4E>(x); x += dppf<0x141>(x); return x; }

__device__ __forceinline__ f32x4 unpack4(u32x2 w) {
  f32x4 f; f[0] = __uint_as_float(w[0] << 16); f[1] = __uint_as_float(w[0] & 0xffff0000u);
  f[2] = __uint_as_float(w[1] << 16); f[3] = __uint_as_float(w[1] & 0xffff0000u); return f;
}
__device__ __forceinline__ bf16x8 pack8(f32x4 a, f32x4 b) {
  u32x4 u; u[0] = pk2(a[0], a[1]); u[1] = pk2(a[2], a[3]); u[2] = pk2(b[0], b[1]); u[3] = pk2(b[2], b[3]);
  return __builtin_bit_cast(bf16x8, u);
}
__device__ __forceinline__ u32x2 pack4(f32x4 a) { u32x2 u; u[0] = pk2(a[0], a[1]); u[1] = pk2(a[2], a[3]); return u; }
__device__ __forceinline__ const float* xin_row(const Params& P, int l, int row) {
  if (l > 0) return P.out + (size_t)row * D;
  return row < NTP ? P.in[I_XP] + (size_t)row * D : P.in[I_XS] + (size_t)(row - NTP) * D;
}

__device__ __forceinline__ int gu_row(int c, int up) { return (c >> 6) * 128 + ((c >> 5) & 1) * 64 + up * 32 + (c & 31); }
__device__ void xpose_tile(unsigned char* smem, const float* __restrict__ W, int N, int kt, int ntl, bf16_t* __restrict__ dst, int dstK, int mode) {
  float (*tile)[65] = (float (*)[65])smem;
  const int tid = otid();
  __syncthreads();
#pragma unroll 4
  for (int i = 0; i < 16; ++i) {
    const int k = i * 4 + (tid >> 6), n = tid & 63, gn = ntl * 64 + n;
    tile[k][n] = gn < N ? W[(size_t)(kt * 64 + k) * N + gn] : 0.f;
  }
  __syncthreads();
#pragma unroll 4
  for (int i = 0; i < 16; ++i) {
    const int n = i * 4 + (tid >> 6), k = tid & 63, gn = ntl * 64 + n;
    const int drow = mode == 0 ? gn : gu_row(gn, mode - 1);
    dst[(size_t)drow * dstK + kt * 64 + k] = f2bf(tile[k][n]);
  }
}
__device__ void wconv_phase(const Params& P, unsigned char* smem, int l) {
  for (int job = obid(); job < 3392; job += gridDim.x) {
    if (job < 1024) xpose_tile(smem, P.in[I_WIN] + (size_t)l * 1024 * IN_COLS, IN_COLS, job & 15, job >> 4, WSP(bf16_t, OFF_WTIN), 1024, 0);
    else if (job < 1280) { const int j = job - 1024; xpose_tile(smem, P.in[I_WOUT] + (size_t)l * 1024 * 1024, 1024, j & 15, j >> 4, WSP(bf16_t, OFF_WTOUT), 1024, 0); }
    else if (job < 1984) { const int j = job - 1280; xpose_tile(smem, P.in[I_WG] + (size_t)l * 1024 * DFF, DFF, j & 15, j >> 4, WSP(bf16_t, OFF_WTGU), 1024, 1); }
    else if (job < 2688) { const int j = job - 1984; xpose_tile(smem, P.in[I_WU] + (size_t)l * 1024 * DFF, DFF, j & 15, j >> 4, WSP(bf16_t, OFF_WTGU), 1024, 2); }
    else { const int j = job - 2688; xpose_tile(smem, P.in[I_WD] + (size_t)l * DFF * 1024, 1024, j % 44, j / 44, WSP(bf16_t, OFF_WTDN), DFF, 0); }
  }
  bf16_t* lw = WSP(bf16_t, OFF_LORA);
  for (int idx = obid() * 256 + otid(); idx < 122880; idx += gridDim.x * 256) {
    float v = 0.f;
    if (idx < A2T) { const int n = idx >> 6, k = idx & 63; v = P.in[I_W2][(size_t)l * 64 * 384 + k * 384 + n]; }
    else if (idx < G2T) { const int i = idx - A2T, n = i >> 6, k = i & 63; v = P.in[I_A2][(size_t)l * 64 * 384 + k * 384 + n]; }
    else if (idx < V1T) { const int i = idx - G2T, n = i >> 7, k = i & 127; v = P.in[I_G2][(size_t)l * 128 * 384 + k * 384 + n]; }
    else if (idx < V2T) { if (l > 0) { const int i = idx - V1T, n = i / 384, k = i - n * 384; v = P.in[I_V1][(size_t)(l - 1) * 384 * 32 + k * 32 + n]; } }
    else { if (l > 0) { const int i = idx - V2T, n = i >> 5, k = i & 31; v = P.in[I_V2][(size_t)(l - 1) * 32 * 384 + k * 384 + n]; } }
    lw[idx] = f2bf(v);
  }
}

__device__ void norm_phase(const Params& P, int l_in, const float* __restrict__ w) {
  bf16_t* act = WSP(bf16_t, OFF_ACT);
  const int lane = otid() & 63, wid = otid() >> 6;
  for (int row = obid() * 4 + wid; row < NTOK; row += gridDim.x * 4) {
    const float* xr = xin_row(P, l_in, row);
    f32x4 v[4]; float ss = 0.f;
#pragma unroll
    for (int i = 0; i < 4; ++i) { v[i] = *(const f32x4*)(xr + i * 256 + lane * 4); ss += v[i][0] * v[i][0] + v[i][1] * v[i][1] + v[i][2] * v[i][2] + v[i][3] * v[i][3]; }
    ss = wave_sum(ss);
    const float rstd = rsqrtf(ss * (1.f / 1024.f) + 1e-6f);
#pragma unroll
    for (int i = 0; i < 4; ++i) {
      const f32x4 wv = *(const f32x4*)(w + i * 256 + lane * 4);
      u32x2 o; o[0] = pk2(v[i][0] * rstd * wv[0], v[i][1] * rstd * wv[1]); o[1] = pk2(v[i][2] * rstd * wv[2], v[i][3] * rstd * wv[3]);
      *(u32x2*)(act + (size_t)row * 1024 + i * 256 + lane * 4) = o;
    }
  }
}
__device__ void final_norm_phase(const Params& P) {
  const float* w = P.in[I_NORM_FINAL];
  const int lane = otid() & 63, wid = otid() >> 6;
  for (int row = obid() * 4 + wid; row < NTOK; row += gridDim.x * 4) {
    float* xr = P.out + (size_t)row * D;
    f32x4 v[4]; float ss = 0.f;
#pragma unroll
    for (int i = 0; i < 4; ++i) { v[i] = *(const f32x4*)(xr + i * 256 + lane * 4); ss += v[i][0] * v[i][0] + v[i][1] * v[i][1] + v[i][2] * v[i][2] + v[i][3] * v[i][3]; }
    ss = wave_sum(ss);
    const float rstd = rsqrtf(ss * (1.f / 1024.f) + 1e-6f);
#pragma unroll
    for (int i = 0; i < 4; ++i) {
      const f32x4 wv = *(const f32x4*)(w + i * 256 + lane * 4);
      f32x4 o; o[0] = v[i][0] * rstd * wv[0]; o[1] = v[i][1] * rstd * wv[1]; o[2] = v[i][2] * rstd * wv[2]; o[3] = v[i][3] * rstd * wv[3];
      *(f32x4*)(xr + i * 256 + lane * 4) = o;
    }
  }
}

enum { EPI_P = 0, EPI_RES = 1, EPI_SWIGLU = 2 };
template <int EPI>
__device__ void gemm_phase(const Params& P, unsigned char* smem, const bf16_t* __restrict__ A, int lda, const bf16_t* __restrict__ Bt, int K, int nN, int l) {
  const int tid = otid(), lane = tid & 63, wid = tid >> 6, wr = wid >> 1, wc = wid & 1, fr = lane & 15, fq = lane >> 4;
  const int ntiles = 129 * nN, nk = K >> 6;
  const int r0s = tid >> 3, cs = tid & 7;
  const int swz = (fr >> 1) & 7;
  for (int tile = obid(); tile < ntiles; tile += gridDim.x) {
    const int mt = tile / nN, nt = tile - mt * nN;
    const bf16_t* Ag = A + (size_t)(mt * 128 + r0s) * lda + cs * 8;
    const bf16_t* Bg = Bt + (size_t)(nt * 128 + r0s) * K + cs * 8;
    f32x4 acc[4][4];
#pragma unroll
    for (int m = 0; m < 4; ++m)
#pragma unroll
      for (int n = 0; n < 4; ++n) acc[m][n] = (f32x4){0.f, 0.f, 0.f, 0.f};
    u32x4 ra[4], rb[4];
#pragma unroll
    for (int i = 0; i < 4; ++i) { ra[i] = *(const u32x4*)(Ag + (size_t)i * 32 * lda); rb[i] = *(const u32x4*)(Bg + (size_t)i * 32 * K); }
#pragma unroll
    for (int i = 0; i < 4; ++i) {
      const int row = r0s + i * 32; const int off = row * 128 + ((cs ^ ((row >> 1) & 7)) << 4);
      *(u32x4*)(smem + off) = ra[i]; *(u32x4*)(smem + 16384 + off) = rb[i];
    }
    __syncthreads();
    for (int kt = 0; kt < nk; ++kt) {
      const bool nxt = kt + 1 < nk;
      if (nxt) {
#pragma unroll
        for (int i = 0; i < 4; ++i) { ra[i] = *(const u32x4*)(Ag + (size_t)i * 32 * lda + (kt + 1) * 64); rb[i] = *(const u32x4*)(Bg + (size_t)i * 32 * K + (kt + 1) * 64); }
      }
      const unsigned char* sA = smem + (kt & 1) * 32768;
      const unsigned char* sB = sA + 16384;
#pragma unroll
      for (int kk = 0; kk < 2; ++kk) {
        bf16x8 af[4], bfg[4];
        const int coff = ((kk * 4 + fq) ^ swz) << 4;
#pragma unroll
        for (int m = 0; m < 4; ++m) af[m] = *(const bf16x8*)(sA + (wr * 64 + m * 16 + fr) * 128 + coff);
#pragma unroll
        for (int n = 0; n < 4; ++n) bfg[n] = *(const bf16x8*)(sB + (wc * 64 + n * 16 + fr) * 128 + coff);
#pragma unroll
        for (int m = 0; m < 4; ++m)
#pragma unroll
          for (int n = 0; n < 4; ++n) acc[m][n] = __builtin_amdgcn_mfma_f32_16x16x32_bf16(bfg[n], af[m], acc[m][n], 0, 0, 0);
      }
      if (nxt) {
        unsigned char* dA = smem + ((kt + 1) & 1) * 32768;
#pragma unroll
        for (int i = 0; i < 4; ++i) {
          const int row = r0s + i * 32; const int off = row * 128 + ((cs ^ ((row >> 1) & 7)) << 4);
          *(u32x4*)(dA + off) = ra[i]; *(u32x4*)(dA + 16384 + off) = rb[i];
        }
      }
      __syncthreads();
    }
#pragma unroll
    for (int m = 0; m < 4; ++m) {
      const int row = mt * 128 + wr * 64 + m * 16 + fr;
      if (EPI == EPI_P) {
        bf16_t* pr = WSP(bf16_t, OFF_P) + (size_t)row * PSTR;
#pragma unroll
        for (int n = 0; n < 4; ++n) {
          const int col = nt * 128 + wc * 64 + n * 16 + fq * 4;
          if (col < IN_COLS) { u32x2 o; o[0] = pk2(acc[m][n][0], acc[m][n][1]); o[1] = pk2(acc[m][n][2], acc[m][n][3]); *(u32x2*)(pr + col) = o; }
        }
      } else if (EPI == EPI_RES) {
        const float* xi = xin_row(P, l, row);
        float* xo = P.out + (size_t)row * D;
#pragma unroll
        for (int n = 0; n < 4; ++n) {
          const int col = nt * 128 + wc * 64 + n * 16 + fq * 4;
          const f32x4 xv = *(const f32x4*)(xi + col);
          *(f32x4*)(xo + col) = xv + acc[m][n];
        }
      } else {
        bf16_t* ur = WSP(bf16_t, OFF_P) + (size_t)row * DFF;
#pragma unroll
        for (int n = 0; n < 2; ++n) {
          const int col = nt * 64 + wc * 32 + n * 16 + fq * 4;
          float r[4];
#pragma unroll
          for (int j = 0; j < 4; ++j) r[j] = silu(acc[m][n][j]) * acc[m][n + 2][j];
          u32x2 o; o[0] = pk2(r[0], r[1]); o[1] = pk2(r[2], r[3]);
          *(u32x2*)(ur + col) = o;
        }
      }
    }
  }
}

__device__ __forceinline__ float lbval(const Params& P, int l, int c) {
  const float* hb = P.in[I_HLB];
  const float a0 = hb[c], a1 = hb[256 + c], a2 = hb[512 + c], a3 = hb[768 + c];
  const float m = fmaxf(fmaxf(a0, a1), fmaxf(a2, a3));
  const float e0 = __expf(a0 - m), e1 = __expf(a1 - m), e2 = __expf(a2 - m), e3 = __expf(a3 - m);
  const float inv = 1.f / (e0 + e1 + e2 + e3);
  float s = 0.f;
  if (l >= 1) s += e1; if (l >= 2) s += e2; if (l >= 3) s += e3;
  return s * inv;
}

__device__ __forceinline__ void gdn_conv_emit(const Params& P, int g, int lane, int row, float s) {
  const int h = g % 6;
  if (g < 12) {
    const float ss = wave_sum(s * s);
    const float o = s * rsqrtf(ss + 1e-6f) * (g < 6 ? 0.125f : 1.f);
    (g < 6 ? WSP(bf16_t, OFF_GQ) : WSP(bf16_t, OFF_GK))[(size_t)row * 384 + h * 64 + lane] = f2bf(o);
  } else {
    WSP(bf16_t, OFF_GV)[(size_t)row * 384 + h * 64 + lane] = f2bf(s);
  }
}
__device__ __forceinline__ void gdn_gate_emit(const Params& P, int l, int h, int row) {
  const bf16_t* pr = WSP(bf16_t, OFF_P) + (size_t)row * PSTR;
  const float braw = bf2f(pr[1536 + h]), araw = bf2f(pr[1542 + h]);
  const float gg = -__expf(P.in[I_ALOG][l * 6 + h]) * softplus(araw + P.in[I_DTB][l * 6 + h]);
  WSP(float, OFF_GDEC)[(size_t)row * 8 + h] = __expf(gg);
  WSP(float, OFF_GBETA)[(size_t)row * 8 + h] = sigm(braw);
}
__device__ void prep_gdn_prompt(const Params& P, int l, int ci) {
  const int lane = otid() & 63, wid = otid() >> 6;
  const int r0 = ci * 32, b = r0 / TSEQ, t0 = r0 % TSEQ;
  const bf16_t* p = WSP(bf16_t, OFF_P);
  for (int g = wid; g < 18; g += 4) {
    const int col = g * 64 + lane;
    const float* cw = P.in[I_CONVW] + (size_t)l * 4 * 1152 + col;
    const float c0 = cw[0], c1 = cw[1152], c2 = cw[2304], c3 = cw[3456];
    float x3 = 0.f, x2 = 0.f, x1 = 0.f;
    if (t0 > 0) { x3 = bf2f(p[(size_t)(r0 - 3) * PSTR + col]); x2 = bf2f(p[(size_t)(r0 - 2) * PSTR + col]); x1 = bf2f(p[(size_t)(r0 - 1) * PSTR + col]); }
    for (int t = 0; t < 32; ++t) {
      const float x0 = bf2f(p[(size_t)(r0 + t) * PSTR + col]);
      const float y = c0 * x3 + c1 * x2 + c2 * x1 + c3 * x0;
      gdn_conv_emit(P, g, lane, r0 + t, silu(y));
      x3 = x2; x2 = x1; x1 = x0;
    }
    if (t0 + 32 == TSEQ) {
      float* cp = P.out + O_CONV_P + (size_t)(l * 8 + b) * 3 * 1152 + col;
      cp[0] = x3; cp[1152] = x2; cp[2304] = x1;
    }
    if (g < 6 && lane < 32) gdn_gate_emit(P, l, g, r0 + lane);
  }
}
__device__ void prep_gdn_sample(const Params& P, int l, int si) {
  const int lane = otid() & 63, wid = otid() >> 6;
  const bf16_t* p = WSP(bf16_t, OFF_P);
  for (int u = wid; u < 8 * 18; u += 4) {
    const int s = si * 8 + u / 18, g = u % 18, col = g * 64 + lane, row = NTP + s;
    const float* cw = P.in[I_CONVW] + (size_t)l * 4 * 1152 + col;
    const float c0 = cw[0], c1 = cw[1152], c2 = cw[2304], c3 = cw[3456];
    const float* cb = P.in[I_SCONV] + (size_t)(l * 128 + s) * 3 * 1152 + col;
    const float x3 = cb[0], x2 = cb[1152], x1 = cb[2304];
    const float x0 = bf2f(p[(size_t)row * PSTR + col]);
    const float y = c0 * x3 + c1 * x2 + c2 * x1 + c3 * x0;
    gdn_conv_emit(P, g, lane, row, silu(y));
    float* cp = P.out + O_CONV_S + (size_t)(l * 128 + s) * 3 * 1152 + col;
    cp[0] = x2; cp[1152] = x1; cp[2304] = x0;
    if (g < 6 && lane == 0) gdn_gate_emit(P, l, g, row);
  }
}
__device__ void prep_hgrn(const Params& P, int l, int ti) {
  const int c = otid();
  const float oml = 1.f - lbval(P, l, c);
  const bf16_t* p = WSP(bf16_t, OFF_P);
  bf16_t* hq = WSP(bf16_t, OFF_HQ); bf16_t* hk = WSP(bf16_t, OFF_HK);
  for (int t = 0; t < 64; ++t) {
    const int row = ti * 64 + t;
    const float q = bf2f(p[(size_t)row * PSTR + PC + c]), f = bf2f(p[(size_t)row * PSTR + PC + 256 + c]);
    hq[(size_t)row * 256 + c] = f2bf(silu(q) * 0.125f);
    hk[(size_t)row * 256 + c] = f2bf(oml * sigm(-f));
  }
}
__device__ __forceinline__ f32x4 xs4(const Params& P, int l, int row, int col0) {
  const bf16_t* p = WSP(bf16_t, OFF_P);
  const f32x4 pv = unpack4(*(const u32x2*)(p + (size_t)row * PSTR + PB + col0));
  f32x4 prev = (f32x4){0.f, 0.f, 0.f, 0.f};
  if (row >= NTP) prev = *(const f32x4*)(P.in[I_SSHIFT] + (size_t)(l * 128 + (row - NTP)) * 1408 + col0);
  else if ((row & (TSEQ - 1)) != 0) prev = unpack4(*(const u32x2*)(p + (size_t)(row - 1) * PSTR + PB + col0));
  const f32x4 mu = *(const f32x4*)(P.in[I_MU] + l * 1408 + col0);
  return pv + (prev - pv) * mu;
}
__device__ __forceinline__ float tanh_fast(float x) { return 1.f - 2.f / (__expf(2.f * x) + 1.f); }

__device__ void prep_rwkv_unit(const Params& P, int l, int mt, int hh) {
  const int lane = otid() & 63, fr = lane & 15, fq = lane >> 4;
  const int row = mt * 16 + fr, cb = hh * 192;
  const bf16_t* lw = WSP(bf16_t, OFF_LORA);
  const size_t ro = (size_t)row * 384;
  f32x4 acc[12];
#pragma unroll
  for (int nf = 0; nf < 12; ++nf) acc[nf] = (f32x4){0.f, 0.f, 0.f, 0.f};
#pragma unroll
  for (int ks = 0; ks < 2; ++ks) {
    f32x4 x0 = xs4(P, l, row, 1152 + ks * 32 + fq * 8), x1 = xs4(P, l, row, 1152 + ks * 32 + fq * 8 + 4);
#pragma unroll
    for (int j = 0; j < 4; ++j) { x0[j] = tanh_fast(x0[j]); x1[j] = tanh_fast(x1[j]); }
    const bf16x8 A = pack8(x0, x1);
#pragma unroll
    for (int nf = 0; nf < 12; ++nf) {
      const bf16x8 B = *(const bf16x8*)(lw + W2T + (cb + nf * 16 + fr) * 64 + ks * 32 + fq * 8);
      acc[nf] = __builtin_amdgcn_mfma_f32_16x16x32_bf16(B, A, acc[nf], 0, 0, 0);
    }
  }
#pragma unroll
  for (int nf = 0; nf < 12; ++nf) {
    const int c = cb + nf * 16 + fq * 4;
    const f32x4 w0 = *(const f32x4*)(P.in[I_W0] + l * 384 + c);
    f32x4 d;
#pragma unroll
    for (int j = 0; j < 4; ++j) {
      const float x = -(w0[j] + acc[nf][j]);
      const float sp = x > 15.f ? x : __logf(1.f + __expf(x));
      d[j] = __expf(-__expf(-sp - 0.5f));
    }
    *(f32x4*)(WSP(float, OFF_RW) + ro + c) = d;
  }
#pragma unroll
  for (int nf = 0; nf < 12; ++nf) acc[nf] = (f32x4){0.f, 0.f, 0.f, 0.f};
#pragma unroll
  for (int ks = 0; ks < 2; ++ks) {
    const bf16x8 A = pack8(xs4(P, l, row, 1216 + ks * 32 + fq * 8), xs4(P, l, row, 1216 + ks * 32 + fq * 8 + 4));
#pragma unroll
    for (int nf = 0; nf < 12; ++nf) {
      const bf16x8 B = *(const bf16x8*)(lw + A2T + (cb + nf * 16 + fr) * 64 + ks * 32 + fq * 8);
      acc[nf] = __builtin_amdgcn_mfma_f32_16x16x32_bf16(B, A, acc[nf], 0, 0, 0);
    }
  }
#pragma unroll
  for (int hl = 0; hl < 3; ++hl) {
    f32x4 kr[4], kkr[4];
    float ss = 0.f;
#pragma unroll
    for (int q = 0; q < 4; ++q) {
      const int c = cb + (hl * 4 + q) * 16 + fq * 4;
      kr[q] = xs4(P, l, row, 384 + c);
      kkr[q] = kr[q] * *(const f32x4*)(P.in[I_KK] + l * 384 + c);
      ss += kkr[q][0] * kkr[q][0] + kkr[q][1] * kkr[q][1] + kkr[q][2] * kkr[q][2] + kkr[q][3] * kkr[q][3];
    }
    ss += __shfl_xor(ss, 16); ss += __shfl_xor(ss, 32);
    const float rn = rsqrtf(ss + 1e-6f);
#pragma unroll
    for (int q = 0; q < 4; ++q) {
      const int nf = hl * 4 + q, c = cb + nf * 16 + fq * 4;
      const f32x4 a0 = *(const f32x4*)(P.in[I_A0] + l * 384 + c), ka = *(const f32x4*)(P.in[I_KA] + l * 384 + c);
      f32x4 kn, kk, kb;
#pragma unroll
      for (int j = 0; j < 4; ++j) {
        const float a = sigm(a0[j] + acc[nf][j]);
        kk[j] = kkr[q][j] * rn; kb[j] = kk[j] * a; kn[j] = kr[q][j] * (1.f + (a - 1.f) * ka[j]);
      }
      *(u32x2*)(WSP(bf16_t, OFF_RK) + ro + c) = pack4(kn);
      *(u32x2*)(WSP(bf16_t, OFF_RKK) + ro + c) = pack4(kk);
      *(u32x2*)(WSP(bf16_t, OFF_RB) + ro + c) = pack4(kb);
      *(u32x2*)(WSP(bf16_t, OFF_RR) + ro + c) = pack4(xs4(P, l, row, c));
    }
  }
#pragma unroll
  for (int nf = 0; nf < 12; ++nf) acc[nf] = (f32x4){0.f, 0.f, 0.f, 0.f};
#pragma unroll
  for (int ks = 0; ks < 4; ++ks) {
    f32x4 x0 = xs4(P, l, row, 1280 + ks * 32 + fq * 8), x1 = xs4(P, l, row, 1280 + ks * 32 + fq * 8 + 4);
#pragma unroll
    for (int j = 0; j < 4; ++j) { x0[j] = sigm(x0[j]); x1[j] = sigm(x1[j]); }
    const bf16x8 A = pack8(x0, x1);
#pragma unroll
    for (int nf = 0; nf < 12; ++nf) {
      const bf16x8 B = *(const bf16x8*)(lw + G2T + (cb + nf * 16 + fr) * 128 + ks * 32 + fq * 8);
      acc[nf] = __builtin_amdgcn_mfma_f32_16x16x32_bf16(B, A, acc[nf], 0, 0, 0);
    }
  }
#pragma unroll
  for (int nf = 0; nf < 12; ++nf) *(u32x2*)(WSP(bf16_t, OFF_RG) + ro + cb + nf * 16 + fq * 4) = pack4(acc[nf]);
  if (l == 0) {
#pragma unroll
    for (int nf = 0; nf < 12; ++nf) {
      const int c = cb + nf * 16 + fq * 4;
      const u32x2 o = pack4(xs4(P, l, row, 768 + c));
      *(u32x2*)(WSP(bf16_t, OFF_RV) + ro + c) = o;
      *(u32x2*)(WSP(bf16_t, OFF_VF) + ro + c) = o;
    }
  } else {
    f32x4 lo0 = (f32x4){0.f, 0.f, 0.f, 0.f}, lo1 = lo0;
#pragma unroll 4
    for (int ks = 0; ks < 12; ++ks) {
      const bf16x8 A = pack8(xs4(P, l, row, 768 + ks * 32 + fq * 8), xs4(P, l, row, 768 + ks * 32 + fq * 8 + 4));
      const bf16x8 B0 = *(const bf16x8*)(lw + V1T + fr * 384 + ks * 32 + fq * 8);
      const bf16x8 B1 = *(const bf16x8*)(lw + V1T + (16 + fr) * 384 + ks * 32 + fq * 8);
      lo0 = __builtin_amdgcn_mfma_f32_16x16x32_bf16(B0, A, lo0, 0, 0, 0);
      lo1 = __builtin_amdgcn_mfma_f32_16x16x32_bf16(B1, A, lo1, 0, 0, 0);
    }
    const bf16x8 A2 = pack8(lo0, lo1);
#pragma unroll
    for (int nf = 0; nf < 12; ++nf) {
      const int c = cb + nf * 16 + fq * 4;
      const bf16_t* vr = lw + V2T + (cb + nf * 16 + fr) * 32;
      u32x4 bw; { const u32x2 b0 = *(const u32x2*)(vr + fq * 4), b1 = *(const u32x2*)(vr + 16 + fq * 4); bw[0] = b0[0]; bw[1] = b0[1]; bw[2] = b1[0]; bw[3] = b1[1]; }
      const f32x4 mv = __builtin_amdgcn_mfma_f32_16x16x32_bf16(__builtin_bit_cast(bf16x8, bw), A2, (f32x4){0.f, 0.f, 0.f, 0.f}, 0, 0, 0);
      const f32x4 v0 = *(const f32x4*)(P.in[I_V0] + (l - 1) * 384 + c);
      const f32x4 v = xs4(P, l, row, 768 + c), vf = unpack4(*(const u32x2*)(WSP(bf16_t, OFF_VF) + ro + c));
      f32x4 o;
#pragma unroll
      for (int j = 0; j < 4; ++j) o[j] = v[j] + (vf[j] - v[j]) * sigm(v0[j] + mv[j]);
      *(u32x2*)(WSP(bf16_t, OFF_RV) + ro + c) = pack4(o);
    }
  }
}
__device__ void prep_phase(const Params& P, unsigned char* smem, int l) {
  for (int it = obid(); it < 1302; it += gridDim.x) {
    if (it < 516) { const int wid = otid() >> 6; prep_rwkv_unit(P, l, it * 2 + (wid >> 1), wid & 1); }
    else if (it < 1028) prep_gdn_prompt(P, l, it - 516);
    else if (it < 1044) prep_gdn_sample(P, l, it - 1028);
    else prep_hgrn(P, l, it - 1044);
  }
  const bf16_t* p = WSP(bf16_t, OFF_P);
  for (int idx = obid() * 256 + otid(); idx < 136 * 1408; idx += gridDim.x * 256) {
    const int q = idx / 1408, col = idx - q * 1408;
    if (q < 8) P.out[O_SHIFT_P + (size_t)(l * 8 + q) * 1408 + col] = bf2f(p[(size_t)(q * TSEQ + TSEQ - 1) * PSTR + PB + col]);
    else P.out[O_SHIFT_S + (size_t)(l * 128 + (q - 8)) * 1408 + col] = bf2f(p[(size_t)(NTP + q - 8) * PSTR + PB + col]);
  }
}

template <int KIND> struct ScanCfg { static constexpr int STRIDE = KIND == 0 ? 164 : (KIND == 1 ? 352 : 160); };

template <int KIND> struct ScanPre { u32x2 a, b, c, d, v; f32x4 w; float g; };

template <int KIND>
__device__ __forceinline__ void scan_load(const Params& P, ScanPre<KIND>& r, int h, int half, int rowbase, int nvalid) {
  const int tid = otid();
  const int s = tid >> 4, j4 = (tid & 15) * 4;
  const int s2 = (tid >> 3) & 15, j2 = (tid & 7) * 4;
  const u32x2 z2 = {0u, 0u};
  const bool ok = s < nvalid, ok2 = (tid < 128) && (s2 < nvalid);
  if (KIND == 0) {
    const size_t o = (size_t)(rowbase + s) * 384 + h * 64 + j4;
    r.a = ok ? *(const u32x2*)(WSP(bf16_t, OFF_GK) + o) : z2;
    r.b = ok ? *(const u32x2*)(WSP(bf16_t, OFF_GQ) + o) : z2;
    r.v = ok2 ? *(const u32x2*)(WSP(bf16_t, OFF_GV) + (size_t)(rowbase + s2) * 384 + h * 64 + half * 32 + j2) : z2;
    const int sg = (tid >> 1) & 15;
    r.g = (tid < 32 && sg < nvalid) ? ((tid & 1) ? WSP(float, OFF_GBETA) : WSP(float, OFF_GDEC))[(size_t)(rowbase + sg) * 8 + h] : 0.f;
  } else if (KIND == 1) {
    const size_t o = (size_t)(rowbase + s) * 384 + h * 64 + j4;
    r.a = ok ? *(const u32x2*)(WSP(bf16_t, OFF_RR) + o) : z2;
    r.w = ok ? *(const f32x4*)(WSP(float, OFF_RW) + o) : (f32x4){0.f, 0.f, 0.f, 0.f};
    r.b = ok ? *(const u32x2*)(WSP(bf16_t, OFF_RK) + o) : z2;
    r.c = ok ? *(const u32x2*)(WSP(bf16_t, OFF_RKK) + o) : z2;
    r.d = ok ? *(const u32x2*)(WSP(bf16_t, OFF_RB) + o) : z2;
    r.v = ok2 ? *(const u32x2*)(WSP(bf16_t, OFF_RV) + (size_t)(rowbase + s2) * 384 + h * 64 + half * 32 + j2) : z2;
  } else {
    const size_t o = (size_t)(rowbase + s) * 256 + h * 64 + j4;
    r.a = ok ? *(const u32x2*)(WSP(bf16_t, OFF_HQ) + o) : z2;
    r.b = ok ? *(const u32x2*)(WSP(bf16_t, OFF_HK) + o) : z2;
    r.v = ok2 ? *(const u32x2*)(WSP(bf16_t, OFF_P) + (size_t)(rowbase + s2) * PSTR + PC + 512 + h * 64 + half * 32 + j2) : z2;
  }
}
template <int KIND>
__device__ __forceinline__ void scan_store(const ScanPre<KIND>& r, float* buf) {
  constexpr int STRIDE = ScanCfg<KIND>::STRIDE;
  const int tid = otid();
  const int s = tid >> 4, j4 = (tid & 15) * 4;
  const int s2 = (tid >> 3) & 15, j2 = (tid & 7) * 4;
  float* bs = buf + s * STRIDE + j4;
  if (KIND == 0) {
    *(f32x4*)(bs) = unpack4(r.a); *(f32x4*)(bs + 64) = unpack4(r.b);
    if (tid < 128) *(f32x4*)(buf + s2 * STRIDE + 128 + j2) = unpack4(r.v);
    if (tid < 32) buf[((tid >> 1) & 15) * STRIDE + 160 + (tid & 1)] = r.g;
  } else if (KIND == 1) {
    *(f32x4*)(bs) = unpack4(r.a); *(f32x4*)(bs + 64) = r.w; *(f32x4*)(bs + 128) = unpack4(r.b);
    *(f32x4*)(bs + 192) = unpack4(r.c); *(f32x4*)(bs + 256) = unpack4(r.d);
    if (tid < 128) *(f32x4*)(buf + s2 * STRIDE + 320 + j2) = unpack4(r.v);
  } else {
    *(f32x4*)(bs) = unpack4(r.a); *(f32x4*)(bs + 64) = unpack4(r.b);
    if (tid < 128) *(f32x4*)(buf + s2 * STRIDE + 128 + j2) = unpack4(r.v);
  }
}

template <int KIND>
__device__ void scan_task(const Params& P, unsigned char* smem, int l, int seq, int h, int half) {
  constexpr int STRIDE = ScanCfg<KIND>::STRIDE, NEL = 16 * STRIDE;
  constexpr int NH = KIND == 2 ? 4 : 6;
  float* buf = (float*)smem;
  float* obuf = buf + 2 * NEL;
  const int tid = otid(), lane = tid & 63, wid = tid >> 6;
  const int col_l = lane >> 3, sub = lane & 7, cl = wid * 8 + col_l, col = half * 32 + cl, e0 = sub * 8;
  const bool sample = seq >= 8;
  const int R0 = sample ? NTP + (seq - 8) : seq * TSEQ, T = sample ? 1 : TSEQ;
  const int ocol = (KIND == 0 ? 0 : (KIND == 1 ? 384 : 768)) + h * 64 + half * 32;
  const size_t O_P = KIND == 0 ? O_GDN_P : (KIND == 1 ? O_RWKV_P : O_HGRN_P);
  const size_t O_S = KIND == 0 ? O_GDN_S : (KIND == 1 ? O_RWKV_S : O_HGRN_S);
  const int I_ST = KIND == 0 ? I_SGDN : (KIND == 1 ? I_SRWKV : I_SHGRN);
  float S[8];
  if (sample) {
    const float* st = P.in[I_ST] + ((size_t)(l * 128 + (seq - 8)) * NH + h) * 4096;
#pragma unroll
    for (int i = 0; i < 8; ++i) S[i] = KIND == 1 ? st[col * 64 + e0 + i] : st[(e0 + i) * 64 + col];
  } else {
#pragma unroll
    for (int i = 0; i < 8; ++i) S[i] = 0.f;
  }
  ScanPre<KIND> pre;
  __syncthreads();
  scan_load<KIND>(P, pre, h, half, R0, T);
  scan_store<KIND>(pre, buf);
  __syncthreads();
  const int nchunks = (T + 15) >> 4;
  bf16_t* oraw = WSP(bf16_t, OFF_P);
  for (int c = 0; c < nchunks; ++c) {
    const int t0 = c * 16, n = (T - t0) < 16 ? (T - t0) : 16;
    const bool has_next = c + 1 < nchunks;
    if (has_next) scan_load<KIND>(P, pre, h, half, R0 + t0 + 16, T - t0 - 16);
    const float* b = buf + (c & 1) * NEL;
    float* ob = obuf + (c & 1) * 512;
    for (int s = 0; s < n; ++s) {
      const float* bs = b + s * STRIDE;
      float o;
      if (KIND == 0) {
        const f32x4 k0 = *(const f32x4*)(bs + e0), k1 = *(const f32x4*)(bs + e0 + 4);
        const f32x4 q0 = *(const f32x4*)(bs + 64 + e0), q1 = *(const f32x4*)(bs + 64 + e0 + 4);
        const float vv = bs[128 + cl], dec = bs[160], beta = bs[161];
        const float kf[8] = {k0[0], k0[1], k0[2], k0[3], k1[0], k1[1], k1[2], k1[3]};
        const float qf[8] = {q0[0], q0[1], q0[2], q0[3], q1[0], q1[1], q1[2], q1[3]};
        float ks = 0.f;
#pragma unroll
        for (int i = 0; i < 8; ++i) ks += kf[i] * S[i];
        ks = reduce8(ks);
        const float vn = beta * (vv - dec * ks);
        o = 0.f;
#pragma unroll
        for (int i = 0; i < 8; ++i) { S[i] = dec * S[i] + kf[i] * vn; o += qf[i] * S[i]; }
        o = reduce8(o);
      } else if (KIND == 1) {
        const f32x4 r0 = *(const f32x4*)(bs + e0), r1 = *(const f32x4*)(bs + e0 + 4);
        const f32x4 w0 = *(const f32x4*)(bs + 64 + e0), w1 = *(const f32x4*)(bs + 64 + e0 + 4);
        const f32x4 k0 = *(const f32x4*)(bs + 128 + e0), k1 = *(const f32x4*)(bs + 128 + e0 + 4);
        const f32x4 c0 = *(const f32x4*)(bs + 192 + e0), c1 = *(const f32x4*)(bs + 192 + e0 + 4);
        const f32x4 b0 = *(const f32x4*)(bs + 256 + e0), b1 = *(const f32x4*)(bs + 256 + e0 + 4);
        const float vv = bs[320 + cl];
        const float rf[8] = {r0[0], r0[1], r0[2], r0[3], r1[0], r1[1], r1[2], r1[3]};
        const float wf[8] = {w0[0], w0[1], w0[2], w0[3], w1[0], w1[1], w1[2], w1[3]};
        const float kf[8] = {k0[0], k0[1], k0[2], k0[3], k1[0], k1[1], k1[2], k1[3]};
        const float cf[8] = {c0[0], c0[1], c0[2], c0[3], c1[0], c1[1], c1[2], c1[3]};
        const float bf[8] = {b0[0], b0[1], b0[2], b0[3], b1[0], b1[1], b1[2], b1[3]};
        float sa = 0.f;
#pragma unroll
        for (int i = 0; i < 8; ++i) sa += S[i] * cf[i];
        sa = -reduce8(sa);
        o = 0.f;
#pragma unroll
        for (int i = 0; i < 8; ++i) { S[i] = S[i] * wf[i] + sa * bf[i] + vv * kf[i]; o += S[i] * rf[i]; }
        o = reduce8(o);
      } else {
        const f32x4 q0 = *(const f32x4*)(bs + e0), q1 = *(const f32x4*)(bs + e0 + 4);
        const f32x4 k0 = *(const f32x4*)(bs + 64 + e0), k1 = *(const f32x4*)(bs + 64 + e0 + 4);
        const float iv = bs[128 + cl];
        const float qf[8] = {q0[0], q0[1], q0[2], q0[3], q1[0], q1[1], q1[2], q1[3]};
        const float kf[8] = {k0[0], k0[1], k0[2], k0[3], k1[0], k1[1], k1[2], k1[3]};
        o = 0.f;
#pragma unroll
        for (int i = 0; i < 8; ++i) { S[i] = S[i] + kf[i] * (iv - S[i]); o += qf[i] * S[i]; }
        o = reduce8(o);
      }
      if (sub == 0) ob[s * 32 + cl] = o;
    }
    if (has_next) scan_store<KIND>(pre, buf + ((c + 1) & 1) * NEL);
    __syncthreads();
#pragma unroll
    for (int i = 0; i < 2; ++i) {
      const int idx = tid + i * 256, s = idx >> 5, cc = idx & 31;
      if (s < n) oraw[(size_t)(R0 + t0 + s) * PSTR + ocol + cc] = f2bf(ob[idx]);
    }
  }
  float* so = P.out + (sample ? O_S + ((size_t)(l * 128 + (seq - 8)) * NH + h) * 4096 : O_P + ((size_t)(l * 8 + seq) * NH + h) * 4096);
#pragma unroll
  for (int i = 0; i < 8; ++i) { if (KIND == 1) so[col * 64 + e0 + i] = S[i]; else so[(e0 + i) * 64 + col] = S[i]; }
}

__device__ void scan_long(const Params& P, unsigned char* smem, int l, int lt) {
  if (lt < 96) { const int half = lt & 1, bh = lt >> 1; scan_task<1>(P, smem, l, bh / 6, bh % 6, half); }
  else if (lt < 192) { const int x = lt - 96, half = x & 1, bh = x >> 1; scan_task<0>(P, smem, l, bh / 6, bh % 6, half); }
  else { const int x = lt - 192, half = x & 1, bh = x >> 1; scan_task<2>(P, smem, l, bh / 4, bh % 4, half); }
}
__device__ void scan_short(const Params& P, unsigned char* smem, int l, int st) {
  const int s = st >> 4, hh = st & 15;
  for (int half = 0; half < 2; ++half) {
    if (hh < 6) scan_task<0>(P, smem, l, 8 + s, hh, half);
    else if (hh < 12) scan_task<1>(P, smem, l, 8 + s, hh - 6, half);
    else scan_task<2>(P, smem, l, 8 + s, hh - 12, half);
  }
}
__device__ void scan_phase(const Params& P, unsigned char* smem, int l) {
  const int G = gridDim.x, bid = obid();
  if (G >= 512) {
    if (bid < 256) scan_long(P, smem, l, bid);
    else for (int st = bid - 256; st < 2048; st += G - 256) scan_short(P, smem, l, st);
  } else {
    for (int lt = bid; lt < 256; lt += G) scan_long(P, smem, l, lt);
    for (int st = bid; st < 2048; st += G) scan_short(P, smem, l, st);
  }
}

__device__ void post_phase(const Params& P, int l) {
  const int lane = otid() & 63, wid = otid() >> 6;
  const bf16_t* p = WSP(bf16_t, OFF_P);
  bf16_t* act = WSP(bf16_t, OFF_ACT);
  const float gnw = P.in[I_GNW][l * 64 + lane], hnw = P.in[I_HNW][l * 64 + lane];
  for (int u = obid() * 4 + wid; u < NTOK * 16; u += gridDim.x * 4) {
    const int row = u >> 4, hh = u & 15;
    const float o = bf2f(p[(size_t)row * PSTR + hh * 64 + lane]);
    float out;
    if (hh < 6) {
      const float z = bf2f(p[(size_t)row * PSTR + 1152 + hh * 64 + lane]);
      const float ms = wave_sum(o * o) * (1.f / 64.f);
      out = o * rsqrtf(ms + 1e-6f) * gnw * silu(z);
    } else if (hh < 12) {
      const int h = hh - 6; const size_t idx = (size_t)row * 384 + h * 64 + lane;
      const float mu = wave_sum(o) * (1.f / 64.f);
      const float yc = o - mu;
      const float var = wave_sum(yc * yc) * (1.f / 64.f);
      const float y = yc * rsqrtf(var + 64e-5f) * P.in[I_LNW][l * 384 + h * 64 + lane] + P.in[I_LNB][l * 384 + h * 64 + lane];
      const float r = bf2f(WSP(bf16_t, OFF_RR)[idx]), k = bf2f(WSP(bf16_t, OFF_RK)[idx]), v = bf2f(WSP(bf16_t, OFF_RV)[idx]), g = bf2f(WSP(bf16_t, OFF_RG)[idx]);
      const float rk = wave_sum(r * k * P.in[I_RK][l * 384 + h * 64 + lane]);
      out = (y + rk * v) * g;
    } else {
      const int h = hh - 12;
      const float z = bf2f(p[(size_t)row * PSTR + PC + 768 + h * 64 + lane]);
      const float ms = wave_sum(o * o) * (1.f / 64.f);
      out = o * rsqrtf(ms + 1e-6f) * hnw * silu(z);
    }
    act[(size_t)row * 1024 + hh * 64 + lane] = f2bf(out);
  }
}


#define XB_TMO      128
#define XB_XCNT(j)  (256  + 64 * (j))
#define XB_XSUB(j)  (1280 + 64 * (j))
#define XB_XGEN(j)  (2304 + 64 * (j))
#define XB_TOP      3328
#define XB_TOPGEN   3392
#define XCD_BAR_WORDS 3456
#define XB_SPIN_CAP (1u << 20)
#define LAS __attribute__((address_space(3)))
__device__ __forceinline__ unsigned xb_ld(unsigned* p)              { return __hip_atomic_load(p, __ATOMIC_RELAXED, __HIP_MEMORY_SCOPE_AGENT); }
__device__ __forceinline__ unsigned xb_add(unsigned* p, unsigned v) { return __hip_atomic_fetch_add(p, v, __ATOMIC_RELAXED, __HIP_MEMORY_SCOPE_AGENT); }
__device__ __forceinline__ unsigned xb_xcc_id() { return (unsigned)__builtin_amdgcn_s_getreg((3 << 11) | 20) & 0xFu; }
#define XB_SPIN(cond, bar) do { unsigned _sp = 0; while (cond) { __builtin_amdgcn_s_sleep(1); \
    if ((++_sp & 255u) == 0u) { if (xb_ld(&(bar)[XB_TMO])) break; if (_sp > XB_SPIN_CAP) { atomicAdd(&(bar)[XB_TMO], 1u); break; } } } } while (0)
struct XcdBarrier { unsigned* bar; unsigned x; volatile LAS unsigned* st; };
__device__ __forceinline__ XcdBarrier xcd_barrier_post(unsigned* bar, volatile LAS unsigned* st) {
  XcdBarrier b; b.bar = bar; b.x = xb_xcc_id(); b.st = st;
  if (threadIdx.x == 0) (void)xb_add(&bar[XB_XCNT(b.x)], 1u);
  return b;
}
__device__ __forceinline__ void xcd_barrier_complete(unsigned* bar, unsigned x, unsigned& nloc, unsigned& nx) {
  const unsigned G = gridDim.x * gridDim.y * gridDim.z;
  unsigned sum, cnt, mine, sp = 0u;
  for (;;) {
    sum = 0u; cnt = 0u; mine = 0u;
#pragma unroll
    for (unsigned j = 0; j < 16; ++j) { const unsigned c = xb_ld(&bar[XB_XCNT(j)]); sum += c; cnt += (c > 0u) ? 1u : 0u; mine = (j == x) ? c : mine; }
    if (sum == G) break;
    __builtin_amdgcn_s_sleep(1);
    if ((++sp & 255u) == 0u) { if (xb_ld(&bar[XB_TMO])) break; if (sp > XB_SPIN_CAP) { atomicAdd(&bar[XB_TMO], 1u); break; } }
  }
  nloc = mine > 0u ? mine : 1u; nx = cnt > 0u ? cnt : 1u;
}
__device__ __forceinline__ void xcd_barrier(const XcdBarrier& b) {
  asm volatile("s_waitcnt vmcnt(0)" ::: "memory");
  __syncthreads();
  if (threadIdx.x == 0) {
    unsigned* bar = b.bar;
    __builtin_amdgcn_s_waitcnt(0);
    unsigned nloc = b.st[0], nx = b.st[1];
    if (nloc == 0u) { xcd_barrier_complete(bar, b.x, nloc, nx); b.st[0] = nloc; b.st[1] = nx; }
    const unsigned old = xb_add(&bar[XB_XSUB(b.x)], 1u);
    const unsigned gen = old / nloc;
    if (old + 1u == (gen + 1u) * nloc) {
      __builtin_amdgcn_fence(__ATOMIC_RELEASE, "agent");
      asm volatile("s_waitcnt vmcnt(0)" ::: "memory");
      const unsigned og = xb_add(&bar[XB_TOP], 1u);
      const unsigned tg = og / nx;
      if (og + 1u == (tg + 1u) * nx) xb_add(&bar[XB_TOPGEN], 1u);
      else XB_SPIN(xb_ld(&bar[XB_TOPGEN]) == tg, bar);
      __builtin_amdgcn_fence(__ATOMIC_ACQUIRE, "agent");
      xb_add(&bar[XB_XGEN(b.x)], 1u);
      asm volatile("s_waitcnt vmcnt(0)" ::: "memory");
    } else {
      XB_SPIN(xb_ld(&bar[XB_XGEN(b.x)]) == gen, bar);
      __builtin_amdgcn_fence(__ATOMIC_ACQUIRE, "agent");
      asm volatile("s_waitcnt vmcnt(0)" ::: "memory");
    }
  }
  __syncthreads();
}

__global__ void __launch_bounds__(256, 2) hybrid_fwd(Params P) {
  cg::grid_group grid = cg::this_grid();
  __shared__ __attribute__((aligned(16))) unsigned char smem[65536];
  __shared__ uint4 xb_words;
  if (threadIdx.x == 0) xb_words = make_uint4(0u, 0u, 0u, 0u);
  __syncthreads();
  const XcdBarrier xb = xcd_barrier_post(WSP(unsigned, OFF_BAR), (volatile LAS unsigned*)&xb_words);
#pragma unroll 1
  for (int step = 0; step < NLAYER * 9; ++step) {
    const int l = step / 9, ph = step - l * 9;
    switch (ph) {
      case 0: wconv_phase(P, smem, l); norm_phase(P, l, P.in[I_NORM_MIX] + l * D); break;
      case 1: gemm_phase<EPI_P>(P, smem, WSP(bf16_t, OFF_ACT), 1024, WSP(bf16_t, OFF_WTIN), 1024, 32, l); break;
      case 2: prep_phase(P, smem, l); break;
      case 3: scan_phase(P, smem, l); break;
      case 4: post_phase(P, l); break;
      case 5: gemm_phase<EPI_RES>(P, smem, WSP(bf16_t, OFF_ACT), 1024, WSP(bf16_t, OFF_WTOUT), 1024, 8, l); break;
      case 6: norm_phase(P, 1, P.in[I_NORM_FFN] + l * D); break;
      case 7: gemm_phase<EPI_SWIGLU>(P, smem, WSP(bf16_t, OFF_ACT), 1024, WSP(bf16_t, OFF_WTGU), 1024, 44, 1); break;
      default: gemm_phase<EPI_RES>(P, smem, WSP(bf16_t, OFF_P), DFF, WSP(bf16_t, OFF_WTDN), DFF, 8, 1); break;
    }
    if (step == 0) grid.sync();
    else xcd_barrier(xb);
  }
  final_norm_phase(P);
}

extern "C" void kernel_launch(void* const* d_in, const int* in_sizes, int n_in,
                              void* d_out, int out_size, void* d_ws, size_t ws_size,
                              hipStream_t stream) {
  static int grid_blocks = 0;
  if (!grid_blocks) {
    int dev = 0, cus = 0, per_cu = 0;
    (void)hipGetDevice(&dev);
    (void)hipDeviceGetAttribute(&cus, hipDeviceAttributeMultiprocessorCount, dev);
    (void)hipOccupancyMaxActiveBlocksPerMultiprocessor(&per_cu, hybrid_fwd, 256, 0);
    if (per_cu > 2) per_cu = 2;
    if (per_cu < 1) per_cu = 1;
    grid_blocks = cus * per_cu;
  }
  if (ws_size < WS_NEED) { fprintf(stderr, "workspace too small: %zu < %zu\n", ws_size, (size_t)WS_NEED); return; }
  Params p{};
  for (int i = 0; i < N_IN; ++i) p.in[i] = (const float*)d_in[i];
  p.out = (float*)d_out;
  p.ws = (unsigned char*)d_ws;
  (void)hipMemsetAsync((unsigned char*)d_ws + OFF_BAR, 0, 16384, stream);
  void* args[] = {&p};
  hipError_t e = hipLaunchCooperativeKernel((void*)hybrid_fwd, dim3(grid_blocks), dim3(256), args, 0, stream);
  if (e != hipSuccess) fprintf(stderr, "cooperative launch failed: %s (grid %d)\n", hipGetErrorString(e), grid_blocks);
}
```

```cpp
#include <hip/hip_runtime.h>
#include <hip/hip_cooperative_groups.h>
#include <cstdio>
namespace cg = cooperative_groups;

typedef unsigned short bf16_t;
typedef short bf16x8 __attribute__((ext_vector_type(8)));
typedef float f32x4 __attribute__((ext_vector_type(4)));
typedef unsigned u32x4 __attribute__((ext_vector_type(4)));
typedef unsigned u32x2 __attribute__((ext_vector_type(2)));

constexpr int D = 1024, NTP = 16384, NTS = 128, NTOK = 16512, TSEQ = 2048, NLAYER = 4;
constexpr int IN_COLS = 3980, PSTR = 3984, DFF = 2816;
constexpr int PB = 1548, PC = 2956;

enum { I_XP = 0, I_XS, I_SGDN, I_SCONV, I_SRWKV, I_SSHIFT, I_SHGRN, I_NORM_MIX, I_WIN, I_WOUT, I_CONVW, I_ALOG, I_DTB, I_GNW,
       I_MU, I_W0, I_W2, I_A0, I_A2, I_G2, I_V0, I_V1, I_V2, I_KK, I_KA, I_RK, I_LNW, I_LNB, I_HLB, I_HNW, I_NORM_FFN,
       I_WG, I_WU, I_WD, I_NORM_FINAL, N_IN };

constexpr size_t O_YP = 0, O_YS = 16777216, O_GDN_P = 16908288, O_GDN_S = 17694720, O_CONV_P = 30277632, O_CONV_S = 30388224,
                 O_RWKV_P = 32157696, O_RWKV_S = 32944128, O_SHIFT_P = 45527040, O_SHIFT_S = 45572096, O_HGRN_P = 46292992,
                 O_HGRN_S = 46817280;

constexpr size_t SZ_WTIN = (size_t)4096 * 1024 * 2, SZ_WTOUT = (size_t)1024 * 1024 * 2, SZ_WTGU = (size_t)5632 * 1024 * 2,
                 SZ_WTDN = (size_t)1024 * 2816 * 2, SZ_P = (size_t)NTOK * PSTR * 2, SZ_ACT = (size_t)NTOK * 1024 * 2,
                 SZ_T384 = (size_t)NTOK * 384 * 2, SZ_T8F = (size_t)NTOK * 8 * 4, SZ_T256 = (size_t)NTOK * 256 * 2,
                 SZ_T384F = (size_t)NTOK * 384 * 4;
constexpr size_t OFF_WTIN = 0, OFF_WTOUT = OFF_WTIN + SZ_WTIN, OFF_WTGU = OFF_WTOUT + SZ_WTOUT, OFF_WTDN = OFF_WTGU + SZ_WTGU,
                 OFF_P = OFF_WTDN + SZ_WTDN, OFF_ACT = OFF_P + SZ_P, OFF_GQ = OFF_ACT + SZ_ACT, OFF_GK = OFF_GQ + SZ_T384,
                 OFF_GV = OFF_GK + SZ_T384, OFF_GDEC = OFF_GV + SZ_T384, OFF_GBETA = OFF_GDEC + SZ_T8F, OFF_HQ = OFF_GBETA + SZ_T8F,
                 OFF_HK = OFF_HQ + SZ_T256, OFF_RR = OFF_HK + SZ_T256, OFF_RK = OFF_RR + SZ_T384, OFF_RV = OFF_RK + SZ_T384,
                 OFF_RKK = OFF_RV + SZ_T384, OFF_RB = OFF_RKK + SZ_T384, OFF_RG = OFF_RB + SZ_T384, OFF_RW = OFF_RG + SZ_T384,
                 OFF_VF = OFF_RW + SZ_T384F, OFF_LORA = OFF_VF + SZ_T384, OFF_BAR = OFF_LORA + 245760, OFF_CUTAB = OFF_BAR + 16384, OFF_QUEUE = OFF_CUTAB + 16384, BAR_BYTES = 16384 + 16384 + 4096, WS_NEED = OFF_BAR + BAR_BYTES;
constexpr int W2T = 0, A2T = 24576, G2T = 49152, V1T = 98304, V2T = 110592;

struct Params {
  const float* in[N_IN];
  float* out;
  unsigned char* ws;
};

#define WSP(T, off) ((T*)(P.ws + (off)))

__device__ __forceinline__ int otid() { int t = __builtin_amdgcn_workitem_id_x(); asm volatile("" : "+v"(t)); return t; }
__device__ __forceinline__ int obid() { int b = __builtin_amdgcn_workgroup_id_x(); asm volatile("" : "+s"(b)); return b; }
__device__ __forceinline__ float bf2f(bf16_t h) { return __uint_as_float(((unsigned)h) << 16); }
typedef float f32x2_t __attribute__((ext_vector_type(2)));
typedef __bf16 bf16x2_t __attribute__((ext_vector_type(2)));
__device__ __forceinline__ unsigned pk2(float lo, float hi) {
  const f32x2_t v = {lo, hi};
  return __builtin_bit_cast(unsigned, __builtin_convertvector(v, bf16x2_t));
}
__device__ __forceinline__ bf16_t f2bf(float f) { return (bf16_t)(pk2(f, 0.f) & 0xffffu); }
__device__ __forceinline__ float sigm(float x) { return 1.f / (1.f + __expf(-x)); }
__device__ __forceinline__ float silu(float x) { return x / (1.f + __expf(-x)); }
__device__ __forceinline__ float softplus(float x) { return x > 20.f ? x : log1pf(__expf(x)); }
template <int CTRL> __device__ __forceinline__ float dppf(float x) {
  return __builtin_bit_cast(float, __builtin_amdgcn_mov_dpp(__builtin_bit_cast(int, x), CTRL, 0xf, 0xf, true));
}
__device__ __forceinline__ float wave_sum(float v) {
  v += dppf<0xB1>(v); v += dppf<0x4E>(v); v += dppf<0x141>(v); v += dppf<0x140>(v);
  const int iv = __builtin_bit_cast(int, v);
  const float s0 = __builtin_bit_cast(float, __builtin_amdgcn_readlane(iv, 0)), s1 = __builtin_bit_cast(float, __builtin_amdgcn_readlane(iv, 16));
  const float s2 = __builtin_bit_cast(float, __builtin_amdgcn_readlane(iv, 32)), s3 = __builtin_bit_cast(float, __builtin_amdgcn_readlane(iv, 48));
  return (s0 + s1) + (s2 + s3);
}
__device__ __forceinline__ float reduce8(float x) { x += dppf<0xB1>(x); x += dppf<0x4E>(x); x += dppf<0x141>(x); return x; }

__device__ __forceinline__ f32x4 unpack4(u32x2 w) {
  f32x4 f; f[0] = __uint_as_float(w[0] << 16); f[1] = __uint_as_float(w[0] & 0xffff0000u);
  f[2] = __uint_as_float(w[1] << 16); f[3] = __uint_as_float(w[1] & 0xffff0000u); return f;
}
__device__ __forceinline__ bf16x8 pack8(f32x4 a, f32x4 b) {
  u32x4 u; u[0] = pk2(a[0], a[1]); u[1] = pk2(a[2], a[3]); u[2] = pk2(b[0], b[1]); u[3] = pk2(b[2], b[3]);
  return __builtin_bit_cast(bf16x8, u);
}
__device__ __forceinline__ u32x2 pack4(f32x4 a) { u32x2 u; u[0] = pk2(a[0], a[1]); u[1] = pk2(a[2], a[3]); return u; }
__device__ __forceinline__ const float* xin_row(const Params& P, int l, int row) {
  if (l > 0) return P.out + (size_t)row * D;
  return row < NTP ? P.in[I_XP] + (size_t)row * D : P.in[I_XS] + (size_t)(row - NTP) * D;
}

__device__ __forceinline__ int gu_row(int c, int up) { return (c >> 6) * 128 + ((c >> 5) & 1) * 64 + up * 32 + (c & 31); }
__device__ void xpose_tile(unsigned char* smem, const float* __restrict__ W, int N, int kt, int ntl, bf16_t* __restrict__ dst, int dstK, int mode) {
  float (*tile)[65] = (float (*)[65])smem;
  const int tid = otid();
  __syncthreads();
#pragma unroll 4
  for (int i = 0; i < 16; ++i) {
    const int k = i * 4 + (tid >> 6), n = tid & 63, gn = ntl * 64 + n;
    tile[k][n] = gn < N ? W[(size_t)(kt * 64 + k) * N + gn] : 0.f;
  }
  __syncthreads();
#pragma unroll 4
  for (int i = 0; i < 16; ++i) {
    const int n = i * 4 + (tid >> 6), k = tid & 63, gn = ntl * 64 + n;
    const int drow = mode == 0 ? gn : gu_row(gn, mode - 1);
    dst[(size_t)drow * dstK + kt * 64 + k] = f2bf(tile[k][n]);
  }
}
__device__ void wconv_phase(const Params& P, unsigned char* smem, int l) {
  for (int job = obid(); job < 3392; job += gridDim.x) {
    if (job < 1024) xpose_tile(smem, P.in[I_WIN] + (size_t)l * 1024 * IN_COLS, IN_COLS, job & 15, job >> 4, WSP(bf16_t, OFF_WTIN), 1024, 0);
    else if (job < 1280) { const int j = job - 1024; xpose_tile(smem, P.in[I_WOUT] + (size_t)l * 1024 * 1024, 1024, j & 15, j >> 4, WSP(bf16_t, OFF_WTOUT), 1024, 0); }
    else if (job < 1984) { const int j = job - 1280; xpose_tile(smem, P.in[I_WG] + (size_t)l * 1024 * DFF, DFF, j & 15, j >> 4, WSP(bf16_t, OFF_WTGU), 1024, 1); }
    else if (job < 2688) { const int j = job - 1984; xpose_tile(smem, P.in[I_WU] + (size_t)l * 1024 * DFF, DFF, j & 15, j >> 4, WSP(bf16_t, OFF_WTGU), 1024, 2); }
    else { const int j = job - 2688; xpose_tile(smem, P.in[I_WD] + (size_t)l * DFF * 1024, 1024, j % 44, j / 44, WSP(bf16_t, OFF_WTDN), DFF, 0); }
  }
  bf16_t* lw = WSP(bf16_t, OFF_LORA);
  for (int idx = obid() * 256 + otid(); idx < 122880; idx += gridDim.x * 256) {
    float v = 0.f;
    if (idx < A2T) { const int n = idx >> 6, k = idx & 63; v = P.in[I_W2][(size_t)l * 64 * 384 + k * 384 + n]; }
    else if (idx < G2T) { const int i = idx - A2T, n = i >> 6, k = i & 63; v = P.in[I_A2][(size_t)l * 64 * 384 + k * 384 + n]; }
    else if (idx < V1T) { const int i = idx - G2T, n = i >> 7, k = i & 127; v = P.in[I_G2][(size_t)l * 128 * 384 + k * 384 + n]; }
    else if (idx < V2T) { if (l > 0) { const int i = idx - V1T, n = i / 384, k = i - n * 384; v = P.in[I_V1][(size_t)(l - 1) * 384 * 32 + k * 32 + n]; } }
    else { if (l > 0) { const int i = idx - V2T, n = i >> 5, k = i & 31; v = P.in[I_V2][(size_t)(l - 1) * 32 * 384 + k * 384 + n]; } }
    lw[idx] = f2bf(v);
  }
}

__device__ void norm_phase(const Params& P, int l_in, const float* __restrict__ w) {
  bf16_t* act = WSP(bf16_t, OFF_ACT);
  const int lane = otid() & 63, wid = otid() >> 6;
  for (int row = obid() * 4 + wid; row < NTOK; row += gridDim.x * 4) {
    const float* xr = xin_row(P, l_in, row);
    f32x4 v[4]; float ss = 0.f;
#pragma unroll
    for (int i = 0; i < 4; ++i) { v[i] = *(const f32x4*)(xr + i * 256 + lane * 4); ss += v[i][0] * v[i][0] + v[i][1] * v[i][1] + v[i][2] * v[i][2] + v[i][3] * v[i][3]; }
    ss = wave_sum(ss);
    const float rstd = rsqrtf(ss * (1.f / 1024.f) + 1e-6f);
#pragma unroll
    for (int i = 0; i < 4; ++i) {
      const f32x4 wv = *(const f32x4*)(w + i * 256 + lane * 4);
      u32x2 o; o[0] = pk2(v[i][0] * rstd * wv[0], v[i][1] * rstd * wv[1]); o[1] = pk2(v[i][2] * rstd * wv[2], v[i][3] * rstd * wv[3]);
      *(u32x2*)(act + (size_t)row * 1024 + i * 256 + lane * 4) = o;
    }
  }
}
__device__ void final_norm_phase(const Params& P) {
  const float* w = P.in[I_NORM_FINAL];
  const int lane = otid() & 63, wid = otid() >> 6;
  for (int row = obid() * 4 + wid; row < NTOK; row += gridDim.x * 4) {
    float* xr = P.out + (size_t)row * D;
    f32x4 v[4]; float ss = 0.f;
#pragma unroll
    for (int i = 0; i < 4; ++i) { v[i] = *(const f32x4*)(xr + i * 256 + lane * 4); ss += v[i][0] * v[i][0] + v[i][1] * v[i][1] + v[i][2] * v[i][2] + v[i][3] * v[i][3]; }
    ss = wave_sum(ss);
    const float rstd = rsqrtf(ss * (1.f / 1024.f) + 1e-6f);
#pragma unroll
    for (int i = 0; i < 4; ++i) {
      const f32x4 wv = *(const f32x4*)(w + i * 256 + lane * 4);
      f32x4 o; o[0] = v[i][0] * rstd * wv[0]; o[1] = v[i][1] * rstd * wv[1]; o[2] = v[i][2] * rstd * wv[2]; o[3] = v[i][3] * rstd * wv[3];
      *(f32x4*)(xr + i * 256 + lane * 4) = o;
    }
  }
}

enum { EPI_P = 0, EPI_RES = 1, EPI_SWIGLU = 2 };
template <int EPI>
__device__ void gemm_phase(const Params& P, unsigned char* smem, const bf16_t* __restrict__ A, int lda, const bf16_t* __restrict__ Bt, int K, int nN, int l) {
  const int tid = otid(), lane = tid & 63, wid = tid >> 6, wr = wid >> 1, wc = wid & 1, fr = lane & 15, fq = lane >> 4;
  const int ntiles = 128 * nN, nk = K >> 6;
  const int r0s = tid >> 3, cs = tid & 7;
  const int swz = (fr >> 1) & 7;
  for (int tile = obid(); tile < ntiles; tile += gridDim.x) {
    const int mt = tile / nN, nt = tile - mt * nN;
    const bf16_t* Ag = A + (size_t)(mt * 128 + r0s) * lda + cs * 8;
    const bf16_t* Bg = Bt + (size_t)(nt * 128 + r0s) * K + cs * 8;
    f32x4 acc[4][4];
#pragma unroll
    for (int m = 0; m < 4; ++m)
#pragma unroll
      for (int n = 0; n < 4; ++n) acc[m][n] = (f32x4){0.f, 0.f, 0.f, 0.f};
    u32x4 ra[4], rb[4];
#pragma unroll
    for (int i = 0; i < 4; ++i) { ra[i] = *(const u32x4*)(Ag + (size_t)i * 32 * lda); rb[i] = *(const u32x4*)(Bg + (size_t)i * 32 * K); }
#pragma unroll
    for (int i = 0; i < 4; ++i) {
      const int row = r0s + i * 32; const int off = row * 128 + ((cs ^ ((row >> 1) & 7)) << 4);
      *(u32x4*)(smem + off) = ra[i]; *(u32x4*)(smem + 16384 + off) = rb[i];
    }
    __syncthreads();
    for (int kt = 0; kt < nk; ++kt) {
      const bool nxt = kt + 1 < nk;
      if (nxt) {
#pragma unroll
        for (int i = 0; i < 4; ++i) { ra[i] = *(const u32x4*)(Ag + (size_t)i * 32 * lda + (kt + 1) * 64); rb[i] = *(const u32x4*)(Bg + (size_t)i * 32 * K + (kt + 1) * 64); }
      }
      const unsigned char* sA = smem + (kt & 1) * 32768;
      const unsigned char* sB = sA + 16384;
#pragma unroll
      for (int kk = 0; kk < 2; ++kk) {
        bf16x8 af[4], bfg[4];
        const int coff = ((kk * 4 + fq) ^ swz) << 4;
#pragma unroll
        for (int m = 0; m < 4; ++m) af[m] = *(const bf16x8*)(sA + (wr * 64 + m * 16 + fr) * 128 + coff);
#pragma unroll
        for (int n = 0; n < 4; ++n) bfg[n] = *(const bf16x8*)(sB + (wc * 64 + n * 16 + fr) * 128 + coff);
#pragma unroll
        for (int m = 0; m < 4; ++m)
#pragma unroll
          for (int n = 0; n < 4; ++n) acc[m][n] = __builtin_amdgcn_mfma_f32_16x16x32_bf16(bfg[n], af[m], acc[m][n], 0, 0, 0);
      }
      if (nxt) {
        unsigned char* dA = smem + ((kt + 1) & 1) * 32768;
#pragma unroll
        for (int i = 0; i < 4; ++i) {
          const int row = r0s + i * 32; const int off = row * 128 + ((cs ^ ((row >> 1) & 7)) << 4);
          *(u32x4*)(dA + off) = ra[i]; *(u32x4*)(dA + 16384 + off) = rb[i];
        }
      }
      __syncthreads();
    }
#pragma unroll
    for (int m = 0; m < 4; ++m) {
      const int row = mt * 128 + wr * 64 + m * 16 + fr;
      if (EPI == EPI_P) {
        bf16_t* pr = WSP(bf16_t, OFF_P) + (size_t)row * PSTR;
#pragma unroll
        for (int n = 0; n < 4; ++n) {
          const int col = nt * 128 + wc * 64 + n * 16 + fq * 4;
          if (col < IN_COLS) { u32x2 o; o[0] = pk2(acc[m][n][0], acc[m][n][1]); o[1] = pk2(acc[m][n][2], acc[m][n][3]); *(u32x2*)(pr + col) = o; }
        }
      } else if (EPI == EPI_RES) {
        const float* xi = xin_row(P, l, row);
        float* xo = P.out + (size_t)row * D;
#pragma unroll
        for (int n = 0; n < 4; ++n) {
          const int col = nt * 128 + wc * 64 + n * 16 + fq * 4;
          const f32x4 xv = *(const f32x4*)(xi + col);
          *(f32x4*)(xo + col) = xv + acc[m][n];
        }
      } else {
        bf16_t* ur = WSP(bf16_t, OFF_P) + (size_t)row * DFF;
#pragma unroll
        for (int n = 0; n < 2; ++n) {
          const int col = nt * 64 + wc * 32 + n * 16 + fq * 4;
          float r[4];
#pragma unroll
          for (int j = 0; j < 4; ++j) r[j] = silu(acc[m][n][j]) * acc[m][n + 2][j];
          u32x2 o; o[0] = pk2(r[0], r[1]); o[1] = pk2(r[2], r[3]);
          *(u32x2*)(ur + col) = o;
        }
      }
    }
  }
}

template <int EPI>
__device__ void gemm_sample(const Params& P, const bf16_t* __restrict__ A, int lda, const bf16_t* __restrict__ Bt, int K, int nunits, int l) {
  const int tid = otid(), lane = tid & 63, wid = tid >> 6, fr = lane & 15, fq = lane >> 4;
  for (int u = (int)gridDim.x - 1 - obid(); u < nunits; u += gridDim.x) {
    const int brow0 = EPI == EPI_SWIGLU ? gu_row(u * 16 + fr, 0) : u * 16 + fr;
    const int brow1 = EPI == EPI_SWIGLU ? gu_row(u * 16 + fr, 1) : 0;
    const bf16_t* a0p = A + (size_t)(NTP + wid * 32 + fr) * lda + fq * 8;
    const bf16_t* a1p = a0p + (size_t)16 * lda;
    const bf16_t* b0p = Bt + (size_t)brow0 * K + fq * 8;
    const bf16_t* b1p = Bt + (size_t)brow1 * K + fq * 8;
    f32x4 c00 = (f32x4){0.f, 0.f, 0.f, 0.f}, c10 = c00, c01 = c00, c11 = c00;
#pragma unroll 8
    for (int ks = 0; ks < K; ks += 32) {
      const bf16x8 A0 = *(const bf16x8*)(a0p + ks), A1 = *(const bf16x8*)(a1p + ks), B0 = *(const bf16x8*)(b0p + ks);
      c00 = __builtin_amdgcn_mfma_f32_16x16x32_bf16(B0, A0, c00, 0, 0, 0);
      c10 = __builtin_amdgcn_mfma_f32_16x16x32_bf16(B0, A1, c10, 0, 0, 0);
      if (EPI == EPI_SWIGLU) {
        const bf16x8 B1 = *(const bf16x8*)(b1p + ks);
        c01 = __builtin_amdgcn_mfma_f32_16x16x32_bf16(B1, A0, c01, 0, 0, 0);
        c11 = __builtin_amdgcn_mfma_f32_16x16x32_bf16(B1, A1, c11, 0, 0, 0);
      }
    }
#pragma unroll
    for (int m = 0; m < 2; ++m) {
      const int row = NTP + wid * 32 + m * 16 + fr, col = u * 16 + fq * 4;
      const f32x4 g = m ? c10 : c00, up = m ? c11 : c01;
      if (EPI == EPI_P) {
        if (col < IN_COLS) *(u32x2*)(WSP(bf16_t, OFF_P) + (size_t)row * PSTR + col) = pack4(g);
      } else if (EPI == EPI_RES) {
        const float* xi = xin_row(P, l, row);
        *(f32x4*)(P.out + (size_t)row * D + col) = *(const f32x4*)(xi + col) + g;
      } else {
        f32x4 r;
#pragma unroll
        for (int j = 0; j < 4; ++j) r[j] = silu(g[j]) * up[j];
        *(u32x2*)(WSP(bf16_t, OFF_P) + (size_t)row * DFF + col) = pack4(r);
      }
    }
  }
}

__device__ __forceinline__ float lbval(const Params& P, int l, int c) {
  const float* hb = P.in[I_HLB];
  const float a0 = hb[c], a1 = hb[256 + c], a2 = hb[512 + c], a3 = hb[768 + c];
  const float m = fmaxf(fmaxf(a0, a1), fmaxf(a2, a3));
  const float e0 = __expf(a0 - m), e1 = __expf(a1 - m), e2 = __expf(a2 - m), e3 = __expf(a3 - m);
  const float inv = 1.f / (e0 + e1 + e2 + e3);
  float s = 0.f;
  if (l >= 1) s += e1; if (l >= 2) s += e2; if (l >= 3) s += e3;
  return s * inv;
}

__device__ __forceinline__ void gdn_conv_emit(const Params& P, int g, int lane, int row, float s) {
  const int h = g % 6;
  if (g < 12) {
    const float ss = wave_sum(s * s);
    const float o = s * rsqrtf(ss + 1e-6f) * (g < 6 ? 0.125f : 1.f);
    (g < 6 ? WSP(bf16_t, OFF_GQ) : WSP(bf16_t, OFF_GK))[(size_t)row * 384 + h * 64 + lane] = f2bf(o);
  } else {
    WSP(bf16_t, OFF_GV)[(size_t)row * 384 + h * 64 + lane] = f2bf(s);
  }
}
__device__ __forceinline__ void gdn_gate_emit(const Params& P, int l, int h, int row) {
  const bf16_t* pr = WSP(bf16_t, OFF_P) + (size_t)row * PSTR;
  const float braw = bf2f(pr[1536 + h]), araw = bf2f(pr[1542 + h]);
  const float gg = -__expf(P.in[I_ALOG][l * 6 + h]) * softplus(araw + P.in[I_DTB][l * 6 + h]);
  WSP(float, OFF_GDEC)[(size_t)row * 8 + h] = __expf(gg);
  WSP(float, OFF_GBETA)[(size_t)row * 8 + h] = sigm(braw);
}
__device__ void prep_gdn_prompt(const Params& P, int l, int ci) {
  const int lane = otid() & 63, wid = otid() >> 6;
  const int r0 = ci * 32, b = r0 / TSEQ, t0 = r0 % TSEQ;
  const bf16_t* p = WSP(bf16_t, OFF_P);
  for (int g = wid; g < 18; g += 4) {
    const int col = g * 64 + lane;
    const float* cw = P.in[I_CONVW] + (size_t)l * 4 * 1152 + col;
    const float c0 = cw[0], c1 = cw[1152], c2 = cw[2304], c3 = cw[3456];
    float xr[35];
#pragma unroll
    for (int t = 0; t < 35; ++t) xr[t] = (t >= 3 || t0 > 0) ? bf2f(p[(size_t)(r0 - 3 + t) * PSTR + col]) : 0.f;
#pragma unroll
    for (int t = 0; t < 32; ++t) {
      const float y = c0 * xr[t] + c1 * xr[t + 1] + c2 * xr[t + 2] + c3 * xr[t + 3];
      gdn_conv_emit(P, g, lane, r0 + t, silu(y));
    }
    if (t0 + 32 == TSEQ) {
      float* cp = P.out + O_CONV_P + (size_t)(l * 8 + b) * 3 * 1152 + col;
      cp[0] = xr[32]; cp[1152] = xr[33]; cp[2304] = xr[34];
    }
    if (g < 6 && lane < 32) gdn_gate_emit(P, l, g, r0 + lane);
  }
}
__device__ void prep_gdn_sample(const Params& P, int l, int si) {
  const int lane = otid() & 63, wid = otid() >> 6;
  const bf16_t* p = WSP(bf16_t, OFF_P);
  for (int u = wid; u < 8 * 18; u += 4) {
    const int s = si * 8 + u / 18, g = u % 18, col = g * 64 + lane, row = NTP + s;
    const float* cw = P.in[I_CONVW] + (size_t)l * 4 * 1152 + col;
    const float c0 = cw[0], c1 = cw[1152], c2 = cw[2304], c3 = cw[3456];
    const float* cb = P.in[I_SCONV] + (size_t)(l * 128 + s) * 3 * 1152 + col;
    const float x3 = cb[0], x2 = cb[1152], x1 = cb[2304];
    const float x0 = bf2f(p[(size_t)row * PSTR + col]);
    const float y = c0 * x3 + c1 * x2 + c2 * x1 + c3 * x0;
    gdn_conv_emit(P, g, lane, row, silu(y));
    float* cp = P.out + O_CONV_S + (size_t)(l * 128 + s) * 3 * 1152 + col;
    cp[0] = x2; cp[1152] = x1; cp[2304] = x0;
    if (g < 6 && lane == 0) gdn_gate_emit(P, l, g, row);
  }
}
__device__ void prep_hgrn(const Params& P, int l, int ti) {
  const int c = otid();
  const float oml = 1.f - lbval(P, l, c);
  const bf16_t* p = WSP(bf16_t, OFF_P);
  bf16_t* hq = WSP(bf16_t, OFF_HQ); bf16_t* hk = WSP(bf16_t, OFF_HK);
  for (int t = 0; t < 64; ++t) {
    const int row = ti * 64 + t;
    const float q = bf2f(p[(size_t)row * PSTR + PC + c]), f = bf2f(p[(size_t)row * PSTR + PC + 256 + c]);
    hq[(size_t)row * 256 + c] = f2bf(silu(q) * 0.125f);
    hk[(size_t)row * 256 + c] = f2bf(oml * sigm(-f));
  }
}
__device__ __forceinline__ f32x4 xs4(const Params& P, int l, int row, int col0) {
  const bf16_t* p = WSP(bf16_t, OFF_P);
  const f32x4 pv = unpack4(*(const u32x2*)(p + (size_t)row * PSTR + PB + col0));
  f32x4 prev = (f32x4){0.f, 0.f, 0.f, 0.f};
  if (row >= NTP) prev = *(const f32x4*)(P.in[I_SSHIFT] + (size_t)(l * 128 + (row - NTP)) * 1408 + col0);
  else if ((row & (TSEQ - 1)) != 0) prev = unpack4(*(const u32x2*)(p + (size_t)(row - 1) * PSTR + PB + col0));
  const f32x4 mu = *(const f32x4*)(P.in[I_MU] + l * 1408 + col0);
  return pv + (prev - pv) * mu;
}
__device__ __forceinline__ float tanh_fast(float x) { return 1.f - 2.f / (__expf(2.f * x) + 1.f); }

__device__ void prep_rwkv_unit(const Params& P, int l, int mt, int hh) {
  const int lane = otid() & 63, fr = lane & 15, fq = lane >> 4;
  const int row = mt * 16 + fr, cb = hh * 192;
  const bf16_t* lw = WSP(bf16_t, OFF_LORA);
  const size_t ro = (size_t)row * 384;
  f32x4 acc[12];
#pragma unroll
  for (int nf = 0; nf < 12; ++nf) acc[nf] = (f32x4){0.f, 0.f, 0.f, 0.f};
#pragma unroll
  for (int ks = 0; ks < 2; ++ks) {
    f32x4 x0 = xs4(P, l, row, 1152 + ks * 32 + fq * 8), x1 = xs4(P, l, row, 1152 + ks * 32 + fq * 8 + 4);
#pragma unroll
    for (int j = 0; j < 4; ++j) { x0[j] = tanh_fast(x0[j]); x1[j] = tanh_fast(x1[j]); }
    const bf16x8 A = pack8(x0, x1);
#pragma unroll
    for (int nf = 0; nf < 12; ++nf) {
      const bf16x8 B = *(const bf16x8*)(lw + W2T + (cb + nf * 16 + fr) * 64 + ks * 32 + fq * 8);
      acc[nf] = __builtin_amdgcn_mfma_f32_16x16x32_bf16(B, A, acc[nf], 0, 0, 0);
    }
  }
#pragma unroll
  for (int nf = 0; nf < 12; ++nf) {
    const int c = cb + nf * 16 + fq * 4;
    const f32x4 w0 = *(const f32x4*)(P.in[I_W0] + l * 384 + c);
    f32x4 d;
#pragma unroll
    for (int j = 0; j < 4; ++j) {
      const float x = -(w0[j] + acc[nf][j]);
      const float sp = x > 15.f ? x : __logf(1.f + __expf(x));
      d[j] = __expf(-__expf(-sp - 0.5f));
    }
    *(f32x4*)(WSP(float, OFF_RW) + ro + c) = d;
  }
#pragma unroll
  for (int nf = 0; nf < 12; ++nf) acc[nf] = (f32x4){0.f, 0.f, 0.f, 0.f};
#pragma unroll
  for (int ks = 0; ks < 2; ++ks) {
    const bf16x8 A = pack8(xs4(P, l, row, 1216 + ks * 32 + fq * 8), xs4(P, l, row, 1216 + ks * 32 + fq * 8 + 4));
#pragma unroll
    for (int nf = 0; nf < 12; ++nf) {
      const bf16x8 B = *(const bf16x8*)(lw + A2T + (cb + nf * 16 + fr) * 64 + ks * 32 + fq * 8);
      acc[nf] = __builtin_amdgcn_mfma_f32_16x16x32_bf16(B, A, acc[nf], 0, 0, 0);
    }
  }
#pragma unroll
  for (int hl = 0; hl < 3; ++hl) {
    f32x4 kr[4], kkr[4];
    float ss = 0.f;
#pragma unroll
    for (int q = 0; q < 4; ++q) {
      const int c = cb + (hl * 4 + q) * 16 + fq * 4;
      kr[q] = xs4(P, l, row, 384 + c);
      kkr[q] = kr[q] * *(const f32x4*)(P.in[I_KK] + l * 384 + c);
      ss += kkr[q][0] * kkr[q][0] + kkr[q][1] * kkr[q][1] + kkr[q][2] * kkr[q][2] + kkr[q][3] * kkr[q][3];
    }
    ss += __shfl_xor(ss, 16); ss += __shfl_xor(ss, 32);
    const float rn = rsqrtf(ss + 1e-6f);
#pragma unroll
    for (int q = 0; q < 4; ++q) {
      const int nf = hl * 4 + q, c = cb + nf * 16 + fq * 4;
      const f32x4 a0 = *(const f32x4*)(P.in[I_A0] + l * 384 + c), ka = *(const f32x4*)(P.in[I_KA] + l * 384 + c);
      f32x4 kn, kk, kb;
#pragma unroll
      for (int j = 0; j < 4; ++j) {
        const float a = sigm(a0[j] + acc[nf][j]);
        kk[j] = kkr[q][j] * rn; kb[j] = kk[j] * a; kn[j] = kr[q][j] * (1.f + (a - 1.f) * ka[j]);
      }
      *(u32x2*)(WSP(bf16_t, OFF_RK) + ro + c) = pack4(kn);
      *(u32x2*)(WSP(bf16_t, OFF_RKK) + ro + c) = pack4(kk);
      *(u32x2*)(WSP(bf16_t, OFF_RB) + ro + c) = pack4(kb);
      *(u32x2*)(WSP(bf16_t, OFF_RR) + ro + c) = pack4(xs4(P, l, row, c));
    }
  }
#pragma unroll
  for (int nf = 0; nf < 12; ++nf) acc[nf] = (f32x4){0.f, 0.f, 0.f, 0.f};
#pragma unroll
  for (int ks = 0; ks < 4; ++ks) {
    f32x4 x0 = xs4(P, l, row, 1280 + ks * 32 + fq * 8), x1 = xs4(P, l, row, 1280 + ks * 32 + fq * 8 + 4);
#pragma unroll
    for (int j = 0; j < 4; ++j) { x0[j] = sigm(x0[j]); x1[j] = sigm(x1[j]); }
    const bf16x8 A = pack8(x0, x1);
#pragma unroll
    for (int nf = 0; nf < 12; ++nf) {
      const bf16x8 B = *(const bf16x8*)(lw + G2T + (cb + nf * 16 + fr) * 128 + ks * 32 + fq * 8);
      acc[nf] = __builtin_amdgcn_mfma_f32_16x16x32_bf16(B, A, acc[nf], 0, 0, 0);
    }
  }
#pragma unroll
  for (int nf = 0; nf < 12; ++nf) *(u32x2*)(WSP(bf16_t, OFF_RG) + ro + cb + nf * 16 + fq * 4) = pack4(acc[nf]);
  if (l == 0) {
#pragma unroll
    for (int nf = 0; nf < 12; ++nf) {
      const int c = cb + nf * 16 + fq * 4;
      const u32x2 o = pack4(xs4(P, l, row, 768 + c));
      *(u32x2*)(WSP(bf16_t, OFF_RV) + ro + c) = o;
      *(u32x2*)(WSP(bf16_t, OFF_VF) + ro + c) = o;
    }
  } else {
    f32x4 lo0 = (f32x4){0.f, 0.f, 0.f, 0.f}, lo1 = lo0;
#pragma unroll 4
    for (int ks = 0; ks < 12; ++ks) {
      const bf16x8 A = pack8(xs4(P, l, row, 768 + ks * 32 + fq * 8), xs4(P, l, row, 768 + ks * 32 + fq * 8 + 4));
      const bf16x8 B0 = *(const bf16x8*)(lw + V1T + fr * 384 + ks * 32 + fq * 8);
      const bf16x8 B1 = *(const bf16x8*)(lw + V1T + (16 + fr) * 384 + ks * 32 + fq * 8);
      lo0 = __builtin_amdgcn_mfma_f32_16x16x32_bf16(B0, A, lo0, 0, 0, 0);
      lo1 = __builtin_amdgcn_mfma_f32_16x16x32_bf16(B1, A, lo1, 0, 0, 0);
    }
    const bf16x8 A2 = pack8(lo0, lo1);
#pragma unroll
    for (int nf = 0; nf < 12; ++nf) {
      const int c = cb + nf * 16 + fq * 4;
      const bf16_t* vr = lw + V2T + (cb + nf * 16 + fr) * 32;
      u32x4 bw; { const u32x2 b0 = *(const u32x2*)(vr + fq * 4), b1 = *(const u32x2*)(vr + 16 + fq * 4); bw[0] = b0[0]; bw[1] = b0[1]; bw[2] = b1[0]; bw[3] = b1[1]; }
      const f32x4 mv = __builtin_amdgcn_mfma_f32_16x16x32_bf16(__builtin_bit_cast(bf16x8, bw), A2, (f32x4){0.f, 0.f, 0.f, 0.f}, 0, 0, 0);
      const f32x4 v0 = *(const f32x4*)(P.in[I_V0] + (l - 1) * 384 + c);
      const f32x4 v = xs4(P, l, row, 768 + c), vf = unpack4(*(const u32x2*)(WSP(bf16_t, OFF_VF) + ro + c));
      f32x4 o;
#pragma unroll
      for (int j = 0; j < 4; ++j) o[j] = v[j] + (vf[j] - v[j]) * sigm(v0[j] + mv[j]);
      *(u32x2*)(WSP(bf16_t, OFF_RV) + ro + c) = pack4(o);
    }
  }
}
__device__ void prep_phase(const Params& P, unsigned char* smem, int l) {
  for (int it = obid(); it < 1302; it += gridDim.x) {
    if (it < 516) { const int wid = otid() >> 6; prep_rwkv_unit(P, l, it * 2 + (wid >> 1), wid & 1); }
    else if (it < 1028) prep_gdn_prompt(P, l, it - 516);
    else if (it < 1044) prep_gdn_sample(P, l, it - 1028);
    else prep_hgrn(P, l, it - 1044);
  }
  const bf16_t* p = WSP(bf16_t, OFF_P);
  for (int idx = obid() * 256 + otid(); idx < 136 * 1408; idx += gridDim.x * 256) {
    const int q = idx / 1408, col = idx - q * 1408;
    if (q < 8) P.out[O_SHIFT_P + (size_t)(l * 8 + q) * 1408 + col] = bf2f(p[(size_t)(q * TSEQ + TSEQ - 1) * PSTR + PB + col]);
    else P.out[O_SHIFT_S + (size_t)(l * 128 + (q - 8)) * 1408 + col] = bf2f(p[(size_t)(NTP + q - 8) * PSTR + PB + col]);
  }
}

template <int KIND> struct ScanCfg { static constexpr int STRIDE = KIND == 1 ? 356 : 164; };
typedef float f32x2 __attribute__((ext_vector_type(2)));
__device__ __forceinline__ float row_sum16(float v) { v += dppf<0xB1>(v); v += dppf<0x4E>(v); v += dppf<0x141>(v); v += dppf<0x140>(v); return v; }
__device__ __forceinline__ float dot4(f32x4 a, f32x4 b) { return (a[0] * b[0] + a[1] * b[1]) + (a[2] * b[2] + a[3] * b[3]); }

template <int KIND> struct ScanPre { u32x2 a, b, c, d, v; f32x4 w; float g; };

template <int KIND>
__device__ __forceinline__ void scan_load(const Params& P, ScanPre<KIND>& r, int h, int half, int rowbase, int nvalid) {
  const int tid = otid();
  const int s = tid >> 4, j4 = (tid & 15) * 4;
  const int s2 = (tid >> 3) & 15, j2 = (tid & 7) * 4;
  const u32x2 z2 = {0u, 0u};
  const bool ok = s < nvalid, ok2 = (tid < 128) && (s2 < nvalid);
  if (KIND == 0) {
    const size_t o = (size_t)(rowbase + s) * 384 + h * 64 + j4;
    r.a = ok ? *(const u32x2*)(WSP(bf16_t, OFF_GK) + o) : z2;
    r.b = ok ? *(const u32x2*)(WSP(bf16_t, OFF_GQ) + o) : z2;
    r.v = ok2 ? *(const u32x2*)(WSP(bf16_t, OFF_GV) + (size_t)(rowbase + s2) * 384 + h * 64 + half * 32 + j2) : z2;
    const int sg = (tid >> 1) & 15;
    r.g = (tid < 32 && sg < nvalid) ? ((tid & 1) ? WSP(float, OFF_GBETA) : WSP(float, OFF_GDEC))[(size_t)(rowbase + sg) * 8 + h] : 0.f;
  } else if (KIND == 1) {
    const size_t o = (size_t)(rowbase + s) * 384 + h * 64 + j4;
    r.a = ok ? *(const u32x2*)(WSP(bf16_t, OFF_RR) + o) : z2;
    r.w = ok ? *(const f32x4*)(WSP(float, OFF_RW) + o) : (f32x4){0.f, 0.f, 0.f, 0.f};
    r.b = ok ? *(const u32x2*)(WSP(bf16_t, OFF_RK) + o) : z2;
    r.c = ok ? *(const u32x2*)(WSP(bf16_t, OFF_RKK) + o) : z2;
    r.d = ok ? *(const u32x2*)(WSP(bf16_t, OFF_RB) + o) : z2;
    r.v = ok2 ? *(const u32x2*)(WSP(bf16_t, OFF_RV) + (size_t)(rowbase + s2) * 384 + h * 64 + half * 32 + j2) : z2;
  } else {
    const size_t o = (size_t)(rowbase + s) * 256 + h * 64 + j4;
    r.a = ok ? *(const u32x2*)(WSP(bf16_t, OFF_HQ) + o) : z2;
    r.b = ok ? *(const u32x2*)(WSP(bf16_t, OFF_HK) + o) : z2;
    r.v = ok2 ? *(const u32x2*)(WSP(bf16_t, OFF_P) + (size_t)(rowbase + s2) * PSTR + PC + 512 + h * 64 + half * 32 + j2) : z2;
  }
}
template <int KIND>
__device__ __forceinline__ void scan_store(const ScanPre<KIND>& r, float* buf) {
  constexpr int STRIDE = ScanCfg<KIND>::STRIDE;
  const int tid = otid();
  const int s = tid >> 4, j4 = (tid & 15) * 4;
  const int s2 = (tid >> 3) & 15, j2 = (tid & 7) * 4;
  float* bs = buf + s * STRIDE + j4;
  if (KIND == 0) {
    const f32x4 k = unpack4(r.a), q = unpack4(r.b);
    *(f32x4*)(bs) = k; *(f32x4*)(bs + 64) = q;
    const float qk = row_sum16(dot4(q, k));
    if ((tid & 15) == 0) buf[s * STRIDE + 162] = qk;
    if (tid < 128) *(f32x4*)(buf + s2 * STRIDE + 128 + j2) = unpack4(r.v);
    if (tid < 32) buf[((tid >> 1) & 15) * STRIDE + 160 + (tid & 1)] = r.g;
  } else if (KIND == 1) {
    const f32x4 rr = unpack4(r.a), k = unpack4(r.b), kk = unpack4(r.c), bb = unpack4(r.d);
    *(f32x4*)(bs) = r.w * rr; *(f32x4*)(bs + 64) = r.w; *(f32x4*)(bs + 128) = k;
    *(f32x4*)(bs + 192) = kk; *(f32x4*)(bs + 256) = bb;
    const float br = row_sum16(dot4(bb, rr)), kr = row_sum16(dot4(k, rr));
    if ((tid & 15) == 0) { buf[s * STRIDE + 352] = br; buf[s * STRIDE + 353] = kr; }
    if (tid < 128) *(f32x4*)(buf + s2 * STRIDE + 320 + j2) = unpack4(r.v);
  } else {
    const f32x4 q = unpack4(r.a), k = unpack4(r.b);
    *(f32x4*)(bs) = q * (1.f - k); *(f32x4*)(bs + 64) = k;
    const float qk = row_sum16(dot4(q, k));
    if ((tid & 15) == 0) buf[s * STRIDE + 160] = qk;
    if (tid < 128) *(f32x4*)(buf + s2 * STRIDE + 128 + j2) = unpack4(r.v);
  }
}

template <int KIND> struct StepOps { f32x2 a[4], b[4], c[4], d[4], e[4]; float v, s0, s1, s2; };
template <int KIND>
__device__ __forceinline__ void step_load(StepOps<KIND>& o, const float* bs, int e0, int cl) {
#define LD8(dst, off) { const f32x4 _x = *(const f32x4*)(bs + (off) + e0), _y = *(const f32x4*)(bs + (off) + e0 + 4); \
    dst[0] = (f32x2){_x[0], _x[1]}; dst[1] = (f32x2){_x[2], _x[3]}; dst[2] = (f32x2){_y[0], _y[1]}; dst[3] = (f32x2){_y[2], _y[3]}; }
  if (KIND == 0) {
    LD8(o.a, 0) LD8(o.b, 64)
    o.v = bs[128 + cl];
    const f32x4 sc = *(const f32x4*)(bs + 160); o.s0 = sc[0]; o.s1 = sc[1]; o.s2 = sc[2];
  } else if (KIND == 1) {
    LD8(o.a, 0) LD8(o.b, 64) LD8(o.c, 128) LD8(o.d, 192) LD8(o.e, 256)
    o.v = bs[320 + cl];
    const f32x2 sc = *(const f32x2*)(bs + 352); o.s0 = sc[0]; o.s1 = sc[1];
  } else {
    LD8(o.a, 0) LD8(o.b, 64)
    o.v = bs[128 + cl]; o.s0 = bs[160];
  }
#undef LD8
}
template <int KIND>
__device__ __forceinline__ float step_compute(const StepOps<KIND>& o, f32x2 (&S)[4]) {
  if (KIND == 0) {
    f32x2 ks2 = o.a[0] * S[0], qs2 = o.b[0] * S[0];
#pragma unroll
    for (int i = 1; i < 4; ++i) { ks2 += o.a[i] * S[i]; qs2 += o.b[i] * S[i]; }
    float ks = ks2[0] + ks2[1], qs = qs2[0] + qs2[1];
    ks += dppf<0xB1>(ks); qs += dppf<0xB1>(qs); ks += dppf<0x4E>(ks); qs += dppf<0x4E>(qs); ks += dppf<0x141>(ks); qs += dppf<0x141>(qs);
    const float dec = o.s0, vn = o.s1 * (o.v - dec * ks);
#pragma unroll
    for (int i = 0; i < 4; ++i) S[i] = S[i] * dec + o.a[i] * vn;
    return dec * qs + vn * o.s2;
  } else if (KIND == 1) {
    f32x2 sa2 = o.d[0] * S[0], p2 = o.a[0] * S[0];
#pragma unroll
    for (int i = 1; i < 4; ++i) { sa2 += o.d[i] * S[i]; p2 += o.a[i] * S[i]; }
    float sa = sa2[0] + sa2[1], p1 = p2[0] + p2[1];
    sa += dppf<0xB1>(sa); p1 += dppf<0xB1>(p1); sa += dppf<0x4E>(sa); p1 += dppf<0x4E>(p1); sa += dppf<0x141>(sa); p1 += dppf<0x141>(p1);
    sa = -sa;
#pragma unroll
    for (int i = 0; i < 4; ++i) S[i] = S[i] * o.b[i] + (o.e[i] * sa + o.c[i] * o.v);
    return p1 + sa * o.s0 + o.v * o.s1;
  } else {
    f32x2 p2 = o.a[0] * S[0];
#pragma unroll
    for (int i = 1; i < 4; ++i) p2 += o.a[i] * S[i];
    float p1 = p2[0] + p2[1];
    p1 += dppf<0xB1>(p1); p1 += dppf<0x4E>(p1); p1 += dppf<0x141>(p1);
#pragma unroll
    for (int i = 0; i < 4; ++i) S[i] = S[i] + o.b[i] * (o.v - S[i]);
    return p1 + o.v * o.s0;
  }
}

template <int KIND>
__device__ void scan_task(const Params& P, unsigned char* smem, int l, int seq, int h, int half) {
  constexpr int STRIDE = ScanCfg<KIND>::STRIDE, NEL = 16 * STRIDE;
  constexpr int NH = KIND == 2 ? 4 : 6;
  float* buf = (float*)smem;
  float* obuf = buf + 2 * NEL;
  const int tid = otid(), lane = tid & 63, wid = tid >> 6;
  const int col_l = lane >> 3, sub = lane & 7, cl = wid * 8 + col_l, col = half * 32 + cl, e0 = sub * 8;
  const bool sample = seq >= 8;
  const int R0 = sample ? NTP + (seq - 8) : seq * TSEQ, T = sample ? 1 : TSEQ;
  const int ocol = (KIND == 0 ? 0 : (KIND == 1 ? 384 : 768)) + h * 64 + half * 32;
  const size_t O_P = KIND == 0 ? O_GDN_P : (KIND == 1 ? O_RWKV_P : O_HGRN_P);
  const size_t O_S = KIND == 0 ? O_GDN_S : (KIND == 1 ? O_RWKV_S : O_HGRN_S);
  const int I_ST = KIND == 0 ? I_SGDN : (KIND == 1 ? I_SRWKV : I_SHGRN);
  f32x2 S[4];
  if (sample) {
    const float* st = P.in[I_ST] + ((size_t)(l * 128 + (seq - 8)) * NH + h) * 4096;
#pragma unroll
    for (int i = 0; i < 8; ++i) S[i >> 1][i & 1] = KIND == 1 ? st[col * 64 + e0 + i] : st[(e0 + i) * 64 + col];
  } else {
#pragma unroll
    for (int i = 0; i < 4; ++i) S[i] = (f32x2){0.f, 0.f};
  }
  ScanPre<KIND> pre;
  __syncthreads();
  scan_load<KIND>(P, pre, h, half, R0, T);
  scan_store<KIND>(pre, buf);
  __syncthreads();
  const int nchunks = (T + 15) >> 4;
  bf16_t* oraw = WSP(bf16_t, OFF_P);
  for (int c = 0; c < nchunks; ++c) {
    const int t0 = c * 16, n = (T - t0) < 16 ? (T - t0) : 16;
    const bool has_next = c + 1 < nchunks;
    if (has_next) scan_load<KIND>(P, pre, h, half, R0 + t0 + 16, T - t0 - 16);
    if (c > 0) {
      const float* pob = obuf + ((c - 1) & 1) * 512;
#pragma unroll
      for (int i = 0; i < 2; ++i) {
        const int idx = tid + i * 256, s = idx >> 5, cc = idx & 31;
        oraw[(size_t)(R0 + t0 - 16 + s) * PSTR + ocol + cc] = f2bf(pob[idx]);
      }
    }
    const float* b = buf + (c & 1) * NEL;
    float* ob = obuf + (c & 1) * 512;
    if (n == 16) {
      StepOps<KIND> A, B;
      step_load<KIND>(A, b, e0, cl);
#pragma unroll 1
      for (int s = 0; s < 16; s += 2) {
        step_load<KIND>(B, b + (s + 1) * STRIDE, e0, cl);
        const float o0 = step_compute<KIND>(A, S);
        if (sub == 0) ob[s * 32 + cl] = o0;
        step_load<KIND>(A, b + (s + 2 < 16 ? s + 2 : 15) * STRIDE, e0, cl);
        const float o1 = step_compute<KIND>(B, S);
        if (sub == 0) ob[(s + 1) * 32 + cl] = o1;
      }
    } else {
      for (int s = 0; s < n; ++s) {
        StepOps<KIND> A;
        step_load<KIND>(A, b + s * STRIDE, e0, cl);
        const float o0 = step_compute<KIND>(A, S);
        if (sub == 0) ob[s * 32 + cl] = o0;
      }
    }
    if (has_next) scan_store<KIND>(pre, buf + ((c + 1) & 1) * NEL);
    __syncthreads();
  }
  {
    const int c = nchunks - 1, t0 = c * 16, n = T - t0;
    const float* pob = obuf + (c & 1) * 512;
#pragma unroll
    for (int i = 0; i < 2; ++i) {
      const int idx = tid + i * 256, s = idx >> 5, cc = idx & 31;
      if (s < n) oraw[(size_t)(R0 + t0 + s) * PSTR + ocol + cc] = f2bf(pob[idx]);
    }
  }
  float* so = P.out + (sample ? O_S + ((size_t)(l * 128 + (seq - 8)) * NH + h) * 4096 : O_P + ((size_t)(l * 8 + seq) * NH + h) * 4096);
#pragma unroll
  for (int i = 0; i < 8; ++i) { if (KIND == 1) so[col * 64 + e0 + i] = S[i >> 1][i & 1]; else so[(e0 + i) * 64 + col] = S[i >> 1][i & 1]; }
}

__device__ void scan_long(const Params& P, unsigned char* smem, int l, int lt) {
  if (lt < 96) { const int half = lt & 1, bh = lt >> 1; scan_task<1>(P, smem, l, bh / 6, bh % 6, half); }
  else if (lt < 192) { const int x = lt - 96, half = x & 1, bh = x >> 1; scan_task<0>(P, smem, l, bh / 6, bh % 6, half); }
  else { const int x = lt - 192, half = x & 1, bh = x >> 1; scan_task<2>(P, smem, l, bh / 4, bh % 4, half); }
}
__device__ void scan_short(const Params& P, unsigned char* smem, int l, int st) {
  const int s = st >> 4, hh = st & 15;
  for (int half = 0; half < 2; ++half) {
    if (hh < 6) scan_task<0>(P, smem, l, 8 + s, hh, half);
    else if (hh < 12) scan_task<1>(P, smem, l, 8 + s, hh - 6, half);
    else scan_task<2>(P, smem, l, 8 + s, hh - 12, half);
  }
}
__device__ void scan_phase(const Params& P, unsigned char* smem, int l, volatile unsigned* blk  ) {
  unsigned* q = WSP(unsigned, OFF_QUEUE) + l * 128;
  const bool primary = blk[2] == 0u;
  for (int pass = 0; pass < 3; ++pass) {
    if (pass == 0 && !primary) continue;
    unsigned* qq = pass == 1 ? q + 64 : q;
    const unsigned ntask = pass == 1 ? 2048u : 256u;
    for (;;) {
      __syncthreads();
      if (threadIdx.x == 0) blk[3] = __hip_atomic_fetch_add(qq, 1u, __ATOMIC_RELAXED, __HIP_MEMORY_SCOPE_AGENT);
      __syncthreads();
      const unsigned t = blk[3];
      if (t >= ntask) break;
      if (pass == 1) scan_short(P, smem, l, (int)t); else scan_long(P, smem, l, (int)t);
    }
  }
}

__device__ void post_phase(const Params& P, int l) {
  const int lane = otid() & 63, wid = otid() >> 6;
  const bf16_t* p = WSP(bf16_t, OFF_P);
  bf16_t* act = WSP(bf16_t, OFF_ACT);
  const int gw = obid() * 4 + wid, nw = gridDim.x * 4;
  const float gnw = P.in[I_GNW][l * 64 + lane], hnw = P.in[I_HNW][l * 64 + lane];
  for (int u0 = gw * 4; u0 < NTOK * 10; u0 += nw * 4) {
    float o[4], z[4]; int oc[4]; size_t rb[4];
#pragma unroll
    for (int k = 0; k < 4; ++k) {
      const int u = u0 + k, row = u / 10, q = u - row * 10;
      oc[k] = q < 6 ? q * 64 : 768 + (q - 6) * 64;
      const int zc = q < 6 ? 1152 + q * 64 : PC + 768 + (q - 6) * 64;
      rb[k] = (size_t)row;
      o[k] = bf2f(p[(size_t)row * PSTR + oc[k] + lane]);
      z[k] = bf2f(p[(size_t)row * PSTR + zc + lane]);
    }
#pragma unroll
    for (int k = 0; k < 4; ++k) {
      const float ms = wave_sum(o[k] * o[k]) * (1.f / 64.f);
      const float out = o[k] * rsqrtf(ms + 1e-6f) * (oc[k] < 384 ? gnw : hnw) * silu(z[k]);
      act[rb[k] * 1024 + oc[k] + lane] = f2bf(out);
    }
  }
  for (int u0 = gw * 2; u0 < NTOK * 6; u0 += nw * 2) {
    float o[2], r[2], kx[2], v[2], g[2]; int hh[2]; size_t rb[2];
#pragma unroll
    for (int k = 0; k < 2; ++k) {
      const int u = u0 + k, row = u / 6, h = u - row * 6;
      const size_t idx = (size_t)row * 384 + h * 64 + lane;
      hh[k] = h; rb[k] = (size_t)row;
      o[k] = bf2f(p[(size_t)row * PSTR + 384 + h * 64 + lane]);
      r[k] = bf2f(WSP(bf16_t, OFF_RR)[idx]); kx[k] = bf2f(WSP(bf16_t, OFF_RK)[idx]);
      v[k] = bf2f(WSP(bf16_t, OFF_RV)[idx]); g[k] = bf2f(WSP(bf16_t, OFF_RG)[idx]);
    }
#pragma unroll
    for (int k = 0; k < 2; ++k) {
      const int hc = l * 384 + hh[k] * 64 + lane;
      const float mu = wave_sum(o[k]) * (1.f / 64.f);
      const float yc = o[k] - mu;
      const float var = wave_sum(yc * yc) * (1.f / 64.f);
      const float y = yc * rsqrtf(var + 64e-5f) * P.in[I_LNW][hc] + P.in[I_LNB][hc];
      const float rk = wave_sum(r[k] * kx[k] * P.in[I_RK][hc]);
      act[rb[k] * 1024 + 384 + hh[k] * 64 + lane] = f2bf((y + rk * v[k]) * g[k]);
    }
  }
}

#define XB_TMO      128
#define XB_XCNT(j)  (256  + 64 * (j))
#define XB_XSUB(j)  (1280 + 64 * (j))
#define XB_XGEN(j)  (2304 + 64 * (j))
#define XB_TOP      3328
#define XB_TOPGEN   3392
#define XCD_BAR_WORDS 3456
#define XB_SPIN_CAP (1u << 20)
#define LAS __attribute__((address_space(3)))
__device__ __forceinline__ unsigned xb_ld(unsigned* p)              { return __hip_atomic_load(p, __ATOMIC_RELAXED, __HIP_MEMORY_SCOPE_AGENT); }
__device__ __forceinline__ unsigned xb_add(unsigned* p, unsigned v) { return __hip_atomic_fetch_add(p, v, __ATOMIC_RELAXED, __HIP_MEMORY_SCOPE_AGENT); }
__device__ __forceinline__ unsigned xb_xcc_id() { return (unsigned)__builtin_amdgcn_s_getreg((3 << 11) | 20) & 0xFu; }
#define XB_SPIN(cond, bar) do { unsigned _sp = 0; while (cond) { __builtin_amdgcn_s_sleep(1); \
    if ((++_sp & 255u) == 0u) { if (xb_ld(&(bar)[XB_TMO])) break; if (_sp > XB_SPIN_CAP) { atomicAdd(&(bar)[XB_TMO], 1u); break; } } } } while (0)
struct XcdBarrier { unsigned* bar; unsigned x; volatile LAS unsigned* st; };
__device__ __forceinline__ XcdBarrier xcd_barrier_post(unsigned* bar, volatile LAS unsigned* st) {
  XcdBarrier b; b.bar = bar; b.x = xb_xcc_id(); b.st = st;
  if (threadIdx.x == 0) (void)xb_add(&bar[XB_XCNT(b.x)], 1u);
  return b;
}
__device__ __forceinline__ void xcd_barrier_complete(unsigned* bar, unsigned x, unsigned& nloc, unsigned& nx) {
  const unsigned G = gridDim.x * gridDim.y * gridDim.z;
  unsigned sum, cnt, mine, sp = 0u;
  for (;;) {
    sum = 0u; cnt = 0u; mine = 0u;
#pragma unroll
    for (unsigned j = 0; j < 16; ++j) { const unsigned c = xb_ld(&bar[XB_XCNT(j)]); sum += c; cnt += (c > 0u) ? 1u : 0u; mine = (j == x) ? c : mine; }
    if (sum == G) break;
    __builtin_amdgcn_s_sleep(1);
    if ((++sp & 255u) == 0u) { if (xb_ld(&bar[XB_TMO])) break; if (sp > XB_SPIN_CAP) { atomicAdd(&bar[XB_TMO], 1u); break; } }
  }
  nloc = mine > 0u ? mine : 1u; nx = cnt > 0u ? cnt : 1u;
}
__device__ __forceinline__ void xcd_barrier(const XcdBarrier& b) {
  asm volatile("s_waitcnt vmcnt(0)" ::: "memory");
  __syncthreads();
  if (threadIdx.x == 0) {
    unsigned* bar = b.bar;
    __builtin_amdgcn_s_waitcnt(0);
    unsigned nloc = b.st[0], nx = b.st[1];
    if (nloc == 0u) { xcd_barrier_complete(bar, b.x, nloc, nx); b.st[0] = nloc; b.st[1] = nx; }
    const unsigned old = xb_add(&bar[XB_XSUB(b.x)], 1u);
    const unsigned gen = old / nloc;
    if (old + 1u == (gen + 1u) * nloc) {
      __builtin_amdgcn_fence(__ATOMIC_RELEASE, "agent");
      asm volatile("s_waitcnt vmcnt(0)" ::: "memory");
      const unsigned og = xb_add(&bar[XB_TOP], 1u);
      const unsigned tg = og / nx;
      if (og + 1u == (tg + 1u) * nx) xb_add(&bar[XB_TOPGEN], 1u);
      else XB_SPIN(xb_ld(&bar[XB_TOPGEN]) == tg, bar);
      __builtin_amdgcn_fence(__ATOMIC_ACQUIRE, "agent");
      xb_add(&bar[XB_XGEN(b.x)], 1u);
      asm volatile("s_waitcnt vmcnt(0)" ::: "memory");
    } else {
      XB_SPIN(xb_ld(&bar[XB_XGEN(b.x)]) == gen, bar);
      __builtin_amdgcn_fence(__ATOMIC_ACQUIRE, "agent");
      asm volatile("s_waitcnt vmcnt(0)" ::: "memory");
    }
  }
  __syncthreads();
}

__global__ void __launch_bounds__(256, 2) hybrid_fwd(Params P) {
  cg::grid_group grid = cg::this_grid();
  __shared__ __attribute__((aligned(16))) unsigned char smem[65536];
  __shared__ uint4 xb_words;
  if (threadIdx.x == 0) xb_words = make_uint4(0u, 0u, 0u, 0u);
  __syncthreads();
  const XcdBarrier xb = xcd_barrier_post(WSP(unsigned, OFF_BAR), (volatile LAS unsigned*)&xb_words);
  if (threadIdx.x == 0) {
    const unsigned hw = (unsigned)__builtin_amdgcn_s_getreg((7 << 11) | (8 << 6) | 4) & 0xffu;
    const unsigned key = (xb.x << 8) | hw;
    ((volatile unsigned*)&xb_words)[2] = __hip_atomic_fetch_add(WSP(unsigned, OFF_CUTAB) + key, 1u, __ATOMIC_RELAXED, __HIP_MEMORY_SCOPE_AGENT);
  }
  __syncthreads();
#pragma unroll 1
  for (int step = 0; step < NLAYER * 9; ++step) {
    const int l = step / 9, ph = step - l * 9;
    switch (ph) {
      case 0: wconv_phase(P, smem, l); norm_phase(P, l, P.in[I_NORM_MIX] + l * D); break;
      case 1: gemm_phase<EPI_P>(P, smem, WSP(bf16_t, OFF_ACT), 1024, WSP(bf16_t, OFF_WTIN), 1024, 32, l);
              gemm_sample<EPI_P>(P, WSP(bf16_t, OFF_ACT), 1024, WSP(bf16_t, OFF_WTIN), 1024, 249, l); break;
      case 2: prep_phase(P, smem, l); break;
      case 3: scan_phase(P, smem, l, (volatile unsigned*)&xb_words); break;
      case 4: post_phase(P, l); break;
      case 5: gemm_phase<EPI_RES>(P, smem, WSP(bf16_t, OFF_ACT), 1024, WSP(bf16_t, OFF_WTOUT), 1024, 8, l);
              gemm_sample<EPI_RES>(P, WSP(bf16_t, OFF_ACT), 1024, WSP(bf16_t, OFF_WTOUT), 1024, 64, l); break;
      case 6: norm_phase(P, 1, P.in[I_NORM_FFN] + l * D); break;
      case 7: gemm_phase<EPI_SWIGLU>(P, smem, WSP(bf16_t, OFF_ACT), 1024, WSP(bf16_t, OFF_WTGU), 1024, 44, 1);
              gemm_sample<EPI_SWIGLU>(P, WSP(bf16_t, OFF_ACT), 1024, WSP(bf16_t, OFF_WTGU), 1024, 176, 1); break;
      default: gemm_phase<EPI_RES>(P, smem, WSP(bf16_t, OFF_P), DFF, WSP(bf16_t, OFF_WTDN), DFF, 8, 1);
               gemm_sample<EPI_RES>(P, WSP(bf16_t, OFF_P), DFF, WSP(bf16_t, OFF_WTDN), DFF, 64, 1); break;
    }
    if (step == 0) grid.sync();
    else xcd_barrier(xb);
  }
  final_norm_phase(P);
}

extern "C" void kernel_launch(void* const* d_in, const int* in_sizes, int n_in,
                              void* d_out, int out_size, void* d_ws, size_t ws_size,
                              hipStream_t stream) {
  static int grid_blocks = 0;
  if (!grid_blocks) {
    int dev = 0, cus = 0, per_cu = 0;
    (void)hipGetDevice(&dev);
    (void)hipDeviceGetAttribute(&cus, hipDeviceAttributeMultiprocessorCount, dev);
    (void)hipOccupancyMaxActiveBlocksPerMultiprocessor(&per_cu, hybrid_fwd, 256, 0);
    if (per_cu > 2) per_cu = 2;
    if (per_cu < 1) per_cu = 1;
    grid_blocks = cus * per_cu;
  }
  if (ws_size < WS_NEED) { fprintf(stderr, "workspace too small: %zu < %zu\n", ws_size, (size_t)WS_NEED); return; }
  Params p{};
  for (int i = 0; i < N_IN; ++i) p.in[i] = (const float*)d_in[i];
  p.out = (float*)d_out;
  p.ws = (unsigned char*)d_ws;
  (void)hipMemsetAsync((unsigned char*)d_ws + OFF_BAR, 0, BAR_BYTES, stream);
  void* args[] = {&p};
  hipError_t e = hipLaunchCooperativeKernel((void*)hybrid_fwd, dim3(grid_blocks), dim3(256), args, 0, stream);
  if (e != hipSuccess) fprintf(stderr, "cooperative launch failed: %s (grid %d)\n", hipGetErrorString(e), grid_blocks);
}
```

```cpp
#include <hip/hip_runtime.h>
#include <hip/hip_cooperative_groups.h>
#include <cstdio>
namespace cg = cooperative_groups;

typedef unsigned short bf16_t;
typedef short bf16x8 __attribute__((ext_vector_type(8)));
typedef float f32x4 __attribute__((ext_vector_type(4)));
typedef unsigned u32x4 __attribute__((ext_vector_type(4)));
typedef unsigned u32x2 __attribute__((ext_vector_type(2)));

constexpr int D = 1024, NTP = 16384, NTS = 128, NTOK = 16512, TSEQ = 2048, NLAYER = 4;
constexpr int IN_COLS = 3980, PSTR = 3984, DFF = 2816;
constexpr int PB = 1548, PC = 2956;

enum { I_XP = 0, I_XS, I_SGDN, I_SCONV, I_SRWKV, I_SSHIFT, I_SHGRN, I_NORM_MIX, I_WIN, I_WOUT, I_CONVW, I_ALOG, I_DTB, I_GNW,
       I_MU, I_W0, I_W2, I_A0, I_A2, I_G2, I_V0, I_V1, I_V2, I_KK, I_KA, I_RK, I_LNW, I_LNB, I_HLB, I_HNW, I_NORM_FFN,
       I_WG, I_WU, I_WD, I_NORM_FINAL, N_IN };

constexpr size_t O_YP = 0, O_YS = 16777216, O_GDN_P = 16908288, O_GDN_S = 17694720, O_CONV_P = 30277632, O_CONV_S = 30388224,
                 O_RWKV_P = 32157696, O_RWKV_S = 32944128, O_SHIFT_P = 45527040, O_SHIFT_S = 45572096, O_HGRN_P = 46292992,
                 O_HGRN_S = 46817280;

constexpr size_t SZ_WTIN = (size_t)4096 * 1024 * 2, SZ_WTOUT = (size_t)1024 * 1024 * 2, SZ_WTGU = (size_t)5632 * 1024 * 2,
                 SZ_WTDN = (size_t)1024 * 2816 * 2, SZ_P = (size_t)NTOK * PSTR * 2, SZ_ACT = (size_t)NTOK * 1024 * 2,
                 SZ_T384 = (size_t)NTOK * 384 * 2, SZ_T8F = (size_t)NTOK * 8 * 4, SZ_T256 = (size_t)NTOK * 256 * 2,
                 SZ_T384F = (size_t)NTOK * 384 * 4;
constexpr size_t OFF_WTIN = 0, OFF_WTOUT = OFF_WTIN + SZ_WTIN, OFF_WTGU = OFF_WTOUT + SZ_WTOUT, OFF_WTDN = OFF_WTGU + SZ_WTGU,
                 OFF_P = OFF_WTDN + SZ_WTDN, OFF_ACT = OFF_P + SZ_P, OFF_GQ = OFF_ACT + SZ_ACT, OFF_GK = OFF_GQ + SZ_T384,
                 OFF_GV = OFF_GK + SZ_T384, OFF_GDEC = OFF_GV + SZ_T384, OFF_GBETA = OFF_GDEC + SZ_T8F, OFF_HQ = OFF_GBETA + SZ_T8F,
                 OFF_HK = OFF_HQ + SZ_T256, OFF_RR = OFF_HK + SZ_T256, OFF_RK = OFF_RR + SZ_T384, OFF_RV = OFF_RK + SZ_T384,
                 OFF_RKK = OFF_RV + SZ_T384, OFF_RB = OFF_RKK + SZ_T384, OFF_RG = OFF_RB + SZ_T384, OFF_RW = OFF_RG + SZ_T384,
                 OFF_VF = OFF_RW + SZ_T384F, OFF_LORA = OFF_VF + SZ_T384, OFF_WTOUT2 = OFF_LORA + 245760, OFF_WTGU2 = OFF_WTOUT2 + SZ_WTOUT, OFF_WTDN2 = OFF_WTGU2 + SZ_WTGU, OFF_BAR = OFF_WTDN2 + SZ_WTDN, OFF_CUTAB = OFF_BAR + 16384, OFF_QUEUE = OFF_CUTAB + 16384, BAR_BYTES = 16384 + 16384 + 4096, WS_NEED = OFF_BAR + BAR_BYTES;
constexpr int W2T = 0, A2T = 24576, G2T = 49152, V1T = 98304, V2T = 110592;

struct Params {
  const float* in[N_IN];
  float* out;
  unsigned char* ws;
};

#define WSP(T, off) ((T*)(P.ws + (off)))

__device__ __forceinline__ int otid() { int t = __builtin_amdgcn_workitem_id_x(); asm volatile("" : "+v"(t)); return t; }
__device__ __forceinline__ int obid() { int b = __builtin_amdgcn_workgroup_id_x(); asm volatile("" : "+s"(b)); return b; }
__device__ __forceinline__ float bf2f(bf16_t h) { return __uint_as_float(((unsigned)h) << 16); }
typedef float f32x2_t __attribute__((ext_vector_type(2)));
typedef __bf16 bf16x2_t __attribute__((ext_vector_type(2)));
__device__ __forceinline__ unsigned pk2(float lo, float hi) {
  const f32x2_t v = {lo, hi};
  return __builtin_bit_cast(unsigned, __builtin_convertvector(v, bf16x2_t));
}
__device__ __forceinline__ bf16_t f2bf(float f) { return (bf16_t)(pk2(f, 0.f) & 0xffffu); }
__device__ __forceinline__ float sigm(float x) { return 1.f / (1.f + __expf(-x)); }
__device__ __forceinline__ float silu(float x) { return x / (1.f + __expf(-x)); }
__device__ __forceinline__ float softplus(float x) { return x > 20.f ? x : log1pf(__expf(x)); }
template <int CTRL> __device__ __forceinline__ float dppf(float x) {
  return __builtin_bit_cast(float, __builtin_amdgcn_mov_dpp(__builtin_bit_cast(int, x), CTRL, 0xf, 0xf, true));
}
__device__ __forceinline__ float wave_sum(float v) {
  v += dppf<0xB1>(v); v += dppf<0x4E>(v); v += dppf<0x141>(v); v += dppf<0x140>(v);
  const int iv = __builtin_bit_cast(int, v);
  const float s0 = __builtin_bit_cast(float, __builtin_amdgcn_readlane(iv, 0)), s1 = __builtin_bit_cast(float, __builtin_amdgcn_readlane(iv, 16));
  const float s2 = __builtin_bit_cast(float, __builtin_amdgcn_readlane(iv, 32)), s3 = __builtin_bit_cast(float, __builtin_amdgcn_readlane(iv, 48));
  return (s0 + s1) + (s2 + s3);
}
__device__ __forceinline__ float reduce8(float x) { x += dppf<0xB1>(x); x += dppf<0x4E>(x); x += dppf<0x141>(x); return x; }

__device__ __forceinline__ f32x4 unpack4(u32x2 w) {
  f32x4 f; f[0] = __uint_as_float(w[0] << 16); f[1] = __uint_as_float(w[0] & 0xffff0000u);
  f[2] = __uint_as_float(w[1] << 16); f[3] = __uint_as_float(w[1] & 0xffff0000u); return f;
}
__device__ __forceinline__ bf16x8 pack8(f32x4 a, f32x4 b) {
  u32x4 u; u[0] = pk2(a[0], a[1]); u[1] = pk2(a[2], a[3]); u[2] = pk2(b[0], b[1]); u[3] = pk2(b[2], b[3]);
  return __builtin_bit_cast(bf16x8, u);
}
__device__ __forceinline__ u32x2 pack4(f32x4 a) { u32x2 u; u[0] = pk2(a[0], a[1]); u[1] = pk2(a[2], a[3]); return u; }
__device__ __forceinline__ const float* xin_row(const Params& P, int l, int row) {
  if (l > 0) return P.out + (size_t)row * D;
  return row < NTP ? P.in[I_XP] + (size_t)row * D : P.in[I_XS] + (size_t)(row - NTP) * D;
}

__device__ __forceinline__ int gu_row(int c, int up) { return (c >> 6) * 128 + ((c >> 5) & 1) * 64 + up * 32 + (c & 31); }
__device__ void xpose_tile(unsigned char* smem, const float* __restrict__ W, int N, int kt, int ntl, bf16_t* __restrict__ dst, int dstK, int mode) {
  float (*tile)[65] = (float (*)[65])smem;
  const int tid = otid();
  __syncthreads();
#pragma unroll 4
  for (int i = 0; i < 16; ++i) {
    const int k = i * 4 + (tid >> 6), n = tid & 63, gn = ntl * 64 + n;
    tile[k][n] = gn < N ? W[(size_t)(kt * 64 + k) * N + gn] : 0.f;
  }
  __syncthreads();
#pragma unroll 4
  for (int i = 0; i < 16; ++i) {
    const int n = i * 4 + (tid >> 6), k = tid & 63, gn = ntl * 64 + n;
    const int drow = mode == 0 ? gn : gu_row(gn, mode - 1);
    dst[(size_t)drow * dstK + kt * 64 + k] = f2bf(tile[k][n]);
  }
}
constexpr int WCONV_JOBS = 3392 + 480;
__device__ __forceinline__ size_t wt_out_off(int l) { return (l & 1) ? OFF_WTOUT2 : OFF_WTOUT; }
__device__ __forceinline__ size_t wt_gu_off(int l) { return (l & 1) ? OFF_WTGU2 : OFF_WTGU; }
__device__ __forceinline__ size_t wt_dn_off(int l) { return (l & 1) ? OFF_WTDN2 : OFF_WTDN; }
__device__ void wconv_job(const Params& P, unsigned char* smem, int l, int job) {
  if (job < 1024) xpose_tile(smem, P.in[I_WIN] + (size_t)l * 1024 * IN_COLS, IN_COLS, job & 15, job >> 4, WSP(bf16_t, OFF_WTIN), 1024, 0);
  else if (job < 1280) { const int j = job - 1024; xpose_tile(smem, P.in[I_WOUT] + (size_t)l * 1024 * 1024, 1024, j & 15, j >> 4, WSP(bf16_t, wt_out_off(l)), 1024, 0); }
  else if (job < 1984) { const int j = job - 1280; xpose_tile(smem, P.in[I_WG] + (size_t)l * 1024 * DFF, DFF, j & 15, j >> 4, WSP(bf16_t, wt_gu_off(l)), 1024, 1); }
  else if (job < 2688) { const int j = job - 1984; xpose_tile(smem, P.in[I_WU] + (size_t)l * 1024 * DFF, DFF, j & 15, j >> 4, WSP(bf16_t, wt_gu_off(l)), 1024, 2); }
  else if (job < 3392) { const int j = job - 2688; xpose_tile(smem, P.in[I_WD] + (size_t)l * DFF * 1024, 1024, j % 44, j / 44, WSP(bf16_t, wt_dn_off(l)), DFF, 0); }
  else {
    bf16_t* lw = WSP(bf16_t, OFF_LORA);
    const int idx = (job - 3392) * 256 + otid();
    float v = 0.f;
    if (idx < A2T) { const int n = idx >> 6, k = idx & 63; v = P.in[I_W2][(size_t)l * 64 * 384 + k * 384 + n]; }
    else if (idx < G2T) { const int i = idx - A2T, n = i >> 6, k = i & 63; v = P.in[I_A2][(size_t)l * 64 * 384 + k * 384 + n]; }
    else if (idx < V1T) { const int i = idx - G2T, n = i >> 7, k = i & 127; v = P.in[I_G2][(size_t)l * 128 * 384 + k * 384 + n]; }
    else if (idx < V2T) { if (l > 0) { const int i = idx - V1T, n = i / 384, k = i - n * 384; v = P.in[I_V1][(size_t)(l - 1) * 384 * 32 + k * 32 + n]; } }
    else { if (l > 0) { const int i = idx - V2T, n = i >> 5, k = i & 31; v = P.in[I_V2][(size_t)(l - 1) * 32 * 384 + k * 384 + n]; } }
    lw[idx] = f2bf(v);
  }
}
__device__ void wconv_phase(const Params& P, unsigned char* smem, int l) {
  for (int job = obid(); job < WCONV_JOBS; job += gridDim.x) wconv_job(P, smem, l, job);
}

__device__ void norm_phase(const Params& P, int l_in, const float* __restrict__ w) {
  bf16_t* act = WSP(bf16_t, OFF_ACT);
  const int lane = otid() & 63, wid = otid() >> 6;
  for (int row = obid() * 4 + wid; row < NTOK; row += gridDim.x * 4) {
    const float* xr = xin_row(P, l_in, row);
    f32x4 v[4]; float ss = 0.f;
#pragma unroll
    for (int i = 0; i < 4; ++i) { v[i] = *(const f32x4*)(xr + i * 256 + lane * 4); ss += v[i][0] * v[i][0] + v[i][1] * v[i][1] + v[i][2] * v[i][2] + v[i][3] * v[i][3]; }
    ss = wave_sum(ss);
    const float rstd = rsqrtf(ss * (1.f / 1024.f) + 1e-6f);
#pragma unroll
    for (int i = 0; i < 4; ++i) {
      const f32x4 wv = *(const f32x4*)(w + i * 256 + lane * 4);
      u32x2 o; o[0] = pk2(v[i][0] * rstd * wv[0], v[i][1] * rstd * wv[1]); o[1] = pk2(v[i][2] * rstd * wv[2], v[i][3] * rstd * wv[3]);
      *(u32x2*)(act + (size_t)row * 1024 + i * 256 + lane * 4) = o;
    }
  }
}
__device__ void final_norm_phase(const Params& P) {
  const float* w = P.in[I_NORM_FINAL];
  const int lane = otid() & 63, wid = otid() >> 6;
  for (int row = obid() * 4 + wid; row < NTOK; row += gridDim.x * 4) {
    float* xr = P.out + (size_t)row * D;
    f32x4 v[4]; float ss = 0.f;
#pragma unroll
    for (int i = 0; i < 4; ++i) { v[i] = *(const f32x4*)(xr + i * 256 + lane * 4); ss += v[i][0] * v[i][0] + v[i][1] * v[i][1] + v[i][2] * v[i][2] + v[i][3] * v[i][3]; }
    ss = wave_sum(ss);
    const float rstd = rsqrtf(ss * (1.f / 1024.f) + 1e-6f);
#pragma unroll
    for (int i = 0; i < 4; ++i) {
      const f32x4 wv = *(const f32x4*)(w + i * 256 + lane * 4);
      f32x4 o; o[0] = v[i][0] * rstd * wv[0]; o[1] = v[i][1] * rstd * wv[1]; o[2] = v[i][2] * rstd * wv[2]; o[3] = v[i][3] * rstd * wv[3];
      *(f32x4*)(xr + i * 256 + lane * 4) = o;
    }
  }
}

enum { EPI_P = 0, EPI_RES = 1, EPI_SWIGLU = 2 };
template <int EPI>
__device__ void gemm_phase(const Params& P, unsigned char* smem, const bf16_t* __restrict__ A, int lda, const bf16_t* __restrict__ Bt, int K, int nN, int l) {
  const int tid = otid(), lane = tid & 63, wid = tid >> 6, wr = wid >> 1, wc = wid & 1, fr = lane & 15, fq = lane >> 4;
  const int ntiles = 128 * nN, nk = K >> 6;
  const int r0s = tid >> 3, cs = tid & 7;
  const int swz = (fr >> 1) & 7;
  for (int tile = obid(); tile < ntiles; tile += gridDim.x) {
    const int mt = tile / nN, nt = tile - mt * nN;
    const bf16_t* Ag = A + (size_t)(mt * 128 + r0s) * lda + cs * 8;
    const bf16_t* Bg = Bt + (size_t)(nt * 128 + r0s) * K + cs * 8;
    f32x4 acc[4][4];
#pragma unroll
    for (int m = 0; m < 4; ++m)
#pragma unroll
      for (int n = 0; n < 4; ++n) acc[m][n] = (f32x4){0.f, 0.f, 0.f, 0.f};
    u32x4 ra[4], rb[4];
#pragma unroll
    for (int i = 0; i < 4; ++i) { ra[i] = *(const u32x4*)(Ag + (size_t)i * 32 * lda); rb[i] = *(const u32x4*)(Bg + (size_t)i * 32 * K); }
#pragma unroll
    for (int i = 0; i < 4; ++i) {
      const int row = r0s + i * 32; const int off = row * 128 + ((cs ^ ((row >> 1) & 7)) << 4);
      *(u32x4*)(smem + off) = ra[i]; *(u32x4*)(smem + 16384 + off) = rb[i];
    }
    __syncthreads();
    for (int kt = 0; kt < nk; ++kt) {
      const bool nxt = kt + 1 < nk;
      if (nxt) {
#pragma unroll
        for (int i = 0; i < 4; ++i) { ra[i] = *(const u32x4*)(Ag + (size_t)i * 32 * lda + (kt + 1) * 64); rb[i] = *(const u32x4*)(Bg + (size_t)i * 32 * K + (kt + 1) * 64); }
      }
      const unsigned char* sA = smem + (kt & 1) * 32768;
      const unsigned char* sB = sA + 16384;
#pragma unroll
      for (int kk = 0; kk < 2; ++kk) {
        bf16x8 af[4], bfg[4];
        const int coff = ((kk * 4 + fq) ^ swz) << 4;
#pragma unroll
        for (int m = 0; m < 4; ++m) af[m] = *(const bf16x8*)(sA + (wr * 64 + m * 16 + fr) * 128 + coff);
#pragma unroll
        for (int n = 0; n < 4; ++n) bfg[n] = *(const bf16x8*)(sB + (wc * 64 + n * 16 + fr) * 128 + coff);
#pragma unroll
        for (int m = 0; m < 4; ++m)
#pragma unroll
          for (int n = 0; n < 4; ++n) acc[m][n] = __builtin_amdgcn_mfma_f32_16x16x32_bf16(bfg[n], af[m], acc[m][n], 0, 0, 0);
      }
      if (nxt) {
        unsigned char* dA = smem + ((kt + 1) & 1) * 32768;
#pragma unroll
        for (int i = 0; i < 4; ++i) {
          const int row = r0s + i * 32; const int off = row * 128 + ((cs ^ ((row >> 1) & 7)) << 4);
          *(u32x4*)(dA + off) = ra[i]; *(u32x4*)(dA + 16384 + off) = rb[i];
        }
      }
      __syncthreads();
    }
#pragma unroll
    for (int m = 0; m < 4; ++m) {
      const int row = mt * 128 + wr * 64 + m * 16 + fr;
      if (EPI == EPI_P) {
        bf16_t* pr = WSP(bf16_t, OFF_P) + (size_t)row * PSTR;
#pragma unroll
        for (int n = 0; n < 4; ++n) {
          const int col = nt * 128 + wc * 64 + n * 16 + fq * 4;
          if (col < IN_COLS) { u32x2 o; o[0] = pk2(acc[m][n][0], acc[m][n][1]); o[1] = pk2(acc[m][n][2], acc[m][n][3]); *(u32x2*)(pr + col) = o; }
        }
      } else if (EPI == EPI_RES) {
        const float* xi = xin_row(P, l, row);
        float* xo = P.out + (size_t)row * D;
#pragma unroll
        for (int n = 0; n < 4; ++n) {
          const int col = nt * 128 + wc * 64 + n * 16 + fq * 4;
          const f32x4 xv = *(const f32x4*)(xi + col);
          *(f32x4*)(xo + col) = xv + acc[m][n];
        }
      } else {
        bf16_t* ur = WSP(bf16_t, OFF_P) + (size_t)row * DFF;
#pragma unroll
        for (int n = 0; n < 2; ++n) {
          const int col = nt * 64 + wc * 32 + n * 16 + fq * 4;
          float r[4];
#pragma unroll
          for (int j = 0; j < 4; ++j) r[j] = silu(acc[m][n][j]) * acc[m][n + 2][j];
          u32x2 o; o[0] = pk2(r[0], r[1]); o[1] = pk2(r[2], r[3]);
          *(u32x2*)(ur + col) = o;
        }
      }
    }
  }
}

template <int EPI>
__device__ void gemm_sample(const Params& P, const bf16_t* __restrict__ A, int lda, const bf16_t* __restrict__ Bt, int K, int nunits, int l) {
  const int tid = otid(), lane = tid & 63, wid = tid >> 6, fr = lane & 15, fq = lane >> 4;
  for (int u = (int)gridDim.x - 1 - obid(); u < nunits; u += gridDim.x) {
    const int brow0 = EPI == EPI_SWIGLU ? gu_row(u * 16 + fr, 0) : u * 16 + fr;
    const int brow1 = EPI == EPI_SWIGLU ? gu_row(u * 16 + fr, 1) : 0;
    const bf16_t* a0p = A + (size_t)(NTP + wid * 32 + fr) * lda + fq * 8;
    const bf16_t* a1p = a0p + (size_t)16 * lda;
    const bf16_t* b0p = Bt + (size_t)brow0 * K + fq * 8;
    const bf16_t* b1p = Bt + (size_t)brow1 * K + fq * 8;
    f32x4 c00 = (f32x4){0.f, 0.f, 0.f, 0.f}, c10 = c00, c01 = c00, c11 = c00;
#pragma unroll 8
    for (int ks = 0; ks < K; ks += 32) {
      const bf16x8 A0 = *(const bf16x8*)(a0p + ks), A1 = *(const bf16x8*)(a1p + ks), B0 = *(const bf16x8*)(b0p + ks);
      c00 = __builtin_amdgcn_mfma_f32_16x16x32_bf16(B0, A0, c00, 0, 0, 0);
      c10 = __builtin_amdgcn_mfma_f32_16x16x32_bf16(B0, A1, c10, 0, 0, 0);
      if (EPI == EPI_SWIGLU) {
        const bf16x8 B1 = *(const bf16x8*)(b1p + ks);
        c01 = __builtin_amdgcn_mfma_f32_16x16x32_bf16(B1, A0, c01, 0, 0, 0);
        c11 = __builtin_amdgcn_mfma_f32_16x16x32_bf16(B1, A1, c11, 0, 0, 0);
      }
    }
#pragma unroll
    for (int m = 0; m < 2; ++m) {
      const int row = NTP + wid * 32 + m * 16 + fr, col = u * 16 + fq * 4;
      const f32x4 g = m ? c10 : c00, up = m ? c11 : c01;
      if (EPI == EPI_P) {
        if (col < IN_COLS) *(u32x2*)(WSP(bf16_t, OFF_P) + (size_t)row * PSTR + col) = pack4(g);
      } else if (EPI == EPI_RES) {
        const float* xi = xin_row(P, l, row);
        *(f32x4*)(P.out + (size_t)row * D + col) = *(const f32x4*)(xi + col) + g;
      } else {
        f32x4 r;
#pragma unroll
        for (int j = 0; j < 4; ++j) r[j] = silu(g[j]) * up[j];
        *(u32x2*)(WSP(bf16_t, OFF_P) + (size_t)row * DFF + col) = pack4(r);
      }
    }
  }
}

__device__ __forceinline__ float lbval(const Params& P, int l, int c) {
  const float* hb = P.in[I_HLB];
  const float a0 = hb[c], a1 = hb[256 + c], a2 = hb[512 + c], a3 = hb[768 + c];
  const float m = fmaxf(fmaxf(a0, a1), fmaxf(a2, a3));
  const float e0 = __expf(a0 - m), e1 = __expf(a1 - m), e2 = __expf(a2 - m), e3 = __expf(a3 - m);
  const float inv = 1.f / (e0 + e1 + e2 + e3);
  float s = 0.f;
  if (l >= 1) s += e1; if (l >= 2) s += e2; if (l >= 3) s += e3;
  return s * inv;
}

__device__ __forceinline__ void gdn_conv_emit(const Params& P, int g, int lane, int row, float s) {
  const int h = g % 6;
  if (g < 12) {
    const float ss = wave_sum(s * s);
    const float o = s * rsqrtf(ss + 1e-6f) * (g < 6 ? 0.125f : 1.f);
    (g < 6 ? WSP(bf16_t, OFF_GQ) : WSP(bf16_t, OFF_GK))[(size_t)row * 384 + h * 64 + lane] = f2bf(o);
  } else {
    WSP(bf16_t, OFF_GV)[(size_t)row * 384 + h * 64 + lane] = f2bf(s);
  }
}
__device__ __forceinline__ void gdn_gate_emit(const Params& P, int l, int h, int row) {
  const bf16_t* pr = WSP(bf16_t, OFF_P) + (size_t)row * PSTR;
  const float braw = bf2f(pr[1536 + h]), araw = bf2f(pr[1542 + h]);
  const float gg = -__expf(P.in[I_ALOG][l * 6 + h]) * softplus(araw + P.in[I_DTB][l * 6 + h]);
  WSP(float, OFF_GDEC)[(size_t)row * 8 + h] = __expf(gg);
  WSP(float, OFF_GBETA)[(size_t)row * 8 + h] = sigm(braw);
}
__device__ void prep_gdn_prompt(const Params& P, int l, int ci) {
  const int lane = otid() & 63, wid = otid() >> 6;
  const int r0 = ci * 32, b = r0 / TSEQ, t0 = r0 % TSEQ;
  const bf16_t* p = WSP(bf16_t, OFF_P);
  for (int g = wid; g < 18; g += 4) {
    const int col = g * 64 + lane;
    const float* cw = P.in[I_CONVW] + (size_t)l * 4 * 1152 + col;
    const float c0 = cw[0], c1 = cw[1152], c2 = cw[2304], c3 = cw[3456];
    float xr[35];
#pragma unroll
    for (int t = 0; t < 35; ++t) xr[t] = (t >= 3 || t0 > 0) ? bf2f(p[(size_t)(r0 - 3 + t) * PSTR + col]) : 0.f;
#pragma unroll
    for (int t = 0; t < 32; ++t) {
      const float y = c0 * xr[t] + c1 * xr[t + 1] + c2 * xr[t + 2] + c3 * xr[t + 3];
      gdn_conv_emit(P, g, lane, r0 + t, silu(y));
    }
    if (t0 + 32 == TSEQ) {
      float* cp = P.out + O_CONV_P + (size_t)(l * 8 + b) * 3 * 1152 + col;
      cp[0] = xr[32]; cp[1152] = xr[33]; cp[2304] = xr[34];
    }
    if (g < 6 && lane < 32) gdn_gate_emit(P, l, g, r0 + lane);
  }
}
__device__ void prep_gdn_sample(const Params& P, int l, int si) {
  const int lane = otid() & 63, wid = otid() >> 6;
  const bf16_t* p = WSP(bf16_t, OFF_P);
  for (int u = wid; u < 8 * 18; u += 4) {
    const int s = si * 8 + u / 18, g = u % 18, col = g * 64 + lane, row = NTP + s;
    const float* cw = P.in[I_CONVW] + (size_t)l * 4 * 1152 + col;
    const float c0 = cw[0], c1 = cw[1152], c2 = cw[2304], c3 = cw[3456];
    const float* cb = P.in[I_SCONV] + (size_t)(l * 128 + s) * 3 * 1152 + col;
    const float x3 = cb[0], x2 = cb[1152], x1 = cb[2304];
    const float x0 = bf2f(p[(size_t)row * PSTR + col]);
    const float y = c0 * x3 + c1 * x2 + c2 * x1 + c3 * x0;
    gdn_conv_emit(P, g, lane, row, silu(y));
    float* cp = P.out + O_CONV_S + (size_t)(l * 128 + s) * 3 * 1152 + col;
    cp[0] = x2; cp[1152] = x1; cp[2304] = x0;
    if (g < 6 && lane == 0) gdn_gate_emit(P, l, g, row);
  }
}
__device__ void prep_hgrn(const Params& P, int l, int ti) {
  const int c = otid();
  const float oml = 1.f - lbval(P, l, c);
  const bf16_t* p = WSP(bf16_t, OFF_P);
  bf16_t* hq = WSP(bf16_t, OFF_HQ); bf16_t* hk = WSP(bf16_t, OFF_HK);
  for (int t = 0; t < 64; ++t) {
    const int row = ti * 64 + t;
    const float q = bf2f(p[(size_t)row * PSTR + PC + c]), f = bf2f(p[(size_t)row * PSTR + PC + 256 + c]);
    hq[(size_t)row * 256 + c] = f2bf(silu(q) * 0.125f);
    hk[(size_t)row * 256 + c] = f2bf(oml * sigm(-f));
  }
}
__device__ __forceinline__ f32x4 xs4(const Params& P, int l, int row, int col0) {
  const bf16_t* p = WSP(bf16_t, OFF_P);
  const f32x4 pv = unpack4(*(const u32x2*)(p + (size_t)row * PSTR + PB + col0));
  f32x4 prev = (f32x4){0.f, 0.f, 0.f, 0.f};
  if (row >= NTP) prev = *(const f32x4*)(P.in[I_SSHIFT] + (size_t)(l * 128 + (row - NTP)) * 1408 + col0);
  else if ((row & (TSEQ - 1)) != 0) prev = unpack4(*(const u32x2*)(p + (size_t)(row - 1) * PSTR + PB + col0));
  const f32x4 mu = *(const f32x4*)(P.in[I_MU] + l * 1408 + col0);
  return pv + (prev - pv) * mu;
}
__device__ __forceinline__ float tanh_fast(float x) { return 1.f - 2.f / (__expf(2.f * x) + 1.f); }

__device__ void prep_rwkv_unit(const Params& P, int l, int mt, int hh) {
  const int lane = otid() & 63, fr = lane & 15, fq = lane >> 4;
  const int row = mt * 16 + fr, cb = hh * 192;
  const bf16_t* lw = WSP(bf16_t, OFF_LORA);
  const size_t ro = (size_t)row * 384;
  f32x4 acc[12];
#pragma unroll
  for (int nf = 0; nf < 12; ++nf) acc[nf] = (f32x4){0.f, 0.f, 0.f, 0.f};
#pragma unroll
  for (int ks = 0; ks < 2; ++ks) {
    f32x4 x0 = xs4(P, l, row, 1152 + ks * 32 + fq * 8), x1 = xs4(P, l, row, 1152 + ks * 32 + fq * 8 + 4);
#pragma unroll
    for (int j = 0; j < 4; ++j) { x0[j] = tanh_fast(x0[j]); x1[j] = tanh_fast(x1[j]); }
    const bf16x8 A = pack8(x0, x1);
#pragma unroll
    for (int nf = 0; nf < 12; ++nf) {
      const bf16x8 B = *(const bf16x8*)(lw + W2T + (cb + nf * 16 + fr) * 64 + ks * 32 + fq * 8);
      acc[nf] = __builtin_amdgcn_mfma_f32_16x16x32_bf16(B, A, acc[nf], 0, 0, 0);
    }
  }
#pragma unroll
  for (int nf = 0; nf < 12; ++nf) {
    const int c = cb + nf * 16 + fq * 4;
    const f32x4 w0 = *(const f32x4*)(P.in[I_W0] + l * 384 + c);
    f32x4 d;
#pragma unroll
    for (int j = 0; j < 4; ++j) {
      const float x = -(w0[j] + acc[nf][j]);
      const float sp = x > 15.f ? x : __logf(1.f + __expf(x));
      d[j] = __expf(-__expf(-sp - 0.5f));
    }
    *(f32x4*)(WSP(float, OFF_RW) + ro + c) = d;
  }
#pragma unroll
  for (int nf = 0; nf < 12; ++nf) acc[nf] = (f32x4){0.f, 0.f, 0.f, 0.f};
#pragma unroll
  for (int ks = 0; ks < 2; ++ks) {
    const bf16x8 A = pack8(xs4(P, l, row, 1216 + ks * 32 + fq * 8), xs4(P, l, row, 1216 + ks * 32 + fq * 8 + 4));
#pragma unroll
    for (int nf = 0; nf < 12; ++nf) {
      const bf16x8 B = *(const bf16x8*)(lw + A2T + (cb + nf * 16 + fr) * 64 + ks * 32 + fq * 8);
      acc[nf] = __builtin_amdgcn_mfma_f32_16x16x32_bf16(B, A, acc[nf], 0, 0, 0);
    }
  }
#pragma unroll
  for (int hl = 0; hl < 3; ++hl) {
    f32x4 kr[4], kkr[4];
    float ss = 0.f;
#pragma unroll
    for (int q = 0; q < 4; ++q) {
      const int c = cb + (hl * 4 + q) * 16 + fq * 4;
      kr[q] = xs4(P, l, row, 384 + c);
      kkr[q] = kr[q] * *(const f32x4*)(P.in[I_KK] + l * 384 + c);
      ss += kkr[q][0] * kkr[q][0] + kkr[q][1] * kkr[q][1] + kkr[q][2] * kkr[q][2] + kkr[q][3] * kkr[q][3];
    }
    ss += __shfl_xor(ss, 16); ss += __shfl_xor(ss, 32);
    const float rn = rsqrtf(ss + 1e-6f);
#pragma unroll
    for (int q = 0; q < 4; ++q) {
      const int nf = hl * 4 + q, c = cb + nf * 16 + fq * 4;
      const f32x4 a0 = *(const f32x4*)(P.in[I_A0] + l * 384 + c), ka = *(const f32x4*)(P.in[I_KA] + l * 384 + c);
      f32x4 kn, kk, kb;
#pragma unroll
      for (int j = 0; j < 4; ++j) {
        const float a = sigm(a0[j] + acc[nf][j]);
        kk[j] = kkr[q][j] * rn; kb[j] = kk[j] * a; kn[j] = kr[q][j] * (1.f + (a - 1.f) * ka[j]);
      }
      *(u32x2*)(WSP(bf16_t, OFF_RK) + ro + c) = pack4(kn);
      *(u32x2*)(WSP(bf16_t, OFF_RKK) + ro + c) = pack4(kk);
      *(u32x2*)(WSP(bf16_t, OFF_RB) + ro + c) = pack4(kb);
      *(u32x2*)(WSP(bf16_t, OFF_RR) + ro + c) = pack4(xs4(P, l, row, c));
    }
  }
#pragma unroll
  for (int nf = 0; nf < 12; ++nf) acc[nf] = (f32x4){0.f, 0.f, 0.f, 0.f};
#pragma unroll
  for (int ks = 0; ks < 4; ++ks) {
    f32x4 x0 = xs4(P, l, row, 1280 + ks * 32 + fq * 8), x1 = xs4(P, l, row, 1280 + ks * 32 + fq * 8 + 4);
#pragma unroll
    for (int j = 0; j < 4; ++j) { x0[j] = sigm(x0[j]); x1[j] = sigm(x1[j]); }
    const bf16x8 A = pack8(x0, x1);
#pragma unroll
    for (int nf = 0; nf < 12; ++nf) {
      const bf16x8 B = *(const bf16x8*)(lw + G2T + (cb + nf * 16 + fr) * 128 + ks * 32 + fq * 8);
      acc[nf] = __builtin_amdgcn_mfma_f32_16x16x32_bf16(B, A, acc[nf], 0, 0, 0);
    }
  }
#pragma unroll
  for (int nf = 0; nf < 12; ++nf) *(u32x2*)(WSP(bf16_t, OFF_RG) + ro + cb + nf * 16 + fq * 4) = pack4(acc[nf]);
  if (l == 0) {
#pragma unroll
    for (int nf = 0; nf < 12; ++nf) {
      const int c = cb + nf * 16 + fq * 4;
      const u32x2 o = pack4(xs4(P, l, row, 768 + c));
      *(u32x2*)(WSP(bf16_t, OFF_RV) + ro + c) = o;
      *(u32x2*)(WSP(bf16_t, OFF_VF) + ro + c) = o;
    }
  } else {
    f32x4 lo0 = (f32x4){0.f, 0.f, 0.f, 0.f}, lo1 = lo0;
#pragma unroll 4
    for (int ks = 0; ks < 12; ++ks) {
      const bf16x8 A = pack8(xs4(P, l, row, 768 + ks * 32 + fq * 8), xs4(P, l, row, 768 + ks * 32 + fq * 8 + 4));
      const bf16x8 B0 = *(const bf16x8*)(lw + V1T + fr * 384 + ks * 32 + fq * 8);
      const bf16x8 B1 = *(const bf16x8*)(lw + V1T + (16 + fr) * 384 + ks * 32 + fq * 8);
      lo0 = __builtin_amdgcn_mfma_f32_16x16x32_bf16(B0, A, lo0, 0, 0, 0);
      lo1 = __builtin_amdgcn_mfma_f32_16x16x32_bf16(B1, A, lo1, 0, 0, 0);
    }
    const bf16x8 A2 = pack8(lo0, lo1);
#pragma unroll
    for (int nf = 0; nf < 12; ++nf) {
      const int c = cb + nf * 16 + fq * 4;
      const bf16_t* vr = lw + V2T + (cb + nf * 16 + fr) * 32;
      u32x4 bw; { const u32x2 b0 = *(const u32x2*)(vr + fq * 4), b1 = *(const u32x2*)(vr + 16 + fq * 4); bw[0] = b0[0]; bw[1] = b0[1]; bw[2] = b1[0]; bw[3] = b1[1]; }
      const f32x4 mv = __builtin_amdgcn_mfma_f32_16x16x32_bf16(__builtin_bit_cast(bf16x8, bw), A2, (f32x4){0.f, 0.f, 0.f, 0.f}, 0, 0, 0);
      const f32x4 v0 = *(const f32x4*)(P.in[I_V0] + (l - 1) * 384 + c);
      const f32x4 v = xs4(P, l, row, 768 + c), vf = unpack4(*(const u32x2*)(WSP(bf16_t, OFF_VF) + ro + c));
      f32x4 o;
#pragma unroll
      for (int j = 0; j < 4; ++j) o[j] = v[j] + (vf[j] - v[j]) * sigm(v0[j] + mv[j]);
      *(u32x2*)(WSP(bf16_t, OFF_RV) + ro + c) = pack4(o);
    }
  }
}
__device__ void prep_phase(const Params& P, unsigned char* smem, int l) {
  for (int it = obid(); it < 1302; it += gridDim.x) {
    if (it < 516) { const int wid = otid() >> 6; prep_rwkv_unit(P, l, it * 2 + (wid >> 1), wid & 1); }
    else if (it < 1028) prep_gdn_prompt(P, l, it - 516);
    else if (it < 1044) prep_gdn_sample(P, l, it - 1028);
    else prep_hgrn(P, l, it - 1044);
  }
  const bf16_t* p = WSP(bf16_t, OFF_P);
  for (int idx = obid() * 256 + otid(); idx < 136 * 1408; idx += gridDim.x * 256) {
    const int q = idx / 1408, col = idx - q * 1408;
    if (q < 8) P.out[O_SHIFT_P + (size_t)(l * 8 + q) * 1408 + col] = bf2f(p[(size_t)(q * TSEQ + TSEQ - 1) * PSTR + PB + col]);
    else P.out[O_SHIFT_S + (size_t)(l * 128 + (q - 8)) * 1408 + col] = bf2f(p[(size_t)(NTP + q - 8) * PSTR + PB + col]);
  }
}

template <int KIND> struct ScanCfg { static constexpr int STRIDE = KIND == 1 ? 356 : 164; };
typedef float f32x2 __attribute__((ext_vector_type(2)));
__device__ __forceinline__ float row_sum16(float v) { v += dppf<0xB1>(v); v += dppf<0x4E>(v); v += dppf<0x141>(v); v += dppf<0x140>(v); return v; }
__device__ __forceinline__ float dot4(f32x4 a, f32x4 b) { return (a[0] * b[0] + a[1] * b[1]) + (a[2] * b[2] + a[3] * b[3]); }

template <int KIND> struct ScanPre { u32x2 a, b, c, d, v; f32x4 w; float g; };

template <int KIND>
__device__ __forceinline__ void scan_load(const Params& P, ScanPre<KIND>& r, int h, int half, int rowbase, int nvalid) {
  const int tid = otid();
  const int s = tid >> 4, j4 = (tid & 15) * 4;
  const int s2 = (tid >> 3) & 15, j2 = (tid & 7) * 4;
  const u32x2 z2 = {0u, 0u};
  const bool ok = s < nvalid, ok2 = (tid < 128) && (s2 < nvalid);
  if (KIND == 0) {
    const size_t o = (size_t)(rowbase + s) * 384 + h * 64 + j4;
    r.a = ok ? *(const u32x2*)(WSP(bf16_t, OFF_GK) + o) : z2;
    r.b = ok ? *(const u32x2*)(WSP(bf16_t, OFF_GQ) + o) : z2;
    r.v = ok2 ? *(const u32x2*)(WSP(bf16_t, OFF_GV) + (size_t)(rowbase + s2) * 384 + h * 64 + half * 32 + j2) : z2;
    const int sg = (tid >> 1) & 15;
    r.g = (tid < 32 && sg < nvalid) ? ((tid & 1) ? WSP(float, OFF_GBETA) : WSP(float, OFF_GDEC))[(size_t)(rowbase + sg) * 8 + h] : 0.f;
  } else if (KIND == 1) {
    const size_t o = (size_t)(rowbase + s) * 384 + h * 64 + j4;
    r.a = ok ? *(const u32x2*)(WSP(bf16_t, OFF_RR) + o) : z2;
    r.w = ok ? *(const f32x4*)(WSP(float, OFF_RW) + o) : (f32x4){0.f, 0.f, 0.f, 0.f};
    r.b = ok ? *(const u32x2*)(WSP(bf16_t, OFF_RK) + o) : z2;
    r.c = ok ? *(const u32x2*)(WSP(bf16_t, OFF_RKK) + o) : z2;
    r.d = ok ? *(const u32x2*)(WSP(bf16_t, OFF_RB) + o) : z2;
    r.v = ok2 ? *(const u32x2*)(WSP(bf16_t, OFF_RV) + (size_t)(rowbase + s2) * 384 + h * 64 + half * 32 + j2) : z2;
  } else {
    const size_t o = (size_t)(rowbase + s) * 256 + h * 64 + j4;
    r.a = ok ? *(const u32x2*)(WSP(bf16_t, OFF_HQ) + o) : z2;
    r.b = ok ? *(const u32x2*)(WSP(bf16_t, OFF_HK) + o) : z2;
    r.v = ok2 ? *(const u32x2*)(WSP(bf16_t, OFF_P) + (size_t)(rowbase + s2) * PSTR + PC + 512 + h * 64 + half * 32 + j2) : z2;
  }
}
template <int KIND>
__device__ __forceinline__ void scan_store(const ScanPre<KIND>& r, float* buf) {
  constexpr int STRIDE = ScanCfg<KIND>::STRIDE;
  const int tid = otid();
  const int s = tid >> 4, j4 = (tid & 15) * 4;
  const int s2 = (tid >> 3) & 15, j2 = (tid & 7) * 4;
  float* bs = buf + s * STRIDE + j4;
  if (KIND == 0) {
    const f32x4 k = unpack4(r.a), q = unpack4(r.b);
    *(f32x4*)(bs) = k; *(f32x4*)(bs + 64) = q;
    const float qk = row_sum16(dot4(q, k));
    if ((tid & 15) == 0) buf[s * STRIDE + 162] = qk;
    if (tid < 128) *(f32x4*)(buf + s2 * STRIDE + 128 + j2) = unpack4(r.v);
    if (tid < 32) buf[((tid >> 1) & 15) * STRIDE + 160 + (tid & 1)] = r.g;
  } else if (KIND == 1) {
    const f32x4 rr = unpack4(r.a), k = unpack4(r.b), kk = unpack4(r.c), bb = unpack4(r.d);
    *(f32x4*)(bs) = r.w * rr; *(f32x4*)(bs + 64) = r.w; *(f32x4*)(bs + 128) = k;
    *(f32x4*)(bs + 192) = kk; *(f32x4*)(bs + 256) = bb;
    const float br = row_sum16(dot4(bb, rr)), kr = row_sum16(dot4(k, rr));
    if ((tid & 15) == 0) { buf[s * STRIDE + 352] = br; buf[s * STRIDE + 353] = kr; }
    if (tid < 128) *(f32x4*)(buf + s2 * STRIDE + 320 + j2) = unpack4(r.v);
  } else {
    const f32x4 q = unpack4(r.a), k = unpack4(r.b);
    *(f32x4*)(bs) = q * (1.f - k); *(f32x4*)(bs + 64) = k;
    const float qk = row_sum16(dot4(q, k));
    if ((tid & 15) == 0) buf[s * STRIDE + 160] = qk;
    if (tid < 128) *(f32x4*)(buf + s2 * STRIDE + 128 + j2) = unpack4(r.v);
  }
}

template <int KIND> struct StepOps { f32x2 a[4], b[4], c[4], d[4], e[4]; float v, s0, s1, s2; };
template <int KIND>
__device__ __forceinline__ void step_load(StepOps<KIND>& o, const float* bs, int e0, int cl) {
#define LD8(dst, off) { const f32x4 _x = *(const f32x4*)(bs + (off) + e0), _y = *(const f32x4*)(bs + (off) + e0 + 4); \
    dst[0] = (f32x2){_x[0], _x[1]}; dst[1] = (f32x2){_x[2], _x[3]}; dst[2] = (f32x2){_y[0], _y[1]}; dst[3] = (f32x2){_y[2], _y[3]}; }
  if (KIND == 0) {
    LD8(o.a, 0) LD8(o.b, 64)
    o.v = bs[128 + cl];
    const f32x4 sc = *(const f32x4*)(bs + 160); o.s0 = sc[0]; o.s1 = sc[1]; o.s2 = sc[2];
  } else if (KIND == 1) {
    LD8(o.a, 0) LD8(o.b, 64) LD8(o.c, 128) LD8(o.d, 192) LD8(o.e, 256)
    o.v = bs[320 + cl];
    const f32x2 sc = *(const f32x2*)(bs + 352); o.s0 = sc[0]; o.s1 = sc[1];
  } else {
    LD8(o.a, 0) LD8(o.b, 64)
    o.v = bs[128 + cl]; o.s0 = bs[160];
  }
#undef LD8
}
template <int KIND>
__device__ __forceinline__ float step_compute(const StepOps<KIND>& o, f32x2 (&S)[4]) {
  if (KIND == 0) {
    f32x2 ks2 = o.a[0] * S[0], qs2 = o.b[0] * S[0];
#pragma unroll
    for (int i = 1; i < 4; ++i) { ks2 += o.a[i] * S[i]; qs2 += o.b[i] * S[i]; }
    float ks = ks2[0] + ks2[1], qs = qs2[0] + qs2[1];
    ks += dppf<0xB1>(ks); qs += dppf<0xB1>(qs); ks += dppf<0x4E>(ks); qs += dppf<0x4E>(qs); ks += dppf<0x141>(ks); qs += dppf<0x141>(qs);
    const float dec = o.s0, vn = o.s1 * (o.v - dec * ks);
#pragma unroll
    for (int i = 0; i < 4; ++i) S[i] = S[i] * dec + o.a[i] * vn;
    return dec * qs + vn * o.s2;
  } else if (KIND == 1) {
    f32x2 sa2 = o.d[0] * S[0], p2 = o.a[0] * S[0];
#pragma unroll
    for (int i = 1; i < 4; ++i) { sa2 += o.d[i] * S[i]; p2 += o.a[i] * S[i]; }
    float sa = sa2[0] + sa2[1], p1 = p2[0] + p2[1];
    sa += dppf<0xB1>(sa); p1 += dppf<0xB1>(p1); sa += dppf<0x4E>(sa); p1 += dppf<0x4E>(p1); sa += dppf<0x141>(sa); p1 += dppf<0x141>(p1);
    sa = -sa;
#pragma unroll
    for (int i = 0; i < 4; ++i) S[i] = S[i] * o.b[i] + (o.e[i] * sa + o.c[i] * o.v);
    return p1 + sa * o.s0 + o.v * o.s1;
  } else {
    f32x2 p2 = o.a[0] * S[0];
#pragma unroll
    for (int i = 1; i < 4; ++i) p2 += o.a[i] * S[i];
    float p1 = p2[0] + p2[1];
    p1 += dppf<0xB1>(p1); p1 += dppf<0x4E>(p1); p1 += dppf<0x141>(p1);
#pragma unroll
    for (int i = 0; i < 4; ++i) S[i] = S[i] + o.b[i] * (o.v - S[i]);
    return p1 + o.v * o.s0;
  }
}

template <int KIND>
__device__ void scan_task(const Params& P, unsigned char* smem, int l, int seq, int h, int half) {
  constexpr int STRIDE = ScanCfg<KIND>::STRIDE, NEL = 16 * STRIDE;
  constexpr int NH = KIND == 2 ? 4 : 6;
  float* buf = (float*)smem;
  float* obuf = buf + 2 * NEL;
  const int tid = otid(), lane = tid & 63, wid = tid >> 6;
  const int col_l = lane >> 3, sub = lane & 7, cl = wid * 8 + col_l, col = half * 32 + cl, e0 = sub * 8;
  const bool sample = seq >= 8;
  const int R0 = sample ? NTP + (seq - 8) : seq * TSEQ, T = sample ? 1 : TSEQ;
  const int ocol = (KIND == 0 ? 0 : (KIND == 1 ? 384 : 768)) + h * 64 + half * 32;
  const size_t O_P = KIND == 0 ? O_GDN_P : (KIND == 1 ? O_RWKV_P : O_HGRN_P);
  const size_t O_S = KIND == 0 ? O_GDN_S : (KIND == 1 ? O_RWKV_S : O_HGRN_S);
  const int I_ST = KIND == 0 ? I_SGDN : (KIND == 1 ? I_SRWKV : I_SHGRN);
  f32x2 S[4];
  if (sample) {
    const float* st = P.in[I_ST] + ((size_t)(l * 128 + (seq - 8)) * NH + h) * 4096;
#pragma unroll
    for (int i = 0; i < 8; ++i) S[i >> 1][i & 1] = KIND == 1 ? st[col * 64 + e0 + i] : st[(e0 + i) * 64 + col];
  } else {
#pragma unroll
    for (int i = 0; i < 4; ++i) S[i] = (f32x2){0.f, 0.f};
  }
  ScanPre<KIND> pre;
  __syncthreads();
  scan_load<KIND>(P, pre, h, half, R0, T);
  scan_store<KIND>(pre, buf);
  __syncthreads();
  const int nchunks = (T + 15) >> 4;
  bf16_t* oraw = WSP(bf16_t, OFF_P);
  for (int c = 0; c < nchunks; ++c) {
    const int t0 = c * 16, n = (T - t0) < 16 ? (T - t0) : 16;
    const bool has_next = c + 1 < nchunks;
    if (has_next) scan_load<KIND>(P, pre, h, half, R0 + t0 + 16, T - t0 - 16);
    if (c > 0) {
      const float* pob = obuf + ((c - 1) & 1) * 512;
#pragma unroll
      for (int i = 0; i < 2; ++i) {
        const int idx = tid + i * 256, s = idx >> 5, cc = idx & 31;
        oraw[(size_t)(R0 + t0 - 16 + s) * PSTR + ocol + cc] = f2bf(pob[idx]);
      }
    }
    const float* b = buf + (c & 1) * NEL;
    float* ob = obuf + (c & 1) * 512;
    if (n == 16) {
      StepOps<KIND> A, B;
      step_load<KIND>(A, b, e0, cl);
#pragma unroll 1
      for (int s = 0; s < 16; s += 2) {
        step_load<KIND>(B, b + (s + 1) * STRIDE, e0, cl);
        const float o0 = step_compute<KIND>(A, S);
        if (sub == 0) ob[s * 32 + cl] = o0;
        step_load<KIND>(A, b + (s + 2 < 16 ? s + 2 : 15) * STRIDE, e0, cl);
        const float o1 = step_compute<KIND>(B, S);
        if (sub == 0) ob[(s + 1) * 32 + cl] = o1;
      }
    } else {
      for (int s = 0; s < n; ++s) {
        StepOps<KIND> A;
        step_load<KIND>(A, b + s * STRIDE, e0, cl);
        const float o0 = step_compute<KIND>(A, S);
        if (sub == 0) ob[s * 32 + cl] = o0;
      }
    }
    if (has_next) scan_store<KIND>(pre, buf + ((c + 1) & 1) * NEL);
    __syncthreads();
  }
  {
    const int c = nchunks - 1, t0 = c * 16, n = T - t0;
    const float* pob = obuf + (c & 1) * 512;
#pragma unroll
    for (int i = 0; i < 2; ++i) {
      const int idx = tid + i * 256, s = idx >> 5, cc = idx & 31;
      if (s < n) oraw[(size_t)(R0 + t0 + s) * PSTR + ocol + cc] = f2bf(pob[idx]);
    }
  }
  float* so = P.out + (sample ? O_S + ((size_t)(l * 128 + (seq - 8)) * NH + h) * 4096 : O_P + ((size_t)(l * 8 + seq) * NH + h) * 4096);
#pragma unroll
  for (int i = 0; i < 8; ++i) { if (KIND == 1) so[col * 64 + e0 + i] = S[i >> 1][i & 1]; else so[(e0 + i) * 64 + col] = S[i >> 1][i & 1]; }
}

__device__ void scan_long(const Params& P, unsigned char* smem, int l, int lt) {
  if (lt < 96) { const int half = lt & 1, bh = lt >> 1; scan_task<1>(P, smem, l, bh / 6, bh % 6, half); }
  else if (lt < 192) { const int x = lt - 96, half = x & 1, bh = x >> 1; scan_task<0>(P, smem, l, bh / 6, bh % 6, half); }
  else { const int x = lt - 192, half = x & 1, bh = x >> 1; scan_task<2>(P, smem, l, bh / 4, bh % 4, half); }
}
__device__ void scan_short(const Params& P, unsigned char* smem, int l, int st) {
  const int s = st >> 4, hh = st & 15;
  for (int half = 0; half < 2; ++half) {
    if (hh < 6) scan_task<0>(P, smem, l, 8 + s, hh, half);
    else if (hh < 12) scan_task<1>(P, smem, l, 8 + s, hh - 6, half);
    else scan_task<2>(P, smem, l, 8 + s, hh - 12, half);
  }
}
__device__ void scan_phase(const Params& P, unsigned char* smem, int l, volatile unsigned* blk  ) {
  unsigned* q = WSP(unsigned, OFF_QUEUE) + l * 128;
  const bool primary = blk[2] == 0u;
  for (int pass = 0; pass < 3; ++pass) {
    if (pass == 0 && !primary) continue;
    unsigned* qq = pass == 1 ? q + 64 : q;
    const unsigned ntask = pass == 1 ? 2048u : 256u;
    for (;;) {
      __syncthreads();
      if (threadIdx.x == 0) blk[3] = __hip_atomic_fetch_add(qq, 1u, __ATOMIC_RELAXED, __HIP_MEMORY_SCOPE_AGENT);
      __syncthreads();
      const unsigned t = blk[3];
      if (t >= ntask) break;
      if (pass == 1) scan_short(P, smem, l, (int)t); else scan_long(P, smem, l, (int)t);
    }
  }
  if (l + 1 < NLAYER) {
    for (;;) {
      __syncthreads();
      if (threadIdx.x == 0) blk[3] = __hip_atomic_fetch_add(q + 96, 1u, __ATOMIC_RELAXED, __HIP_MEMORY_SCOPE_AGENT);
      __syncthreads();
      const unsigned t = blk[3];
      if (t >= (unsigned)WCONV_JOBS) break;
      wconv_job(P, smem, l + 1, (int)t);
    }
  }
}

__device__ void post_phase(const Params& P, int l) {
  const int lane = otid() & 63, wid = otid() >> 6;
  const bf16_t* p = WSP(bf16_t, OFF_P);
  bf16_t* act = WSP(bf16_t, OFF_ACT);
  const int gw = obid() * 4 + wid, nw = gridDim.x * 4;
  const float gnw = P.in[I_GNW][l * 64 + lane], hnw = P.in[I_HNW][l * 64 + lane];
  for (int u0 = gw * 4; u0 < NTOK * 10; u0 += nw * 4) {
    float o[4], z[4]; int oc[4]; size_t rb[4];
#pragma unroll
    for (int k = 0; k < 4; ++k) {
      const int u = u0 + k, row = u / 10, q = u - row * 10;
      oc[k] = q < 6 ? q * 64 : 768 + (q - 6) * 64;
      const int zc = q < 6 ? 1152 + q * 64 : PC + 768 + (q - 6) * 64;
      rb[k] = (size_t)row;
      o[k] = bf2f(p[(size_t)row * PSTR + oc[k] + lane]);
      z[k] = bf2f(p[(size_t)row * PSTR + zc + lane]);
    }
#pragma unroll
    for (int k = 0; k < 4; ++k) {
      const float ms = wave_sum(o[k] * o[k]) * (1.f / 64.f);
      const float out = o[k] * rsqrtf(ms + 1e-6f) * (oc[k] < 384 ? gnw : hnw) * silu(z[k]);
      act[rb[k] * 1024 + oc[k] + lane] = f2bf(out);
    }
  }
  for (int u0 = gw * 2; u0 < NTOK * 6; u0 += nw * 2) {
    float o[2], r[2], kx[2], v[2], g[2]; int hh[2]; size_t rb[2];
#pragma unroll
    for (int k = 0; k < 2; ++k) {
      const int u = u0 + k, row = u / 6, h = u - row * 6;
      const size_t idx = (size_t)row * 384 + h * 64 + lane;
      hh[k] = h; rb[k] = (size_t)row;
      o[k] = bf2f(p[(size_t)row * PSTR + 384 + h * 64 + lane]);
      r[k] = bf2f(WSP(bf16_t, OFF_RR)[idx]); kx[k] = bf2f(WSP(bf16_t, OFF_RK)[idx]);
      v[k] = bf2f(WSP(bf16_t, OFF_RV)[idx]); g[k] = bf2f(WSP(bf16_t, OFF_RG)[idx]);
    }
#pragma unroll
    for (int k = 0; k < 2; ++k) {
      const int hc = l * 384 + hh[k] * 64 + lane;
      const float mu = wave_sum(o[k]) * (1.f / 64.f);
      const float yc = o[k] - mu;
      const float var = wave_sum(yc * yc) * (1.f / 64.f);
      const float y = yc * rsqrtf(var + 64e-5f) * P.in[I_LNW][hc] + P.in[I_LNB][hc];
      const float rk = wave_sum(r[k] * kx[k] * P.in[I_RK][hc]);
      act[rb[k] * 1024 + 384 + hh[k] * 64 + lane] = f2bf((y + rk * v[k]) * g[k]);
    }
  }
}

#define XB_TMO      128
#define XB_XCNT(j)  (256  + 64 * (j))
#define XB_XSUB(j)  (1280 + 64 * (j))
#define XB_XGEN(j)  (2304 + 64 * (j))
#define XB_TOP      3328
#define XB_TOPGEN   3392
#define XCD_BAR_WORDS 3456
#define XB_SPIN_CAP (1u << 20)
#define LAS __attribute__((address_space(3)))
__device__ __forceinline__ unsigned xb_ld(unsigned* p)              { return __hip_atomic_load(p, __ATOMIC_RELAXED, __HIP_MEMORY_SCOPE_AGENT); }
__device__ __forceinline__ unsigned xb_add(unsigned* p, unsigned v) { return __hip_atomic_fetch_add(p, v, __ATOMIC_RELAXED, __HIP_MEMORY_SCOPE_AGENT); }
__device__ __forceinline__ unsigned xb_xcc_id() { return (unsigned)__builtin_amdgcn_s_getreg((3 << 11) | 20) & 0xFu; }
#define XB_SPIN(cond, bar) do { unsigned _sp = 0; while (cond) { __builtin_amdgcn_s_sleep(1); \
    if ((++_sp & 255u) == 0u) { if (xb_ld(&(bar)[XB_TMO])) break; if (_sp > XB_SPIN_CAP) { atomicAdd(&(bar)[XB_TMO], 1u); break; } } } } while (0)
struct XcdBarrier { unsigned* bar; unsigned x; volatile LAS unsigned* st; };
__device__ __forceinline__ XcdBarrier xcd_barrier_post(unsigned* bar, volatile LAS unsigned* st) {
  XcdBarrier b; b.bar = bar; b.x = xb_xcc_id(); b.st = st;
  if (threadIdx.x == 0) (void)xb_add(&bar[XB_XCNT(b.x)], 1u);
  return b;
}
__device__ __forceinline__ void xcd_barrier_complete(unsigned* bar, unsigned x, unsigned& nloc, unsigned& nx) {
  const unsigned G = gridDim.x * gridDim.y * gridDim.z;
  unsigned sum, cnt, mine, sp = 0u;
  for (;;) {
    sum = 0u; cnt = 0u; mine = 0u;
#pragma unroll
    for (unsigned j = 0; j < 16; ++j) { const unsigned c = xb_ld(&bar[XB_XCNT(j)]); sum += c; cnt += (c > 0u) ? 1u : 0u; mine = (j == x) ? c : mine; }
    if (sum == G) break;
    __builtin_amdgcn_s_sleep(1);
    if ((++sp & 255u) == 0u) { if (xb_ld(&bar[XB_TMO])) break; if (sp > XB_SPIN_CAP) { atomicAdd(&bar[XB_TMO], 1u); break; } }
  }
  nloc = mine > 0u ? mine : 1u; nx = cnt > 0u ? cnt : 1u;
}
__device__ __forceinline__ void xcd_barrier(const XcdBarrier& b) {
  asm volatile("s_waitcnt vmcnt(0)" ::: "memory");
  __syncthreads();
  if (threadIdx.x == 0) {
    unsigned* bar = b.bar;
    __builtin_amdgcn_s_waitcnt(0);
    unsigned nloc = b.st[0], nx = b.st[1];
    if (nloc == 0u) { xcd_barrier_complete(bar, b.x, nloc, nx); b.st[0] = nloc; b.st[1] = nx; }
    const unsigned old = xb_add(&bar[XB_XSUB(b.x)], 1u);
    const unsigned gen = old / nloc;
    if (old + 1u == (gen + 1u) * nloc) {
      __builtin_amdgcn_fence(__ATOMIC_RELEASE, "agent");
      asm volatile("s_waitcnt vmcnt(0)" ::: "memory");
      const unsigned og = xb_add(&bar[XB_TOP], 1u);
      const unsigned tg = og / nx;
      if (og + 1u == (tg + 1u) * nx) xb_add(&bar[XB_TOPGEN], 1u);
      else XB_SPIN(xb_ld(&bar[XB_TOPGEN]) == tg, bar);
      __builtin_amdgcn_fence(__ATOMIC_ACQUIRE, "agent");
      xb_add(&bar[XB_XGEN(b.x)], 1u);
      asm volatile("s_waitcnt vmcnt(0)" ::: "memory");
    } else {
      XB_SPIN(xb_ld(&bar[XB_XGEN(b.x)]) == gen, bar);
      __builtin_amdgcn_fence(__ATOMIC_ACQUIRE, "agent");
      asm volatile("s_waitcnt vmcnt(0)" ::: "memory");
    }
  }
  __syncthreads();
}

__global__ void __launch_bounds__(256, 2) hybrid_fwd(Params P) {
  cg::grid_group grid = cg::this_grid();
  __shared__ __attribute__((aligned(16))) unsigned char smem[65536];
  __shared__ uint4 xb_words;
  if (threadIdx.x == 0) xb_words = make_uint4(0u, 0u, 0u, 0u);
  __syncthreads();
  const XcdBarrier xb = xcd_barrier_post(WSP(unsigned, OFF_BAR), (volatile LAS unsigned*)&xb_words);
  if (threadIdx.x == 0) {
    const unsigned hw = (unsigned)__builtin_amdgcn_s_getreg((7 << 11) | (8 << 6) | 4) & 0xffu;
    const unsigned key = (xb.x << 8) | hw;
    ((volatile unsigned*)&xb_words)[2] = __hip_atomic_fetch_add(WSP(unsigned, OFF_CUTAB) + key, 1u, __ATOMIC_RELAXED, __HIP_MEMORY_SCOPE_AGENT);
  }
  __syncthreads();
#pragma unroll 1
  for (int step = 0; step < NLAYER * 9; ++step) {
    const int l = step / 9, ph = step - l * 9;
    switch (ph) {
      case 0: if (l == 0) wconv_phase(P, smem, 0); norm_phase(P, l, P.in[I_NORM_MIX] + l * D); break;
      case 1: gemm_phase<EPI_P>(P, smem, WSP(bf16_t, OFF_ACT), 1024, WSP(bf16_t, OFF_WTIN), 1024, 32, l);
              gemm_sample<EPI_P>(P, WSP(bf16_t, OFF_ACT), 1024, WSP(bf16_t, OFF_WTIN), 1024, 249, l); break;
      case 2: prep_phase(P, smem, l); break;
      case 3: scan_phase(P, smem, l, (volatile unsigned*)&xb_words); break;
      case 4: post_phase(P, l); break;
      case 5: gemm_phase<EPI_RES>(P, smem, WSP(bf16_t, OFF_ACT), 1024, WSP(bf16_t, wt_out_off(l)), 1024, 8, l);
              gemm_sample<EPI_RES>(P, WSP(bf16_t, OFF_ACT), 1024, WSP(bf16_t, wt_out_off(l)), 1024, 64, l); break;
      case 6: norm_phase(P, 1, P.in[I_NORM_FFN] + l * D); break;
      case 7: gemm_phase<EPI_SWIGLU>(P, smem, WSP(bf16_t, OFF_ACT), 1024, WSP(bf16_t, wt_gu_off(l)), 1024, 44, 1);
              gemm_sample<EPI_SWIGLU>(P, WSP(bf16_t, OFF_ACT), 1024, WSP(bf16_t, wt_gu_off(l)), 1024, 176, 1); break;
      default: gemm_phase<EPI_RES>(P, smem, WSP(bf16_t, OFF_P), DFF, WSP(bf16_t, wt_dn_off(l)), DFF, 8, 1);
               gemm_sample<EPI_RES>(P, WSP(bf16_t, OFF_P), DFF, WSP(bf16_t, wt_dn_off(l)), DFF, 64, 1); break;
    }
    if (step == 0) grid.sync();
    else xcd_barrier(xb);
  }
  final_norm_phase(P);
}

extern "C" void kernel_launch(void* const* d_in, const int* in_sizes, int n_in,
                              void* d_out, int out_size, void* d_ws, size_t ws_size,
                              hipStream_t stream) {
  static int grid_blocks = 0;
  if (!grid_blocks) {
    int dev = 0, cus = 0, per_cu = 0;
    (void)hipGetDevice(&dev);
    (void)hipDeviceGetAttribute(&cus, hipDeviceAttributeMultiprocessorCount, dev);
    (void)hipOccupancyMaxActiveBlocksPerMultiprocessor(&per_cu, hybrid_fwd, 256, 0);
    if (per_cu > 2) per_cu = 2;
    if (per_cu < 1) per_cu = 1;
    grid_blocks = cus * per_cu;
  }
  if (ws_size < WS_NEED) { fprintf(stderr, "workspace too small: %zu < %zu\n", ws_size, (size_t)WS_NEED); return; }
  Params p{};
  for (int i = 0; i < N_IN; ++i) p.in[i] = (const float*)d_in[i];
  p.out = (float*)d_out;
  p.ws = (unsigned char*)d_ws;
  (void)hipMemsetAsync((unsigned char*)d_ws + OFF_BAR, 0, BAR_BYTES, stream);
  void* args[] = {&p};
  hipError_t e = hipLaunchCooperativeKernel((void*)hybrid_fwd, dim3(grid_blocks), dim3(256), args, 0, stream);
  if (e != hipSuccess) fprintf(stderr, "cooperative launch failed: %s (grid %d)\n", hipGetErrorString(e), grid_blocks);
}
```

```cpp
#include <hip/hip_runtime.h>
#include <hip/hip_cooperative_groups.h>
#include <cstdio>
namespace cg = cooperative_groups;

typedef unsigned short bf16_t;
typedef short bf16x8 __attribute__((ext_vector_type(8)));
typedef float f32x4 __attribute__((ext_vector_type(4)));
typedef unsigned u32x4 __attribute__((ext_vector_type(4)));
typedef unsigned u32x2 __attribute__((ext_vector_type(2)));

constexpr int D = 1024, NTP = 16384, NTS = 128, NTOK = 16512, TSEQ = 2048, NLAYER = 4;
constexpr int IN_COLS = 3980, PSTR = 3984, DFF = 2816;
constexpr int PB = 1548, PC = 2956;

enum { I_XP = 0, I_XS, I_SGDN, I_SCONV, I_SRWKV, I_SSHIFT, I_SHGRN, I_NORM_MIX, I_WIN, I_WOUT, I_CONVW, I_ALOG, I_DTB, I_GNW,
       I_MU, I_W0, I_W2, I_A0, I_A2, I_G2, I_V0, I_V1, I_V2, I_KK, I_KA, I_RK, I_LNW, I_LNB, I_HLB, I_HNW, I_NORM_FFN,
       I_WG, I_WU, I_WD, I_NORM_FINAL, N_IN };

constexpr size_t O_YP = 0, O_YS = 16777216, O_GDN_P = 16908288, O_GDN_S = 17694720, O_CONV_P = 30277632, O_CONV_S = 30388224,
                 O_RWKV_P = 32157696, O_RWKV_S = 32944128, O_SHIFT_P = 45527040, O_SHIFT_S = 45572096, O_HGRN_P = 46292992,
                 O_HGRN_S = 46817280;

constexpr size_t SZ_WTIN = (size_t)4096 * 1024 * 2, SZ_WTOUT = (size_t)1024 * 1024 * 2, SZ_WTGU = (size_t)5632 * 1024 * 2,
                 SZ_WTDN = (size_t)1024 * 2816 * 2, SZ_P = (size_t)NTOK * PSTR * 2, SZ_ACT = (size_t)NTOK * 1024 * 2,
                 SZ_T384 = (size_t)NTOK * 384 * 2, SZ_T8F = (size_t)NTOK * 8 * 4, SZ_T256 = (size_t)NTOK * 256 * 2,
                 SZ_T384F = (size_t)NTOK * 384 * 4;
constexpr size_t OFF_WTIN = 0, OFF_WTOUT = OFF_WTIN + SZ_WTIN, OFF_WTGU = OFF_WTOUT + SZ_WTOUT, OFF_WTDN = OFF_WTGU + SZ_WTGU,
                 OFF_P = OFF_WTDN + SZ_WTDN, OFF_ACT = OFF_P + SZ_P, OFF_GQ = OFF_ACT + SZ_ACT, OFF_GK = OFF_GQ + SZ_T384,
                 OFF_GV = OFF_GK + SZ_T384, OFF_GDEC = OFF_GV + SZ_T384, OFF_GBETA = OFF_GDEC + SZ_T8F, OFF_HQ = OFF_GBETA + SZ_T8F,
                 OFF_HK = OFF_HQ + SZ_T256, OFF_RR = OFF_HK + SZ_T256, OFF_RK = OFF_RR + SZ_T384, OFF_RV = OFF_RK + SZ_T384,
                 OFF_RKK = OFF_RV + SZ_T384, OFF_RB = OFF_RKK + SZ_T384, OFF_RG = OFF_RB + SZ_T384, OFF_RW = OFF_RG + SZ_T384,
                 OFF_VF = OFF_RW + SZ_T384F, OFF_LORA = OFF_VF + SZ_T384, OFF_WTOUT2 = OFF_LORA + 245760, OFF_WTGU2 = OFF_WTOUT2 + SZ_WTOUT, OFF_WTDN2 = OFF_WTGU2 + SZ_WTGU, OFF_BAR = OFF_WTDN2 + SZ_WTDN, OFF_CUTAB = OFF_BAR + 16384, OFF_QUEUE = OFF_CUTAB + 16384, BAR_BYTES = 16384 + 16384 + 4096, WS_NEED = OFF_BAR + BAR_BYTES;
constexpr int W2T = 0, A2T = 24576, G2T = 49152, V1T = 98304, V2T = 110592;

struct Params {
  const float* in[N_IN];
  float* out;
  unsigned char* ws;
};

#define WSP(T, off) ((T*)(P.ws + (off)))

__device__ __forceinline__ int otid() { int t = __builtin_amdgcn_workitem_id_x(); asm volatile("" : "+v"(t)); return t; }
__device__ __forceinline__ int obid() { int b = __builtin_amdgcn_workgroup_id_x(); asm volatile("" : "+s"(b)); return b; }
template <class T> __device__ __forceinline__ const T* opq(const T* p) { asm volatile("" : "+s"(p)); return p; }
__device__ __forceinline__ float bf2f(bf16_t h) { return __uint_as_float(((unsigned)h) << 16); }
typedef float f32x2_t __attribute__((ext_vector_type(2)));
typedef __bf16 bf16x2_t __attribute__((ext_vector_type(2)));
__device__ __forceinline__ unsigned pk2(float lo, float hi) {
  const f32x2_t v = {lo, hi};
  return __builtin_bit_cast(unsigned, __builtin_convertvector(v, bf16x2_t));
}
__device__ __forceinline__ bf16_t f2bf(float f) { return (bf16_t)(pk2(f, 0.f) & 0xffffu); }
__device__ __forceinline__ float sigm(float x) { return 1.f / (1.f + __expf(-x)); }
__device__ __forceinline__ float silu(float x) { return x / (1.f + __expf(-x)); }
__device__ __forceinline__ float softplus(float x) { return x > 20.f ? x : log1pf(__expf(x)); }
template <int CTRL> __device__ __forceinline__ float dppf(float x) {
  return __builtin_bit_cast(float, __builtin_amdgcn_mov_dpp(__builtin_bit_cast(int, x), CTRL, 0xf, 0xf, true));
}
__device__ __forceinline__ float wave_sum(float v) {
  v += dppf<0xB1>(v); v += dppf<0x4E>(v); v += dppf<0x141>(v); v += dppf<0x140>(v);
  const int iv = __builtin_bit_cast(int, v);
  const float s0 = __builtin_bit_cast(float, __builtin_amdgcn_readlane(iv, 0)), s1 = __builtin_bit_cast(float, __builtin_amdgcn_readlane(iv, 16));
  const float s2 = __builtin_bit_cast(float, __builtin_amdgcn_readlane(iv, 32)), s3 = __builtin_bit_cast(float, __builtin_amdgcn_readlane(iv, 48));
  return (s0 + s1) + (s2 + s3);
}
__device__ __forceinline__ float reduce8(float x) { x += dppf<0xB1>(x); x += dppf<0x4E>(x); x += dppf<0x141>(x); return x; }

__device__ __forceinline__ f32x4 unpack4(u32x2 w) {
  f32x4 f; f[0] = __uint_as_float(w[0] << 16); f[1] = __uint_as_float(w[0] & 0xffff0000u);
  f[2] = __uint_as_float(w[1] << 16); f[3] = __uint_as_float(w[1] & 0xffff0000u); return f;
}
__device__ __forceinline__ bf16x8 pack8(f32x4 a, f32x4 b) {
  u32x4 u; u[0] = pk2(a[0], a[1]); u[1] = pk2(a[2], a[3]); u[2] = pk2(b[0], b[1]); u[3] = pk2(b[2], b[3]);
  return __builtin_bit_cast(bf16x8, u);
}
__device__ __forceinline__ u32x2 pack4(f32x4 a) { u32x2 u; u[0] = pk2(a[0], a[1]); u[1] = pk2(a[2], a[3]); return u; }
__device__ __forceinline__ const float* xin_row(const Params& P, int l, int row) {
  const float* po = opq((const float*)P.out); const float* pp = opq(P.in[I_XP]); const float* ps = opq(P.in[I_XS]);
  if (l > 0) return po + (size_t)row * D;
  return row < NTP ? pp + (size_t)row * D : ps + (size_t)(row - NTP) * D;
}

__device__ __forceinline__ int gu_row(int c, int up) { return (c >> 7) * 256 + up * 128 + (c & 127); }
__device__ __forceinline__ void xpose_tile(unsigned char* smem, const float* __restrict__ W, int N, int kt, int ntl, bf16_t* __restrict__ dst, int dstK, int mode) {
  float (*tile)[65] = (float (*)[65])smem;
  const int tid = otid();
  __syncthreads();
#pragma unroll 4
  for (int i = 0; i < 8; ++i) {
    const int k = i * 8 + (tid >> 6), n = tid & 63, gn = ntl * 64 + n;
    tile[k][n] = gn < N ? W[(size_t)(kt * 64 + k) * N + gn] : 0.f;
  }
  __syncthreads();
#pragma unroll 4
  for (int i = 0; i < 8; ++i) {
    const int n = i * 8 + (tid >> 6), k = tid & 63, gn = ntl * 64 + n;
    const int drow = mode == 0 ? gn : gu_row(gn, mode - 1);
    dst[(size_t)drow * dstK + kt * 64 + k] = f2bf(tile[k][n]);
  }
}
constexpr int WCONV_JOBS = 3392 + 480;
__device__ __forceinline__ size_t wt_out_off(int l) { return (l & 1) ? OFF_WTOUT2 : OFF_WTOUT; }
__device__ __forceinline__ size_t wt_gu_off(int l) { return (l & 1) ? OFF_WTGU2 : OFF_WTGU; }
__device__ __forceinline__ size_t wt_dn_off(int l) { return (l & 1) ? OFF_WTDN2 : OFF_WTDN; }
__device__ __forceinline__ void wconv_job(const Params& P, unsigned char* smem, int l, int job) {
  if (job < 1024) xpose_tile(smem, P.in[I_WIN] + (size_t)l * 1024 * IN_COLS, IN_COLS, job & 15, job >> 4, WSP(bf16_t, OFF_WTIN), 1024, 0);
  else if (job < 1280) { const int j = job - 1024; xpose_tile(smem, P.in[I_WOUT] + (size_t)l * 1024 * 1024, 1024, j & 15, j >> 4, WSP(bf16_t, wt_out_off(l)), 1024, 0); }
  else if (job < 1984) { const int j = job - 1280; xpose_tile(smem, P.in[I_WG] + (size_t)l * 1024 * DFF, DFF, j & 15, j >> 4, WSP(bf16_t, wt_gu_off(l)), 1024, 1); }
  else if (job < 2688) { const int j = job - 1984; xpose_tile(smem, P.in[I_WU] + (size_t)l * 1024 * DFF, DFF, j & 15, j >> 4, WSP(bf16_t, wt_gu_off(l)), 1024, 2); }
  else if (job < 3392) { const int j = job - 2688; xpose_tile(smem, P.in[I_WD] + (size_t)l * DFF * 1024, 1024, j % 44, j / 44, WSP(bf16_t, wt_dn_off(l)), DFF, 0); }
  else {
    bf16_t* lw = WSP(bf16_t, OFF_LORA);
    const int idx = (job - 3392) * 256 + (otid() & 255);
    float v = 0.f;
    const float* pw2 = opq(P.in[I_W2]); const float* pa2 = opq(P.in[I_A2]); const float* pg2 = opq(P.in[I_G2]);
    const float* pv1 = opq(P.in[I_V1]); const float* pv2 = opq(P.in[I_V2]);
    if (idx < A2T) { const int n = idx >> 6, k = idx & 63; v = pw2[(size_t)l * 64 * 384 + k * 384 + n]; }
    else if (idx < G2T) { const int i = idx - A2T, n = i >> 6, k = i & 63; v = pa2[(size_t)l * 64 * 384 + k * 384 + n]; }
    else if (idx < V1T) { const int i = idx - G2T, n = i >> 7, k = i & 127; v = pg2[(size_t)l * 128 * 384 + k * 384 + n]; }
    else if (idx < V2T) { if (l > 0) { const int i = idx - V1T, n = i / 384, k = i - n * 384; v = pv1[(size_t)(l - 1) * 384 * 32 + k * 32 + n]; } }
    else { if (l > 0) { const int i = idx - V2T, n = i >> 5, k = i & 31; v = pv2[(size_t)(l - 1) * 32 * 384 + k * 384 + n]; } }
    if (otid() < 256) lw[idx] = f2bf(v);
  }
}
__device__ __forceinline__ void wconv_phase(const Params& P, unsigned char* smem, int l) {
  for (int job = obid(); job < WCONV_JOBS; job += gridDim.x) wconv_job(P, smem, l, job);
}

__device__ __forceinline__ void norm_phase(const Params& P, int l_in, const float* __restrict__ w) {
  bf16_t* act = WSP(bf16_t, OFF_ACT);
  const int lane = otid() & 63, wid = otid() >> 6;
  for (int row = obid() * 8 + wid; row < NTOK; row += gridDim.x * 8) {
    const float* xr = xin_row(P, l_in, row);
    f32x4 v[4]; float ss = 0.f;
#pragma unroll
    for (int i = 0; i < 4; ++i) { v[i] = *(const f32x4*)(xr + i * 256 + lane * 4); ss += v[i][0] * v[i][0] + v[i][1] * v[i][1] + v[i][2] * v[i][2] + v[i][3] * v[i][3]; }
    ss = wave_sum(ss);
    const float rstd = rsqrtf(ss * (1.f / 1024.f) + 1e-6f);
#pragma unroll
    for (int i = 0; i < 4; ++i) {
      const f32x4 wv = *(const f32x4*)(w + i * 256 + lane * 4);
      u32x2 o; o[0] = pk2(v[i][0] * rstd * wv[0], v[i][1] * rstd * wv[1]); o[1] = pk2(v[i][2] * rstd * wv[2], v[i][3] * rstd * wv[3]);
      *(u32x2*)(act + (size_t)row * 1024 + i * 256 + lane * 4) = o;
    }
  }
}
__device__ __forceinline__ void final_norm_phase(const Params& P) {
  const float* w = P.in[I_NORM_FINAL];
  const int lane = otid() & 63, wid = otid() >> 6;
  for (int row = obid() * 8 + wid; row < NTOK; row += gridDim.x * 8) {
    float* xr = P.out + (size_t)row * D;
    f32x4 v[4]; float ss = 0.f;
#pragma unroll
    for (int i = 0; i < 4; ++i) { v[i] = *(const f32x4*)(xr + i * 256 + lane * 4); ss += v[i][0] * v[i][0] + v[i][1] * v[i][1] + v[i][2] * v[i][2] + v[i][3] * v[i][3]; }
    ss = wave_sum(ss);
    const float rstd = rsqrtf(ss * (1.f / 1024.f) + 1e-6f);
#pragma unroll
    for (int i = 0; i < 4; ++i) {
      const f32x4 wv = *(const f32x4*)(w + i * 256 + lane * 4);
      f32x4 o; o[0] = v[i][0] * rstd * wv[0]; o[1] = v[i][1] * rstd * wv[1]; o[2] = v[i][2] * rstd * wv[2]; o[3] = v[i][3] * rstd * wv[3];
      *(f32x4*)(xr + i * 256 + lane * 4) = o;
    }
  }
}

enum { EPI_P = 0, EPI_RES = 1, EPI_SWIGLU = 2 };
namespace pg8 {
constexpr int BM = 256, BK = 64, HALF = 128, HTB = HALF * BK * 2, NXCD = 8, WGM = 8;
__device__ __forceinline__ int lds_byte(int r, int c) { const int st = (r >> 4) * 2 + (c >> 5), rr = r & 15, cc = c & 31, ob = rr * 64 + cc * 2; return st * 1024 + (ob ^ (((ob >> 9) & 1) << 5)); }
__device__ __forceinline__ void stage_rc(int b, int& R, int& C) { const int st = b / 1024, sb = b % 1024, swz = sb ^ (((sb >> 9) & 1) << 5); R = (st >> 1) * 16 + swz / 64; C = (st & 1) * 32 + (swz % 64) / 2; }
struct Unit { int pm, pn; };
struct StaticOrder {
  int nM, nN, nwg, G, c;
  __device__ __forceinline__ void init(int M, int N, int G_, int c_) { nM = M / BM; nN = N / BM; nwg = nM * nN; G = G_; c = c_; }
  __device__ __forceinline__ bool next(int i, Unit& u) const {
    const long L = (long)i * G + c; if (L >= nwg) return false;
    int wgid = (int)L; { const int q = nwg / NXCD, r = nwg % NXCD, xcd = wgid % NXCD, off = wgid / NXCD; wgid = (xcd < r ? xcd * (q + 1) : r * (q + 1) + (xcd - r) * q) + off; }
    const int nig = WGM * nN, gid = wgid / nig, fm = gid * WGM, gsz = (nM - fm) < WGM ? (nM - fm) : WGM;
    u.pm = fm + ((wgid % nig) % gsz); u.pn = (wgid % nig) / gsz; return true;
  }
};
}

template <int EPI>
__device__ __forceinline__ void gemm_epilogue(const Params& P, const f32x4 (&acc)[2][2][4][2], const pg8::Unit& u, int wr, int wc, int fr, int fq, int l) {
#pragma unroll
  for (int ai = 0; ai < 2; ++ai)
#pragma unroll
    for (int m = 0; m < 4; ++m) {
      const int row = u.pm * 256 + ai * 128 + wr * 64 + m * 16 + fr;
      if (EPI == EPI_P) {
        bf16_t* pr = WSP(bf16_t, OFF_P) + (size_t)row * PSTR;
#pragma unroll
        for (int bj = 0; bj < 2; ++bj)
#pragma unroll
          for (int n = 0; n < 2; ++n) {
            const int col = u.pn * 256 + bj * 128 + wc * 32 + n * 16 + fq * 4;
            if (col < IN_COLS) *(u32x2*)(pr + col) = pack4(acc[ai][bj][m][n]);
          }
      } else if (EPI == EPI_RES) {
        const float* xi = xin_row(P, l, row);
        float* xo = P.out + (size_t)row * D;
#pragma unroll
        for (int bj = 0; bj < 2; ++bj)
#pragma unroll
          for (int n = 0; n < 2; ++n) {
            const int col = u.pn * 256 + bj * 128 + wc * 32 + n * 16 + fq * 4;
            *(f32x4*)(xo + col) = *(const f32x4*)(xi + col) + acc[ai][bj][m][n];
          }
      } else {
        bf16_t* ur = WSP(bf16_t, OFF_P) + (size_t)row * DFF;
#pragma unroll
        for (int n = 0; n < 2; ++n) {
          const int col = u.pn * 128 + wc * 32 + n * 16 + fq * 4;
          f32x4 r;
#pragma unroll
          for (int j = 0; j < 4; ++j) r[j] = silu(acc[ai][0][m][n][j]) * acc[ai][1][m][n][j];
          *(u32x2*)(ur + col) = pack4(r);
        }
      }
    }
}

#define PG8_LAS __attribute__((address_space(3)))
template <int EPI>
__device__ __forceinline__ void gemm_phase(const Params& P, unsigned char* smem, const bf16_t* __restrict__ Ag, int lda_unused, const bf16_t* __restrict__ Btg, int K, int nN128_unused, int l, int N) {
  using namespace pg8;
  PG8_LAS unsigned char* lds = (PG8_LAS unsigned char*)smem;
  const int tid = otid(), wid = __builtin_amdgcn_readfirstlane(tid >> 6), lane = tid & 63, wr = wid >> 2, wc = wid & 3, fr = lane & 15, fq = lane >> 4;
  const int nt = K / BK;
  StaticOrder S; S.init(NTP, N, (int)gridDim.x, obid());
  unsigned voffA[2], voffB[2];
#pragma unroll
  for (int i = 0; i < 2; ++i) { int R, C; stage_rc(tid * 16 + i * 8192, R, C); voffA[i] = (unsigned)(R * K + C) * 2u; voffB[i] = voffA[i]; }
  const size_t kstep = (size_t)(BK * 2);
  const size_t hstep = (size_t)HALF * K * 2;
  const size_t tstep = 2 * hstep;
  const unsigned ldsw = (unsigned)wid * 1024u;
  const int aoff = lds_byte(wr * 64 + fr, fq * 8), boff = lds_byte(wc * 32 + fr, fq * 8);
#define PG8_SA(b, h) (((b) * 2 + (h)) * HTB)
#define PG8_SB(b, h) ((4 + (b) * 2 + (h)) * HTB)
#define PG8_STAGE(bufoff, gbase, voff) do { _Pragma("unroll") for (int _i = 0; _i < 2; ++_i) \
        __builtin_amdgcn_global_load_lds((const unsigned*)((const char*)(gbase) + (voff)[_i]), (PG8_LAS unsigned*)(lds + (bufoff) + ldsw + _i * 8192), 16, 0, 0); } while (0)
#define PG8_LDA(dst, b, h) do { _Pragma("unroll") for (int m = 0; m < 4; ++m) _Pragma("unroll") for (int k = 0; k < 2; ++k) dst[m][k] = *(const PG8_LAS bf16x8*)(lds + PG8_SA(b, h) + aoff + m * 2048 + k * 1024); } while (0)
#define PG8_LDB(dst, b, h) do { _Pragma("unroll") for (int n = 0; n < 2; ++n) _Pragma("unroll") for (int k = 0; k < 2; ++k) dst[n][k] = *(const PG8_LAS bf16x8*)(lds + PG8_SB(b, h) + boff + n * 2048 + k * 1024); } while (0)
#define PG8_MMA(ai, bj, At, Bt) do { __builtin_amdgcn_s_setprio(1); _Pragma("unroll") for (int m = 0; m < 4; ++m) _Pragma("unroll") for (int n = 0; n < 2; ++n) _Pragma("unroll") for (int k = 0; k < 2; ++k) \
        acc[ai][bj][m][n] = __builtin_amdgcn_mfma_f32_16x16x32_bf16(Bt[n][k], At[m][k], acc[ai][bj][m][n], 0, 0, 0); __builtin_amdgcn_s_setprio(0); } while (0)
#define PG8_WAIT_V(n) asm volatile("s_waitcnt vmcnt(" #n ")" ::: "memory")
#define PG8_WAIT_L(n) asm volatile("s_waitcnt lgkmcnt(" #n ")" ::: "memory")
#define PG8_BAR __builtin_amdgcn_s_barrier()
#define PG8_SCHED __builtin_amdgcn_sched_barrier(0)
  Unit cur, nxt; int ui = 0;
  if (!S.next(0, cur)) return;
  f32x4 acc[2][2][4][2];
#pragma unroll
  for (int a = 0; a < 2; ++a)
#pragma unroll
    for (int b = 0; b < 2; ++b)
#pragma unroll
      for (int m = 0; m < 4; ++m)
#pragma unroll
        for (int n = 0; n < 2; ++n) acc[a][b][m][n] = (f32x4){0.f, 0.f, 0.f, 0.f};
  bf16x8 At[4][2], B0[2][2], B1[2][2];
  const char* cA = (const char*)Ag + (size_t)cur.pm * tstep; const char* cB = (const char*)Btg + (size_t)cur.pn * tstep;
  PG8_STAGE(PG8_SB(0, 0), cB, voffB); PG8_STAGE(PG8_SA(0, 0), cA, voffA); PG8_STAGE(PG8_SB(0, 1), cB + hstep, voffB); PG8_STAGE(PG8_SA(0, 1), cA + hstep, voffA);
  if (wr == 1) PG8_BAR;
  PG8_WAIT_V(4); PG8_BAR;
  PG8_STAGE(PG8_SB(1, 0), cB + kstep, voffB); PG8_STAGE(PG8_SA(1, 0), cA + kstep, voffA); PG8_STAGE(PG8_SB(1, 1), cB + hstep + kstep, voffB);
  PG8_WAIT_V(6); PG8_BAR;
  for (;;) {
    const bool has_next = S.next(ui + 1, nxt);
    const char* nA = has_next ? (const char*)Ag + (size_t)nxt.pm * tstep : cA; const char* nB = has_next ? (const char*)Btg + (size_t)nxt.pn * tstep : cB;
    for (int t = 0; t < nt; t += 2) {
      const bool last = (t == nt - 2);
      const char* a1 = cA + (size_t)(t + 1) * kstep;
      const char* a2 = last ? nA : cA + (size_t)(t + 2) * kstep; const char* b2 = last ? nB : cB + (size_t)(t + 2) * kstep;
      const char* a3 = a2 + kstep; const char* b3 = b2 + kstep;
      PG8_LDB(B0, 0, 0); PG8_SCHED; PG8_LDA(At, 0, 0); PG8_STAGE(PG8_SA(1, 1), a1 + hstep, voffA);
      PG8_WAIT_L(8); PG8_BAR; PG8_WAIT_L(0); PG8_MMA(0, 0, At, B0); PG8_BAR; PG8_SCHED;
      PG8_LDB(B1, 0, 1); PG8_STAGE(PG8_SB(0, 0), b2, voffB);
      PG8_BAR; PG8_WAIT_L(0); PG8_MMA(0, 1, At, B1); PG8_BAR;
      PG8_LDA(At, 0, 1); PG8_STAGE(PG8_SA(0, 0), a2, voffA);
      PG8_BAR; PG8_WAIT_L(0); PG8_MMA(1, 0, At, B0); PG8_BAR; PG8_SCHED;
      PG8_STAGE(PG8_SB(0, 1), b2 + hstep, voffB);
      PG8_WAIT_V(6); PG8_BAR; PG8_MMA(1, 1, At, B1); PG8_BAR;
      PG8_LDB(B0, 1, 0); PG8_SCHED; PG8_LDA(At, 1, 0); PG8_STAGE(PG8_SA(0, 1), a2 + hstep, voffA);
      PG8_WAIT_L(8); PG8_BAR; PG8_WAIT_L(0); PG8_MMA(0, 0, At, B0); PG8_BAR; PG8_SCHED;
      PG8_LDB(B1, 1, 1); PG8_STAGE(PG8_SB(1, 0), b3, voffB);
      PG8_BAR; PG8_WAIT_L(0); PG8_MMA(0, 1, At, B1); PG8_BAR;
      PG8_LDA(At, 1, 1); PG8_STAGE(PG8_SA(1, 0), a3, voffA);
      PG8_BAR; PG8_WAIT_L(0); PG8_MMA(1, 0, At, B0); PG8_BAR; PG8_SCHED;
      PG8_STAGE(PG8_SB(1, 1), b3 + hstep, voffB);
      PG8_WAIT_V(6); PG8_BAR; PG8_MMA(1, 1, At, B1); PG8_BAR;
    }
    gemm_epilogue<EPI>(P, acc, cur, wr, wc, fr, fq, l);
    if (!has_next) break;
#pragma unroll
    for (int a = 0; a < 2; ++a)
#pragma unroll
      for (int b = 0; b < 2; ++b)
#pragma unroll
        for (int m = 0; m < 4; ++m)
#pragma unroll
          for (int n = 0; n < 2; ++n) acc[a][b][m][n] = (f32x4){0.f, 0.f, 0.f, 0.f};
    cur = nxt; cA = nA; cB = nB; ++ui;
  }
  PG8_WAIT_V(0);
  if (wr == 0) PG8_BAR;
  PG8_BAR;
#undef PG8_SA
#undef PG8_SB
#undef PG8_STAGE
#undef PG8_LDA
#undef PG8_LDB
#undef PG8_MMA
#undef PG8_WAIT_V
#undef PG8_WAIT_L
#undef PG8_BAR
#undef PG8_SCHED
}

template <int EPI>
__device__ __forceinline__ void gemm_sample(const Params& P, const bf16_t* __restrict__ A, int lda, const bf16_t* __restrict__ Bt, int K, int nunits, int l) {
  const int tid = otid(), lane = tid & 63, wid = tid >> 6, fr = lane & 15, fq = lane >> 4;
  for (int u = (int)gridDim.x - 1 - obid(); u < nunits; u += gridDim.x) {
    const int brow0 = EPI == EPI_SWIGLU ? gu_row(u * 16 + fr, 0) : u * 16 + fr;
    const int brow1 = EPI == EPI_SWIGLU ? gu_row(u * 16 + fr, 1) : 0;
    const bf16_t* a0p = A + (size_t)(NTP + wid * 16 + fr) * lda + fq * 8;
    const bf16_t* b0p = Bt + (size_t)brow0 * K + fq * 8;
    const bf16_t* b1p = Bt + (size_t)brow1 * K + fq * 8;
    f32x4 c00 = (f32x4){0.f, 0.f, 0.f, 0.f}, c01 = c00;
#pragma unroll 8
    for (int ks = 0; ks < K; ks += 32) {
      const bf16x8 A0 = *(const bf16x8*)(a0p + ks), B0 = *(const bf16x8*)(b0p + ks);
      c00 = __builtin_amdgcn_mfma_f32_16x16x32_bf16(B0, A0, c00, 0, 0, 0);
      if (EPI == EPI_SWIGLU) {
        const bf16x8 B1 = *(const bf16x8*)(b1p + ks);
        c01 = __builtin_amdgcn_mfma_f32_16x16x32_bf16(B1, A0, c01, 0, 0, 0);
      }
    }
    {
      const int row = NTP + wid * 16 + fr, col = u * 16 + fq * 4;
      const f32x4 g = c00, up = c01;
      if (EPI == EPI_P) {
        if (col < IN_COLS) *(u32x2*)(WSP(bf16_t, OFF_P) + (size_t)row * PSTR + col) = pack4(g);
      } else if (EPI == EPI_RES) {
        const float* xi = xin_row(P, l, row);
        *(f32x4*)(P.out + (size_t)row * D + col) = *(const f32x4*)(xi + col) + g;
      } else {
        f32x4 r;
#pragma unroll
        for (int j = 0; j < 4; ++j) r[j] = silu(g[j]) * up[j];
        *(u32x2*)(WSP(bf16_t, OFF_P) + (size_t)row * DFF + col) = pack4(r);
      }
    }
  }
}

__device__ __forceinline__ float lbval(const Params& P, int l, int c) {
  const float* hb = P.in[I_HLB];
  const float a0 = hb[c], a1 = hb[256 + c], a2 = hb[512 + c], a3 = hb[768 + c];
  const float m = fmaxf(fmaxf(a0, a1), fmaxf(a2, a3));
  const float e0 = __expf(a0 - m), e1 = __expf(a1 - m), e2 = __expf(a2 - m), e3 = __expf(a3 - m);
  const float inv = 1.f / (e0 + e1 + e2 + e3);
  float s = 0.f;
  if (l >= 1) s += e1; if (l >= 2) s += e2; if (l >= 3) s += e3;
  return s * inv;
}

__device__ __forceinline__ void gdn_conv_emit(const Params& P, int g, int lane, int row, float s) {
  const int h = g % 6;
  if (g < 12) {
    const float ss = wave_sum(s * s);
    const float o = s * rsqrtf(ss + 1e-6f) * (g < 6 ? 0.125f : 1.f);
    (g < 6 ? WSP(bf16_t, OFF_GQ) : WSP(bf16_t, OFF_GK))[(size_t)row * 384 + h * 64 + lane] = f2bf(o);
  } else {
    WSP(bf16_t, OFF_GV)[(size_t)row * 384 + h * 64 + lane] = f2bf(s);
  }
}
__device__ __forceinline__ void gdn_gate_emit(const Params& P, int l, int h, int row) {
  const bf16_t* pr = WSP(bf16_t, OFF_P) + (size_t)row * PSTR;
  const float braw = bf2f(pr[1536 + h]), araw = bf2f(pr[1542 + h]);
  const float gg = -__expf(P.in[I_ALOG][l * 6 + h]) * softplus(araw + P.in[I_DTB][l * 6 + h]);
  WSP(float, OFF_GDEC)[(size_t)row * 8 + h] = __expf(gg);
  WSP(float, OFF_GBETA)[(size_t)row * 8 + h] = sigm(braw);
}
__device__ __forceinline__ void prep_gdn_prompt(const Params& P, int l, int ci) {
  const int lane = otid() & 63, wid = otid() >> 6;
  const int r0 = ci * 32, b = r0 / TSEQ, t0 = r0 % TSEQ;
  const bf16_t* p = WSP(bf16_t, OFF_P);
  for (int g = wid; g < 18; g += 8) {
    const int col = g * 64 + lane;
    const float* cw = P.in[I_CONVW] + (size_t)l * 4 * 1152 + col;
    const float c0 = cw[0], c1 = cw[1152], c2 = cw[2304], c3 = cw[3456];
    float xr[35];
#pragma unroll
    for (int t = 0; t < 35; ++t) xr[t] = (t >= 3 || t0 > 0) ? bf2f(p[(size_t)(r0 - 3 + t) * PSTR + col]) : 0.f;
#pragma unroll
    for (int t = 0; t < 32; ++t) {
      const float y = c0 * xr[t] + c1 * xr[t + 1] + c2 * xr[t + 2] + c3 * xr[t + 3];
      gdn_conv_emit(P, g, lane, r0 + t, silu(y));
    }
    if (t0 + 32 == TSEQ) {
      float* cp = P.out + O_CONV_P + (size_t)(l * 8 + b) * 3 * 1152 + col;
      cp[0] = xr[32]; cp[1152] = xr[33]; cp[2304] = xr[34];
    }
    if (g < 6 && lane < 32) gdn_gate_emit(P, l, g, r0 + lane);
  }
}
__device__ __forceinline__ void prep_gdn_sample(const Params& P, int l, int si) {
  const int lane = otid() & 63, wid = otid() >> 6;
  const bf16_t* p = WSP(bf16_t, OFF_P);
  for (int u = wid; u < 8 * 18; u += 8) {
    const int s = si * 8 + u / 18, g = u % 18, col = g * 64 + lane, row = NTP + s;
    const float* cw = P.in[I_CONVW] + (size_t)l * 4 * 1152 + col;
    const float c0 = cw[0], c1 = cw[1152], c2 = cw[2304], c3 = cw[3456];
    const float* cb = P.in[I_SCONV] + (size_t)(l * 128 + s) * 3 * 1152 + col;
    const float x3 = cb[0], x2 = cb[1152], x1 = cb[2304];
    const float x0 = bf2f(p[(size_t)row * PSTR + col]);
    const float y = c0 * x3 + c1 * x2 + c2 * x1 + c3 * x0;
    gdn_conv_emit(P, g, lane, row, silu(y));
    float* cp = P.out + O_CONV_S + (size_t)(l * 128 + s) * 3 * 1152 + col;
    cp[0] = x2; cp[1152] = x1; cp[2304] = x0;
    if (g < 6 && lane == 0) gdn_gate_emit(P, l, g, row);
  }
}
__device__ __forceinline__ void prep_hgrn(const Params& P, int l, int ti) {
  const int c = otid() & 255, th = otid() >> 8;
  const float oml = 1.f - lbval(P, l, c);
  const bf16_t* p = WSP(bf16_t, OFF_P);
  bf16_t* hq = WSP(bf16_t, OFF_HQ); bf16_t* hk = WSP(bf16_t, OFF_HK);
  for (int t = th * 32; t < th * 32 + 32; ++t) {
    const int row = ti * 64 + t;
    const float q = bf2f(p[(size_t)row * PSTR + PC + c]), f = bf2f(p[(size_t)row * PSTR + PC + 256 + c]);
    hq[(size_t)row * 256 + c] = f2bf(silu(q) * 0.125f);
    hk[(size_t)row * 256 + c] = f2bf(oml * sigm(-f));
  }
}
__device__ __forceinline__ f32x4 xs4(const Params& P, int l, int row, int col0) {
  const bf16_t* p = WSP(bf16_t, OFF_P);
  const f32x4 pv = unpack4(*(const u32x2*)(p + (size_t)row * PSTR + PB + col0));
  f32x4 prev = (f32x4){0.f, 0.f, 0.f, 0.f};
  if (row >= NTP) prev = *(const f32x4*)(P.in[I_SSHIFT] + (size_t)(l * 128 + (row - NTP)) * 1408 + col0);
  else if ((row & (TSEQ - 1)) != 0) prev = unpack4(*(const u32x2*)(p + (size_t)(row - 1) * PSTR + PB + col0));
  const f32x4 mu = *(const f32x4*)(P.in[I_MU] + l * 1408 + col0);
  return pv + (prev - pv) * mu;
}
__device__ __forceinline__ float tanh_fast(float x) { return 1.f - 2.f / (__expf(2.f * x) + 1.f); }

__device__ __forceinline__ void prep_rwkv_unit(const Params& P, int l, int mt, int hh) {
  const int lane = otid() & 63, fr = lane & 15, fq = lane >> 4;
  const int row = mt * 16 + fr, cb = hh * 192;
  const bf16_t* lw = WSP(bf16_t, OFF_LORA);
  const size_t ro = (size_t)row * 384;
  f32x4 acc[12];
#pragma unroll
  for (int nf = 0; nf < 12; ++nf) acc[nf] = (f32x4){0.f, 0.f, 0.f, 0.f};
#pragma unroll
  for (int ks = 0; ks < 2; ++ks) {
    f32x4 x0 = xs4(P, l, row, 1152 + ks * 32 + fq * 8), x1 = xs4(P, l, row, 1152 + ks * 32 + fq * 8 + 4);
#pragma unroll
    for (int j = 0; j < 4; ++j) { x0[j] = tanh_fast(x0[j]); x1[j] = tanh_fast(x1[j]); }
    const bf16x8 A = pack8(x0, x1);
#pragma unroll
    for (int nf = 0; nf < 12; ++nf) {
      const bf16x8 B = *(const bf16x8*)(lw + W2T + (cb + nf * 16 + fr) * 64 + ks * 32 + fq * 8);
      acc[nf] = __builtin_amdgcn_mfma_f32_16x16x32_bf16(B, A, acc[nf], 0, 0, 0);
    }
  }
#pragma unroll
  for (int nf = 0; nf < 12; ++nf) {
    const int c = cb + nf * 16 + fq * 4;
    const f32x4 w0 = *(const f32x4*)(P.in[I_W0] + l * 384 + c);
    f32x4 d;
#pragma unroll
    for (int j = 0; j < 4; ++j) {
      const float x = -(w0[j] + acc[nf][j]);
      const float sp = x > 15.f ? x : __logf(1.f + __expf(x));
      d[j] = __expf(-__expf(-sp - 0.5f));
    }
    *(f32x4*)(WSP(float, OFF_RW) + ro + c) = d;
  }
#pragma unroll
  for (int nf = 0; nf < 12; ++nf) acc[nf] = (f32x4){0.f, 0.f, 0.f, 0.f};
#pragma unroll
  for (int ks = 0; ks < 2; ++ks) {
    const bf16x8 A = pack8(xs4(P, l, row, 1216 + ks * 32 + fq * 8), xs4(P, l, row, 1216 + ks * 32 + fq * 8 + 4));
#pragma unroll
    for (int nf = 0; nf < 12; ++nf) {
      const bf16x8 B = *(const bf16x8*)(lw + A2T + (cb + nf * 16 + fr) * 64 + ks * 32 + fq * 8);
      acc[nf] = __builtin_amdgcn_mfma_f32_16x16x32_bf16(B, A, acc[nf], 0, 0, 0);
    }
  }
#pragma unroll
  for (int hl = 0; hl < 3; ++hl) {
    f32x4 kr[4], kkr[4];
    float ss = 0.f;
#pragma unroll
    for (int q = 0; q < 4; ++q) {
      const int c = cb + (hl * 4 + q) * 16 + fq * 4;
      kr[q] = xs4(P, l, row, 384 + c);
      kkr[q] = kr[q] * *(const f32x4*)(P.in[I_KK] + l * 384 + c);
      ss += kkr[q][0] * kkr[q][0] + kkr[q][1] * kkr[q][1] + kkr[q][2] * kkr[q][2] + kkr[q][3] * kkr[q][3];
    }
    ss += __shfl_xor(ss, 16); ss += __shfl_xor(ss, 32);
    const float rn = rsqrtf(ss + 1e-6f);
#pragma unroll
    for (int q = 0; q < 4; ++q) {
      const int nf = hl * 4 + q, c = cb + nf * 16 + fq * 4;
      const f32x4 a0 = *(const f32x4*)(P.in[I_A0] + l * 384 + c), ka = *(const f32x4*)(P.in[I_KA] + l * 384 + c);
      f32x4 kn, kk, kb;
#pragma unroll
      for (int j = 0; j < 4; ++j) {
        const float a = sigm(a0[j] + acc[nf][j]);
        kk[j] = kkr[q][j] * rn; kb[j] = kk[j] * a; kn[j] = kr[q][j] * (1.f + (a - 1.f) * ka[j]);
      }
      *(u32x2*)(WSP(bf16_t, OFF_RK) + ro + c) = pack4(kn);
      *(u32x2*)(WSP(bf16_t, OFF_RKK) + ro + c) = pack4(kk);
      *(u32x2*)(WSP(bf16_t, OFF_RB) + ro + c) = pack4(kb);
      *(u32x2*)(WSP(bf16_t, OFF_RR) + ro + c) = pack4(xs4(P, l, row, c));
    }
  }
#pragma unroll
  for (int nf = 0; nf < 12; ++nf) acc[nf] = (f32x4){0.f, 0.f, 0.f, 0.f};
#pragma unroll
  for (int ks = 0; ks < 4; ++ks) {
    f32x4 x0 = xs4(P, l, row, 1280 + ks * 32 + fq * 8), x1 = xs4(P, l, row, 1280 + ks * 32 + fq * 8 + 4);
#pragma unroll
    for (int j = 0; j < 4; ++j) { x0[j] = sigm(x0[j]); x1[j] = sigm(x1[j]); }
    const bf16x8 A = pack8(x0, x1);
#pragma unroll
    for (int nf = 0; nf < 12; ++nf) {
      const bf16x8 B = *(const bf16x8*)(lw + G2T + (cb + nf * 16 + fr) * 128 + ks * 32 + fq * 8);
      acc[nf] = __builtin_amdgcn_mfma_f32_16x16x32_bf16(B, A, acc[nf], 0, 0, 0);
    }
  }
#pragma unroll
  for (int nf = 0; nf < 12; ++nf) *(u32x2*)(WSP(bf16_t, OFF_RG) + ro + cb + nf * 16 + fq * 4) = pack4(acc[nf]);
  if (l == 0) {
#pragma unroll
    for (int nf = 0; nf < 12; ++nf) {
      const int c = cb + nf * 16 + fq * 4;
      const u32x2 o = pack4(xs4(P, l, row, 768 + c));
      *(u32x2*)(WSP(bf16_t, OFF_RV) + ro + c) = o;
      *(u32x2*)(WSP(bf16_t, OFF_VF) + ro + c) = o;
    }
  } else {
    f32x4 lo0 = (f32x4){0.f, 0.f, 0.f, 0.f}, lo1 = lo0;
#pragma unroll 4
    for (int ks = 0; ks < 12; ++ks) {
      const bf16x8 A = pack8(xs4(P, l, row, 768 + ks * 32 + fq * 8), xs4(P, l, row, 768 + ks * 32 + fq * 8 + 4));
      const bf16x8 B0 = *(const bf16x8*)(lw + V1T + fr * 384 + ks * 32 + fq * 8);
      const bf16x8 B1 = *(const bf16x8*)(lw + V1T + (16 + fr) * 384 + ks * 32 + fq * 8);
      lo0 = __builtin_amdgcn_mfma_f32_16x16x32_bf16(B0, A, lo0, 0, 0, 0);
      lo1 = __builtin_amdgcn_mfma_f32_16x16x32_bf16(B1, A, lo1, 0, 0, 0);
    }
    const bf16x8 A2 = pack8(lo0, lo1);
#pragma unroll
    for (int nf = 0; nf < 12; ++nf) {
      const int c = cb + nf * 16 + fq * 4;
      const bf16_t* vr = lw + V2T + (cb + nf * 16 + fr) * 32;
      u32x4 bw; { const u32x2 b0 = *(const u32x2*)(vr + fq * 4), b1 = *(const u32x2*)(vr + 16 + fq * 4); bw[0] = b0[0]; bw[1] = b0[1]; bw[2] = b1[0]; bw[3] = b1[1]; }
      const f32x4 mv = __builtin_amdgcn_mfma_f32_16x16x32_bf16(__builtin_bit_cast(bf16x8, bw), A2, (f32x4){0.f, 0.f, 0.f, 0.f}, 0, 0, 0);
      const f32x4 v0 = *(const f32x4*)(P.in[I_V0] + (l - 1) * 384 + c);
      const f32x4 v = xs4(P, l, row, 768 + c), vf = unpack4(*(const u32x2*)(WSP(bf16_t, OFF_VF) + ro + c));
      f32x4 o;
#pragma unroll
      for (int j = 0; j < 4; ++j) o[j] = v[j] + (vf[j] - v[j]) * sigm(v0[j] + mv[j]);
      *(u32x2*)(WSP(bf16_t, OFF_RV) + ro + c) = pack4(o);
    }
  }
}
__device__ __forceinline__ void prep_phase(const Params& P, unsigned char* smem, int l) {
  for (int it = obid(); it < 1044; it += gridDim.x) {
    if (it < 258) { const int wid = otid() >> 6; prep_rwkv_unit(P, l, it * 4 + (wid >> 1), wid & 1); }
    else if (it < 770) prep_gdn_prompt(P, l, it - 258);
    else if (it < 786) prep_gdn_sample(P, l, it - 770);
    else prep_hgrn(P, l, it - 786);
  }
  const bf16_t* p = WSP(bf16_t, OFF_P);
  for (int idx = obid() * 512 + otid(); idx < 136 * 1408; idx += gridDim.x * 512) {
    const int q = idx / 1408, col = idx - q * 1408;
    if (q < 8) P.out[O_SHIFT_P + (size_t)(l * 8 + q) * 1408 + col] = bf2f(p[(size_t)(q * TSEQ + TSEQ - 1) * PSTR + PB + col]);
    else P.out[O_SHIFT_S + (size_t)(l * 128 + (q - 8)) * 1408 + col] = bf2f(p[(size_t)(NTP + q - 8) * PSTR + PB + col]);
  }
}

template <int KIND> struct ScanCfg { static constexpr int STRIDE = KIND == 1 ? 356 : 164; };
typedef float f32x2 __attribute__((ext_vector_type(2)));
__device__ __forceinline__ float row_sum16(float v) { v += dppf<0xB1>(v); v += dppf<0x4E>(v); v += dppf<0x141>(v); v += dppf<0x140>(v); return v; }
__device__ __forceinline__ float dot4(f32x4 a, f32x4 b) { return (a[0] * b[0] + a[1] * b[1]) + (a[2] * b[2] + a[3] * b[3]); }

template <int KIND> struct ScanPre { u32x2 a, b, c, d, v; f32x4 w; float g; };

template <int KIND>
__device__ __forceinline__ void scan_load(const Params& P, ScanPre<KIND>& r, int tid, int h, int half, int rowbase, int nvalid) {
  const int s = tid >> 4, j4 = (tid & 15) * 4;
  const int s2 = (tid >> 3) & 15, j2 = (tid & 7) * 4;
  const u32x2 z2 = {0u, 0u};
  const bool ok = s < nvalid, ok2 = (tid < 128) && (s2 < nvalid);
  if (KIND == 0) {
    const size_t o = (size_t)(rowbase + s) * 384 + h * 64 + j4;
    r.a = ok ? *(const u32x2*)(WSP(bf16_t, OFF_GK) + o) : z2;
    r.b = ok ? *(const u32x2*)(WSP(bf16_t, OFF_GQ) + o) : z2;
    r.v = ok2 ? *(const u32x2*)(WSP(bf16_t, OFF_GV) + (size_t)(rowbase + s2) * 384 + h * 64 + half * 32 + j2) : z2;
    const int sg = (tid >> 1) & 15;
    r.g = (tid < 32 && sg < nvalid) ? ((tid & 1) ? WSP(float, OFF_GBETA) : WSP(float, OFF_GDEC))[(size_t)(rowbase + sg) * 8 + h] : 0.f;
  } else if (KIND == 1) {
    const size_t o = (size_t)(rowbase + s) * 384 + h * 64 + j4;
    r.a = ok ? *(const u32x2*)(WSP(bf16_t, OFF_RR) + o) : z2;
    r.w = ok ? *(const f32x4*)(WSP(float, OFF_RW) + o) : (f32x4){0.f, 0.f, 0.f, 0.f};
    r.b = ok ? *(const u32x2*)(WSP(bf16_t, OFF_RK) + o) : z2;
    r.c = ok ? *(const u32x2*)(WSP(bf16_t, OFF_RKK) + o) : z2;
    r.d = ok ? *(const u32x2*)(WSP(bf16_t, OFF_RB) + o) : z2;
    r.v = ok2 ? *(const u32x2*)(WSP(bf16_t, OFF_RV) + (size_t)(rowbase + s2) * 384 + h * 64 + half * 32 + j2) : z2;
  } else {
    const size_t o = (size_t)(rowbase + s) * 256 + h * 64 + j4;
    r.a = ok ? *(const u32x2*)(WSP(bf16_t, OFF_HQ) + o) : z2;
    r.b = ok ? *(const u32x2*)(WSP(bf16_t, OFF_HK) + o) : z2;
    r.v = ok2 ? *(const u32x2*)(WSP(bf16_t, OFF_P) + (size_t)(rowbase + s2) * PSTR + PC + 512 + h * 64 + half * 32 + j2) : z2;
  }
}
template <int KIND>
__device__ __forceinline__ void scan_store(const ScanPre<KIND>& r, int tid, float* buf) {
  constexpr int STRIDE = ScanCfg<KIND>::STRIDE;
  const int s = tid >> 4, j4 = (tid & 15) * 4;
  const int s2 = (tid >> 3) & 15, j2 = (tid & 7) * 4;
  float* bs = buf + s * STRIDE + j4;
  if (KIND == 0) {
    const f32x4 k = unpack4(r.a), q = unpack4(r.b);
    *(f32x4*)(bs) = k; *(f32x4*)(bs + 64) = q;
    const float qk = row_sum16(dot4(q, k));
    if ((tid & 15) == 0) buf[s * STRIDE + 162] = qk;
    if (tid < 128) *(f32x4*)(buf + s2 * STRIDE + 128 + j2) = unpack4(r.v);
    if (tid < 32) buf[((tid >> 1) & 15) * STRIDE + 160 + (tid & 1)] = r.g;
  } else if (KIND == 1) {
    const f32x4 rr = unpack4(r.a), k = unpack4(r.b), kk = unpack4(r.c), bb = unpack4(r.d);
    *(f32x4*)(bs) = r.w * rr; *(f32x4*)(bs + 64) = r.w; *(f32x4*)(bs + 128) = k;
    *(f32x4*)(bs + 192) = kk; *(f32x4*)(bs + 256) = bb;
    const float br = row_sum16(dot4(bb, rr)), kr = row_sum16(dot4(k, rr));
    if ((tid & 15) == 0) { buf[s * STRIDE + 352] = br; buf[s * STRIDE + 353] = kr; }
    if (tid < 128) *(f32x4*)(buf + s2 * STRIDE + 320 + j2) = unpack4(r.v);
  } else {
    const f32x4 q = unpack4(r.a), k = unpack4(r.b);
    *(f32x4*)(bs) = q * (1.f - k); *(f32x4*)(bs + 64) = k;
    const float qk = row_sum16(dot4(q, k));
    if ((tid & 15) == 0) buf[s * STRIDE + 160] = qk;
    if (tid < 128) *(f32x4*)(buf + s2 * STRIDE + 128 + j2) = unpack4(r.v);
  }
}

template <int KIND> struct StepOps { f32x2 a[4], b[4], c[4], d[4], e[4]; float v, s0, s1, s2; };
template <int KIND>
__device__ __forceinline__ void step_load(StepOps<KIND>& o, const float* bs, int e0, int cl) {
#define LD8(dst, off) { const f32x4 _x = *(const f32x4*)(bs + (off) + e0), _y = *(const f32x4*)(bs + (off) + e0 + 4); \
    dst[0] = (f32x2){_x[0], _x[1]}; dst[1] = (f32x2){_x[2], _x[3]}; dst[2] = (f32x2){_y[0], _y[1]}; dst[3] = (f32x2){_y[2], _y[3]}; }
  if (KIND == 0) {
    LD8(o.a, 0) LD8(o.b, 64)
    o.v = bs[128 + cl];
    const f32x4 sc = *(const f32x4*)(bs + 160); o.s0 = sc[0]; o.s1 = sc[1]; o.s2 = sc[2];
  } else if (KIND == 1) {
    LD8(o.a, 0) LD8(o.b, 64) LD8(o.c, 128) LD8(o.d, 192) LD8(o.e, 256)
    o.v = bs[320 + cl];
    const f32x2 sc = *(const f32x2*)(bs + 352); o.s0 = sc[0]; o.s1 = sc[1];
  } else {
    LD8(o.a, 0) LD8(o.b, 64)
    o.v = bs[128 + cl]; o.s0 = bs[160];
  }
#undef LD8
}
template <int KIND>
__device__ __forceinline__ float step_compute(const StepOps<KIND>& o, f32x2 (&S)[4]) {
  if (KIND == 0) {
    f32x2 ks2 = o.a[0] * S[0], qs2 = o.b[0] * S[0];
#pragma unroll
    for (int i = 1; i < 4; ++i) { ks2 += o.a[i] * S[i]; qs2 += o.b[i] * S[i]; }
    float ks = ks2[0] + ks2[1], qs = qs2[0] + qs2[1];
    ks += dppf<0xB1>(ks); qs += dppf<0xB1>(qs); ks += dppf<0x4E>(ks); qs += dppf<0x4E>(qs); ks += dppf<0x141>(ks); qs += dppf<0x141>(qs);
    const float dec = o.s0, vn = o.s1 * (o.v - dec * ks);
#pragma unroll
    for (int i = 0; i < 4; ++i) S[i] = S[i] * dec + o.a[i] * vn;
    return dec * qs + vn * o.s2;
  } else if (KIND == 1) {
    f32x2 sa2 = o.d[0] * S[0], p2 = o.a[0] * S[0];
#pragma unroll
    for (int i = 1; i < 4; ++i) { sa2 += o.d[i] * S[i]; p2 += o.a[i] * S[i]; }
    float sa = sa2[0] + sa2[1], p1 = p2[0] + p2[1];
    sa += dppf<0xB1>(sa); p1 += dppf<0xB1>(p1); sa += dppf<0x4E>(sa); p1 += dppf<0x4E>(p1); sa += dppf<0x141>(sa); p1 += dppf<0x141>(p1);
    sa = -sa;
#pragma unroll
    for (int i = 0; i < 4; ++i) S[i] = S[i] * o.b[i] + (o.e[i] * sa + o.c[i] * o.v);
    return p1 + sa * o.s0 + o.v * o.s1;
  } else {
    f32x2 p2 = o.a[0] * S[0];
#pragma unroll
    for (int i = 1; i < 4; ++i) p2 += o.a[i] * S[i];
    float p1 = p2[0] + p2[1];
    p1 += dppf<0xB1>(p1); p1 += dppf<0x4E>(p1); p1 += dppf<0x141>(p1);
#pragma unroll
    for (int i = 0; i < 4; ++i) S[i] = S[i] + o.b[i] * (o.v - S[i]);
    return p1 + o.v * o.s0;
  }
}

template <int KIND>
__device__ __forceinline__ void scan_task(const Params& P, unsigned char* smem, int l, int seq, int h, int half, bool active) {
  constexpr int STRIDE = ScanCfg<KIND>::STRIDE, NEL = 16 * STRIDE;
  constexpr int NH = KIND == 2 ? 4 : 6;
  float* buf = (float*)smem;
  float* obuf = buf + 2 * NEL;
  const int tid = otid() & 255, lane = tid & 63, wid = tid >> 6;
  const int col_l = lane >> 3, sub = lane & 7, cl = wid * 8 + col_l, col = half * 32 + cl, e0 = sub * 8;
  const bool sample = seq >= 8;
  const int R0 = sample ? NTP + (seq - 8) : seq * TSEQ, T = sample ? 1 : TSEQ;
  const int ocol = (KIND == 0 ? 0 : (KIND == 1 ? 384 : 768)) + h * 64 + half * 32;
  const size_t O_P = KIND == 0 ? O_GDN_P : (KIND == 1 ? O_RWKV_P : O_HGRN_P);
  const size_t O_S = KIND == 0 ? O_GDN_S : (KIND == 1 ? O_RWKV_S : O_HGRN_S);
  const int I_ST = KIND == 0 ? I_SGDN : (KIND == 1 ? I_SRWKV : I_SHGRN);
  f32x2 S[4];
#pragma unroll
  for (int i = 0; i < 4; ++i) S[i] = (f32x2){0.f, 0.f};
  if (sample && active) {
    const float* st = P.in[I_ST] + ((size_t)(l * 128 + (seq - 8)) * NH + h) * 4096;
#pragma unroll
    for (int i = 0; i < 8; ++i) S[i >> 1][i & 1] = KIND == 1 ? st[col * 64 + e0 + i] : st[(e0 + i) * 64 + col];
  }
  ScanPre<KIND> pre;
  __syncthreads();
  if (active) { scan_load<KIND>(P, pre, tid, h, half, R0, T); scan_store<KIND>(pre, tid, buf); }
  __syncthreads();
  const int nchunks = (T + 15) >> 4;
  bf16_t* oraw = WSP(bf16_t, OFF_P);
  for (int c = 0; c < nchunks; ++c) {
    if (active) {
      const int t0 = c * 16, n = (T - t0) < 16 ? (T - t0) : 16;
      const bool has_next = c + 1 < nchunks;
      if (has_next) scan_load<KIND>(P, pre, tid, h, half, R0 + t0 + 16, T - t0 - 16);
      if (c > 0) {
        const float* pob = obuf + ((c - 1) & 1) * 512;
#pragma unroll
        for (int i = 0; i < 2; ++i) {
          const int idx = tid + i * 256, s = idx >> 5, cc = idx & 31;
          oraw[(size_t)(R0 + t0 - 16 + s) * PSTR + ocol + cc] = f2bf(pob[idx]);
        }
      }
      const float* b = buf + (c & 1) * NEL;
      float* ob = obuf + (c & 1) * 512;
      if (n == 16) {
        StepOps<KIND> A, B;
        step_load<KIND>(A, b, e0, cl);
#pragma unroll 1
        for (int s = 0; s < 16; s += 2) {
          step_load<KIND>(B, b + (s + 1) * STRIDE, e0, cl);
          const float o0 = step_compute<KIND>(A, S);
          if (sub == 0) ob[s * 32 + cl] = o0;
          step_load<KIND>(A, b + (s + 2 < 16 ? s + 2 : 15) * STRIDE, e0, cl);
          const float o1 = step_compute<KIND>(B, S);
          if (sub == 0) ob[(s + 1) * 32 + cl] = o1;
        }
      } else {
        for (int s = 0; s < n; ++s) {
          StepOps<KIND> A;
          step_load<KIND>(A, b + s * STRIDE, e0, cl);
          const float o0 = step_compute<KIND>(A, S);
          if (sub == 0) ob[s * 32 + cl] = o0;
        }
      }
      if (has_next) scan_store<KIND>(pre, tid, buf + ((c + 1) & 1) * NEL);
    }
    __syncthreads();
  }
  if (active) {
    {
      const int c = nchunks - 1, t0 = c * 16, n = T - t0;
      const float* pob = obuf + (c & 1) * 512;
#pragma unroll
      for (int i = 0; i < 2; ++i) {
        const int idx = tid + i * 256, s = idx >> 5, cc = idx & 31;
        if (s < n) oraw[(size_t)(R0 + t0 + s) * PSTR + ocol + cc] = f2bf(pob[idx]);
      }
    }
    float* so = P.out + (sample ? O_S + ((size_t)(l * 128 + (seq - 8)) * NH + h) * 4096 : O_P + ((size_t)(l * 8 + seq) * NH + h) * 4096);
#pragma unroll
    for (int i = 0; i < 8; ++i) { if (KIND == 1) so[col * 64 + e0 + i] = S[i >> 1][i & 1]; else so[(e0 + i) * 64 + col] = S[i >> 1][i & 1]; }
  }
}

__device__ __forceinline__ void scan_phase(const Params& P, unsigned char* smem, int l, volatile unsigned* blk  ) {
  unsigned* q = WSP(unsigned, OFF_QUEUE) + l * 128;
  const int grp = otid() >> 8;
  for (int pass = 0; pass < 2; ++pass) {
    unsigned* qq = pass == 1 ? q + 64 : q;
    const unsigned ntask = pass == 1 ? 2048u : 256u;
    for (;;) {
      __syncthreads();
      if (threadIdx.x == 0) blk[3] = __hip_atomic_fetch_add(qq, 1u, __ATOMIC_RELAXED, __HIP_MEMORY_SCOPE_AGENT);
      __syncthreads();
      const int t = (int)blk[3];
      if (t >= (int)ntask) break;
      int kind, seq, h, half; bool act; unsigned char* sm;
      if (pass == 0) {
        act = grp == 0; sm = smem; half = t & 1;
        if (t < 96) { kind = 1; const int bh = t >> 1; seq = bh / 6; h = bh % 6; }
        else if (t < 192) { kind = 0; const int bh = (t - 96) >> 1; seq = bh / 6; h = bh % 6; }
        else { kind = 2; const int bh = (t - 192) >> 1; seq = bh / 4; h = bh % 4; }
      } else {
        const int hh = t & 15;
        act = true; sm = smem + grp * 51200; half = grp; seq = 8 + (t >> 4);
        if (hh < 6) { kind = 0; h = hh; } else if (hh < 12) { kind = 1; h = hh - 6; } else { kind = 2; h = hh - 12; }
      }
      if (kind == 0) scan_task<0>(P, sm, l, seq, h, half, act);
      else if (kind == 1) scan_task<1>(P, sm, l, seq, h, half, act);
      else scan_task<2>(P, sm, l, seq, h, half, act);
    }
  }
  if (l + 1 < NLAYER) {
    for (;;) {
      __syncthreads();
      if (threadIdx.x == 0) blk[3] = __hip_atomic_fetch_add(q + 96, 1u, __ATOMIC_RELAXED, __HIP_MEMORY_SCOPE_AGENT);
      __syncthreads();
      const unsigned t = blk[3];
      if (t >= (unsigned)WCONV_JOBS) break;
      wconv_job(P, smem, l + 1, (int)t);
    }
  }
}

__device__ __forceinline__ void post_phase(const Params& P, int l) {
  const int lane = otid() & 63, wid = otid() >> 6;
  const bf16_t* p = WSP(bf16_t, OFF_P);
  bf16_t* act = WSP(bf16_t, OFF_ACT);
  const int gw = obid() * 8 + wid, nw = gridDim.x * 8;
  const float gnw = P.in[I_GNW][l * 64 + lane], hnw = P.in[I_HNW][l * 64 + lane];
  for (int u0 = gw * 4; u0 < NTOK * 10; u0 += nw * 4) {
    float o[4], z[4]; int oc[4]; size_t rb[4];
#pragma unroll
    for (int k = 0; k < 4; ++k) {
      const int u = u0 + k, row = u / 10, q = u - row * 10;
      oc[k] = q < 6 ? q * 64 : 768 + (q - 6) * 64;
      const int zc = q < 6 ? 1152 + q * 64 : PC + 768 + (q - 6) * 64;
      rb[k] = (size_t)row;
      o[k] = bf2f(p[(size_t)row * PSTR + oc[k] + lane]);
      z[k] = bf2f(p[(size_t)row * PSTR + zc + lane]);
    }
#pragma unroll
    for (int k = 0; k < 4; ++k) {
      const float ms = wave_sum(o[k] * o[k]) * (1.f / 64.f);
      const float out = o[k] * rsqrtf(ms + 1e-6f) * (oc[k] < 384 ? gnw : hnw) * silu(z[k]);
      act[rb[k] * 1024 + oc[k] + lane] = f2bf(out);
    }
  }
  for (int u0 = gw * 2; u0 < NTOK * 6; u0 += nw * 2) {
    float o[2], r[2], kx[2], v[2], g[2]; int hh[2]; size_t rb[2];
#pragma unroll
    for (int k = 0; k < 2; ++k) {
      const int u = u0 + k, row = u / 6, h = u - row * 6;
      const size_t idx = (size_t)row * 384 + h * 64 + lane;
      hh[k] = h; rb[k] = (size_t)row;
      o[k] = bf2f(p[(size_t)row * PSTR + 384 + h * 64 + lane]);
      r[k] = bf2f(WSP(bf16_t, OFF_RR)[idx]); kx[k] = bf2f(WSP(bf16_t, OFF_RK)[idx]);
      v[k] = bf2f(WSP(bf16_t, OFF_RV)[idx]); g[k] = bf2f(WSP(bf16_t, OFF_RG)[idx]);
    }
#pragma unroll
    for (int k = 0; k < 2; ++k) {
      const int hc = l * 384 + hh[k] * 64 + lane;
      const float mu = wave_sum(o[k]) * (1.f / 64.f);
      const float yc = o[k] - mu;
      const float var = wave_sum(yc * yc) * (1.f / 64.f);
      const float y = yc * rsqrtf(var + 64e-5f) * P.in[I_LNW][hc] + P.in[I_LNB][hc];
      const float rk = wave_sum(r[k] * kx[k] * P.in[I_RK][hc]);
      act[rb[k] * 1024 + 384 + hh[k] * 64 + lane] = f2bf((y + rk * v[k]) * g[k]);
    }
  }
}

#define XB_TMO      128
#define XB_XCNT(j)  (256  + 64 * (j))
#define XB_XSUB(j)  (1280 + 64 * (j))
#define XB_XGEN(j)  (2304 + 64 * (j))
#define XB_TOP      3328
#define XB_TOPGEN   3392
#define XCD_BAR_WORDS 3456
#define XB_SPIN_CAP (1u << 20)
#define LAS __attribute__((address_space(3)))
__device__ __forceinline__ unsigned xb_ld(unsigned* p)              { return __hip_atomic_load(p, __ATOMIC_RELAXED, __HIP_MEMORY_SCOPE_AGENT); }
__device__ __forceinline__ unsigned xb_add(unsigned* p, unsigned v) { return __hip_atomic_fetch_add(p, v, __ATOMIC_RELAXED, __HIP_MEMORY_SCOPE_AGENT); }
__device__ __forceinline__ unsigned xb_xcc_id() { return (unsigned)__builtin_amdgcn_s_getreg((3 << 11) | 20) & 0xFu; }
#define XB_SPIN(cond, bar) do { unsigned _sp = 0; while (cond) { __builtin_amdgcn_s_sleep(1); \
    if ((++_sp & 255u) == 0u) { if (xb_ld(&(bar)[XB_TMO])) break; if (_sp > XB_SPIN_CAP) { atomicAdd(&(bar)[XB_TMO], 1u); break; } } } } while (0)
struct XcdBarrier { unsigned* bar; unsigned x; volatile LAS unsigned* st; };
__device__ __forceinline__ XcdBarrier xcd_barrier_post(unsigned* bar, volatile LAS unsigned* st) {
  XcdBarrier b; b.bar = bar; b.x = xb_xcc_id(); b.st = st;
  if (threadIdx.x == 0) (void)xb_add(&bar[XB_XCNT(b.x)], 1u);
  return b;
}
__device__ __forceinline__ void xcd_barrier_complete(unsigned* bar, unsigned x, unsigned& nloc, unsigned& nx) {
  const unsigned G = gridDim.x * gridDim.y * gridDim.z;
  unsigned sum, cnt, mine, sp = 0u;
  for (;;) {
    sum = 0u; cnt = 0u; mine = 0u;
#pragma unroll
    for (unsigned j = 0; j < 16; ++j) { const unsigned c = xb_ld(&bar[XB_XCNT(j)]); sum += c; cnt += (c > 0u) ? 1u : 0u; mine = (j == x) ? c : mine; }
    if (sum == G) break;
    __builtin_amdgcn_s_sleep(1);
    if ((++sp & 255u) == 0u) { if (xb_ld(&bar[XB_TMO])) break; if (sp > XB_SPIN_CAP) { atomicAdd(&bar[XB_TMO], 1u); break; } }
  }
  nloc = mine > 0u ? mine : 1u; nx = cnt > 0u ? cnt : 1u;
}
__device__ __forceinline__ void xcd_barrier(const XcdBarrier& b) {
  asm volatile("s_waitcnt vmcnt(0)" ::: "memory");
  __syncthreads();
  if (threadIdx.x == 0) {
    unsigned* bar = b.bar;
    __builtin_amdgcn_s_waitcnt(0);
    unsigned nloc = b.st[0], nx = b.st[1];
    if (nloc == 0u) { xcd_barrier_complete(bar, b.x, nloc, nx); b.st[0] = nloc; b.st[1] = nx; }
    const unsigned old = xb_add(&bar[XB_XSUB(b.x)], 1u);
    const unsigned gen = old / nloc;
    if (old + 1u == (gen + 1u) * nloc) {
      __builtin_amdgcn_fence(__ATOMIC_RELEASE, "agent");
      asm volatile("s_waitcnt vmcnt(0)" ::: "memory");
      const unsigned og = xb_add(&bar[XB_TOP], 1u);
      const unsigned tg = og / nx;
      if (og + 1u == (tg + 1u) * nx) xb_add(&bar[XB_TOPGEN], 1u);
      else XB_SPIN(xb_ld(&bar[XB_TOPGEN]) == tg, bar);
      __builtin_amdgcn_fence(__ATOMIC_ACQUIRE, "agent");
      xb_add(&bar[XB_XGEN(b.x)], 1u);
      asm volatile("s_waitcnt vmcnt(0)" ::: "memory");
    } else {
      XB_SPIN(xb_ld(&bar[XB_XGEN(b.x)]) == gen, bar);
      __builtin_amdgcn_fence(__ATOMIC_ACQUIRE, "agent");
      asm volatile("s_waitcnt vmcnt(0)" ::: "memory");
    }
  }
  __syncthreads();
}

__global__ void __launch_bounds__(512, 2) hybrid_fwd(Params P) {
  cg::grid_group grid = cg::this_grid();
  __shared__ __attribute__((aligned(16))) unsigned char smem[131072 + 64];
  uint4& xb_words = *(uint4*)(smem + 131072);
  if (threadIdx.x == 0) xb_words = make_uint4(0u, 0u, 0u, 0u);
  __syncthreads();
  const XcdBarrier xb = xcd_barrier_post(WSP(unsigned, OFF_BAR), (volatile LAS unsigned*)&xb_words);
  if (threadIdx.x == 0) {
    const unsigned hw = (unsigned)__builtin_amdgcn_s_getreg((7 << 11) | (8 << 6) | 4) & 0xffu;
    const unsigned key = (xb.x << 8) | hw;
    ((volatile unsigned*)&xb_words)[2] = __hip_atomic_fetch_add(WSP(unsigned, OFF_CUTAB) + key, 1u, __ATOMIC_RELAXED, __HIP_MEMORY_SCOPE_AGENT);
  }
  __syncthreads();
#pragma unroll 1
  for (int step = 0; step < NLAYER * 9; ++step) {
    const int l = step / 9, ph = step - l * 9;
    switch (ph) {
      case 0: if (l == 0) wconv_phase(P, smem, 0); norm_phase(P, l, P.in[I_NORM_MIX] + l * D); break;
      case 1: gemm_phase<EPI_P>(P, smem, WSP(bf16_t, OFF_ACT), 1024, WSP(bf16_t, OFF_WTIN), 1024, 32, l, 4096);
              gemm_sample<EPI_P>(P, WSP(bf16_t, OFF_ACT), 1024, WSP(bf16_t, OFF_WTIN), 1024, 249, l); break;
      case 2: prep_phase(P, smem, l); break;
      case 3: scan_phase(P, smem, l, (volatile unsigned*)&xb_words); break;
      case 4: post_phase(P, l); break;
      case 5: gemm_phase<EPI_RES>(P, smem, WSP(bf16_t, OFF_ACT), 1024, WSP(bf16_t, wt_out_off(l)), 1024, 8, l, 1024);
              gemm_sample<EPI_RES>(P, WSP(bf16_t, OFF_ACT), 1024, WSP(bf16_t, wt_out_off(l)), 1024, 64, l); break;
      case 6: norm_phase(P, 1, P.in[I_NORM_FFN] + l * D); break;
      case 7: gemm_phase<EPI_SWIGLU>(P, smem, WSP(bf16_t, OFF_ACT), 1024, WSP(bf16_t, wt_gu_off(l)), 1024, 44, 1, 5632);
              gemm_sample<EPI_SWIGLU>(P, WSP(bf16_t, OFF_ACT), 1024, WSP(bf16_t, wt_gu_off(l)), 1024, 176, 1); break;
      default: gemm_phase<EPI_RES>(P, smem, WSP(bf16_t, OFF_P), DFF, WSP(bf16_t, wt_dn_off(l)), DFF, 8, 1, 1024);
               gemm_sample<EPI_RES>(P, WSP(bf16_t, OFF_P), DFF, WSP(bf16_t, wt_dn_off(l)), DFF, 64, 1); break;
    }
    if (step == 0) grid.sync();
    else xcd_barrier(xb);
  }
  final_norm_phase(P);
}

extern "C" void kernel_launch(void* const* d_in, const int* in_sizes, int n_in,
                              void* d_out, int out_size, void* d_ws, size_t ws_size,
                              hipStream_t stream) {
  static int grid_blocks = 0;
  if (!grid_blocks) {
    int dev = 0, cus = 0, per_cu = 0;
    (void)hipGetDevice(&dev);
    (void)hipDeviceGetAttribute(&cus, hipDeviceAttributeMultiprocessorCount, dev);
    (void)hipOccupancyMaxActiveBlocksPerMultiprocessor(&per_cu, hybrid_fwd, 512, 0);
    if (per_cu > 1) per_cu = 1;
    if (per_cu < 1) per_cu = 1;
    grid_blocks = cus * per_cu;
  }
  if (ws_size < WS_NEED) { fprintf(stderr, "workspace too small: %zu < %zu\n", ws_size, (size_t)WS_NEED); return; }
  Params p{};
  for (int i = 0; i < N_IN; ++i) p.in[i] = (const float*)d_in[i];
  p.out = (float*)d_out;
  p.ws = (unsigned char*)d_ws;
  (void)hipMemsetAsync((unsigned char*)d_ws + OFF_BAR, 0, BAR_BYTES, stream);
  void* args[] = {&p};
  hipError_t e = hipLaunchCooperativeKernel((void*)hybrid_fwd, dim3(grid_blocks), dim3(512), args, 0, stream);
  if (e != hipSuccess) fprintf(stderr, "cooperative launch failed: %s (grid %d)\n", hipGetErrorString(e), grid_blocks);
}
```

```cpp
#include <hip/hip_runtime.h>
#include <hip/hip_cooperative_groups.h>
#include <cstdio>
namespace cg = cooperative_groups;

typedef unsigned short bf16_t;
typedef short bf16x8 __attribute__((ext_vector_type(8)));
typedef float f32x4 __attribute__((ext_vector_type(4)));
typedef unsigned u32x4 __attribute__((ext_vector_type(4)));
typedef unsigned u32x2 __attribute__((ext_vector_type(2)));

constexpr int D = 1024, NTP = 16384, NTS = 128, NTOK = 16512, TSEQ = 2048, NLAYER = 4;
constexpr int IN_COLS = 3980, PSTR = 3984, DFF = 2816;
constexpr int PB = 1548, PC = 2956;

enum { I_XP = 0, I_XS, I_SGDN, I_SCONV, I_SRWKV, I_SSHIFT, I_SHGRN, I_NORM_MIX, I_WIN, I_WOUT, I_CONVW, I_ALOG, I_DTB, I_GNW,
       I_MU, I_W0, I_W2, I_A0, I_A2, I_G2, I_V0, I_V1, I_V2, I_KK, I_KA, I_RK, I_LNW, I_LNB, I_HLB, I_HNW, I_NORM_FFN,
       I_WG, I_WU, I_WD, I_NORM_FINAL, N_IN };

constexpr size_t O_YP = 0, O_YS = 16777216, O_GDN_P = 16908288, O_GDN_S = 17694720, O_CONV_P = 30277632, O_CONV_S = 30388224,
                 O_RWKV_P = 32157696, O_RWKV_S = 32944128, O_SHIFT_P = 45527040, O_SHIFT_S = 45572096, O_HGRN_P = 46292992,
                 O_HGRN_S = 46817280;

constexpr size_t SZ_WTIN = (size_t)4096 * 1024 * 2, SZ_WTOUT = (size_t)1024 * 1024 * 2, SZ_WTGU = (size_t)5632 * 1024 * 2,
                 SZ_WTDN = (size_t)1024 * 2816 * 2, SZ_P = (size_t)NTOK * PSTR * 2, SZ_ACT = (size_t)NTOK * 1024 * 2,
                 SZ_T384 = (size_t)NTOK * 384 * 2, SZ_T8F = (size_t)NTOK * 8 * 4, SZ_T256 = (size_t)NTOK * 256 * 2,
                 SZ_T384F = (size_t)NTOK * 384 * 4;
constexpr size_t OFF_WTIN = 0, OFF_WTOUT = OFF_WTIN + SZ_WTIN, OFF_WTGU = OFF_WTOUT + SZ_WTOUT, OFF_WTDN = OFF_WTGU + SZ_WTGU,
                 OFF_P = OFF_WTDN + SZ_WTDN, OFF_ACT = OFF_P + SZ_P, OFF_GQ = OFF_ACT + SZ_ACT, OFF_GK = OFF_GQ + SZ_T384,
                 OFF_GV = OFF_GK + SZ_T384, OFF_GDEC = OFF_GV + SZ_T384, OFF_GBETA = OFF_GDEC + SZ_T8F, OFF_HQ = OFF_GBETA + SZ_T8F,
                 OFF_HK = OFF_HQ + SZ_T256, OFF_RR = OFF_HK + SZ_T256, OFF_RK = OFF_RR + SZ_T384, OFF_RV = OFF_RK + SZ_T384,
                 OFF_RKK = OFF_RV + SZ_T384, OFF_RB = OFF_RKK + SZ_T384, OFF_RG = OFF_RB + SZ_T384, OFF_RW = OFF_RG + SZ_T384,
                 OFF_VF = OFF_RW + SZ_T384F, OFF_LORA = OFF_VF + SZ_T384, OFF_WTOUT2 = OFF_LORA + 245760, OFF_WTGU2 = OFF_WTOUT2 + SZ_WTOUT, OFF_WTDN2 = OFF_WTGU2 + SZ_WTGU, OFF_BAR = OFF_WTDN2 + SZ_WTDN, OFF_CUTAB = OFF_BAR + 16384, OFF_QUEUE = OFF_CUTAB + 16384, BAR_BYTES = 16384 + 16384 + 4096, WS_NEED = OFF_BAR + BAR_BYTES;
constexpr int W2T = 0, A2T = 24576, G2T = 49152, V1T = 98304, V2T = 110592;

struct Params {
  const float* in[N_IN];
  float* out;
  unsigned char* ws;
};

#define WSP(T, off) ((T*)(P.ws + (off)))

__device__ __forceinline__ int otid() { int t = __builtin_amdgcn_workitem_id_x(); asm volatile("" : "+v"(t)); return t; }
__device__ __forceinline__ int obid() { int b = __builtin_amdgcn_workgroup_id_x(); asm volatile("" : "+s"(b)); return b; }
template <class T> __device__ __forceinline__ const T* opq(const T* p) { asm volatile("" : "+s"(p)); return p; }
__device__ __forceinline__ float bf2f(bf16_t h) { return __uint_as_float(((unsigned)h) << 16); }
typedef float f32x2_t __attribute__((ext_vector_type(2)));
typedef __bf16 bf16x2_t __attribute__((ext_vector_type(2)));
__device__ __forceinline__ unsigned pk2(float lo, float hi) {
  const f32x2_t v = {lo, hi};
  return __builtin_bit_cast(unsigned, __builtin_convertvector(v, bf16x2_t));
}
__device__ __forceinline__ bf16_t f2bf(float f) { return (bf16_t)(pk2(f, 0.f) & 0xffffu); }
__device__ __forceinline__ float sigm(float x) { return 1.f / (1.f + __expf(-x)); }
__device__ __forceinline__ float silu(float x) { return x / (1.f + __expf(-x)); }
__device__ __forceinline__ float softplus(float x) { return x > 20.f ? x : log1pf(__expf(x)); }
template <int CTRL> __device__ __forceinline__ float dppf(float x) {
  return __builtin_bit_cast(float, __builtin_amdgcn_mov_dpp(__builtin_bit_cast(int, x), CTRL, 0xf, 0xf, true));
}
__device__ __forceinline__ float wave_sum(float v) {
  v += dppf<0xB1>(v); v += dppf<0x4E>(v); v += dppf<0x141>(v); v += dppf<0x140>(v);
  const int iv = __builtin_bit_cast(int, v);
  const float s0 = __builtin_bit_cast(float, __builtin_amdgcn_readlane(iv, 0)), s1 = __builtin_bit_cast(float, __builtin_amdgcn_readlane(iv, 16));
  const float s2 = __builtin_bit_cast(float, __builtin_amdgcn_readlane(iv, 32)), s3 = __builtin_bit_cast(float, __builtin_amdgcn_readlane(iv, 48));
  return (s0 + s1) + (s2 + s3);
}
__device__ __forceinline__ float reduce8(float x) { x += dppf<0xB1>(x); x += dppf<0x4E>(x); x += dppf<0x141>(x); return x; }

__device__ __forceinline__ f32x4 unpack4(u32x2 w) {
  f32x4 f; f[0] = __uint_as_float(w[0] << 16); f[1] = __uint_as_float(w[0] & 0xffff0000u);
  f[2] = __uint_as_float(w[1] << 16); f[3] = __uint_as_float(w[1] & 0xffff0000u); return f;
}
__device__ __forceinline__ bf16x8 pack8(f32x4 a, f32x4 b) {
  u32x4 u; u[0] = pk2(a[0], a[1]); u[1] = pk2(a[2], a[3]); u[2] = pk2(b[0], b[1]); u[3] = pk2(b[2], b[3]);
  return __builtin_bit_cast(bf16x8, u);
}
__device__ __forceinline__ u32x2 pack4(f32x4 a) { u32x2 u; u[0] = pk2(a[0], a[1]); u[1] = pk2(a[2], a[3]); return u; }
__device__ __forceinline__ float dot4(f32x4 a, f32x4 b) { return (a[0] * b[0] + a[1] * b[1]) + (a[2] * b[2] + a[3] * b[3]); }
__device__ __forceinline__ const float* xin_row(const Params& P, int l, int row) {
  const float* po = opq((const float*)P.out); const float* pp = opq(P.in[I_XP]); const float* ps = opq(P.in[I_XS]);
  if (l > 0) return po + (size_t)row * D;
  return row < NTP ? pp + (size_t)row * D : ps + (size_t)(row - NTP) * D;
}

__device__ __forceinline__ int gu_row(int c, int up) { return (c >> 7) * 256 + up * 128 + (c & 127); }
__device__ __forceinline__ void xpose_tile(unsigned char* smem, const float* __restrict__ W, int N, int kt, int ntl, bf16_t* __restrict__ dst, int dstK, int mode) {
  float (*tile)[65] = (float (*)[65])smem;
  const int tid = otid();
  __syncthreads();
#pragma unroll 4
  for (int i = 0; i < 8; ++i) {
    const int k = i * 8 + (tid >> 6), n = tid & 63, gn = ntl * 64 + n;
    tile[k][n] = gn < N ? W[(size_t)(kt * 64 + k) * N + gn] : 0.f;
  }
  __syncthreads();
#pragma unroll 4
  for (int i = 0; i < 8; ++i) {
    const int n = i * 8 + (tid >> 6), k = tid & 63, gn = ntl * 64 + n;
    const int drow = mode == 0 ? gn : gu_row(gn, mode - 1);
    dst[(size_t)drow * dstK + kt * 64 + k] = f2bf(tile[k][n]);
  }
}
constexpr int WCONV_JOBS = 3392 + 480;
__device__ __forceinline__ size_t wt_out_off(int l) { return (l & 1) ? OFF_WTOUT2 : OFF_WTOUT; }
__device__ __forceinline__ size_t wt_gu_off(int l) { return (l & 1) ? OFF_WTGU2 : OFF_WTGU; }
__device__ __forceinline__ size_t wt_dn_off(int l) { return (l & 1) ? OFF_WTDN2 : OFF_WTDN; }
__device__ __forceinline__ void wconv_job(const Params& P, unsigned char* smem, int l, int job) {
  if (job < 1024) xpose_tile(smem, P.in[I_WIN] + (size_t)l * 1024 * IN_COLS, IN_COLS, job & 15, job >> 4, WSP(bf16_t, OFF_WTIN), 1024, 0);
  else if (job < 1280) { const int j = job - 1024; xpose_tile(smem, P.in[I_WOUT] + (size_t)l * 1024 * 1024, 1024, j & 15, j >> 4, WSP(bf16_t, wt_out_off(l)), 1024, 0); }
  else if (job < 1984) { const int j = job - 1280; xpose_tile(smem, P.in[I_WG] + (size_t)l * 1024 * DFF, DFF, j & 15, j >> 4, WSP(bf16_t, wt_gu_off(l)), 1024, 1); }
  else if (job < 2688) { const int j = job - 1984; xpose_tile(smem, P.in[I_WU] + (size_t)l * 1024 * DFF, DFF, j & 15, j >> 4, WSP(bf16_t, wt_gu_off(l)), 1024, 2); }
  else if (job < 3392) { const int j = job - 2688; xpose_tile(smem, P.in[I_WD] + (size_t)l * DFF * 1024, 1024, j % 44, j / 44, WSP(bf16_t, wt_dn_off(l)), DFF, 0); }
  else {
    bf16_t* lw = WSP(bf16_t, OFF_LORA);
    const int idx = (job - 3392) * 256 + (otid() & 255);
    float v = 0.f;
    const float* pw2 = opq(P.in[I_W2]); const float* pa2 = opq(P.in[I_A2]); const float* pg2 = opq(P.in[I_G2]);
    const float* pv1 = opq(P.in[I_V1]); const float* pv2 = opq(P.in[I_V2]);
    if (idx < A2T) { const int n = idx >> 6, k = idx & 63; v = pw2[(size_t)l * 64 * 384 + k * 384 + n]; }
    else if (idx < G2T) { const int i = idx - A2T, n = i >> 6, k = i & 63; v = pa2[(size_t)l * 64 * 384 + k * 384 + n]; }
    else if (idx < V1T) { const int i = idx - G2T, n = i >> 7, k = i & 127; v = pg2[(size_t)l * 128 * 384 + k * 384 + n]; }
    else if (idx < V2T) { if (l > 0) { const int i = idx - V1T, n = i / 384, k = i - n * 384; v = pv1[(size_t)(l - 1) * 384 * 32 + k * 32 + n]; } }
    else { if (l > 0) { const int i = idx - V2T, n = i >> 5, k = i & 31; v = pv2[(size_t)(l - 1) * 32 * 384 + k * 384 + n]; } }
    if (otid() < 256) lw[idx] = f2bf(v);
  }
}
__device__ __forceinline__ void wconv_phase(const Params& P, unsigned char* smem, int l) {
  for (int job = obid(); job < WCONV_JOBS; job += gridDim.x) wconv_job(P, smem, l, job);
}

__device__ __forceinline__ void norm_phase(const Params& P, int l_in, const float* __restrict__ w) {
  bf16_t* act = WSP(bf16_t, OFF_ACT);
  const int lane = otid() & 63, wid = otid() >> 6;
  for (int row = obid() * 8 + wid; row < NTOK; row += gridDim.x * 8) {
    const float* xr = xin_row(P, l_in, row);
    f32x4 v[4]; float ss = 0.f;
#pragma unroll
    for (int i = 0; i < 4; ++i) { v[i] = *(const f32x4*)(xr + i * 256 + lane * 4); ss += v[i][0] * v[i][0] + v[i][1] * v[i][1] + v[i][2] * v[i][2] + v[i][3] * v[i][3]; }
    ss = wave_sum(ss);
    const float rstd = rsqrtf(ss * (1.f / 1024.f) + 1e-6f);
#pragma unroll
    for (int i = 0; i < 4; ++i) {
      const f32x4 wv = *(const f32x4*)(w + i * 256 + lane * 4);
      u32x2 o; o[0] = pk2(v[i][0] * rstd * wv[0], v[i][1] * rstd * wv[1]); o[1] = pk2(v[i][2] * rstd * wv[2], v[i][3] * rstd * wv[3]);
      *(u32x2*)(act + (size_t)row * 1024 + i * 256 + lane * 4) = o;
    }
  }
}
__device__ __forceinline__ void final_norm_phase(const Params& P) {
  const float* w = P.in[I_NORM_FINAL];
  const int lane = otid() & 63, wid = otid() >> 6;
  for (int row = obid() * 8 + wid; row < NTOK; row += gridDim.x * 8) {
    float* xr = P.out + (size_t)row * D;
    f32x4 v[4]; float ss = 0.f;
#pragma unroll
    for (int i = 0; i < 4; ++i) { v[i] = *(const f32x4*)(xr + i * 256 + lane * 4); ss += v[i][0] * v[i][0] + v[i][1] * v[i][1] + v[i][2] * v[i][2] + v[i][3] * v[i][3]; }
    ss = wave_sum(ss);
    const float rstd = rsqrtf(ss * (1.f / 1024.f) + 1e-6f);
#pragma unroll
    for (int i = 0; i < 4; ++i) {
      const f32x4 wv = *(const f32x4*)(w + i * 256 + lane * 4);
      f32x4 o; o[0] = v[i][0] * rstd * wv[0]; o[1] = v[i][1] * rstd * wv[1]; o[2] = v[i][2] * rstd * wv[2]; o[3] = v[i][3] * rstd * wv[3];
      *(f32x4*)(xr + i * 256 + lane * 4) = o;
    }
  }
}

enum { EPI_P = 0, EPI_RES = 1, EPI_SWIGLU = 2 };
namespace pg8 {
constexpr int BM = 256, BK = 64, HALF = 128, HTB = HALF * BK * 2, NXCD = 8, WGM = 8;
__device__ __forceinline__ int lds_byte(int r, int c) { const int st = (r >> 4) * 2 + (c >> 5), rr = r & 15, cc = c & 31, ob = rr * 64 + cc * 2; return st * 1024 + (ob ^ (((ob >> 9) & 1) << 5)); }
__device__ __forceinline__ void stage_rc(int b, int& R, int& C) { const int st = b / 1024, sb = b % 1024, swz = sb ^ (((sb >> 9) & 1) << 5); R = (st >> 1) * 16 + swz / 64; C = (st & 1) * 32 + (swz % 64) / 2; }
struct Unit { int pm, pn; };
struct StaticOrder {
  int nM, nN, nwg, G, c;
  __device__ __forceinline__ void init(int M, int N, int G_, int c_) { nM = M / BM; nN = N / BM; nwg = nM * nN; G = G_; c = c_; }
  __device__ __forceinline__ bool next(int i, Unit& u) const {
    const long L = (long)i * G + c; if (L >= nwg) return false;
    int wgid = (int)L; { const int q = nwg / NXCD, r = nwg % NXCD, xcd = wgid % NXCD, off = wgid / NXCD; wgid = (xcd < r ? xcd * (q + 1) : r * (q + 1) + (xcd - r) * q) + off; }
    const int nig = WGM * nN, gid = wgid / nig, fm = gid * WGM, gsz = (nM - fm) < WGM ? (nM - fm) : WGM;
    u.pm = fm + ((wgid % nig) % gsz); u.pn = (wgid % nig) / gsz; return true;
  }
};
}

template <int EPI>
__device__ __forceinline__ void gemm_epilogue(const Params& P, const f32x4 (&acc)[2][2][4][2], const pg8::Unit& u, int wr, int wc, int fr, int fq, int l) {
#pragma unroll
  for (int ai = 0; ai < 2; ++ai)
#pragma unroll
    for (int m = 0; m < 4; ++m) {
      const int row = u.pm * 256 + ai * 128 + wr * 64 + m * 16 + fr;
      if (EPI == EPI_P) {
        bf16_t* pr = WSP(bf16_t, OFF_P) + (size_t)row * PSTR;
#pragma unroll
        for (int bj = 0; bj < 2; ++bj)
#pragma unroll
          for (int n = 0; n < 2; ++n) {
            const int col = u.pn * 256 + bj * 128 + wc * 32 + n * 16 + fq * 4;
            if (col < IN_COLS) *(u32x2*)(pr + col) = pack4(acc[ai][bj][m][n]);
          }
      } else if (EPI == EPI_RES) {
        const float* xi = xin_row(P, l, row);
        float* xo = P.out + (size_t)row * D;
#pragma unroll
        for (int bj = 0; bj < 2; ++bj)
#pragma unroll
          for (int n = 0; n < 2; ++n) {
            const int col = u.pn * 256 + bj * 128 + wc * 32 + n * 16 + fq * 4;
            *(f32x4*)(xo + col) = *(const f32x4*)(xi + col) + acc[ai][bj][m][n];
          }
      } else {
        bf16_t* ur = WSP(bf16_t, OFF_P) + (size_t)row * DFF;
#pragma unroll
        for (int n = 0; n < 2; ++n) {
          const int col = u.pn * 128 + wc * 32 + n * 16 + fq * 4;
          f32x4 r;
#pragma unroll
          for (int j = 0; j < 4; ++j) r[j] = silu(acc[ai][0][m][n][j]) * acc[ai][1][m][n][j];
          *(u32x2*)(ur + col) = pack4(r);
        }
      }
    }
}

#define PG8_LAS __attribute__((address_space(3)))
template <int EPI>
__device__ __forceinline__ void gemm_phase(const Params& P, unsigned char* smem, const bf16_t* __restrict__ Ag, int lda_unused, const bf16_t* __restrict__ Btg, int K, int nN128_unused, int l, int N) {
  using namespace pg8;
  PG8_LAS unsigned char* lds = (PG8_LAS unsigned char*)smem;
  const int tid = otid(), wid = __builtin_amdgcn_readfirstlane(tid >> 6), lane = tid & 63, wr = wid >> 2, wc = wid & 3, fr = lane & 15, fq = lane >> 4;
  const int nt = K / BK;
  StaticOrder S; S.init(NTP, N, (int)gridDim.x, obid());
  unsigned voffA[2], voffB[2];
#pragma unroll
  for (int i = 0; i < 2; ++i) { int R, C; stage_rc(tid * 16 + i * 8192, R, C); voffA[i] = (unsigned)(R * K + C) * 2u; voffB[i] = voffA[i]; }
  const size_t kstep = (size_t)(BK * 2);
  const size_t hstep = (size_t)HALF * K * 2;
  const size_t tstep = 2 * hstep;
  const unsigned ldsw = (unsigned)wid * 1024u;
  const int aoff = lds_byte(wr * 64 + fr, fq * 8), boff = lds_byte(wc * 32 + fr, fq * 8);
#define PG8_SA(b, h) (((b) * 2 + (h)) * HTB)
#define PG8_SB(b, h) ((4 + (b) * 2 + (h)) * HTB)
#define PG8_STAGE(bufoff, gbase, voff) do { _Pragma("unroll") for (int _i = 0; _i < 2; ++_i) \
        __builtin_amdgcn_global_load_lds((const unsigned*)((const char*)(gbase) + (voff)[_i]), (PG8_LAS unsigned*)(lds + (bufoff) + ldsw + _i * 8192), 16, 0, 0); } while (0)
#define PG8_LDA(dst, b, h) do { _Pragma("unroll") for (int m = 0; m < 4; ++m) _Pragma("unroll") for (int k = 0; k < 2; ++k) dst[m][k] = *(const PG8_LAS bf16x8*)(lds + PG8_SA(b, h) + aoff + m * 2048 + k * 1024); } while (0)
#define PG8_LDB(dst, b, h) do { _Pragma("unroll") for (int n = 0; n < 2; ++n) _Pragma("unroll") for (int k = 0; k < 2; ++k) dst[n][k] = *(const PG8_LAS bf16x8*)(lds + PG8_SB(b, h) + boff + n * 2048 + k * 1024); } while (0)
#define PG8_MMA(ai, bj, At, Bt) do { __builtin_amdgcn_s_setprio(1); _Pragma("unroll") for (int m = 0; m < 4; ++m) _Pragma("unroll") for (int n = 0; n < 2; ++n) _Pragma("unroll") for (int k = 0; k < 2; ++k) \
        acc[ai][bj][m][n] = __builtin_amdgcn_mfma_f32_16x16x32_bf16(Bt[n][k], At[m][k], acc[ai][bj][m][n], 0, 0, 0); __builtin_amdgcn_s_setprio(0); } while (0)
#define PG8_WAIT_V(n) asm volatile("s_waitcnt vmcnt(" #n ")" ::: "memory")
#define PG8_WAIT_L(n) asm volatile("s_waitcnt lgkmcnt(" #n ")" ::: "memory")
#define PG8_BAR __builtin_amdgcn_s_barrier()
#define PG8_SCHED __builtin_amdgcn_sched_barrier(0)
  Unit cur, nxt; int ui = 0;
  if (!S.next(0, cur)) return;
  f32x4 acc[2][2][4][2];
#pragma unroll
  for (int a = 0; a < 2; ++a)
#pragma unroll
    for (int b = 0; b < 2; ++b)
#pragma unroll
      for (int m = 0; m < 4; ++m)
#pragma unroll
        for (int n = 0; n < 2; ++n) acc[a][b][m][n] = (f32x4){0.f, 0.f, 0.f, 0.f};
  bf16x8 At[4][2], B0[2][2], B1[2][2];
  const char* cA = (const char*)Ag + (size_t)cur.pm * tstep; const char* cB = (const char*)Btg + (size_t)cur.pn * tstep;
  PG8_STAGE(PG8_SB(0, 0), cB, voffB); PG8_STAGE(PG8_SA(0, 0), cA, voffA); PG8_STAGE(PG8_SB(0, 1), cB + hstep, voffB); PG8_STAGE(PG8_SA(0, 1), cA + hstep, voffA);
  if (wr == 1) PG8_BAR;
  PG8_WAIT_V(4); PG8_BAR;
  PG8_STAGE(PG8_SB(1, 0), cB + kstep, voffB); PG8_STAGE(PG8_SA(1, 0), cA + kstep, voffA); PG8_STAGE(PG8_SB(1, 1), cB + hstep + kstep, voffB);
  PG8_WAIT_V(6); PG8_BAR;
  for (;;) {
    const bool has_next = S.next(ui + 1, nxt);
    const char* nA = has_next ? (const char*)Ag + (size_t)nxt.pm * tstep : cA; const char* nB = has_next ? (const char*)Btg + (size_t)nxt.pn * tstep : cB;
    for (int t = 0; t < nt; t += 2) {
      const bool last = (t == nt - 2);
      const char* a1 = cA + (size_t)(t + 1) * kstep;
      const char* a2 = last ? nA : cA + (size_t)(t + 2) * kstep; const char* b2 = last ? nB : cB + (size_t)(t + 2) * kstep;
      const char* a3 = a2 + kstep; const char* b3 = b2 + kstep;
      PG8_LDB(B0, 0, 0); PG8_SCHED; PG8_LDA(At, 0, 0); PG8_STAGE(PG8_SA(1, 1), a1 + hstep, voffA);
      PG8_WAIT_L(8); PG8_BAR; PG8_WAIT_L(0); PG8_MMA(0, 0, At, B0); PG8_BAR; PG8_SCHED;
      PG8_LDB(B1, 0, 1); PG8_STAGE(PG8_SB(0, 0), b2, voffB);
      PG8_BAR; PG8_WAIT_L(0); PG8_MMA(0, 1, At, B1); PG8_BAR;
      PG8_LDA(At, 0, 1); PG8_STAGE(PG8_SA(0, 0), a2, voffA);
      PG8_BAR; PG8_WAIT_L(0); PG8_MMA(1, 0, At, B0); PG8_BAR; PG8_SCHED;
      PG8_STAGE(PG8_SB(0, 1), b2 + hstep, voffB);
      PG8_WAIT_V(6); PG8_BAR; PG8_MMA(1, 1, At, B1); PG8_BAR;
      PG8_LDB(B0, 1, 0); PG8_SCHED; PG8_LDA(At, 1, 0); PG8_STAGE(PG8_SA(0, 1), a2 + hstep, voffA);
      PG8_WAIT_L(8); PG8_BAR; PG8_WAIT_L(0); PG8_MMA(0, 0, At, B0); PG8_BAR; PG8_SCHED;
      PG8_LDB(B1, 1, 1); PG8_STAGE(PG8_SB(1, 0), b3, voffB);
      PG8_BAR; PG8_WAIT_L(0); PG8_MMA(0, 1, At, B1); PG8_BAR;
      PG8_LDA(At, 1, 1); PG8_STAGE(PG8_SA(1, 0), a3, voffA);
      PG8_BAR; PG8_WAIT_L(0); PG8_MMA(1, 0, At, B0); PG8_BAR; PG8_SCHED;
      PG8_STAGE(PG8_SB(1, 1), b3 + hstep, voffB);
      PG8_WAIT_V(6); PG8_BAR; PG8_MMA(1, 1, At, B1); PG8_BAR;
    }
    gemm_epilogue<EPI>(P, acc, cur, wr, wc, fr, fq, l);
    if (!has_next) break;
#pragma unroll
    for (int a = 0; a < 2; ++a)
#pragma unroll
      for (int b = 0; b < 2; ++b)
#pragma unroll
        for (int m = 0; m < 4; ++m)
#pragma unroll
          for (int n = 0; n < 2; ++n) acc[a][b][m][n] = (f32x4){0.f, 0.f, 0.f, 0.f};
    cur = nxt; cA = nA; cB = nB; ++ui;
  }
  PG8_WAIT_V(0);
  if (wr == 0) PG8_BAR;
  PG8_BAR;
#undef PG8_SA
#undef PG8_SB
#undef PG8_STAGE
#undef PG8_LDA
#undef PG8_LDB
#undef PG8_MMA
#undef PG8_WAIT_V
#undef PG8_WAIT_L
#undef PG8_BAR
#undef PG8_SCHED
}

template <int EPI>
__device__ __forceinline__ void gemm_sample(const Params& P, const bf16_t* __restrict__ A, int lda, const bf16_t* __restrict__ Bt, int K, int nunits, int l) {
  const int tid = otid(), lane = tid & 63, wid = tid >> 6, fr = lane & 15, fq = lane >> 4;
  for (int u = (int)gridDim.x - 1 - obid(); u < nunits; u += gridDim.x) {
    const int brow0 = EPI == EPI_SWIGLU ? gu_row(u * 16 + fr, 0) : u * 16 + fr;
    const int brow1 = EPI == EPI_SWIGLU ? gu_row(u * 16 + fr, 1) : 0;
    const bf16_t* a0p = A + (size_t)(NTP + wid * 16 + fr) * lda + fq * 8;
    const bf16_t* b0p = Bt + (size_t)brow0 * K + fq * 8;
    const bf16_t* b1p = Bt + (size_t)brow1 * K + fq * 8;
    f32x4 c00 = (f32x4){0.f, 0.f, 0.f, 0.f}, c01 = c00;
#pragma unroll 8
    for (int ks = 0; ks < K; ks += 32) {
      const bf16x8 A0 = *(const bf16x8*)(a0p + ks), B0 = *(const bf16x8*)(b0p + ks);
      c00 = __builtin_amdgcn_mfma_f32_16x16x32_bf16(B0, A0, c00, 0, 0, 0);
      if (EPI == EPI_SWIGLU) {
        const bf16x8 B1 = *(const bf16x8*)(b1p + ks);
        c01 = __builtin_amdgcn_mfma_f32_16x16x32_bf16(B1, A0, c01, 0, 0, 0);
      }
    }
    {
      const int row = NTP + wid * 16 + fr, col = u * 16 + fq * 4;
      const f32x4 g = c00, up = c01;
      if (EPI == EPI_P) {
        if (col < IN_COLS) *(u32x2*)(WSP(bf16_t, OFF_P) + (size_t)row * PSTR + col) = pack4(g);
      } else if (EPI == EPI_RES) {
        const float* xi = xin_row(P, l, row);
        *(f32x4*)(P.out + (size_t)row * D + col) = *(const f32x4*)(xi + col) + g;
      } else {
        f32x4 r;
#pragma unroll
        for (int j = 0; j < 4; ++j) r[j] = silu(g[j]) * up[j];
        *(u32x2*)(WSP(bf16_t, OFF_P) + (size_t)row * DFF + col) = pack4(r);
      }
    }
  }
}

__device__ __forceinline__ float lbval(const Params& P, int l, int c) {
  const float* hb = P.in[I_HLB];
  const float a0 = hb[c], a1 = hb[256 + c], a2 = hb[512 + c], a3 = hb[768 + c];
  const float m = fmaxf(fmaxf(a0, a1), fmaxf(a2, a3));
  const float e0 = __expf(a0 - m), e1 = __expf(a1 - m), e2 = __expf(a2 - m), e3 = __expf(a3 - m);
  const float inv = 1.f / (e0 + e1 + e2 + e3);
  float s = 0.f;
  if (l >= 1) s += e1; if (l >= 2) s += e2; if (l >= 3) s += e3;
  return s * inv;
}

__device__ __forceinline__ void gdn_conv_emit(const Params& P, int g, int lane, int row, float s) {
  const int h = g % 6;
  if (g < 12) {
    const float ss = wave_sum(s * s);
    const float o = s * rsqrtf(ss + 1e-6f) * (g < 6 ? 0.125f : 1.f);
    (g < 6 ? WSP(bf16_t, OFF_GQ) : WSP(bf16_t, OFF_GK))[(size_t)row * 384 + h * 64 + lane] = f2bf(o);
  } else {
    WSP(bf16_t, OFF_GV)[(size_t)row * 384 + h * 64 + lane] = f2bf(s);
  }
}
__device__ __forceinline__ void gdn_gate_emit(const Params& P, int l, int h, int row) {
  const bf16_t* pr = WSP(bf16_t, OFF_P) + (size_t)row * PSTR;
  const float braw = bf2f(pr[1536 + h]), araw = bf2f(pr[1542 + h]);
  const float gg = -__expf(P.in[I_ALOG][l * 6 + h]) * softplus(araw + P.in[I_DTB][l * 6 + h]);
  WSP(float, OFF_GDEC)[(size_t)row * 8 + h] = __expf(gg);
  WSP(float, OFF_GBETA)[(size_t)row * 8 + h] = sigm(braw);
}
__device__ __forceinline__ void prep_gdn_prompt(const Params& P, int l, int ci) {
  const int lane = otid() & 63, wid = otid() >> 6;
  const int r0 = ci * 32, b = r0 / TSEQ, t0 = r0 % TSEQ;
  const bf16_t* p = WSP(bf16_t, OFF_P);
  for (int g = wid; g < 18; g += 8) {
    const int col = g * 64 + lane;
    const float* cw = P.in[I_CONVW] + (size_t)l * 4 * 1152 + col;
    const float c0 = cw[0], c1 = cw[1152], c2 = cw[2304], c3 = cw[3456];
    float xr[35];
#pragma unroll
    for (int t = 0; t < 35; ++t) xr[t] = (t >= 3 || t0 > 0) ? bf2f(p[(size_t)(r0 - 3 + t) * PSTR + col]) : 0.f;
#pragma unroll
    for (int t = 0; t < 32; ++t) {
      const float y = c0 * xr[t] + c1 * xr[t + 1] + c2 * xr[t + 2] + c3 * xr[t + 3];
      gdn_conv_emit(P, g, lane, r0 + t, silu(y));
    }
    if (t0 + 32 == TSEQ) {
      float* cp = P.out + O_CONV_P + (size_t)(l * 8 + b) * 3 * 1152 + col;
      cp[0] = xr[32]; cp[1152] = xr[33]; cp[2304] = xr[34];
    }
    if (g < 6 && lane < 32) gdn_gate_emit(P, l, g, r0 + lane);
  }
}
__device__ __forceinline__ void prep_gdn_sample(const Params& P, int l, int si) {
  const int lane = otid() & 63, wid = otid() >> 6;
  const bf16_t* p = WSP(bf16_t, OFF_P);
  for (int u = wid; u < 8 * 18; u += 8) {
    const int s = si * 8 + u / 18, g = u % 18, col = g * 64 + lane, row = NTP + s;
    const float* cw = P.in[I_CONVW] + (size_t)l * 4 * 1152 + col;
    const float c0 = cw[0], c1 = cw[1152], c2 = cw[2304], c3 = cw[3456];
    const float* cb = P.in[I_SCONV] + (size_t)(l * 128 + s) * 3 * 1152 + col;
    const float x3 = cb[0], x2 = cb[1152], x1 = cb[2304];
    const float x0 = bf2f(p[(size_t)row * PSTR + col]);
    const float y = c0 * x3 + c1 * x2 + c2 * x1 + c3 * x0;
    gdn_conv_emit(P, g, lane, row, silu(y));
    float* cp = P.out + O_CONV_S + (size_t)(l * 128 + s) * 3 * 1152 + col;
    cp[0] = x2; cp[1152] = x1; cp[2304] = x0;
    if (g < 6 && lane == 0) gdn_gate_emit(P, l, g, row);
  }
}
__device__ __forceinline__ void prep_hgrn(const Params& P, int l, int ti) {
  const int c = otid() & 255, th = otid() >> 8;
  const float oml = 1.f - lbval(P, l, c);
  const bf16_t* p = WSP(bf16_t, OFF_P);
  bf16_t* hq = WSP(bf16_t, OFF_HQ); bf16_t* hk = WSP(bf16_t, OFF_HK);
  for (int t = th * 32; t < th * 32 + 32; ++t) {
    const int row = ti * 64 + t;
    const float q = bf2f(p[(size_t)row * PSTR + PC + c]), f = bf2f(p[(size_t)row * PSTR + PC + 256 + c]);
    hq[(size_t)row * 256 + c] = f2bf(silu(q) * 0.125f);
    hk[(size_t)row * 256 + c] = f2bf(oml * sigm(-f));
  }
}
template <bool SAMP>
__device__ __forceinline__ f32x4 xs4t(const Params& P, int l, int row, int col0) {
  const bf16_t* p = WSP(bf16_t, OFF_P);
  const f32x4 pv = unpack4(*(const u32x2*)(p + (size_t)row * PSTR + PB + col0));
  f32x4 prev;
  if (SAMP) prev = *(const f32x4*)(P.in[I_SSHIFT] + (size_t)(l * 128 + (row - NTP)) * 1408 + col0);
  else {
    const bool first = (row & (TSEQ - 1)) == 0;
    prev = unpack4(*(const u32x2*)(p + (size_t)(row - (first ? 0 : 1)) * PSTR + PB + col0)) * (first ? 0.f : 1.f);
  }
  const f32x4 mu = *(const f32x4*)(P.in[I_MU] + l * 1408 + col0);
  return pv + (prev - pv) * mu;
}
__device__ __forceinline__ float tanh_fast(float x) { return 1.f - 2.f / (__expf(2.f * x) + 1.f); }

template <int ROWB>
__device__ __forceinline__ void stage_lora(unsigned char* smem, const bf16_t* __restrict__ src) {
  constexpr int CPR = ROWB / 16, NCH = 384 * CPR;
  __syncthreads();
  for (int idx = otid(); idx < NCH; idx += 512) {
    const int r = idx / CPR, c = idx - r * CPR;
    *(u32x4*)(smem + r * (ROWB + 16) + c * 16) = *(const u32x4*)((const unsigned char*)src + (size_t)idx * 16);
  }
  __syncthreads();
}
template <bool SAMP>
__device__ __forceinline__ void prep_rwkv_unit(const Params& P, unsigned char* smem, int l, int mt, int hh) {
  const int lane = otid() & 63, fr = lane & 15, fq = lane >> 4;
  const int row = mt * 16 + fr, cb = hh * 192;
  const bf16_t* lw = WSP(bf16_t, OFF_LORA);
  const size_t ro = (size_t)row * 384;
  f32x4 acc[12];
  {
    f32x4 x[2][2]; bf16x8 Bf[2][12];
    stage_lora<128>(smem, lw + W2T);
#pragma unroll
    for (int ks = 0; ks < 2; ++ks) { x[ks][0] = xs4t<SAMP>(P, l, row, 1152 + ks * 32 + fq * 8); x[ks][1] = xs4t<SAMP>(P, l, row, 1152 + ks * 32 + fq * 8 + 4); }
#pragma unroll
    for (int ks = 0; ks < 2; ++ks)
#pragma unroll
      for (int nf = 0; nf < 12; ++nf) Bf[ks][nf] = *(const bf16x8*)(smem + (cb + nf * 16 + fr) * 144 + ks * 64 + fq * 16);
#pragma unroll
    for (int nf = 0; nf < 12; ++nf) acc[nf] = (f32x4){0.f, 0.f, 0.f, 0.f};
#pragma unroll
    for (int ks = 0; ks < 2; ++ks) {
#pragma unroll
      for (int j = 0; j < 4; ++j) { x[ks][0][j] = tanh_fast(x[ks][0][j]); x[ks][1][j] = tanh_fast(x[ks][1][j]); }
      const bf16x8 A = pack8(x[ks][0], x[ks][1]);
#pragma unroll
      for (int nf = 0; nf < 12; ++nf) acc[nf] = __builtin_amdgcn_mfma_f32_16x16x32_bf16(Bf[ks][nf], A, acc[nf], 0, 0, 0);
    }
    f32x4 w0v[12];
#pragma unroll
    for (int nf = 0; nf < 12; ++nf) w0v[nf] = *(const f32x4*)(P.in[I_W0] + l * 384 + cb + nf * 16 + fq * 4);
#pragma unroll
    for (int nf = 0; nf < 12; ++nf) {
      f32x4 d;
#pragma unroll
      for (int j = 0; j < 4; ++j) {
        const float xx = -(w0v[nf][j] + acc[nf][j]);
        const float sp = xx > 15.f ? xx : __logf(1.f + __expf(xx));
        d[j] = __expf(-__expf(-sp - 0.5f));
      }
      *(f32x4*)(WSP(float, OFF_RW) + ro + cb + nf * 16 + fq * 4) = d;
    }
  }
  {
    f32x4 x[2][2]; bf16x8 Bf[2][12];
    stage_lora<128>(smem, lw + A2T);
#pragma unroll
    for (int ks = 0; ks < 2; ++ks) { x[ks][0] = xs4t<SAMP>(P, l, row, 1216 + ks * 32 + fq * 8); x[ks][1] = xs4t<SAMP>(P, l, row, 1216 + ks * 32 + fq * 8 + 4); }
#pragma unroll
    for (int ks = 0; ks < 2; ++ks)
#pragma unroll
      for (int nf = 0; nf < 12; ++nf) Bf[ks][nf] = *(const bf16x8*)(smem + (cb + nf * 16 + fr) * 144 + ks * 64 + fq * 16);
#pragma unroll
    for (int nf = 0; nf < 12; ++nf) acc[nf] = (f32x4){0.f, 0.f, 0.f, 0.f};
#pragma unroll
    for (int ks = 0; ks < 2; ++ks) {
      const bf16x8 A = pack8(x[ks][0], x[ks][1]);
#pragma unroll
      for (int nf = 0; nf < 12; ++nf) acc[nf] = __builtin_amdgcn_mfma_f32_16x16x32_bf16(Bf[ks][nf], A, acc[nf], 0, 0, 0);
    }
  }
#pragma unroll
  for (int hl = 0; hl < 3; ++hl) {
    f32x4 kr[4], rr[4], kkw[4], a0[4], ka[4];
#pragma unroll
    for (int q = 0; q < 4; ++q) {
      const int c = cb + (hl * 4 + q) * 16 + fq * 4;
      kr[q] = xs4t<SAMP>(P, l, row, 384 + c); rr[q] = xs4t<SAMP>(P, l, row, c);
      kkw[q] = *(const f32x4*)(P.in[I_KK] + l * 384 + c); a0[q] = *(const f32x4*)(P.in[I_A0] + l * 384 + c); ka[q] = *(const f32x4*)(P.in[I_KA] + l * 384 + c);
    }
    float ss = 0.f;
#pragma unroll
    for (int q = 0; q < 4; ++q) { kkw[q] = kr[q] * kkw[q]; ss += dot4(kkw[q], kkw[q]); }
    ss += __shfl_xor(ss, 16); ss += __shfl_xor(ss, 32);
    const float rn = rsqrtf(ss + 1e-6f);
#pragma unroll
    for (int q = 0; q < 4; ++q) {
      const int nf = hl * 4 + q, c = cb + nf * 16 + fq * 4;
      f32x4 kn, kk, kb;
#pragma unroll
      for (int j = 0; j < 4; ++j) {
        const float a = sigm(a0[q][j] + acc[nf][j]);
        kk[j] = kkw[q][j] * rn; kb[j] = kk[j] * a; kn[j] = kr[q][j] * (1.f + (a - 1.f) * ka[q][j]);
      }
      *(u32x2*)(WSP(bf16_t, OFF_RK) + ro + c) = pack4(kn);
      *(u32x2*)(WSP(bf16_t, OFF_RKK) + ro + c) = pack4(kk);
      *(u32x2*)(WSP(bf16_t, OFF_RB) + ro + c) = pack4(kb);
      *(u32x2*)(WSP(bf16_t, OFF_RR) + ro + c) = pack4(rr[q]);
    }
  }
  {
    f32x4 x[4][2];
    stage_lora<256>(smem, lw + G2T);
#pragma unroll
    for (int ks = 0; ks < 4; ++ks) { x[ks][0] = xs4t<SAMP>(P, l, row, 1280 + ks * 32 + fq * 8); x[ks][1] = xs4t<SAMP>(P, l, row, 1280 + ks * 32 + fq * 8 + 4); }
    bf16x8 A[4];
#pragma unroll
    for (int ks = 0; ks < 4; ++ks) {
#pragma unroll
      for (int j = 0; j < 4; ++j) { x[ks][0][j] = sigm(x[ks][0][j]); x[ks][1][j] = sigm(x[ks][1][j]); }
      A[ks] = pack8(x[ks][0], x[ks][1]);
    }
#pragma unroll
    for (int hf = 0; hf < 2; ++hf) {
      bf16x8 Bf[4][6];
#pragma unroll
      for (int ks = 0; ks < 4; ++ks)
#pragma unroll
        for (int n6 = 0; n6 < 6; ++n6) Bf[ks][n6] = *(const bf16x8*)(smem + (cb + (hf * 6 + n6) * 16 + fr) * 272 + ks * 64 + fq * 16);
#pragma unroll
      for (int n6 = 0; n6 < 6; ++n6) {
        f32x4 g = (f32x4){0.f, 0.f, 0.f, 0.f};
#pragma unroll
        for (int ks = 0; ks < 4; ++ks) g = __builtin_amdgcn_mfma_f32_16x16x32_bf16(Bf[ks][n6], A[ks], g, 0, 0, 0);
        *(u32x2*)(WSP(bf16_t, OFF_RG) + ro + cb + (hf * 6 + n6) * 16 + fq * 4) = pack4(g);
      }
    }
  }
  if (l == 0) {
    f32x4 v[12];
#pragma unroll
    for (int nf = 0; nf < 12; ++nf) v[nf] = xs4t<SAMP>(P, l, row, 768 + cb + nf * 16 + fq * 4);
#pragma unroll
    for (int nf = 0; nf < 12; ++nf) {
      const int c = cb + nf * 16 + fq * 4;
      const u32x2 o = pack4(v[nf]);
      *(u32x2*)(WSP(bf16_t, OFF_RV) + ro + c) = o;
      *(u32x2*)(WSP(bf16_t, OFF_VF) + ro + c) = o;
    }
  } else {
    f32x4 lo0 = (f32x4){0.f, 0.f, 0.f, 0.f}, lo1 = lo0;
#pragma unroll
    for (int hf = 0; hf < 2; ++hf) {
      f32x4 x[6][2]; bf16x8 B0[6], B1[6];
#pragma unroll
      for (int k6 = 0; k6 < 6; ++k6) {
        const int ks = hf * 6 + k6;
        x[k6][0] = xs4t<SAMP>(P, l, row, 768 + ks * 32 + fq * 8); x[k6][1] = xs4t<SAMP>(P, l, row, 768 + ks * 32 + fq * 8 + 4);
        B0[k6] = *(const bf16x8*)(lw + V1T + fr * 384 + ks * 32 + fq * 8);
        B1[k6] = *(const bf16x8*)(lw + V1T + (16 + fr) * 384 + ks * 32 + fq * 8);
      }
#pragma unroll
      for (int k6 = 0; k6 < 6; ++k6) {
        const bf16x8 A = pack8(x[k6][0], x[k6][1]);
        lo0 = __builtin_amdgcn_mfma_f32_16x16x32_bf16(B0[k6], A, lo0, 0, 0, 0);
        lo1 = __builtin_amdgcn_mfma_f32_16x16x32_bf16(B1[k6], A, lo1, 0, 0, 0);
      }
    }
    const bf16x8 A2 = pack8(lo0, lo1);
#pragma unroll
    for (int hf = 0; hf < 2; ++hf) {
      u32x4 bw[6]; f32x4 v0[6], v[6]; u32x2 vf[6];
#pragma unroll
      for (int n6 = 0; n6 < 6; ++n6) {
        const int nf = hf * 6 + n6, c = cb + nf * 16 + fq * 4;
        const bf16_t* vr = lw + V2T + (cb + nf * 16 + fr) * 32;
        const u32x2 b0 = *(const u32x2*)(vr + fq * 4), b1 = *(const u32x2*)(vr + 16 + fq * 4);
        bw[n6][0] = b0[0]; bw[n6][1] = b0[1]; bw[n6][2] = b1[0]; bw[n6][3] = b1[1];
        v0[n6] = *(const f32x4*)(P.in[I_V0] + (l - 1) * 384 + c);
        v[n6] = xs4t<SAMP>(P, l, row, 768 + c);
        vf[n6] = *(const u32x2*)(WSP(bf16_t, OFF_VF) + ro + c);
      }
#pragma unroll
      for (int n6 = 0; n6 < 6; ++n6) {
        const int c = cb + (hf * 6 + n6) * 16 + fq * 4;
        const f32x4 mv = __builtin_amdgcn_mfma_f32_16x16x32_bf16(__builtin_bit_cast(bf16x8, bw[n6]), A2, (f32x4){0.f, 0.f, 0.f, 0.f}, 0, 0, 0);
        const f32x4 vfv = unpack4(vf[n6]);
        f32x4 o;
#pragma unroll
        for (int j = 0; j < 4; ++j) o[j] = v[n6][j] + (vfv[j] - v[n6][j]) * sigm(v0[n6][j] + mv[j]);
        *(u32x2*)(WSP(bf16_t, OFF_RV) + ro + c) = pack4(o);
      }
    }
  }
}
__device__ __forceinline__ void prep_phase(const Params& P, unsigned char* smem, int l) {
  for (int it = obid(); it < 1044; it += gridDim.x) {
    if (it < 256) { const int wid = otid() >> 6; prep_rwkv_unit<false>(P, smem, l, it * 4 + (wid >> 1), wid & 1); }
    else if (it < 258) { const int wid = otid() >> 6; prep_rwkv_unit<true>(P, smem, l, it * 4 + (wid >> 1), wid & 1); }
    else if (it < 770) prep_gdn_prompt(P, l, it - 258);
    else if (it < 786) prep_gdn_sample(P, l, it - 770);
    else prep_hgrn(P, l, it - 786);
  }
  const bf16_t* p = WSP(bf16_t, OFF_P);
  for (int idx = obid() * 512 + otid(); idx < 136 * 1408; idx += gridDim.x * 512) {
    const int q = idx / 1408, col = idx - q * 1408;
    if (q < 8) P.out[O_SHIFT_P + (size_t)(l * 8 + q) * 1408 + col] = bf2f(p[(size_t)(q * TSEQ + TSEQ - 1) * PSTR + PB + col]);
    else P.out[O_SHIFT_S + (size_t)(l * 128 + (q - 8)) * 1408 + col] = bf2f(p[(size_t)(NTP + q - 8) * PSTR + PB + col]);
  }
}

template <int KIND> struct ScanCfg { static constexpr int STRIDE = KIND == 1 ? 356 : 164; };
typedef float f32x2 __attribute__((ext_vector_type(2)));
__device__ __forceinline__ float row_sum16(float v) { v += dppf<0xB1>(v); v += dppf<0x4E>(v); v += dppf<0x141>(v); v += dppf<0x140>(v); return v; }

template <int KIND> struct ScanPre { u32x2 a, b, c, d, v; f32x4 w; float g; };

template <int KIND>
__device__ __forceinline__ void scan_load(const Params& P, ScanPre<KIND>& r, int tid, int h, int half, int rowbase, int nvalid) {
  const int s = tid >> 4, j4 = (tid & 15) * 4;
  const int s2 = (tid >> 3) & 15, j2 = (tid & 7) * 4;
  const u32x2 z2 = {0u, 0u};
  const bool ok = s < nvalid, ok2 = (tid < 128) && (s2 < nvalid);
  if (KIND == 0) {
    const size_t o = (size_t)(rowbase + s) * 384 + h * 64 + j4;
    r.a = ok ? *(const u32x2*)(WSP(bf16_t, OFF_GK) + o) : z2;
    r.b = ok ? *(const u32x2*)(WSP(bf16_t, OFF_GQ) + o) : z2;
    r.v = ok2 ? *(const u32x2*)(WSP(bf16_t, OFF_GV) + (size_t)(rowbase + s2) * 384 + h * 64 + half * 32 + j2) : z2;
    const int sg = (tid >> 1) & 15;
    r.g = (tid < 32 && sg < nvalid) ? ((tid & 1) ? WSP(float, OFF_GBETA) : WSP(float, OFF_GDEC))[(size_t)(rowbase + sg) * 8 + h] : 0.f;
  } else if (KIND == 1) {
    const size_t o = (size_t)(rowbase + s) * 384 + h * 64 + j4;
    r.a = ok ? *(const u32x2*)(WSP(bf16_t, OFF_RR) + o) : z2;
    r.w = ok ? *(const f32x4*)(WSP(float, OFF_RW) + o) : (f32x4){0.f, 0.f, 0.f, 0.f};
    r.b = ok ? *(const u32x2*)(WSP(bf16_t, OFF_RK) + o) : z2;
    r.c = ok ? *(const u32x2*)(WSP(bf16_t, OFF_RKK) + o) : z2;
    r.d = ok ? *(const u32x2*)(WSP(bf16_t, OFF_RB) + o) : z2;
    r.v = ok2 ? *(const u32x2*)(WSP(bf16_t, OFF_RV) + (size_t)(rowbase + s2) * 384 + h * 64 + half * 32 + j2) : z2;
  } else {
    const size_t o = (size_t)(rowbase + s) * 256 + h * 64 + j4;
    r.a = ok ? *(const u32x2*)(WSP(bf16_t, OFF_HQ) + o) : z2;
    r.b = ok ? *(const u32x2*)(WSP(bf16_t, OFF_HK) + o) : z2;
    r.v = ok2 ? *(const u32x2*)(WSP(bf16_t, OFF_P) + (size_t)(rowbase + s2) * PSTR + PC + 512 + h * 64 + half * 32 + j2) : z2;
  }
}
template <int KIND>
__device__ __forceinline__ void scan_store(const ScanPre<KIND>& r, int tid, float* buf) {
  constexpr int STRIDE = ScanCfg<KIND>::STRIDE;
  const int s = tid >> 4, j4 = (tid & 15) * 4;
  const int s2 = (tid >> 3) & 15, j2 = (tid & 7) * 4;
  float* bs = buf + s * STRIDE + j4;
  if (KIND == 0) {
    const f32x4 k = unpack4(r.a), q = unpack4(r.b);
    *(f32x4*)(bs) = k; *(f32x4*)(bs + 64) = q;
    const float qk = row_sum16(dot4(q, k));
    if ((tid & 15) == 0) buf[s * STRIDE + 162] = qk;
    if (tid < 128) *(f32x4*)(buf + s2 * STRIDE + 128 + j2) = unpack4(r.v);
    if (tid < 32) buf[((tid >> 1) & 15) * STRIDE + 160 + (tid & 1)] = r.g;
  } else if (KIND == 1) {
    const f32x4 rr = unpack4(r.a), k = unpack4(r.b), kk = unpack4(r.c), bb = unpack4(r.d);
    *(f32x4*)(bs) = r.w * rr; *(f32x4*)(bs + 64) = r.w; *(f32x4*)(bs + 128) = k;
    *(f32x4*)(bs + 192) = kk; *(f32x4*)(bs + 256) = bb;
    const float br = row_sum16(dot4(bb, rr)), kr = row_sum16(dot4(k, rr));
    if ((tid & 15) == 0) { buf[s * STRIDE + 352] = br; buf[s * STRIDE + 353] = kr; }
    if (tid < 128) *(f32x4*)(buf + s2 * STRIDE + 320 + j2) = unpack4(r.v);
  } else {
    const f32x4 q = unpack4(r.a), k = unpack4(r.b);
    *(f32x4*)(bs) = q * (1.f - k); *(f32x4*)(bs + 64) = k;
    const float qk = row_sum16(dot4(q, k));
    if ((tid & 15) == 0) buf[s * STRIDE + 160] = qk;
    if (tid < 128) *(f32x4*)(buf + s2 * STRIDE + 128 + j2) = unpack4(r.v);
  }
}

template <int KIND> struct StepOps { f32x2 a[4], b[4], c[4], d[4], e[4]; float v, s0, s1, s2; };
template <int KIND>
__device__ __forceinline__ void step_load(StepOps<KIND>& o, const float* bs, int e0, int cl) {
#define LD8(dst, off) { const f32x4 _x = *(const f32x4*)(bs + (off) + e0), _y = *(const f32x4*)(bs + (off) + e0 + 4); \
    dst[0] = (f32x2){_x[0], _x[1]}; dst[1] = (f32x2){_x[2], _x[3]}; dst[2] = (f32x2){_y[0], _y[1]}; dst[3] = (f32x2){_y[2], _y[3]}; }
  if (KIND == 0) {
    LD8(o.a, 0) LD8(o.b, 64)
    o.v = bs[128 + cl];
    const f32x4 sc = *(const f32x4*)(bs + 160); o.s0 = sc[0]; o.s1 = sc[1]; o.s2 = sc[2];
  } else if (KIND == 1) {
    LD8(o.a, 0) LD8(o.b, 64) LD8(o.c, 128) LD8(o.d, 192) LD8(o.e, 256)
    o.v = bs[320 + cl];
    const f32x2 sc = *(const f32x2*)(bs + 352); o.s0 = sc[0]; o.s1 = sc[1];
  } else {
    LD8(o.a, 0) LD8(o.b, 64)
    o.v = bs[128 + cl]; o.s0 = bs[160];
  }
#undef LD8
}
template <int KIND>
__device__ __forceinline__ float step_compute(const StepOps<KIND>& o, f32x2 (&S)[4]) {
  if (KIND == 0) {
    f32x2 ks2 = o.a[0] * S[0], qs2 = o.b[0] * S[0];
#pragma unroll
    for (int i = 1; i < 4; ++i) { ks2 += o.a[i] * S[i]; qs2 += o.b[i] * S[i]; }
    float ks = ks2[0] + ks2[1], qs = qs2[0] + qs2[1];
    ks += dppf<0xB1>(ks); qs += dppf<0xB1>(qs); ks += dppf<0x4E>(ks); qs += dppf<0x4E>(qs); ks += dppf<0x141>(ks); qs += dppf<0x141>(qs);
    const float dec = o.s0, vn = o.s1 * (o.v - dec * ks);
#pragma unroll
    for (int i = 0; i < 4; ++i) S[i] = S[i] * dec + o.a[i] * vn;
    return dec * qs + vn * o.s2;
  } else if (KIND == 1) {
    f32x2 sa2 = o.d[0] * S[0], p2 = o.a[0] * S[0];
#pragma unroll
    for (int i = 1; i < 4; ++i) { sa2 += o.d[i] * S[i]; p2 += o.a[i] * S[i]; }
    float sa = sa2[0] + sa2[1], p1 = p2[0] + p2[1];
    sa += dppf<0xB1>(sa); p1 += dppf<0xB1>(p1); sa += dppf<0x4E>(sa); p1 += dppf<0x4E>(p1); sa += dppf<0x141>(sa); p1 += dppf<0x141>(p1);
    sa = -sa;
#pragma unroll
    for (int i = 0; i < 4; ++i) S[i] = S[i] * o.b[i] + (o.e[i] * sa + o.c[i] * o.v);
    return p1 + sa * o.s0 + o.v * o.s1;
  } else {
    f32x2 p2 = o.a[0] * S[0];
#pragma unroll
    for (int i = 1; i < 4; ++i) p2 += o.a[i] * S[i];
    float p1 = p2[0] + p2[1];
    p1 += dppf<0xB1>(p1); p1 += dppf<0x4E>(p1); p1 += dppf<0x141>(p1);
#pragma unroll
    for (int i = 0; i < 4; ++i) S[i] = S[i] + o.b[i] * (o.v - S[i]);
    return p1 + o.v * o.s0;
  }
}

template <int KIND>
__device__ __forceinline__ void scan_task(const Params& P, unsigned char* smem, int l, int seq, int h, int half, bool active) {
  constexpr int STRIDE = ScanCfg<KIND>::STRIDE, NEL = 16 * STRIDE;
  constexpr int NH = KIND == 2 ? 4 : 6;
  float* buf = (float*)smem;
  float* obuf = buf + 2 * NEL;
  const int tid = otid() & 255, lane = tid & 63, wid = tid >> 6;
  const int col_l = lane >> 3, sub = lane & 7, cl = wid * 8 + col_l, col = half * 32 + cl, e0 = sub * 8;
  const bool sample = seq >= 8;
  const int R0 = sample ? NTP + (seq - 8) : seq * TSEQ, T = sample ? 1 : TSEQ;
  const int ocol = (KIND == 0 ? 0 : (KIND == 1 ? 384 : 768)) + h * 64 + half * 32;
  const size_t O_P = KIND == 0 ? O_GDN_P : (KIND == 1 ? O_RWKV_P : O_HGRN_P);
  const size_t O_S = KIND == 0 ? O_GDN_S : (KIND == 1 ? O_RWKV_S : O_HGRN_S);
  const int I_ST = KIND == 0 ? I_SGDN : (KIND == 1 ? I_SRWKV : I_SHGRN);
  f32x2 S[4];
#pragma unroll
  for (int i = 0; i < 4; ++i) S[i] = (f32x2){0.f, 0.f};
  if (sample && active) {
    const float* st = P.in[I_ST] + ((size_t)(l * 128 + (seq - 8)) * NH + h) * 4096;
#pragma unroll
    for (int i = 0; i < 8; ++i) S[i >> 1][i & 1] = KIND == 1 ? st[col * 64 + e0 + i] : st[(e0 + i) * 64 + col];
  }
  ScanPre<KIND> pre;
  __syncthreads();
  if (active) { scan_load<KIND>(P, pre, tid, h, half, R0, T); scan_store<KIND>(pre, tid, buf); }
  __syncthreads();
  const int nchunks = (T + 15) >> 4;
  bf16_t* oraw = WSP(bf16_t, OFF_P);
  for (int c = 0; c < nchunks; ++c) {
    if (active) {
      const int t0 = c * 16, n = (T - t0) < 16 ? (T - t0) : 16;
      const bool has_next = c + 1 < nchunks;
      if (has_next) scan_load<KIND>(P, pre, tid, h, half, R0 + t0 + 16, T - t0 - 16);
      if (c > 0) {
        const float* pob = obuf + ((c - 1) & 1) * 512;
#pragma unroll
        for (int i = 0; i < 2; ++i) {
          const int idx = tid + i * 256, s = idx >> 5, cc = idx & 31;
          oraw[(size_t)(R0 + t0 - 16 + s) * PSTR + ocol + cc] = f2bf(pob[idx]);
        }
      }
      const float* b = buf + (c & 1) * NEL;
      float* ob = obuf + (c & 1) * 512;
      if (n == 16) {
        StepOps<KIND> A, B;
        step_load<KIND>(A, b, e0, cl);
#pragma unroll 1
        for (int s = 0; s < 16; s += 2) {
          step_load<KIND>(B, b + (s + 1) * STRIDE, e0, cl);
          const float o0 = step_compute<KIND>(A, S);
          if (sub == 0) ob[s * 32 + cl] = o0;
          step_load<KIND>(A, b + (s + 2 < 16 ? s + 2 : 15) * STRIDE, e0, cl);
          const float o1 = step_compute<KIND>(B, S);
          if (sub == 0) ob[(s + 1) * 32 + cl] = o1;
        }
      } else {
        for (int s = 0; s < n; ++s) {
          StepOps<KIND> A;
          step_load<KIND>(A, b + s * STRIDE, e0, cl);
          const float o0 = step_compute<KIND>(A, S);
          if (sub == 0) ob[s * 32 + cl] = o0;
        }
      }
      if (has_next) scan_store<KIND>(pre, tid, buf + ((c + 1) & 1) * NEL);
    }
    __syncthreads();
  }
  if (active) {
    {
      const int c = nchunks - 1, t0 = c * 16, n = T - t0;
      const float* pob = obuf + (c & 1) * 512;
#pragma unroll
      for (int i = 0; i < 2; ++i) {
        const int idx = tid + i * 256, s = idx >> 5, cc = idx & 31;
        if (s < n) oraw[(size_t)(R0 + t0 + s) * PSTR + ocol + cc] = f2bf(pob[idx]);
      }
    }
    float* so = P.out + (sample ? O_S + ((size_t)(l * 128 + (seq - 8)) * NH + h) * 4096 : O_P + ((size_t)(l * 8 + seq) * NH + h) * 4096);
#pragma unroll
    for (int i = 0; i < 8; ++i) { if (KIND == 1) so[col * 64 + e0 + i] = S[i >> 1][i & 1]; else so[(e0 + i) * 64 + col] = S[i >> 1][i & 1]; }
  }
}

__device__ __forceinline__ void scan_phase(const Params& P, unsigned char* smem, int l, volatile unsigned* blk  ) {
  unsigned* q = WSP(unsigned, OFF_QUEUE) + l * 128;
  const int grp = otid() >> 8;
  for (int pass = 0; pass < 2; ++pass) {
    unsigned* qq = pass == 1 ? q + 64 : q;
    const unsigned ntask = pass == 1 ? 2048u : 256u;
    for (;;) {
      __syncthreads();
      if (threadIdx.x == 0) blk[3] = __hip_atomic_fetch_add(qq, 1u, __ATOMIC_RELAXED, __HIP_MEMORY_SCOPE_AGENT);
      __syncthreads();
      const int t = (int)blk[3];
      if (t >= (int)ntask) break;
      int kind, seq, h, half; bool act; unsigned char* sm;
      if (pass == 0) {
        act = grp == 0; sm = smem; half = t & 1;
        if (t < 96) { kind = 1; const int bh = t >> 1; seq = bh / 6; h = bh % 6; }
        else if (t < 192) { kind = 0; const int bh = (t - 96) >> 1; seq = bh / 6; h = bh % 6; }
        else { kind = 2; const int bh = (t - 192) >> 1; seq = bh / 4; h = bh % 4; }
      } else {
        const int hh = t & 15;
        act = true; sm = smem + grp * 51200; half = grp; seq = 8 + (t >> 4);
        if (hh < 6) { kind = 0; h = hh; } else if (hh < 12) { kind = 1; h = hh - 6; } else { kind = 2; h = hh - 12; }
      }
      if (kind == 0) scan_task<0>(P, sm, l, seq, h, half, act);
      else if (kind == 1) scan_task<1>(P, sm, l, seq, h, half, act);
      else scan_task<2>(P, sm, l, seq, h, half, act);
    }
  }
  if (l + 1 < NLAYER) {
    for (;;) {
      __syncthreads();
      if (threadIdx.x == 0) blk[3] = __hip_atomic_fetch_add(q + 96, 1u, __ATOMIC_RELAXED, __HIP_MEMORY_SCOPE_AGENT);
      __syncthreads();
      const unsigned t = blk[3];
      if (t >= (unsigned)WCONV_JOBS) break;
      wconv_job(P, smem, l + 1, (int)t);
    }
  }
}

__device__ __forceinline__ void post_phase(const Params& P, int l) {
  const int lane = otid() & 63, wid = otid() >> 6;
  const bf16_t* p = WSP(bf16_t, OFF_P);
  bf16_t* act = WSP(bf16_t, OFF_ACT);
  const int gw = obid() * 8 + wid, nw = gridDim.x * 8;
  const float gnw = P.in[I_GNW][l * 64 + lane], hnw = P.in[I_HNW][l * 64 + lane];
  for (int u0 = gw * 4; u0 < NTOK * 10; u0 += nw * 4) {
    float o[4], z[4]; int oc[4]; size_t rb[4];
#pragma unroll
    for (int k = 0; k < 4; ++k) {
      const int u = u0 + k, row = u / 10, q = u - row * 10;
      oc[k] = q < 6 ? q * 64 : 768 + (q - 6) * 64;
      const int zc = q < 6 ? 1152 + q * 64 : PC + 768 + (q - 6) * 64;
      rb[k] = (size_t)row;
      o[k] = bf2f(p[(size_t)row * PSTR + oc[k] + lane]);
      z[k] = bf2f(p[(size_t)row * PSTR + zc + lane]);
    }
#pragma unroll
    for (int k = 0; k < 4; ++k) {
      const float ms = wave_sum(o[k] * o[k]) * (1.f / 64.f);
      const float out = o[k] * rsqrtf(ms + 1e-6f) * (oc[k] < 384 ? gnw : hnw) * silu(z[k]);
      act[rb[k] * 1024 + oc[k] + lane] = f2bf(out);
    }
  }
  for (int u0 = gw * 2; u0 < NTOK * 6; u0 += nw * 2) {
    float o[2], r[2], kx[2], v[2], g[2]; int hh[2]; size_t rb[2];
#pragma unroll
    for (int k = 0; k < 2; ++k) {
      const int u = u0 + k, row = u / 6, h = u - row * 6;
      const size_t idx = (size_t)row * 384 + h * 64 + lane;
      hh[k] = h; rb[k] = (size_t)row;
      o[k] = bf2f(p[(size_t)row * PSTR + 384 + h * 64 + lane]);
      r[k] = bf2f(WSP(bf16_t, OFF_RR)[idx]); kx[k] = bf2f(WSP(bf16_t, OFF_RK)[idx]);
      v[k] = bf2f(WSP(bf16_t, OFF_RV)[idx]); g[k] = bf2f(WSP(bf16_t, OFF_RG)[idx]);
    }
#pragma unroll
    for (int k = 0; k < 2; ++k) {
      const int hc = l * 384 + hh[k] * 64 + lane;
      const float mu = wave_sum(o[k]) * (1.f / 64.f);
      const float yc = o[k] - mu;
      const float var = wave_sum(yc * yc) * (1.f / 64.f);
      const float y = yc * rsqrtf(var + 64e-5f) * P.in[I_LNW][hc] + P.in[I_LNB][hc];
      const float rk = wave_sum(r[k] * kx[k] * P.in[I_RK][hc]);
      act[rb[k] * 1024 + 384 + hh[k] * 64 + lane] = f2bf((y + rk * v[k]) * g[k]);
    }
  }
}

#define XB_TMO      128
#define XB_XCNT(j)  (256  + 64 * (j))
#define XB_XSUB(j)  (1280 + 64 * (j))
#define XB_XGEN(j)  (2304 + 64 * (j))
#define XB_TOP      3328
#define XB_TOPGEN   3392
#define XCD_BAR_WORDS 3456
#define XB_SPIN_CAP (1u << 20)
#define LAS __attribute__((address_space(3)))
__device__ __forceinline__ unsigned xb_ld(unsigned* p)              { return __hip_atomic_load(p, __ATOMIC_RELAXED, __HIP_MEMORY_SCOPE_AGENT); }
__device__ __forceinline__ unsigned xb_add(unsigned* p, unsigned v) { return __hip_atomic_fetch_add(p, v, __ATOMIC_RELAXED, __HIP_MEMORY_SCOPE_AGENT); }
__device__ __forceinline__ unsigned xb_xcc_id() { return (unsigned)__builtin_amdgcn_s_getreg((3 << 11) | 20) & 0xFu; }
#define XB_SPIN(cond, bar) do { unsigned _sp = 0; while (cond) { __builtin_amdgcn_s_sleep(1); \
    if ((++_sp & 255u) == 0u) { if (xb_ld(&(bar)[XB_TMO])) break; if (_sp > XB_SPIN_CAP) { atomicAdd(&(bar)[XB_TMO], 1u); break; } } } } while (0)
struct XcdBarrier { unsigned* bar; unsigned x; volatile LAS unsigned* st; };
__device__ __forceinline__ XcdBarrier xcd_barrier_post(unsigned* bar, volatile LAS unsigned* st) {
  XcdBarrier b; b.bar = bar; b.x = xb_xcc_id(); b.st = st;
  if (threadIdx.x == 0) (void)xb_add(&bar[XB_XCNT(b.x)], 1u);
  return b;
}
__device__ __forceinline__ void xcd_barrier_complete(unsigned* bar, unsigned x, unsigned& nloc, unsigned& nx) {
  const unsigned G = gridDim.x * gridDim.y * gridDim.z;
  unsigned sum, cnt, mine, sp = 0u;
  for (;;) {
    sum = 0u; cnt = 0u; mine = 0u;
#pragma unroll
    for (unsigned j = 0; j < 16; ++j) { const unsigned c = xb_ld(&bar[XB_XCNT(j)]); sum += c; cnt += (c > 0u) ? 1u : 0u; mine = (j == x) ? c : mine; }
    if (sum == G) break;
    __builtin_amdgcn_s_sleep(1);
    if ((++sp & 255u) == 0u) { if (xb_ld(&bar[XB_TMO])) break; if (sp > XB_SPIN_CAP) { atomicAdd(&bar[XB_TMO], 1u); break; } }
  }
  nloc = mine > 0u ? mine : 1u; nx = cnt > 0u ? cnt : 1u;
}
__device__ __forceinline__ void xcd_barrier(const XcdBarrier& b) {
  asm volatile("s_waitcnt vmcnt(0)" ::: "memory");
  __syncthreads();
  if (threadIdx.x == 0) {
    unsigned* bar = b.bar;
    __builtin_amdgcn_s_waitcnt(0);
    unsigned nloc = b.st[0], nx = b.st[1];
    if (nloc == 0u) { xcd_barrier_complete(bar, b.x, nloc, nx); b.st[0] = nloc; b.st[1] = nx; }
    const unsigned old = xb_add(&bar[XB_XSUB(b.x)], 1u);
    const unsigned gen = old / nloc;
    if (old + 1u == (gen + 1u) * nloc) {
      __builtin_amdgcn_fence(__ATOMIC_RELEASE, "agent");
      asm volatile("s_waitcnt vmcnt(0)" ::: "memory");
      const unsigned og = xb_add(&bar[XB_TOP], 1u);
      const unsigned tg = og / nx;
      if (og + 1u == (tg + 1u) * nx) xb_add(&bar[XB_TOPGEN], 1u);
      else XB_SPIN(xb_ld(&bar[XB_TOPGEN]) == tg, bar);
      __builtin_amdgcn_fence(__ATOMIC_ACQUIRE, "agent");
      xb_add(&bar[XB_XGEN(b.x)], 1u);
      asm volatile("s_waitcnt vmcnt(0)" ::: "memory");
    } else {
      XB_SPIN(xb_ld(&bar[XB_XGEN(b.x)]) == gen, bar);
      __builtin_amdgcn_fence(__ATOMIC_ACQUIRE, "agent");
      asm volatile("s_waitcnt vmcnt(0)" ::: "memory");
    }
  }
  __syncthreads();
}

__global__ void __launch_bounds__(512, 2) hybrid_fwd(Params P) {
  cg::grid_group grid = cg::this_grid();
  __shared__ __attribute__((aligned(16))) unsigned char smem[131072 + 64];
  uint4& xb_words = *(uint4*)(smem + 131072);
  if (threadIdx.x == 0) xb_words = make_uint4(0u, 0u, 0u, 0u);
  __syncthreads();
  const XcdBarrier xb = xcd_barrier_post(WSP(unsigned, OFF_BAR), (volatile LAS unsigned*)&xb_words);
  if (threadIdx.x == 0) {
    const unsigned hw = (unsigned)__builtin_amdgcn_s_getreg((7 << 11) | (8 << 6) | 4) & 0xffu;
    const unsigned key = (xb.x << 8) | hw;
    ((volatile unsigned*)&xb_words)[2] = __hip_atomic_fetch_add(WSP(unsigned, OFF_CUTAB) + key, 1u, __ATOMIC_RELAXED, __HIP_MEMORY_SCOPE_AGENT);
  }
  __syncthreads();
#pragma unroll 1
  for (int step = 0; step < NLAYER * 9; ++step) {
    const int l = step / 9, ph = step - l * 9;
    switch (ph) {
      case 0: if (l == 0) wconv_phase(P, smem, 0); norm_phase(P, l, P.in[I_NORM_MIX] + l * D); break;
      case 1: gemm_phase<EPI_P>(P, smem, WSP(bf16_t, OFF_ACT), 1024, WSP(bf16_t, OFF_WTIN), 1024, 32, l, 4096);
              gemm_sample<EPI_P>(P, WSP(bf16_t, OFF_ACT), 1024, WSP(bf16_t, OFF_WTIN), 1024, 249, l); break;
      case 2: prep_phase(P, smem, l); break;
      case 3: scan_phase(P, smem, l, (volatile unsigned*)&xb_words); break;
      case 4: post_phase(P, l); break;
      case 5: gemm_phase<EPI_RES>(P, smem, WSP(bf16_t, OFF_ACT), 1024, WSP(bf16_t, wt_out_off(l)), 1024, 8, l, 1024);
              gemm_sample<EPI_RES>(P, WSP(bf16_t, OFF_ACT), 1024, WSP(bf16_t, wt_out_off(l)), 1024, 64, l); break;
      case 6: norm_phase(P, 1, P.in[I_NORM_FFN] + l * D); break;
      case 7: gemm_phase<EPI_SWIGLU>(P, smem, WSP(bf16_t, OFF_ACT), 1024, WSP(bf16_t, wt_gu_off(l)), 1024, 44, 1, 5632);
              gemm_sample<EPI_SWIGLU>(P, WSP(bf16_t, OFF_ACT), 1024, WSP(bf16_t, wt_gu_off(l)), 1024, 176, 1); break;
      default: gemm_phase<EPI_RES>(P, smem, WSP(bf16_t, OFF_P), DFF, WSP(bf16_t, wt_dn_off(l)), DFF, 8, 1, 1024);
               gemm_sample<EPI_RES>(P, WSP(bf16_t, OFF_P), DFF, WSP(bf16_t, wt_dn_off(l)), DFF, 64, 1); break;
    }
    if (step == 0) grid.sync();
    else xcd_barrier(xb);
  }
  final_norm_phase(P);
}

extern "C" void kernel_launch(void* const* d_in, const int* in_sizes, int n_in,
                              void* d_out, int out_size, void* d_ws, size_t ws_size,
                              hipStream_t stream) {
  static int grid_blocks = 0;
  if (!grid_blocks) {
    int dev = 0, cus = 0, per_cu = 0;
    (void)hipGetDevice(&dev);
    (void)hipDeviceGetAttribute(&cus, hipDeviceAttributeMultiprocessorCount, dev);
    (void)hipOccupancyMaxActiveBlocksPerMultiprocessor(&per_cu, hybrid_fwd, 512, 0);
    if (per_cu > 1) per_cu = 1;
    if (per_cu < 1) per_cu = 1;
    grid_blocks = cus * per_cu;
  }
  if (ws_size < WS_NEED) { fprintf(stderr, "workspace too small: %zu < %zu\n", ws_size, (size_t)WS_NEED); return; }
  Params p{};
  for (int i = 0; i < N_IN; ++i) p.in[i] = (const float*)d_in[i];
  p.out = (float*)d_out;
  p.ws = (unsigned char*)d_ws;
  (void)hipMemsetAsync((unsigned char*)d_ws + OFF_BAR, 0, BAR_BYTES, stream);
  void* args[] = {&p};
  hipError_t e = hipLaunchCooperativeKernel((void*)hybrid_fwd, dim3(grid_blocks), dim3(512), args, 0, stream);
  if (e != hipSuccess) fprintf(stderr, "cooperative launch failed: %s (grid %d)\n", hipGetErrorString(e), grid_blocks);
}
```

```cpp
#include <hip/hip_runtime.h>
#include <hip/hip_cooperative_groups.h>
#include <cstdio>
namespace cg = cooperative_groups;

typedef unsigned short bf16_t;
typedef short bf16x8 __attribute__((ext_vector_type(8)));
typedef float f32x4 __attribute__((ext_vector_type(4)));
typedef unsigned u32x4 __attribute__((ext_vector_type(4)));
typedef unsigned u32x2 __attribute__((ext_vector_type(2)));

constexpr int D = 1024, NTP = 16384, NTS = 128, NTOK = 16512, TSEQ = 2048, NLAYER = 4;
constexpr int IN_COLS = 3980, PSTR = 3984, DFF = 2816;
constexpr int PB = 1548, PC = 2956;

enum { I_XP = 0, I_XS, I_SGDN, I_SCONV, I_SRWKV, I_SSHIFT, I_SHGRN, I_NORM_MIX, I_WIN, I_WOUT, I_CONVW, I_ALOG, I_DTB, I_GNW,
       I_MU, I_W0, I_W2, I_A0, I_A2, I_G2, I_V0, I_V1, I_V2, I_KK, I_KA, I_RK, I_LNW, I_LNB, I_HLB, I_HNW, I_NORM_FFN,
       I_WG, I_WU, I_WD, I_NORM_FINAL, N_IN };

constexpr size_t O_YP = 0, O_YS = 16777216, O_GDN_P = 16908288, O_GDN_S = 17694720, O_CONV_P = 30277632, O_CONV_S = 30388224,
                 O_RWKV_P = 32157696, O_RWKV_S = 32944128, O_SHIFT_P = 45527040, O_SHIFT_S = 45572096, O_HGRN_P = 46292992,
                 O_HGRN_S = 46817280;

constexpr size_t SZ_WTIN = (size_t)4096 * 1024 * 2, SZ_WTOUT = (size_t)1024 * 1024 * 2, SZ_WTGU = (size_t)5632 * 1024 * 2,
                 SZ_WTDN = (size_t)1024 * 2816 * 2, SZ_P = (size_t)NTOK * PSTR * 2, SZ_ACT = (size_t)NTOK * 1024 * 2,
                 SZ_T384 = (size_t)NTOK * 384 * 2, SZ_T8F = (size_t)NTOK * 8 * 4, SZ_T256 = (size_t)NTOK * 256 * 2,
                 SZ_T384F = (size_t)NTOK * 384 * 4;
constexpr size_t OFF_WTIN = 0, OFF_WTOUT = OFF_WTIN + SZ_WTIN, OFF_WTGU = OFF_WTOUT + SZ_WTOUT, OFF_WTDN = OFF_WTGU + SZ_WTGU,
                 OFF_P = OFF_WTDN + SZ_WTDN, OFF_ACT = OFF_P + SZ_P, OFF_GQ = OFF_ACT + SZ_ACT, OFF_GK = OFF_GQ + SZ_T384,
                 OFF_GV = OFF_GK + SZ_T384, OFF_GDEC = OFF_GV + SZ_T384, OFF_GBETA = OFF_GDEC + SZ_T8F, OFF_HQ = OFF_GBETA + SZ_T8F,
                 OFF_HK = OFF_HQ + SZ_T256, OFF_RR = OFF_HK + SZ_T256, OFF_RK = OFF_RR + SZ_T384, OFF_RV = OFF_RK + SZ_T384,
                 OFF_RKK = OFF_RV + SZ_T384, OFF_RB = OFF_RKK + SZ_T384, OFF_RG = OFF_RB + SZ_T384, OFF_RW = OFF_RG + SZ_T384,
                 OFF_VF = OFF_RW + SZ_T384F, OFF_LORA = OFF_VF + SZ_T384, OFF_WTOUT2 = OFF_LORA + 245760, OFF_WTGU2 = OFF_WTOUT2 + SZ_WTOUT, OFF_WTDN2 = OFF_WTGU2 + SZ_WTGU, OFF_BAR = OFF_WTDN2 + SZ_WTDN, OFF_CUTAB = OFF_BAR + 16384, OFF_QUEUE = OFF_CUTAB + 16384, BAR_BYTES = 16384 + 16384 + 4096, WS_NEED = OFF_BAR + BAR_BYTES;
constexpr int W2T = 0, A2T = 24576, G2T = 49152, V1T = 98304, V2T = 110592;

struct Params {
  const float* in[N_IN];
  float* out;
  unsigned char* ws;
};

#define WSP(T, off) ((T*)(P.ws + (off)))

__device__ __forceinline__ int otid() { int t = __builtin_amdgcn_workitem_id_x(); asm volatile("" : "+v"(t)); return t; }
__device__ __forceinline__ int obid() { int b = __builtin_amdgcn_workgroup_id_x(); asm volatile("" : "+s"(b)); return b; }
template <class T> __device__ __forceinline__ const T* opq(const T* p) { asm volatile("" : "+s"(p)); return p; }
__device__ __forceinline__ float bf2f(bf16_t h) { return __uint_as_float(((unsigned)h) << 16); }
typedef float f32x2_t __attribute__((ext_vector_type(2)));
typedef __bf16 bf16x2_t __attribute__((ext_vector_type(2)));
__device__ __forceinline__ unsigned pk2(float lo, float hi) {
  const f32x2_t v = {lo, hi};
  return __builtin_bit_cast(unsigned, __builtin_convertvector(v, bf16x2_t));
}
__device__ __forceinline__ bf16_t f2bf(float f) { return (bf16_t)(pk2(f, 0.f) & 0xffffu); }
__device__ __forceinline__ float sigm(float x) { return 1.f / (1.f + __expf(-x)); }
__device__ __forceinline__ float silu(float x) { return x / (1.f + __expf(-x)); }
__device__ __forceinline__ float softplus(float x) { return x > 20.f ? x : log1pf(__expf(x)); }
template <int CTRL> __device__ __forceinline__ float dppf(float x) {
  return __builtin_bit_cast(float, __builtin_amdgcn_mov_dpp(__builtin_bit_cast(int, x), CTRL, 0xf, 0xf, true));
}
__device__ __forceinline__ float wave_sum(float v) {
  v += dppf<0xB1>(v); v += dppf<0x4E>(v); v += dppf<0x141>(v); v += dppf<0x140>(v);
  const int iv = __builtin_bit_cast(int, v);
  const float s0 = __builtin_bit_cast(float, __builtin_amdgcn_readlane(iv, 0)), s1 = __builtin_bit_cast(float, __builtin_amdgcn_readlane(iv, 16));
  const float s2 = __builtin_bit_cast(float, __builtin_amdgcn_readlane(iv, 32)), s3 = __builtin_bit_cast(float, __builtin_amdgcn_readlane(iv, 48));
  return (s0 + s1) + (s2 + s3);
}
__device__ __forceinline__ float reduce8(float x) { x += dppf<0xB1>(x); x += dppf<0x4E>(x); x += dppf<0x141>(x); return x; }

__device__ __forceinline__ f32x4 unpack4(u32x2 w) {
  f32x4 f; f[0] = __uint_as_float(w[0] << 16); f[1] = __uint_as_float(w[0] & 0xffff0000u);
  f[2] = __uint_as_float(w[1] << 16); f[3] = __uint_as_float(w[1] & 0xffff0000u); return f;
}
__device__ __forceinline__ bf16x8 pack8(f32x4 a, f32x4 b) {
  u32x4 u; u[0] = pk2(a[0], a[1]); u[1] = pk2(a[2], a[3]); u[2] = pk2(b[0], b[1]); u[3] = pk2(b[2], b[3]);
  return __builtin_bit_cast(bf16x8, u);
}
__device__ __forceinline__ u32x2 pack4(f32x4 a) { u32x2 u; u[0] = pk2(a[0], a[1]); u[1] = pk2(a[2], a[3]); return u; }
__device__ __forceinline__ float dot4(f32x4 a, f32x4 b) { return (a[0] * b[0] + a[1] * b[1]) + (a[2] * b[2] + a[3] * b[3]); }
__device__ __forceinline__ const float* xin_row(const Params& P, int l, int row) {
  const float* po = opq((const float*)P.out); const float* pp = opq(P.in[I_XP]); const float* ps = opq(P.in[I_XS]);
  if (l > 0) return po + (size_t)row * D;
  return row < NTP ? pp + (size_t)row * D : ps + (size_t)(row - NTP) * D;
}

__device__ __forceinline__ int gu_row(int c, int up) { return (c >> 7) * 256 + up * 128 + (c & 127); }
__device__ __forceinline__ void xpose_tile(unsigned char* smem, const float* __restrict__ W, int N, int kt, int ntl, bf16_t* __restrict__ dst, int dstK, int mode) {
  float (*tile)[65] = (float (*)[65])smem;
  const int tid = otid();
  __syncthreads();
#pragma unroll 4
  for (int i = 0; i < 8; ++i) {
    const int k = i * 8 + (tid >> 6), n = tid & 63, gn = ntl * 64 + n;
    tile[k][n] = gn < N ? W[(size_t)(kt * 64 + k) * N + gn] : 0.f;
  }
  __syncthreads();
#pragma unroll 4
  for (int i = 0; i < 8; ++i) {
    const int n = i * 8 + (tid >> 6), k = tid & 63, gn = ntl * 64 + n;
    const int drow = mode == 0 ? gn : gu_row(gn, mode - 1);
    dst[(size_t)drow * dstK + kt * 64 + k] = f2bf(tile[k][n]);
  }
}
constexpr int WCONV_JOBS = 3392 + 480;
__device__ __forceinline__ size_t wt_out_off(int l) { return (l & 1) ? OFF_WTOUT2 : OFF_WTOUT; }
__device__ __forceinline__ size_t wt_gu_off(int l) { return (l & 1) ? OFF_WTGU2 : OFF_WTGU; }
__device__ __forceinline__ size_t wt_dn_off(int l) { return (l & 1) ? OFF_WTDN2 : OFF_WTDN; }
__device__ __forceinline__ void wconv_job(const Params& P, unsigned char* smem, int l, int job) {
  if (job < 1024) xpose_tile(smem, P.in[I_WIN] + (size_t)l * 1024 * IN_COLS, IN_COLS, job & 15, job >> 4, WSP(bf16_t, OFF_WTIN), 1024, 0);
  else if (job < 1280) { const int j = job - 1024; xpose_tile(smem, P.in[I_WOUT] + (size_t)l * 1024 * 1024, 1024, j & 15, j >> 4, WSP(bf16_t, wt_out_off(l)), 1024, 0); }
  else if (job < 1984) { const int j = job - 1280; xpose_tile(smem, P.in[I_WG] + (size_t)l * 1024 * DFF, DFF, j & 15, j >> 4, WSP(bf16_t, wt_gu_off(l)), 1024, 1); }
  else if (job < 2688) { const int j = job - 1984; xpose_tile(smem, P.in[I_WU] + (size_t)l * 1024 * DFF, DFF, j & 15, j >> 4, WSP(bf16_t, wt_gu_off(l)), 1024, 2); }
  else if (job < 3392) { const int j = job - 2688; xpose_tile(smem, P.in[I_WD] + (size_t)l * DFF * 1024, 1024, j % 44, j / 44, WSP(bf16_t, wt_dn_off(l)), DFF, 0); }
  else {
    bf16_t* lw = WSP(bf16_t, OFF_LORA);
    const int idx = (job - 3392) * 256 + (otid() & 255);
    float v = 0.f;
    const float* pw2 = opq(P.in[I_W2]); const float* pa2 = opq(P.in[I_A2]); const float* pg2 = opq(P.in[I_G2]);
    const float* pv1 = opq(P.in[I_V1]); const float* pv2 = opq(P.in[I_V2]);
    if (idx < A2T) { const int n = idx >> 6, k = idx & 63; v = pw2[(size_t)l * 64 * 384 + k * 384 + n]; }
    else if (idx < G2T) { const int i = idx - A2T, n = i >> 6, k = i & 63; v = pa2[(size_t)l * 64 * 384 + k * 384 + n]; }
    else if (idx < V1T) { const int i = idx - G2T, n = i >> 7, k = i & 127; v = pg2[(size_t)l * 128 * 384 + k * 384 + n]; }
    else if (idx < V2T) { if (l > 0) { const int i = idx - V1T, n = i / 384, k = i - n * 384; v = pv1[(size_t)(l - 1) * 384 * 32 + k * 32 + n]; } }
    else { if (l > 0) { const int i = idx - V2T, n = i >> 5, k = i & 31; v = pv2[(size_t)(l - 1) * 32 * 384 + k * 384 + n]; } }
    if (otid() < 256) lw[idx] = f2bf(v);
  }
}
__device__ __forceinline__ void wconv_phase(const Params& P, unsigned char* smem, int l) {
  for (int job = obid(); job < WCONV_JOBS; job += gridDim.x) wconv_job(P, smem, l, job);
}

__device__ __forceinline__ void norm_phase(const Params& P, int l_in, const float* __restrict__ w) {
  bf16_t* act = WSP(bf16_t, OFF_ACT);
  const int lane = otid() & 63, wid = otid() >> 6;
  for (int row = obid() * 8 + wid; row < NTOK; row += gridDim.x * 8) {
    const float* xr = xin_row(P, l_in, row);
    f32x4 v[4]; float ss = 0.f;
#pragma unroll
    for (int i = 0; i < 4; ++i) { v[i] = *(const f32x4*)(xr + i * 256 + lane * 4); ss += v[i][0] * v[i][0] + v[i][1] * v[i][1] + v[i][2] * v[i][2] + v[i][3] * v[i][3]; }
    ss = wave_sum(ss);
    const float rstd = rsqrtf(ss * (1.f / 1024.f) + 1e-6f);
#pragma unroll
    for (int i = 0; i < 4; ++i) {
      const f32x4 wv = *(const f32x4*)(w + i * 256 + lane * 4);
      u32x2 o; o[0] = pk2(v[i][0] * rstd * wv[0], v[i][1] * rstd * wv[1]); o[1] = pk2(v[i][2] * rstd * wv[2], v[i][3] * rstd * wv[3]);
      *(u32x2*)(act + (size_t)row * 1024 + i * 256 + lane * 4) = o;
    }
  }
}
__device__ __forceinline__ void final_norm_phase(const Params& P) {
  const float* w = P.in[I_NORM_FINAL];
  const int lane = otid() & 63, wid = otid() >> 6;
  for (int row = obid() * 8 + wid; row < NTOK; row += gridDim.x * 8) {
    float* xr = P.out + (size_t)row * D;
    f32x4 v[4]; float ss = 0.f;
#pragma unroll
    for (int i = 0; i < 4; ++i) { v[i] = *(const f32x4*)(xr + i * 256 + lane * 4); ss += v[i][0] * v[i][0] + v[i][1] * v[i][1] + v[i][2] * v[i][2] + v[i][3] * v[i][3]; }
    ss = wave_sum(ss);
    const float rstd = rsqrtf(ss * (1.f / 1024.f) + 1e-6f);
#pragma unroll
    for (int i = 0; i < 4; ++i) {
      const f32x4 wv = *(const f32x4*)(w + i * 256 + lane * 4);
      f32x4 o; o[0] = v[i][0] * rstd * wv[0]; o[1] = v[i][1] * rstd * wv[1]; o[2] = v[i][2] * rstd * wv[2]; o[3] = v[i][3] * rstd * wv[3];
      *(f32x4*)(xr + i * 256 + lane * 4) = o;
    }
  }
}

enum { EPI_P = 0, EPI_RES = 1, EPI_SWIGLU = 2 };
namespace pg8 {
constexpr int BM = 256, BK = 64, HALF = 128, HTB = HALF * BK * 2, NXCD = 8, WGM = 8;
__device__ __forceinline__ int lds_byte(int r, int c) { const int st = (r >> 4) * 2 + (c >> 5), rr = r & 15, cc = c & 31, ob = rr * 64 + cc * 2; return st * 1024 + (ob ^ (((ob >> 9) & 1) << 5)); }
__device__ __forceinline__ void stage_rc(int b, int& R, int& C) { const int st = b / 1024, sb = b % 1024, swz = sb ^ (((sb >> 9) & 1) << 5); R = (st >> 1) * 16 + swz / 64; C = (st & 1) * 32 + (swz % 64) / 2; }
struct Unit { int pm, pn; };
struct StaticOrder {
  int nM, nN, nwg, G, c;
  __device__ __forceinline__ void init(int M, int N, int G_, int c_) { nM = M / BM; nN = N / BM; nwg = nM * nN; G = G_; c = c_; }
  __device__ __forceinline__ bool next(int i, Unit& u) const {
    const long L = (long)i * G + c; if (L >= nwg) return false;
    int wgid = (int)L; { const int q = nwg / NXCD, r = nwg % NXCD, xcd = wgid % NXCD, off = wgid / NXCD; wgid = (xcd < r ? xcd * (q + 1) : r * (q + 1) + (xcd - r) * q) + off; }
    const int nig = WGM * nN, gid = wgid / nig, fm = gid * WGM, gsz = (nM - fm) < WGM ? (nM - fm) : WGM;
    u.pm = fm + ((wgid % nig) % gsz); u.pn = (wgid % nig) / gsz; return true;
  }
};
}

template <int EPI>
__device__ __forceinline__ void gemm_epilogue(const Params& P, const f32x4 (&acc)[2][2][4][2], const pg8::Unit& u, int wr, int wc, int fr, int fq, int l) {
#pragma unroll
  for (int ai = 0; ai < 2; ++ai)
#pragma unroll
    for (int m = 0; m < 4; ++m) {
      const int row = u.pm * 256 + ai * 128 + wr * 64 + m * 16 + fr;
      if (EPI == EPI_P) {
        bf16_t* pr = WSP(bf16_t, OFF_P) + (size_t)row * PSTR;
#pragma unroll
        for (int bj = 0; bj < 2; ++bj)
#pragma unroll
          for (int n = 0; n < 2; ++n) {
            const int col = u.pn * 256 + bj * 128 + wc * 32 + n * 16 + fq * 4;
            if (col < IN_COLS) *(u32x2*)(pr + col) = pack4(acc[ai][bj][m][n]);
          }
      } else if (EPI == EPI_RES) {
        const float* xi = xin_row(P, l, row);
        float* xo = P.out + (size_t)row * D;
#pragma unroll
        for (int bj = 0; bj < 2; ++bj)
#pragma unroll
          for (int n = 0; n < 2; ++n) {
            const int col = u.pn * 256 + bj * 128 + wc * 32 + n * 16 + fq * 4;
            *(f32x4*)(xo + col) = *(const f32x4*)(xi + col) + acc[ai][bj][m][n];
          }
      } else {
        bf16_t* ur = WSP(bf16_t, OFF_P) + (size_t)row * DFF;
#pragma unroll
        for (int n = 0; n < 2; ++n) {
          const int col = u.pn * 128 + wc * 32 + n * 16 + fq * 4;
          f32x4 r;
#pragma unroll
          for (int j = 0; j < 4; ++j) r[j] = silu(acc[ai][0][m][n][j]) * acc[ai][1][m][n][j];
          *(u32x2*)(ur + col) = pack4(r);
        }
      }
    }
}

#define PG8_LAS __attribute__((address_space(3)))
template <int EPI>
__device__ __forceinline__ void gemm_phase(const Params& P, unsigned char* smem, const bf16_t* __restrict__ Ag, int lda_unused, const bf16_t* __restrict__ Btg, int K, int nN128_unused, int l, int N) {
  using namespace pg8;
  PG8_LAS unsigned char* lds = (PG8_LAS unsigned char*)smem;
  const int tid = otid(), wid = __builtin_amdgcn_readfirstlane(tid >> 6), lane = tid & 63, wr = wid >> 2, wc = wid & 3, fr = lane & 15, fq = lane >> 4;
  const int nt = K / BK;
  StaticOrder S; S.init(NTP, N, (int)gridDim.x, obid());
  unsigned voffA[2], voffB[2];
#pragma unroll
  for (int i = 0; i < 2; ++i) { int R, C; stage_rc(tid * 16 + i * 8192, R, C); voffA[i] = (unsigned)(R * K + C) * 2u; voffB[i] = voffA[i]; }
  const size_t kstep = (size_t)(BK * 2);
  const size_t hstep = (size_t)HALF * K * 2;
  const size_t tstep = 2 * hstep;
  const unsigned ldsw = (unsigned)wid * 1024u;
  const int aoff = lds_byte(wr * 64 + fr, fq * 8), boff = lds_byte(wc * 32 + fr, fq * 8);
#define PG8_SA(b, h) (((b) * 2 + (h)) * HTB)
#define PG8_SB(b, h) ((4 + (b) * 2 + (h)) * HTB)
#define PG8_STAGE(bufoff, gbase, voff) do { _Pragma("unroll") for (int _i = 0; _i < 2; ++_i) \
        __builtin_amdgcn_global_load_lds((const unsigned*)((const char*)(gbase) + (voff)[_i]), (PG8_LAS unsigned*)(lds + (bufoff) + ldsw + _i * 8192), 16, 0, 0); } while (0)
#define PG8_LDA(dst, b, h) do { _Pragma("unroll") for (int m = 0; m < 4; ++m) _Pragma("unroll") for (int k = 0; k < 2; ++k) dst[m][k] = *(const PG8_LAS bf16x8*)(lds + PG8_SA(b, h) + aoff + m * 2048 + k * 1024); } while (0)
#define PG8_LDB(dst, b, h) do { _Pragma("unroll") for (int n = 0; n < 2; ++n) _Pragma("unroll") for (int k = 0; k < 2; ++k) dst[n][k] = *(const PG8_LAS bf16x8*)(lds + PG8_SB(b, h) + boff + n * 2048 + k * 1024); } while (0)
#define PG8_MMA(ai, bj, At, Bt) do { __builtin_amdgcn_s_setprio(1); _Pragma("unroll") for (int m = 0; m < 4; ++m) _Pragma("unroll") for (int n = 0; n < 2; ++n) _Pragma("unroll") for (int k = 0; k < 2; ++k) \
        acc[ai][bj][m][n] = __builtin_amdgcn_mfma_f32_16x16x32_bf16(Bt[n][k], At[m][k], acc[ai][bj][m][n], 0, 0, 0); __builtin_amdgcn_s_setprio(0); } while (0)
#define PG8_WAIT_V(n) asm volatile("s_waitcnt vmcnt(" #n ")" ::: "memory")
#define PG8_WAIT_L(n) asm volatile("s_waitcnt lgkmcnt(" #n ")" ::: "memory")
#define PG8_BAR __builtin_amdgcn_s_barrier()
#define PG8_SCHED __builtin_amdgcn_sched_barrier(0)
  Unit cur, nxt; int ui = 0;
  if (!S.next(0, cur)) return;
  f32x4 acc[2][2][4][2];
#pragma unroll
  for (int a = 0; a < 2; ++a)
#pragma unroll
    for (int b = 0; b < 2; ++b)
#pragma unroll
      for (int m = 0; m < 4; ++m)
#pragma unroll
        for (int n = 0; n < 2; ++n) acc[a][b][m][n] = (f32x4){0.f, 0.f, 0.f, 0.f};
  bf16x8 At[4][2], B0[2][2], B1[2][2];
  const char* cA = (const char*)Ag + (size_t)cur.pm * tstep; const char* cB = (const char*)Btg + (size_t)cur.pn * tstep;
  PG8_STAGE(PG8_SB(0, 0), cB, voffB); PG8_STAGE(PG8_SA(0, 0), cA, voffA); PG8_STAGE(PG8_SB(0, 1), cB + hstep, voffB); PG8_STAGE(PG8_SA(0, 1), cA + hstep, voffA);
  if (wr == 1) PG8_BAR;
  PG8_WAIT_V(4); PG8_BAR;
  PG8_STAGE(PG8_SB(1, 0), cB + kstep, voffB); PG8_STAGE(PG8_SA(1, 0), cA + kstep, voffA); PG8_STAGE(PG8_SB(1, 1), cB + hstep + kstep, voffB);
  PG8_WAIT_V(6); PG8_BAR;
  for (;;) {
    const bool has_next = S.next(ui + 1, nxt);
    const char* nA = has_next ? (const char*)Ag + (size_t)nxt.pm * tstep : cA; const char* nB = has_next ? (const char*)Btg + (size_t)nxt.pn * tstep : cB;
    for (int t = 0; t < nt; t += 2) {
      const bool last = (t == nt - 2);
      const char* a1 = cA + (size_t)(t + 1) * kstep;
      const char* a2 = last ? nA : cA + (size_t)(t + 2) * kstep; const char* b2 = last ? nB : cB + (size_t)(t + 2) * kstep;
      const char* a3 = a2 + kstep; const char* b3 = b2 + kstep;
      PG8_LDB(B0, 0, 0); PG8_SCHED; PG8_LDA(At, 0, 0); PG8_STAGE(PG8_SA(1, 1), a1 + hstep, voffA);
      PG8_WAIT_L(8); PG8_BAR; PG8_WAIT_L(0); PG8_MMA(0, 0, At, B0); PG8_BAR; PG8_SCHED;
      PG8_LDB(B1, 0, 1); PG8_STAGE(PG8_SB(0, 0), b2, voffB);
      PG8_BAR; PG8_WAIT_L(0); PG8_MMA(0, 1, At, B1); PG8_BAR;
      PG8_LDA(At, 0, 1); PG8_STAGE(PG8_SA(0, 0), a2, voffA);
      PG8_BAR; PG8_WAIT_L(0); PG8_MMA(1, 0, At, B0); PG8_BAR; PG8_SCHED;
      PG8_STAGE(PG8_SB(0, 1), b2 + hstep, voffB);
      PG8_WAIT_V(6); PG8_BAR; PG8_MMA(1, 1, At, B1); PG8_BAR;
      PG8_LDB(B0, 1, 0); PG8_SCHED; PG8_LDA(At, 1, 0); PG8_STAGE(PG8_SA(0, 1), a2 + hstep, voffA);
      PG8_WAIT_L(8); PG8_BAR; PG8_WAIT_L(0); PG8_MMA(0, 0, At, B0); PG8_BAR; PG8_SCHED;
      PG8_LDB(B1, 1, 1); PG8_STAGE(PG8_SB(1, 0), b3, voffB);
      PG8_BAR; PG8_WAIT_L(0); PG8_MMA(0, 1, At, B1); PG8_BAR;
      PG8_LDA(At, 1, 1); PG8_STAGE(PG8_SA(1, 0), a3, voffA);
      PG8_BAR; PG8_WAIT_L(0); PG8_MMA(1, 0, At, B0); PG8_BAR; PG8_SCHED;
      PG8_STAGE(PG8_SB(1, 1), b3 + hstep, voffB);
      PG8_WAIT_V(6); PG8_BAR; PG8_MMA(1, 1, At, B1); PG8_BAR;
    }
    gemm_epilogue<EPI>(P, acc, cur, wr, wc, fr, fq, l);
    if (!has_next) break;
#pragma unroll
    for (int a = 0; a < 2; ++a)
#pragma unroll
      for (int b = 0; b < 2; ++b)
#pragma unroll
        for (int m = 0; m < 4; ++m)
#pragma unroll
          for (int n = 0; n < 2; ++n) acc[a][b][m][n] = (f32x4){0.f, 0.f, 0.f, 0.f};
    cur = nxt; cA = nA; cB = nB; ++ui;
  }
  PG8_WAIT_V(0);
  if (wr == 0) PG8_BAR;
  PG8_BAR;
#undef PG8_SA
#undef PG8_SB
#undef PG8_STAGE
#undef PG8_LDA
#undef PG8_LDB
#undef PG8_MMA
#undef PG8_WAIT_V
#undef PG8_WAIT_L
#undef PG8_BAR
#undef PG8_SCHED
}

template <int EPI>
__device__ __forceinline__ void gemm_sample(const Params& P, const bf16_t* __restrict__ A, int lda, const bf16_t* __restrict__ Bt, int K, int nunits, int l) {
  const int tid = otid(), lane = tid & 63, wid = tid >> 6, fr = lane & 15, fq = lane >> 4;
  for (int u = (int)gridDim.x - 1 - obid(); u < nunits; u += gridDim.x) {
    const int brow0 = EPI == EPI_SWIGLU ? gu_row(u * 16 + fr, 0) : u * 16 + fr;
    const int brow1 = EPI == EPI_SWIGLU ? gu_row(u * 16 + fr, 1) : 0;
    const bf16_t* a0p = A + (size_t)(NTP + wid * 16 + fr) * lda + fq * 8;
    const bf16_t* b0p = Bt + (size_t)brow0 * K + fq * 8;
    const bf16_t* b1p = Bt + (size_t)brow1 * K + fq * 8;
    f32x4 c00 = (f32x4){0.f, 0.f, 0.f, 0.f}, c01 = c00;
#pragma unroll 8
    for (int ks = 0; ks < K; ks += 32) {
      const bf16x8 A0 = *(const bf16x8*)(a0p + ks), B0 = *(const bf16x8*)(b0p + ks);
      c00 = __builtin_amdgcn_mfma_f32_16x16x32_bf16(B0, A0, c00, 0, 0, 0);
      if (EPI == EPI_SWIGLU) {
        const bf16x8 B1 = *(const bf16x8*)(b1p + ks);
        c01 = __builtin_amdgcn_mfma_f32_16x16x32_bf16(B1, A0, c01, 0, 0, 0);
      }
    }
    {
      const int row = NTP + wid * 16 + fr, col = u * 16 + fq * 4;
      const f32x4 g = c00, up = c01;
      if (EPI == EPI_P) {
        if (col < IN_COLS) *(u32x2*)(WSP(bf16_t, OFF_P) + (size_t)row * PSTR + col) = pack4(g);
      } else if (EPI == EPI_RES) {
        const float* xi = xin_row(P, l, row);
        *(f32x4*)(P.out + (size_t)row * D + col) = *(const f32x4*)(xi + col) + g;
      } else {
        f32x4 r;
#pragma unroll
        for (int j = 0; j < 4; ++j) r[j] = silu(g[j]) * up[j];
        *(u32x2*)(WSP(bf16_t, OFF_P) + (size_t)row * DFF + col) = pack4(r);
      }
    }
  }
}

__device__ __forceinline__ float lbval(const Params& P, int l, int c) {
  const float* hb = P.in[I_HLB];
  const float a0 = hb[c], a1 = hb[256 + c], a2 = hb[512 + c], a3 = hb[768 + c];
  const float m = fmaxf(fmaxf(a0, a1), fmaxf(a2, a3));
  const float e0 = __expf(a0 - m), e1 = __expf(a1 - m), e2 = __expf(a2 - m), e3 = __expf(a3 - m);
  const float inv = 1.f / (e0 + e1 + e2 + e3);
  float s = 0.f;
  if (l >= 1) s += e1; if (l >= 2) s += e2; if (l >= 3) s += e3;
  return s * inv;
}

__device__ __forceinline__ void gdn_conv_emit(const Params& P, int g, int lane, int row, float s) {
  const int h = g % 6;
  if (g < 12) {
    const float ss = wave_sum(s * s);
    const float o = s * rsqrtf(ss + 1e-6f) * (g < 6 ? 0.125f : 1.f);
    (g < 6 ? WSP(bf16_t, OFF_GQ) : WSP(bf16_t, OFF_GK))[(size_t)row * 384 + h * 64 + lane] = f2bf(o);
  } else {
    WSP(bf16_t, OFF_GV)[(size_t)row * 384 + h * 64 + lane] = f2bf(s);
  }
}
__device__ __forceinline__ void gdn_gate_emit(const Params& P, int l, int h, int row) {
  const bf16_t* pr = WSP(bf16_t, OFF_P) + (size_t)row * PSTR;
  const float braw = bf2f(pr[1536 + h]), araw = bf2f(pr[1542 + h]);
  const float gg = -__expf(P.in[I_ALOG][l * 6 + h]) * softplus(araw + P.in[I_DTB][l * 6 + h]);
  WSP(float, OFF_GDEC)[(size_t)row * 8 + h] = __expf(gg);
  WSP(float, OFF_GBETA)[(size_t)row * 8 + h] = sigm(braw);
}
__device__ __forceinline__ void prep_gdn_prompt(const Params& P, int l, int ci) {
  const int lane = otid() & 63, wid = otid() >> 6;
  const int r0 = ci * 32, b = r0 / TSEQ, t0 = r0 % TSEQ;
  const bf16_t* p = WSP(bf16_t, OFF_P);
  for (int g = wid; g < 18; g += 8) {
    const int col = g * 64 + lane;
    const float* cw = P.in[I_CONVW] + (size_t)l * 4 * 1152 + col;
    const float c0 = cw[0], c1 = cw[1152], c2 = cw[2304], c3 = cw[3456];
    float xr[35];
#pragma unroll
    for (int t = 0; t < 35; ++t) xr[t] = (t >= 3 || t0 > 0) ? bf2f(p[(size_t)(r0 - 3 + t) * PSTR + col]) : 0.f;
#pragma unroll
    for (int t = 0; t < 32; ++t) {
      const float y = c0 * xr[t] + c1 * xr[t + 1] + c2 * xr[t + 2] + c3 * xr[t + 3];
      gdn_conv_emit(P, g, lane, r0 + t, silu(y));
    }
    if (t0 + 32 == TSEQ) {
      float* cp = P.out + O_CONV_P + (size_t)(l * 8 + b) * 3 * 1152 + col;
      cp[0] = xr[32]; cp[1152] = xr[33]; cp[2304] = xr[34];
    }
    if (g < 6 && lane < 32) gdn_gate_emit(P, l, g, r0 + lane);
  }
}
__device__ __forceinline__ void prep_gdn_sample(const Params& P, int l, int si) {
  const int lane = otid() & 63, wid = otid() >> 6;
  const bf16_t* p = WSP(bf16_t, OFF_P);
  for (int u = wid; u < 2 * 18; u += 8) {
    const int s = si * 2 + u / 18, g = u % 18, col = g * 64 + lane, row = NTP + s;
    const float* cw = P.in[I_CONVW] + (size_t)l * 4 * 1152 + col;
    const float c0 = cw[0], c1 = cw[1152], c2 = cw[2304], c3 = cw[3456];
    const float* cb = P.in[I_SCONV] + (size_t)(l * 128 + s) * 3 * 1152 + col;
    const float x3 = cb[0], x2 = cb[1152], x1 = cb[2304];
    const float x0 = bf2f(p[(size_t)row * PSTR + col]);
    const float y = c0 * x3 + c1 * x2 + c2 * x1 + c3 * x0;
    gdn_conv_emit(P, g, lane, row, silu(y));
    float* cp = P.out + O_CONV_S + (size_t)(l * 128 + s) * 3 * 1152 + col;
    cp[0] = x2; cp[1152] = x1; cp[2304] = x0;
    if (g < 6 && lane == 0) gdn_gate_emit(P, l, g, row);
  }
}
__device__ __forceinline__ void prep_hgrn(const Params& P, int l, int ti) {
  const int c = otid() & 255, th = otid() >> 8;
  const float oml = 1.f - lbval(P, l, c);
  const bf16_t* p = WSP(bf16_t, OFF_P);
  bf16_t* hq = WSP(bf16_t, OFF_HQ); bf16_t* hk = WSP(bf16_t, OFF_HK);
  for (int t0 = th * 32; t0 < th * 32 + 32; t0 += 8) {
    float q[8], f[8];
#pragma unroll
    for (int i = 0; i < 8; ++i) { const int row = ti * 64 + t0 + i; q[i] = bf2f(p[(size_t)row * PSTR + PC + c]); f[i] = bf2f(p[(size_t)row * PSTR + PC + 256 + c]); }
#pragma unroll
    for (int i = 0; i < 8; ++i) {
      const int row = ti * 64 + t0 + i;
      hq[(size_t)row * 256 + c] = f2bf(silu(q[i]) * 0.125f);
      hk[(size_t)row * 256 + c] = f2bf(oml * sigm(-f[i]));
    }
  }
}
template <bool SAMP>
__device__ __forceinline__ f32x4 xs4t(const Params& P, int l, int row, int col0) {
  const bf16_t* p = WSP(bf16_t, OFF_P);
  const f32x4 pv = unpack4(*(const u32x2*)(p + (size_t)row * PSTR + PB + col0));
  f32x4 prev;
  if (SAMP) prev = *(const f32x4*)(P.in[I_SSHIFT] + (size_t)(l * 128 + (row - NTP)) * 1408 + col0);
  else {
    const bool first = (row & (TSEQ - 1)) == 0;
    prev = unpack4(*(const u32x2*)(p + (size_t)(row - (first ? 0 : 1)) * PSTR + PB + col0)) * (first ? 0.f : 1.f);
  }
  const f32x4 mu = *(const f32x4*)(P.in[I_MU] + l * 1408 + col0);
  return pv + (prev - pv) * mu;
}
__device__ __forceinline__ float tanh_fast(float x) { return 1.f - 2.f / (__expf(2.f * x) + 1.f); }

template <int ROWB>
__device__ __forceinline__ void stage_lora(unsigned char* smem, const bf16_t* __restrict__ src) {
  constexpr int CPR = ROWB / 16, NCH = 384 * CPR;
  __syncthreads();
  u32x4 t[NCH / 512];
#pragma unroll
  for (int i = 0; i < NCH / 512; ++i) t[i] = *(const u32x4*)((const unsigned char*)src + (size_t)(otid() + i * 512) * 16);
#pragma unroll
  for (int i = 0; i < NCH / 512; ++i) { const int idx = otid() + i * 512, r = idx / CPR, c = idx - r * CPR; *(u32x4*)(smem + r * (ROWB + 16) + c * 16) = t[i]; }
  __syncthreads();
}
template <bool SAMP>
__device__ __forceinline__ void prep_rwkv_unit(const Params& P, unsigned char* smem, int l, int mt, int hh) {
  const int lane = otid() & 63, fr = lane & 15, fq = lane >> 4;
  const int row = mt * 16 + fr, cb = hh * 192;
  const bf16_t* lw = WSP(bf16_t, OFF_LORA);
  const size_t ro = (size_t)row * 384;
  f32x4 acc[12];
  {
    f32x4 x[2][2]; bf16x8 Bf[2][12];
    stage_lora<128>(smem, lw + W2T);
#pragma unroll
    for (int ks = 0; ks < 2; ++ks) { x[ks][0] = xs4t<SAMP>(P, l, row, 1152 + ks * 32 + fq * 8); x[ks][1] = xs4t<SAMP>(P, l, row, 1152 + ks * 32 + fq * 8 + 4); }
#pragma unroll
    for (int ks = 0; ks < 2; ++ks)
#pragma unroll
      for (int nf = 0; nf < 12; ++nf) Bf[ks][nf] = *(const bf16x8*)(smem + (cb + nf * 16 + fr) * 144 + ks * 64 + fq * 16);
#pragma unroll
    for (int nf = 0; nf < 12; ++nf) acc[nf] = (f32x4){0.f, 0.f, 0.f, 0.f};
#pragma unroll
    for (int ks = 0; ks < 2; ++ks) {
#pragma unroll
      for (int j = 0; j < 4; ++j) { x[ks][0][j] = tanh_fast(x[ks][0][j]); x[ks][1][j] = tanh_fast(x[ks][1][j]); }
      const bf16x8 A = pack8(x[ks][0], x[ks][1]);
#pragma unroll
      for (int nf = 0; nf < 12; ++nf) acc[nf] = __builtin_amdgcn_mfma_f32_16x16x32_bf16(Bf[ks][nf], A, acc[nf], 0, 0, 0);
    }
    f32x4 w0v[12];
#pragma unroll
    for (int nf = 0; nf < 12; ++nf) w0v[nf] = *(const f32x4*)(P.in[I_W0] + l * 384 + cb + nf * 16 + fq * 4);
#pragma unroll
    for (int nf = 0; nf < 12; ++nf) {
      f32x4 d;
#pragma unroll
      for (int j = 0; j < 4; ++j) {
        const float xx = -(w0v[nf][j] + acc[nf][j]);
        const float sp = xx > 15.f ? xx : __logf(1.f + __expf(xx));
        d[j] = __expf(-__expf(-sp - 0.5f));
      }
      *(f32x4*)(WSP(float, OFF_RW) + ro + cb + nf * 16 + fq * 4) = d;
    }
  }
  {
    f32x4 x[2][2]; bf16x8 Bf[2][12];
    stage_lora<128>(smem, lw + A2T);
#pragma unroll
    for (int ks = 0; ks < 2; ++ks) { x[ks][0] = xs4t<SAMP>(P, l, row, 1216 + ks * 32 + fq * 8); x[ks][1] = xs4t<SAMP>(P, l, row, 1216 + ks * 32 + fq * 8 + 4); }
#pragma unroll
    for (int ks = 0; ks < 2; ++ks)
#pragma unroll
      for (int nf = 0; nf < 12; ++nf) Bf[ks][nf] = *(const bf16x8*)(smem + (cb + nf * 16 + fr) * 144 + ks * 64 + fq * 16);
#pragma unroll
    for (int nf = 0; nf < 12; ++nf) acc[nf] = (f32x4){0.f, 0.f, 0.f, 0.f};
#pragma unroll
    for (int ks = 0; ks < 2; ++ks) {
      const bf16x8 A = pack8(x[ks][0], x[ks][1]);
#pragma unroll
      for (int nf = 0; nf < 12; ++nf) acc[nf] = __builtin_amdgcn_mfma_f32_16x16x32_bf16(Bf[ks][nf], A, acc[nf], 0, 0, 0);
    }
  }
#pragma unroll
  for (int hl = 0; hl < 3; ++hl) {
    f32x4 kr[4], rr[4], kkw[4], a0[4], ka[4];
#pragma unroll
    for (int q = 0; q < 4; ++q) {
      const int c = cb + (hl * 4 + q) * 16 + fq * 4;
      kr[q] = xs4t<SAMP>(P, l, row, 384 + c); rr[q] = xs4t<SAMP>(P, l, row, c);
      kkw[q] = *(const f32x4*)(P.in[I_KK] + l * 384 + c); a0[q] = *(const f32x4*)(P.in[I_A0] + l * 384 + c); ka[q] = *(const f32x4*)(P.in[I_KA] + l * 384 + c);
    }
    float ss = 0.f;
#pragma unroll
    for (int q = 0; q < 4; ++q) { kkw[q] = kr[q] * kkw[q]; ss += dot4(kkw[q], kkw[q]); }
    ss += __shfl_xor(ss, 16); ss += __shfl_xor(ss, 32);
    const float rn = rsqrtf(ss + 1e-6f);
#pragma unroll
    for (int q = 0; q < 4; ++q) {
      const int nf = hl * 4 + q, c = cb + nf * 16 + fq * 4;
      f32x4 kn, kk, kb;
#pragma unroll
      for (int j = 0; j < 4; ++j) {
        const float a = sigm(a0[q][j] + acc[nf][j]);
        kk[j] = kkw[q][j] * rn; kb[j] = kk[j] * a; kn[j] = kr[q][j] * (1.f + (a - 1.f) * ka[q][j]);
      }
      *(u32x2*)(WSP(bf16_t, OFF_RK) + ro + c) = pack4(kn);
      *(u32x2*)(WSP(bf16_t, OFF_RKK) + ro + c) = pack4(kk);
      *(u32x2*)(WSP(bf16_t, OFF_RB) + ro + c) = pack4(kb);
      *(u32x2*)(WSP(bf16_t, OFF_RR) + ro + c) = pack4(rr[q]);
    }
  }
  {
    f32x4 x[4][2];
    stage_lora<256>(smem, lw + G2T);
#pragma unroll
    for (int ks = 0; ks < 4; ++ks) { x[ks][0] = xs4t<SAMP>(P, l, row, 1280 + ks * 32 + fq * 8); x[ks][1] = xs4t<SAMP>(P, l, row, 1280 + ks * 32 + fq * 8 + 4); }
    bf16x8 A[4];
#pragma unroll
    for (int ks = 0; ks < 4; ++ks) {
#pragma unroll
      for (int j = 0; j < 4; ++j) { x[ks][0][j] = sigm(x[ks][0][j]); x[ks][1][j] = sigm(x[ks][1][j]); }
      A[ks] = pack8(x[ks][0], x[ks][1]);
    }
#pragma unroll
    for (int hf = 0; hf < 2; ++hf) {
      bf16x8 Bf[4][6];
#pragma unroll
      for (int ks = 0; ks < 4; ++ks)
#pragma unroll
        for (int n6 = 0; n6 < 6; ++n6) Bf[ks][n6] = *(const bf16x8*)(smem + (cb + (hf * 6 + n6) * 16 + fr) * 272 + ks * 64 + fq * 16);
#pragma unroll
      for (int n6 = 0; n6 < 6; ++n6) {
        f32x4 g = (f32x4){0.f, 0.f, 0.f, 0.f};
#pragma unroll
        for (int ks = 0; ks < 4; ++ks) g = __builtin_amdgcn_mfma_f32_16x16x32_bf16(Bf[ks][n6], A[ks], g, 0, 0, 0);
        *(u32x2*)(WSP(bf16_t, OFF_RG) + ro + cb + (hf * 6 + n6) * 16 + fq * 4) = pack4(g);
      }
    }
  }
  if (l == 0) {
    f32x4 v[12];
#pragma unroll
    for (int nf = 0; nf < 12; ++nf) v[nf] = xs4t<SAMP>(P, l, row, 768 + cb + nf * 16 + fq * 4);
#pragma unroll
    for (int nf = 0; nf < 12; ++nf) {
      const int c = cb + nf * 16 + fq * 4;
      const u32x2 o = pack4(v[nf]);
      *(u32x2*)(WSP(bf16_t, OFF_RV) + ro + c) = o;
      *(u32x2*)(WSP(bf16_t, OFF_VF) + ro + c) = o;
    }
  } else {
    f32x4 lo0 = (f32x4){0.f, 0.f, 0.f, 0.f}, lo1 = lo0;
#pragma unroll
    for (int hf = 0; hf < 2; ++hf) {
      f32x4 x[6][2]; bf16x8 B0[6], B1[6];
#pragma unroll
      for (int k6 = 0; k6 < 6; ++k6) {
        const int ks = hf * 6 + k6;
        x[k6][0] = xs4t<SAMP>(P, l, row, 768 + ks * 32 + fq * 8); x[k6][1] = xs4t<SAMP>(P, l, row, 768 + ks * 32 + fq * 8 + 4);
        B0[k6] = *(const bf16x8*)(lw + V1T + fr * 384 + ks * 32 + fq * 8);
        B1[k6] = *(const bf16x8*)(lw + V1T + (16 + fr) * 384 + ks * 32 + fq * 8);
      }
#pragma unroll
      for (int k6 = 0; k6 < 6; ++k6) {
        const bf16x8 A = pack8(x[k6][0], x[k6][1]);
        lo0 = __builtin_amdgcn_mfma_f32_16x16x32_bf16(B0[k6], A, lo0, 0, 0, 0);
        lo1 = __builtin_amdgcn_mfma_f32_16x16x32_bf16(B1[k6], A, lo1, 0, 0, 0);
      }
    }
    const bf16x8 A2 = pack8(lo0, lo1);
#pragma unroll
    for (int hf = 0; hf < 2; ++hf) {
      u32x4 bw[6]; f32x4 v0[6], v[6]; u32x2 vf[6];
#pragma unroll
      for (int n6 = 0; n6 < 6; ++n6) {
        const int nf = hf * 6 + n6, c = cb + nf * 16 + fq * 4;
        const bf16_t* vr = lw + V2T + (cb + nf * 16 + fr) * 32;
        const u32x2 b0 = *(const u32x2*)(vr + fq * 4), b1 = *(const u32x2*)(vr + 16 + fq * 4);
        bw[n6][0] = b0[0]; bw[n6][1] = b0[1]; bw[n6][2] = b1[0]; bw[n6][3] = b1[1];
        v0[n6] = *(const f32x4*)(P.in[I_V0] + (l - 1) * 384 + c);
        v[n6] = xs4t<SAMP>(P, l, row, 768 + c);
        vf[n6] = *(const u32x2*)(WSP(bf16_t, OFF_VF) + ro + c);
      }
#pragma unroll
      for (int n6 = 0; n6 < 6; ++n6) {
        const int c = cb + (hf * 6 + n6) * 16 + fq * 4;
        const f32x4 mv = __builtin_amdgcn_mfma_f32_16x16x32_bf16(__builtin_bit_cast(bf16x8, bw[n6]), A2, (f32x4){0.f, 0.f, 0.f, 0.f}, 0, 0, 0);
        const f32x4 vfv = unpack4(vf[n6]);
        f32x4 o;
#pragma unroll
        for (int j = 0; j < 4; ++j) o[j] = v[n6][j] + (vfv[j] - v[n6][j]) * sigm(v0[n6][j] + mv[j]);
        *(u32x2*)(WSP(bf16_t, OFF_RV) + ro + c) = pack4(o);
      }
    }
  }
}
__device__ __forceinline__ void prep_phase(const Params& P, unsigned char* smem, int l) {
  for (int it = obid(); it < 1092; it += gridDim.x) {
    if (it < 256) { const int wid = otid() >> 6; prep_rwkv_unit<false>(P, smem, l, it * 4 + (wid >> 1), wid & 1); }
    else if (it < 258) { const int wid = otid() >> 6; prep_rwkv_unit<true>(P, smem, l, it * 4 + (wid >> 1), wid & 1); }
    else if (it < 770) prep_gdn_prompt(P, l, it - 258);
    else if (it < 834) prep_gdn_sample(P, l, it - 770);
    else prep_hgrn(P, l, it - 834);
  }
  const bf16_t* p = WSP(bf16_t, OFF_P);
  for (int idx = obid() * 512 + otid(); idx < 136 * 1408; idx += gridDim.x * 512) {
    const int q = idx / 1408, col = idx - q * 1408;
    if (q < 8) P.out[O_SHIFT_P + (size_t)(l * 8 + q) * 1408 + col] = bf2f(p[(size_t)(q * TSEQ + TSEQ - 1) * PSTR + PB + col]);
    else P.out[O_SHIFT_S + (size_t)(l * 128 + (q - 8)) * 1408 + col] = bf2f(p[(size_t)(NTP + q - 8) * PSTR + PB + col]);
  }
}

template <int KIND> struct ScanCfg { static constexpr int STRIDE = KIND == 1 ? 356 : 164; };
typedef float f32x2 __attribute__((ext_vector_type(2)));
__device__ __forceinline__ float row_sum16(float v) { v += dppf<0xB1>(v); v += dppf<0x4E>(v); v += dppf<0x141>(v); v += dppf<0x140>(v); return v; }

template <int KIND> struct ScanPre { u32x2 a, b, c, d, v; f32x4 w; float g; };

template <int KIND>
__device__ __forceinline__ void scan_load(const Params& P, ScanPre<KIND>& r, int tid, int h, int half, int rowbase, int nvalid) {
  const int s = tid >> 4, j4 = (tid & 15) * 4;
  const int s2 = (tid >> 3) & 15, j2 = (tid & 7) * 4;
  const u32x2 z2 = {0u, 0u};
  const bool ok = s < nvalid, ok2 = (tid < 128) && (s2 < nvalid);
  if (KIND == 0) {
    const size_t o = (size_t)(rowbase + s) * 384 + h * 64 + j4;
    r.a = ok ? *(const u32x2*)(WSP(bf16_t, OFF_GK) + o) : z2;
    r.b = ok ? *(const u32x2*)(WSP(bf16_t, OFF_GQ) + o) : z2;
    r.v = ok2 ? *(const u32x2*)(WSP(bf16_t, OFF_GV) + (size_t)(rowbase + s2) * 384 + h * 64 + half * 32 + j2) : z2;
    const int sg = (tid >> 1) & 15;
    r.g = (tid < 32 && sg < nvalid) ? ((tid & 1) ? WSP(float, OFF_GBETA) : WSP(float, OFF_GDEC))[(size_t)(rowbase + sg) * 8 + h] : 0.f;
  } else if (KIND == 1) {
    const size_t o = (size_t)(rowbase + s) * 384 + h * 64 + j4;
    r.a = ok ? *(const u32x2*)(WSP(bf16_t, OFF_RR) + o) : z2;
    r.w = ok ? *(const f32x4*)(WSP(float, OFF_RW) + o) : (f32x4){0.f, 0.f, 0.f, 0.f};
    r.b = ok ? *(const u32x2*)(WSP(bf16_t, OFF_RK) + o) : z2;
    r.c = ok ? *(const u32x2*)(WSP(bf16_t, OFF_RKK) + o) : z2;
    r.d = ok ? *(const u32x2*)(WSP(bf16_t, OFF_RB) + o) : z2;
    r.v = ok2 ? *(const u32x2*)(WSP(bf16_t, OFF_RV) + (size_t)(rowbase + s2) * 384 + h * 64 + half * 32 + j2) : z2;
  } else {
    const size_t o = (size_t)(rowbase + s) * 256 + h * 64 + j4;
    r.a = ok ? *(const u32x2*)(WSP(bf16_t, OFF_HQ) + o) : z2;
    r.b = ok ? *(const u32x2*)(WSP(bf16_t, OFF_HK) + o) : z2;
    r.v = ok2 ? *(const u32x2*)(WSP(bf16_t, OFF_P) + (size_t)(rowbase + s2) * PSTR + PC + 512 + h * 64 + half * 32 + j2) : z2;
  }
}
template <int KIND>
__device__ __forceinline__ void scan_store(const ScanPre<KIND>& r, int tid, float* buf) {
  constexpr int STRIDE = ScanCfg<KIND>::STRIDE;
  const int s = tid >> 4, j4 = (tid & 15) * 4;
  const int s2 = (tid >> 3) & 15, j2 = (tid & 7) * 4;
  float* bs = buf + s * STRIDE + j4;
  if (KIND == 0) {
    const f32x4 k = unpack4(r.a), q = unpack4(r.b);
    *(f32x4*)(bs) = k; *(f32x4*)(bs + 64) = q;
    const float qk = row_sum16(dot4(q, k));
    if ((tid & 15) == 0) buf[s * STRIDE + 162] = qk;
    if (tid < 128) *(f32x4*)(buf + s2 * STRIDE + 128 + j2) = unpack4(r.v);
    if (tid < 32) buf[((tid >> 1) & 15) * STRIDE + 160 + (tid & 1)] = r.g;
  } else if (KIND == 1) {
    const f32x4 rr = unpack4(r.a), k = unpack4(r.b), kk = unpack4(r.c), bb = unpack4(r.d);
    *(f32x4*)(bs) = r.w * rr; *(f32x4*)(bs + 64) = r.w; *(f32x4*)(bs + 128) = k;
    *(f32x4*)(bs + 192) = kk; *(f32x4*)(bs + 256) = bb;
    const float br = row_sum16(dot4(bb, rr)), kr = row_sum16(dot4(k, rr));
    if ((tid & 15) == 0) { buf[s * STRIDE + 352] = br; buf[s * STRIDE + 353] = kr; }
    if (tid < 128) *(f32x4*)(buf + s2 * STRIDE + 320 + j2) = unpack4(r.v);
  } else {
    const f32x4 q = unpack4(r.a), k = unpack4(r.b);
    *(f32x4*)(bs) = q * (1.f - k); *(f32x4*)(bs + 64) = k;
    const float qk = row_sum16(dot4(q, k));
    if ((tid & 15) == 0) buf[s * STRIDE + 160] = qk;
    if (tid < 128) *(f32x4*)(buf + s2 * STRIDE + 128 + j2) = unpack4(r.v);
  }
}

template <int KIND> struct StepOps { f32x2 a[4], b[4], c[4], d[4], e[4]; float v, s0, s1, s2; };
template <int KIND>
__device__ __forceinline__ void step_load(StepOps<KIND>& o, const float* bs, int e0, int cl) {
#define LD8(dst, off) { const f32x4 _x = *(const f32x4*)(bs + (off) + e0), _y = *(const f32x4*)(bs + (off) + e0 + 4); \
    dst[0] = (f32x2){_x[0], _x[1]}; dst[1] = (f32x2){_x[2], _x[3]}; dst[2] = (f32x2){_y[0], _y[1]}; dst[3] = (f32x2){_y[2], _y[3]}; }
  if (KIND == 0) {
    LD8(o.a, 0) LD8(o.b, 64)
    o.v = bs[128 + cl];
    const f32x4 sc = *(const f32x4*)(bs + 160); o.s0 = sc[0]; o.s1 = sc[1]; o.s2 = sc[2];
  } else if (KIND == 1) {
    LD8(o.a, 0) LD8(o.b, 64) LD8(o.c, 128) LD8(o.d, 192) LD8(o.e, 256)
    o.v = bs[320 + cl];
    const f32x2 sc = *(const f32x2*)(bs + 352); o.s0 = sc[0]; o.s1 = sc[1];
  } else {
    LD8(o.a, 0) LD8(o.b, 64)
    o.v = bs[128 + cl]; o.s0 = bs[160];
  }
#undef LD8
}
template <int KIND>
__device__ __forceinline__ float step_compute(const StepOps<KIND>& o, f32x2 (&S)[4]) {
  if (KIND == 0) {
    f32x2 ks2 = o.a[0] * S[0], qs2 = o.b[0] * S[0];
#pragma unroll
    for (int i = 1; i < 4; ++i) { ks2 += o.a[i] * S[i]; qs2 += o.b[i] * S[i]; }
    float ks = ks2[0] + ks2[1], qs = qs2[0] + qs2[1];
    ks += dppf<0xB1>(ks); qs += dppf<0xB1>(qs); ks += dppf<0x4E>(ks); qs += dppf<0x4E>(qs); ks += dppf<0x141>(ks); qs += dppf<0x141>(qs);
    const float dec = o.s0, vn = o.s1 * (o.v - dec * ks);
#pragma unroll
    for (int i = 0; i < 4; ++i) S[i] = S[i] * dec + o.a[i] * vn;
    return dec * qs + vn * o.s2;
  } else if (KIND == 1) {
    f32x2 sa2 = o.d[0] * S[0], p2 = o.a[0] * S[0];
#pragma unroll
    for (int i = 1; i < 4; ++i) { sa2 += o.d[i] * S[i]; p2 += o.a[i] * S[i]; }
    float sa = sa2[0] + sa2[1], p1 = p2[0] + p2[1];
    sa += dppf<0xB1>(sa); p1 += dppf<0xB1>(p1); sa += dppf<0x4E>(sa); p1 += dppf<0x4E>(p1); sa += dppf<0x141>(sa); p1 += dppf<0x141>(p1);
    sa = -sa;
#pragma unroll
    for (int i = 0; i < 4; ++i) S[i] = S[i] * o.b[i] + (o.e[i] * sa + o.c[i] * o.v);
    return p1 + sa * o.s0 + o.v * o.s1;
  } else {
    f32x2 p2 = o.a[0] * S[0];
#pragma unroll
    for (int i = 1; i < 4; ++i) p2 += o.a[i] * S[i];
    float p1 = p2[0] + p2[1];
    p1 += dppf<0xB1>(p1); p1 += dppf<0x4E>(p1); p1 += dppf<0x141>(p1);
#pragma unroll
    for (int i = 0; i < 4; ++i) S[i] = S[i] + o.b[i] * (o.v - S[i]);
    return p1 + o.v * o.s0;
  }
}

template <int KIND>
__device__ __forceinline__ void scan_task(const Params& P, unsigned char* smem, int l, int seq, int h, int half, bool active) {
  constexpr int STRIDE = ScanCfg<KIND>::STRIDE, NEL = 16 * STRIDE;
  constexpr int NH = KIND == 2 ? 4 : 6;
  float* buf = (float*)smem;
  float* obuf = buf + 2 * NEL;
  const int tid = otid() & 255, lane = tid & 63, wid = tid >> 6;
  const int col_l = lane >> 3, sub = lane & 7, cl = wid * 8 + col_l, col = half * 32 + cl, e0 = sub * 8;
  const bool sample = seq >= 8;
  const int R0 = sample ? NTP + (seq - 8) : seq * TSEQ, T = sample ? 1 : TSEQ;
  const int ocol = (KIND == 0 ? 0 : (KIND == 1 ? 384 : 768)) + h * 64 + half * 32;
  const size_t O_P = KIND == 0 ? O_GDN_P : (KIND == 1 ? O_RWKV_P : O_HGRN_P);
  const size_t O_S = KIND == 0 ? O_GDN_S : (KIND == 1 ? O_RWKV_S : O_HGRN_S);
  const int I_ST = KIND == 0 ? I_SGDN : (KIND == 1 ? I_SRWKV : I_SHGRN);
  f32x2 S[4];
#pragma unroll
  for (int i = 0; i < 4; ++i) S[i] = (f32x2){0.f, 0.f};
  if (sample && active) {
    const float* st = P.in[I_ST] + ((size_t)(l * 128 + (seq - 8)) * NH + h) * 4096;
#pragma unroll
    for (int i = 0; i < 8; ++i) S[i >> 1][i & 1] = KIND == 1 ? st[col * 64 + e0 + i] : st[(e0 + i) * 64 + col];
  }
#pragma unroll
  for (int i = 0; i < 4; ++i) asm volatile("" : "+v"(S[i]));
  ScanPre<KIND> pre;
  __syncthreads();
  if (active) { scan_load<KIND>(P, pre, tid, h, half, R0, T); scan_store<KIND>(pre, tid, buf); }
  __syncthreads();
  const int nchunks = (T + 15) >> 4;
  bf16_t* oraw = WSP(bf16_t, OFF_P);
  for (int c = 0; c < nchunks; ++c) {
    if (active) {
      const int t0 = c * 16, n = (T - t0) < 16 ? (T - t0) : 16;
      const bool has_next = c + 1 < nchunks;
      if (c > 0) {
        const float* pob = obuf + ((c - 1) & 1) * 512;
#pragma unroll
        for (int i = 0; i < 2; ++i) {
          const int idx = tid + i * 256, s = idx >> 5, cc = idx & 31;
          oraw[(size_t)(R0 + t0 - 16 + s) * PSTR + ocol + cc] = f2bf(pob[idx]);
        }
      }
      if (has_next) scan_load<KIND>(P, pre, tid, h, half, R0 + t0 + 16, T - t0 - 16);
      const float* b = buf + (c & 1) * NEL;
      float* ob = obuf + (c & 1) * 512;
      if (n == 16) {
        StepOps<KIND> A, B;
        step_load<KIND>(A, b, e0, cl);
#pragma unroll
        for (int s = 0; s < 16; s += 2) {
          step_load<KIND>(B, b + (s + 1) * STRIDE, e0, cl);
          const float o0 = step_compute<KIND>(A, S);
          ob[s * 32 + cl] = o0;
          step_load<KIND>(A, b + (s + 2 < 16 ? s + 2 : 15) * STRIDE, e0, cl);
          const float o1 = step_compute<KIND>(B, S);
          ob[(s + 1) * 32 + cl] = o1;
        }
      } else {
        for (int s = 0; s < n; ++s) {
          StepOps<KIND> A;
          step_load<KIND>(A, b + s * STRIDE, e0, cl);
          const float o0 = step_compute<KIND>(A, S);
          ob[s * 32 + cl] = o0;
        }
      }
      if (has_next) scan_store<KIND>(pre, tid, buf + ((c + 1) & 1) * NEL);
    }
    __syncthreads();
  }
  if (active) {
    {
      const int c = nchunks - 1, t0 = c * 16, n = T - t0;
      const float* pob = obuf + (c & 1) * 512;
#pragma unroll
      for (int i = 0; i < 2; ++i) {
        const int idx = tid + i * 256, s = idx >> 5, cc = idx & 31;
        if (s < n) oraw[(size_t)(R0 + t0 + s) * PSTR + ocol + cc] = f2bf(pob[idx]);
      }
    }
    float* so = P.out + (sample ? O_S + ((size_t)(l * 128 + (seq - 8)) * NH + h) * 4096 : O_P + ((size_t)(l * 8 + seq) * NH + h) * 4096);
#pragma unroll
    for (int i = 0; i < 8; ++i) { if (KIND == 1) so[col * 64 + e0 + i] = S[i >> 1][i & 1]; else so[(e0 + i) * 64 + col] = S[i >> 1][i & 1]; }
  }
}

__device__ __forceinline__ void scan_phase(const Params& P, unsigned char* smem, int l, volatile unsigned* blk  ) {
  unsigned* q = WSP(unsigned, OFF_QUEUE) + l * 128;
  const int grp = otid() >> 8;
  for (int pass = 0; pass < 2; ++pass) {
    unsigned* qq = pass == 1 ? q + 64 : q;
    const unsigned ntask = pass == 1 ? 2048u : 256u;
    for (;;) {
      __syncthreads();
      if (threadIdx.x == 0) blk[3] = __hip_atomic_fetch_add(qq, 1u, __ATOMIC_RELAXED, __HIP_MEMORY_SCOPE_AGENT);
      __syncthreads();
      const int t = (int)blk[3];
      if (t >= (int)ntask) break;
      int kind, seq, h, half; bool act; unsigned char* sm;
      if (pass == 0) {
        act = grp == 0; sm = smem; half = t & 1;
        if (t < 96) { kind = 1; const int bh = t >> 1; seq = bh / 6; h = bh % 6; }
        else if (t < 192) { kind = 0; const int bh = (t - 96) >> 1; seq = bh / 6; h = bh % 6; }
        else { kind = 2; const int bh = (t - 192) >> 1; seq = bh / 4; h = bh % 4; }
      } else {
        const int hh = t & 15;
        act = true; sm = smem + grp * 51200; half = grp; seq = 8 + (t >> 4);
        if (hh < 6) { kind = 0; h = hh; } else if (hh < 12) { kind = 1; h = hh - 6; } else { kind = 2; h = hh - 12; }
      }
      if (kind == 0) scan_task<0>(P, sm, l, seq, h, half, act);
      else if (kind == 1) scan_task<1>(P, sm, l, seq, h, half, act);
      else scan_task<2>(P, sm, l, seq, h, half, act);
    }
  }
  if (l + 1 < NLAYER) {
    for (;;) {
      __syncthreads();
      if (threadIdx.x == 0) blk[3] = __hip_atomic_fetch_add(q + 96, 1u, __ATOMIC_RELAXED, __HIP_MEMORY_SCOPE_AGENT);
      __syncthreads();
      const unsigned t = blk[3];
      if (t >= (unsigned)WCONV_JOBS) break;
      wconv_job(P, smem, l + 1, (int)t);
    }
  }
}

__device__ __forceinline__ void post_phase(const Params& P, int l) {
  const int lane = otid() & 63, wid = otid() >> 6;
  const bf16_t* p = WSP(bf16_t, OFF_P);
  bf16_t* act = WSP(bf16_t, OFF_ACT);
  const int gw = obid() * 8 + wid, nw = gridDim.x * 8;
  const float gnw = P.in[I_GNW][l * 64 + lane], hnw = P.in[I_HNW][l * 64 + lane];
  for (int u0 = gw * 4; u0 < NTOK * 10; u0 += nw * 4) {
    float o[4], z[4]; int oc[4]; size_t rb[4];
#pragma unroll
    for (int k = 0; k < 4; ++k) {
      const int u = u0 + k, row = u / 10, q = u - row * 10;
      oc[k] = q < 6 ? q * 64 : 768 + (q - 6) * 64;
      const int zc = q < 6 ? 1152 + q * 64 : PC + 768 + (q - 6) * 64;
      rb[k] = (size_t)row;
      o[k] = bf2f(p[(size_t)row * PSTR + oc[k] + lane]);
      z[k] = bf2f(p[(size_t)row * PSTR + zc + lane]);
    }
#pragma unroll
    for (int k = 0; k < 4; ++k) {
      const float ms = wave_sum(o[k] * o[k]) * (1.f / 64.f);
      const float out = o[k] * rsqrtf(ms + 1e-6f) * (oc[k] < 384 ? gnw : hnw) * silu(z[k]);
      act[rb[k] * 1024 + oc[k] + lane] = f2bf(out);
    }
  }
  for (int u0 = gw * 2; u0 < NTOK * 6; u0 += nw * 2) {
    float o[2], r[2], kx[2], v[2], g[2]; int hh[2]; size_t rb[2];
#pragma unroll
    for (int k = 0; k < 2; ++k) {
      const int u = u0 + k, row = u / 6, h = u - row * 6;
      const size_t idx = (size_t)row * 384 + h * 64 + lane;
      hh[k] = h; rb[k] = (size_t)row;
      o[k] = bf2f(p[(size_t)row * PSTR + 384 + h * 64 + lane]);
      r[k] = bf2f(WSP(bf16_t, OFF_RR)[idx]); kx[k] = bf2f(WSP(bf16_t, OFF_RK)[idx]);
      v[k] = bf2f(WSP(bf16_t, OFF_RV)[idx]); g[k] = bf2f(WSP(bf16_t, OFF_RG)[idx]);
    }
#pragma unroll
    for (int k = 0; k < 2; ++k) {
      const int hc = l * 384 + hh[k] * 64 + lane;
      const float mu = wave_sum(o[k]) * (1.f / 64.f);
      const float yc = o[k] - mu;
      const float var = wave_sum(yc * yc) * (1.f / 64.f);
      const float y = yc * rsqrtf(var + 64e-5f) * P.in[I_LNW][hc] + P.in[I_LNB][hc];
      const float rk = wave_sum(r[k] * kx[k] * P.in[I_RK][hc]);
      act[rb[k] * 1024 + 384 + hh[k] * 64 + lane] = f2bf((y + rk * v[k]) * g[k]);
    }
  }
}

#define XB_TMO      128
#define XB_XCNT(j)  (256  + 64 * (j))
#define XB_XSUB(j)  (1280 + 64 * (j))
#define XB_XGEN(j)  (2304 + 64 * (j))
#define XB_TOP      3328
#define XB_TOPGEN   3392
#define XCD_BAR_WORDS 3456
#define XB_SPIN_CAP (1u << 20)
#define LAS __attribute__((address_space(3)))
__device__ __forceinline__ unsigned xb_ld(unsigned* p)              { return __hip_atomic_load(p, __ATOMIC_RELAXED, __HIP_MEMORY_SCOPE_AGENT); }
__device__ __forceinline__ unsigned xb_add(unsigned* p, unsigned v) { return __hip_atomic_fetch_add(p, v, __ATOMIC_RELAXED, __HIP_MEMORY_SCOPE_AGENT); }
__device__ __forceinline__ unsigned xb_xcc_id() { return (unsigned)__builtin_amdgcn_s_getreg((3 << 11) | 20) & 0xFu; }
#define XB_SPIN(cond, bar) do { unsigned _sp = 0; while (cond) { __builtin_amdgcn_s_sleep(1); \
    if ((++_sp & 255u) == 0u) { if (xb_ld(&(bar)[XB_TMO])) break; if (_sp > XB_SPIN_CAP) { atomicAdd(&(bar)[XB_TMO], 1u); break; } } } } while (0)
struct XcdBarrier { unsigned* bar; unsigned x; volatile LAS unsigned* st; };
__device__ __forceinline__ XcdBarrier xcd_barrier_post(unsigned* bar, volatile LAS unsigned* st) {
  XcdBarrier b; b.bar = bar; b.x = xb_xcc_id(); b.st = st;
  if (threadIdx.x == 0) (void)xb_add(&bar[XB_XCNT(b.x)], 1u);
  return b;
}
__device__ __forceinline__ void xcd_barrier_complete(unsigned* bar, unsigned x, unsigned& nloc, unsigned& nx) {
  const unsigned G = gridDim.x * gridDim.y * gridDim.z;
  unsigned sum, cnt, mine, sp = 0u;
  for (;;) {
    sum = 0u; cnt = 0u; mine = 0u;
#pragma unroll
    for (unsigned j = 0; j < 16; ++j) { const unsigned c = xb_ld(&bar[XB_XCNT(j)]); sum += c; cnt += (c > 0u) ? 1u : 0u; mine = (j == x) ? c : mine; }
    if (sum == G) break;
    __builtin_amdgcn_s_sleep(1);
    if ((++sp & 255u) == 0u) { if (xb_ld(&bar[XB_TMO])) break; if (sp > XB_SPIN_CAP) { atomicAdd(&bar[XB_TMO], 1u); break; } }
  }
  nloc = mine > 0u ? mine : 1u; nx = cnt > 0u ? cnt : 1u;
}
__device__ __forceinline__ void xcd_barrier(const XcdBarrier& b) {
  asm volatile("s_waitcnt vmcnt(0)" ::: "memory");
  __syncthreads();
  if (threadIdx.x == 0) {
    unsigned* bar = b.bar;
    __builtin_amdgcn_s_waitcnt(0);
    unsigned nloc = b.st[0], nx = b.st[1];
    if (nloc == 0u) { xcd_barrier_complete(bar, b.x, nloc, nx); b.st[0] = nloc; b.st[1] = nx; }
    const unsigned old = xb_add(&bar[XB_XSUB(b.x)], 1u);
    const unsigned gen = old / nloc;
    if (old + 1u == (gen + 1u) * nloc) {
      __builtin_amdgcn_fence(__ATOMIC_RELEASE, "agent");
      asm volatile("s_waitcnt vmcnt(0)" ::: "memory");
      const unsigned og = xb_add(&bar[XB_TOP], 1u);
      const unsigned tg = og / nx;
      if (og + 1u == (tg + 1u) * nx) xb_add(&bar[XB_TOPGEN], 1u);
      else XB_SPIN(xb_ld(&bar[XB_TOPGEN]) == tg, bar);
      __builtin_amdgcn_fence(__ATOMIC_ACQUIRE, "agent");
      xb_add(&bar[XB_XGEN(b.x)], 1u);
      asm volatile("s_waitcnt vmcnt(0)" ::: "memory");
    } else {
      XB_SPIN(xb_ld(&bar[XB_XGEN(b.x)]) == gen, bar);
      __builtin_amdgcn_fence(__ATOMIC_ACQUIRE, "agent");
      asm volatile("s_waitcnt vmcnt(0)" ::: "memory");
    }
  }
  __syncthreads();
}

__global__ void __launch_bounds__(512, 2) hybrid_fwd(Params P) {
  cg::grid_group grid = cg::this_grid();
  __shared__ __attribute__((aligned(16))) unsigned char smem[131072 + 64];
  uint4& xb_words = *(uint4*)(smem + 131072);
  if (threadIdx.x == 0) xb_words = make_uint4(0u, 0u, 0u, 0u);
  __syncthreads();
  const XcdBarrier xb = xcd_barrier_post(WSP(unsigned, OFF_BAR), (volatile LAS unsigned*)&xb_words);
  if (threadIdx.x == 0) {
    const unsigned hw = (unsigned)__builtin_amdgcn_s_getreg((7 << 11) | (8 << 6) | 4) & 0xffu;
    const unsigned key = (xb.x << 8) | hw;
    ((volatile unsigned*)&xb_words)[2] = __hip_atomic_fetch_add(WSP(unsigned, OFF_CUTAB) + key, 1u, __ATOMIC_RELAXED, __HIP_MEMORY_SCOPE_AGENT);
  }
  __syncthreads();
#pragma unroll 1
  for (int step = 0; step < NLAYER * 9; ++step) {
    const int l = step / 9, ph = step - l * 9;
    switch (ph) {
      case 0: if (l == 0) wconv_phase(P, smem, 0); norm_phase(P, l, P.in[I_NORM_MIX] + l * D); break;
      case 1: gemm_phase<EPI_P>(P, smem, WSP(bf16_t, OFF_ACT), 1024, WSP(bf16_t, OFF_WTIN), 1024, 32, l, 4096);
              gemm_sample<EPI_P>(P, WSP(bf16_t, OFF_ACT), 1024, WSP(bf16_t, OFF_WTIN), 1024, 249, l); break;
      case 2: prep_phase(P, smem, l); break;
      case 3: scan_phase(P, smem, l, (volatile unsigned*)&xb_words); break;
      case 4: post_phase(P, l); break;
      case 5: gemm_phase<EPI_RES>(P, smem, WSP(bf16_t, OFF_ACT), 1024, WSP(bf16_t, wt_out_off(l)), 1024, 8, l, 1024);
              gemm_sample<EPI_RES>(P, WSP(bf16_t, OFF_ACT), 1024, WSP(bf16_t, wt_out_off(l)), 1024, 64, l); break;
      case 6: norm_phase(P, 1, P.in[I_NORM_FFN] + l * D); break;
      case 7: gemm_phase<EPI_SWIGLU>(P, smem, WSP(bf16_t, OFF_ACT), 1024, WSP(bf16_t, wt_gu_off(l)), 1024, 44, 1, 5632);
              gemm_sample<EPI_SWIGLU>(P, WSP(bf16_t, OFF_ACT), 1024, WSP(bf16_t, wt_gu_off(l)), 1024, 176, 1); break;
      default: gemm_phase<EPI_RES>(P, smem, WSP(bf16_t, OFF_P), DFF, WSP(bf16_t, wt_dn_off(l)), DFF, 8, 1, 1024);
               gemm_sample<EPI_RES>(P, WSP(bf16_t, OFF_P), DFF, WSP(bf16_t, wt_dn_off(l)), DFF, 64, 1); break;
    }
    if (step == 0) grid.sync();
    else xcd_barrier(xb);
  }
  final_norm_phase(P);
}

extern "C" void kernel_launch(void* const* d_in, const int* in_sizes, int n_in,
                              void* d_out, int out_size, void* d_ws, size_t ws_size,
                              hipStream_t stream) {
  static int grid_blocks = 0;
  if (!grid_blocks) {
    int dev = 0, cus = 0, per_cu = 0;
    (void)hipGetDevice(&dev);
    (void)hipDeviceGetAttribute(&cus, hipDeviceAttributeMultiprocessorCount, dev);
    (void)hipOccupancyMaxActiveBlocksPerMultiprocessor(&per_cu, hybrid_fwd, 512, 0);
    if (per_cu > 1) per_cu = 1;
    if (per_cu < 1) per_cu = 1;
    grid_blocks = cus * per_cu;
  }
  if (ws_size < WS_NEED) { fprintf(stderr, "workspace too small: %zu < %zu\n", ws_size, (size_t)WS_NEED); return; }
  Params p{};
  for (int i = 0; i < N_IN; ++i) p.in[i] = (const float*)d_in[i];
  p.out = (float*)d_out;
  p.ws = (unsigned char*)d_ws;
  (void)hipMemsetAsync((unsigned char*)d_ws + OFF_BAR, 0, BAR_BYTES, stream);
  void* args[] = {&p};
  hipError_t e = hipLaunchCooperativeKernel((void*)hybrid_fwd, dim3(grid_blocks), dim3(512), args, 0, stream);
  if (e != hipSuccess) fprintf(stderr, "cooperative launch failed: %s (grid %d)\n", hipGetErrorString(e), grid_blocks);
}
```

```cpp
#include <hip/hip_runtime.h>
#include <hip/hip_cooperative_groups.h>
#include <cstdio>
namespace cg = cooperative_groups;

typedef unsigned short bf16_t;
typedef short bf16x8 __attribute__((ext_vector_type(8)));
typedef float f32x4 __attribute__((ext_vector_type(4)));
typedef unsigned u32x4 __attribute__((ext_vector_type(4)));
typedef unsigned u32x2 __attribute__((ext_vector_type(2)));

constexpr int D = 1024, NTP = 16384, NTS = 128, NTOK = 16512, TSEQ = 2048, NLAYER = 4;
constexpr int IN_COLS = 3980, PSTR = 3984, DFF = 2816;
constexpr int PB = 1548, PC = 2956;

enum { I_XP = 0, I_XS, I_SGDN, I_SCONV, I_SRWKV, I_SSHIFT, I_SHGRN, I_NORM_MIX, I_WIN, I_WOUT, I_CONVW, I_ALOG, I_DTB, I_GNW,
       I_MU, I_W0, I_W2, I_A0, I_A2, I_G2, I_V0, I_V1, I_V2, I_KK, I_KA, I_RK, I_LNW, I_LNB, I_HLB, I_HNW, I_NORM_FFN,
       I_WG, I_WU, I_WD, I_NORM_FINAL, N_IN };

constexpr size_t O_YP = 0, O_YS = 16777216, O_GDN_P = 16908288, O_GDN_S = 17694720, O_CONV_P = 30277632, O_CONV_S = 30388224,
                 O_RWKV_P = 32157696, O_RWKV_S = 32944128, O_SHIFT_P = 45527040, O_SHIFT_S = 45572096, O_HGRN_P = 46292992,
                 O_HGRN_S = 46817280;

constexpr size_t SZ_WTIN = (size_t)4096 * 1024 * 2, SZ_WTOUT = (size_t)1024 * 1024 * 2, SZ_WTGU = (size_t)5632 * 1024 * 2,
                 SZ_WTDN = (size_t)1024 * 2816 * 2, SZ_P = (size_t)NTOK * PSTR * 2, SZ_ACT = (size_t)NTOK * 1024 * 2,
                 SZ_T384 = (size_t)NTOK * 384 * 2, SZ_T8F = (size_t)NTOK * 8 * 4, SZ_T256 = (size_t)NTOK * 256 * 2,
                 SZ_T384F = (size_t)NTOK * 384 * 4;
constexpr size_t OFF_WTIN = 0, OFF_WTOUT = OFF_WTIN + SZ_WTIN, OFF_WTGU = OFF_WTOUT + SZ_WTOUT, OFF_WTDN = OFF_WTGU + SZ_WTGU,
                 OFF_P = OFF_WTDN + SZ_WTDN, OFF_ACT = OFF_P + SZ_P, OFF_GQ = OFF_ACT + SZ_ACT, OFF_GK = OFF_GQ + SZ_T384,
                 OFF_GV = OFF_GK + SZ_T384, OFF_GDEC = OFF_GV + SZ_T384, OFF_GBETA = OFF_GDEC + SZ_T8F, OFF_HQ = OFF_GBETA + SZ_T8F,
                 OFF_HK = OFF_HQ + SZ_T256, OFF_RR = OFF_HK + SZ_T256, OFF_RK = OFF_RR + SZ_T384, OFF_RV = OFF_RK + SZ_T384,
                 OFF_RKK = OFF_RV + SZ_T384, OFF_RB = OFF_RKK + SZ_T384, OFF_RG = OFF_RB + SZ_T384, OFF_RW = OFF_RG + SZ_T384,
                 OFF_VF = OFF_RW + SZ_T384F, OFF_LORA = OFF_VF + SZ_T384, OFF_WTOUT2 = OFF_LORA + 245760, OFF_WTGU2 = OFF_WTOUT2 + SZ_WTOUT, OFF_WTDN2 = OFF_WTGU2 + SZ_WTGU, OFF_BAR = OFF_WTDN2 + SZ_WTDN, OFF_CUTAB = OFF_BAR + 16384, OFF_QUEUE = OFF_CUTAB + 16384, BAR_BYTES = 16384 + 16384 + 4096, WS_NEED = OFF_BAR + BAR_BYTES;
constexpr int W2T = 0, A2T = 24576, G2T = 49152, V1T = 98304, V2T = 110592;

struct Params {
  const float* in[N_IN];
  float* out;
  unsigned char* ws;
};

#define WSP(T, off) ((T*)(P.ws + (off)))

__device__ __forceinline__ int otid() { int t = __builtin_amdgcn_workitem_id_x(); asm volatile("" : "+v"(t)); return t; }
__device__ __forceinline__ int obid() { int b = __builtin_amdgcn_workgroup_id_x(); asm volatile("" : "+s"(b)); return b; }
template <class T> __device__ __forceinline__ const T* opq(const T* p) { asm volatile("" : "+s"(p)); return p; }
__device__ __forceinline__ float bf2f(bf16_t h) { return __uint_as_float(((unsigned)h) << 16); }
typedef float f32x2_t __attribute__((ext_vector_type(2)));
typedef __bf16 bf16x2_t __attribute__((ext_vector_type(2)));
__device__ __forceinline__ unsigned pk2(float lo, float hi) {
  const f32x2_t v = {lo, hi};
  return __builtin_bit_cast(unsigned, __builtin_convertvector(v, bf16x2_t));
}
__device__ __forceinline__ bf16_t f2bf(float f) { return (bf16_t)(pk2(f, 0.f) & 0xffffu); }
__device__ __forceinline__ float sigm(float x) { return 1.f / (1.f + __expf(-x)); }
__device__ __forceinline__ float silu(float x) { return x / (1.f + __expf(-x)); }
__device__ __forceinline__ float softplus(float x) { return x > 20.f ? x : log1pf(__expf(x)); }
template <int CTRL> __device__ __forceinline__ float dppf(float x) {
  return __builtin_bit_cast(float, __builtin_amdgcn_mov_dpp(__builtin_bit_cast(int, x), CTRL, 0xf, 0xf, true));
}
__device__ __forceinline__ float wave_sum(float v) {
  v += dppf<0xB1>(v); v += dppf<0x4E>(v); v += dppf<0x141>(v); v += dppf<0x140>(v);
  const int iv = __builtin_bit_cast(int, v);
  const float s0 = __builtin_bit_cast(float, __builtin_amdgcn_readlane(iv, 0)), s1 = __builtin_bit_cast(float, __builtin_amdgcn_readlane(iv, 16));
  const float s2 = __builtin_bit_cast(float, __builtin_amdgcn_readlane(iv, 32)), s3 = __builtin_bit_cast(float, __builtin_amdgcn_readlane(iv, 48));
  return (s0 + s1) + (s2 + s3);
}
typedef float f32x2 __attribute__((ext_vector_type(2)));
__device__ __forceinline__ float row_sum16(float v) { v += dppf<0xB1>(v); v += dppf<0x4E>(v); v += dppf<0x141>(v); v += dppf<0x140>(v); return v; }
__device__ __forceinline__ float half_sum(float v) { v = row_sum16(v); return v + __shfl_xor(v, 16); }
__device__ __forceinline__ float reduce8(float x) { x += dppf<0xB1>(x); x += dppf<0x4E>(x); x += dppf<0x141>(x); return x; }

__device__ __forceinline__ f32x4 unpack4(u32x2 w) {
  f32x4 f; f[0] = __uint_as_float(w[0] << 16); f[1] = __uint_as_float(w[0] & 0xffff0000u);
  f[2] = __uint_as_float(w[1] << 16); f[3] = __uint_as_float(w[1] & 0xffff0000u); return f;
}
__device__ __forceinline__ bf16x8 pack8(f32x4 a, f32x4 b) {
  u32x4 u; u[0] = pk2(a[0], a[1]); u[1] = pk2(a[2], a[3]); u[2] = pk2(b[0], b[1]); u[3] = pk2(b[2], b[3]);
  return __builtin_bit_cast(bf16x8, u);
}
__device__ __forceinline__ u32x2 pack4(f32x4 a) { u32x2 u; u[0] = pk2(a[0], a[1]); u[1] = pk2(a[2], a[3]); return u; }
__device__ __forceinline__ float dot4(f32x4 a, f32x4 b) { return (a[0] * b[0] + a[1] * b[1]) + (a[2] * b[2] + a[3] * b[3]); }
__device__ __forceinline__ const float* xin_row(const Params& P, int l, int row) {
  const float* po = opq((const float*)P.out); const float* pp = opq(P.in[I_XP]); const float* ps = opq(P.in[I_XS]);
  if (l > 0) return po + (size_t)row * D;
  return row < NTP ? pp + (size_t)row * D : ps + (size_t)(row - NTP) * D;
}

__device__ __forceinline__ int gu_row(int c, int up) { return (c >> 7) * 256 + up * 128 + (c & 127); }
__device__ __forceinline__ void xpose_tile(unsigned char* smem, const float* __restrict__ W, int N, int kt, int ntl, bf16_t* __restrict__ dst, int dstK, int mode) {
  float (*tile)[65] = (float (*)[65])smem;
  const int tid = otid();
  __syncthreads();
#pragma unroll 4
  for (int i = 0; i < 8; ++i) {
    const int k = i * 8 + (tid >> 6), n = tid & 63, gn = ntl * 64 + n;
    tile[k][n] = gn < N ? W[(size_t)(kt * 64 + k) * N + gn] : 0.f;
  }
  __syncthreads();
#pragma unroll 4
  for (int i = 0; i < 4; ++i) {
    const int n = i * 16 + (tid >> 5), k = (tid & 31) * 2, gn = ntl * 64 + n;
    const int drow = mode == 0 ? gn : gu_row(gn, mode - 1);
    *(unsigned*)(dst + (size_t)drow * dstK + kt * 64 + k) = pk2(tile[k][n], tile[k + 1][n]);
  }
}
constexpr int WCONV_JOBS = 3392 + 480;
__device__ __forceinline__ size_t wt_out_off(int l) { return (l & 1) ? OFF_WTOUT2 : OFF_WTOUT; }
__device__ __forceinline__ size_t wt_gu_off(int l) { return (l & 1) ? OFF_WTGU2 : OFF_WTGU; }
__device__ __forceinline__ size_t wt_dn_off(int l) { return (l & 1) ? OFF_WTDN2 : OFF_WTDN; }
__device__ __forceinline__ void wconv_job(const Params& P, unsigned char* smem, int l, int job) {
  if (job < 1024) xpose_tile(smem, P.in[I_WIN] + (size_t)l * 1024 * IN_COLS, IN_COLS, job & 15, job >> 4, WSP(bf16_t, OFF_WTIN), 1024, 0);
  else if (job < 1280) { const int j = job - 1024; xpose_tile(smem, P.in[I_WOUT] + (size_t)l * 1024 * 1024, 1024, j & 15, j >> 4, WSP(bf16_t, wt_out_off(l)), 1024, 0); }
  else if (job < 1984) { const int j = job - 1280; xpose_tile(smem, P.in[I_WG] + (size_t)l * 1024 * DFF, DFF, j & 15, j >> 4, WSP(bf16_t, wt_gu_off(l)), 1024, 1); }
  else if (job < 2688) { const int j = job - 1984; xpose_tile(smem, P.in[I_WU] + (size_t)l * 1024 * DFF, DFF, j & 15, j >> 4, WSP(bf16_t, wt_gu_off(l)), 1024, 2); }
  else if (job < 3392) { const int j = job - 2688; xpose_tile(smem, P.in[I_WD] + (size_t)l * DFF * 1024, 1024, j % 44, j / 44, WSP(bf16_t, wt_dn_off(l)), DFF, 0); }
  else {
    bf16_t* lw = WSP(bf16_t, OFF_LORA);
    const int idx = (job - 3392) * 256 + (otid() & 255);
    float v = 0.f;
    const float* pw2 = opq(P.in[I_W2]); const float* pa2 = opq(P.in[I_A2]); const float* pg2 = opq(P.in[I_G2]);
    const float* pv1 = opq(P.in[I_V1]); const float* pv2 = opq(P.in[I_V2]);
    if (idx < A2T) { const int n = idx >> 6, k = idx & 63; v = pw2[(size_t)l * 64 * 384 + k * 384 + n]; }
    else if (idx < G2T) { const int i = idx - A2T, n = i >> 6, k = i & 63; v = pa2[(size_t)l * 64 * 384 + k * 384 + n]; }
    else if (idx < V1T) { const int i = idx - G2T, n = i >> 7, k = i & 127; v = pg2[(size_t)l * 128 * 384 + k * 384 + n]; }
    else if (idx < V2T) { if (l > 0) { const int i = idx - V1T, n = i / 384, k = i - n * 384; v = pv1[(size_t)(l - 1) * 384 * 32 + k * 32 + n]; } }
    else { if (l > 0) { const int i = idx - V2T, n = i >> 5, k = i & 31; v = pv2[(size_t)(l - 1) * 32 * 384 + k * 384 + n]; } }
    if (otid() < 256) lw[idx] = f2bf(v);
  }
}
__device__ __forceinline__ void wconv_phase(const Params& P, unsigned char* smem, int l) {
  for (int job = obid(); job < WCONV_JOBS; job += gridDim.x) wconv_job(P, smem, l, job);
}

__device__ __forceinline__ void norm_phase(const Params& P, int l_in, const float* __restrict__ w) {
  bf16_t* act = WSP(bf16_t, OFF_ACT);
  const int lane = otid() & 63, wid = otid() >> 6;
  for (int row = obid() * 8 + wid; row < NTOK; row += gridDim.x * 8) {
    const float* xr = xin_row(P, l_in, row);
    f32x4 v[4]; float ss = 0.f;
#pragma unroll
    for (int i = 0; i < 4; ++i) { v[i] = *(const f32x4*)(xr + i * 256 + lane * 4); ss += v[i][0] * v[i][0] + v[i][1] * v[i][1] + v[i][2] * v[i][2] + v[i][3] * v[i][3]; }
    ss = wave_sum(ss);
    const float rstd = rsqrtf(ss * (1.f / 1024.f) + 1e-6f);
#pragma unroll
    for (int i = 0; i < 4; ++i) {
      const f32x4 wv = *(const f32x4*)(w + i * 256 + lane * 4);
      u32x2 o; o[0] = pk2(v[i][0] * rstd * wv[0], v[i][1] * rstd * wv[1]); o[1] = pk2(v[i][2] * rstd * wv[2], v[i][3] * rstd * wv[3]);
      *(u32x2*)(act + (size_t)row * 1024 + i * 256 + lane * 4) = o;
    }
  }
}
__device__ __forceinline__ void final_norm_phase(const Params& P) {
  const float* w = P.in[I_NORM_FINAL];
  const int lane = otid() & 63, wid = otid() >> 6;
  for (int row = obid() * 8 + wid; row < NTOK; row += gridDim.x * 8) {
    float* xr = P.out + (size_t)row * D;
    f32x4 v[4]; float ss = 0.f;
#pragma unroll
    for (int i = 0; i < 4; ++i) { v[i] = *(const f32x4*)(xr + i * 256 + lane * 4); ss += v[i][0] * v[i][0] + v[i][1] * v[i][1] + v[i][2] * v[i][2] + v[i][3] * v[i][3]; }
    ss = wave_sum(ss);
    const float rstd = rsqrtf(ss * (1.f / 1024.f) + 1e-6f);
#pragma unroll
    for (int i = 0; i < 4; ++i) {
      const f32x4 wv = *(const f32x4*)(w + i * 256 + lane * 4);
      f32x4 o; o[0] = v[i][0] * rstd * wv[0]; o[1] = v[i][1] * rstd * wv[1]; o[2] = v[i][2] * rstd * wv[2]; o[3] = v[i][3] * rstd * wv[3];
      *(f32x4*)(xr + i * 256 + lane * 4) = o;
    }
  }
}

enum { EPI_P = 0, EPI_RES = 1, EPI_SWIGLU = 2 };
namespace pg8 {
constexpr int BM = 256, BK = 64, HALF = 128, HTB = HALF * BK * 2, NXCD = 8, WGM = 8;
__device__ __forceinline__ int lds_byte(int r, int c) { const int st = (r >> 4) * 2 + (c >> 5), rr = r & 15, cc = c & 31, ob = rr * 64 + cc * 2; return st * 1024 + (ob ^ (((ob >> 9) & 1) << 5)); }
__device__ __forceinline__ void stage_rc(int b, int& R, int& C) { const int st = b / 1024, sb = b % 1024, swz = sb ^ (((sb >> 9) & 1) << 5); R = (st >> 1) * 16 + swz / 64; C = (st & 1) * 32 + (swz % 64) / 2; }
struct Unit { int pm, pn; };
struct StaticOrder {
  int nM, nN, nwg, G, c;
  __device__ __forceinline__ void init(int M, int N, int G_, int c_) { nM = M / BM; nN = N / BM; nwg = nM * nN; G = G_; c = c_; }
  __device__ __forceinline__ bool next(int i, Unit& u) const {
    const long L = (long)i * G + c; if (L >= nwg) return false;
    int wgid = (int)L; { const int q = nwg / NXCD, r = nwg % NXCD, xcd = wgid % NXCD, off = wgid / NXCD; wgid = (xcd < r ? xcd * (q + 1) : r * (q + 1) + (xcd - r) * q) + off; }
    const int nig = WGM * nN, gid = wgid / nig, fm = gid * WGM, gsz = (nM - fm) < WGM ? (nM - fm) : WGM;
    u.pm = fm + ((wgid % nig) % gsz); u.pn = (wgid % nig) / gsz; return true;
  }
};
}

template <int EPI>
__device__ __forceinline__ void gemm_epilogue(const Params& P, const f32x4 (&acc)[2][2][4][2], const pg8::Unit& u, int wr, int wc, int fr, int fq, int l) {
#pragma unroll
  for (int ai = 0; ai < 2; ++ai)
#pragma unroll
    for (int m = 0; m < 4; ++m) {
      const int row = u.pm * 256 + ai * 128 + wr * 64 + m * 16 + fr;
      if (EPI == EPI_P) {
        bf16_t* pr = WSP(bf16_t, OFF_P) + (size_t)row * PSTR;
#pragma unroll
        for (int bj = 0; bj < 2; ++bj)
#pragma unroll
          for (int n = 0; n < 2; ++n) {
            const int col = u.pn * 256 + bj * 128 + wc * 32 + n * 16 + fq * 4;
            if (col < IN_COLS) *(u32x2*)(pr + col) = pack4(acc[ai][bj][m][n]);
          }
      } else if (EPI == EPI_RES) {
        const float* xi = xin_row(P, l, row);
        float* xo = P.out + (size_t)row * D;
#pragma unroll
        for (int bj = 0; bj < 2; ++bj)
#pragma unroll
          for (int n = 0; n < 2; ++n) {
            const int col = u.pn * 256 + bj * 128 + wc * 32 + n * 16 + fq * 4;
            *(f32x4*)(xo + col) = *(const f32x4*)(xi + col) + acc[ai][bj][m][n];
          }
      } else {
        bf16_t* ur = WSP(bf16_t, OFF_P) + (size_t)row * DFF;
#pragma unroll
        for (int n = 0; n < 2; ++n) {
          const int col = u.pn * 128 + wc * 32 + n * 16 + fq * 4;
          f32x4 r;
#pragma unroll
          for (int j = 0; j < 4; ++j) r[j] = silu(acc[ai][0][m][n][j]) * acc[ai][1][m][n][j];
          *(u32x2*)(ur + col) = pack4(r);
        }
      }
    }
}

#define PG8_LAS __attribute__((address_space(3)))
template <int EPI>
__device__ __forceinline__ void gemm_phase(const Params& P, unsigned char* smem, const bf16_t* __restrict__ Ag, int lda_unused, const bf16_t* __restrict__ Btg, int K, int nN128_unused, int l, int N) {
  using namespace pg8;
  PG8_LAS unsigned char* lds = (PG8_LAS unsigned char*)smem;
  const int tid = otid(), wid = __builtin_amdgcn_readfirstlane(tid >> 6), lane = tid & 63, wr = wid >> 2, wc = wid & 3, fr = lane & 15, fq = lane >> 4;
  const int nt = K / BK;
  StaticOrder S; S.init(NTP, N, (int)gridDim.x, obid());
  unsigned voffA[2], voffB[2];
#pragma unroll
  for (int i = 0; i < 2; ++i) { int R, C; stage_rc(tid * 16 + i * 8192, R, C); voffA[i] = (unsigned)(R * K + C) * 2u; voffB[i] = voffA[i]; }
  const size_t kstep = (size_t)(BK * 2);
  const size_t hstep = (size_t)HALF * K * 2;
  const size_t tstep = 2 * hstep;
  const unsigned ldsw = (unsigned)wid * 1024u;
  const int aoff = lds_byte(wr * 64 + fr, fq * 8), boff = lds_byte(wc * 32 + fr, fq * 8);
#define PG8_SA(b, h) (((b) * 2 + (h)) * HTB)
#define PG8_SB(b, h) ((4 + (b) * 2 + (h)) * HTB)
#define PG8_STAGE(bufoff, gbase, voff) do { _Pragma("unroll") for (int _i = 0; _i < 2; ++_i) \
        __builtin_amdgcn_global_load_lds((const unsigned*)((const char*)(gbase) + (voff)[_i]), (PG8_LAS unsigned*)(lds + (bufoff) + ldsw + _i * 8192), 16, 0, 0); } while (0)
#define PG8_LDA(dst, b, h) do { _Pragma("unroll") for (int m = 0; m < 4; ++m) _Pragma("unroll") for (int k = 0; k < 2; ++k) dst[m][k] = *(const PG8_LAS bf16x8*)(lds + PG8_SA(b, h) + aoff + m * 2048 + k * 1024); } while (0)
#define PG8_LDB(dst, b, h) do { _Pragma("unroll") for (int n = 0; n < 2; ++n) _Pragma("unroll") for (int k = 0; k < 2; ++k) dst[n][k] = *(const PG8_LAS bf16x8*)(lds + PG8_SB(b, h) + boff + n * 2048 + k * 1024); } while (0)
#define PG8_MMA(ai, bj, At, Bt) do { __builtin_amdgcn_s_setprio(1); _Pragma("unroll") for (int m = 0; m < 4; ++m) _Pragma("unroll") for (int n = 0; n < 2; ++n) _Pragma("unroll") for (int k = 0; k < 2; ++k) \
        acc[ai][bj][m][n] = __builtin_amdgcn_mfma_f32_16x16x32_bf16(Bt[n][k], At[m][k], acc[ai][bj][m][n], 0, 0, 0); __builtin_amdgcn_s_setprio(0); } while (0)
#define PG8_WAIT_V(n) asm volatile("s_waitcnt vmcnt(" #n ")" ::: "memory")
#define PG8_WAIT_L(n) asm volatile("s_waitcnt lgkmcnt(" #n ")" ::: "memory")
#define PG8_BAR __builtin_amdgcn_s_barrier()
#define PG8_SCHED __builtin_amdgcn_sched_barrier(0)
  Unit cur, nxt; int ui = 0;
  if (!S.next(0, cur)) return;
  f32x4 acc[2][2][4][2];
#pragma unroll
  for (int a = 0; a < 2; ++a)
#pragma unroll
    for (int b = 0; b < 2; ++b)
#pragma unroll
      for (int m = 0; m < 4; ++m)
#pragma unroll
        for (int n = 0; n < 2; ++n) acc[a][b][m][n] = (f32x4){0.f, 0.f, 0.f, 0.f};
  bf16x8 At[4][2], B0[2][2], B1[2][2];
  const char* cA = (const char*)Ag + (size_t)cur.pm * tstep; const char* cB = (const char*)Btg + (size_t)cur.pn * tstep;
  PG8_STAGE(PG8_SB(0, 0), cB, voffB); PG8_STAGE(PG8_SA(0, 0), cA, voffA); PG8_STAGE(PG8_SB(0, 1), cB + hstep, voffB); PG8_STAGE(PG8_SA(0, 1), cA + hstep, voffA);
  if (wr == 1) PG8_BAR;
  PG8_WAIT_V(4); PG8_BAR;
  PG8_STAGE(PG8_SB(1, 0), cB + kstep, voffB); PG8_STAGE(PG8_SA(1, 0), cA + kstep, voffA); PG8_STAGE(PG8_SB(1, 1), cB + hstep + kstep, voffB);
  PG8_WAIT_V(6); PG8_BAR;
  for (;;) {
    const bool has_next = S.next(ui + 1, nxt);
    const char* nA = has_next ? (const char*)Ag + (size_t)nxt.pm * tstep : cA; const char* nB = has_next ? (const char*)Btg + (size_t)nxt.pn * tstep : cB;
    for (int t = 0; t < nt; t += 2) {
      const bool last = (t == nt - 2);
      const char* a1 = cA + (size_t)(t + 1) * kstep;
      const char* a2 = last ? nA : cA + (size_t)(t + 2) * kstep; const char* b2 = last ? nB : cB + (size_t)(t + 2) * kstep;
      const char* a3 = a2 + kstep; const char* b3 = b2 + kstep;
      PG8_LDB(B0, 0, 0); PG8_SCHED; PG8_LDA(At, 0, 0); PG8_STAGE(PG8_SA(1, 1), a1 + hstep, voffA);
      PG8_WAIT_L(8); PG8_BAR; PG8_WAIT_L(0); PG8_MMA(0, 0, At, B0); PG8_BAR; PG8_SCHED;
      PG8_LDB(B1, 0, 1); PG8_STAGE(PG8_SB(0, 0), b2, voffB);
      PG8_BAR; PG8_WAIT_L(0); PG8_MMA(0, 1, At, B1); PG8_BAR;
      PG8_LDA(At, 0, 1); PG8_STAGE(PG8_SA(0, 0), a2, voffA);
      PG8_BAR; PG8_WAIT_L(0); PG8_MMA(1, 0, At, B0); PG8_BAR; PG8_SCHED;
      PG8_STAGE(PG8_SB(0, 1), b2 + hstep, voffB);
      PG8_WAIT_V(6); PG8_BAR; PG8_MMA(1, 1, At, B1); PG8_BAR;
      PG8_LDB(B0, 1, 0); PG8_SCHED; PG8_LDA(At, 1, 0); PG8_STAGE(PG8_SA(0, 1), a2 + hstep, voffA);
      PG8_WAIT_L(8); PG8_BAR; PG8_WAIT_L(0); PG8_MMA(0, 0, At, B0); PG8_BAR; PG8_SCHED;
      PG8_LDB(B1, 1, 1); PG8_STAGE(PG8_SB(1, 0), b3, voffB);
      PG8_BAR; PG8_WAIT_L(0); PG8_MMA(0, 1, At, B1); PG8_BAR;
      PG8_LDA(At, 1, 1); PG8_STAGE(PG8_SA(1, 0), a3, voffA);
      PG8_BAR; PG8_WAIT_L(0); PG8_MMA(1, 0, At, B0); PG8_BAR; PG8_SCHED;
      PG8_STAGE(PG8_SB(1, 1), b3 + hstep, voffB);
      PG8_WAIT_V(6); PG8_BAR; PG8_MMA(1, 1, At, B1); PG8_BAR;
    }
    gemm_epilogue<EPI>(P, acc, cur, wr, wc, fr, fq, l);
    if (!has_next) break;
#pragma unroll
    for (int a = 0; a < 2; ++a)
#pragma unroll
      for (int b = 0; b < 2; ++b)
#pragma unroll
        for (int m = 0; m < 4; ++m)
#pragma unroll
          for (int n = 0; n < 2; ++n) acc[a][b][m][n] = (f32x4){0.f, 0.f, 0.f, 0.f};
    cur = nxt; cA = nA; cB = nB; ++ui;
  }
  PG8_WAIT_V(0);
  if (wr == 0) PG8_BAR;
  PG8_BAR;
#undef PG8_SA
#undef PG8_SB
#undef PG8_STAGE
#undef PG8_LDA
#undef PG8_LDB
#undef PG8_MMA
#undef PG8_WAIT_V
#undef PG8_WAIT_L
#undef PG8_BAR
#undef PG8_SCHED
}

template <int EPI>
__device__ __forceinline__ void gemm_sample(const Params& P, const bf16_t* __restrict__ A, int lda, const bf16_t* __restrict__ Bt, int K, int nunits, int l) {
  const int tid = otid(), lane = tid & 63, wid = tid >> 6, fr = lane & 15, fq = lane >> 4;
  for (int u = (int)gridDim.x - 1 - obid(); u < nunits; u += gridDim.x) {
    const int brow0 = EPI == EPI_SWIGLU ? gu_row(u * 16 + fr, 0) : u * 16 + fr;
    const int brow1 = EPI == EPI_SWIGLU ? gu_row(u * 16 + fr, 1) : 0;
    const bf16_t* a0p = A + (size_t)(NTP + wid * 16 + fr) * lda + fq * 8;
    const bf16_t* b0p = Bt + (size_t)brow0 * K + fq * 8;
    const bf16_t* b1p = Bt + (size_t)brow1 * K + fq * 8;
    f32x4 c00 = (f32x4){0.f, 0.f, 0.f, 0.f}, c01 = c00;
#pragma unroll 8
    for (int ks = 0; ks < K; ks += 32) {
      const bf16x8 A0 = *(const bf16x8*)(a0p + ks), B0 = *(const bf16x8*)(b0p + ks);
      c00 = __builtin_amdgcn_mfma_f32_16x16x32_bf16(B0, A0, c00, 0, 0, 0);
      if (EPI == EPI_SWIGLU) {
        const bf16x8 B1 = *(const bf16x8*)(b1p + ks);
        c01 = __builtin_amdgcn_mfma_f32_16x16x32_bf16(B1, A0, c01, 0, 0, 0);
      }
    }
    {
      const int row = NTP + wid * 16 + fr, col = u * 16 + fq * 4;
      const f32x4 g = c00, up = c01;
      if (EPI == EPI_P) {
        if (col < IN_COLS) *(u32x2*)(WSP(bf16_t, OFF_P) + (size_t)row * PSTR + col) = pack4(g);
      } else if (EPI == EPI_RES) {
        const float* xi = xin_row(P, l, row);
        *(f32x4*)(P.out + (size_t)row * D + col) = *(const f32x4*)(xi + col) + g;
      } else {
        f32x4 r;
#pragma unroll
        for (int j = 0; j < 4; ++j) r[j] = silu(g[j]) * up[j];
        *(u32x2*)(WSP(bf16_t, OFF_P) + (size_t)row * DFF + col) = pack4(r);
      }
    }
  }
}

__device__ __forceinline__ float lbval(const Params& P, int l, int c) {
  const float* hb = P.in[I_HLB];
  const float a0 = hb[c], a1 = hb[256 + c], a2 = hb[512 + c], a3 = hb[768 + c];
  const float m = fmaxf(fmaxf(a0, a1), fmaxf(a2, a3));
  const float e0 = __expf(a0 - m), e1 = __expf(a1 - m), e2 = __expf(a2 - m), e3 = __expf(a3 - m);
  const float inv = 1.f / (e0 + e1 + e2 + e3);
  float s = 0.f;
  if (l >= 1) s += e1; if (l >= 2) s += e2; if (l >= 3) s += e3;
  return s * inv;
}

__device__ __forceinline__ void gdn_conv_emit2(const Params& P, int g, int c2, int row, float s0, float s1) {
  const int h = g % 6;
  if (g < 12) {
    const float rn = rsqrtf(half_sum(s0 * s0 + s1 * s1) + 1e-6f) * (g < 6 ? 0.125f : 1.f);
    *(unsigned*)((g < 6 ? WSP(bf16_t, OFF_GQ) : WSP(bf16_t, OFF_GK)) + (size_t)row * 384 + h * 64 + c2) = pk2(s0 * rn, s1 * rn);
  } else {
    *(unsigned*)(WSP(bf16_t, OFF_GV) + (size_t)row * 384 + h * 64 + c2) = pk2(s0, s1);
  }
}
__device__ __forceinline__ void gdn_gate_emit(const Params& P, int l, int h, int row) {
  const bf16_t* pr = WSP(bf16_t, OFF_P) + (size_t)row * PSTR;
  const float braw = bf2f(pr[1536 + h]), araw = bf2f(pr[1542 + h]);
  const float gg = -__expf(P.in[I_ALOG][l * 6 + h]) * softplus(araw + P.in[I_DTB][l * 6 + h]);
  WSP(float, OFF_GDEC)[(size_t)row * 8 + h] = __expf(gg);
  WSP(float, OFF_GBETA)[(size_t)row * 8 + h] = sigm(braw);
}
__device__ __forceinline__ void prep_gdn_prompt(const Params& P, int l, int ci) {
  const int lane = otid() & 63, wid = otid() >> 6, hl = lane >> 5, c2 = (lane & 31) * 2;
  const int r0 = ci * 32, b = r0 / TSEQ, t0 = r0 % TSEQ;
  const bf16_t* p = WSP(bf16_t, OFF_P);
  for (int gp = wid; gp < 9; gp += 8) {
    const int g = gp * 2 + hl, col = g * 64 + c2;
    const float* cw = P.in[I_CONVW] + (size_t)l * 4 * 1152 + col;
    const f32x2 w0 = *(const f32x2*)cw, w1 = *(const f32x2*)(cw + 1152), w2 = *(const f32x2*)(cw + 2304), w3 = *(const f32x2*)(cw + 3456);
    unsigned xr[35];
#pragma unroll
    for (int t = 0; t < 35; ++t) xr[t] = (t >= 3 || t0 > 0) ? *(const unsigned*)(p + (size_t)(r0 - 3 + t) * PSTR + col) : 0u;
    f32x2 x3 = {__uint_as_float(xr[0] << 16), __uint_as_float(xr[0] & 0xffff0000u)};
    f32x2 x2 = {__uint_as_float(xr[1] << 16), __uint_as_float(xr[1] & 0xffff0000u)};
    f32x2 x1 = {__uint_as_float(xr[2] << 16), __uint_as_float(xr[2] & 0xffff0000u)};
#pragma unroll
    for (int t = 0; t < 32; ++t) {
      const f32x2 x0 = {__uint_as_float(xr[t + 3] << 16), __uint_as_float(xr[t + 3] & 0xffff0000u)};
      const f32x2 y = w0 * x3 + w1 * x2 + w2 * x1 + w3 * x0;
      gdn_conv_emit2(P, g, c2, r0 + t, silu(y[0]), silu(y[1]));
      x3 = x2; x2 = x1; x1 = x0;
    }
    if (t0 + 32 == TSEQ) {
      float* cp = P.out + O_CONV_P + (size_t)(l * 8 + b) * 3 * 1152 + col;
      *(f32x2*)cp = x3; *(f32x2*)(cp + 1152) = x2; *(f32x2*)(cp + 2304) = x1;
    }
    if (g < 6) gdn_gate_emit(P, l, g, r0 + (lane & 31));
  }
}
__device__ __forceinline__ void prep_gdn_sample(const Params& P, int l, int si) {
  const int lane = otid() & 63, wid = otid() >> 6, hl = lane >> 5, c2 = (lane & 31) * 2;
  const bf16_t* p = WSP(bf16_t, OFF_P);
  for (int u = wid; u < 18; u += 8) {
    const int s = si * 2 + u / 9, g = (u % 9) * 2 + hl, col = g * 64 + c2, row = NTP + s;
    const float* cw = P.in[I_CONVW] + (size_t)l * 4 * 1152 + col;
    const f32x2 w0 = *(const f32x2*)cw, w1 = *(const f32x2*)(cw + 1152), w2 = *(const f32x2*)(cw + 2304), w3 = *(const f32x2*)(cw + 3456);
    const float* cb = P.in[I_SCONV] + (size_t)(l * 128 + s) * 3 * 1152 + col;
    const f32x2 x3 = *(const f32x2*)cb, x2 = *(const f32x2*)(cb + 1152), x1 = *(const f32x2*)(cb + 2304);
    const unsigned xw = *(const unsigned*)(p + (size_t)row * PSTR + col);
    const f32x2 x0 = {__uint_as_float(xw << 16), __uint_as_float(xw & 0xffff0000u)};
    const f32x2 y = w0 * x3 + w1 * x2 + w2 * x1 + w3 * x0;
    gdn_conv_emit2(P, g, c2, row, silu(y[0]), silu(y[1]));
    float* cp = P.out + O_CONV_S + (size_t)(l * 128 + s) * 3 * 1152 + col;
    *(f32x2*)cp = x2; *(f32x2*)(cp + 1152) = x1; *(f32x2*)(cp + 2304) = x0;
    if (g < 6 && (lane & 31) == 0) gdn_gate_emit(P, l, g, row);
  }
}
__device__ __forceinline__ void prep_hgrn(const Params& P, int l, int ti) {
  const int c2 = (otid() & 127) * 2, tg = otid() >> 7;
  const float oml0 = 1.f - lbval(P, l, c2), oml1 = 1.f - lbval(P, l, c2 + 1);
  const bf16_t* p = WSP(bf16_t, OFF_P);
  bf16_t* hq = WSP(bf16_t, OFF_HQ); bf16_t* hk = WSP(bf16_t, OFF_HK);
  for (int t0 = tg * 16; t0 < tg * 16 + 16; t0 += 8) {
    unsigned q[8], f[8];
#pragma unroll
    for (int i = 0; i < 8; ++i) { const int row = ti * 64 + t0 + i; q[i] = *(const unsigned*)(p + (size_t)row * PSTR + PC + c2); f[i] = *(const unsigned*)(p + (size_t)row * PSTR + PC + 256 + c2); }
#pragma unroll
    for (int i = 0; i < 8; ++i) {
      const int row = ti * 64 + t0 + i;
      const float q0 = __uint_as_float(q[i] << 16), q1 = __uint_as_float(q[i] & 0xffff0000u);
      const float f0 = __uint_as_float(f[i] << 16), f1 = __uint_as_float(f[i] & 0xffff0000u);
      *(unsigned*)(hq + (size_t)row * 256 + c2) = pk2(silu(q0) * 0.125f, silu(q1) * 0.125f);
      *(unsigned*)(hk + (size_t)row * 256 + c2) = pk2(oml0 * sigm(-f0), oml1 * sigm(-f1));
    }
  }
}
template <bool SAMP>
__device__ __forceinline__ f32x4 xs4t(const Params& P, int l, int row, int col0) {
  const bf16_t* p = WSP(bf16_t, OFF_P);
  const f32x4 pv = unpack4(*(const u32x2*)(p + (size_t)row * PSTR + PB + col0));
  f32x4 prev;
  if (SAMP) prev = *(const f32x4*)(P.in[I_SSHIFT] + (size_t)(l * 128 + (row - NTP)) * 1408 + col0);
  else {
    const bool first = (row & (TSEQ - 1)) == 0;
    prev = unpack4(*(const u32x2*)(p + (size_t)(row - (first ? 0 : 1)) * PSTR + PB + col0)) * (first ? 0.f : 1.f);
  }
  const f32x4 mu = *(const f32x4*)(P.in[I_MU] + l * 1408 + col0);
  return pv + (prev - pv) * mu;
}
__device__ __forceinline__ float tanh_fast(float x) { return 1.f - 2.f / (__expf(2.f * x) + 1.f); }

template <int ROWB>
__device__ __forceinline__ void stage_lora(unsigned char* smem, const bf16_t* __restrict__ src) {
  constexpr int CPR = ROWB / 16, NCH = 384 * CPR;
  __syncthreads();
  u32x4 t[NCH / 512];
#pragma unroll
  for (int i = 0; i < NCH / 512; ++i) t[i] = *(const u32x4*)((const unsigned char*)src + (size_t)(otid() + i * 512) * 16);
#pragma unroll
  for (int i = 0; i < NCH / 512; ++i) { const int idx = otid() + i * 512, r = idx / CPR, c = idx - r * CPR; *(u32x4*)(smem + r * (ROWB + 16) + c * 16) = t[i]; }
  __syncthreads();
}
template <bool SAMP>
__device__ __forceinline__ void prep_rwkv_unit(const Params& P, unsigned char* smem, int l, int mt, int hh) {
  const int lane = otid() & 63, fr = lane & 15, fq = lane >> 4;
  const int row = mt * 16 + fr, cb = hh * 192;
  const bf16_t* lw = WSP(bf16_t, OFF_LORA);
  const size_t ro = (size_t)row * 384;
  f32x4 acc[12];
  {
    f32x4 x[2][2]; bf16x8 Bf[2][12];
    stage_lora<128>(smem, lw + W2T);
#pragma unroll
    for (int ks = 0; ks < 2; ++ks) { x[ks][0] = xs4t<SAMP>(P, l, row, 1152 + ks * 32 + fq * 8); x[ks][1] = xs4t<SAMP>(P, l, row, 1152 + ks * 32 + fq * 8 + 4); }
#pragma unroll
    for (int ks = 0; ks < 2; ++ks)
#pragma unroll
      for (int nf = 0; nf < 12; ++nf) Bf[ks][nf] = *(const bf16x8*)(smem + (cb + nf * 16 + fr) * 144 + ks * 64 + fq * 16);
#pragma unroll
    for (int nf = 0; nf < 12; ++nf) acc[nf] = (f32x4){0.f, 0.f, 0.f, 0.f};
#pragma unroll
    for (int ks = 0; ks < 2; ++ks) {
#pragma unroll
      for (int j = 0; j < 4; ++j) { x[ks][0][j] = tanh_fast(x[ks][0][j]); x[ks][1][j] = tanh_fast(x[ks][1][j]); }
      const bf16x8 A = pack8(x[ks][0], x[ks][1]);
#pragma unroll
      for (int nf = 0; nf < 12; ++nf) acc[nf] = __builtin_amdgcn_mfma_f32_16x16x32_bf16(Bf[ks][nf], A, acc[nf], 0, 0, 0);
    }
    f32x4 w0v[12];
#pragma unroll
    for (int nf = 0; nf < 12; ++nf) w0v[nf] = *(const f32x4*)(P.in[I_W0] + l * 384 + cb + nf * 16 + fq * 4);
#pragma unroll
    for (int nf = 0; nf < 12; ++nf) {
      f32x4 d;
#pragma unroll
      for (int j = 0; j < 4; ++j) {
        const float xx = -(w0v[nf][j] + acc[nf][j]);
        const float sp = xx > 15.f ? xx : __logf(1.f + __expf(xx));
        d[j] = __expf(-__expf(-sp - 0.5f));
      }
      *(f32x4*)(WSP(float, OFF_RW) + ro + cb + nf * 16 + fq * 4) = d;
    }
  }
  {
    f32x4 x[2][2]; bf16x8 Bf[2][12];
    stage_lora<128>(smem, lw + A2T);
#pragma unroll
    for (int ks = 0; ks < 2; ++ks) { x[ks][0] = xs4t<SAMP>(P, l, row, 1216 + ks * 32 + fq * 8); x[ks][1] = xs4t<SAMP>(P, l, row, 1216 + ks * 32 + fq * 8 + 4); }
#pragma unroll
    for (int ks = 0; ks < 2; ++ks)
#pragma unroll
      for (int nf = 0; nf < 12; ++nf) Bf[ks][nf] = *(const bf16x8*)(smem + (cb + nf * 16 + fr) * 144 + ks * 64 + fq * 16);
#pragma unroll
    for (int nf = 0; nf < 12; ++nf) acc[nf] = (f32x4){0.f, 0.f, 0.f, 0.f};
#pragma unroll
    for (int ks = 0; ks < 2; ++ks) {
      const bf16x8 A = pack8(x[ks][0], x[ks][1]);
#pragma unroll
      for (int nf = 0; nf < 12; ++nf) acc[nf] = __builtin_amdgcn_mfma_f32_16x16x32_bf16(Bf[ks][nf], A, acc[nf], 0, 0, 0);
    }
  }
#pragma unroll
  for (int hl = 0; hl < 3; ++hl) {
    f32x4 kr[4], rr[4], kkw[4], a0[4], ka[4];
#pragma unroll
    for (int q = 0; q < 4; ++q) {
      const int c = cb + (hl * 4 + q) * 16 + fq * 4;
      kr[q] = xs4t<SAMP>(P, l, row, 384 + c); rr[q] = xs4t<SAMP>(P, l, row, c);
      kkw[q] = *(const f32x4*)(P.in[I_KK] + l * 384 + c); a0[q] = *(const f32x4*)(P.in[I_A0] + l * 384 + c); ka[q] = *(const f32x4*)(P.in[I_KA] + l * 384 + c);
    }
    float ss = 0.f;
#pragma unroll
    for (int q = 0; q < 4; ++q) { kkw[q] = kr[q] * kkw[q]; ss += dot4(kkw[q], kkw[q]); }
    ss += __shfl_xor(ss, 16); ss += __shfl_xor(ss, 32);
    const float rn = rsqrtf(ss + 1e-6f);
#pragma unroll
    for (int q = 0; q < 4; ++q) {
      const int nf = hl * 4 + q, c = cb + nf * 16 + fq * 4;
      f32x4 kn, kk, kb;
#pragma unroll
      for (int j = 0; j < 4; ++j) {
        const float a = sigm(a0[q][j] + acc[nf][j]);
        kk[j] = kkw[q][j] * rn; kb[j] = kk[j] * a; kn[j] = kr[q][j] * (1.f + (a - 1.f) * ka[q][j]);
      }
      *(u32x2*)(WSP(bf16_t, OFF_RK) + ro + c) = pack4(kn);
      *(u32x2*)(WSP(bf16_t, OFF_RKK) + ro + c) = pack4(kk);
      *(u32x2*)(WSP(bf16_t, OFF_RB) + ro + c) = pack4(kb);
      *(u32x2*)(WSP(bf16_t, OFF_RR) + ro + c) = pack4(rr[q]);
    }
  }
  {
    f32x4 x[4][2];
    stage_lora<256>(smem, lw + G2T);
#pragma unroll
    for (int ks = 0; ks < 4; ++ks) { x[ks][0] = xs4t<SAMP>(P, l, row, 1280 + ks * 32 + fq * 8); x[ks][1] = xs4t<SAMP>(P, l, row, 1280 + ks * 32 + fq * 8 + 4); }
    bf16x8 A[4];
#pragma unroll
    for (int ks = 0; ks < 4; ++ks) {
#pragma unroll
      for (int j = 0; j < 4; ++j) { x[ks][0][j] = sigm(x[ks][0][j]); x[ks][1][j] = sigm(x[ks][1][j]); }
      A[ks] = pack8(x[ks][0], x[ks][1]);
    }
#pragma unroll
    for (int hf = 0; hf < 2; ++hf) {
      bf16x8 Bf[4][6];
#pragma unroll
      for (int ks = 0; ks < 4; ++ks)
#pragma unroll
        for (int n6 = 0; n6 < 6; ++n6) Bf[ks][n6] = *(const bf16x8*)(smem + (cb + (hf * 6 + n6) * 16 + fr) * 272 + ks * 64 + fq * 16);
#pragma unroll
      for (int n6 = 0; n6 < 6; ++n6) {
        f32x4 g = (f32x4){0.f, 0.f, 0.f, 0.f};
#pragma unroll
        for (int ks = 0; ks < 4; ++ks) g = __builtin_amdgcn_mfma_f32_16x16x32_bf16(Bf[ks][n6], A[ks], g, 0, 0, 0);
        *(u32x2*)(WSP(bf16_t, OFF_RG) + ro + cb + (hf * 6 + n6) * 16 + fq * 4) = pack4(g);
      }
    }
  }
  if (l == 0) {
    f32x4 v[12];
#pragma unroll
    for (int nf = 0; nf < 12; ++nf) v[nf] = xs4t<SAMP>(P, l, row, 768 + cb + nf * 16 + fq * 4);
#pragma unroll
    for (int nf = 0; nf < 12; ++nf) {
      const int c = cb + nf * 16 + fq * 4;
      const u32x2 o = pack4(v[nf]);
      *(u32x2*)(WSP(bf16_t, OFF_RV) + ro + c) = o;
      *(u32x2*)(WSP(bf16_t, OFF_VF) + ro + c) = o;
    }
  } else {
    f32x4 lo0 = (f32x4){0.f, 0.f, 0.f, 0.f}, lo1 = lo0;
#pragma unroll
    for (int hf = 0; hf < 2; ++hf) {
      f32x4 x[6][2]; bf16x8 B0[6], B1[6];
#pragma unroll
      for (int k6 = 0; k6 < 6; ++k6) {
        const int ks = hf * 6 + k6;
        x[k6][0] = xs4t<SAMP>(P, l, row, 768 + ks * 32 + fq * 8); x[k6][1] = xs4t<SAMP>(P, l, row, 768 + ks * 32 + fq * 8 + 4);
        B0[k6] = *(const bf16x8*)(lw + V1T + fr * 384 + ks * 32 + fq * 8);
        B1[k6] = *(const bf16x8*)(lw + V1T + (16 + fr) * 384 + ks * 32 + fq * 8);
      }
#pragma unroll
      for (int k6 = 0; k6 < 6; ++k6) {
        const bf16x8 A = pack8(x[k6][0], x[k6][1]);
        lo0 = __builtin_amdgcn_mfma_f32_16x16x32_bf16(B0[k6], A, lo0, 0, 0, 0);
        lo1 = __builtin_amdgcn_mfma_f32_16x16x32_bf16(B1[k6], A, lo1, 0, 0, 0);
      }
    }
    const bf16x8 A2 = pack8(lo0, lo1);
#pragma unroll
    for (int hf = 0; hf < 2; ++hf) {
      u32x4 bw[6]; f32x4 v0[6], v[6]; u32x2 vf[6];
#pragma unroll
      for (int n6 = 0; n6 < 6; ++n6) {
        const int nf = hf * 6 + n6, c = cb + nf * 16 + fq * 4;
        const bf16_t* vr = lw + V2T + (cb + nf * 16 + fr) * 32;
        const u32x2 b0 = *(const u32x2*)(vr + fq * 4), b1 = *(const u32x2*)(vr + 16 + fq * 4);
        bw[n6][0] = b0[0]; bw[n6][1] = b0[1]; bw[n6][2] = b1[0]; bw[n6][3] = b1[1];
        v0[n6] = *(const f32x4*)(P.in[I_V0] + (l - 1) * 384 + c);
        v[n6] = xs4t<SAMP>(P, l, row, 768 + c);
        vf[n6] = *(const u32x2*)(WSP(bf16_t, OFF_VF) + ro + c);
      }
#pragma unroll
      for (int n6 = 0; n6 < 6; ++n6) {
        const int c = cb + (hf * 6 + n6) * 16 + fq * 4;
        const f32x4 mv = __builtin_amdgcn_mfma_f32_16x16x32_bf16(__builtin_bit_cast(bf16x8, bw[n6]), A2, (f32x4){0.f, 0.f, 0.f, 0.f}, 0, 0, 0);
        const f32x4 vfv = unpack4(vf[n6]);
        f32x4 o;
#pragma unroll
        for (int j = 0; j < 4; ++j) o[j] = v[n6][j] + (vfv[j] - v[n6][j]) * sigm(v0[n6][j] + mv[j]);
        *(u32x2*)(WSP(bf16_t, OFF_RV) + ro + c) = pack4(o);
      }
    }
  }
}
__device__ __forceinline__ void prep_phase(const Params& P, unsigned char* smem, int l) {
  for (int it = obid(); it < 1092; it += gridDim.x) {
    if (it < 256) { const int wid = otid() >> 6; prep_rwkv_unit<false>(P, smem, l, it * 4 + (wid >> 1), wid & 1); }
    else if (it < 258) { const int wid = otid() >> 6; prep_rwkv_unit<true>(P, smem, l, it * 4 + (wid >> 1), wid & 1); }
    else if (it < 770) prep_gdn_prompt(P, l, it - 258);
    else if (it < 834) prep_gdn_sample(P, l, it - 770);
    else prep_hgrn(P, l, it - 834);
  }
  const bf16_t* p = WSP(bf16_t, OFF_P);
  for (int idx = obid() * 512 + otid(); idx < 136 * 1408; idx += gridDim.x * 512) {
    const int q = idx / 1408, col = idx - q * 1408;
    if (q < 8) P.out[O_SHIFT_P + (size_t)(l * 8 + q) * 1408 + col] = bf2f(p[(size_t)(q * TSEQ + TSEQ - 1) * PSTR + PB + col]);
    else P.out[O_SHIFT_S + (size_t)(l * 128 + (q - 8)) * 1408 + col] = bf2f(p[(size_t)(NTP + q - 8) * PSTR + PB + col]);
  }
}

template <int KIND> struct ScanCfg { static constexpr int STRIDE = KIND == 1 ? 356 : 164; };

template <int KIND> struct ScanPre { u32x2 a, b, c, d, v; f32x4 w; float g; };

template <int KIND>
__device__ __forceinline__ void scan_load(const Params& P, ScanPre<KIND>& r, int tid, int h, int half, int rowbase, int nvalid) {
  const int s = tid >> 4, j4 = (tid & 15) * 4;
  const int s2 = (tid >> 3) & 15, j2 = (tid & 7) * 4;
  const u32x2 z2 = {0u, 0u};
  const bool ok = s < nvalid, ok2 = (tid < 128) && (s2 < nvalid);
  if (KIND == 0) {
    const size_t o = (size_t)(rowbase + s) * 384 + h * 64 + j4;
    r.a = ok ? *(const u32x2*)(WSP(bf16_t, OFF_GK) + o) : z2;
    r.b = ok ? *(const u32x2*)(WSP(bf16_t, OFF_GQ) + o) : z2;
    r.v = ok2 ? *(const u32x2*)(WSP(bf16_t, OFF_GV) + (size_t)(rowbase + s2) * 384 + h * 64 + half * 32 + j2) : z2;
    const int sg = (tid >> 1) & 15;
    r.g = (tid < 32 && sg < nvalid) ? ((tid & 1) ? WSP(float, OFF_GBETA) : WSP(float, OFF_GDEC))[(size_t)(rowbase + sg) * 8 + h] : 0.f;
  } else if (KIND == 1) {
    const size_t o = (size_t)(rowbase + s) * 384 + h * 64 + j4;
    r.a = ok ? *(const u32x2*)(WSP(bf16_t, OFF_RR) + o) : z2;
    r.w = ok ? *(const f32x4*)(WSP(float, OFF_RW) + o) : (f32x4){0.f, 0.f, 0.f, 0.f};
    r.b = ok ? *(const u32x2*)(WSP(bf16_t, OFF_RK) + o) : z2;
    r.c = ok ? *(const u32x2*)(WSP(bf16_t, OFF_RKK) + o) : z2;
    r.d = ok ? *(const u32x2*)(WSP(bf16_t, OFF_RB) + o) : z2;
    r.v = ok2 ? *(const u32x2*)(WSP(bf16_t, OFF_RV) + (size_t)(rowbase + s2) * 384 + h * 64 + half * 32 + j2) : z2;
  } else {
    const size_t o = (size_t)(rowbase + s) * 256 + h * 64 + j4;
    r.a = ok ? *(const u32x2*)(WSP(bf16_t, OFF_HQ) + o) : z2;
    r.b = ok ? *(const u32x2*)(WSP(bf16_t, OFF_HK) + o) : z2;
    r.v = ok2 ? *(const u32x2*)(WSP(bf16_t, OFF_P) + (size_t)(rowbase + s2) * PSTR + PC + 512 + h * 64 + half * 32 + j2) : z2;
  }
}
template <int KIND>
__device__ __forceinline__ void scan_store(const ScanPre<KIND>& r, int tid, float* buf) {
  constexpr int STRIDE = ScanCfg<KIND>::STRIDE;
  const int s = tid >> 4, j4 = (tid & 15) * 4;
  const int s2 = (tid >> 3) & 15, j2 = (tid & 7) * 4;
  float* bs = buf + s * STRIDE + j4;
  if (KIND == 0) {
    const f32x4 k = unpack4(r.a), q = unpack4(r.b);
    *(f32x4*)(bs) = k; *(f32x4*)(bs + 64) = q;
    const float qk = row_sum16(dot4(q, k));
    if ((tid & 15) == 0) buf[s * STRIDE + 162] = qk;
    if (tid < 128) *(f32x4*)(buf + s2 * STRIDE + 128 + j2) = unpack4(r.v);
    if (tid < 32) buf[((tid >> 1) & 15) * STRIDE + 160 + (tid & 1)] = r.g;
  } else if (KIND == 1) {
    const f32x4 rr = unpack4(r.a), k = unpack4(r.b), kk = unpack4(r.c), bb = unpack4(r.d);
    *(f32x4*)(bs) = r.w * rr; *(f32x4*)(bs + 64) = r.w; *(f32x4*)(bs + 128) = k;
    *(f32x4*)(bs + 192) = kk; *(f32x4*)(bs + 256) = bb;
    const float br = row_sum16(dot4(bb, rr)), kr = row_sum16(dot4(k, rr));
    if ((tid & 15) == 0) { buf[s * STRIDE + 352] = br; buf[s * STRIDE + 353] = kr; }
    if (tid < 128) *(f32x4*)(buf + s2 * STRIDE + 320 + j2) = unpack4(r.v);
  } else {
    const f32x4 q = unpack4(r.a), k = unpack4(r.b);
    *(f32x4*)(bs) = q * (1.f - k); *(f32x4*)(bs + 64) = k;
    const float qk = row_sum16(dot4(q, k));
    if ((tid & 15) == 0) buf[s * STRIDE + 160] = qk;
    if (tid < 128) *(f32x4*)(buf + s2 * STRIDE + 128 + j2) = unpack4(r.v);
  }
}

template <int KIND> struct StepOps { f32x2 a[4], b[4], c[4], d[4], e[4]; float v, s0, s1, s2; };
template <int KIND>
__device__ __forceinline__ void step_load(StepOps<KIND>& o, const float* bs, int e0, int cl) {
#define LD8(dst, off) { const f32x4 _x = *(const f32x4*)(bs + (off) + e0), _y = *(const f32x4*)(bs + (off) + e0 + 4); \
    dst[0] = (f32x2){_x[0], _x[1]}; dst[1] = (f32x2){_x[2], _x[3]}; dst[2] = (f32x2){_y[0], _y[1]}; dst[3] = (f32x2){_y[2], _y[3]}; }
  if (KIND == 0) {
    LD8(o.a, 0) LD8(o.b, 64)
    o.v = bs[128 + cl];
    const f32x4 sc = *(const f32x4*)(bs + 160); o.s0 = sc[0]; o.s1 = sc[1]; o.s2 = sc[2];
  } else if (KIND == 1) {
    LD8(o.a, 0) LD8(o.b, 64) LD8(o.c, 128) LD8(o.d, 192) LD8(o.e, 256)
    o.v = bs[320 + cl];
    const f32x2 sc = *(const f32x2*)(bs + 352); o.s0 = sc[0]; o.s1 = sc[1];
  } else {
    LD8(o.a, 0) LD8(o.b, 64)
    o.v = bs[128 + cl]; o.s0 = bs[160];
  }
#undef LD8
}
template <int KIND>
__device__ __forceinline__ float step_compute(const StepOps<KIND>& o, f32x2 (&S)[4]) {
  if (KIND == 0) {
    f32x2 ks2 = o.a[0] * S[0], qs2 = o.b[0] * S[0];
#pragma unroll
    for (int i = 1; i < 4; ++i) { ks2 += o.a[i] * S[i]; qs2 += o.b[i] * S[i]; }
    float ks = ks2[0] + ks2[1], qs = qs2[0] + qs2[1];
    ks += dppf<0xB1>(ks); qs += dppf<0xB1>(qs); ks += dppf<0x4E>(ks); qs += dppf<0x4E>(qs); ks += dppf<0x141>(ks); qs += dppf<0x141>(qs);
    const float dec = o.s0, vn = o.s1 * (o.v - dec * ks);
#pragma unroll
    for (int i = 0; i < 4; ++i) S[i] = S[i] * dec + o.a[i] * vn;
    return dec * qs + vn * o.s2;
  } else if (KIND == 1) {
    f32x2 sa2 = o.d[0] * S[0], p2 = o.a[0] * S[0];
#pragma unroll
    for (int i = 1; i < 4; ++i) { sa2 += o.d[i] * S[i]; p2 += o.a[i] * S[i]; }
    float sa = sa2[0] + sa2[1], p1 = p2[0] + p2[1];
    sa += dppf<0xB1>(sa); p1 += dppf<0xB1>(p1); sa += dppf<0x4E>(sa); p1 += dppf<0x4E>(p1); sa += dppf<0x141>(sa); p1 += dppf<0x141>(p1);
    sa = -sa;
#pragma unroll
    for (int i = 0; i < 4; ++i) S[i] = S[i] * o.b[i] + (o.e[i] * sa + o.c[i] * o.v);
    return p1 + sa * o.s0 + o.v * o.s1;
  } else {
    f32x2 p2 = o.a[0] * S[0];
#pragma unroll
    for (int i = 1; i < 4; ++i) p2 += o.a[i] * S[i];
    float p1 = p2[0] + p2[1];
    p1 += dppf<0xB1>(p1); p1 += dppf<0x4E>(p1); p1 += dppf<0x141>(p1);
#pragma unroll
    for (int i = 0; i < 4; ++i) S[i] = S[i] + o.b[i] * (o.v - S[i]);
    return p1 + o.v * o.s0;
  }
}

template <int KIND>
__device__ __forceinline__ void scan_task(const Params& P, unsigned char* smem, int l, int seq, int h, int half, bool active) {
  constexpr int STRIDE = ScanCfg<KIND>::STRIDE, NEL = 16 * STRIDE;
  constexpr int NH = KIND == 2 ? 4 : 6;
  float* buf = (float*)smem;
  float* obuf = buf + 2 * NEL;
  const int tid = otid() & 255, lane = tid & 63, wid = tid >> 6;
  const int col_l = lane >> 3, sub = lane & 7, cl = wid * 8 + col_l, col = half * 32 + cl, e0 = sub * 8;
  const bool sample = seq >= 8;
  const int R0 = sample ? NTP + (seq - 8) : seq * TSEQ, T = sample ? 1 : TSEQ;
  const int ocol = (KIND == 0 ? 0 : (KIND == 1 ? 384 : 768)) + h * 64 + half * 32;
  const size_t O_P = KIND == 0 ? O_GDN_P : (KIND == 1 ? O_RWKV_P : O_HGRN_P);
  const size_t O_S = KIND == 0 ? O_GDN_S : (KIND == 1 ? O_RWKV_S : O_HGRN_S);
  const int I_ST = KIND == 0 ? I_SGDN : (KIND == 1 ? I_SRWKV : I_SHGRN);
  f32x2 S[4];
#pragma unroll
  for (int i = 0; i < 4; ++i) S[i] = (f32x2){0.f, 0.f};
  if (sample && active) {
    const float* st = P.in[I_ST] + ((size_t)(l * 128 + (seq - 8)) * NH + h) * 4096;
#pragma unroll
    for (int i = 0; i < 8; ++i) S[i >> 1][i & 1] = KIND == 1 ? st[col * 64 + e0 + i] : st[(e0 + i) * 64 + col];
  }
#pragma unroll
  for (int i = 0; i < 4; ++i) asm volatile("" : "+v"(S[i]));
  ScanPre<KIND> pre;
  __syncthreads();
  if (active) { scan_load<KIND>(P, pre, tid, h, half, R0, T); scan_store<KIND>(pre, tid, buf); }
  __syncthreads();
  const int nchunks = (T + 15) >> 4;
  bf16_t* oraw = WSP(bf16_t, OFF_P);
  for (int c = 0; c < nchunks; ++c) {
    if (active) {
      const int t0 = c * 16, n = (T - t0) < 16 ? (T - t0) : 16;
      const bool has_next = c + 1 < nchunks;
      if (c > 0) {
        const float* pob = obuf + ((c - 1) & 1) * 512;
        {
          const int s = tid >> 4, cc = (tid & 15) * 2;
          const f32x2 ov = *(const f32x2*)(pob + s * 32 + cc);
          *(unsigned*)(oraw + (size_t)(R0 + t0 - 16 + s) * PSTR + ocol + cc) = pk2(ov[0], ov[1]);
        }
      }
      if (has_next) scan_load<KIND>(P, pre, tid, h, half, R0 + t0 + 16, T - t0 - 16);
      const float* b = buf + (c & 1) * NEL;
      float* ob = obuf + (c & 1) * 512;
      if (n == 16) {
        StepOps<KIND> A, B;
        step_load<KIND>(A, b, e0, cl);
#pragma unroll
        for (int s = 0; s < 16; s += 2) {
          step_load<KIND>(B, b + (s + 1) * STRIDE, e0, cl);
          const float o0 = step_compute<KIND>(A, S);
          ob[s * 32 + cl] = o0;
          step_load<KIND>(A, b + (s + 2 < 16 ? s + 2 : 15) * STRIDE, e0, cl);
          const float o1 = step_compute<KIND>(B, S);
          ob[(s + 1) * 32 + cl] = o1;
        }
      } else {
        for (int s = 0; s < n; ++s) {
          StepOps<KIND> A;
          step_load<KIND>(A, b + s * STRIDE, e0, cl);
          const float o0 = step_compute<KIND>(A, S);
          ob[s * 32 + cl] = o0;
        }
      }
      if (has_next) scan_store<KIND>(pre, tid, buf + ((c + 1) & 1) * NEL);
    }
    __syncthreads();
  }
  if (active) {
    {
      const int c = nchunks - 1, t0 = c * 16, n = T - t0;
      const float* pob = obuf + (c & 1) * 512;
      {
        const int s = tid >> 4, cc = (tid & 15) * 2;
        const f32x2 ov = *(const f32x2*)(pob + s * 32 + cc);
        if (s < n) *(unsigned*)(oraw + (size_t)(R0 + t0 + s) * PSTR + ocol + cc) = pk2(ov[0], ov[1]);
      }
    }
    float* so = P.out + (sample ? O_S + ((size_t)(l * 128 + (seq - 8)) * NH + h) * 4096 : O_P + ((size_t)(l * 8 + seq) * NH + h) * 4096);
#pragma unroll
    for (int i = 0; i < 8; ++i) { if (KIND == 1) so[col * 64 + e0 + i] = S[i >> 1][i & 1]; else so[(e0 + i) * 64 + col] = S[i >> 1][i & 1]; }
  }
}

__device__ __forceinline__ void scan_phase(const Params& P, unsigned char* smem, int l, volatile unsigned* blk  ) {
  unsigned* q = WSP(unsigned, OFF_QUEUE) + l * 128;
  const int grp = otid() >> 8;
  for (int pass = 0; pass < 2; ++pass) {
    unsigned* qq = pass == 1 ? q + 64 : q;
    const unsigned ntask = pass == 1 ? 2048u : 256u;
    for (;;) {
      __syncthreads();
      if (threadIdx.x == 0) blk[3] = __hip_atomic_fetch_add(qq, 1u, __ATOMIC_RELAXED, __HIP_MEMORY_SCOPE_AGENT);
      __syncthreads();
      const int t = (int)blk[3];
      if (t >= (int)ntask) break;
      int kind, seq, h, half; bool act; unsigned char* sm;
      if (pass == 0) {
        act = grp == 0; sm = smem; half = t & 1;
        if (t < 96) { kind = 1; const int bh = t >> 1; seq = bh / 6; h = bh % 6; }
        else if (t < 192) { kind = 0; const int bh = (t - 96) >> 1; seq = bh / 6; h = bh % 6; }
        else { kind = 2; const int bh = (t - 192) >> 1; seq = bh / 4; h = bh % 4; }
      } else {
        const int hh = t & 15;
        act = true; sm = smem + grp * 51200; half = grp; seq = 8 + (t >> 4);
        if (hh < 6) { kind = 0; h = hh; } else if (hh < 12) { kind = 1; h = hh - 6; } else { kind = 2; h = hh - 12; }
      }
      if (kind == 0) scan_task<0>(P, sm, l, seq, h, half, act);
      else if (kind == 1) scan_task<1>(P, sm, l, seq, h, half, act);
      else scan_task<2>(P, sm, l, seq, h, half, act);
    }
  }
  if (l + 1 < NLAYER) {
    for (;;) {
      __syncthreads();
      if (threadIdx.x == 0) blk[3] = __hip_atomic_fetch_add(q + 96, 1u, __ATOMIC_RELAXED, __HIP_MEMORY_SCOPE_AGENT);
      __syncthreads();
      const unsigned t = blk[3];
      if (t >= (unsigned)WCONV_JOBS) break;
      wconv_job(P, smem, l + 1, (int)t);
    }
  }
}

__device__ __forceinline__ void post_phase(const Params& P, int l) {
  const int lane = otid() & 63, wid = otid() >> 6, hl = lane >> 5, c2 = (lane & 31) * 2;
  const bf16_t* p = WSP(bf16_t, OFF_P);
  bf16_t* act = WSP(bf16_t, OFF_ACT);
  const int gw = obid() * 8 + wid, nw = gridDim.x * 8;
  const f32x2 gnw = *(const f32x2*)(P.in[I_GNW] + l * 64 + c2), hnw = *(const f32x2*)(P.in[I_HNW] + l * 64 + c2);
  for (int u0 = gw * 8; u0 < NTOK * 10; u0 += nw * 8) {
    unsigned o[4], z[4]; int oc[4]; size_t rb[4];
#pragma unroll
    for (int k = 0; k < 4; ++k) {
      const int u = u0 + 2 * k + hl, row = u / 10, q = u - row * 10;
      oc[k] = q < 6 ? q * 64 : 768 + (q - 6) * 64;
      const int zc = q < 6 ? 1152 + q * 64 : PC + 768 + (q - 6) * 64;
      rb[k] = (size_t)row;
      o[k] = *(const unsigned*)(p + (size_t)row * PSTR + oc[k] + c2);
      z[k] = *(const unsigned*)(p + (size_t)row * PSTR + zc + c2);
    }
#pragma unroll
    for (int k = 0; k < 4; ++k) {
      const float o0 = __uint_as_float(o[k] << 16), o1 = __uint_as_float(o[k] & 0xffff0000u);
      const float z0 = __uint_as_float(z[k] << 16), z1 = __uint_as_float(z[k] & 0xffff0000u);
      const float rn = rsqrtf(half_sum(o0 * o0 + o1 * o1) * (1.f / 64.f) + 1e-6f);
      const f32x2 w = oc[k] < 384 ? gnw : hnw;
      *(unsigned*)(act + rb[k] * 1024 + oc[k] + c2) = pk2(o0 * rn * w[0] * silu(z0), o1 * rn * w[1] * silu(z1));
    }
  }
  for (int u0 = gw * 4; u0 < NTOK * 6; u0 += nw * 4) {
    unsigned o[2], r[2], kx[2], v[2], g[2]; int hh[2]; size_t rb[2];
#pragma unroll
    for (int k = 0; k < 2; ++k) {
      const int u = u0 + 2 * k + hl, row = u / 6, h = u - row * 6;
      const size_t idx = (size_t)row * 384 + h * 64 + c2;
      hh[k] = h; rb[k] = (size_t)row;
      o[k] = *(const unsigned*)(p + (size_t)row * PSTR + 384 + h * 64 + c2);
      r[k] = *(const unsigned*)(WSP(bf16_t, OFF_RR) + idx); kx[k] = *(const unsigned*)(WSP(bf16_t, OFF_RK) + idx);
      v[k] = *(const unsigned*)(WSP(bf16_t, OFF_RV) + idx); g[k] = *(const unsigned*)(WSP(bf16_t, OFF_RG) + idx);
    }
#pragma unroll
    for (int k = 0; k < 2; ++k) {
      const int hc = l * 384 + hh[k] * 64 + c2;
      const f32x2 lw = *(const f32x2*)(P.in[I_LNW] + hc), lb = *(const f32x2*)(P.in[I_LNB] + hc), rkw = *(const f32x2*)(P.in[I_RK] + hc);
      const float o0 = __uint_as_float(o[k] << 16), o1 = __uint_as_float(o[k] & 0xffff0000u);
      const float r0 = __uint_as_float(r[k] << 16), r1 = __uint_as_float(r[k] & 0xffff0000u);
      const float k0 = __uint_as_float(kx[k] << 16), k1 = __uint_as_float(kx[k] & 0xffff0000u);
      const float v0 = __uint_as_float(v[k] << 16), v1 = __uint_as_float(v[k] & 0xffff0000u);
      const float g0 = __uint_as_float(g[k] << 16), g1 = __uint_as_float(g[k] & 0xffff0000u);
      const float mu = half_sum(o0 + o1) * (1.f / 64.f);
      const float y0 = o0 - mu, y1 = o1 - mu;
      const float rn = rsqrtf(half_sum(y0 * y0 + y1 * y1) * (1.f / 64.f) + 64e-5f);
      const float rk = half_sum(r0 * k0 * rkw[0] + r1 * k1 * rkw[1]);
      *(unsigned*)(act + rb[k] * 1024 + 384 + hh[k] * 64 + c2) = pk2((y0 * rn * lw[0] + lb[0] + rk * v0) * g0, (y1 * rn * lw[1] + lb[1] + rk * v1) * g1);
    }
  }
}

#define XB_TMO      128
#define XB_XCNT(j)  (256  + 64 * (j))
#define XB_XSUB(j)  (1280 + 64 * (j))
#define XB_XGEN(j)  (2304 + 64 * (j))
#define XB_TOP      3328
#define XB_TOPGEN   3392
#define XCD_BAR_WORDS 3456
#define XB_SPIN_CAP (1u << 20)
#define LAS __attribute__((address_space(3)))
__device__ __forceinline__ unsigned xb_ld(unsigned* p)              { return __hip_atomic_load(p, __ATOMIC_RELAXED, __HIP_MEMORY_SCOPE_AGENT); }
__device__ __forceinline__ unsigned xb_add(unsigned* p, unsigned v) { return __hip_atomic_fetch_add(p, v, __ATOMIC_RELAXED, __HIP_MEMORY_SCOPE_AGENT); }
__device__ __forceinline__ unsigned xb_xcc_id() { return (unsigned)__builtin_amdgcn_s_getreg((3 << 11) | 20) & 0xFu; }
#define XB_SPIN(cond, bar) do { unsigned _sp = 0; while (cond) { __builtin_amdgcn_s_sleep(1); \
    if ((++_sp & 255u) == 0u) { if (xb_ld(&(bar)[XB_TMO])) break; if (_sp > XB_SPIN_CAP) { atomicAdd(&(bar)[XB_TMO], 1u); break; } } } } while (0)
struct XcdBarrier { unsigned* bar; unsigned x; volatile LAS unsigned* st; };
__device__ __forceinline__ XcdBarrier xcd_barrier_post(unsigned* bar, volatile LAS unsigned* st) {
  XcdBarrier b; b.bar = bar; b.x = xb_xcc_id(); b.st = st;
  if (threadIdx.x == 0) (void)xb_add(&bar[XB_XCNT(b.x)], 1u);
  return b;
}
__device__ __forceinline__ void xcd_barrier_complete(unsigned* bar, unsigned x, unsigned& nloc, unsigned& nx) {
  const unsigned G = gridDim.x * gridDim.y * gridDim.z;
  unsigned sum, cnt, mine, sp = 0u;
  for (;;) {
    sum = 0u; cnt = 0u; mine = 0u;
#pragma unroll
    for (unsigned j = 0; j < 16; ++j) { const unsigned c = xb_ld(&bar[XB_XCNT(j)]); sum += c; cnt += (c > 0u) ? 1u : 0u; mine = (j == x) ? c : mine; }
    if (sum == G) break;
    __builtin_amdgcn_s_sleep(1);
    if ((++sp & 255u) == 0u) { if (xb_ld(&bar[XB_TMO])) break; if (sp > XB_SPIN_CAP) { atomicAdd(&bar[XB_TMO], 1u); break; } }
  }
  nloc = mine > 0u ? mine : 1u; nx = cnt > 0u ? cnt : 1u;
}
__device__ __forceinline__ void xcd_barrier(const XcdBarrier& b) {
  asm volatile("s_waitcnt vmcnt(0)" ::: "memory");
  __syncthreads();
  if (threadIdx.x == 0) {
    unsigned* bar = b.bar;
    __builtin_amdgcn_s_waitcnt(0);
    unsigned nloc = b.st[0], nx = b.st[1];
    if (nloc == 0u) { xcd_barrier_complete(bar, b.x, nloc, nx); b.st[0] = nloc; b.st[1] = nx; }
    const unsigned old = xb_add(&bar[XB_XSUB(b.x)], 1u);
    const unsigned gen = old / nloc;
    if (old + 1u == (gen + 1u) * nloc) {
      __builtin_amdgcn_fence(__ATOMIC_RELEASE, "agent");
      asm volatile("s_waitcnt vmcnt(0)" ::: "memory");
      const unsigned og = xb_add(&bar[XB_TOP], 1u);
      const unsigned tg = og / nx;
      if (og + 1u == (tg + 1u) * nx) xb_add(&bar[XB_TOPGEN], 1u);
      else XB_SPIN(xb_ld(&bar[XB_TOPGEN]) == tg, bar);
      __builtin_amdgcn_fence(__ATOMIC_ACQUIRE, "agent");
      xb_add(&bar[XB_XGEN(b.x)], 1u);
      asm volatile("s_waitcnt vmcnt(0)" ::: "memory");
    } else {
      XB_SPIN(xb_ld(&bar[XB_XGEN(b.x)]) == gen, bar);
      __builtin_amdgcn_fence(__ATOMIC_ACQUIRE, "agent");
      asm volatile("s_waitcnt vmcnt(0)" ::: "memory");
    }
  }
  __syncthreads();
}

__global__ void __launch_bounds__(512, 2) hybrid_fwd(Params P) {
  cg::grid_group grid = cg::this_grid();
  __shared__ __attribute__((aligned(16))) unsigned char smem[131072 + 64];
  uint4& xb_words = *(uint4*)(smem + 131072);
  if (threadIdx.x == 0) xb_words = make_uint4(0u, 0u, 0u, 0u);
  __syncthreads();
  const XcdBarrier xb = xcd_barrier_post(WSP(unsigned, OFF_BAR), (volatile LAS unsigned*)&xb_words);
  if (threadIdx.x == 0) {
    const unsigned hw = (unsigned)__builtin_amdgcn_s_getreg((7 << 11) | (8 << 6) | 4) & 0xffu;
    const unsigned key = (xb.x << 8) | hw;
    ((volatile unsigned*)&xb_words)[2] = __hip_atomic_fetch_add(WSP(unsigned, OFF_CUTAB) + key, 1u, __ATOMIC_RELAXED, __HIP_MEMORY_SCOPE_AGENT);
  }
  __syncthreads();
#pragma unroll 1
  for (int step = 0; step < NLAYER * 9; ++step) {
    const int l = step / 9, ph = step - l * 9;
    switch (ph) {
      case 0: if (l == 0) wconv_phase(P, smem, 0); norm_phase(P, l, P.in[I_NORM_MIX] + l * D); break;
      case 1: gemm_phase<EPI_P>(P, smem, WSP(bf16_t, OFF_ACT), 1024, WSP(bf16_t, OFF_WTIN), 1024, 32, l, 4096);
              gemm_sample<EPI_P>(P, WSP(bf16_t, OFF_ACT), 1024, WSP(bf16_t, OFF_WTIN), 1024, 249, l); break;
      case 2: prep_phase(P, smem, l); break;
      case 3: scan_phase(P, smem, l, (volatile unsigned*)&xb_words); break;
      case 4: post_phase(P, l); break;
      case 5: gemm_phase<EPI_RES>(P, smem, WSP(bf16_t, OFF_ACT), 1024, WSP(bf16_t, wt_out_off(l)), 1024, 8, l, 1024);
              gemm_sample<EPI_RES>(P, WSP(bf16_t, OFF_ACT), 1024, WSP(bf16_t, wt_out_off(l)), 1024, 64, l); break;
      case 6: norm_phase(P, 1, P.in[I_NORM_FFN] + l * D); break;
      case 7: gemm_phase<EPI_SWIGLU>(P, smem, WSP(bf16_t, OFF_ACT), 1024, WSP(bf16_t, wt_gu_off(l)), 1024, 44, 1, 5632);
              gemm_sample<EPI_SWIGLU>(P, WSP(bf16_t, OFF_ACT), 1024, WSP(bf16_t, wt_gu_off(l)), 1024, 176, 1); break;
      default: gemm_phase<EPI_RES>(P, smem, WSP(bf16_t, OFF_P), DFF, WSP(bf16_t, wt_dn_off(l)), DFF, 8, 1, 1024);
               gemm_sample<EPI_RES>(P, WSP(bf16_t, OFF_P), DFF, WSP(bf16_t, wt_dn_off(l)), DFF, 64, 1); break;
    }
    if (step == 0) grid.sync();
    else xcd_barrier(xb);
  }
  final_norm_phase(P);
}

extern "C" void kernel_launch(void* const* d_in, const int* in_sizes, int n_in,
                              void* d_out, int out_size, void* d_ws, size_t ws_size,
                              hipStream_t stream) {
  static int grid_blocks = 0;
  if (!grid_blocks) {
    int dev = 0, cus = 0, per_cu = 0;
    (void)hipGetDevice(&dev);
    (void)hipDeviceGetAttribute(&cus, hipDeviceAttributeMultiprocessorCount, dev);
    (void)hipOccupancyMaxActiveBlocksPerMultiprocessor(&per_cu, hybrid_fwd, 512, 0);
    if (per_cu > 1) per_cu = 1;
    if (per_cu < 1) per_cu = 1;
    grid_blocks = cus * per_cu;
  }
  if (ws_size < WS_NEED) { fprintf(stderr, "workspace too small: %zu < %zu\n", ws_size, (size_t)WS_NEED); return; }
  Params p{};
  for (int i = 0; i < N_IN; ++i) p.in[i] = (const float*)d_in[i];
  p.out = (float*)d_out;
  p.ws = (unsigned char*)d_ws;
  (void)hipMemsetAsync((unsigned char*)d_ws + OFF_BAR, 0, BAR_BYTES, stream);
  void* args[] = {&p};
  hipError_t e = hipLaunchCooperativeKernel((void*)hybrid_fwd, dim3(grid_blocks), dim3(512), args, 0, stream);
  if (e != hipSuccess) fprintf(stderr, "cooperative launch failed: %s (grid %d)\n", hipGetErrorString(e), grid_blocks);
}
```

```cpp
#include <hip/hip_runtime.h>
#include <hip/hip_cooperative_groups.h>
#include <cstdio>
namespace cg = cooperative_groups;

typedef unsigned short bf16_t;
typedef short bf16x8 __attribute__((ext_vector_type(8)));
typedef float f32x4 __attribute__((ext_vector_type(4)));
typedef unsigned u32x4 __attribute__((ext_vector_type(4)));
typedef unsigned u32x2 __attribute__((ext_vector_type(2)));

constexpr int D = 1024, NTP = 16384, NTS = 128, NTOK = 16512, TSEQ = 2048, NLAYER = 4;
constexpr int IN_COLS = 3980, PSTR = 3984, DFF = 2816;
constexpr int PB = 1548, PC = 2956;

enum { I_XP = 0, I_XS, I_SGDN, I_SCONV, I_SRWKV, I_SSHIFT, I_SHGRN, I_NORM_MIX, I_WIN, I_WOUT, I_CONVW, I_ALOG, I_DTB, I_GNW,
       I_MU, I_W0, I_W2, I_A0, I_A2, I_G2, I_V0, I_V1, I_V2, I_KK, I_KA, I_RK, I_LNW, I_LNB, I_HLB, I_HNW, I_NORM_FFN,
       I_WG, I_WU, I_WD, I_NORM_FINAL, N_IN };

constexpr size_t O_YP = 0, O_YS = 16777216, O_GDN_P = 16908288, O_GDN_S = 17694720, O_CONV_P = 30277632, O_CONV_S = 30388224,
                 O_RWKV_P = 32157696, O_RWKV_S = 32944128, O_SHIFT_P = 45527040, O_SHIFT_S = 45572096, O_HGRN_P = 46292992,
                 O_HGRN_S = 46817280;

constexpr size_t SZ_WTIN = (size_t)4096 * 1024 * 2, SZ_WTOUT = (size_t)1024 * 1024 * 2, SZ_WTGU = (size_t)5632 * 1024 * 2,
                 SZ_WTDN = (size_t)1024 * 2816 * 2, SZ_P = (size_t)NTOK * PSTR * 2, SZ_ACT = (size_t)NTOK * 1024 * 2,
                 SZ_T384 = (size_t)NTOK * 384 * 2, SZ_T8F = (size_t)NTOK * 8 * 4, SZ_T256 = (size_t)NTOK * 256 * 2,
                 SZ_T384F = (size_t)NTOK * 384 * 4;
constexpr size_t OFF_WTIN = 0, OFF_WTOUT = OFF_WTIN + SZ_WTIN, OFF_WTGU = OFF_WTOUT + SZ_WTOUT, OFF_WTDN = OFF_WTGU + SZ_WTGU,
                 OFF_P = OFF_WTDN + SZ_WTDN, OFF_ACT = OFF_P + SZ_P, OFF_GQ = OFF_ACT + SZ_ACT, OFF_GK = OFF_GQ + SZ_T384,
                 OFF_GV = OFF_GK + SZ_T384, OFF_GDEC = OFF_GV + SZ_T384, OFF_GBETA = OFF_GDEC + SZ_T8F, OFF_HQ = OFF_GBETA + SZ_T8F,
                 OFF_HK = OFF_HQ + SZ_T256, OFF_RR = OFF_HK + SZ_T256, OFF_RK = OFF_RR + SZ_T384, OFF_RV = OFF_RK + SZ_T384,
                 OFF_RKK = OFF_RV + SZ_T384, OFF_RB = OFF_RKK + SZ_T384, OFF_RG = OFF_RB + SZ_T384, OFF_RW = OFF_RG + SZ_T384,
                 OFF_VF = OFF_RW + SZ_T384F, OFF_LORA = OFF_VF + SZ_T384, OFF_WTOUT2 = OFF_LORA + 245760, OFF_WTGU2 = OFF_WTOUT2 + SZ_WTOUT, OFF_WTDN2 = OFF_WTGU2 + SZ_WTGU, OFF_BAR = OFF_WTDN2 + SZ_WTDN, OFF_CUTAB = OFF_BAR + 16384, OFF_QUEUE = OFF_CUTAB + 16384, BAR_BYTES = 16384 + 16384 + 4096, WS_NEED = OFF_BAR + BAR_BYTES;
constexpr int W2T = 0, A2T = 24576, G2T = 49152, V1T = 98304, V2T = 110592;

struct Params {
  const float* in[N_IN];
  float* out;
  unsigned char* ws;
};

#define WSP(T, off) ((T*)(P.ws + (off)))

__device__ __forceinline__ int otid() { int t = __builtin_amdgcn_workitem_id_x(); asm volatile("" : "+v"(t)); return t; }
__device__ __forceinline__ int obid() { int b = __builtin_amdgcn_workgroup_id_x(); asm volatile("" : "+s"(b)); return b; }
template <class T> __device__ __forceinline__ const T* opq(const T* p) { asm volatile("" : "+s"(p)); return p; }
__device__ __forceinline__ float bf2f(bf16_t h) { return __uint_as_float(((unsigned)h) << 16); }
typedef float f32x2_t __attribute__((ext_vector_type(2)));
typedef __bf16 bf16x2_t __attribute__((ext_vector_type(2)));
__device__ __forceinline__ unsigned pk2(float lo, float hi) {
  const f32x2_t v = {lo, hi};
  return __builtin_bit_cast(unsigned, __builtin_convertvector(v, bf16x2_t));
}
__device__ __forceinline__ bf16_t f2bf(float f) { return (bf16_t)(pk2(f, 0.f) & 0xffffu); }
__device__ __forceinline__ float sigm(float x) { return 1.f / (1.f + __expf(-x)); }
__device__ __forceinline__ float silu(float x) { return x / (1.f + __expf(-x)); }
__device__ __forceinline__ float softplus(float x) { return x > 20.f ? x : log1pf(__expf(x)); }
template <int CTRL> __device__ __forceinline__ float dppf(float x) {
  return __builtin_bit_cast(float, __builtin_amdgcn_mov_dpp(__builtin_bit_cast(int, x), CTRL, 0xf, 0xf, true));
}
__device__ __forceinline__ float wave_sum(float v) {
  v += dppf<0xB1>(v); v += dppf<0x4E>(v); v += dppf<0x141>(v); v += dppf<0x140>(v);
  const int iv = __builtin_bit_cast(int, v);
  const float s0 = __builtin_bit_cast(float, __builtin_amdgcn_readlane(iv, 0)), s1 = __builtin_bit_cast(float, __builtin_amdgcn_readlane(iv, 16));
  const float s2 = __builtin_bit_cast(float, __builtin_amdgcn_readlane(iv, 32)), s3 = __builtin_bit_cast(float, __builtin_amdgcn_readlane(iv, 48));
  return (s0 + s1) + (s2 + s3);
}
typedef float f32x2 __attribute__((ext_vector_type(2)));
__device__ __forceinline__ float row_sum16(float v) { v += dppf<0xB1>(v); v += dppf<0x4E>(v); v += dppf<0x141>(v); v += dppf<0x140>(v); return v; }
__device__ __forceinline__ float half_sum(float v) { v = row_sum16(v); return v + __shfl_xor(v, 16); }
__device__ __forceinline__ float reduce8(float x) { x += dppf<0xB1>(x); x += dppf<0x4E>(x); x += dppf<0x141>(x); return x; }

__device__ __forceinline__ f32x4 unpack4(u32x2 w) {
  f32x4 f; f[0] = __uint_as_float(w[0] << 16); f[1] = __uint_as_float(w[0] & 0xffff0000u);
  f[2] = __uint_as_float(w[1] << 16); f[3] = __uint_as_float(w[1] & 0xffff0000u); return f;
}
__device__ __forceinline__ bf16x8 pack8(f32x4 a, f32x4 b) {
  u32x4 u; u[0] = pk2(a[0], a[1]); u[1] = pk2(a[2], a[3]); u[2] = pk2(b[0], b[1]); u[3] = pk2(b[2], b[3]);
  return __builtin_bit_cast(bf16x8, u);
}
__device__ __forceinline__ u32x2 pack4(f32x4 a) { u32x2 u; u[0] = pk2(a[0], a[1]); u[1] = pk2(a[2], a[3]); return u; }
__device__ __forceinline__ float dot4(f32x4 a, f32x4 b) { return (a[0] * b[0] + a[1] * b[1]) + (a[2] * b[2] + a[3] * b[3]); }
__device__ __forceinline__ const float* xin_row(const Params& P, int l, int row) {
  const float* po = opq((const float*)P.out); const float* pp = opq(P.in[I_XP]); const float* ps = opq(P.in[I_XS]);
  if (l > 0) return po + (size_t)row * D;
  return row < NTP ? pp + (size_t)row * D : ps + (size_t)(row - NTP) * D;
}

__device__ __forceinline__ int gu_row(int c, int up) { return (c >> 7) * 256 + up * 128 + (c & 127); }
__device__ __forceinline__ void xpose_tile(unsigned char* smem, const float* __restrict__ W, int N, int kt, int ntl, bf16_t* __restrict__ dst, int dstK, int mode) {
  float (*tile)[65] = (float (*)[65])smem;
  const int tid = otid();
  __syncthreads();
#pragma unroll 4
  for (int i = 0; i < 8; ++i) {
    const int k = i * 8 + (tid >> 6), n = tid & 63, gn = ntl * 64 + n;
    tile[k][n] = gn < N ? W[(size_t)(kt * 64 + k) * N + gn] : 0.f;
  }
  __syncthreads();
#pragma unroll 4
  for (int i = 0; i < 4; ++i) {
    const int n = i * 16 + (tid >> 5), k = (tid & 31) * 2, gn = ntl * 64 + n;
    const int drow = mode == 0 ? gn : gu_row(gn, mode - 1);
    *(unsigned*)(dst + (size_t)drow * dstK + kt * 64 + k) = pk2(tile[k][n], tile[k + 1][n]);
  }
}
constexpr int WCONV_JOBS = 3392 + 480;
__device__ __forceinline__ size_t wt_out_off(int l) { return (l & 1) ? OFF_WTOUT2 : OFF_WTOUT; }
__device__ __forceinline__ size_t wt_gu_off(int l) { return (l & 1) ? OFF_WTGU2 : OFF_WTGU; }
__device__ __forceinline__ size_t wt_dn_off(int l) { return (l & 1) ? OFF_WTDN2 : OFF_WTDN; }
__device__ __forceinline__ void wconv_job(const Params& P, unsigned char* smem, int l, int job) {
  if (job < 1024) xpose_tile(smem, P.in[I_WIN] + (size_t)l * 1024 * IN_COLS, IN_COLS, job & 15, job >> 4, WSP(bf16_t, OFF_WTIN), 1024, 0);
  else if (job < 1280) { const int j = job - 1024; xpose_tile(smem, P.in[I_WOUT] + (size_t)l * 1024 * 1024, 1024, j & 15, j >> 4, WSP(bf16_t, wt_out_off(l)), 1024, 0); }
  else if (job < 1984) { const int j = job - 1280; xpose_tile(smem, P.in[I_WG] + (size_t)l * 1024 * DFF, DFF, j & 15, j >> 4, WSP(bf16_t, wt_gu_off(l)), 1024, 1); }
  else if (job < 2688) { const int j = job - 1984; xpose_tile(smem, P.in[I_WU] + (size_t)l * 1024 * DFF, DFF, j & 15, j >> 4, WSP(bf16_t, wt_gu_off(l)), 1024, 2); }
  else if (job < 3392) { const int j = job - 2688; xpose_tile(smem, P.in[I_WD] + (size_t)l * DFF * 1024, 1024, j % 44, j / 44, WSP(bf16_t, wt_dn_off(l)), DFF, 0); }
  else {
    bf16_t* lw = WSP(bf16_t, OFF_LORA);
    const int idx = (job - 3392) * 256 + (otid() & 255);
    float v = 0.f;
    const float* pw2 = opq(P.in[I_W2]); const float* pa2 = opq(P.in[I_A2]); const float* pg2 = opq(P.in[I_G2]);
    const float* pv1 = opq(P.in[I_V1]); const float* pv2 = opq(P.in[I_V2]);
    if (idx < A2T) { const int n = idx >> 6, k = idx & 63; v = pw2[(size_t)l * 64 * 384 + k * 384 + n]; }
    else if (idx < G2T) { const int i = idx - A2T, n = i >> 6, k = i & 63; v = pa2[(size_t)l * 64 * 384 + k * 384 + n]; }
    else if (idx < V1T) { const int i = idx - G2T, n = i >> 7, k = i & 127; v = pg2[(size_t)l * 128 * 384 + k * 384 + n]; }
    else if (idx < V2T) { if (l > 0) { const int i = idx - V1T, n = i / 384, k = i - n * 384; v = pv1[(size_t)(l - 1) * 384 * 32 + k * 32 + n]; } }
    else { if (l > 0) { const int i = idx - V2T, n = i >> 5, k = i & 31; v = pv2[(size_t)(l - 1) * 32 * 384 + k * 384 + n]; } }
    if (otid() < 256) lw[idx] = f2bf(v);
  }
}
__device__ __forceinline__ void wconv_phase(const Params& P, unsigned char* smem, int l) {
  for (int job = obid(); job < WCONV_JOBS; job += gridDim.x) wconv_job(P, smem, l, job);
}

__device__ __forceinline__ void norm_phase(const Params& P, int l_in, const float* __restrict__ w) {
  bf16_t* act = WSP(bf16_t, OFF_ACT);
  const int lane = otid() & 63, wid = otid() >> 6;
  f32x4 wv[4];
#pragma unroll
  for (int i = 0; i < 4; ++i) wv[i] = *(const f32x4*)(w + i * 256 + lane * 4);
  for (int r0 = (obid() * 8 + wid) * 4; r0 < NTOK; r0 += gridDim.x * 32) {
    f32x4 v[4][4];
#pragma unroll
    for (int r = 0; r < 4; ++r) {
      const float* xr = xin_row(P, l_in, r0 + r);
#pragma unroll
      for (int i = 0; i < 4; ++i) v[r][i] = *(const f32x4*)(xr + i * 256 + lane * 4);
    }
#pragma unroll
    for (int r = 0; r < 4; ++r) {
      float ss = 0.f;
#pragma unroll
      for (int i = 0; i < 4; ++i) ss += dot4(v[r][i], v[r][i]);
      const float rstd = rsqrtf(wave_sum(ss) * (1.f / 1024.f) + 1e-6f);
#pragma unroll
      for (int i = 0; i < 4; ++i) *(u32x2*)(act + (size_t)(r0 + r) * 1024 + i * 256 + lane * 4) = pack4(v[r][i] * rstd * wv[i]);
    }
  }
}
__device__ __forceinline__ void final_norm_phase(const Params& P) {
  const float* w = P.in[I_NORM_FINAL];
  const int lane = otid() & 63, wid = otid() >> 6;
  f32x4 wv[4];
#pragma unroll
  for (int i = 0; i < 4; ++i) wv[i] = *(const f32x4*)(w + i * 256 + lane * 4);
  for (int r0 = (obid() * 8 + wid) * 4; r0 < NTOK; r0 += gridDim.x * 32) {
    f32x4 v[4][4];
#pragma unroll
    for (int r = 0; r < 4; ++r)
#pragma unroll
      for (int i = 0; i < 4; ++i) v[r][i] = *(const f32x4*)(P.out + (size_t)(r0 + r) * D + i * 256 + lane * 4);
#pragma unroll
    for (int r = 0; r < 4; ++r) {
      float ss = 0.f;
#pragma unroll
      for (int i = 0; i < 4; ++i) ss += dot4(v[r][i], v[r][i]);
      const float rstd = rsqrtf(wave_sum(ss) * (1.f / 1024.f) + 1e-6f);
#pragma unroll
      for (int i = 0; i < 4; ++i) *(f32x4*)(P.out + (size_t)(r0 + r) * D + i * 256 + lane * 4) = v[r][i] * rstd * wv[i];
    }
  }
}

enum { EPI_P = 0, EPI_RES = 1, EPI_SWIGLU = 2 };
namespace pg8 {
constexpr int BM = 256, BK = 64, HALF = 128, HTB = HALF * BK * 2, NXCD = 8, WGM = 8;
__device__ __forceinline__ int lds_byte(int r, int c) { const int st = (r >> 4) * 2 + (c >> 5), rr = r & 15, cc = c & 31, ob = rr * 64 + cc * 2; return st * 1024 + (ob ^ (((ob >> 9) & 1) << 5)); }
__device__ __forceinline__ void stage_rc(int b, int& R, int& C) { const int st = b / 1024, sb = b % 1024, swz = sb ^ (((sb >> 9) & 1) << 5); R = (st >> 1) * 16 + swz / 64; C = (st & 1) * 32 + (swz % 64) / 2; }
__device__ __forceinline__ int perm32(int rho) { const int n = rho >> 4, i = rho & 15; return 8 * (i >> 2) + 4 * n + (i & 3); }
struct Unit { int pm, pn; };
struct StaticOrder {
  int nM, nN, nwg, G, c;
  __device__ __forceinline__ void init(int M, int N, int G_, int c_) { nM = M / BM; nN = N / BM; nwg = nM * nN; G = G_; c = c_; }
  __device__ __forceinline__ bool next(int i, Unit& u) const {
    const long L = (long)i * G + c; if (L >= nwg) return false;
    int wgid = (int)L; { const int q = nwg / NXCD, r = nwg % NXCD, xcd = wgid % NXCD, off = wgid / NXCD; wgid = (xcd < r ? xcd * (q + 1) : r * (q + 1) + (xcd - r) * q) + off; }
    const int nig = WGM * nN, gid = wgid / nig, fm = gid * WGM, gsz = (nM - fm) < WGM ? (nM - fm) : WGM;
    u.pm = fm + ((wgid % nig) % gsz); u.pn = (wgid % nig) / gsz; return true;
  }
};
}

template <int EPI>
__device__ __forceinline__ void gemm_epilogue(const Params& P, const f32x4 (&acc)[2][2][4][2], const pg8::Unit& u, int wr, int wc, int fr, int fq, int l) {
#pragma unroll
  for (int ai = 0; ai < 2; ++ai)
#pragma unroll
    for (int m = 0; m < 4; ++m) {
      const int row = u.pm * 256 + ai * 128 + wr * 64 + m * 16 + fr;
      if (EPI == EPI_P) {
        bf16_t* pr = WSP(bf16_t, OFF_P) + (size_t)row * PSTR;
#pragma unroll
        for (int bj = 0; bj < 2; ++bj) {
          const int col = u.pn * 256 + bj * 128 + wc * 32 + fq * 8;
          if (col < PSTR) { const u32x2 lo = pack4(acc[ai][bj][m][0]), hi = pack4(acc[ai][bj][m][1]); *(u32x4*)(pr + col) = (u32x4){lo[0], lo[1], hi[0], hi[1]}; }
        }
      } else if (EPI == EPI_RES) {
        const float* xi = xin_row(P, l, row);
        float* xo = P.out + (size_t)row * D;
#pragma unroll
        for (int bj = 0; bj < 2; ++bj)
#pragma unroll
          for (int n = 0; n < 2; ++n) {
            const int col = u.pn * 256 + bj * 128 + wc * 32 + n * 16 + fq * 4;
            *(f32x4*)(xo + col) = *(const f32x4*)(xi + col) + acc[ai][bj][m][n];
          }
      } else {
        bf16_t* ur = WSP(bf16_t, OFF_P) + (size_t)row * DFF;
        {
          const int col = u.pn * 128 + wc * 32 + fq * 8;
          f32x4 r0, r1;
#pragma unroll
          for (int j = 0; j < 4; ++j) { r0[j] = silu(acc[ai][0][m][0][j]) * acc[ai][1][m][0][j]; r1[j] = silu(acc[ai][0][m][1][j]) * acc[ai][1][m][1][j]; }
          const u32x2 lo = pack4(r0), hi = pack4(r1);
          *(u32x4*)(ur + col) = (u32x4){lo[0], lo[1], hi[0], hi[1]};
        }
      }
    }
}

#define PG8_LAS __attribute__((address_space(3)))
template <int EPI>
__device__ __forceinline__ void gemm_phase(const Params& P, unsigned char* smem, const bf16_t* __restrict__ Ag, int lda_unused, const bf16_t* __restrict__ Btg, int K, int nN128_unused, int l, int N) {
  using namespace pg8;
  PG8_LAS unsigned char* lds = (PG8_LAS unsigned char*)smem;
  const int tid = otid(), wid = __builtin_amdgcn_readfirstlane(tid >> 6), lane = tid & 63, wr = wid >> 2, wc = wid & 3, fr = lane & 15, fq = lane >> 4;
  const int nt = K / BK;
  StaticOrder S; S.init(NTP, N, (int)gridDim.x, obid());
  unsigned voffA[2], voffB[2];
#pragma unroll
  for (int i = 0; i < 2; ++i) { int R, C; stage_rc(tid * 16 + i * 8192, R, C); const int Rb = EPI == EPI_RES ? R : ((R & ~31) + perm32(R & 31));
    voffA[i] = (unsigned)(R * K + C) * 2u; voffB[i] = (unsigned)(Rb * K + C) * 2u; }
  const size_t kstep = (size_t)(BK * 2);
  const size_t hstep = (size_t)HALF * K * 2;
  const size_t tstep = 2 * hstep;
  const unsigned ldsw = (unsigned)wid * 1024u;
  const int aoff = lds_byte(wr * 64 + fr, fq * 8), boff = lds_byte(wc * 32 + fr, fq * 8);
#define PG8_SA(b, h) (((b) * 2 + (h)) * HTB)
#define PG8_SB(b, h) ((4 + (b) * 2 + (h)) * HTB)
#define PG8_STAGE(bufoff, gbase, voff) do { _Pragma("unroll") for (int _i = 0; _i < 2; ++_i) \
        __builtin_amdgcn_global_load_lds((const unsigned*)((const char*)(gbase) + (voff)[_i]), (PG8_LAS unsigned*)(lds + (bufoff) + ldsw + _i * 8192), 16, 0, 0); } while (0)
#define PG8_LDA(dst, b, h) do { _Pragma("unroll") for (int m = 0; m < 4; ++m) _Pragma("unroll") for (int k = 0; k < 2; ++k) dst[m][k] = *(const PG8_LAS bf16x8*)(lds + PG8_SA(b, h) + aoff + m * 2048 + k * 1024); } while (0)
#define PG8_LDB(dst, b, h) do { _Pragma("unroll") for (int n = 0; n < 2; ++n) _Pragma("unroll") for (int k = 0; k < 2; ++k) dst[n][k] = *(const PG8_LAS bf16x8*)(lds + PG8_SB(b, h) + boff + n * 2048 + k * 1024); } while (0)
#define PG8_MMA(ai, bj, At, Bt) do { __builtin_amdgcn_s_setprio(1); _Pragma("unroll") for (int m = 0; m < 4; ++m) _Pragma("unroll") for (int n = 0; n < 2; ++n) _Pragma("unroll") for (int k = 0; k < 2; ++k) \
        acc[ai][bj][m][n] = __builtin_amdgcn_mfma_f32_16x16x32_bf16(Bt[n][k], At[m][k], acc[ai][bj][m][n], 0, 0, 0); __builtin_amdgcn_s_setprio(0); } while (0)
#define PG8_WAIT_V(n) asm volatile("s_waitcnt vmcnt(" #n ")" ::: "memory")
#define PG8_WAIT_L(n) asm volatile("s_waitcnt lgkmcnt(" #n ")" ::: "memory")
#define PG8_BAR __builtin_amdgcn_s_barrier()
#define PG8_SCHED __builtin_amdgcn_sched_barrier(0)
  Unit cur, nxt; int ui = 0;
  if (!S.next(0, cur)) return;
  f32x4 acc[2][2][4][2];
#pragma unroll
  for (int a = 0; a < 2; ++a)
#pragma unroll
    for (int b = 0; b < 2; ++b)
#pragma unroll
      for (int m = 0; m < 4; ++m)
#pragma unroll
        for (int n = 0; n < 2; ++n) acc[a][b][m][n] = (f32x4){0.f, 0.f, 0.f, 0.f};
  bf16x8 At[4][2], B0[2][2], B1[2][2];
  const char* cA = (const char*)Ag + (size_t)cur.pm * tstep; const char* cB = (const char*)Btg + (size_t)cur.pn * tstep;
  PG8_STAGE(PG8_SB(0, 0), cB, voffB); PG8_STAGE(PG8_SA(0, 0), cA, voffA); PG8_STAGE(PG8_SB(0, 1), cB + hstep, voffB); PG8_STAGE(PG8_SA(0, 1), cA + hstep, voffA);
  if (wr == 1) PG8_BAR;
  PG8_WAIT_V(4); PG8_BAR;
  PG8_STAGE(PG8_SB(1, 0), cB + kstep, voffB); PG8_STAGE(PG8_SA(1, 0), cA + kstep, voffA); PG8_STAGE(PG8_SB(1, 1), cB + hstep + kstep, voffB);
  PG8_WAIT_V(6); PG8_BAR;
  for (;;) {
    const bool has_next = S.next(ui + 1, nxt);
    const char* nA = has_next ? (const char*)Ag + (size_t)nxt.pm * tstep : cA; const char* nB = has_next ? (const char*)Btg + (size_t)nxt.pn * tstep : cB;
    for (int t = 0; t < nt; t += 2) {
      const bool last = (t == nt - 2);
      const char* a1 = cA + (size_t)(t + 1) * kstep;
      const char* a2 = last ? nA : cA + (size_t)(t + 2) * kstep; const char* b2 = last ? nB : cB + (size_t)(t + 2) * kstep;
      const char* a3 = a2 + kstep; const char* b3 = b2 + kstep;
      PG8_LDB(B0, 0, 0); PG8_SCHED; PG8_LDA(At, 0, 0); PG8_STAGE(PG8_SA(1, 1), a1 + hstep, voffA);
      PG8_WAIT_L(8); PG8_BAR; PG8_WAIT_L(0); PG8_MMA(0, 0, At, B0); PG8_BAR; PG8_SCHED;
      PG8_LDB(B1, 0, 1); PG8_STAGE(PG8_SB(0, 0), b2, voffB);
      PG8_BAR; PG8_WAIT_L(0); PG8_MMA(0, 1, At, B1); PG8_BAR;
      PG8_LDA(At, 0, 1); PG8_STAGE(PG8_SA(0, 0), a2, voffA);
      PG8_BAR; PG8_WAIT_L(0); PG8_MMA(1, 0, At, B0); PG8_BAR; PG8_SCHED;
      PG8_STAGE(PG8_SB(0, 1), b2 + hstep, voffB);
      PG8_WAIT_V(6); PG8_BAR; PG8_MMA(1, 1, At, B1); PG8_BAR;
      PG8_LDB(B0, 1, 0); PG8_SCHED; PG8_LDA(At, 1, 0); PG8_STAGE(PG8_SA(0, 1), a2 + hstep, voffA);
      PG8_WAIT_L(8); PG8_BAR; PG8_WAIT_L(0); PG8_MMA(0, 0, At, B0); PG8_BAR; PG8_SCHED;
      PG8_LDB(B1, 1, 1); PG8_STAGE(PG8_SB(1, 0), b3, voffB);
      PG8_BAR; PG8_WAIT_L(0); PG8_MMA(0, 1, At, B1); PG8_BAR;
      PG8_LDA(At, 1, 1); PG8_STAGE(PG8_SA(1, 0), a3, voffA);
      PG8_BAR; PG8_WAIT_L(0); PG8_MMA(1, 0, At, B0); PG8_BAR; PG8_SCHED;
      PG8_STAGE(PG8_SB(1, 1), b3 + hstep, voffB);
      PG8_WAIT_V(6); PG8_BAR; PG8_MMA(1, 1, At, B1); PG8_BAR;
    }
    gemm_epilogue<EPI>(P, acc, cur, wr, wc, fr, fq, l);
    if (!has_next) break;
#pragma unroll
    for (int a = 0; a < 2; ++a)
#pragma unroll
      for (int b = 0; b < 2; ++b)
#pragma unroll
        for (int m = 0; m < 4; ++m)
#pragma unroll
          for (int n = 0; n < 2; ++n) acc[a][b][m][n] = (f32x4){0.f, 0.f, 0.f, 0.f};
    cur = nxt; cA = nA; cB = nB; ++ui;
  }
  PG8_WAIT_V(0);
  if (wr == 0) PG8_BAR;
  PG8_BAR;
#undef PG8_SA
#undef PG8_SB
#undef PG8_STAGE
#undef PG8_LDA
#undef PG8_LDB
#undef PG8_MMA
#undef PG8_WAIT_V
#undef PG8_WAIT_L
#undef PG8_BAR
#undef PG8_SCHED
}

template <int EPI>
__device__ __forceinline__ void gemm_sample(const Params& P, unsigned char* smem, const bf16_t* __restrict__ A, int lda, const bf16_t* __restrict__ Bt, int K, int nunits, int l) {
  const int tid = otid(), lane = tid & 63, wid = tid >> 6, fr = lane & 15, fq = lane >> 4;
  const int kslice = K >> 3;
  for (int u = (int)gridDim.x - 1 - obid(); u < nunits; u += gridDim.x) {
    const int brow0 = EPI == EPI_SWIGLU ? gu_row(u * 16 + fr, 0) : u * 16 + fr;
    const int brow1 = EPI == EPI_SWIGLU ? gu_row(u * 16 + fr, 1) : 0;
    const bf16_t* ap = A + (size_t)(NTP + fr) * lda + wid * kslice + fq * 8;
    const bf16_t* b0p = Bt + (size_t)brow0 * K + wid * kslice + fq * 8;
    const bf16_t* b1p = Bt + (size_t)brow1 * K + wid * kslice + fq * 8;
    f32x4 c0[8], c1[8];
#pragma unroll
    for (int m = 0; m < 8; ++m) { c0[m] = (f32x4){0.f, 0.f, 0.f, 0.f}; c1[m] = c0[m]; }
#pragma unroll 2
    for (int ks = 0; ks < kslice; ks += 32) {
      bf16x8 Af[8];
#pragma unroll
      for (int m = 0; m < 8; ++m) Af[m] = *(const bf16x8*)(ap + (size_t)m * 16 * lda + ks);
      const bf16x8 B0 = *(const bf16x8*)(b0p + ks);
      bf16x8 B1 = B0;
      if (EPI == EPI_SWIGLU) B1 = *(const bf16x8*)(b1p + ks);
#pragma unroll
      for (int m = 0; m < 8; ++m) {
        c0[m] = __builtin_amdgcn_mfma_f32_16x16x32_bf16(B0, Af[m], c0[m], 0, 0, 0);
        if (EPI == EPI_SWIGLU) c1[m] = __builtin_amdgcn_mfma_f32_16x16x32_bf16(B1, Af[m], c1[m], 0, 0, 0);
      }
    }
    __syncthreads();
#pragma unroll
    for (int m = 0; m < 8; ++m) {
      *(f32x4*)(smem + ((wid * 8 + m) * 64 + lane) * 16) = c0[m];
      if (EPI == EPI_SWIGLU) *(f32x4*)(smem + 65536 + ((wid * 8 + m) * 64 + lane) * 16) = c1[m];
    }
    __syncthreads();
    f32x4 g = (f32x4){0.f, 0.f, 0.f, 0.f}, up = g;
#pragma unroll
    for (int w = 0; w < 8; ++w) {
      g += *(const f32x4*)(smem + ((w * 8 + wid) * 64 + lane) * 16);
      if (EPI == EPI_SWIGLU) up += *(const f32x4*)(smem + 65536 + ((w * 8 + wid) * 64 + lane) * 16);
    }
    {
      const int row = NTP + wid * 16 + fr, col = u * 16 + fq * 4;
      if (EPI == EPI_P) {
        if (col < IN_COLS) *(u32x2*)(WSP(bf16_t, OFF_P) + (size_t)row * PSTR + col) = pack4(g);
      } else if (EPI == EPI_RES) {
        const float* xi = xin_row(P, l, row);
        *(f32x4*)(P.out + (size_t)row * D + col) = *(const f32x4*)(xi + col) + g;
      } else {
        f32x4 r;
#pragma unroll
        for (int j = 0; j < 4; ++j) r[j] = silu(g[j]) * up[j];
        *(u32x2*)(WSP(bf16_t, OFF_P) + (size_t)row * DFF + col) = pack4(r);
      }
    }
  }
}

__device__ __forceinline__ float lbval(const Params& P, int l, int c) {
  const float* hb = P.in[I_HLB];
  const float a0 = hb[c], a1 = hb[256 + c], a2 = hb[512 + c], a3 = hb[768 + c];
  const float m = fmaxf(fmaxf(a0, a1), fmaxf(a2, a3));
  const float e0 = __expf(a0 - m), e1 = __expf(a1 - m), e2 = __expf(a2 - m), e3 = __expf(a3 - m);
  const float inv = 1.f / (e0 + e1 + e2 + e3);
  float s = 0.f;
  if (l >= 1) s += e1; if (l >= 2) s += e2; if (l >= 3) s += e3;
  return s * inv;
}

__device__ __forceinline__ void gdn_conv_emit2(const Params& P, int g, int c2, int row, float s0, float s1) {
  const int h = g % 6;
  if (g < 12) {
    const float rn = rsqrtf(half_sum(s0 * s0 + s1 * s1) + 1e-6f) * (g < 6 ? 0.125f : 1.f);
    *(unsigned*)((g < 6 ? WSP(bf16_t, OFF_GQ) : WSP(bf16_t, OFF_GK)) + (size_t)row * 384 + h * 64 + c2) = pk2(s0 * rn, s1 * rn);
  } else {
    *(unsigned*)(WSP(bf16_t, OFF_GV) + (size_t)row * 384 + h * 64 + c2) = pk2(s0, s1);
  }
}
__device__ __forceinline__ void gdn_gate_emit(const Params& P, int l, int h, int row) {
  const bf16_t* pr = WSP(bf16_t, OFF_P) + (size_t)row * PSTR;
  const float braw = bf2f(pr[1536 + h]), araw = bf2f(pr[1542 + h]);
  const float gg = -__expf(P.in[I_ALOG][l * 6 + h]) * softplus(araw + P.in[I_DTB][l * 6 + h]);
  WSP(float, OFF_GDEC)[(size_t)row * 8 + h] = __expf(gg);
  WSP(float, OFF_GBETA)[(size_t)row * 8 + h] = sigm(braw);
}
__device__ __forceinline__ void prep_gdn_prompt(const Params& P, int l, int ci) {
  const int lane = otid() & 63, wid = otid() >> 6, hl = lane >> 5, c2 = (lane & 31) * 2;
  const int r0 = ci * 32, b = r0 / TSEQ, t0 = r0 % TSEQ;
  const bf16_t* p = WSP(bf16_t, OFF_P);
  for (int gp = wid; gp < 9; gp += 8) {
    const int g = gp * 2 + hl, col = g * 64 + c2;
    const float* cw = P.in[I_CONVW] + (size_t)l * 4 * 1152 + col;
    const f32x2 w0 = *(const f32x2*)cw, w1 = *(const f32x2*)(cw + 1152), w2 = *(const f32x2*)(cw + 2304), w3 = *(const f32x2*)(cw + 3456);
    unsigned xr[35];
#pragma unroll
    for (int t = 0; t < 35; ++t) xr[t] = (t >= 3 || t0 > 0) ? *(const unsigned*)(p + (size_t)(r0 - 3 + t) * PSTR + col) : 0u;
    f32x2 x3 = {__uint_as_float(xr[0] << 16), __uint_as_float(xr[0] & 0xffff0000u)};
    f32x2 x2 = {__uint_as_float(xr[1] << 16), __uint_as_float(xr[1] & 0xffff0000u)};
    f32x2 x1 = {__uint_as_float(xr[2] << 16), __uint_as_float(xr[2] & 0xffff0000u)};
#pragma unroll
    for (int t = 0; t < 32; ++t) {
      const f32x2 x0 = {__uint_as_float(xr[t + 3] << 16), __uint_as_float(xr[t + 3] & 0xffff0000u)};
      const f32x2 y = w0 * x3 + w1 * x2 + w2 * x1 + w3 * x0;
      gdn_conv_emit2(P, g, c2, r0 + t, silu(y[0]), silu(y[1]));
      x3 = x2; x2 = x1; x1 = x0;
    }
    if (t0 + 32 == TSEQ) {
      float* cp = P.out + O_CONV_P + (size_t)(l * 8 + b) * 3 * 1152 + col;
      *(f32x2*)cp = x3; *(f32x2*)(cp + 1152) = x2; *(f32x2*)(cp + 2304) = x1;
    }
    if (g < 6) gdn_gate_emit(P, l, g, r0 + (lane & 31));
  }
}
__device__ __forceinline__ void prep_gdn_sample(const Params& P, int l, int si) {
  const int lane = otid() & 63, wid = otid() >> 6, hl = lane >> 5, c2 = (lane & 31) * 2;
  const bf16_t* p = WSP(bf16_t, OFF_P);
  for (int u = wid; u < 18; u += 8) {
    const int s = si * 2 + u / 9, g = (u % 9) * 2 + hl, col = g * 64 + c2, row = NTP + s;
    const float* cw = P.in[I_CONVW] + (size_t)l * 4 * 1152 + col;
    const f32x2 w0 = *(const f32x2*)cw, w1 = *(const f32x2*)(cw + 1152), w2 = *(const f32x2*)(cw + 2304), w3 = *(const f32x2*)(cw + 3456);
    const float* cb = P.in[I_SCONV] + (size_t)(l * 128 + s) * 3 * 1152 + col;
    const f32x2 x3 = *(const f32x2*)cb, x2 = *(const f32x2*)(cb + 1152), x1 = *(const f32x2*)(cb + 2304);
    const unsigned xw = *(const unsigned*)(p + (size_t)row * PSTR + col);
    const f32x2 x0 = {__uint_as_float(xw << 16), __uint_as_float(xw & 0xffff0000u)};
    const f32x2 y = w0 * x3 + w1 * x2 + w2 * x1 + w3 * x0;
    gdn_conv_emit2(P, g, c2, row, silu(y[0]), silu(y[1]));
    float* cp = P.out + O_CONV_S + (size_t)(l * 128 + s) * 3 * 1152 + col;
    *(f32x2*)cp = x2; *(f32x2*)(cp + 1152) = x1; *(f32x2*)(cp + 2304) = x0;
    if (g < 6 && (lane & 31) == 0) gdn_gate_emit(P, l, g, row);
  }
}
__device__ __forceinline__ void prep_hgrn(const Params& P, int l, int ti) {
  const int c2 = (otid() & 127) * 2, tg = otid() >> 7;
  const float oml0 = 1.f - lbval(P, l, c2), oml1 = 1.f - lbval(P, l, c2 + 1);
  const bf16_t* p = WSP(bf16_t, OFF_P);
  bf16_t* hq = WSP(bf16_t, OFF_HQ); bf16_t* hk = WSP(bf16_t, OFF_HK);
  for (int t0 = tg * 16; t0 < tg * 16 + 16; t0 += 8) {
    unsigned q[8], f[8];
#pragma unroll
    for (int i = 0; i < 8; ++i) { const int row = ti * 64 + t0 + i; q[i] = *(const unsigned*)(p + (size_t)row * PSTR + PC + c2); f[i] = *(const unsigned*)(p + (size_t)row * PSTR + PC + 256 + c2); }
#pragma unroll
    for (int i = 0; i < 8; ++i) {
      const int row = ti * 64 + t0 + i;
      const float q0 = __uint_as_float(q[i] << 16), q1 = __uint_as_float(q[i] & 0xffff0000u);
      const float f0 = __uint_as_float(f[i] << 16), f1 = __uint_as_float(f[i] & 0xffff0000u);
      *(unsigned*)(hq + (size_t)row * 256 + c2) = pk2(silu(q0) * 0.125f, silu(q1) * 0.125f);
      *(unsigned*)(hk + (size_t)row * 256 + c2) = pk2(oml0 * sigm(-f0), oml1 * sigm(-f1));
    }
  }
}
template <bool SAMP>
__device__ __forceinline__ f32x4 xs4t(const Params& P, int l, int row, int col0) {
  const bf16_t* p = WSP(bf16_t, OFF_P);
  const f32x4 pv = unpack4(*(const u32x2*)(p + (size_t)row * PSTR + PB + col0));
  f32x4 prev;
  if (SAMP) prev = *(const f32x4*)(P.in[I_SSHIFT] + (size_t)(l * 128 + (row - NTP)) * 1408 + col0);
  else {
    const bool first = (row & (TSEQ - 1)) == 0;
    prev = unpack4(*(const u32x2*)(p + (size_t)(row - (first ? 0 : 1)) * PSTR + PB + col0)) * (first ? 0.f : 1.f);
  }
  const f32x4 mu = *(const f32x4*)(P.in[I_MU] + l * 1408 + col0);
  return pv + (prev - pv) * mu;
}
__device__ __forceinline__ float tanh_fast(float x) { return 1.f - 2.f / (__expf(2.f * x) + 1.f); }

template <int ROWB>
__device__ __forceinline__ void stage_lora(unsigned char* smem, const bf16_t* __restrict__ src) {
  constexpr int CPR = ROWB / 16, NCH = 384 * CPR;
  __syncthreads();
  u32x4 t[NCH / 512];
#pragma unroll
  for (int i = 0; i < NCH / 512; ++i) t[i] = *(const u32x4*)((const unsigned char*)src + (size_t)(otid() + i * 512) * 16);
#pragma unroll
  for (int i = 0; i < NCH / 512; ++i) { const int idx = otid() + i * 512, r = idx / CPR, c = idx - r * CPR; *(u32x4*)(smem + r * (ROWB + 16) + c * 16) = t[i]; }
  __syncthreads();
}
template <bool SAMP>
__device__ __forceinline__ void prep_rwkv_unit(const Params& P, unsigned char* smem, int l, int mt, int hh) {
  const int lane = otid() & 63, fr = lane & 15, fq = lane >> 4;
  const int row = mt * 16 + fr, cb = hh * 192;
  const bf16_t* lw = WSP(bf16_t, OFF_LORA);
  const size_t ro = (size_t)row * 384;
  f32x4 acc[12];
  {
    f32x4 x[2][2]; bf16x8 Bf[2][12];
    stage_lora<128>(smem, lw + W2T);
#pragma unroll
    for (int ks = 0; ks < 2; ++ks) { x[ks][0] = xs4t<SAMP>(P, l, row, 1152 + ks * 32 + fq * 8); x[ks][1] = xs4t<SAMP>(P, l, row, 1152 + ks * 32 + fq * 8 + 4); }
#pragma unroll
    for (int ks = 0; ks < 2; ++ks)
#pragma unroll
      for (int nf = 0; nf < 12; ++nf) Bf[ks][nf] = *(const bf16x8*)(smem + (cb + nf * 16 + fr) * 144 + ks * 64 + fq * 16);
#pragma unroll
    for (int nf = 0; nf < 12; ++nf) acc[nf] = (f32x4){0.f, 0.f, 0.f, 0.f};
#pragma unroll
    for (int ks = 0; ks < 2; ++ks) {
#pragma unroll
      for (int j = 0; j < 4; ++j) { x[ks][0][j] = tanh_fast(x[ks][0][j]); x[ks][1][j] = tanh_fast(x[ks][1][j]); }
      const bf16x8 A = pack8(x[ks][0], x[ks][1]);
#pragma unroll
      for (int nf = 0; nf < 12; ++nf) acc[nf] = __builtin_amdgcn_mfma_f32_16x16x32_bf16(Bf[ks][nf], A, acc[nf], 0, 0, 0);
    }
    f32x4 w0v[12];
#pragma unroll
    for (int nf = 0; nf < 12; ++nf) w0v[nf] = *(const f32x4*)(P.in[I_W0] + l * 384 + cb + nf * 16 + fq * 4);
#pragma unroll
    for (int nf = 0; nf < 12; ++nf) {
      f32x4 d;
#pragma unroll
      for (int j = 0; j < 4; ++j) {
        const float xx = -(w0v[nf][j] + acc[nf][j]);
        const float sp = xx > 15.f ? xx : __logf(1.f + __expf(xx));
        d[j] = __expf(-__expf(-sp - 0.5f));
      }
      *(f32x4*)(WSP(float, OFF_RW) + ro + cb + nf * 16 + fq * 4) = d;
    }
  }
  {
    f32x4 x[2][2]; bf16x8 Bf[2][12];
    stage_lora<128>(smem, lw + A2T);
#pragma unroll
    for (int ks = 0; ks < 2; ++ks) { x[ks][0] = xs4t<SAMP>(P, l, row, 1216 + ks * 32 + fq * 8); x[ks][1] = xs4t<SAMP>(P, l, row, 1216 + ks * 32 + fq * 8 + 4); }
#pragma unroll
    for (int ks = 0; ks < 2; ++ks)
#pragma unroll
      for (int nf = 0; nf < 12; ++nf) Bf[ks][nf] = *(const bf16x8*)(smem + (cb + nf * 16 + fr) * 144 + ks * 64 + fq * 16);
#pragma unroll
    for (int nf = 0; nf < 12; ++nf) acc[nf] = (f32x4){0.f, 0.f, 0.f, 0.f};
#pragma unroll
    for (int ks = 0; ks < 2; ++ks) {
      const bf16x8 A = pack8(x[ks][0], x[ks][1]);
#pragma unroll
      for (int nf = 0; nf < 12; ++nf) acc[nf] = __builtin_amdgcn_mfma_f32_16x16x32_bf16(Bf[ks][nf], A, acc[nf], 0, 0, 0);
    }
  }
#pragma unroll
  for (int hl = 0; hl < 3; ++hl) {
    f32x4 kr[4], rr[4], kkw[4], a0[4], ka[4];
#pragma unroll
    for (int q = 0; q < 4; ++q) {
      const int c = cb + (hl * 4 + q) * 16 + fq * 4;
      kr[q] = xs4t<SAMP>(P, l, row, 384 + c); rr[q] = xs4t<SAMP>(P, l, row, c);
      kkw[q] = *(const f32x4*)(P.in[I_KK] + l * 384 + c); a0[q] = *(const f32x4*)(P.in[I_A0] + l * 384 + c); ka[q] = *(const f32x4*)(P.in[I_KA] + l * 384 + c);
    }
    float ss = 0.f;
#pragma unroll
    for (int q = 0; q < 4; ++q) { kkw[q] = kr[q] * kkw[q]; ss += dot4(kkw[q], kkw[q]); }
    ss += __shfl_xor(ss, 16); ss += __shfl_xor(ss, 32);
    const float rn = rsqrtf(ss + 1e-6f);
#pragma unroll
    for (int q = 0; q < 4; ++q) {
      const int nf = hl * 4 + q, c = cb + nf * 16 + fq * 4;
      f32x4 kn, kk, kb;
#pragma unroll
      for (int j = 0; j < 4; ++j) {
        const float a = sigm(a0[q][j] + acc[nf][j]);
        kk[j] = kkw[q][j] * rn; kb[j] = kk[j] * a; kn[j] = kr[q][j] * (1.f + (a - 1.f) * ka[q][j]);
      }
      *(u32x2*)(WSP(bf16_t, OFF_RK) + ro + c) = pack4(kn);
      *(u32x2*)(WSP(bf16_t, OFF_RKK) + ro + c) = pack4(kk);
      *(u32x2*)(WSP(bf16_t, OFF_RB) + ro + c) = pack4(kb);
      *(u32x2*)(WSP(bf16_t, OFF_RR) + ro + c) = pack4(rr[q]);
    }
  }
  {
    f32x4 x[4][2];
    stage_lora<256>(smem, lw + G2T);
#pragma unroll
    for (int ks = 0; ks < 4; ++ks) { x[ks][0] = xs4t<SAMP>(P, l, row, 1280 + ks * 32 + fq * 8); x[ks][1] = xs4t<SAMP>(P, l, row, 1280 + ks * 32 + fq * 8 + 4); }
    bf16x8 A[4];
#pragma unroll
    for (int ks = 0; ks < 4; ++ks) {
#pragma unroll
      for (int j = 0; j < 4; ++j) { x[ks][0][j] = sigm(x[ks][0][j]); x[ks][1][j] = sigm(x[ks][1][j]); }
      A[ks] = pack8(x[ks][0], x[ks][1]);
    }
#pragma unroll
    for (int hf = 0; hf < 2; ++hf) {
      bf16x8 Bf[4][6];
#pragma unroll
      for (int ks = 0; ks < 4; ++ks)
#pragma unroll
        for (int n6 = 0; n6 < 6; ++n6) Bf[ks][n6] = *(const bf16x8*)(smem + (cb + (hf * 6 + n6) * 16 + fr) * 272 + ks * 64 + fq * 16);
#pragma unroll
      for (int n6 = 0; n6 < 6; ++n6) {
        f32x4 g = (f32x4){0.f, 0.f, 0.f, 0.f};
#pragma unroll
        for (int ks = 0; ks < 4; ++ks) g = __builtin_amdgcn_mfma_f32_16x16x32_bf16(Bf[ks][n6], A[ks], g, 0, 0, 0);
        *(u32x2*)(WSP(bf16_t, OFF_RG) + ro + cb + (hf * 6 + n6) * 16 + fq * 4) = pack4(g);
      }
    }
  }
  if (l == 0) {
    f32x4 v[12];
#pragma unroll
    for (int nf = 0; nf < 12; ++nf) v[nf] = xs4t<SAMP>(P, l, row, 768 + cb + nf * 16 + fq * 4);
#pragma unroll
    for (int nf = 0; nf < 12; ++nf) {
      const int c = cb + nf * 16 + fq * 4;
      const u32x2 o = pack4(v[nf]);
      *(u32x2*)(WSP(bf16_t, OFF_RV) + ro + c) = o;
      *(u32x2*)(WSP(bf16_t, OFF_VF) + ro + c) = o;
    }
  } else {
    f32x4 lo0 = (f32x4){0.f, 0.f, 0.f, 0.f}, lo1 = lo0;
#pragma unroll
    for (int hf = 0; hf < 2; ++hf) {
      f32x4 x[6][2]; bf16x8 B0[6], B1[6];
#pragma unroll
      for (int k6 = 0; k6 < 6; ++k6) {
        const int ks = hf * 6 + k6;
        x[k6][0] = xs4t<SAMP>(P, l, row, 768 + ks * 32 + fq * 8); x[k6][1] = xs4t<SAMP>(P, l, row, 768 + ks * 32 + fq * 8 + 4);
        B0[k6] = *(const bf16x8*)(lw + V1T + fr * 384 + ks * 32 + fq * 8);
        B1[k6] = *(const bf16x8*)(lw + V1T + (16 + fr) * 384 + ks * 32 + fq * 8);
      }
#pragma unroll
      for (int k6 = 0; k6 < 6; ++k6) {
        const bf16x8 A = pack8(x[k6][0], x[k6][1]);
        lo0 = __builtin_amdgcn_mfma_f32_16x16x32_bf16(B0[k6], A, lo0, 0, 0, 0);
        lo1 = __builtin_amdgcn_mfma_f32_16x16x32_bf16(B1[k6], A, lo1, 0, 0, 0);
      }
    }
    const bf16x8 A2 = pack8(lo0, lo1);
#pragma unroll
    for (int hf = 0; hf < 2; ++hf) {
      u32x4 bw[6]; f32x4 v0[6], v[6]; u32x2 vf[6];
#pragma unroll
      for (int n6 = 0; n6 < 6; ++n6) {
        const int nf = hf * 6 + n6, c = cb + nf * 16 + fq * 4;
        const bf16_t* vr = lw + V2T + (cb + nf * 16 + fr) * 32;
        const u32x2 b0 = *(const u32x2*)(vr + fq * 4), b1 = *(const u32x2*)(vr + 16 + fq * 4);
        bw[n6][0] = b0[0]; bw[n6][1] = b0[1]; bw[n6][2] = b1[0]; bw[n6][3] = b1[1];
        v0[n6] = *(const f32x4*)(P.in[I_V0] + (l - 1) * 384 + c);
        v[n6] = xs4t<SAMP>(P, l, row, 768 + c);
        vf[n6] = *(const u32x2*)(WSP(bf16_t, OFF_VF) + ro + c);
      }
#pragma unroll
      for (int n6 = 0; n6 < 6; ++n6) {
        const int c = cb + (hf * 6 + n6) * 16 + fq * 4;
        const f32x4 mv = __builtin_amdgcn_mfma_f32_16x16x32_bf16(__builtin_bit_cast(bf16x8, bw[n6]), A2, (f32x4){0.f, 0.f, 0.f, 0.f}, 0, 0, 0);
        const f32x4 vfv = unpack4(vf[n6]);
        f32x4 o;
#pragma unroll
        for (int j = 0; j < 4; ++j) o[j] = v[n6][j] + (vfv[j] - v[n6][j]) * sigm(v0[n6][j] + mv[j]);
        *(u32x2*)(WSP(bf16_t, OFF_RV) + ro + c) = pack4(o);
      }
    }
  }
}
__device__ __forceinline__ void prep_phase(const Params& P, unsigned char* smem, int l) {
  for (int it = obid(); it < 1092; it += gridDim.x) {
    if (it < 256) { const int wid = otid() >> 6; prep_rwkv_unit<false>(P, smem, l, it * 4 + (wid >> 1), wid & 1); }
    else if (it < 258) { const int wid = otid() >> 6; prep_rwkv_unit<true>(P, smem, l, it * 4 + (wid >> 1), wid & 1); }
    else if (it < 770) prep_gdn_prompt(P, l, it - 258);
    else if (it < 834) prep_gdn_sample(P, l, it - 770);
    else prep_hgrn(P, l, it - 834);
  }
  const bf16_t* p = WSP(bf16_t, OFF_P);
  for (int idx = obid() * 512 + otid(); idx < 136 * 1408; idx += gridDim.x * 512) {
    const int q = idx / 1408, col = idx - q * 1408;
    if (q < 8) P.out[O_SHIFT_P + (size_t)(l * 8 + q) * 1408 + col] = bf2f(p[(size_t)(q * TSEQ + TSEQ - 1) * PSTR + PB + col]);
    else P.out[O_SHIFT_S + (size_t)(l * 128 + (q - 8)) * 1408 + col] = bf2f(p[(size_t)(NTP + q - 8) * PSTR + PB + col]);
  }
}

template <int KIND> struct ScanCfg { static constexpr int STRIDE = KIND == 1 ? 356 : 164; };

template <int KIND> struct ScanPre { u32x2 a, b, c, d, v; f32x4 w; float g; };

template <int KIND>
__device__ __forceinline__ void scan_load(const Params& P, ScanPre<KIND>& r, int tid, int h, int half, int rowbase, int nvalid) {
  const int s = tid >> 4, j4 = (tid & 15) * 4;
  const int s2 = (tid >> 3) & 15, j2 = (tid & 7) * 4;
  const u32x2 z2 = {0u, 0u};
  const bool ok = s < nvalid, ok2 = (tid < 128) && (s2 < nvalid);
  if (KIND == 0) {
    const size_t o = (size_t)(rowbase + s) * 384 + h * 64 + j4;
    r.a = ok ? *(const u32x2*)(WSP(bf16_t, OFF_GK) + o) : z2;
    r.b = ok ? *(const u32x2*)(WSP(bf16_t, OFF_GQ) + o) : z2;
    r.v = ok2 ? *(const u32x2*)(WSP(bf16_t, OFF_GV) + (size_t)(rowbase + s2) * 384 + h * 64 + half * 32 + j2) : z2;
    const int sg = (tid >> 1) & 15;
    r.g = (tid < 32 && sg < nvalid) ? ((tid & 1) ? WSP(float, OFF_GBETA) : WSP(float, OFF_GDEC))[(size_t)(rowbase + sg) * 8 + h] : 0.f;
  } else if (KIND == 1) {
    const size_t o = (size_t)(rowbase + s) * 384 + h * 64 + j4;
    r.a = ok ? *(const u32x2*)(WSP(bf16_t, OFF_RR) + o) : z2;
    r.w = ok ? *(const f32x4*)(WSP(float, OFF_RW) + o) : (f32x4){0.f, 0.f, 0.f, 0.f};
    r.b = ok ? *(const u32x2*)(WSP(bf16_t, OFF_RK) + o) : z2;
    r.c = ok ? *(const u32x2*)(WSP(bf16_t, OFF_RKK) + o) : z2;
    r.d = ok ? *(const u32x2*)(WSP(bf16_t, OFF_RB) + o) : z2;
    r.v = ok2 ? *(const u32x2*)(WSP(bf16_t, OFF_RV) + (size_t)(rowbase + s2) * 384 + h * 64 + half * 32 + j2) : z2;
  } else {
    const size_t o = (size_t)(rowbase + s) * 256 + h * 64 + j4;
    r.a = ok ? *(const u32x2*)(WSP(bf16_t, OFF_HQ) + o) : z2;
    r.b = ok ? *(const u32x2*)(WSP(bf16_t, OFF_HK) + o) : z2;
    r.v = ok2 ? *(const u32x2*)(WSP(bf16_t, OFF_P) + (size_t)(rowbase + s2) * PSTR + PC + 512 + h * 64 + half * 32 + j2) : z2;
  }
}
template <int KIND>
__device__ __forceinline__ void scan_store(const ScanPre<KIND>& r, int tid, float* buf) {
  constexpr int STRIDE = ScanCfg<KIND>::STRIDE;
  const int s = tid >> 4, j4 = (tid & 15) * 4;
  const int s2 = (tid >> 3) & 15, j2 = (tid & 7) * 4;
  float* bs = buf + s * STRIDE + j4;
  if (KIND == 0) {
    const f32x4 k = unpack4(r.a), q = unpack4(r.b);
    *(f32x4*)(bs) = k; *(f32x4*)(bs + 64) = q;
    const float qk = row_sum16(dot4(q, k));
    if ((tid & 15) == 0) buf[s * STRIDE + 162] = qk;
    if (tid < 128) *(f32x4*)(buf + s2 * STRIDE + 128 + j2) = unpack4(r.v);
    if (tid < 32) buf[((tid >> 1) & 15) * STRIDE + 160 + (tid & 1)] = r.g;
  } else if (KIND == 1) {
    const f32x4 rr = unpack4(r.a), k = unpack4(r.b), kk = unpack4(r.c), bb = unpack4(r.d);
    *(f32x4*)(bs) = r.w * rr; *(f32x4*)(bs + 64) = r.w; *(f32x4*)(bs + 128) = k;
    *(f32x4*)(bs + 192) = kk; *(f32x4*)(bs + 256) = bb;
    const float br = row_sum16(dot4(bb, rr)), kr = row_sum16(dot4(k, rr));
    if ((tid & 15) == 0) { buf[s * STRIDE + 352] = br; buf[s * STRIDE + 353] = kr; }
    if (tid < 128) *(f32x4*)(buf + s2 * STRIDE + 320 + j2) = unpack4(r.v);
  } else {
    const f32x4 q = unpack4(r.a), k = unpack4(r.b);
    *(f32x4*)(bs) = q * (1.f - k); *(f32x4*)(bs + 64) = k;
    const float qk = row_sum16(dot4(q, k));
    if ((tid & 15) == 0) buf[s * STRIDE + 160] = qk;
    if (tid < 128) *(f32x4*)(buf + s2 * STRIDE + 128 + j2) = unpack4(r.v);
  }
}

template <int KIND> struct StepOps { f32x2 a[4], b[4], c[4], d[4], e[4]; float v, s0, s1, s2; };
template <int KIND>
__device__ __forceinline__ void step_load(StepOps<KIND>& o, const float* bs, int e0, int cl) {
#define LD8(dst, off) { const f32x4 _x = *(const f32x4*)(bs + (off) + e0), _y = *(const f32x4*)(bs + (off) + e0 + 4); \
    dst[0] = (f32x2){_x[0], _x[1]}; dst[1] = (f32x2){_x[2], _x[3]}; dst[2] = (f32x2){_y[0], _y[1]}; dst[3] = (f32x2){_y[2], _y[3]}; }
  if (KIND == 0) {
    LD8(o.a, 0) LD8(o.b, 64)
    o.v = bs[128 + cl];
    const f32x4 sc = *(const f32x4*)(bs + 160); o.s0 = sc[0]; o.s1 = sc[1]; o.s2 = sc[2];
  } else if (KIND == 1) {
    LD8(o.a, 0) LD8(o.b, 64) LD8(o.c, 128) LD8(o.d, 192) LD8(o.e, 256)
    o.v = bs[320 + cl];
    const f32x2 sc = *(const f32x2*)(bs + 352); o.s0 = sc[0]; o.s1 = sc[1];
  } else {
    LD8(o.a, 0) LD8(o.b, 64)
    o.v = bs[128 + cl]; o.s0 = bs[160];
  }
#undef LD8
}
template <int KIND>
__device__ __forceinline__ float step_compute(const StepOps<KIND>& o, f32x2 (&S)[4]) {
  if (KIND == 0) {
    f32x2 ks2 = o.a[0] * S[0], qs2 = o.b[0] * S[0];
#pragma unroll
    for (int i = 1; i < 4; ++i) { ks2 += o.a[i] * S[i]; qs2 += o.b[i] * S[i]; }
    float ks = ks2[0] + ks2[1], qs = qs2[0] + qs2[1];
    ks += dppf<0xB1>(ks); qs += dppf<0xB1>(qs); ks += dppf<0x4E>(ks); qs += dppf<0x4E>(qs); ks += dppf<0x141>(ks); qs += dppf<0x141>(qs);
    const float dec = o.s0, vn = o.s1 * (o.v - dec * ks);
#pragma unroll
    for (int i = 0; i < 4; ++i) S[i] = S[i] * dec + o.a[i] * vn;
    return dec * qs + vn * o.s2;
  } else if (KIND == 1) {
    f32x2 sa2 = o.d[0] * S[0], p2 = o.a[0] * S[0];
#pragma unroll
    for (int i = 1; i < 4; ++i) { sa2 += o.d[i] * S[i]; p2 += o.a[i] * S[i]; }
    float sa = sa2[0] + sa2[1], p1 = p2[0] + p2[1];
    sa += dppf<0xB1>(sa); p1 += dppf<0xB1>(p1); sa += dppf<0x4E>(sa); p1 += dppf<0x4E>(p1); sa += dppf<0x141>(sa); p1 += dppf<0x141>(p1);
    sa = -sa;
#pragma unroll
    for (int i = 0; i < 4; ++i) S[i] = S[i] * o.b[i] + (o.e[i] * sa + o.c[i] * o.v);
    return p1 + sa * o.s0 + o.v * o.s1;
  } else {
    f32x2 p2 = o.a[0] * S[0];
#pragma unroll
    for (int i = 1; i < 4; ++i) p2 += o.a[i] * S[i];
    float p1 = p2[0] + p2[1];
    p1 += dppf<0xB1>(p1); p1 += dppf<0x4E>(p1); p1 += dppf<0x141>(p1);
#pragma unroll
    for (int i = 0; i < 4; ++i) S[i] = S[i] + o.b[i] * (o.v - S[i]);
    return p1 + o.v * o.s0;
  }
}

template <int KIND>
__device__ __forceinline__ void scan_task(const Params& P, unsigned char* smem, int l, int seq, int h, int half, bool active) {
  constexpr int STRIDE = ScanCfg<KIND>::STRIDE, NEL = 16 * STRIDE;
  constexpr int NH = KIND == 2 ? 4 : 6;
  float* buf = (float*)smem;
  float* obuf = buf + 2 * NEL;
  const int tid = otid() & 255, lane = tid & 63, wid = tid >> 6;
  const int col_l = lane >> 3, sub = lane & 7, cl = wid * 8 + col_l, col = half * 32 + cl, e0 = sub * 8;
  const bool sample = seq >= 8;
  const int R0 = sample ? NTP + (seq - 8) : seq * TSEQ, T = sample ? 1 : TSEQ;
  const int ocol = (KIND == 0 ? 0 : (KIND == 1 ? 384 : 768)) + h * 64 + half * 32;
  const size_t O_P = KIND == 0 ? O_GDN_P : (KIND == 1 ? O_RWKV_P : O_HGRN_P);
  const size_t O_S = KIND == 0 ? O_GDN_S : (KIND == 1 ? O_RWKV_S : O_HGRN_S);
  const int I_ST = KIND == 0 ? I_SGDN : (KIND == 1 ? I_SRWKV : I_SHGRN);
  f32x2 S[4];
#pragma unroll
  for (int i = 0; i < 4; ++i) S[i] = (f32x2){0.f, 0.f};
  if (sample && active) {
    const float* st = P.in[I_ST] + ((size_t)(l * 128 + (seq - 8)) * NH + h) * 4096;
#pragma unroll
    for (int i = 0; i < 8; ++i) S[i >> 1][i & 1] = KIND == 1 ? st[col * 64 + e0 + i] : st[(e0 + i) * 64 + col];
  }
#pragma unroll
  for (int i = 0; i < 4; ++i) asm volatile("" : "+v"(S[i]));
  ScanPre<KIND> pre;
  __syncthreads();
  if (active) { scan_load<KIND>(P, pre, tid, h, half, R0, T); scan_store<KIND>(pre, tid, buf); }
  __syncthreads();
  const int nchunks = (T + 15) >> 4;
  bf16_t* oraw = WSP(bf16_t, OFF_P);
  for (int c = 0; c < nchunks; ++c) {
    if (active) {
      const int t0 = c * 16, n = (T - t0) < 16 ? (T - t0) : 16;
      const bool has_next = c + 1 < nchunks;
      if (c > 0) {
        const float* pob = obuf + ((c - 1) & 1) * 512;
        {
          const int s = tid >> 4, cc = (tid & 15) * 2;
          const f32x2 ov = *(const f32x2*)(pob + s * 32 + cc);
          *(unsigned*)(oraw + (size_t)(R0 + t0 - 16 + s) * PSTR + ocol + cc) = pk2(ov[0], ov[1]);
        }
      }
      if (has_next) scan_load<KIND>(P, pre, tid, h, half, R0 + t0 + 16, T - t0 - 16);
      const float* b = buf + (c & 1) * NEL;
      float* ob = obuf + (c & 1) * 512;
      if (n == 16) {
        StepOps<KIND> A, B;
        step_load<KIND>(A, b, e0, cl);
#pragma unroll
        for (int s = 0; s < 16; s += 2) {
          step_load<KIND>(B, b + (s + 1) * STRIDE, e0, cl);
          const float o0 = step_compute<KIND>(A, S);
          ob[s * 32 + cl] = o0;
          step_load<KIND>(A, b + (s + 2 < 16 ? s + 2 : 15) * STRIDE, e0, cl);
          const float o1 = step_compute<KIND>(B, S);
          ob[(s + 1) * 32 + cl] = o1;
        }
      } else {
        for (int s = 0; s < n; ++s) {
          StepOps<KIND> A;
          step_load<KIND>(A, b + s * STRIDE, e0, cl);
          const float o0 = step_compute<KIND>(A, S);
          ob[s * 32 + cl] = o0;
        }
      }
      if (has_next) scan_store<KIND>(pre, tid, buf + ((c + 1) & 1) * NEL);
    }
    __syncthreads();
  }
  if (active) {
    {
      const int c = nchunks - 1, t0 = c * 16, n = T - t0;
      const float* pob = obuf + (c & 1) * 512;
      {
        const int s = tid >> 4, cc = (tid & 15) * 2;
        const f32x2 ov = *(const f32x2*)(pob + s * 32 + cc);
        if (s < n) *(unsigned*)(oraw + (size_t)(R0 + t0 + s) * PSTR + ocol + cc) = pk2(ov[0], ov[1]);
      }
    }
    float* so = P.out + (sample ? O_S + ((size_t)(l * 128 + (seq - 8)) * NH + h) * 4096 : O_P + ((size_t)(l * 8 + seq) * NH + h) * 4096);
#pragma unroll
    for (int i = 0; i < 8; ++i) { if (KIND == 1) so[col * 64 + e0 + i] = S[i >> 1][i & 1]; else so[(e0 + i) * 64 + col] = S[i >> 1][i & 1]; }
  }
}

__device__ __forceinline__ void scan_phase(const Params& P, unsigned char* smem, int l, volatile unsigned* blk  ) {
  unsigned* q = WSP(unsigned, OFF_QUEUE) + l * 128;
  const int grp = otid() >> 8;
  for (int pass = 0; pass < 2; ++pass) {
    unsigned* qq = pass == 1 ? q + 64 : q;
    const unsigned ntask = pass == 1 ? 2048u : 256u;
    for (;;) {
      __syncthreads();
      if (threadIdx.x == 0) blk[3] = __hip_atomic_fetch_add(qq, 1u, __ATOMIC_RELAXED, __HIP_MEMORY_SCOPE_AGENT);
      __syncthreads();
      const int t = (int)blk[3];
      if (t >= (int)ntask) break;
      int kind, seq, h, half; bool act; unsigned char* sm;
      if (pass == 0) {
        act = grp == 0; sm = smem; half = t & 1;
        if (t < 96) { kind = 1; const int bh = t >> 1; seq = bh / 6; h = bh % 6; }
        else if (t < 192) { kind = 0; const int bh = (t - 96) >> 1; seq = bh / 6; h = bh % 6; }
        else { kind = 2; const int bh = (t - 192) >> 1; seq = bh / 4; h = bh % 4; }
      } else {
        const int hh = t & 15;
        act = true; sm = smem + grp * 51200; half = grp; seq = 8 + (t >> 4);
        if (hh < 6) { kind = 0; h = hh; } else if (hh < 12) { kind = 1; h = hh - 6; } else { kind = 2; h = hh - 12; }
      }
      if (kind == 0) scan_task<0>(P, sm, l, seq, h, half, act);
      else if (kind == 1) scan_task<1>(P, sm, l, seq, h, half, act);
      else scan_task<2>(P, sm, l, seq, h, half, act);
    }
  }
  if (l + 1 < NLAYER) {
    for (;;) {
      __syncthreads();
      if (threadIdx.x == 0) blk[3] = __hip_atomic_fetch_add(q + 96, 1u, __ATOMIC_RELAXED, __HIP_MEMORY_SCOPE_AGENT);
      __syncthreads();
      const unsigned t = blk[3];
      if (t >= (unsigned)WCONV_JOBS) break;
      wconv_job(P, smem, l + 1, (int)t);
    }
  }
}

__device__ __forceinline__ void post_phase(const Params& P, int l) {
  const int lane = otid() & 63, wid = otid() >> 6, hl = lane >> 5, c2 = (lane & 31) * 2;
  const bf16_t* p = WSP(bf16_t, OFF_P);
  bf16_t* act = WSP(bf16_t, OFF_ACT);
  const int gw = obid() * 8 + wid, nw = gridDim.x * 8;
  const f32x2 gnw = *(const f32x2*)(P.in[I_GNW] + l * 64 + c2), hnw = *(const f32x2*)(P.in[I_HNW] + l * 64 + c2);
  for (int u0 = gw * 8; u0 < NTOK * 10; u0 += nw * 8) {
    unsigned o[4], z[4]; int oc[4]; size_t rb[4];
#pragma unroll
    for (int k = 0; k < 4; ++k) {
      const int u = u0 + 2 * k + hl, row = u / 10, q = u - row * 10;
      oc[k] = q < 6 ? q * 64 : 768 + (q - 6) * 64;
      const int zc = q < 6 ? 1152 + q * 64 : PC + 768 + (q - 6) * 64;
      rb[k] = (size_t)row;
      o[k] = *(const unsigned*)(p + (size_t)row * PSTR + oc[k] + c2);
      z[k] = *(const unsigned*)(p + (size_t)row * PSTR + zc + c2);
    }
#pragma unroll
    for (int k = 0; k < 4; ++k) {
      const float o0 = __uint_as_float(o[k] << 16), o1 = __uint_as_float(o[k] & 0xffff0000u);
      const float z0 = __uint_as_float(z[k] << 16), z1 = __uint_as_float(z[k] & 0xffff0000u);
      const float rn = rsqrtf(half_sum(o0 * o0 + o1 * o1) * (1.f / 64.f) + 1e-6f);
      const f32x2 w = oc[k] < 384 ? gnw : hnw;
      *(unsigned*)(act + rb[k] * 1024 + oc[k] + c2) = pk2(o0 * rn * w[0] * silu(z0), o1 * rn * w[1] * silu(z1));
    }
  }
  for (int u0 = gw * 4; u0 < NTOK * 6; u0 += nw * 4) {
    unsigned o[2], r[2], kx[2], v[2], g[2]; int hh[2]; size_t rb[2];
#pragma unroll
    for (int k = 0; k < 2; ++k) {
      const int u = u0 + 2 * k + hl, row = u / 6, h = u - row * 6;
      const size_t idx = (size_t)row * 384 + h * 64 + c2;
      hh[k] = h; rb[k] = (size_t)row;
      o[k] = *(const unsigned*)(p + (size_t)row * PSTR + 384 + h * 64 + c2);
      r[k] = *(const unsigned*)(WSP(bf16_t, OFF_RR) + idx); kx[k] = *(const unsigned*)(WSP(bf16_t, OFF_RK) + idx);
      v[k] = *(const unsigned*)(WSP(bf16_t, OFF_RV) + idx); g[k] = *(const unsigned*)(WSP(bf16_t, OFF_RG) + idx);
    }
#pragma unroll
    for (int k = 0; k < 2; ++k) {
      const int hc = l * 384 + hh[k] * 64 + c2;
      const f32x2 lw = *(const f32x2*)(P.in[I_LNW] + hc), lb = *(const f32x2*)(P.in[I_LNB] + hc), rkw = *(const f32x2*)(P.in[I_RK] + hc);
      const float o0 = __uint_as_float(o[k] << 16), o1 = __uint_as_float(o[k] & 0xffff0000u);
      const float r0 = __uint_as_float(r[k] << 16), r1 = __uint_as_float(r[k] & 0xffff0000u);
      const float k0 = __uint_as_float(kx[k] << 16), k1 = __uint_as_float(kx[k] & 0xffff0000u);
      const float v0 = __uint_as_float(v[k] << 16), v1 = __uint_as_float(v[k] & 0xffff0000u);
      const float g0 = __uint_as_float(g[k] << 16), g1 = __uint_as_float(g[k] & 0xffff0000u);
      const float mu = half_sum(o0 + o1) * (1.f / 64.f);
      const float y0 = o0 - mu, y1 = o1 - mu;
      const float rn = rsqrtf(half_sum(y0 * y0 + y1 * y1) * (1.f / 64.f) + 64e-5f);
      const float rk = half_sum(r0 * k0 * rkw[0] + r1 * k1 * rkw[1]);
      *(unsigned*)(act + rb[k] * 1024 + 384 + hh[k] * 64 + c2) = pk2((y0 * rn * lw[0] + lb[0] + rk * v0) * g0, (y1 * rn * lw[1] + lb[1] + rk * v1) * g1);
    }
  }
}

#define XB_TMO      128
#define XB_XCNT(j)  (256  + 64 * (j))
#define XB_XSUB(j)  (1280 + 64 * (j))
#define XB_XGEN(j)  (2304 + 64 * (j))
#define XB_TOP      3328
#define XB_TOPGEN   3392
#define XCD_BAR_WORDS 3456
#define XB_SPIN_CAP (1u << 20)
#define LAS __attribute__((address_space(3)))
__device__ __forceinline__ unsigned xb_ld(unsigned* p)              { return __hip_atomic_load(p, __ATOMIC_RELAXED, __HIP_MEMORY_SCOPE_AGENT); }
__device__ __forceinline__ unsigned xb_add(unsigned* p, unsigned v) { return __hip_atomic_fetch_add(p, v, __ATOMIC_RELAXED, __HIP_MEMORY_SCOPE_AGENT); }
__device__ __forceinline__ unsigned xb_xcc_id() { return (unsigned)__builtin_amdgcn_s_getreg((3 << 11) | 20) & 0xFu; }
#define XB_SPIN(cond, bar) do { unsigned _sp = 0; while (cond) { __builtin_amdgcn_s_sleep(1); \
    if ((++_sp & 255u) == 0u) { if (xb_ld(&(bar)[XB_TMO])) break; if (_sp > XB_SPIN_CAP) { atomicAdd(&(bar)[XB_TMO], 1u); break; } } } } while (0)
struct XcdBarrier { unsigned* bar; unsigned x; volatile LAS unsigned* st; };
__device__ __forceinline__ XcdBarrier xcd_barrier_post(unsigned* bar, volatile LAS unsigned* st) {
  XcdBarrier b; b.bar = bar; b.x = xb_xcc_id(); b.st = st;
  if (threadIdx.x == 0) (void)xb_add(&bar[XB_XCNT(b.x)], 1u);
  return b;
}
__device__ __forceinline__ void xcd_barrier_complete(unsigned* bar, unsigned x, unsigned& nloc, unsigned& nx) {
  const unsigned G = gridDim.x * gridDim.y * gridDim.z;
  unsigned sum, cnt, mine, sp = 0u;
  for (;;) {
    sum = 0u; cnt = 0u; mine = 0u;
#pragma unroll
    for (unsigned j = 0; j < 16; ++j) { const unsigned c = xb_ld(&bar[XB_XCNT(j)]); sum += c; cnt += (c > 0u) ? 1u : 0u; mine = (j == x) ? c : mine; }
    if (sum == G) break;
    __builtin_amdgcn_s_sleep(1);
    if ((++sp & 255u) == 0u) { if (xb_ld(&bar[XB_TMO])) break; if (sp > XB_SPIN_CAP) { atomicAdd(&bar[XB_TMO], 1u); break; } }
  }
  nloc = mine > 0u ? mine : 1u; nx = cnt > 0u ? cnt : 1u;
}
__device__ __forceinline__ void xcd_barrier(const XcdBarrier& b) {
  asm volatile("s_waitcnt vmcnt(0)" ::: "memory");
  __syncthreads();
  if (threadIdx.x == 0) {
    unsigned* bar = b.bar;
    __builtin_amdgcn_s_waitcnt(0);
    unsigned nloc = b.st[0], nx = b.st[1];
    if (nloc == 0u) { xcd_barrier_complete(bar, b.x, nloc, nx); b.st[0] = nloc; b.st[1] = nx; }
    const unsigned old = xb_add(&bar[XB_XSUB(b.x)], 1u);
    const unsigned gen = old / nloc;
    if (old + 1u == (gen + 1u) * nloc) {
      __builtin_amdgcn_fence(__ATOMIC_RELEASE, "agent");
      asm volatile("s_waitcnt vmcnt(0)" ::: "memory");
      const unsigned og = xb_add(&bar[XB_TOP], 1u);
      const unsigned tg = og / nx;
      if (og + 1u == (tg + 1u) * nx) xb_add(&bar[XB_TOPGEN], 1u);
      else XB_SPIN(xb_ld(&bar[XB_TOPGEN]) == tg, bar);
      __builtin_amdgcn_fence(__ATOMIC_ACQUIRE, "agent");
      xb_add(&bar[XB_XGEN(b.x)], 1u);
      asm volatile("s_waitcnt vmcnt(0)" ::: "memory");
    } else {
      XB_SPIN(xb_ld(&bar[XB_XGEN(b.x)]) == gen, bar);
      __builtin_amdgcn_fence(__ATOMIC_ACQUIRE, "agent");
      asm volatile("s_waitcnt vmcnt(0)" ::: "memory");
    }
  }
  __syncthreads();
}

__global__ void __launch_bounds__(512, 2) hybrid_fwd(Params P) {
  cg::grid_group grid = cg::this_grid();
  __shared__ __attribute__((aligned(16))) unsigned char smem[131072 + 64];
  uint4& xb_words = *(uint4*)(smem + 131072);
  if (threadIdx.x == 0) xb_words = make_uint4(0u, 0u, 0u, 0u);
  __syncthreads();
  const XcdBarrier xb = xcd_barrier_post(WSP(unsigned, OFF_BAR), (volatile LAS unsigned*)&xb_words);
  if (threadIdx.x == 0) {
    const unsigned hw = (unsigned)__builtin_amdgcn_s_getreg((7 << 11) | (8 << 6) | 4) & 0xffu;
    const unsigned key = (xb.x << 8) | hw;
    ((volatile unsigned*)&xb_words)[2] = __hip_atomic_fetch_add(WSP(unsigned, OFF_CUTAB) + key, 1u, __ATOMIC_RELAXED, __HIP_MEMORY_SCOPE_AGENT);
  }
  __syncthreads();
#pragma unroll 1
  for (int step = 0; step < NLAYER * 9; ++step) {
    const int l = step / 9, ph = step - l * 9;
    switch (ph) {
      case 0: if (l == 0) wconv_phase(P, smem, 0); norm_phase(P, l, P.in[I_NORM_MIX] + l * D); break;
      case 1: gemm_phase<EPI_P>(P, smem, WSP(bf16_t, OFF_ACT), 1024, WSP(bf16_t, OFF_WTIN), 1024, 32, l, 4096);
              gemm_sample<EPI_P>(P, smem, WSP(bf16_t, OFF_ACT), 1024, WSP(bf16_t, OFF_WTIN), 1024, 249, l); break;
      case 2: prep_phase(P, smem, l); break;
      case 3: scan_phase(P, smem, l, (volatile unsigned*)&xb_words); break;
      case 4: post_phase(P, l); break;
      case 5: gemm_phase<EPI_RES>(P, smem, WSP(bf16_t, OFF_ACT), 1024, WSP(bf16_t, wt_out_off(l)), 1024, 8, l, 1024);
              gemm_sample<EPI_RES>(P, smem, WSP(bf16_t, OFF_ACT), 1024, WSP(bf16_t, wt_out_off(l)), 1024, 64, l); break;
      case 6: norm_phase(P, 1, P.in[I_NORM_FFN] + l * D); break;
      case 7: gemm_phase<EPI_SWIGLU>(P, smem, WSP(bf16_t, OFF_ACT), 1024, WSP(bf16_t, wt_gu_off(l)), 1024, 44, 1, 5632);
              gemm_sample<EPI_SWIGLU>(P, smem, WSP(bf16_t, OFF_ACT), 1024, WSP(bf16_t, wt_gu_off(l)), 1024, 176, 1); break;
      default: gemm_phase<EPI_RES>(P, smem, WSP(bf16_t, OFF_P), DFF, WSP(bf16_t, wt_dn_off(l)), DFF, 8, 1, 1024);
               gemm_sample<EPI_RES>(P, smem, WSP(bf16_t, OFF_P), DFF, WSP(bf16_t, wt_dn_off(l)), DFF, 64, 1); break;
    }
    if (step == 0) grid.sync();
    else xcd_barrier(xb);
  }
  final_norm_phase(P);
}

extern "C" void kernel_launch(void* const* d_in, const int* in_sizes, int n_in,
                              void* d_out, int out_size, void* d_ws, size_t ws_size,
                              hipStream_t stream) {
  static int grid_blocks = 0;
  if (!grid_blocks) {
    int dev = 0, cus = 0, per_cu = 0;
    (void)hipGetDevice(&dev);
    (void)hipDeviceGetAttribute(&cus, hipDeviceAttributeMultiprocessorCount, dev);
    (void)hipOccupancyMaxActiveBlocksPerMultiprocessor(&per_cu, hybrid_fwd, 512, 0);
    if (per_cu > 1) per_cu = 1;
    if (per_cu < 1) per_cu = 1;
    grid_blocks = cus * per_cu;
  }
  if (ws_size < WS_NEED) { fprintf(stderr, "workspace too small: %zu < %zu\n", ws_size, (size_t)WS_NEED); return; }
  Params p{};
  for (int i = 0; i < N_IN; ++i) p.in[i] = (const float*)d_in[i];
  p.out = (float*)d_out;
  p.ws = (unsigned char*)d_ws;
  (void)hipMemsetAsync((unsigned char*)d_ws + OFF_BAR, 0, BAR_BYTES, stream);
  void* args[] = {&p};
  hipError_t e = hipLaunchCooperativeKernel((void*)hybrid_fwd, dim3(grid_blocks), dim3(512), args, 0, stream);
  if (e != hipSuccess) fprintf(stderr, "cooperative launch failed: %s (grid %d)\n", hipGetErrorString(e), grid_blocks);
}
```

```cpp
#include <hip/hip_runtime.h>
#include <hip/hip_cooperative_groups.h>
#include <cstdio>
namespace cg = cooperative_groups;

typedef unsigned short bf16_t;
typedef short bf16x8 __attribute__((ext_vector_type(8)));
typedef float f32x4 __attribute__((ext_vector_type(4)));
typedef unsigned u32x4 __attribute__((ext_vector_type(4)));
typedef unsigned u32x2 __attribute__((ext_vector_type(2)));

constexpr int D = 1024, NTP = 16384, NTS = 128, NTOK = 16512, TSEQ = 2048, NLAYER = 4;
constexpr int IN_COLS = 3980, PSTR = 3984, DFF = 2816;
constexpr int PB = 1548, PC = 2956;

enum { I_XP = 0, I_XS, I_SGDN, I_SCONV, I_SRWKV, I_SSHIFT, I_SHGRN, I_NORM_MIX, I_WIN, I_WOUT, I_CONVW, I_ALOG, I_DTB, I_GNW,
       I_MU, I_W0, I_W2, I_A0, I_A2, I_G2, I_V0, I_V1, I_V2, I_KK, I_KA, I_RK, I_LNW, I_LNB, I_HLB, I_HNW, I_NORM_FFN,
       I_WG, I_WU, I_WD, I_NORM_FINAL, N_IN };

constexpr size_t O_YP = 0, O_YS = 16777216, O_GDN_P = 16908288, O_GDN_S = 17694720, O_CONV_P = 30277632, O_CONV_S = 30388224,
                 O_RWKV_P = 32157696, O_RWKV_S = 32944128, O_SHIFT_P = 45527040, O_SHIFT_S = 45572096, O_HGRN_P = 46292992,
                 O_HGRN_S = 46817280;

constexpr size_t SZ_WTIN = (size_t)4096 * 1024 * 2, SZ_WTOUT = (size_t)1024 * 1024 * 2, SZ_WTGU = (size_t)5632 * 1024 * 2,
                 SZ_WTDN = (size_t)1024 * 2816 * 2, SZ_P = (size_t)NTOK * PSTR * 2, SZ_ACT = (size_t)NTOK * 1024 * 2,
                 SZ_T384 = (size_t)NTOK * 384 * 2, SZ_T8F = (size_t)NTOK * 8 * 4, SZ_T256 = (size_t)NTOK * 256 * 2,
                 SZ_T384F = (size_t)NTOK * 384 * 4;
constexpr size_t OFF_WTIN = 0, OFF_WTOUT = OFF_WTIN + SZ_WTIN, OFF_WTGU = OFF_WTOUT + SZ_WTOUT, OFF_WTDN = OFF_WTGU + SZ_WTGU,
                 OFF_P = OFF_WTDN + SZ_WTDN, OFF_ACT = OFF_P + SZ_P, OFF_GQ = OFF_ACT + SZ_ACT, OFF_GK = OFF_GQ + SZ_T384,
                 OFF_GV = OFF_GK + SZ_T384, OFF_GDEC = OFF_GV + SZ_T384, OFF_GBETA = OFF_GDEC + SZ_T8F, OFF_HQ = OFF_GBETA + SZ_T8F,
                 OFF_HK = OFF_HQ + SZ_T256, OFF_RR = OFF_HK + SZ_T256, OFF_RK = OFF_RR + SZ_T384, OFF_RV = OFF_RK + SZ_T384,
                 OFF_RKK = OFF_RV + SZ_T384, OFF_RB = OFF_RKK + SZ_T384, OFF_RG = OFF_RB + SZ_T384, OFF_RW = OFF_RG + SZ_T384,
                 OFF_VF = OFF_RW + SZ_T384F, OFF_LORA = OFF_VF + SZ_T384, OFF_WTOUT2 = OFF_LORA + 245760, OFF_WTGU2 = OFF_WTOUT2 + SZ_WTOUT, OFF_WTDN2 = OFF_WTGU2 + SZ_WTGU, OFF_BAR = OFF_WTDN2 + SZ_WTDN, OFF_CUTAB = OFF_BAR + 16384, OFF_QUEUE = OFF_CUTAB + 16384, BAR_BYTES = 16384 + 16384 + 4096, WS_NEED = OFF_BAR + BAR_BYTES;
constexpr int W2T = 0, A2T = 24576, G2T = 49152, V1T = 98304, V2T = 110592;

struct Params {
  const float* in[N_IN];
  float* out;
  unsigned char* ws;
};

#define WSP(T, off) ((T*)(P.ws + (off)))

__device__ __forceinline__ int otid() { int t = __builtin_amdgcn_workitem_id_x(); asm volatile("" : "+v"(t)); return t; }
__device__ __forceinline__ int obid() { int b = __builtin_amdgcn_workgroup_id_x(); asm volatile("" : "+s"(b)); return b; }
template <class T> __device__ __forceinline__ const T* opq(const T* p) { asm volatile("" : "+s"(p)); return p; }
__device__ __forceinline__ float bf2f(bf16_t h) { return __uint_as_float(((unsigned)h) << 16); }
typedef float f32x2_t __attribute__((ext_vector_type(2)));
typedef __bf16 bf16x2_t __attribute__((ext_vector_type(2)));
__device__ __forceinline__ unsigned pk2(float lo, float hi) {
  const f32x2_t v = {lo, hi};
  return __builtin_bit_cast(unsigned, __builtin_convertvector(v, bf16x2_t));
}
__device__ __forceinline__ bf16_t f2bf(float f) { return (bf16_t)(pk2(f, 0.f) & 0xffffu); }
__device__ __forceinline__ float sigm(float x) { return 1.f / (1.f + __expf(-x)); }
__device__ __forceinline__ float silu(float x) { return x / (1.f + __expf(-x)); }
__device__ __forceinline__ float softplus(float x) { return x > 20.f ? x : log1pf(__expf(x)); }
template <int CTRL> __device__ __forceinline__ float dppf(float x) {
  return __builtin_bit_cast(float, __builtin_amdgcn_mov_dpp(__builtin_bit_cast(int, x), CTRL, 0xf, 0xf, true));
}
__device__ __forceinline__ float wave_sum(float v) {
  v += dppf<0xB1>(v); v += dppf<0x4E>(v); v += dppf<0x141>(v); v += dppf<0x140>(v);
  const int iv = __builtin_bit_cast(int, v);
  const float s0 = __builtin_bit_cast(float, __builtin_amdgcn_readlane(iv, 0)), s1 = __builtin_bit_cast(float, __builtin_amdgcn_readlane(iv, 16));
  const float s2 = __builtin_bit_cast(float, __builtin_amdgcn_readlane(iv, 32)), s3 = __builtin_bit_cast(float, __builtin_amdgcn_readlane(iv, 48));
  return (s0 + s1) + (s2 + s3);
}
typedef float f32x2 __attribute__((ext_vector_type(2)));
__device__ __forceinline__ float row_sum16(float v) { v += dppf<0xB1>(v); v += dppf<0x4E>(v); v += dppf<0x141>(v); v += dppf<0x140>(v); return v; }
__device__ __forceinline__ float half_sum(float v) { v = row_sum16(v); return v + __shfl_xor(v, 16); }
__device__ __forceinline__ float reduce8(float x) { x += dppf<0xB1>(x); x += dppf<0x4E>(x); x += dppf<0x141>(x); return x; }

__device__ __forceinline__ f32x4 unpack4(u32x2 w) {
  f32x4 f; f[0] = __uint_as_float(w[0] << 16); f[1] = __uint_as_float(w[0] & 0xffff0000u);
  f[2] = __uint_as_float(w[1] << 16); f[3] = __uint_as_float(w[1] & 0xffff0000u); return f;
}
__device__ __forceinline__ bf16x8 pack8(f32x4 a, f32x4 b) {
  u32x4 u; u[0] = pk2(a[0], a[1]); u[1] = pk2(a[2], a[3]); u[2] = pk2(b[0], b[1]); u[3] = pk2(b[2], b[3]);
  return __builtin_bit_cast(bf16x8, u);
}
__device__ __forceinline__ u32x2 pack4(f32x4 a) { u32x2 u; u[0] = pk2(a[0], a[1]); u[1] = pk2(a[2], a[3]); return u; }
__device__ __forceinline__ float dot4(f32x4 a, f32x4 b) { return (a[0] * b[0] + a[1] * b[1]) + (a[2] * b[2] + a[3] * b[3]); }
__device__ __forceinline__ const float* xin_row(const Params& P, int l, int row) {
  const float* po = opq((const float*)P.out); const float* pp = opq(P.in[I_XP]); const float* ps = opq(P.in[I_XS]);
  if (l > 0) return po + (size_t)row * D;
  return row < NTP ? pp + (size_t)row * D : ps + (size_t)(row - NTP) * D;
}

__device__ __forceinline__ int gu_row(int c, int up) { return (c >> 7) * 256 + up * 128 + (c & 127); }
__device__ __forceinline__ void xpose_tile(unsigned char* smem, const float* __restrict__ W, int N, int kt, int ntl, bf16_t* __restrict__ dst, int dstK, int mode) {
  float (*tile)[65] = (float (*)[65])smem;
  const int tid = otid();
  __syncthreads();
#pragma unroll 4
  for (int i = 0; i < 8; ++i) {
    const int k = i * 8 + (tid >> 6), n = tid & 63, gn = ntl * 64 + n;
    tile[k][n] = gn < N ? W[(size_t)(kt * 64 + k) * N + gn] : 0.f;
  }
  __syncthreads();
#pragma unroll 4
  for (int i = 0; i < 4; ++i) {
    const int n = i * 16 + (tid >> 5), k = (tid & 31) * 2, gn = ntl * 64 + n;
    const int drow = mode == 0 ? gn : gu_row(gn, mode - 1);
    *(unsigned*)(dst + (size_t)drow * dstK + kt * 64 + k) = pk2(tile[k][n], tile[k + 1][n]);
  }
}
constexpr int WCONV_JOBS = 3392 + 480;
__device__ __forceinline__ size_t wt_out_off(int l) { return (l & 1) ? OFF_WTOUT2 : OFF_WTOUT; }
__device__ __forceinline__ size_t wt_gu_off(int l) { return (l & 1) ? OFF_WTGU2 : OFF_WTGU; }
__device__ __forceinline__ size_t wt_dn_off(int l) { return (l & 1) ? OFF_WTDN2 : OFF_WTDN; }
__device__ __forceinline__ void wconv_job(const Params& P, unsigned char* smem, int l, int job) {
  if (job < 1024) xpose_tile(smem, P.in[I_WIN] + (size_t)l * 1024 * IN_COLS, IN_COLS, job & 15, job >> 4, WSP(bf16_t, OFF_WTIN), 1024, 0);
  else if (job < 1280) { const int j = job - 1024; xpose_tile(smem, P.in[I_WOUT] + (size_t)l * 1024 * 1024, 1024, j & 15, j >> 4, WSP(bf16_t, wt_out_off(l)), 1024, 0); }
  else if (job < 1984) { const int j = job - 1280; xpose_tile(smem, P.in[I_WG] + (size_t)l * 1024 * DFF, DFF, j & 15, j >> 4, WSP(bf16_t, wt_gu_off(l)), 1024, 1); }
  else if (job < 2688) { const int j = job - 1984; xpose_tile(smem, P.in[I_WU] + (size_t)l * 1024 * DFF, DFF, j & 15, j >> 4, WSP(bf16_t, wt_gu_off(l)), 1024, 2); }
  else if (job < 3392) { const int j = job - 2688; xpose_tile(smem, P.in[I_WD] + (size_t)l * DFF * 1024, 1024, j % 44, j / 44, WSP(bf16_t, wt_dn_off(l)), DFF, 0); }
  else {
    bf16_t* lw = WSP(bf16_t, OFF_LORA);
    const int idx = (job - 3392) * 256 + (otid() & 255);
    float v = 0.f;
    const float* pw2 = opq(P.in[I_W2]); const float* pa2 = opq(P.in[I_A2]); const float* pg2 = opq(P.in[I_G2]);
    const float* pv1 = opq(P.in[I_V1]); const float* pv2 = opq(P.in[I_V2]);
    if (idx < A2T) { const int n = idx >> 6, k = idx & 63; v = pw2[(size_t)l * 64 * 384 + k * 384 + n]; }
    else if (idx < G2T) { const int i = idx - A2T, n = i >> 6, k = i & 63; v = pa2[(size_t)l * 64 * 384 + k * 384 + n]; }
    else if (idx < V1T) { const int i = idx - G2T, n = i >> 7, k = i & 127; v = pg2[(size_t)l * 128 * 384 + k * 384 + n]; }
    else if (idx < V2T) { if (l > 0) { const int i = idx - V1T, n = i / 384, k = i - n * 384; v = pv1[(size_t)(l - 1) * 384 * 32 + k * 32 + n]; } }
    else { if (l > 0) { const int i = idx - V2T, n = i >> 5, k = i & 31; v = pv2[(size_t)(l - 1) * 32 * 384 + k * 384 + n]; } }
    if (otid() < 256) lw[idx] = f2bf(v);
  }
}
__device__ __forceinline__ void wconv_phase(const Params& P, unsigned char* smem, int l) {
  for (int j = obid(); j < 1024 + 480; j += gridDim.x) wconv_job(P, smem, l, j < 1024 ? j : j + 2368);
}

__device__ __forceinline__ void norm_phase(const Params& P, int l_in, const float* __restrict__ w) {
  bf16_t* act = WSP(bf16_t, OFF_ACT);
  const int lane = otid() & 63, wid = otid() >> 6;
  f32x4 wv[4];
#pragma unroll
  for (int i = 0; i < 4; ++i) wv[i] = *(const f32x4*)(w + i * 256 + lane * 4);
  for (int r0 = (obid() * 8 + wid) * 4; r0 < NTOK; r0 += gridDim.x * 32) {
    f32x4 v[4][4];
#pragma unroll
    for (int r = 0; r < 4; ++r) {
      const float* xr = xin_row(P, l_in, r0 + r);
#pragma unroll
      for (int i = 0; i < 4; ++i) v[r][i] = *(const f32x4*)(xr + i * 256 + lane * 4);
    }
#pragma unroll
    for (int r = 0; r < 4; ++r) {
      float ss = 0.f;
#pragma unroll
      for (int i = 0; i < 4; ++i) ss += dot4(v[r][i], v[r][i]);
      const float rstd = rsqrtf(wave_sum(ss) * (1.f / 1024.f) + 1e-6f);
#pragma unroll
      for (int i = 0; i < 4; ++i) *(u32x2*)(act + (size_t)(r0 + r) * 1024 + i * 256 + lane * 4) = pack4(v[r][i] * rstd * wv[i]);
    }
  }
}
__device__ __forceinline__ void final_norm_phase(const Params& P) {
  const float* w = P.in[I_NORM_FINAL];
  const int lane = otid() & 63, wid = otid() >> 6;
  f32x4 wv[4];
#pragma unroll
  for (int i = 0; i < 4; ++i) wv[i] = *(const f32x4*)(w + i * 256 + lane * 4);
  for (int r0 = (obid() * 8 + wid) * 4; r0 < NTOK; r0 += gridDim.x * 32) {
    f32x4 v[4][4];
#pragma unroll
    for (int r = 0; r < 4; ++r)
#pragma unroll
      for (int i = 0; i < 4; ++i) v[r][i] = *(const f32x4*)(P.out + (size_t)(r0 + r) * D + i * 256 + lane * 4);
#pragma unroll
    for (int r = 0; r < 4; ++r) {
      float ss = 0.f;
#pragma unroll
      for (int i = 0; i < 4; ++i) ss += dot4(v[r][i], v[r][i]);
      const float rstd = rsqrtf(wave_sum(ss) * (1.f / 1024.f) + 1e-6f);
#pragma unroll
      for (int i = 0; i < 4; ++i) *(f32x4*)(P.out + (size_t)(r0 + r) * D + i * 256 + lane * 4) = v[r][i] * rstd * wv[i];
    }
  }
}

enum { EPI_P = 0, EPI_RES = 1, EPI_SWIGLU = 2 };
namespace pg8 {
constexpr int BM = 256, BK = 64, HALF = 128, HTB = HALF * BK * 2, NXCD = 8, WGM = 8;
__device__ __forceinline__ int lds_byte(int r, int c) { const int st = (r >> 4) * 2 + (c >> 5), rr = r & 15, cc = c & 31, ob = rr * 64 + cc * 2; return st * 1024 + (ob ^ (((ob >> 9) & 1) << 5)); }
__device__ __forceinline__ void stage_rc(int b, int& R, int& C) { const int st = b / 1024, sb = b % 1024, swz = sb ^ (((sb >> 9) & 1) << 5); R = (st >> 1) * 16 + swz / 64; C = (st & 1) * 32 + (swz % 64) / 2; }
__device__ __forceinline__ int perm32(int rho) { const int n = rho >> 4, i = rho & 15; return 8 * (i >> 2) + 4 * n + (i & 3); }
struct Unit { int pm, pn; };
struct StaticOrder {
  int nM, nN, nwg, G, c;
  __device__ __forceinline__ void init(int M, int N, int G_, int c_) { nM = M / BM; nN = N / BM; nwg = nM * nN; G = G_; c = c_; }
  __device__ __forceinline__ bool next(int i, Unit& u) const {
    const long L = (long)i * G + c; if (L >= nwg) return false;
    int wgid = (int)L; { const int q = nwg / NXCD, r = nwg % NXCD, xcd = wgid % NXCD, off = wgid / NXCD; wgid = (xcd < r ? xcd * (q + 1) : r * (q + 1) + (xcd - r) * q) + off; }
    const int nig = WGM * nN, gid = wgid / nig, fm = gid * WGM, gsz = (nM - fm) < WGM ? (nM - fm) : WGM;
    u.pm = fm + ((wgid % nig) % gsz); u.pn = (wgid % nig) / gsz; return true;
  }
};
}

template <int EPI>
__device__ __forceinline__ void gemm_epilogue(const Params& P, const f32x4 (&acc)[2][2][4][2], const pg8::Unit& u, int wr, int wc, int fr, int fq, int l) {
#pragma unroll
  for (int ai = 0; ai < 2; ++ai)
#pragma unroll
    for (int m = 0; m < 4; ++m) {
      const int row = u.pm * 256 + ai * 128 + wr * 64 + m * 16 + fr;
      if (EPI == EPI_P) {
        bf16_t* pr = WSP(bf16_t, OFF_P) + (size_t)row * PSTR;
#pragma unroll
        for (int bj = 0; bj < 2; ++bj) {
          const int col = u.pn * 256 + bj * 128 + wc * 32 + fq * 8;
          if (col < PSTR) { const u32x2 lo = pack4(acc[ai][bj][m][0]), hi = pack4(acc[ai][bj][m][1]); *(u32x4*)(pr + col) = (u32x4){lo[0], lo[1], hi[0], hi[1]}; }
        }
      } else if (EPI == EPI_RES) {
        const float* xi = xin_row(P, l, row);
        float* xo = P.out + (size_t)row * D;
#pragma unroll
        for (int bj = 0; bj < 2; ++bj)
#pragma unroll
          for (int n = 0; n < 2; ++n) {
            const int col = u.pn * 256 + bj * 128 + wc * 32 + n * 16 + fq * 4;
            *(f32x4*)(xo + col) = *(const f32x4*)(xi + col) + acc[ai][bj][m][n];
          }
      } else {
        bf16_t* ur = WSP(bf16_t, OFF_P) + (size_t)row * DFF;
        {
          const int col = u.pn * 128 + wc * 32 + fq * 8;
          f32x4 r0, r1;
#pragma unroll
          for (int j = 0; j < 4; ++j) { r0[j] = silu(acc[ai][0][m][0][j]) * acc[ai][1][m][0][j]; r1[j] = silu(acc[ai][0][m][1][j]) * acc[ai][1][m][1][j]; }
          const u32x2 lo = pack4(r0), hi = pack4(r1);
          *(u32x4*)(ur + col) = (u32x4){lo[0], lo[1], hi[0], hi[1]};
        }
      }
    }
}

#define PG8_LAS __attribute__((address_space(3)))
template <int EPI>
__device__ __forceinline__ void gemm_phase(const Params& P, unsigned char* smem, const bf16_t* __restrict__ Ag, int lda_unused, const bf16_t* __restrict__ Btg, int K, int nN128_unused, int l, int N) {
  using namespace pg8;
  PG8_LAS unsigned char* lds = (PG8_LAS unsigned char*)smem;
  const int tid = otid(), wid = __builtin_amdgcn_readfirstlane(tid >> 6), lane = tid & 63, wr = wid >> 2, wc = wid & 3, fr = lane & 15, fq = lane >> 4;
  const int nt = K / BK;
  StaticOrder S; S.init(NTP, N, (int)gridDim.x, obid());
  unsigned voffA[2], voffB[2];
#pragma unroll
  for (int i = 0; i < 2; ++i) { int R, C; stage_rc(tid * 16 + i * 8192, R, C); const int Rb = EPI == EPI_RES ? R : ((R & ~31) + perm32(R & 31));
    voffA[i] = (unsigned)(R * K + C) * 2u; voffB[i] = (unsigned)(Rb * K + C) * 2u; }
  const size_t kstep = (size_t)(BK * 2);
  const size_t hstep = (size_t)HALF * K * 2;
  const size_t tstep = 2 * hstep;
  const unsigned ldsw = (unsigned)wid * 1024u;
  const int aoff = lds_byte(wr * 64 + fr, fq * 8), boff = lds_byte(wc * 32 + fr, fq * 8);
#define PG8_SA(b, h) (((b) * 2 + (h)) * HTB)
#define PG8_SB(b, h) ((4 + (b) * 2 + (h)) * HTB)
#define PG8_STAGE(bufoff, gbase, voff) do { _Pragma("unroll") for (int _i = 0; _i < 2; ++_i) \
        __builtin_amdgcn_global_load_lds((const unsigned*)((const char*)(gbase) + (voff)[_i]), (PG8_LAS unsigned*)(lds + (bufoff) + ldsw + _i * 8192), 16, 0, 0); } while (0)
#define PG8_LDA(dst, b, h) do { _Pragma("unroll") for (int m = 0; m < 4; ++m) _Pragma("unroll") for (int k = 0; k < 2; ++k) dst[m][k] = *(const PG8_LAS bf16x8*)(lds + PG8_SA(b, h) + aoff + m * 2048 + k * 1024); } while (0)
#define PG8_LDB(dst, b, h) do { _Pragma("unroll") for (int n = 0; n < 2; ++n) _Pragma("unroll") for (int k = 0; k < 2; ++k) dst[n][k] = *(const PG8_LAS bf16x8*)(lds + PG8_SB(b, h) + boff + n * 2048 + k * 1024); } while (0)
#define PG8_MMA(ai, bj, At, Bt) do { __builtin_amdgcn_s_setprio(1); _Pragma("unroll") for (int m = 0; m < 4; ++m) _Pragma("unroll") for (int n = 0; n < 2; ++n) _Pragma("unroll") for (int k = 0; k < 2; ++k) \
        acc[ai][bj][m][n] = __builtin_amdgcn_mfma_f32_16x16x32_bf16(Bt[n][k], At[m][k], acc[ai][bj][m][n], 0, 0, 0); __builtin_amdgcn_s_setprio(0); } while (0)
#define PG8_WAIT_V(n) asm volatile("s_waitcnt vmcnt(" #n ")" ::: "memory")
#define PG8_WAIT_L(n) asm volatile("s_waitcnt lgkmcnt(" #n ")" ::: "memory")
#define PG8_BAR __builtin_amdgcn_s_barrier()
#define PG8_SCHED __builtin_amdgcn_sched_barrier(0)
  Unit cur, nxt; int ui = 0;
  if (!S.next(0, cur)) return;
  f32x4 acc[2][2][4][2];
#pragma unroll
  for (int a = 0; a < 2; ++a)
#pragma unroll
    for (int b = 0; b < 2; ++b)
#pragma unroll
      for (int m = 0; m < 4; ++m)
#pragma unroll
        for (int n = 0; n < 2; ++n) acc[a][b][m][n] = (f32x4){0.f, 0.f, 0.f, 0.f};
  bf16x8 At[4][2], B0[2][2], B1[2][2];
  const char* cA = (const char*)Ag + (size_t)cur.pm * tstep; const char* cB = (const char*)Btg + (size_t)cur.pn * tstep;
  PG8_STAGE(PG8_SB(0, 0), cB, voffB); PG8_STAGE(PG8_SA(0, 0), cA, voffA); PG8_STAGE(PG8_SB(0, 1), cB + hstep, voffB); PG8_STAGE(PG8_SA(0, 1), cA + hstep, voffA);
  if (wr == 1) PG8_BAR;
  PG8_WAIT_V(4); PG8_BAR;
  PG8_STAGE(PG8_SB(1, 0), cB + kstep, voffB); PG8_STAGE(PG8_SA(1, 0), cA + kstep, voffA); PG8_STAGE(PG8_SB(1, 1), cB + hstep + kstep, voffB);
  PG8_WAIT_V(6); PG8_BAR;
  for (;;) {
    const bool has_next = S.next(ui + 1, nxt);
    const char* nA = has_next ? (const char*)Ag + (size_t)nxt.pm * tstep : cA; const char* nB = has_next ? (const char*)Btg + (size_t)nxt.pn * tstep : cB;
    for (int t = 0; t < nt; t += 2) {
      const bool last = (t == nt - 2);
      const char* a1 = cA + (size_t)(t + 1) * kstep;
      const char* a2 = last ? nA : cA + (size_t)(t + 2) * kstep; const char* b2 = last ? nB : cB + (size_t)(t + 2) * kstep;
      const char* a3 = a2 + kstep; const char* b3 = b2 + kstep;
      PG8_LDB(B0, 0, 0); PG8_SCHED; PG8_LDA(At, 0, 0); PG8_STAGE(PG8_SA(1, 1), a1 + hstep, voffA);
      PG8_WAIT_L(8); PG8_BAR; PG8_WAIT_L(0); PG8_MMA(0, 0, At, B0); PG8_BAR; PG8_SCHED;
      PG8_LDB(B1, 0, 1); PG8_STAGE(PG8_SB(0, 0), b2, voffB);
      PG8_BAR; PG8_WAIT_L(0); PG8_MMA(0, 1, At, B1); PG8_BAR;
      PG8_LDA(At, 0, 1); PG8_STAGE(PG8_SA(0, 0), a2, voffA);
      PG8_BAR; PG8_WAIT_L(0); PG8_MMA(1, 0, At, B0); PG8_BAR; PG8_SCHED;
      PG8_STAGE(PG8_SB(0, 1), b2 + hstep, voffB);
      PG8_WAIT_V(6); PG8_BAR; PG8_MMA(1, 1, At, B1); PG8_BAR;
      PG8_LDB(B0, 1, 0); PG8_SCHED; PG8_LDA(At, 1, 0); PG8_STAGE(PG8_SA(0, 1), a2 + hstep, voffA);
      PG8_WAIT_L(8); PG8_BAR; PG8_WAIT_L(0); PG8_MMA(0, 0, At, B0); PG8_BAR; PG8_SCHED;
      PG8_LDB(B1, 1, 1); PG8_STAGE(PG8_SB(1, 0), b3, voffB);
      PG8_BAR; PG8_WAIT_L(0); PG8_MMA(0, 1, At, B1); PG8_BAR;
      PG8_LDA(At, 1, 1); PG8_STAGE(PG8_SA(1, 0), a3, voffA);
      PG8_BAR; PG8_WAIT_L(0); PG8_MMA(1, 0, At, B0); PG8_BAR; PG8_SCHED;
      PG8_STAGE(PG8_SB(1, 1), b3 + hstep, voffB);
      PG8_WAIT_V(6); PG8_BAR; PG8_MMA(1, 1, At, B1); PG8_BAR;
    }
    gemm_epilogue<EPI>(P, acc, cur, wr, wc, fr, fq, l);
    if (!has_next) break;
#pragma unroll
    for (int a = 0; a < 2; ++a)
#pragma unroll
      for (int b = 0; b < 2; ++b)
#pragma unroll
        for (int m = 0; m < 4; ++m)
#pragma unroll
          for (int n = 0; n < 2; ++n) acc[a][b][m][n] = (f32x4){0.f, 0.f, 0.f, 0.f};
    cur = nxt; cA = nA; cB = nB; ++ui;
  }
  PG8_WAIT_V(0);
  if (wr == 0) PG8_BAR;
  PG8_BAR;
#undef PG8_SA
#undef PG8_SB
#undef PG8_STAGE
#undef PG8_LDA
#undef PG8_LDB
#undef PG8_MMA
#undef PG8_WAIT_V
#undef PG8_WAIT_L
#undef PG8_BAR
#undef PG8_SCHED
}

template <int EPI>
__device__ __forceinline__ void gemm_sample(const Params& P, unsigned char* smem, const bf16_t* __restrict__ A, int lda, const bf16_t* __restrict__ Bt, int K, int nunits, int l) {
  const int tid = otid(), lane = tid & 63, wid = tid >> 6, fr = lane & 15, fq = lane >> 4;
  const int kslice = K >> 3;
  for (int u = (int)gridDim.x - 1 - obid(); u < nunits; u += gridDim.x) {
    const int brow0 = EPI == EPI_SWIGLU ? gu_row(u * 16 + fr, 0) : u * 16 + fr;
    const int brow1 = EPI == EPI_SWIGLU ? gu_row(u * 16 + fr, 1) : 0;
    const bf16_t* ap = A + (size_t)(NTP + fr) * lda + wid * kslice + fq * 8;
    const bf16_t* b0p = Bt + (size_t)brow0 * K + wid * kslice + fq * 8;
    const bf16_t* b1p = Bt + (size_t)brow1 * K + wid * kslice + fq * 8;
    f32x4 c0[8], c1[8];
#pragma unroll
    for (int m = 0; m < 8; ++m) { c0[m] = (f32x4){0.f, 0.f, 0.f, 0.f}; c1[m] = c0[m]; }
#pragma unroll 2
    for (int ks = 0; ks < kslice; ks += 32) {
      bf16x8 Af[8];
#pragma unroll
      for (int m = 0; m < 8; ++m) Af[m] = *(const bf16x8*)(ap + (size_t)m * 16 * lda + ks);
      const bf16x8 B0 = *(const bf16x8*)(b0p + ks);
      bf16x8 B1 = B0;
      if (EPI == EPI_SWIGLU) B1 = *(const bf16x8*)(b1p + ks);
#pragma unroll
      for (int m = 0; m < 8; ++m) {
        c0[m] = __builtin_amdgcn_mfma_f32_16x16x32_bf16(B0, Af[m], c0[m], 0, 0, 0);
        if (EPI == EPI_SWIGLU) c1[m] = __builtin_amdgcn_mfma_f32_16x16x32_bf16(B1, Af[m], c1[m], 0, 0, 0);
      }
    }
    __syncthreads();
#pragma unroll
    for (int m = 0; m < 8; ++m) {
      *(f32x4*)(smem + ((wid * 8 + m) * 64 + lane) * 16) = c0[m];
      if (EPI == EPI_SWIGLU) *(f32x4*)(smem + 65536 + ((wid * 8 + m) * 64 + lane) * 16) = c1[m];
    }
    __syncthreads();
    f32x4 g = (f32x4){0.f, 0.f, 0.f, 0.f}, up = g;
#pragma unroll
    for (int w = 0; w < 8; ++w) {
      g += *(const f32x4*)(smem + ((w * 8 + wid) * 64 + lane) * 16);
      if (EPI == EPI_SWIGLU) up += *(const f32x4*)(smem + 65536 + ((w * 8 + wid) * 64 + lane) * 16);
    }
    {
      const int row = NTP + wid * 16 + fr, col = u * 16 + fq * 4;
      if (EPI == EPI_P) {
        if (col < IN_COLS) *(u32x2*)(WSP(bf16_t, OFF_P) + (size_t)row * PSTR + col) = pack4(g);
      } else if (EPI == EPI_RES) {
        const float* xi = xin_row(P, l, row);
        *(f32x4*)(P.out + (size_t)row * D + col) = *(const f32x4*)(xi + col) + g;
      } else {
        f32x4 r;
#pragma unroll
        for (int j = 0; j < 4; ++j) r[j] = silu(g[j]) * up[j];
        *(u32x2*)(WSP(bf16_t, OFF_P) + (size_t)row * DFF + col) = pack4(r);
      }
    }
  }
}

__device__ __forceinline__ float lbval(const Params& P, int l, int c) {
  const float* hb = P.in[I_HLB];
  const float a0 = hb[c], a1 = hb[256 + c], a2 = hb[512 + c], a3 = hb[768 + c];
  const float m = fmaxf(fmaxf(a0, a1), fmaxf(a2, a3));
  const float e0 = __expf(a0 - m), e1 = __expf(a1 - m), e2 = __expf(a2 - m), e3 = __expf(a3 - m);
  const float inv = 1.f / (e0 + e1 + e2 + e3);
  float s = 0.f;
  if (l >= 1) s += e1; if (l >= 2) s += e2; if (l >= 3) s += e3;
  return s * inv;
}

__device__ __forceinline__ void gdn_conv_emit2(const Params& P, int g, int c2, int row, float s0, float s1) {
  const int h = g % 6;
  if (g < 12) {
    const float rn = rsqrtf(half_sum(s0 * s0 + s1 * s1) + 1e-6f) * (g < 6 ? 0.125f : 1.f);
    *(unsigned*)((g < 6 ? WSP(bf16_t, OFF_GQ) : WSP(bf16_t, OFF_GK)) + (size_t)row * 384 + h * 64 + c2) = pk2(s0 * rn, s1 * rn);
  } else {
    *(unsigned*)(WSP(bf16_t, OFF_GV) + (size_t)row * 384 + h * 64 + c2) = pk2(s0, s1);
  }
}
__device__ __forceinline__ void gdn_gate_emit(const Params& P, int l, int h, int row) {
  const bf16_t* pr = WSP(bf16_t, OFF_P) + (size_t)row * PSTR;
  const float braw = bf2f(pr[1536 + h]), araw = bf2f(pr[1542 + h]);
  const float gg = -__expf(P.in[I_ALOG][l * 6 + h]) * softplus(araw + P.in[I_DTB][l * 6 + h]);
  WSP(float, OFF_GDEC)[(size_t)row * 8 + h] = __expf(gg);
  WSP(float, OFF_GBETA)[(size_t)row * 8 + h] = sigm(braw);
}
__device__ __forceinline__ void prep_gdn_prompt(const Params& P, int l, int ci) {
  const int lane = otid() & 63, wid = otid() >> 6, hl = lane >> 5, c2 = (lane & 31) * 2;
  const int r0 = ci * 32, b = r0 / TSEQ, t0 = r0 % TSEQ;
  const bf16_t* p = WSP(bf16_t, OFF_P);
  for (int gp = wid; gp < 9; gp += 8) {
    const int g = gp * 2 + hl, col = g * 64 + c2;
    const float* cw = P.in[I_CONVW] + (size_t)l * 4 * 1152 + col;
    const f32x2 w0 = *(const f32x2*)cw, w1 = *(const f32x2*)(cw + 1152), w2 = *(const f32x2*)(cw + 2304), w3 = *(const f32x2*)(cw + 3456);
    unsigned xr[35];
#pragma unroll
    for (int t = 0; t < 35; ++t) xr[t] = (t >= 3 || t0 > 0) ? *(const unsigned*)(p + (size_t)(r0 - 3 + t) * PSTR + col) : 0u;
    f32x2 x3 = {__uint_as_float(xr[0] << 16), __uint_as_float(xr[0] & 0xffff0000u)};
    f32x2 x2 = {__uint_as_float(xr[1] << 16), __uint_as_float(xr[1] & 0xffff0000u)};
    f32x2 x1 = {__uint_as_float(xr[2] << 16), __uint_as_float(xr[2] & 0xffff0000u)};
#pragma unroll
    for (int t = 0; t < 32; ++t) {
      const f32x2 x0 = {__uint_as_float(xr[t + 3] << 16), __uint_as_float(xr[t + 3] & 0xffff0000u)};
      const f32x2 y = w0 * x3 + w1 * x2 + w2 * x1 + w3 * x0;
      gdn_conv_emit2(P, g, c2, r0 + t, silu(y[0]), silu(y[1]));
      x3 = x2; x2 = x1; x1 = x0;
    }
    if (t0 + 32 == TSEQ) {
      float* cp = P.out + O_CONV_P + (size_t)(l * 8 + b) * 3 * 1152 + col;
      *(f32x2*)cp = x3; *(f32x2*)(cp + 1152) = x2; *(f32x2*)(cp + 2304) = x1;
    }
    if (g < 6) gdn_gate_emit(P, l, g, r0 + (lane & 31));
  }
}
__device__ __forceinline__ void prep_gdn_sample(const Params& P, int l, int si) {
  const int lane = otid() & 63, wid = otid() >> 6, hl = lane >> 5, c2 = (lane & 31) * 2;
  const bf16_t* p = WSP(bf16_t, OFF_P);
  for (int u = wid; u < 18; u += 8) {
    const int s = si * 2 + u / 9, g = (u % 9) * 2 + hl, col = g * 64 + c2, row = NTP + s;
    const float* cw = P.in[I_CONVW] + (size_t)l * 4 * 1152 + col;
    const f32x2 w0 = *(const f32x2*)cw, w1 = *(const f32x2*)(cw + 1152), w2 = *(const f32x2*)(cw + 2304), w3 = *(const f32x2*)(cw + 3456);
    const float* cb = P.in[I_SCONV] + (size_t)(l * 128 + s) * 3 * 1152 + col;
    const f32x2 x3 = *(const f32x2*)cb, x2 = *(const f32x2*)(cb + 1152), x1 = *(const f32x2*)(cb + 2304);
    const unsigned xw = *(const unsigned*)(p + (size_t)row * PSTR + col);
    const f32x2 x0 = {__uint_as_float(xw << 16), __uint_as_float(xw & 0xffff0000u)};
    const f32x2 y = w0 * x3 + w1 * x2 + w2 * x1 + w3 * x0;
    gdn_conv_emit2(P, g, c2, row, silu(y[0]), silu(y[1]));
    float* cp = P.out + O_CONV_S + (size_t)(l * 128 + s) * 3 * 1152 + col;
    *(f32x2*)cp = x2; *(f32x2*)(cp + 1152) = x1; *(f32x2*)(cp + 2304) = x0;
    if (g < 6 && (lane & 31) == 0) gdn_gate_emit(P, l, g, row);
  }
}
__device__ __forceinline__ void prep_hgrn(const Params& P, int l, int ti) {
  const int c2 = (otid() & 127) * 2, tg = otid() >> 7;
  const float oml0 = 1.f - lbval(P, l, c2), oml1 = 1.f - lbval(P, l, c2 + 1);
  const bf16_t* p = WSP(bf16_t, OFF_P);
  bf16_t* hq = WSP(bf16_t, OFF_HQ); bf16_t* hk = WSP(bf16_t, OFF_HK);
  for (int t0 = tg * 16; t0 < tg * 16 + 16; t0 += 8) {
    unsigned q[8], f[8];
#pragma unroll
    for (int i = 0; i < 8; ++i) { const int row = ti * 64 + t0 + i; q[i] = *(const unsigned*)(p + (size_t)row * PSTR + PC + c2); f[i] = *(const unsigned*)(p + (size_t)row * PSTR + PC + 256 + c2); }
#pragma unroll
    for (int i = 0; i < 8; ++i) {
      const int row = ti * 64 + t0 + i;
      const float q0 = __uint_as_float(q[i] << 16), q1 = __uint_as_float(q[i] & 0xffff0000u);
      const float f0 = __uint_as_float(f[i] << 16), f1 = __uint_as_float(f[i] & 0xffff0000u);
      *(unsigned*)(hq + (size_t)row * 256 + c2) = pk2(silu(q0) * 0.125f, silu(q1) * 0.125f);
      *(unsigned*)(hk + (size_t)row * 256 + c2) = pk2(oml0 * sigm(-f0), oml1 * sigm(-f1));
    }
  }
}
template <bool SAMP>
__device__ __forceinline__ f32x4 xs4t(const Params& P, int l, int row, int col0) {
  const bf16_t* p = WSP(bf16_t, OFF_P);
  const f32x4 pv = unpack4(*(const u32x2*)(p + (size_t)row * PSTR + PB + col0));
  f32x4 prev;
  if (SAMP) prev = *(const f32x4*)(P.in[I_SSHIFT] + (size_t)(l * 128 + (row - NTP)) * 1408 + col0);
  else {
    const bool first = (row & (TSEQ - 1)) == 0;
    prev = unpack4(*(const u32x2*)(p + (size_t)(row - (first ? 0 : 1)) * PSTR + PB + col0)) * (first ? 0.f : 1.f);
  }
  const f32x4 mu = *(const f32x4*)(P.in[I_MU] + l * 1408 + col0);
  return pv + (prev - pv) * mu;
}
__device__ __forceinline__ float tanh_fast(float x) { return 1.f - 2.f / (__expf(2.f * x) + 1.f); }

template <int ROWB>
__device__ __forceinline__ void stage_lora(unsigned char* smem, const bf16_t* __restrict__ src) {
  constexpr int CPR = ROWB / 16, NCH = 384 * CPR;
  __syncthreads();
  u32x4 t[NCH / 512];
#pragma unroll
  for (int i = 0; i < NCH / 512; ++i) t[i] = *(const u32x4*)((const unsigned char*)src + (size_t)(otid() + i * 512) * 16);
#pragma unroll
  for (int i = 0; i < NCH / 512; ++i) { const int idx = otid() + i * 512, r = idx / CPR, c = idx - r * CPR; *(u32x4*)(smem + r * (ROWB + 16) + c * 16) = t[i]; }
  __syncthreads();
}
template <bool SAMP>
__device__ __forceinline__ void prep_rwkv_unit(const Params& P, unsigned char* smem, int l, int mt, int hh) {
  const int lane = otid() & 63, fr = lane & 15, fq = lane >> 4;
  const int row = mt * 16 + fr, cb = hh * 192;
  const bf16_t* lw = WSP(bf16_t, OFF_LORA);
  const size_t ro = (size_t)row * 384;
  f32x4 acc[12];
  {
    f32x4 x[2][2]; bf16x8 Bf[2][12];
    stage_lora<128>(smem, lw + W2T);
#pragma unroll
    for (int ks = 0; ks < 2; ++ks) { x[ks][0] = xs4t<SAMP>(P, l, row, 1152 + ks * 32 + fq * 8); x[ks][1] = xs4t<SAMP>(P, l, row, 1152 + ks * 32 + fq * 8 + 4); }
#pragma unroll
    for (int ks = 0; ks < 2; ++ks)
#pragma unroll
      for (int nf = 0; nf < 12; ++nf) Bf[ks][nf] = *(const bf16x8*)(smem + (cb + nf * 16 + fr) * 144 + ks * 64 + fq * 16);
#pragma unroll
    for (int nf = 0; nf < 12; ++nf) acc[nf] = (f32x4){0.f, 0.f, 0.f, 0.f};
#pragma unroll
    for (int ks = 0; ks < 2; ++ks) {
#pragma unroll
      for (int j = 0; j < 4; ++j) { x[ks][0][j] = tanh_fast(x[ks][0][j]); x[ks][1][j] = tanh_fast(x[ks][1][j]); }
      const bf16x8 A = pack8(x[ks][0], x[ks][1]);
#pragma unroll
      for (int nf = 0; nf < 12; ++nf) acc[nf] = __builtin_amdgcn_mfma_f32_16x16x32_bf16(Bf[ks][nf], A, acc[nf], 0, 0, 0);
    }
    f32x4 w0v[12];
#pragma unroll
    for (int nf = 0; nf < 12; ++nf) w0v[nf] = *(const f32x4*)(P.in[I_W0] + l * 384 + cb + nf * 16 + fq * 4);
#pragma unroll
    for (int nf = 0; nf < 12; ++nf) {
      f32x4 d;
#pragma unroll
      for (int j = 0; j < 4; ++j) {
        const float xx = -(w0v[nf][j] + acc[nf][j]);
        const float sp = xx > 15.f ? xx : __logf(1.f + __expf(xx));
        d[j] = __expf(-__expf(-sp - 0.5f));
      }
      *(f32x4*)(WSP(float, OFF_RW) + ro + cb + nf * 16 + fq * 4) = d;
    }
  }
  {
    f32x4 x[2][2]; bf16x8 Bf[2][12];
    stage_lora<128>(smem, lw + A2T);
#pragma unroll
    for (int ks = 0; ks < 2; ++ks) { x[ks][0] = xs4t<SAMP>(P, l, row, 1216 + ks * 32 + fq * 8); x[ks][1] = xs4t<SAMP>(P, l, row, 1216 + ks * 32 + fq * 8 + 4); }
#pragma unroll
    for (int ks = 0; ks < 2; ++ks)
#pragma unroll
      for (int nf = 0; nf < 12; ++nf) Bf[ks][nf] = *(const bf16x8*)(smem + (cb + nf * 16 + fr) * 144 + ks * 64 + fq * 16);
#pragma unroll
    for (int nf = 0; nf < 12; ++nf) acc[nf] = (f32x4){0.f, 0.f, 0.f, 0.f};
#pragma unroll
    for (int ks = 0; ks < 2; ++ks) {
      const bf16x8 A = pack8(x[ks][0], x[ks][1]);
#pragma unroll
      for (int nf = 0; nf < 12; ++nf) acc[nf] = __builtin_amdgcn_mfma_f32_16x16x32_bf16(Bf[ks][nf], A, acc[nf], 0, 0, 0);
    }
  }
#pragma unroll
  for (int hl = 0; hl < 3; ++hl) {
    f32x4 kr[4], rr[4], kkw[4], a0[4], ka[4];
#pragma unroll
    for (int q = 0; q < 4; ++q) {
      const int c = cb + (hl * 4 + q) * 16 + fq * 4;
      kr[q] = xs4t<SAMP>(P, l, row, 384 + c); rr[q] = xs4t<SAMP>(P, l, row, c);
      kkw[q] = *(const f32x4*)(P.in[I_KK] + l * 384 + c); a0[q] = *(const f32x4*)(P.in[I_A0] + l * 384 + c); ka[q] = *(const f32x4*)(P.in[I_KA] + l * 384 + c);
    }
    float ss = 0.f;
#pragma unroll
    for (int q = 0; q < 4; ++q) { kkw[q] = kr[q] * kkw[q]; ss += dot4(kkw[q], kkw[q]); }
    ss += __shfl_xor(ss, 16); ss += __shfl_xor(ss, 32);
    const float rn = rsqrtf(ss + 1e-6f);
#pragma unroll
    for (int q = 0; q < 4; ++q) {
      const int nf = hl * 4 + q, c = cb + nf * 16 + fq * 4;
      f32x4 kn, kk, kb;
#pragma unroll
      for (int j = 0; j < 4; ++j) {
        const float a = sigm(a0[q][j] + acc[nf][j]);
        kk[j] = kkw[q][j] * rn; kb[j] = kk[j] * a; kn[j] = kr[q][j] * (1.f + (a - 1.f) * ka[q][j]);
      }
      *(u32x2*)(WSP(bf16_t, OFF_RK) + ro + c) = pack4(kn);
      *(u32x2*)(WSP(bf16_t, OFF_RKK) + ro + c) = pack4(kk);
      *(u32x2*)(WSP(bf16_t, OFF_RB) + ro + c) = pack4(kb);
      *(u32x2*)(WSP(bf16_t, OFF_RR) + ro + c) = pack4(rr[q]);
    }
  }
  {
    f32x4 x[4][2];
    stage_lora<256>(smem, lw + G2T);
#pragma unroll
    for (int ks = 0; ks < 4; ++ks) { x[ks][0] = xs4t<SAMP>(P, l, row, 1280 + ks * 32 + fq * 8); x[ks][1] = xs4t<SAMP>(P, l, row, 1280 + ks * 32 + fq * 8 + 4); }
    bf16x8 A[4];
#pragma unroll
    for (int ks = 0; ks < 4; ++ks) {
#pragma unroll
      for (int j = 0; j < 4; ++j) { x[ks][0][j] = sigm(x[ks][0][j]); x[ks][1][j] = sigm(x[ks][1][j]); }
      A[ks] = pack8(x[ks][0], x[ks][1]);
    }
#pragma unroll
    for (int hf = 0; hf < 2; ++hf) {
      bf16x8 Bf[4][6];
#pragma unroll
      for (int ks = 0; ks < 4; ++ks)
#pragma unroll
        for (int n6 = 0; n6 < 6; ++n6) Bf[ks][n6] = *(const bf16x8*)(smem + (cb + (hf * 6 + n6) * 16 + fr) * 272 + ks * 64 + fq * 16);
#pragma unroll
      for (int n6 = 0; n6 < 6; ++n6) {
        f32x4 g = (f32x4){0.f, 0.f, 0.f, 0.f};
#pragma unroll
        for (int ks = 0; ks < 4; ++ks) g = __builtin_amdgcn_mfma_f32_16x16x32_bf16(Bf[ks][n6], A[ks], g, 0, 0, 0);
        *(u32x2*)(WSP(bf16_t, OFF_RG) + ro + cb + (hf * 6 + n6) * 16 + fq * 4) = pack4(g);
      }
    }
  }
  if (l == 0) {
    f32x4 v[12];
#pragma unroll
    for (int nf = 0; nf < 12; ++nf) v[nf] = xs4t<SAMP>(P, l, row, 768 + cb + nf * 16 + fq * 4);
#pragma unroll
    for (int nf = 0; nf < 12; ++nf) {
      const int c = cb + nf * 16 + fq * 4;
      const u32x2 o = pack4(v[nf]);
      *(u32x2*)(WSP(bf16_t, OFF_RV) + ro + c) = o;
      *(u32x2*)(WSP(bf16_t, OFF_VF) + ro + c) = o;
    }
  } else {
    f32x4 lo0 = (f32x4){0.f, 0.f, 0.f, 0.f}, lo1 = lo0;
#pragma unroll
    for (int hf = 0; hf < 2; ++hf) {
      f32x4 x[6][2]; bf16x8 B0[6], B1[6];
#pragma unroll
      for (int k6 = 0; k6 < 6; ++k6) {
        const int ks = hf * 6 + k6;
        x[k6][0] = xs4t<SAMP>(P, l, row, 768 + ks * 32 + fq * 8); x[k6][1] = xs4t<SAMP>(P, l, row, 768 + ks * 32 + fq * 8 + 4);
        B0[k6] = *(const bf16x8*)(lw + V1T + fr * 384 + ks * 32 + fq * 8);
        B1[k6] = *(const bf16x8*)(lw + V1T + (16 + fr) * 384 + ks * 32 + fq * 8);
      }
#pragma unroll
      for (int k6 = 0; k6 < 6; ++k6) {
        const bf16x8 A = pack8(x[k6][0], x[k6][1]);
        lo0 = __builtin_amdgcn_mfma_f32_16x16x32_bf16(B0[k6], A, lo0, 0, 0, 0);
        lo1 = __builtin_amdgcn_mfma_f32_16x16x32_bf16(B1[k6], A, lo1, 0, 0, 0);
      }
    }
    const bf16x8 A2 = pack8(lo0, lo1);
#pragma unroll
    for (int hf = 0; hf < 2; ++hf) {
      u32x4 bw[6]; f32x4 v0[6], v[6]; u32x2 vf[6];
#pragma unroll
      for (int n6 = 0; n6 < 6; ++n6) {
        const int nf = hf * 6 + n6, c = cb + nf * 16 + fq * 4;
        const bf16_t* vr = lw + V2T + (cb + nf * 16 + fr) * 32;
        const u32x2 b0 = *(const u32x2*)(vr + fq * 4), b1 = *(const u32x2*)(vr + 16 + fq * 4);
        bw[n6][0] = b0[0]; bw[n6][1] = b0[1]; bw[n6][2] = b1[0]; bw[n6][3] = b1[1];
        v0[n6] = *(const f32x4*)(P.in[I_V0] + (l - 1) * 384 + c);
        v[n6] = xs4t<SAMP>(P, l, row, 768 + c);
        vf[n6] = *(const u32x2*)(WSP(bf16_t, OFF_VF) + ro + c);
      }
#pragma unroll
      for (int n6 = 0; n6 < 6; ++n6) {
        const int c = cb + (hf * 6 + n6) * 16 + fq * 4;
        const f32x4 mv = __builtin_amdgcn_mfma_f32_16x16x32_bf16(__builtin_bit_cast(bf16x8, bw[n6]), A2, (f32x4){0.f, 0.f, 0.f, 0.f}, 0, 0, 0);
        const f32x4 vfv = unpack4(vf[n6]);
        f32x4 o;
#pragma unroll
        for (int j = 0; j < 4; ++j) o[j] = v[n6][j] + (vfv[j] - v[n6][j]) * sigm(v0[n6][j] + mv[j]);
        *(u32x2*)(WSP(bf16_t, OFF_RV) + ro + c) = pack4(o);
      }
    }
  }
}
__device__ __forceinline__ void prep_phase(const Params& P, unsigned char* smem, int l) {
  for (int it = obid(); it < 1092; it += gridDim.x) {
    if (it < 256) { const int wid = otid() >> 6; prep_rwkv_unit<false>(P, smem, l, it * 4 + (wid >> 1), wid & 1); }
    else if (it < 258) { const int wid = otid() >> 6; prep_rwkv_unit<true>(P, smem, l, it * 4 + (wid >> 1), wid & 1); }
    else if (it < 770) prep_gdn_prompt(P, l, it - 258);
    else if (it < 834) prep_gdn_sample(P, l, it - 770);
    else prep_hgrn(P, l, it - 834);
  }
  const bf16_t* p = WSP(bf16_t, OFF_P);
  for (int idx = obid() * 512 + otid(); idx < 136 * 1408; idx += gridDim.x * 512) {
    const int q = idx / 1408, col = idx - q * 1408;
    if (q < 8) P.out[O_SHIFT_P + (size_t)(l * 8 + q) * 1408 + col] = bf2f(p[(size_t)(q * TSEQ + TSEQ - 1) * PSTR + PB + col]);
    else P.out[O_SHIFT_S + (size_t)(l * 128 + (q - 8)) * 1408 + col] = bf2f(p[(size_t)(NTP + q - 8) * PSTR + PB + col]);
  }
}

template <int KIND> struct ScanCfg { static constexpr int STRIDE = KIND == 1 ? 356 : 164; };

template <int KIND> struct ScanPre { u32x2 a, b, c, d, v; f32x4 w; float g; };

template <int KIND>
__device__ __forceinline__ void scan_load(const Params& P, ScanPre<KIND>& r, int tid, int h, int half, int rowbase, int nvalid) {
  const int s = tid >> 4, j4 = (tid & 15) * 4;
  const int s2 = (tid >> 3) & 15, j2 = (tid & 7) * 4;
  const u32x2 z2 = {0u, 0u};
  const bool ok = s < nvalid, ok2 = (tid < 128) && (s2 < nvalid);
  if (KIND == 0) {
    const size_t o = (size_t)(rowbase + s) * 384 + h * 64 + j4;
    r.a = ok ? *(const u32x2*)(WSP(bf16_t, OFF_GK) + o) : z2;
    r.b = ok ? *(const u32x2*)(WSP(bf16_t, OFF_GQ) + o) : z2;
    r.v = ok2 ? *(const u32x2*)(WSP(bf16_t, OFF_GV) + (size_t)(rowbase + s2) * 384 + h * 64 + half * 32 + j2) : z2;
    const int sg = (tid >> 1) & 15;
    r.g = (tid < 32 && sg < nvalid) ? ((tid & 1) ? WSP(float, OFF_GBETA) : WSP(float, OFF_GDEC))[(size_t)(rowbase + sg) * 8 + h] : 0.f;
  } else if (KIND == 1) {
    const size_t o = (size_t)(rowbase + s) * 384 + h * 64 + j4;
    r.a = ok ? *(const u32x2*)(WSP(bf16_t, OFF_RR) + o) : z2;
    r.w = ok ? *(const f32x4*)(WSP(float, OFF_RW) + o) : (f32x4){0.f, 0.f, 0.f, 0.f};
    r.b = ok ? *(const u32x2*)(WSP(bf16_t, OFF_RK) + o) : z2;
    r.c = ok ? *(const u32x2*)(WSP(bf16_t, OFF_RKK) + o) : z2;
    r.d = ok ? *(const u32x2*)(WSP(bf16_t, OFF_RB) + o) : z2;
    r.v = ok2 ? *(const u32x2*)(WSP(bf16_t, OFF_RV) + (size_t)(rowbase + s2) * 384 + h * 64 + half * 32 + j2) : z2;
  } else {
    const size_t o = (size_t)(rowbase + s) * 256 + h * 64 + j4;
    r.a = ok ? *(const u32x2*)(WSP(bf16_t, OFF_HQ) + o) : z2;
    r.b = ok ? *(const u32x2*)(WSP(bf16_t, OFF_HK) + o) : z2;
    r.v = ok2 ? *(const u32x2*)(WSP(bf16_t, OFF_P) + (size_t)(rowbase + s2) * PSTR + PC + 512 + h * 64 + half * 32 + j2) : z2;
  }
}
template <int KIND>
__device__ __forceinline__ void scan_store(const ScanPre<KIND>& r, int tid, float* buf) {
  constexpr int STRIDE = ScanCfg<KIND>::STRIDE;
  const int s = tid >> 4, j4 = (tid & 15) * 4;
  const int s2 = (tid >> 3) & 15, j2 = (tid & 7) * 4;
  float* bs = buf + s * STRIDE + j4;
  if (KIND == 0) {
    const f32x4 k = unpack4(r.a), q = unpack4(r.b);
    *(f32x4*)(bs) = k; *(f32x4*)(bs + 64) = q;
    const float qk = row_sum16(dot4(q, k));
    if ((tid & 15) == 0) buf[s * STRIDE + 162] = qk;
    if (tid < 128) *(f32x4*)(buf + s2 * STRIDE + 128 + j2) = unpack4(r.v);
    if (tid < 32) buf[((tid >> 1) & 15) * STRIDE + 160 + (tid & 1)] = r.g;
  } else if (KIND == 1) {
    const f32x4 rr = unpack4(r.a), k = unpack4(r.b), kk = unpack4(r.c), bb = unpack4(r.d);
    *(f32x4*)(bs) = r.w * rr; *(f32x4*)(bs + 64) = r.w; *(f32x4*)(bs + 128) = k;
    *(f32x4*)(bs + 192) = kk; *(f32x4*)(bs + 256) = bb;
    const float br = row_sum16(dot4(bb, rr)), kr = row_sum16(dot4(k, rr));
    if ((tid & 15) == 0) { buf[s * STRIDE + 352] = br; buf[s * STRIDE + 353] = kr; }
    if (tid < 128) *(f32x4*)(buf + s2 * STRIDE + 320 + j2) = unpack4(r.v);
  } else {
    const f32x4 q = unpack4(r.a), k = unpack4(r.b);
    *(f32x4*)(bs) = q * (1.f - k); *(f32x4*)(bs + 64) = k;
    const float qk = row_sum16(dot4(q, k));
    if ((tid & 15) == 0) buf[s * STRIDE + 160] = qk;
    if (tid < 128) *(f32x4*)(buf + s2 * STRIDE + 128 + j2) = unpack4(r.v);
  }
}

template <int KIND> struct StepOps { f32x2 a[4], b[4], c[4], d[4], e[4]; float v, s0, s1, s2; };
template <int KIND>
__device__ __forceinline__ void step_load(StepOps<KIND>& o, const float* bs, int e0, int cl) {
#define LD8(dst, off) { const f32x4 _x = *(const f32x4*)(bs + (off) + e0), _y = *(const f32x4*)(bs + (off) + e0 + 4); \
    dst[0] = (f32x2){_x[0], _x[1]}; dst[1] = (f32x2){_x[2], _x[3]}; dst[2] = (f32x2){_y[0], _y[1]}; dst[3] = (f32x2){_y[2], _y[3]}; }
  if (KIND == 0) {
    LD8(o.a, 0) LD8(o.b, 64)
    o.v = bs[128 + cl];
    const f32x4 sc = *(const f32x4*)(bs + 160); o.s0 = sc[0]; o.s1 = sc[1]; o.s2 = sc[2];
  } else if (KIND == 1) {
    LD8(o.a, 0) LD8(o.b, 64) LD8(o.c, 128) LD8(o.d, 192) LD8(o.e, 256)
    o.v = bs[320 + cl];
    const f32x2 sc = *(const f32x2*)(bs + 352); o.s0 = sc[0]; o.s1 = sc[1];
  } else {
    LD8(o.a, 0) LD8(o.b, 64)
    o.v = bs[128 + cl]; o.s0 = bs[160];
  }
#undef LD8
}
template <int KIND>
__device__ __forceinline__ float step_compute(const StepOps<KIND>& o, f32x2 (&S)[4]) {
  if (KIND == 0) {
    f32x2 ks2 = o.a[0] * S[0], qs2 = o.b[0] * S[0];
#pragma unroll
    for (int i = 1; i < 4; ++i) { ks2 += o.a[i] * S[i]; qs2 += o.b[i] * S[i]; }
    float ks = ks2[0] + ks2[1], qs = qs2[0] + qs2[1];
    ks += dppf<0xB1>(ks); qs += dppf<0xB1>(qs); ks += dppf<0x4E>(ks); qs += dppf<0x4E>(qs); ks += dppf<0x141>(ks); qs += dppf<0x141>(qs);
    const float dec = o.s0, vn = o.s1 * (o.v - dec * ks);
#pragma unroll
    for (int i = 0; i < 4; ++i) S[i] = S[i] * dec + o.a[i] * vn;
    return dec * qs + vn * o.s2;
  } else if (KIND == 1) {
    f32x2 sa2 = o.d[0] * S[0], p2 = o.a[0] * S[0];
#pragma unroll
    for (int i = 1; i < 4; ++i) { sa2 += o.d[i] * S[i]; p2 += o.a[i] * S[i]; }
    float sa = sa2[0] + sa2[1], p1 = p2[0] + p2[1];
    sa += dppf<0xB1>(sa); p1 += dppf<0xB1>(p1); sa += dppf<0x4E>(sa); p1 += dppf<0x4E>(p1); sa += dppf<0x141>(sa); p1 += dppf<0x141>(p1);
    sa = -sa;
#pragma unroll
    for (int i = 0; i < 4; ++i) S[i] = S[i] * o.b[i] + (o.e[i] * sa + o.c[i] * o.v);
    return p1 + sa * o.s0 + o.v * o.s1;
  } else {
    f32x2 p2 = o.a[0] * S[0];
#pragma unroll
    for (int i = 1; i < 4; ++i) p2 += o.a[i] * S[i];
    float p1 = p2[0] + p2[1];
    p1 += dppf<0xB1>(p1); p1 += dppf<0x4E>(p1); p1 += dppf<0x141>(p1);
#pragma unroll
    for (int i = 0; i < 4; ++i) S[i] = S[i] + o.b[i] * (o.v - S[i]);
    return p1 + o.v * o.s0;
  }
}

template <int KIND>
__device__ __forceinline__ void scan_task(const Params& P, unsigned char* smem, int l, int seq, int h, int half, bool active) {
  constexpr int STRIDE = ScanCfg<KIND>::STRIDE, NEL = 16 * STRIDE;
  constexpr int NH = KIND == 2 ? 4 : 6;
  float* buf = (float*)smem;
  float* obuf = buf + 2 * NEL;
  const int tid = otid() & 255, lane = tid & 63, wid = tid >> 6;
  const int col_l = lane >> 3, sub = lane & 7, cl = wid * 8 + col_l, col = half * 32 + cl, e0 = sub * 8;
  const bool sample = seq >= 8;
  const int R0 = sample ? NTP + (seq - 8) : seq * TSEQ, T = sample ? 1 : TSEQ;
  const int ocol = (KIND == 0 ? 0 : (KIND == 1 ? 384 : 768)) + h * 64 + half * 32;
  const size_t O_P = KIND == 0 ? O_GDN_P : (KIND == 1 ? O_RWKV_P : O_HGRN_P);
  const size_t O_S = KIND == 0 ? O_GDN_S : (KIND == 1 ? O_RWKV_S : O_HGRN_S);
  const int I_ST = KIND == 0 ? I_SGDN : (KIND == 1 ? I_SRWKV : I_SHGRN);
  f32x2 S[4];
#pragma unroll
  for (int i = 0; i < 4; ++i) S[i] = (f32x2){0.f, 0.f};
  if (sample && active) {
    const float* st = P.in[I_ST] + ((size_t)(l * 128 + (seq - 8)) * NH + h) * 4096;
#pragma unroll
    for (int i = 0; i < 8; ++i) S[i >> 1][i & 1] = KIND == 1 ? st[col * 64 + e0 + i] : st[(e0 + i) * 64 + col];
  }
#pragma unroll
  for (int i = 0; i < 4; ++i) asm volatile("" : "+v"(S[i]));
  ScanPre<KIND> pre;
  __syncthreads();
  if (active) { scan_load<KIND>(P, pre, tid, h, half, R0, T); scan_store<KIND>(pre, tid, buf); }
  __syncthreads();
  const int nchunks = (T + 15) >> 4;
  bf16_t* oraw = WSP(bf16_t, OFF_P);
  for (int c = 0; c < nchunks; ++c) {
    if (active) {
      const int t0 = c * 16, n = (T - t0) < 16 ? (T - t0) : 16;
      const bool has_next = c + 1 < nchunks;
      if (c > 0) {
        const float* pob = obuf + ((c - 1) & 1) * 512;
        {
          const int s = tid >> 4, cc = (tid & 15) * 2;
          const f32x2 ov = *(const f32x2*)(pob + s * 32 + cc);
          *(unsigned*)(oraw + (size_t)(R0 + t0 - 16 + s) * PSTR + ocol + cc) = pk2(ov[0], ov[1]);
        }
      }
      if (has_next) scan_load<KIND>(P, pre, tid, h, half, R0 + t0 + 16, T - t0 - 16);
      const float* b = buf + (c & 1) * NEL;
      float* ob = obuf + (c & 1) * 512;
      if (n == 16) {
        StepOps<KIND> A, B;
        step_load<KIND>(A, b, e0, cl);
#pragma unroll
        for (int s = 0; s < 16; s += 2) {
          step_load<KIND>(B, b + (s + 1) * STRIDE, e0, cl);
          const float o0 = step_compute<KIND>(A, S);
          ob[s * 32 + cl] = o0;
          step_load<KIND>(A, b + (s + 2 < 16 ? s + 2 : 15) * STRIDE, e0, cl);
          const float o1 = step_compute<KIND>(B, S);
          ob[(s + 1) * 32 + cl] = o1;
        }
      } else {
        for (int s = 0; s < n; ++s) {
          StepOps<KIND> A;
          step_load<KIND>(A, b + s * STRIDE, e0, cl);
          const float o0 = step_compute<KIND>(A, S);
          ob[s * 32 + cl] = o0;
        }
      }
      if (has_next) scan_store<KIND>(pre, tid, buf + ((c + 1) & 1) * NEL);
    }
    __syncthreads();
  }
  if (active) {
    {
      const int c = nchunks - 1, t0 = c * 16, n = T - t0;
      const float* pob = obuf + (c & 1) * 512;
      {
        const int s = tid >> 4, cc = (tid & 15) * 2;
        const f32x2 ov = *(const f32x2*)(pob + s * 32 + cc);
        if (s < n) *(unsigned*)(oraw + (size_t)(R0 + t0 + s) * PSTR + ocol + cc) = pk2(ov[0], ov[1]);
      }
    }
    float* so = P.out + (sample ? O_S + ((size_t)(l * 128 + (seq - 8)) * NH + h) * 4096 : O_P + ((size_t)(l * 8 + seq) * NH + h) * 4096);
#pragma unroll
    for (int i = 0; i < 8; ++i) { if (KIND == 1) so[col * 64 + e0 + i] = S[i >> 1][i & 1]; else so[(e0 + i) * 64 + col] = S[i >> 1][i & 1]; }
  }
}

__device__ __forceinline__ void scan_phase(const Params& P, unsigned char* smem, int l, volatile unsigned* blk  ) {
  unsigned* q = WSP(unsigned, OFF_QUEUE) + l * 128;
  const int grp = otid() >> 8;
  for (int pass = 0; pass < 2; ++pass) {
    unsigned* qq = pass == 1 ? q + 64 : q;
    const unsigned ntask = pass == 1 ? 2048u : 256u;
    for (;;) {
      __syncthreads();
      if (threadIdx.x == 0) blk[3] = __hip_atomic_fetch_add(qq, 1u, __ATOMIC_RELAXED, __HIP_MEMORY_SCOPE_AGENT);
      __syncthreads();
      const int t = (int)blk[3];
      if (t >= (int)ntask) break;
      int kind, seq, h, half; bool act; unsigned char* sm;
      if (pass == 0) {
        act = grp == 0; sm = smem; half = t & 1;
        if (t < 96) { kind = 1; const int bh = t >> 1; seq = bh / 6; h = bh % 6; }
        else if (t < 192) { kind = 0; const int bh = (t - 96) >> 1; seq = bh / 6; h = bh % 6; }
        else { kind = 2; const int bh = (t - 192) >> 1; seq = bh / 4; h = bh % 4; }
      } else {
        const int hh = t & 15;
        act = true; sm = smem + grp * 51200; half = grp; seq = 8 + (t >> 4);
        if (hh < 6) { kind = 0; h = hh; } else if (hh < 12) { kind = 1; h = hh - 6; } else { kind = 2; h = hh - 12; }
      }
      if (kind == 0) scan_task<0>(P, sm, l, seq, h, half, act);
      else if (kind == 1) scan_task<1>(P, sm, l, seq, h, half, act);
      else scan_task<2>(P, sm, l, seq, h, half, act);
    }
  }
  if (l + 1 < NLAYER) {
    for (;;) {
      __syncthreads();
      if (threadIdx.x == 0) blk[3] = __hip_atomic_fetch_add(q + 96, 1u, __ATOMIC_RELAXED, __HIP_MEMORY_SCOPE_AGENT);
      __syncthreads();
      const unsigned t = blk[3];
      if (t >= (unsigned)WCONV_JOBS) break;
      wconv_job(P, smem, l + 1, (int)t);
    }
  }
  if (l == 0) {
    for (;;) {
      __syncthreads();
      if (threadIdx.x == 0) blk[3] = __hip_atomic_fetch_add(q + 112, 1u, __ATOMIC_RELAXED, __HIP_MEMORY_SCOPE_AGENT);
      __syncthreads();
      const unsigned t = blk[3];
      if (t >= 2368u) break;
      wconv_job(P, smem, 0, 1024 + (int)t);
    }
  }
}

__device__ __forceinline__ void post_phase(const Params& P, int l) {
  const int lane = otid() & 63, wid = otid() >> 6, hl = lane >> 5, c2 = (lane & 31) * 2;
  const bf16_t* p = WSP(bf16_t, OFF_P);
  bf16_t* act = WSP(bf16_t, OFF_ACT);
  const int gw = obid() * 8 + wid, nw = gridDim.x * 8;
  const f32x2 gnw = *(const f32x2*)(P.in[I_GNW] + l * 64 + c2), hnw = *(const f32x2*)(P.in[I_HNW] + l * 64 + c2);
  for (int u0 = gw * 8; u0 < NTOK * 10; u0 += nw * 8) {
    unsigned o[4], z[4]; int oc[4]; size_t rb[4];
#pragma unroll
    for (int k = 0; k < 4; ++k) {
      const int u = u0 + 2 * k + hl, row = u / 10, q = u - row * 10;
      oc[k] = q < 6 ? q * 64 : 768 + (q - 6) * 64;
      const int zc = q < 6 ? 1152 + q * 64 : PC + 768 + (q - 6) * 64;
      rb[k] = (size_t)row;
      o[k] = *(const unsigned*)(p + (size_t)row * PSTR + oc[k] + c2);
      z[k] = *(const unsigned*)(p + (size_t)row * PSTR + zc + c2);
    }
#pragma unroll
    for (int k = 0; k < 4; ++k) {
      const float o0 = __uint_as_float(o[k] << 16), o1 = __uint_as_float(o[k] & 0xffff0000u);
      const float z0 = __uint_as_float(z[k] << 16), z1 = __uint_as_float(z[k] & 0xffff0000u);
      const float rn = rsqrtf(half_sum(o0 * o0 + o1 * o1) * (1.f / 64.f) + 1e-6f);
      const f32x2 w = oc[k] < 384 ? gnw : hnw;
      *(unsigned*)(act + rb[k] * 1024 + oc[k] + c2) = pk2(o0 * rn * w[0] * silu(z0), o1 * rn * w[1] * silu(z1));
    }
  }
  for (int u0 = gw * 4; u0 < NTOK * 6; u0 += nw * 4) {
    unsigned o[2], r[2], kx[2], v[2], g[2]; int hh[2]; size_t rb[2];
#pragma unroll
    for (int k = 0; k < 2; ++k) {
      const int u = u0 + 2 * k + hl, row = u / 6, h = u - row * 6;
      const size_t idx = (size_t)row * 384 + h * 64 + c2;
      hh[k] = h; rb[k] = (size_t)row;
      o[k] = *(const unsigned*)(p + (size_t)row * PSTR + 384 + h * 64 + c2);
      r[k] = *(const unsigned*)(WSP(bf16_t, OFF_RR) + idx); kx[k] = *(const unsigned*)(WSP(bf16_t, OFF_RK) + idx);
      v[k] = *(const unsigned*)(WSP(bf16_t, OFF_RV) + idx); g[k] = *(const unsigned*)(WSP(bf16_t, OFF_RG) + idx);
    }
#pragma unroll
    for (int k = 0; k < 2; ++k) {
      const int hc = l * 384 + hh[k] * 64 + c2;
      const f32x2 lw = *(const f32x2*)(P.in[I_LNW] + hc), lb = *(const f32x2*)(P.in[I_LNB] + hc), rkw = *(const f32x2*)(P.in[I_RK] + hc);
      const float o0 = __uint_as_float(o[k] << 16), o1 = __uint_as_float(o[k] & 0xffff0000u);
      const float r0 = __uint_as_float(r[k] << 16), r1 = __uint_as_float(r[k] & 0xffff0000u);
      const float k0 = __uint_as_float(kx[k] << 16), k1 = __uint_as_float(kx[k] & 0xffff0000u);
      const float v0 = __uint_as_float(v[k] << 16), v1 = __uint_as_float(v[k] & 0xffff0000u);
      const float g0 = __uint_as_float(g[k] << 16), g1 = __uint_as_float(g[k] & 0xffff0000u);
      const float mu = half_sum(o0 + o1) * (1.f / 64.f);
      const float y0 = o0 - mu, y1 = o1 - mu;
      const float rn = rsqrtf(half_sum(y0 * y0 + y1 * y1) * (1.f / 64.f) + 64e-5f);
      const float rk = half_sum(r0 * k0 * rkw[0] + r1 * k1 * rkw[1]);
      *(unsigned*)(act + rb[k] * 1024 + 384 + hh[k] * 64 + c2) = pk2((y0 * rn * lw[0] + lb[0] + rk * v0) * g0, (y1 * rn * lw[1] + lb[1] + rk * v1) * g1);
    }
  }
}

#define XB_TMO      128
#define XB_XCNT(j)  (256  + 64 * (j))
#define XB_XSUB(j)  (1280 + 64 * (j))
#define XB_XGEN(j)  (2304 + 64 * (j))
#define XB_TOP      3328
#define XB_TOPGEN   3392
#define XCD_BAR_WORDS 3456
#define XB_SPIN_CAP (1u << 20)
#define LAS __attribute__((address_space(3)))
__device__ __forceinline__ unsigned xb_ld(unsigned* p)              { return __hip_atomic_load(p, __ATOMIC_RELAXED, __HIP_MEMORY_SCOPE_AGENT); }
__device__ __forceinline__ unsigned xb_add(unsigned* p, unsigned v) { return __hip_atomic_fetch_add(p, v, __ATOMIC_RELAXED, __HIP_MEMORY_SCOPE_AGENT); }
__device__ __forceinline__ unsigned xb_xcc_id() { return (unsigned)__builtin_amdgcn_s_getreg((3 << 11) | 20) & 0xFu; }
#define XB_SPIN(cond, bar) do { unsigned _sp = 0; while (cond) { __builtin_amdgcn_s_sleep(1); \
    if ((++_sp & 255u) == 0u) { if (xb_ld(&(bar)[XB_TMO])) break; if (_sp > XB_SPIN_CAP) { atomicAdd(&(bar)[XB_TMO], 1u); break; } } } } while (0)
struct XcdBarrier { unsigned* bar; unsigned x; volatile LAS unsigned* st; };
__device__ __forceinline__ XcdBarrier xcd_barrier_post(unsigned* bar, volatile LAS unsigned* st) {
  XcdBarrier b; b.bar = bar; b.x = xb_xcc_id(); b.st = st;
  if (threadIdx.x == 0) (void)xb_add(&bar[XB_XCNT(b.x)], 1u);
  return b;
}
__device__ __forceinline__ void xcd_barrier_complete(unsigned* bar, unsigned x, unsigned& nloc, unsigned& nx) {
  const unsigned G = gridDim.x * gridDim.y * gridDim.z;
  unsigned sum, cnt, mine, sp = 0u;
  for (;;) {
    sum = 0u; cnt = 0u; mine = 0u;
#pragma unroll
    for (unsigned j = 0; j < 16; ++j) { const unsigned c = xb_ld(&bar[XB_XCNT(j)]); sum += c; cnt += (c > 0u) ? 1u : 0u; mine = (j == x) ? c : mine; }
    if (sum == G) break;
    __builtin_amdgcn_s_sleep(1);
    if ((++sp & 255u) == 0u) { if (xb_ld(&bar[XB_TMO])) break; if (sp > XB_SPIN_CAP) { atomicAdd(&bar[XB_TMO], 1u); break; } }
  }
  nloc = mine > 0u ? mine : 1u; nx = cnt > 0u ? cnt : 1u;
}
__device__ __forceinline__ void xcd_barrier(const XcdBarrier& b) {
  asm volatile("s_waitcnt vmcnt(0)" ::: "memory");
  __syncthreads();
  if (threadIdx.x == 0) {
    unsigned* bar = b.bar;
    __builtin_amdgcn_s_waitcnt(0);
    unsigned nloc = b.st[0], nx = b.st[1];
    if (nloc == 0u) { xcd_barrier_complete(bar, b.x, nloc, nx); b.st[0] = nloc; b.st[1] = nx; }
    const unsigned old = xb_add(&bar[XB_XSUB(b.x)], 1u);
    const unsigned gen = old / nloc;
    if (old + 1u == (gen + 1u) * nloc) {
      __builtin_amdgcn_fence(__ATOMIC_RELEASE, "agent");
      asm volatile("s_waitcnt vmcnt(0)" ::: "memory");
      const unsigned og = xb_add(&bar[XB_TOP], 1u);
      const unsigned tg = og / nx;
      if (og + 1u == (tg + 1u) * nx) xb_add(&bar[XB_TOPGEN], 1u);
      else XB_SPIN(xb_ld(&bar[XB_TOPGEN]) == tg, bar);
      __builtin_amdgcn_fence(__ATOMIC_ACQUIRE, "agent");
      xb_add(&bar[XB_XGEN(b.x)], 1u);
      asm volatile("s_waitcnt vmcnt(0)" ::: "memory");
    } else {
      XB_SPIN(xb_ld(&bar[XB_XGEN(b.x)]) == gen, bar);
      __builtin_amdgcn_fence(__ATOMIC_ACQUIRE, "agent");
      asm volatile("s_waitcnt vmcnt(0)" ::: "memory");
    }
  }
  __syncthreads();
}

__global__ void __launch_bounds__(512, 2) hybrid_fwd(Params P) {
  cg::grid_group grid = cg::this_grid();
  __shared__ __attribute__((aligned(16))) unsigned char smem[131072 + 64];
  uint4& xb_words = *(uint4*)(smem + 131072);
  if (threadIdx.x == 0) xb_words = make_uint4(0u, 0u, 0u, 0u);
  __syncthreads();
  const XcdBarrier xb = xcd_barrier_post(WSP(unsigned, OFF_BAR), (volatile LAS unsigned*)&xb_words);
  if (threadIdx.x == 0) {
    const unsigned hw = (unsigned)__builtin_amdgcn_s_getreg((7 << 11) | (8 << 6) | 4) & 0xffu;
    const unsigned key = (xb.x << 8) | hw;
    ((volatile unsigned*)&xb_words)[2] = __hip_atomic_fetch_add(WSP(unsigned, OFF_CUTAB) + key, 1u, __ATOMIC_RELAXED, __HIP_MEMORY_SCOPE_AGENT);
  }
  __syncthreads();
#pragma unroll 1
  for (int step = 0; step < NLAYER * 9; ++step) {
    const int l = step / 9, ph = step - l * 9;
    switch (ph) {
      case 0: if (l == 0) wconv_phase(P, smem, 0); norm_phase(P, l, P.in[I_NORM_MIX] + l * D); break;
      case 1: gemm_phase<EPI_P>(P, smem, WSP(bf16_t, OFF_ACT), 1024, WSP(bf16_t, OFF_WTIN), 1024, 32, l, 4096);
              gemm_sample<EPI_P>(P, smem, WSP(bf16_t, OFF_ACT), 1024, WSP(bf16_t, OFF_WTIN), 1024, 249, l); break;
      case 2: prep_phase(P, smem, l); break;
      case 3: scan_phase(P, smem, l, (volatile unsigned*)&xb_words); break;
      case 4: post_phase(P, l); break;
      case 5: gemm_phase<EPI_RES>(P, smem, WSP(bf16_t, OFF_ACT), 1024, WSP(bf16_t, wt_out_off(l)), 1024, 8, l, 1024);
              gemm_sample<EPI_RES>(P, smem, WSP(bf16_t, OFF_ACT), 1024, WSP(bf16_t, wt_out_off(l)), 1024, 64, l); break;
      case 6: norm_phase(P, 1, P.in[I_NORM_FFN] + l * D); break;
      case 7: gemm_phase<EPI_SWIGLU>(P, smem, WSP(bf16_t, OFF_ACT), 1024, WSP(bf16_t, wt_gu_off(l)), 1024, 44, 1, 5632);
              gemm_sample<EPI_SWIGLU>(P, smem, WSP(bf16_t, OFF_ACT), 1024, WSP(bf16_t, wt_gu_off(l)), 1024, 176, 1); break;
      default: gemm_phase<EPI_RES>(P, smem, WSP(bf16_t, OFF_P), DFF, WSP(bf16_t, wt_dn_off(l)), DFF, 8, 1, 1024);
               gemm_sample<EPI_RES>(P, smem, WSP(bf16_t, OFF_P), DFF, WSP(bf16_t, wt_dn_off(l)), DFF, 64, 1); break;
    }
    if (step == 0) grid.sync();
    else xcd_barrier(xb);
  }
  final_norm_phase(P);
}

extern "C" void kernel_launch(void* const* d_in, const int* in_sizes, int n_in,
                              void* d_out, int out_size, void* d_ws, size_t ws_size,
                              hipStream_t stream) {
  static int grid_blocks = 0;
  if (!grid_blocks) {
    int dev = 0, cus = 0, per_cu = 0;
    (void)hipGetDevice(&dev);
    (void)hipDeviceGetAttribute(&cus, hipDeviceAttributeMultiprocessorCount, dev);
    (void)hipOccupancyMaxActiveBlocksPerMultiprocessor(&per_cu, hybrid_fwd, 512, 0);
    if (per_cu > 1) per_cu = 1;
    if (per_cu < 1) per_cu = 1;
    grid_blocks = cus * per_cu;
  }
  if (ws_size < WS_NEED) { fprintf(stderr, "workspace too small: %zu < %zu\n", ws_size, (size_t)WS_NEED); return; }
  Params p{};
  for (int i = 0; i < N_IN; ++i) p.in[i] = (const float*)d_in[i];
  p.out = (float*)d_out;
  p.ws = (unsigned char*)d_ws;
  (void)hipMemsetAsync((unsigned char*)d_ws + OFF_BAR, 0, BAR_BYTES, stream);
  void* args[] = {&p};
  hipError_t e = hipLaunchCooperativeKernel((void*)hybrid_fwd, dim3(grid_blocks), dim3(512), args, 0, stream);
  if (e != hipSuccess) fprintf(stderr, "cooperative launch failed: %s (grid %d)\n", hipGetErrorString(e), grid_blocks);
}
```

```cpp
#include <hip/hip_runtime.h>
#include <hip/hip_cooperative_groups.h>
#include <cstdio>
namespace cg = cooperative_groups;

typedef unsigned short bf16_t;
typedef short bf16x8 __attribute__((ext_vector_type(8)));
typedef float f32x4 __attribute__((ext_vector_type(4)));
typedef unsigned u32x4 __attribute__((ext_vector_type(4)));
typedef unsigned u32x2 __attribute__((ext_vector_type(2)));

constexpr int D = 1024, NTP = 16384, NTS = 128, NTOK = 16512, TSEQ = 2048, NLAYER = 4;
constexpr int IN_COLS = 3980, PSTR = 3984, DFF = 2816;
constexpr int PB = 1548, PC = 2956;

enum { I_XP = 0, I_XS, I_SGDN, I_SCONV, I_SRWKV, I_SSHIFT, I_SHGRN, I_NORM_MIX, I_WIN, I_WOUT, I_CONVW, I_ALOG, I_DTB, I_GNW,
       I_MU, I_W0, I_W2, I_A0, I_A2, I_G2, I_V0, I_V1, I_V2, I_KK, I_KA, I_RK, I_LNW, I_LNB, I_HLB, I_HNW, I_NORM_FFN,
       I_WG, I_WU, I_WD, I_NORM_FINAL, N_IN };

constexpr size_t O_YP = 0, O_YS = 16777216, O_GDN_P = 16908288, O_GDN_S = 17694720, O_CONV_P = 30277632, O_CONV_S = 30388224,
                 O_RWKV_P = 32157696, O_RWKV_S = 32944128, O_SHIFT_P = 45527040, O_SHIFT_S = 45572096, O_HGRN_P = 46292992,
                 O_HGRN_S = 46817280;

constexpr size_t SZ_WTIN = (size_t)4096 * 1024 * 2, SZ_WTOUT = (size_t)1024 * 1024 * 2, SZ_WTGU = (size_t)5632 * 1024 * 2,
                 SZ_WTDN = (size_t)1024 * 2816 * 2, SZ_P = (size_t)NTOK * PSTR * 2, SZ_ACT = (size_t)NTOK * 1024 * 2,
                 SZ_T384 = (size_t)NTOK * 384 * 2, SZ_T8F = (size_t)NTOK * 8 * 4, SZ_T256 = (size_t)NTOK * 256 * 2,
                 SZ_T384F = (size_t)NTOK * 384 * 4;
constexpr size_t OFF_WTIN = 0, OFF_WTOUT = OFF_WTIN + SZ_WTIN, OFF_WTGU = OFF_WTOUT + SZ_WTOUT, OFF_WTDN = OFF_WTGU + SZ_WTGU,
                 OFF_P = OFF_WTDN + SZ_WTDN, OFF_ACT = OFF_P + SZ_P, OFF_GQ = OFF_ACT + SZ_ACT, OFF_GK = OFF_GQ + SZ_T384,
                 OFF_GV = OFF_GK + SZ_T384, OFF_GDEC = OFF_GV + SZ_T384, OFF_GBETA = OFF_GDEC + SZ_T8F, OFF_HQ = OFF_GBETA + SZ_T8F,
                 OFF_HK = OFF_HQ + SZ_T256, OFF_RR = OFF_HK + SZ_T256, OFF_RK = OFF_RR + SZ_T384, OFF_RV = OFF_RK + SZ_T384,
                 OFF_RKK = OFF_RV + SZ_T384, OFF_RB = OFF_RKK + SZ_T384, OFF_RG = OFF_RB + SZ_T384, OFF_RW = OFF_RG + SZ_T384,
                 OFF_VF = OFF_RW + SZ_T384F, OFF_LORA = OFF_VF + SZ_T384, OFF_WTOUT2 = OFF_LORA + 245760, OFF_WTGU2 = OFF_WTOUT2 + SZ_WTOUT, OFF_WTDN2 = OFF_WTGU2 + SZ_WTGU, OFF_BAR = OFF_WTDN2 + SZ_WTDN, OFF_CUTAB = OFF_BAR + 16384, OFF_QUEUE = OFF_CUTAB + 16384, BAR_BYTES = 16384 + 16384 + 4096, WS_NEED = OFF_BAR + BAR_BYTES;
constexpr int W2T = 0, A2T = 24576, G2T = 49152, V1T = 98304, V2T = 110592;

struct Params {
  const float* in[N_IN];
  float* out;
  unsigned char* ws;
};

#define WSP(T, off) ((T*)(P.ws + (off)))

__device__ __forceinline__ int otid() { int t = __builtin_amdgcn_workitem_id_x(); asm volatile("" : "+v"(t)); return t; }
__device__ __forceinline__ int obid() { int b = __builtin_amdgcn_workgroup_id_x(); asm volatile("" : "+s"(b)); return b; }
template <class T> __device__ __forceinline__ const T* opq(const T* p) { asm volatile("" : "+s"(p)); return p; }
__device__ __forceinline__ float bf2f(bf16_t h) { return __uint_as_float(((unsigned)h) << 16); }
typedef float f32x2_t __attribute__((ext_vector_type(2)));
typedef __bf16 bf16x2_t __attribute__((ext_vector_type(2)));
__device__ __forceinline__ unsigned pk2(float lo, float hi) {
  const f32x2_t v = {lo, hi};
  return __builtin_bit_cast(unsigned, __builtin_convertvector(v, bf16x2_t));
}
__device__ __forceinline__ bf16_t f2bf(float f) { return (bf16_t)(pk2(f, 0.f) & 0xffffu); }
__device__ __forceinline__ float sigm(float x) { return 1.f / (1.f + __expf(-x)); }
__device__ __forceinline__ float silu(float x) { return x / (1.f + __expf(-x)); }
__device__ __forceinline__ float softplus(float x) { return x > 20.f ? x : log1pf(__expf(x)); }
template <int CTRL> __device__ __forceinline__ float dppf(float x) {
  return __builtin_bit_cast(float, __builtin_amdgcn_mov_dpp(__builtin_bit_cast(int, x), CTRL, 0xf, 0xf, true));
}
__device__ __forceinline__ float wave_sum(float v) {
  v += dppf<0xB1>(v); v += dppf<0x4E>(v); v += dppf<0x141>(v); v += dppf<0x140>(v);
  const int iv = __builtin_bit_cast(int, v);
  const float s0 = __builtin_bit_cast(float, __builtin_amdgcn_readlane(iv, 0)), s1 = __builtin_bit_cast(float, __builtin_amdgcn_readlane(iv, 16));
  const float s2 = __builtin_bit_cast(float, __builtin_amdgcn_readlane(iv, 32)), s3 = __builtin_bit_cast(float, __builtin_amdgcn_readlane(iv, 48));
  return (s0 + s1) + (s2 + s3);
}
typedef float f32x2 __attribute__((ext_vector_type(2)));
__device__ __forceinline__ float row_sum16(float v) { v += dppf<0xB1>(v); v += dppf<0x4E>(v); v += dppf<0x141>(v); v += dppf<0x140>(v); return v; }
__device__ __forceinline__ float half_sum(float v) { v = row_sum16(v); return v + __shfl_xor(v, 16); }
__device__ __forceinline__ float reduce8(float x) { x += dppf<0xB1>(x); x += dppf<0x4E>(x); x += dppf<0x141>(x); return x; }

__device__ __forceinline__ f32x4 unpack4(u32x2 w) {
  f32x4 f; f[0] = __uint_as_float(w[0] << 16); f[1] = __uint_as_float(w[0] & 0xffff0000u);
  f[2] = __uint_as_float(w[1] << 16); f[3] = __uint_as_float(w[1] & 0xffff0000u); return f;
}
__device__ __forceinline__ bf16x8 pack8(f32x4 a, f32x4 b) {
  u32x4 u; u[0] = pk2(a[0], a[1]); u[1] = pk2(a[2], a[3]); u[2] = pk2(b[0], b[1]); u[3] = pk2(b[2], b[3]);
  return __builtin_bit_cast(bf16x8, u);
}
__device__ __forceinline__ u32x2 pack4(f32x4 a) { u32x2 u; u[0] = pk2(a[0], a[1]); u[1] = pk2(a[2], a[3]); return u; }
__device__ __forceinline__ float dot4(f32x4 a, f32x4 b) { return (a[0] * b[0] + a[1] * b[1]) + (a[2] * b[2] + a[3] * b[3]); }
__device__ __forceinline__ const float* xin_row(const Params& P, int l, int row) {
  const float* po = opq((const float*)P.out); const float* pp = opq(P.in[I_XP]); const float* ps = opq(P.in[I_XS]);
  if (l > 0) return po + (size_t)row * D;
  return row < NTP ? pp + (size_t)row * D : ps + (size_t)(row - NTP) * D;
}

__device__ __forceinline__ int gu_row(int c, int up) { return (c >> 7) * 256 + up * 128 + (c & 127); }
__device__ __forceinline__ void xpose_tile(unsigned char* smem, const float* __restrict__ W, int N, int kt, int ntl, bf16_t* __restrict__ dst, int dstK, int mode) {
  float (*tile)[65] = (float (*)[65])smem;
  const int tid = otid();
  __syncthreads();
#pragma unroll 4
  for (int i = 0; i < 8; ++i) {
    const int k = i * 8 + (tid >> 6), n = tid & 63, gn = ntl * 64 + n;
    tile[k][n] = gn < N ? W[(size_t)(kt * 64 + k) * N + gn] : 0.f;
  }
  __syncthreads();
#pragma unroll 4
  for (int i = 0; i < 4; ++i) {
    const int n = i * 16 + (tid >> 5), k = (tid & 31) * 2, gn = ntl * 64 + n;
    const int drow = mode == 0 ? gn : gu_row(gn, mode - 1);
    *(unsigned*)(dst + (size_t)drow * dstK + kt * 64 + k) = pk2(tile[k][n], tile[k + 1][n]);
  }
}
constexpr int WCONV_JOBS = 3392 + 480;
__device__ __forceinline__ size_t wt_out_off(int l) { return (l & 1) ? OFF_WTOUT2 : OFF_WTOUT; }
__device__ __forceinline__ size_t wt_gu_off(int l) { return (l & 1) ? OFF_WTGU2 : OFF_WTGU; }
__device__ __forceinline__ size_t wt_dn_off(int l) { return (l & 1) ? OFF_WTDN2 : OFF_WTDN; }
__device__ __forceinline__ void wconv_job(const Params& P, unsigned char* smem, int l, int job) {
  if (job < 1024) xpose_tile(smem, P.in[I_WIN] + (size_t)l * 1024 * IN_COLS, IN_COLS, job & 15, job >> 4, WSP(bf16_t, OFF_WTIN), 1024, 0);
  else if (job < 1280) { const int j = job - 1024; xpose_tile(smem, P.in[I_WOUT] + (size_t)l * 1024 * 1024, 1024, j & 15, j >> 4, WSP(bf16_t, wt_out_off(l)), 1024, 0); }
  else if (job < 1984) { const int j = job - 1280; xpose_tile(smem, P.in[I_WG] + (size_t)l * 1024 * DFF, DFF, j & 15, j >> 4, WSP(bf16_t, wt_gu_off(l)), 1024, 1); }
  else if (job < 2688) { const int j = job - 1984; xpose_tile(smem, P.in[I_WU] + (size_t)l * 1024 * DFF, DFF, j & 15, j >> 4, WSP(bf16_t, wt_gu_off(l)), 1024, 2); }
  else if (job < 3392) { const int j = job - 2688; xpose_tile(smem, P.in[I_WD] + (size_t)l * DFF * 1024, 1024, j % 44, j / 44, WSP(bf16_t, wt_dn_off(l)), DFF, 0); }
  else {
    bf16_t* lw = WSP(bf16_t, OFF_LORA);
    const int idx = (job - 3392) * 256 + (otid() & 255);
    float v = 0.f;
    const float* pw2 = opq(P.in[I_W2]); const float* pa2 = opq(P.in[I_A2]); const float* pg2 = opq(P.in[I_G2]);
    const float* pv1 = opq(P.in[I_V1]); const float* pv2 = opq(P.in[I_V2]);
    if (idx < A2T) { const int n = idx >> 6, k = idx & 63; v = pw2[(size_t)l * 64 * 384 + k * 384 + n]; }
    else if (idx < G2T) { const int i = idx - A2T, n = i >> 6, k = i & 63; v = pa2[(size_t)l * 64 * 384 + k * 384 + n]; }
    else if (idx < V1T) { const int i = idx - G2T, n = i >> 7, k = i & 127; v = pg2[(size_t)l * 128 * 384 + k * 384 + n]; }
    else if (idx < V2T) { if (l > 0) { const int i = idx - V1T, n = i / 384, k = i - n * 384; v = pv1[(size_t)(l - 1) * 384 * 32 + k * 32 + n]; } }
    else { if (l > 0) { const int i = idx - V2T, n = i >> 5, k = i & 31; v = pv2[(size_t)(l - 1) * 32 * 384 + k * 384 + n]; } }
    if (otid() < 256) lw[idx] = f2bf(v);
  }
}
__device__ __forceinline__ void wconv_phase(const Params& P, unsigned char* smem, int l) {
  for (int j = obid(); j < 1024 + 480; j += gridDim.x) wconv_job(P, smem, l, j < 1024 ? j : j + 2368);
}

__device__ __forceinline__ void norm_phase(const Params& P, int l_in, const float* __restrict__ w) {
  bf16_t* act = WSP(bf16_t, OFF_ACT);
  const int lane = otid() & 63, wid = otid() >> 6;
  f32x4 wv[4];
#pragma unroll
  for (int i = 0; i < 4; ++i) wv[i] = *(const f32x4*)(w + i * 256 + lane * 4);
  for (int r0 = (obid() * 8 + wid) * 4; r0 < NTOK; r0 += gridDim.x * 32) {
    f32x4 v[4][4];
#pragma unroll
    for (int r = 0; r < 4; ++r) {
      const float* xr = xin_row(P, l_in, r0 + r);
#pragma unroll
      for (int i = 0; i < 4; ++i) v[r][i] = *(const f32x4*)(xr + i * 256 + lane * 4);
    }
#pragma unroll
    for (int r = 0; r < 4; ++r) {
      float ss = 0.f;
#pragma unroll
      for (int i = 0; i < 4; ++i) ss += dot4(v[r][i], v[r][i]);
      const float rstd = rsqrtf(wave_sum(ss) * (1.f / 1024.f) + 1e-6f);
#pragma unroll
      for (int i = 0; i < 4; ++i) *(u32x2*)(act + (size_t)(r0 + r) * 1024 + i * 256 + lane * 4) = pack4(v[r][i] * rstd * wv[i]);
    }
  }
}
__device__ __forceinline__ void final_norm_phase(const Params& P) {
  const float* w = P.in[I_NORM_FINAL];
  const int lane = otid() & 63, wid = otid() >> 6;
  f32x4 wv[4];
#pragma unroll
  for (int i = 0; i < 4; ++i) wv[i] = *(const f32x4*)(w + i * 256 + lane * 4);
  for (int r0 = (obid() * 8 + wid) * 4; r0 < NTOK; r0 += gridDim.x * 32) {
    f32x4 v[4][4];
#pragma unroll
    for (int r = 0; r < 4; ++r)
#pragma unroll
      for (int i = 0; i < 4; ++i) v[r][i] = *(const f32x4*)(P.out + (size_t)(r0 + r) * D + i * 256 + lane * 4);
#pragma unroll
    for (int r = 0; r < 4; ++r) {
      float ss = 0.f;
#pragma unroll
      for (int i = 0; i < 4; ++i) ss += dot4(v[r][i], v[r][i]);
      const float rstd = rsqrtf(wave_sum(ss) * (1.f / 1024.f) + 1e-6f);
#pragma unroll
      for (int i = 0; i < 4; ++i) *(f32x4*)(P.out + (size_t)(r0 + r) * D + i * 256 + lane * 4) = v[r][i] * rstd * wv[i];
    }
  }
}

enum { EPI_P = 0, EPI_RES = 1, EPI_SWIGLU = 2 };
namespace pg8 {
constexpr int BM = 256, BK = 64, HALF = 128, HTB = HALF * BK * 2, NXCD = 8, WGM = 8;
__device__ __forceinline__ int lds_byte(int r, int c) { const int st = (r >> 4) * 2 + (c >> 5), rr = r & 15, cc = c & 31, ob = rr * 64 + cc * 2; return st * 1024 + (ob ^ (((ob >> 9) & 1) << 5)); }
__device__ __forceinline__ void stage_rc(int b, int& R, int& C) { const int st = b / 1024, sb = b % 1024, swz = sb ^ (((sb >> 9) & 1) << 5); R = (st >> 1) * 16 + swz / 64; C = (st & 1) * 32 + (swz % 64) / 2; }
__device__ __forceinline__ int perm32(int rho) { const int n = rho >> 4, i = rho & 15; return 8 * (i >> 2) + 4 * n + (i & 3); }
struct Unit { int pm, pn; };
struct StaticOrder {
  int nM, nN, nwg, G, c;
  __device__ __forceinline__ void init(int M, int N, int G_, int c_) { nM = M / BM; nN = N / BM; nwg = nM * nN; G = G_; c = c_; }
  __device__ __forceinline__ bool next(int i, Unit& u) const {
    const long L = (long)i * G + c; if (L >= nwg) return false;
    int wgid = (int)L; { const int q = nwg / NXCD, r = nwg % NXCD, xcd = wgid % NXCD, off = wgid / NXCD; wgid = (xcd < r ? xcd * (q + 1) : r * (q + 1) + (xcd - r) * q) + off; }
    const int nig = WGM * nN, gid = wgid / nig, fm = gid * WGM, gsz = (nM - fm) < WGM ? (nM - fm) : WGM;
    u.pm = fm + ((wgid % nig) % gsz); u.pn = (wgid % nig) / gsz; return true;
  }
};
}

template <int EPI>
__device__ __forceinline__ void gemm_epilogue(const Params& P, const f32x4 (&acc)[2][2][4][2], const pg8::Unit& u, int wr, int wc, int fr, int fq, int l) {
#pragma unroll
  for (int ai = 0; ai < 2; ++ai)
#pragma unroll
    for (int m = 0; m < 4; ++m) {
      const int row = u.pm * 256 + ai * 128 + wr * 64 + m * 16 + fr;
      if (EPI == EPI_P) {
        bf16_t* pr = WSP(bf16_t, OFF_P) + (size_t)row * PSTR;
#pragma unroll
        for (int bj = 0; bj < 2; ++bj) {
          const int col = u.pn * 256 + bj * 128 + wc * 32 + fq * 8;
          if (col < PSTR) { const u32x2 lo = pack4(acc[ai][bj][m][0]), hi = pack4(acc[ai][bj][m][1]); *(u32x4*)(pr + col) = (u32x4){lo[0], lo[1], hi[0], hi[1]}; }
        }
      } else if (EPI == EPI_RES) {
        const float* xi = xin_row(P, l, row);
        float* xo = P.out + (size_t)row * D;
#pragma unroll
        for (int bj = 0; bj < 2; ++bj)
#pragma unroll
          for (int n = 0; n < 2; ++n) {
            const int col = u.pn * 256 + bj * 128 + wc * 32 + n * 16 + fq * 4;
            *(f32x4*)(xo + col) = *(const f32x4*)(xi + col) + acc[ai][bj][m][n];
          }
      } else {
        bf16_t* ur = WSP(bf16_t, OFF_P) + (size_t)row * DFF;
        {
          const int col = u.pn * 128 + wc * 32 + fq * 8;
          f32x4 r0, r1;
#pragma unroll
          for (int j = 0; j < 4; ++j) { r0[j] = silu(acc[ai][0][m][0][j]) * acc[ai][1][m][0][j]; r1[j] = silu(acc[ai][0][m][1][j]) * acc[ai][1][m][1][j]; }
          const u32x2 lo = pack4(r0), hi = pack4(r1);
          *(u32x4*)(ur + col) = (u32x4){lo[0], lo[1], hi[0], hi[1]};
        }
      }
    }
}

#define PG8_LAS __attribute__((address_space(3)))
template <int EPI>
__device__ __forceinline__ void gemm_phase(const Params& P, unsigned char* smem, const bf16_t* __restrict__ Ag, int lda_unused, const bf16_t* __restrict__ Btg, int K, int nN128_unused, int l, int N) {
  using namespace pg8;
  PG8_LAS unsigned char* lds = (PG8_LAS unsigned char*)smem;
  const int tid = otid(), wid = __builtin_amdgcn_readfirstlane(tid >> 6), lane = tid & 63, wr = wid >> 2, wc = wid & 3, fr = lane & 15, fq = lane >> 4;
  const int nt = K / BK;
  StaticOrder S; S.init(NTP, N, (int)gridDim.x, obid());
  unsigned voffA[2], voffB[2];
#pragma unroll
  for (int i = 0; i < 2; ++i) { int R, C; stage_rc(tid * 16 + i * 8192, R, C); const int Rb = EPI == EPI_RES ? R : ((R & ~31) + perm32(R & 31));
    voffA[i] = (unsigned)(R * K + C) * 2u; voffB[i] = (unsigned)(Rb * K + C) * 2u; }
  const size_t kstep = (size_t)(BK * 2);
  const size_t hstep = (size_t)HALF * K * 2;
  const size_t tstep = 2 * hstep;
  const unsigned ldsw = (unsigned)wid * 1024u;
  const int aoff = lds_byte(wr * 64 + fr, fq * 8), boff = lds_byte(wc * 32 + fr, fq * 8);
#define PG8_SA(b, h) (((b) * 2 + (h)) * HTB)
#define PG8_SB(b, h) ((4 + (b) * 2 + (h)) * HTB)
#define PG8_STAGE(bufoff, gbase, voff) do { _Pragma("unroll") for (int _i = 0; _i < 2; ++_i) \
        __builtin_amdgcn_global_load_lds((const unsigned*)((const char*)(gbase) + (voff)[_i]), (PG8_LAS unsigned*)(lds + (bufoff) + ldsw + _i * 8192), 16, 0, 0); } while (0)
#define PG8_LDA(dst, b, h) do { _Pragma("unroll") for (int m = 0; m < 4; ++m) _Pragma("unroll") for (int k = 0; k < 2; ++k) dst[m][k] = *(const PG8_LAS bf16x8*)(lds + PG8_SA(b, h) + aoff + m * 2048 + k * 1024); } while (0)
#define PG8_LDB(dst, b, h) do { _Pragma("unroll") for (int n = 0; n < 2; ++n) _Pragma("unroll") for (int k = 0; k < 2; ++k) dst[n][k] = *(const PG8_LAS bf16x8*)(lds + PG8_SB(b, h) + boff + n * 2048 + k * 1024); } while (0)
#define PG8_MMA(ai, bj, At, Bt) do { __builtin_amdgcn_s_setprio(1); _Pragma("unroll") for (int m = 0; m < 4; ++m) _Pragma("unroll") for (int n = 0; n < 2; ++n) _Pragma("unroll") for (int k = 0; k < 2; ++k) \
        acc[ai][bj][m][n] = __builtin_amdgcn_mfma_f32_16x16x32_bf16(Bt[n][k], At[m][k], acc[ai][bj][m][n], 0, 0, 0); __builtin_amdgcn_s_setprio(0); } while (0)
#define PG8_WAIT_V(n) asm volatile("s_waitcnt vmcnt(" #n ")" ::: "memory")
#define PG8_WAIT_L(n) asm volatile("s_waitcnt lgkmcnt(" #n ")" ::: "memory")
#define PG8_BAR __builtin_amdgcn_s_barrier()
#define PG8_SCHED __builtin_amdgcn_sched_barrier(0)
  Unit cur, nxt; int ui = 0;
  if (!S.next(0, cur)) return;
  f32x4 acc[2][2][4][2];
#pragma unroll
  for (int a = 0; a < 2; ++a)
#pragma unroll
    for (int b = 0; b < 2; ++b)
#pragma unroll
      for (int m = 0; m < 4; ++m)
#pragma unroll
        for (int n = 0; n < 2; ++n) acc[a][b][m][n] = (f32x4){0.f, 0.f, 0.f, 0.f};
  bf16x8 At[4][2], B0[2][2], B1[2][2];
  const char* cA = (const char*)Ag + (size_t)cur.pm * tstep; const char* cB = (const char*)Btg + (size_t)cur.pn * tstep;
  PG8_STAGE(PG8_SB(0, 0), cB, voffB); PG8_STAGE(PG8_SA(0, 0), cA, voffA); PG8_STAGE(PG8_SB(0, 1), cB + hstep, voffB); PG8_STAGE(PG8_SA(0, 1), cA + hstep, voffA);
  if (wr == 1) PG8_BAR;
  PG8_WAIT_V(4); PG8_BAR;
  PG8_STAGE(PG8_SB(1, 0), cB + kstep, voffB); PG8_STAGE(PG8_SA(1, 0), cA + kstep, voffA); PG8_STAGE(PG8_SB(1, 1), cB + hstep + kstep, voffB);
  PG8_WAIT_V(6); PG8_BAR;
  for (;;) {
    const bool has_next = S.next(ui + 1, nxt);
    const char* nA = has_next ? (const char*)Ag + (size_t)nxt.pm * tstep : cA; const char* nB = has_next ? (const char*)Btg + (size_t)nxt.pn * tstep : cB;
    for (int t = 0; t < nt; t += 2) {
      const bool last = (t == nt - 2);
      const char* a1 = cA + (size_t)(t + 1) * kstep;
      const char* a2 = last ? nA : cA + (size_t)(t + 2) * kstep; const char* b2 = last ? nB : cB + (size_t)(t + 2) * kstep;
      const char* a3 = a2 + kstep; const char* b3 = b2 + kstep;
      PG8_LDB(B0, 0, 0); PG8_SCHED; PG8_LDA(At, 0, 0); PG8_STAGE(PG8_SA(1, 1), a1 + hstep, voffA);
      PG8_WAIT_L(8); PG8_BAR; PG8_WAIT_L(0); PG8_MMA(0, 0, At, B0); PG8_BAR; PG8_SCHED;
      PG8_LDB(B1, 0, 1); PG8_STAGE(PG8_SB(0, 0), b2, voffB);
      PG8_BAR; PG8_WAIT_L(0); PG8_MMA(0, 1, At, B1); PG8_BAR;
      PG8_LDA(At, 0, 1); PG8_STAGE(PG8_SA(0, 0), a2, voffA);
      PG8_BAR; PG8_WAIT_L(0); PG8_MMA(1, 0, At, B0); PG8_BAR; PG8_SCHED;
      PG8_STAGE(PG8_SB(0, 1), b2 + hstep, voffB);
      PG8_WAIT_V(6); PG8_BAR; PG8_MMA(1, 1, At, B1); PG8_BAR;
      PG8_LDB(B0, 1, 0); PG8_SCHED; PG8_LDA(At, 1, 0); PG8_STAGE(PG8_SA(0, 1), a2 + hstep, voffA);
      PG8_WAIT_L(8); PG8_BAR; PG8_WAIT_L(0); PG8_MMA(0, 0, At, B0); PG8_BAR; PG8_SCHED;
      PG8_LDB(B1, 1, 1); PG8_STAGE(PG8_SB(1, 0), b3, voffB);
      PG8_BAR; PG8_WAIT_L(0); PG8_MMA(0, 1, At, B1); PG8_BAR;
      PG8_LDA(At, 1, 1); PG8_STAGE(PG8_SA(1, 0), a3, voffA);
      PG8_BAR; PG8_WAIT_L(0); PG8_MMA(1, 0, At, B0); PG8_BAR; PG8_SCHED;
      PG8_STAGE(PG8_SB(1, 1), b3 + hstep, voffB);
      PG8_WAIT_V(6); PG8_BAR; PG8_MMA(1, 1, At, B1); PG8_BAR;
    }
    gemm_epilogue<EPI>(P, acc, cur, wr, wc, fr, fq, l);
    if (!has_next) break;
#pragma unroll
    for (int a = 0; a < 2; ++a)
#pragma unroll
      for (int b = 0; b < 2; ++b)
#pragma unroll
        for (int m = 0; m < 4; ++m)
#pragma unroll
          for (int n = 0; n < 2; ++n) acc[a][b][m][n] = (f32x4){0.f, 0.f, 0.f, 0.f};
    cur = nxt; cA = nA; cB = nB; ++ui;
  }
  PG8_WAIT_V(0);
  if (wr == 0) PG8_BAR;
  PG8_BAR;
#undef PG8_SA
#undef PG8_SB
#undef PG8_STAGE
#undef PG8_LDA
#undef PG8_LDB
#undef PG8_MMA
#undef PG8_WAIT_V
#undef PG8_WAIT_L
#undef PG8_BAR
#undef PG8_SCHED
}

template <int EPI>
__device__ __forceinline__ void gemm_sample(const Params& P, unsigned char* smem, const bf16_t* __restrict__ A, int lda, const bf16_t* __restrict__ Bt, int K, int nunits, int l) {
  const int tid = otid(), lane = tid & 63, wid = tid >> 6, fr = lane & 15, fq = lane >> 4;
  const int kslice = K >> 3;
  for (int u = (int)gridDim.x - 1 - obid(); u < nunits; u += gridDim.x) {
    const int brow0 = EPI == EPI_SWIGLU ? gu_row(u * 16 + fr, 0) : u * 16 + fr;
    const int brow1 = EPI == EPI_SWIGLU ? gu_row(u * 16 + fr, 1) : 0;
    const bf16_t* ap = A + (size_t)(NTP + fr) * lda + wid * kslice + fq * 8;
    const bf16_t* b0p = Bt + (size_t)brow0 * K + wid * kslice + fq * 8;
    const bf16_t* b1p = Bt + (size_t)brow1 * K + wid * kslice + fq * 8;
    f32x4 c0[8], c1[8];
#pragma unroll
    for (int m = 0; m < 8; ++m) { c0[m] = (f32x4){0.f, 0.f, 0.f, 0.f}; c1[m] = c0[m]; }
#pragma unroll 2
    for (int ks = 0; ks < kslice; ks += 32) {
      bf16x8 Af[8];
#pragma unroll
      for (int m = 0; m < 8; ++m) Af[m] = *(const bf16x8*)(ap + (size_t)m * 16 * lda + ks);
      const bf16x8 B0 = *(const bf16x8*)(b0p + ks);
      bf16x8 B1 = B0;
      if (EPI == EPI_SWIGLU) B1 = *(const bf16x8*)(b1p + ks);
#pragma unroll
      for (int m = 0; m < 8; ++m) {
        c0[m] = __builtin_amdgcn_mfma_f32_16x16x32_bf16(B0, Af[m], c0[m], 0, 0, 0);
        if (EPI == EPI_SWIGLU) c1[m] = __builtin_amdgcn_mfma_f32_16x16x32_bf16(B1, Af[m], c1[m], 0, 0, 0);
      }
    }
    __syncthreads();
#pragma unroll
    for (int m = 0; m < 8; ++m) {
      *(f32x4*)(smem + ((wid * 8 + m) * 64 + lane) * 16) = c0[m];
      if (EPI == EPI_SWIGLU) *(f32x4*)(smem + 65536 + ((wid * 8 + m) * 64 + lane) * 16) = c1[m];
    }
    __syncthreads();
    f32x4 g = (f32x4){0.f, 0.f, 0.f, 0.f}, up = g;
#pragma unroll
    for (int w = 0; w < 8; ++w) {
      g += *(const f32x4*)(smem + ((w * 8 + wid) * 64 + lane) * 16);
      if (EPI == EPI_SWIGLU) up += *(const f32x4*)(smem + 65536 + ((w * 8 + wid) * 64 + lane) * 16);
    }
    {
      const int row = NTP + wid * 16 + fr, col = u * 16 + fq * 4;
      if (EPI == EPI_P) {
        if (col < IN_COLS) *(u32x2*)(WSP(bf16_t, OFF_P) + (size_t)row * PSTR + col) = pack4(g);
      } else if (EPI == EPI_RES) {
        const float* xi = xin_row(P, l, row);
        *(f32x4*)(P.out + (size_t)row * D + col) = *(const f32x4*)(xi + col) + g;
      } else {
        f32x4 r;
#pragma unroll
        for (int j = 0; j < 4; ++j) r[j] = silu(g[j]) * up[j];
        *(u32x2*)(WSP(bf16_t, OFF_P) + (size_t)row * DFF + col) = pack4(r);
      }
    }
  }
}

__device__ __forceinline__ float lbval(const Params& P, int l, int c) {
  const float* hb = P.in[I_HLB];
  const float a0 = hb[c], a1 = hb[256 + c], a2 = hb[512 + c], a3 = hb[768 + c];
  const float m = fmaxf(fmaxf(a0, a1), fmaxf(a2, a3));
  const float e0 = __expf(a0 - m), e1 = __expf(a1 - m), e2 = __expf(a2 - m), e3 = __expf(a3 - m);
  const float inv = 1.f / (e0 + e1 + e2 + e3);
  float s = 0.f;
  if (l >= 1) s += e1; if (l >= 2) s += e2; if (l >= 3) s += e3;
  return s * inv;
}

__device__ __forceinline__ void gdn_conv_emit2(const Params& P, int g, int c2, int row, float s0, float s1) {
  const int h = g % 6;
  if (g < 12) {
    const float rn = rsqrtf(half_sum(s0 * s0 + s1 * s1) + 1e-6f) * (g < 6 ? 0.125f : 1.f);
    *(unsigned*)((g < 6 ? WSP(bf16_t, OFF_GQ) : WSP(bf16_t, OFF_GK)) + (size_t)row * 384 + h * 64 + c2) = pk2(s0 * rn, s1 * rn);
  } else {
    *(unsigned*)(WSP(bf16_t, OFF_GV) + (size_t)row * 384 + h * 64 + c2) = pk2(s0, s1);
  }
}
__device__ __forceinline__ void gdn_gate_emit(const Params& P, int l, int h, int row) {
  const bf16_t* pr = WSP(bf16_t, OFF_P) + (size_t)row * PSTR;
  const float braw = bf2f(pr[1536 + h]), araw = bf2f(pr[1542 + h]);
  const float gg = -__expf(P.in[I_ALOG][l * 6 + h]) * softplus(araw + P.in[I_DTB][l * 6 + h]);
  WSP(float, OFF_GDEC)[(size_t)row * 8 + h] = __expf(gg);
  WSP(float, OFF_GBETA)[(size_t)row * 8 + h] = sigm(braw);
}
__device__ __forceinline__ void prep_gdn_prompt(const Params& P, int l, int ci) {
  const int lane = otid() & 63, wid = otid() >> 6, hl = lane >> 5, c2 = (lane & 31) * 2;
  const int r0 = ci * 32, b = r0 / TSEQ, t0 = r0 % TSEQ;
  const bf16_t* p = WSP(bf16_t, OFF_P);
  for (int gp = wid; gp < 9; gp += 8) {
    const int g = gp * 2 + hl, col = g * 64 + c2;
    const float* cw = P.in[I_CONVW] + (size_t)l * 4 * 1152 + col;
    const f32x2 w0 = *(const f32x2*)cw, w1 = *(const f32x2*)(cw + 1152), w2 = *(const f32x2*)(cw + 2304), w3 = *(const f32x2*)(cw + 3456);
    unsigned xr[35];
#pragma unroll
    for (int t = 0; t < 35; ++t) xr[t] = (t >= 3 || t0 > 0) ? *(const unsigned*)(p + (size_t)(r0 - 3 + t) * PSTR + col) : 0u;
    f32x2 x3 = {__uint_as_float(xr[0] << 16), __uint_as_float(xr[0] & 0xffff0000u)};
    f32x2 x2 = {__uint_as_float(xr[1] << 16), __uint_as_float(xr[1] & 0xffff0000u)};
    f32x2 x1 = {__uint_as_float(xr[2] << 16), __uint_as_float(xr[2] & 0xffff0000u)};
#pragma unroll
    for (int t = 0; t < 32; ++t) {
      const f32x2 x0 = {__uint_as_float(xr[t + 3] << 16), __uint_as_float(xr[t + 3] & 0xffff0000u)};
      const f32x2 y = w0 * x3 + w1 * x2 + w2 * x1 + w3 * x0;
      gdn_conv_emit2(P, g, c2, r0 + t, silu(y[0]), silu(y[1]));
      x3 = x2; x2 = x1; x1 = x0;
    }
    if (t0 + 32 == TSEQ) {
      float* cp = P.out + O_CONV_P + (size_t)(l * 8 + b) * 3 * 1152 + col;
      *(f32x2*)cp = x3; *(f32x2*)(cp + 1152) = x2; *(f32x2*)(cp + 2304) = x1;
    }
    if (g < 6) gdn_gate_emit(P, l, g, r0 + (lane & 31));
  }
}
__device__ __forceinline__ void prep_gdn_sample(const Params& P, int l, int si) {
  const int lane = otid() & 63, wid = otid() >> 6, hl = lane >> 5, c2 = (lane & 31) * 2;
  const bf16_t* p = WSP(bf16_t, OFF_P);
  for (int u = wid; u < 18; u += 8) {
    const int s = si * 2 + u / 9, g = (u % 9) * 2 + hl, col = g * 64 + c2, row = NTP + s;
    const float* cw = P.in[I_CONVW] + (size_t)l * 4 * 1152 + col;
    const f32x2 w0 = *(const f32x2*)cw, w1 = *(const f32x2*)(cw + 1152), w2 = *(const f32x2*)(cw + 2304), w3 = *(const f32x2*)(cw + 3456);
    const float* cb = P.in[I_SCONV] + (size_t)(l * 128 + s) * 3 * 1152 + col;
    const f32x2 x3 = *(const f32x2*)cb, x2 = *(const f32x2*)(cb + 1152), x1 = *(const f32x2*)(cb + 2304);
    const unsigned xw = *(const unsigned*)(p + (size_t)row * PSTR + col);
    const f32x2 x0 = {__uint_as_float(xw << 16), __uint_as_float(xw & 0xffff0000u)};
    const f32x2 y = w0 * x3 + w1 * x2 + w2 * x1 + w3 * x0;
    gdn_conv_emit2(P, g, c2, row, silu(y[0]), silu(y[1]));
    float* cp = P.out + O_CONV_S + (size_t)(l * 128 + s) * 3 * 1152 + col;
    *(f32x2*)cp = x2; *(f32x2*)(cp + 1152) = x1; *(f32x2*)(cp + 2304) = x0;
    if (g < 6 && (lane & 31) == 0) gdn_gate_emit(P, l, g, row);
  }
}
__device__ __forceinline__ void prep_hgrn(const Params& P, int l, int ti) {
  const int c2 = (otid() & 127) * 2, tg = otid() >> 7;
  const float oml0 = 1.f - lbval(P, l, c2), oml1 = 1.f - lbval(P, l, c2 + 1);
  const bf16_t* p = WSP(bf16_t, OFF_P);
  bf16_t* hq = WSP(bf16_t, OFF_HQ); bf16_t* hk = WSP(bf16_t, OFF_HK);
  for (int t0 = tg * 16; t0 < tg * 16 + 16; t0 += 8) {
    unsigned q[8], f[8];
#pragma unroll
    for (int i = 0; i < 8; ++i) { const int row = ti * 64 + t0 + i; q[i] = *(const unsigned*)(p + (size_t)row * PSTR + PC + c2); f[i] = *(const unsigned*)(p + (size_t)row * PSTR + PC + 256 + c2); }
#pragma unroll
    for (int i = 0; i < 8; ++i) {
      const int row = ti * 64 + t0 + i;
      const float q0 = __uint_as_float(q[i] << 16), q1 = __uint_as_float(q[i] & 0xffff0000u);
      const float f0 = __uint_as_float(f[i] << 16), f1 = __uint_as_float(f[i] & 0xffff0000u);
      *(unsigned*)(hq + (size_t)row * 256 + c2) = pk2(silu(q0) * 0.125f, silu(q1) * 0.125f);
      *(unsigned*)(hk + (size_t)row * 256 + c2) = pk2(oml0 * sigm(-f0), oml1 * sigm(-f1));
    }
  }
}
template <bool SAMP>
__device__ __forceinline__ f32x4 xs4t(const Params& P, int l, int row, int col0) {
  const bf16_t* p = WSP(bf16_t, OFF_P);
  const f32x4 pv = unpack4(*(const u32x2*)(p + (size_t)row * PSTR + PB + col0));
  f32x4 prev;
  if (SAMP) prev = *(const f32x4*)(P.in[I_SSHIFT] + (size_t)(l * 128 + (row - NTP)) * 1408 + col0);
  else {
    const bool first = (row & (TSEQ - 1)) == 0;
    prev = unpack4(*(const u32x2*)(p + (size_t)(row - (first ? 0 : 1)) * PSTR + PB + col0)) * (first ? 0.f : 1.f);
  }
  const f32x4 mu = *(const f32x4*)(P.in[I_MU] + l * 1408 + col0);
  return pv + (prev - pv) * mu;
}
__device__ __forceinline__ float tanh_fast(float x) { return 1.f - 2.f / (__expf(2.f * x) + 1.f); }

template <int ROWB>
__device__ __forceinline__ void stage_lora(unsigned char* smem, const bf16_t* __restrict__ src) {
  constexpr int CPR = ROWB / 16, NCH = 384 * CPR;
  __syncthreads();
  u32x4 t[NCH / 512];
#pragma unroll
  for (int i = 0; i < NCH / 512; ++i) t[i] = *(const u32x4*)((const unsigned char*)src + (size_t)(otid() + i * 512) * 16);
#pragma unroll
  for (int i = 0; i < NCH / 512; ++i) { const int idx = otid() + i * 512, r = idx / CPR, c = idx - r * CPR; *(u32x4*)(smem + r * (ROWB + 16) + c * 16) = t[i]; }
  __syncthreads();
}
template <bool SAMP>
__device__ __forceinline__ void prep_rwkv_unit(const Params& P, unsigned char* smem, int l, int mt, int hh) {
  const int lane = otid() & 63, fr = lane & 15, fq = lane >> 4;
  const int row = mt * 16 + fr, cb = hh * 192;
  const bf16_t* lw = WSP(bf16_t, OFF_LORA);
  const size_t ro = (size_t)row * 384;
  f32x4 acc[12];
  {
    f32x4 x[2][2]; bf16x8 Bf[2][12];
    stage_lora<128>(smem, lw + W2T);
#pragma unroll
    for (int ks = 0; ks < 2; ++ks) { x[ks][0] = xs4t<SAMP>(P, l, row, 1152 + ks * 32 + fq * 8); x[ks][1] = xs4t<SAMP>(P, l, row, 1152 + ks * 32 + fq * 8 + 4); }
#pragma unroll
    for (int ks = 0; ks < 2; ++ks)
#pragma unroll
      for (int nf = 0; nf < 12; ++nf) Bf[ks][nf] = *(const bf16x8*)(smem + (cb + nf * 16 + fr) * 144 + ks * 64 + fq * 16);
#pragma unroll
    for (int nf = 0; nf < 12; ++nf) acc[nf] = (f32x4){0.f, 0.f, 0.f, 0.f};
#pragma unroll
    for (int ks = 0; ks < 2; ++ks) {
#pragma unroll
      for (int j = 0; j < 4; ++j) { x[ks][0][j] = tanh_fast(x[ks][0][j]); x[ks][1][j] = tanh_fast(x[ks][1][j]); }
      const bf16x8 A = pack8(x[ks][0], x[ks][1]);
#pragma unroll
      for (int nf = 0; nf < 12; ++nf) acc[nf] = __builtin_amdgcn_mfma_f32_16x16x32_bf16(Bf[ks][nf], A, acc[nf], 0, 0, 0);
    }
    f32x4 w0v[12];
#pragma unroll
    for (int nf = 0; nf < 12; ++nf) w0v[nf] = *(const f32x4*)(P.in[I_W0] + l * 384 + cb + nf * 16 + fq * 4);
#pragma unroll
    for (int nf = 0; nf < 12; ++nf) {
      f32x4 d;
#pragma unroll
      for (int j = 0; j < 4; ++j) {
        const float xx = -(w0v[nf][j] + acc[nf][j]);
        const float sp = xx > 15.f ? xx : __logf(1.f + __expf(xx));
        d[j] = __expf(-__expf(-sp - 0.5f));
      }
      *(f32x4*)(WSP(float, OFF_RW) + ro + cb + nf * 16 + fq * 4) = d;
    }
  }
  {
    f32x4 x[2][2]; bf16x8 Bf[2][12];
    stage_lora<128>(smem, lw + A2T);
#pragma unroll
    for (int ks = 0; ks < 2; ++ks) { x[ks][0] = xs4t<SAMP>(P, l, row, 1216 + ks * 32 + fq * 8); x[ks][1] = xs4t<SAMP>(P, l, row, 1216 + ks * 32 + fq * 8 + 4); }
#pragma unroll
    for (int ks = 0; ks < 2; ++ks)
#pragma unroll
      for (int nf = 0; nf < 12; ++nf) Bf[ks][nf] = *(const bf16x8*)(smem + (cb + nf * 16 + fr) * 144 + ks * 64 + fq * 16);
#pragma unroll
    for (int nf = 0; nf < 12; ++nf) acc[nf] = (f32x4){0.f, 0.f, 0.f, 0.f};
#pragma unroll
    for (int ks = 0; ks < 2; ++ks) {
      const bf16x8 A = pack8(x[ks][0], x[ks][1]);
#pragma unroll
      for (int nf = 0; nf < 12; ++nf) acc[nf] = __builtin_amdgcn_mfma_f32_16x16x32_bf16(Bf[ks][nf], A, acc[nf], 0, 0, 0);
    }
  }
#pragma unroll
  for (int hl = 0; hl < 3; ++hl) {
    f32x4 kr[4], rr[4], kkw[4], a0[4], ka[4];
#pragma unroll
    for (int q = 0; q < 4; ++q) {
      const int c = cb + (hl * 4 + q) * 16 + fq * 4;
      kr[q] = xs4t<SAMP>(P, l, row, 384 + c); rr[q] = xs4t<SAMP>(P, l, row, c);
      kkw[q] = *(const f32x4*)(P.in[I_KK] + l * 384 + c); a0[q] = *(const f32x4*)(P.in[I_A0] + l * 384 + c); ka[q] = *(const f32x4*)(P.in[I_KA] + l * 384 + c);
    }
    float ss = 0.f;
#pragma unroll
    for (int q = 0; q < 4; ++q) { kkw[q] = kr[q] * kkw[q]; ss += dot4(kkw[q], kkw[q]); }
    ss += __shfl_xor(ss, 16); ss += __shfl_xor(ss, 32);
    const float rn = rsqrtf(ss + 1e-6f);
#pragma unroll
    for (int q = 0; q < 4; ++q) {
      const int nf = hl * 4 + q, c = cb + nf * 16 + fq * 4;
      f32x4 kn, kk, kb;
#pragma unroll
      for (int j = 0; j < 4; ++j) {
        const float a = sigm(a0[q][j] + acc[nf][j]);
        kk[j] = kkw[q][j] * rn; kb[j] = kk[j] * a; kn[j] = kr[q][j] * (1.f + (a - 1.f) * ka[q][j]);
      }
      *(u32x2*)(WSP(bf16_t, OFF_RK) + ro + c) = pack4(kn);
      *(u32x2*)(WSP(bf16_t, OFF_RKK) + ro + c) = pack4(kk);
      *(u32x2*)(WSP(bf16_t, OFF_RB) + ro + c) = pack4(kb);
      *(u32x2*)(WSP(bf16_t, OFF_RR) + ro + c) = pack4(rr[q]);
    }
  }
  {
    f32x4 x[4][2];
    stage_lora<256>(smem, lw + G2T);
#pragma unroll
    for (int ks = 0; ks < 4; ++ks) { x[ks][0] = xs4t<SAMP>(P, l, row, 1280 + ks * 32 + fq * 8); x[ks][1] = xs4t<SAMP>(P, l, row, 1280 + ks * 32 + fq * 8 + 4); }
    bf16x8 A[4];
#pragma unroll
    for (int ks = 0; ks < 4; ++ks) {
#pragma unroll
      for (int j = 0; j < 4; ++j) { x[ks][0][j] = sigm(x[ks][0][j]); x[ks][1][j] = sigm(x[ks][1][j]); }
      A[ks] = pack8(x[ks][0], x[ks][1]);
    }
#pragma unroll
    for (int hf = 0; hf < 2; ++hf) {
      bf16x8 Bf[4][6];
#pragma unroll
      for (int ks = 0; ks < 4; ++ks)
#pragma unroll
        for (int n6 = 0; n6 < 6; ++n6) Bf[ks][n6] = *(const bf16x8*)(smem + (cb + (hf * 6 + n6) * 16 + fr) * 272 + ks * 64 + fq * 16);
#pragma unroll
      for (int n6 = 0; n6 < 6; ++n6) {
        f32x4 g = (f32x4){0.f, 0.f, 0.f, 0.f};
#pragma unroll
        for (int ks = 0; ks < 4; ++ks) g = __builtin_amdgcn_mfma_f32_16x16x32_bf16(Bf[ks][n6], A[ks], g, 0, 0, 0);
        *(u32x2*)(WSP(bf16_t, OFF_RG) + ro + cb + (hf * 6 + n6) * 16 + fq * 4) = pack4(g);
      }
    }
  }
  if (l == 0) {
    f32x4 v[12];
#pragma unroll
    for (int nf = 0; nf < 12; ++nf) v[nf] = xs4t<SAMP>(P, l, row, 768 + cb + nf * 16 + fq * 4);
#pragma unroll
    for (int nf = 0; nf < 12; ++nf) {
      const int c = cb + nf * 16 + fq * 4;
      const u32x2 o = pack4(v[nf]);
      *(u32x2*)(WSP(bf16_t, OFF_RV) + ro + c) = o;
      *(u32x2*)(WSP(bf16_t, OFF_VF) + ro + c) = o;
    }
  } else {
    f32x4 lo0 = (f32x4){0.f, 0.f, 0.f, 0.f}, lo1 = lo0;
#pragma unroll
    for (int hf = 0; hf < 2; ++hf) {
      f32x4 x[6][2]; bf16x8 B0[6], B1[6];
#pragma unroll
      for (int k6 = 0; k6 < 6; ++k6) {
        const int ks = hf * 6 + k6;
        x[k6][0] = xs4t<SAMP>(P, l, row, 768 + ks * 32 + fq * 8); x[k6][1] = xs4t<SAMP>(P, l, row, 768 + ks * 32 + fq * 8 + 4);
        B0[k6] = *(const bf16x8*)(lw + V1T + fr * 384 + ks * 32 + fq * 8);
        B1[k6] = *(const bf16x8*)(lw + V1T + (16 + fr) * 384 + ks * 32 + fq * 8);
      }
#pragma unroll
      for (int k6 = 0; k6 < 6; ++k6) {
        const bf16x8 A = pack8(x[k6][0], x[k6][1]);
        lo0 = __builtin_amdgcn_mfma_f32_16x16x32_bf16(B0[k6], A, lo0, 0, 0, 0);
        lo1 = __builtin_amdgcn_mfma_f32_16x16x32_bf16(B1[k6], A, lo1, 0, 0, 0);
      }
    }
    const bf16x8 A2 = pack8(lo0, lo1);
#pragma unroll
    for (int hf = 0; hf < 2; ++hf) {
      u32x4 bw[6]; f32x4 v0[6], v[6]; u32x2 vf[6];
#pragma unroll
      for (int n6 = 0; n6 < 6; ++n6) {
        const int nf = hf * 6 + n6, c = cb + nf * 16 + fq * 4;
        const bf16_t* vr = lw + V2T + (cb + nf * 16 + fr) * 32;
        const u32x2 b0 = *(const u32x2*)(vr + fq * 4), b1 = *(const u32x2*)(vr + 16 + fq * 4);
        bw[n6][0] = b0[0]; bw[n6][1] = b0[1]; bw[n6][2] = b1[0]; bw[n6][3] = b1[1];
        v0[n6] = *(const f32x4*)(P.in[I_V0] + (l - 1) * 384 + c);
        v[n6] = xs4t<SAMP>(P, l, row, 768 + c);
        vf[n6] = *(const u32x2*)(WSP(bf16_t, OFF_VF) + ro + c);
      }
#pragma unroll
      for (int n6 = 0; n6 < 6; ++n6) {
        const int c = cb + (hf * 6 + n6) * 16 + fq * 4;
        const f32x4 mv = __builtin_amdgcn_mfma_f32_16x16x32_bf16(__builtin_bit_cast(bf16x8, bw[n6]), A2, (f32x4){0.f, 0.f, 0.f, 0.f}, 0, 0, 0);
        const f32x4 vfv = unpack4(vf[n6]);
        f32x4 o;
#pragma unroll
        for (int j = 0; j < 4; ++j) o[j] = v[n6][j] + (vfv[j] - v[n6][j]) * sigm(v0[n6][j] + mv[j]);
        *(u32x2*)(WSP(bf16_t, OFF_RV) + ro + c) = pack4(o);
      }
    }
  }
}
__device__ __forceinline__ void prep_phase(const Params& P, unsigned char* smem, int l) {
  for (int it = obid(); it < 1092; it += gridDim.x) {
    if (it < 256) { const int wid = otid() >> 6; prep_rwkv_unit<false>(P, smem, l, it * 4 + (wid >> 1), wid & 1); }
    else if (it < 258) { const int wid = otid() >> 6; prep_rwkv_unit<true>(P, smem, l, it * 4 + (wid >> 1), wid & 1); }
    else if (it < 770) prep_gdn_prompt(P, l, it - 258);
    else if (it < 834) prep_gdn_sample(P, l, it - 770);
    else prep_hgrn(P, l, it - 834);
  }
  const bf16_t* p = WSP(bf16_t, OFF_P);
  for (int idx = obid() * 512 + otid(); idx < 136 * 1408; idx += gridDim.x * 512) {
    const int q = idx / 1408, col = idx - q * 1408;
    if (q < 8) P.out[O_SHIFT_P + (size_t)(l * 8 + q) * 1408 + col] = bf2f(p[(size_t)(q * TSEQ + TSEQ - 1) * PSTR + PB + col]);
    else P.out[O_SHIFT_S + (size_t)(l * 128 + (q - 8)) * 1408 + col] = bf2f(p[(size_t)(NTP + q - 8) * PSTR + PB + col]);
  }
}

template <int KIND> struct ScanCfg { static constexpr int STRIDE = KIND == 1 ? 356 : 164; };

template <int KIND> struct ScanPre { u32x2 a, b, c, d, v; f32x4 w; float g; };

template <int KIND>
__device__ __forceinline__ void scan_load(const Params& P, ScanPre<KIND>& r, int tid, int h, int half, int rowbase, int nvalid) {
  const int s = tid >> 4, j4 = (tid & 15) * 4;
  const int s2 = (tid >> 3) & 15, j2 = (tid & 7) * 4;
  const u32x2 z2 = {0u, 0u};
  const bool ok = s < nvalid, ok2 = (tid < 128) && (s2 < nvalid);
  if (KIND == 0) {
    const size_t o = (size_t)(rowbase + s) * 384 + h * 64 + j4;
    r.a = ok ? *(const u32x2*)(WSP(bf16_t, OFF_GK) + o) : z2;
    r.b = ok ? *(const u32x2*)(WSP(bf16_t, OFF_GQ) + o) : z2;
    r.v = ok2 ? *(const u32x2*)(WSP(bf16_t, OFF_GV) + (size_t)(rowbase + s2) * 384 + h * 64 + half * 32 + j2) : z2;
    const int sg = (tid >> 1) & 15;
    r.g = (tid < 32 && sg < nvalid) ? ((tid & 1) ? WSP(float, OFF_GBETA) : WSP(float, OFF_GDEC))[(size_t)(rowbase + sg) * 8 + h] : 0.f;
  } else if (KIND == 1) {
    const size_t o = (size_t)(rowbase + s) * 384 + h * 64 + j4;
    r.a = ok ? *(const u32x2*)(WSP(bf16_t, OFF_RR) + o) : z2;
    r.w = ok ? *(const f32x4*)(WSP(float, OFF_RW) + o) : (f32x4){0.f, 0.f, 0.f, 0.f};
    r.b = ok ? *(const u32x2*)(WSP(bf16_t, OFF_RK) + o) : z2;
    r.c = ok ? *(const u32x2*)(WSP(bf16_t, OFF_RKK) + o) : z2;
    r.d = ok ? *(const u32x2*)(WSP(bf16_t, OFF_RB) + o) : z2;
    r.v = ok2 ? *(const u32x2*)(WSP(bf16_t, OFF_RV) + (size_t)(rowbase + s2) * 384 + h * 64 + half * 32 + j2) : z2;
  } else {
    const size_t o = (size_t)(rowbase + s) * 256 + h * 64 + j4;
    r.a = ok ? *(const u32x2*)(WSP(bf16_t, OFF_HQ) + o) : z2;
    r.b = ok ? *(const u32x2*)(WSP(bf16_t, OFF_HK) + o) : z2;
    r.v = ok2 ? *(const u32x2*)(WSP(bf16_t, OFF_P) + (size_t)(rowbase + s2) * PSTR + PC + 512 + h * 64 + half * 32 + j2) : z2;
  }
}
template <int KIND>
__device__ __forceinline__ void scan_store(const ScanPre<KIND>& r, int tid, float* buf) {
  constexpr int STRIDE = ScanCfg<KIND>::STRIDE;
  const int s = tid >> 4, j4 = (tid & 15) * 4;
  const int s2 = (tid >> 3) & 15, j2 = (tid & 7) * 4;
  float* bs = buf + s * STRIDE + j4;
  if (KIND == 0) {
    const f32x4 k = unpack4(r.a), q = unpack4(r.b);
    *(f32x4*)(bs) = k; *(f32x4*)(bs + 64) = q;
    const float qk = row_sum16(dot4(q, k));
    if ((tid & 15) == 0) buf[s * STRIDE + 162] = qk;
    if (tid < 128) *(f32x4*)(buf + s2 * STRIDE + 128 + j2) = unpack4(r.v);
    if (tid < 32) buf[((tid >> 1) & 15) * STRIDE + 160 + (tid & 1)] = r.g;
  } else if (KIND == 1) {
    const f32x4 rr = unpack4(r.a), k = unpack4(r.b), kk = unpack4(r.c), bb = unpack4(r.d);
    *(f32x4*)(bs) = r.w * rr; *(f32x4*)(bs + 64) = r.w; *(f32x4*)(bs + 128) = k;
    *(f32x4*)(bs + 192) = kk; *(f32x4*)(bs + 256) = bb;
    const float br = row_sum16(dot4(bb, rr)), kr = row_sum16(dot4(k, rr));
    if ((tid & 15) == 0) { buf[s * STRIDE + 352] = br; buf[s * STRIDE + 353] = kr; }
    if (tid < 128) *(f32x4*)(buf + s2 * STRIDE + 320 + j2) = unpack4(r.v);
  } else {
    const f32x4 q = unpack4(r.a), k = unpack4(r.b);
    *(f32x4*)(bs) = q * (1.f - k); *(f32x4*)(bs + 64) = k;
    const float qk = row_sum16(dot4(q, k));
    if ((tid & 15) == 0) buf[s * STRIDE + 160] = qk;
    if (tid < 128) *(f32x4*)(buf + s2 * STRIDE + 128 + j2) = unpack4(r.v);
  }
}

template <int KIND> struct StepOps { f32x2 a[4], b[4], c[4], d[4], e[4]; float v, s0, s1, s2; };
template <int KIND>
__device__ __forceinline__ void step_load(StepOps<KIND>& o, const float* bs, int e0, int cl) {
#define LD8(dst, off) { const f32x4 _x = *(const f32x4*)(bs + (off) + e0), _y = *(const f32x4*)(bs + (off) + e0 + 4); \
    dst[0] = (f32x2){_x[0], _x[1]}; dst[1] = (f32x2){_x[2], _x[3]}; dst[2] = (f32x2){_y[0], _y[1]}; dst[3] = (f32x2){_y[2], _y[3]}; }
  if (KIND == 0) {
    LD8(o.a, 0) LD8(o.b, 64)
    o.v = bs[128 + cl];
    const f32x4 sc = *(const f32x4*)(bs + 160); o.s0 = sc[0]; o.s1 = sc[1]; o.s2 = sc[2];
  } else if (KIND == 1) {
    LD8(o.a, 0) LD8(o.b, 64) LD8(o.c, 128) LD8(o.d, 192) LD8(o.e, 256)
    o.v = bs[320 + cl];
    const f32x2 sc = *(const f32x2*)(bs + 352); o.s0 = sc[0]; o.s1 = sc[1];
  } else {
    LD8(o.a, 0) LD8(o.b, 64)
    o.v = bs[128 + cl]; o.s0 = bs[160];
  }
#undef LD8
}
template <int KIND>
__device__ __forceinline__ float step_compute(const StepOps<KIND>& o, f32x2 (&S)[4]) {
  if (KIND == 0) {
    f32x2 ks2 = o.a[0] * S[0], qs2 = o.b[0] * S[0];
#pragma unroll
    for (int i = 1; i < 4; ++i) { ks2 += o.a[i] * S[i]; qs2 += o.b[i] * S[i]; }
    float ks = ks2[0] + ks2[1], qs = qs2[0] + qs2[1];
    ks += dppf<0xB1>(ks); qs += dppf<0xB1>(qs); ks += dppf<0x4E>(ks); qs += dppf<0x4E>(qs); ks += dppf<0x141>(ks); qs += dppf<0x141>(qs);
    const float dec = o.s0, vn = o.s1 * (o.v - dec * ks);
#pragma unroll
    for (int i = 0; i < 4; ++i) S[i] = S[i] * dec + o.a[i] * vn;
    return dec * qs + vn * o.s2;
  } else if (KIND == 1) {
    f32x2 sa2 = o.d[0] * S[0], p2 = o.a[0] * S[0];
#pragma unroll
    for (int i = 1; i < 4; ++i) { sa2 += o.d[i] * S[i]; p2 += o.a[i] * S[i]; }
    float sa = sa2[0] + sa2[1], p1 = p2[0] + p2[1];
    sa += dppf<0xB1>(sa); p1 += dppf<0xB1>(p1); sa += dppf<0x4E>(sa); p1 += dppf<0x4E>(p1); sa += dppf<0x141>(sa); p1 += dppf<0x141>(p1);
    sa = -sa;
#pragma unroll
    for (int i = 0; i < 4; ++i) S[i] = S[i] * o.b[i] + (o.e[i] * sa + o.c[i] * o.v);
    return p1 + sa * o.s0 + o.v * o.s1;
  } else {
    f32x2 p2 = o.a[0] * S[0];
#pragma unroll
    for (int i = 1; i < 4; ++i) p2 += o.a[i] * S[i];
    float p1 = p2[0] + p2[1];
    p1 += dppf<0xB1>(p1); p1 += dppf<0x4E>(p1); p1 += dppf<0x141>(p1);
#pragma unroll
    for (int i = 0; i < 4; ++i) S[i] = S[i] + o.b[i] * (o.v - S[i]);
    return p1 + o.v * o.s0;
  }
}

template <int KIND>
__device__ __forceinline__ void scan_task(const Params& P, unsigned char* smem, int l, int seq, int h, int half, int mode) {
  constexpr int STRIDE = ScanCfg<KIND>::STRIDE, NEL = 16 * STRIDE;
  constexpr int NH = KIND == 2 ? 4 : 6;
  float* buf = (float*)smem;
  float* obuf = buf + 2 * NEL;
  const bool do_comp = mode != 2, do_stage = mode != 1;
  const int tid = otid() & 255, lane = tid & 63, wid = tid >> 6;
  const int col_l = lane >> 3, sub = lane & 7, cl = wid * 8 + col_l, col = half * 32 + cl, e0 = sub * 8;
  const bool sample = seq >= 8;
  const int R0 = sample ? NTP + (seq - 8) : seq * TSEQ, T = sample ? 1 : TSEQ;
  const int ocol = (KIND == 0 ? 0 : (KIND == 1 ? 384 : 768)) + h * 64 + half * 32;
  const size_t O_P = KIND == 0 ? O_GDN_P : (KIND == 1 ? O_RWKV_P : O_HGRN_P);
  const size_t O_S = KIND == 0 ? O_GDN_S : (KIND == 1 ? O_RWKV_S : O_HGRN_S);
  const int I_ST = KIND == 0 ? I_SGDN : (KIND == 1 ? I_SRWKV : I_SHGRN);
  const int nchunks = (T + 15) >> 4;
  bf16_t* oraw = WSP(bf16_t, OFF_P);
  f32x2 S[4];
#pragma unroll
  for (int i = 0; i < 4; ++i) S[i] = (f32x2){0.f, 0.f};
  if (sample && do_comp) {
    const float* st = P.in[I_ST] + ((size_t)(l * 128 + (seq - 8)) * NH + h) * 4096;
#pragma unroll
    for (int i = 0; i < 8; ++i) S[i >> 1][i & 1] = KIND == 1 ? st[col * 64 + e0 + i] : st[(e0 + i) * 64 + col];
  }
#pragma unroll
  for (int i = 0; i < 4; ++i) asm volatile("" : "+v"(S[i]));
  ScanPre<KIND> pre;
  __syncthreads();
  if (do_stage) {
    scan_load<KIND>(P, pre, tid, h, half, R0, T); scan_store<KIND>(pre, tid, buf);
    if (nchunks > 1) scan_load<KIND>(P, pre, tid, h, half, R0 + 16, T - 16);
  }
  __syncthreads();
  for (int c = 0; c < nchunks; ++c) {
    const int t0 = c * 16, n = (T - t0) < 16 ? (T - t0) : 16;
    if (do_stage) {
      if (c + 1 < nchunks) scan_store<KIND>(pre, tid, buf + ((c + 1) & 1) * NEL);
      if (c > 0) {
        const float* pob = obuf + ((c - 1) & 1) * 512;
        const int s = tid >> 4, cc = (tid & 15) * 2;
        const f32x2 ov = *(const f32x2*)(pob + s * 32 + cc);
        *(unsigned*)(oraw + (size_t)(R0 + t0 - 16 + s) * PSTR + ocol + cc) = pk2(ov[0], ov[1]);
      }
      if (c + 2 < nchunks) scan_load<KIND>(P, pre, tid, h, half, R0 + t0 + 32, T - t0 - 32);
    }
    if (do_comp) {
      const float* b = buf + (c & 1) * NEL;
      float* ob = obuf + (c & 1) * 512;
      if (n == 16) {
        StepOps<KIND> A, B;
        step_load<KIND>(A, b, e0, cl);
#pragma unroll
        for (int s = 0; s < 16; s += 2) {
          step_load<KIND>(B, b + (s + 1) * STRIDE, e0, cl);
          const float o0 = step_compute<KIND>(A, S);
          ob[s * 32 + cl] = o0;
          step_load<KIND>(A, b + (s + 2 < 16 ? s + 2 : 15) * STRIDE, e0, cl);
          const float o1 = step_compute<KIND>(B, S);
          ob[(s + 1) * 32 + cl] = o1;
        }
      } else {
        for (int s = 0; s < n; ++s) {
          StepOps<KIND> A;
          step_load<KIND>(A, b + s * STRIDE, e0, cl);
          const float o0 = step_compute<KIND>(A, S);
          ob[s * 32 + cl] = o0;
        }
      }
    }
    __syncthreads();
  }
  if (do_stage) {
    const int c = nchunks - 1, t0 = c * 16, n = T - t0;
    const float* pob = obuf + (c & 1) * 512;
    const int s = tid >> 4, cc = (tid & 15) * 2;
    const f32x2 ov = *(const f32x2*)(pob + s * 32 + cc);
    if (s < n) *(unsigned*)(oraw + (size_t)(R0 + t0 + s) * PSTR + ocol + cc) = pk2(ov[0], ov[1]);
  }
  if (do_comp) {
    float* so = P.out + (sample ? O_S + ((size_t)(l * 128 + (seq - 8)) * NH + h) * 4096 : O_P + ((size_t)(l * 8 + seq) * NH + h) * 4096);
#pragma unroll
    for (int i = 0; i < 8; ++i) { if (KIND == 1) so[col * 64 + e0 + i] = S[i >> 1][i & 1]; else so[(e0 + i) * 64 + col] = S[i >> 1][i & 1]; }
  }
}

__device__ __forceinline__ void scan_phase(const Params& P, unsigned char* smem, int l, volatile unsigned* blk  ) {
  unsigned* q = WSP(unsigned, OFF_QUEUE) + l * 128;
  const int grp = otid() >> 8;
  for (int pass = 0; pass < 2; ++pass) {
    unsigned* qq = pass == 1 ? q + 64 : q;
    const unsigned ntask = pass == 1 ? 2048u : 256u;
    for (;;) {
      __syncthreads();
      if (threadIdx.x == 0) blk[3] = __hip_atomic_fetch_add(qq, 1u, __ATOMIC_RELAXED, __HIP_MEMORY_SCOPE_AGENT);
      __syncthreads();
      const int t = (int)blk[3];
      if (t >= (int)ntask) break;
      int kind, seq, h, half, act; unsigned char* sm;
      if (pass == 0) {
        act = grp == 0 ? 1 : 2; sm = smem; half = t & 1;
        if (t < 96) { kind = 1; const int bh = t >> 1; seq = bh / 6; h = bh % 6; }
        else if (t < 192) { kind = 0; const int bh = (t - 96) >> 1; seq = bh / 6; h = bh % 6; }
        else { kind = 2; const int bh = (t - 192) >> 1; seq = bh / 4; h = bh % 4; }
      } else {
        const int hh = t & 15;
        act = 0; sm = smem + grp * 51200; half = grp; seq = 8 + (t >> 4);
        if (hh < 6) { kind = 0; h = hh; } else if (hh < 12) { kind = 1; h = hh - 6; } else { kind = 2; h = hh - 12; }
      }
      if (kind == 0) scan_task<0>(P, sm, l, seq, h, half, act);
      else if (kind == 1) scan_task<1>(P, sm, l, seq, h, half, act);
      else scan_task<2>(P, sm, l, seq, h, half, act);
    }
  }
  if (l + 1 < NLAYER) {
    for (;;) {
      __syncthreads();
      if (threadIdx.x == 0) blk[3] = __hip_atomic_fetch_add(q + 96, 1u, __ATOMIC_RELAXED, __HIP_MEMORY_SCOPE_AGENT);
      __syncthreads();
      const unsigned t = blk[3];
      if (t >= (unsigned)WCONV_JOBS) break;
      wconv_job(P, smem, l + 1, (int)t);
    }
  }
  if (l == 0) {
    for (;;) {
      __syncthreads();
      if (threadIdx.x == 0) blk[3] = __hip_atomic_fetch_add(q + 112, 1u, __ATOMIC_RELAXED, __HIP_MEMORY_SCOPE_AGENT);
      __syncthreads();
      const unsigned t = blk[3];
      if (t >= 2368u) break;
      wconv_job(P, smem, 0, 1024 + (int)t);
    }
  }
}

__device__ __forceinline__ void post_phase(const Params& P, int l) {
  const int lane = otid() & 63, wid = otid() >> 6, hl = lane >> 5, c2 = (lane & 31) * 2;
  const bf16_t* p = WSP(bf16_t, OFF_P);
  bf16_t* act = WSP(bf16_t, OFF_ACT);
  const int gw = obid() * 8 + wid, nw = gridDim.x * 8;
  const f32x2 gnw = *(const f32x2*)(P.in[I_GNW] + l * 64 + c2), hnw = *(const f32x2*)(P.in[I_HNW] + l * 64 + c2);
  for (int u0 = gw * 8; u0 < NTOK * 10; u0 += nw * 8) {
    unsigned o[4], z[4]; int oc[4]; size_t rb[4];
#pragma unroll
    for (int k = 0; k < 4; ++k) {
      const int u = u0 + 2 * k + hl, row = u / 10, q = u - row * 10;
      oc[k] = q < 6 ? q * 64 : 768 + (q - 6) * 64;
      const int zc = q < 6 ? 1152 + q * 64 : PC + 768 + (q - 6) * 64;
      rb[k] = (size_t)row;
      o[k] = *(const unsigned*)(p + (size_t)row * PSTR + oc[k] + c2);
      z[k] = *(const unsigned*)(p + (size_t)row * PSTR + zc + c2);
    }
#pragma unroll
    for (int k = 0; k < 4; ++k) {
      const float o0 = __uint_as_float(o[k] << 16), o1 = __uint_as_float(o[k] & 0xffff0000u);
      const float z0 = __uint_as_float(z[k] << 16), z1 = __uint_as_float(z[k] & 0xffff0000u);
      const float rn = rsqrtf(half_sum(o0 * o0 + o1 * o1) * (1.f / 64.f) + 1e-6f);
      const f32x2 w = oc[k] < 384 ? gnw : hnw;
      *(unsigned*)(act + rb[k] * 1024 + oc[k] + c2) = pk2(o0 * rn * w[0] * silu(z0), o1 * rn * w[1] * silu(z1));
    }
  }
  for (int u0 = gw * 4; u0 < NTOK * 6; u0 += nw * 4) {
    unsigned o[2], r[2], kx[2], v[2], g[2]; int hh[2]; size_t rb[2];
#pragma unroll
    for (int k = 0; k < 2; ++k) {
      const int u = u0 + 2 * k + hl, row = u / 6, h = u - row * 6;
      const size_t idx = (size_t)row * 384 + h * 64 + c2;
      hh[k] = h; rb[k] = (size_t)row;
      o[k] = *(const unsigned*)(p + (size_t)row * PSTR + 384 + h * 64 + c2);
      r[k] = *(const unsigned*)(WSP(bf16_t, OFF_RR) + idx); kx[k] = *(const unsigned*)(WSP(bf16_t, OFF_RK) + idx);
      v[k] = *(const unsigned*)(WSP(bf16_t, OFF_RV) + idx); g[k] = *(const unsigned*)(WSP(bf16_t, OFF_RG) + idx);
    }
#pragma unroll
    for (int k = 0; k < 2; ++k) {
      const int hc = l * 384 + hh[k] * 64 + c2;
      const f32x2 lw = *(const f32x2*)(P.in[I_LNW] + hc), lb = *(const f32x2*)(P.in[I_LNB] + hc), rkw = *(const f32x2*)(P.in[I_RK] + hc);
      const float o0 = __uint_as_float(o[k] << 16), o1 = __uint_as_float(o[k] & 0xffff0000u);
      const float r0 = __uint_as_float(r[k] << 16), r1 = __uint_as_float(r[k] & 0xffff0000u);
      const float k0 = __uint_as_float(kx[k] << 16), k1 = __uint_as_float(kx[k] & 0xffff0000u);
      const float v0 = __uint_as_float(v[k] << 16), v1 = __uint_as_float(v[k] & 0xffff0000u);
      const float g0 = __uint_as_float(g[k] << 16), g1 = __uint_as_float(g[k] & 0xffff0000u);
      const float mu = half_sum(o0 + o1) * (1.f / 64.f);
      const float y0 = o0 - mu, y1 = o1 - mu;
      const float rn = rsqrtf(half_sum(y0 * y0 + y1 * y1) * (1.f / 64.f) + 64e-5f);
      const float rk = half_sum(r0 * k0 * rkw[0] + r1 * k1 * rkw[1]);
      *(unsigned*)(act + rb[k] * 1024 + 384 + hh[k] * 64 + c2) = pk2((y0 * rn * lw[0] + lb[0] + rk * v0) * g0, (y1 * rn * lw[1] + lb[1] + rk * v1) * g1);
    }
  }
}

#define XB_TMO      128
#define XB_XCNT(j)  (256  + 64 * (j))
#define XB_XSUB(j)  (1280 + 64 * (j))
#define XB_XGEN(j)  (2304 + 64 * (j))
#define XB_TOP      3328
#define XB_TOPGEN   3392
#define XCD_BAR_WORDS 3456
#define XB_SPIN_CAP (1u << 20)
#define LAS __attribute__((address_space(3)))
__device__ __forceinline__ unsigned xb_ld(unsigned* p)              { return __hip_atomic_load(p, __ATOMIC_RELAXED, __HIP_MEMORY_SCOPE_AGENT); }
__device__ __forceinline__ unsigned xb_add(unsigned* p, unsigned v) { return __hip_atomic_fetch_add(p, v, __ATOMIC_RELAXED, __HIP_MEMORY_SCOPE_AGENT); }
__device__ __forceinline__ unsigned xb_xcc_id() { return (unsigned)__builtin_amdgcn_s_getreg((3 << 11) | 20) & 0xFu; }
#define XB_SPIN(cond, bar) do { unsigned _sp = 0; while (cond) { __builtin_amdgcn_s_sleep(1); \
    if ((++_sp & 255u) == 0u) { if (xb_ld(&(bar)[XB_TMO])) break; if (_sp > XB_SPIN_CAP) { atomicAdd(&(bar)[XB_TMO], 1u); break; } } } } while (0)
struct XcdBarrier { unsigned* bar; unsigned x; volatile LAS unsigned* st; };
__device__ __forceinline__ XcdBarrier xcd_barrier_post(unsigned* bar, volatile LAS unsigned* st) {
  XcdBarrier b; b.bar = bar; b.x = xb_xcc_id(); b.st = st;
  if (threadIdx.x == 0) (void)xb_add(&bar[XB_XCNT(b.x)], 1u);
  return b;
}
__device__ __forceinline__ void xcd_barrier_complete(unsigned* bar, unsigned x, unsigned& nloc, unsigned& nx) {
  const unsigned G = gridDim.x * gridDim.y * gridDim.z;
  unsigned sum, cnt, mine, sp = 0u;
  for (;;) {
    sum = 0u; cnt = 0u; mine = 0u;
#pragma unroll
    for (unsigned j = 0; j < 16; ++j) { const unsigned c = xb_ld(&bar[XB_XCNT(j)]); sum += c; cnt += (c > 0u) ? 1u : 0u; mine = (j == x) ? c : mine; }
    if (sum == G) break;
    __builtin_amdgcn_s_sleep(1);
    if ((++sp & 255u) == 0u) { if (xb_ld(&bar[XB_TMO])) break; if (sp > XB_SPIN_CAP) { atomicAdd(&bar[XB_TMO], 1u); break; } }
  }
  nloc = mine > 0u ? mine : 1u; nx = cnt > 0u ? cnt : 1u;
}
__device__ __forceinline__ void xcd_barrier(const XcdBarrier& b) {
  asm volatile("s_waitcnt vmcnt(0)" ::: "memory");
  __syncthreads();
  if (threadIdx.x == 0) {
    unsigned* bar = b.bar;
    __builtin_amdgcn_s_waitcnt(0);
    unsigned nloc = b.st[0], nx = b.st[1];
    if (nloc == 0u) { xcd_barrier_complete(bar, b.x, nloc, nx); b.st[0] = nloc; b.st[1] = nx; }
    const unsigned old = xb_add(&bar[XB_XSUB(b.x)], 1u);
    const unsigned gen = old / nloc;
    if (old + 1u == (gen + 1u) * nloc) {
      __builtin_amdgcn_fence(__ATOMIC_RELEASE, "agent");
      asm volatile("s_waitcnt vmcnt(0)" ::: "memory");
      const unsigned og = xb_add(&bar[XB_TOP], 1u);
      const unsigned tg = og / nx;
      if (og + 1u == (tg + 1u) * nx) xb_add(&bar[XB_TOPGEN], 1u);
      else XB_SPIN(xb_ld(&bar[XB_TOPGEN]) == tg, bar);
      __builtin_amdgcn_fence(__ATOMIC_ACQUIRE, "agent");
      xb_add(&bar[XB_XGEN(b.x)], 1u);
      asm volatile("s_waitcnt vmcnt(0)" ::: "memory");
    } else {
      XB_SPIN(xb_ld(&bar[XB_XGEN(b.x)]) == gen, bar);
      __builtin_amdgcn_fence(__ATOMIC_ACQUIRE, "agent");
      asm volatile("s_waitcnt vmcnt(0)" ::: "memory");
    }
  }
  __syncthreads();
}

__global__ void __launch_bounds__(512, 2) hybrid_fwd(Params P) {
  cg::grid_group grid = cg::this_grid();
  __shared__ __attribute__((aligned(16))) unsigned char smem[131072 + 64];
  uint4& xb_words = *(uint4*)(smem + 131072);
  if (threadIdx.x == 0) xb_words = make_uint4(0u, 0u, 0u, 0u);
  __syncthreads();
  const XcdBarrier xb = xcd_barrier_post(WSP(unsigned, OFF_BAR), (volatile LAS unsigned*)&xb_words);
  if (threadIdx.x == 0) {
    const unsigned hw = (unsigned)__builtin_amdgcn_s_getreg((7 << 11) | (8 << 6) | 4) & 0xffu;
    const unsigned key = (xb.x << 8) | hw;
    ((volatile unsigned*)&xb_words)[2] = __hip_atomic_fetch_add(WSP(unsigned, OFF_CUTAB) + key, 1u, __ATOMIC_RELAXED, __HIP_MEMORY_SCOPE_AGENT);
  }
  __syncthreads();
#pragma unroll 1
  for (int step = 0; step < NLAYER * 9; ++step) {
    const int l = step / 9, ph = step - l * 9;
    switch (ph) {
      case 0: if (l == 0) wconv_phase(P, smem, 0); norm_phase(P, l, P.in[I_NORM_MIX] + l * D); break;
      case 1: gemm_phase<EPI_P>(P, smem, WSP(bf16_t, OFF_ACT), 1024, WSP(bf16_t, OFF_WTIN), 1024, 32, l, 4096);
              gemm_sample<EPI_P>(P, smem, WSP(bf16_t, OFF_ACT), 1024, WSP(bf16_t, OFF_WTIN), 1024, 249, l); break;
      case 2: prep_phase(P, smem, l); break;
      case 3: scan_phase(P, smem, l, (volatile unsigned*)&xb_words); break;
      case 4: post_phase(P, l); break;
      case 5: gemm_phase<EPI_RES>(P, smem, WSP(bf16_t, OFF_ACT), 1024, WSP(bf16_t, wt_out_off(l)), 1024, 8, l, 1024);
              gemm_sample<EPI_RES>(P, smem, WSP(bf16_t, OFF_ACT), 1024, WSP(bf16_t, wt_out_off(l)), 1024, 64, l); break;
      case 6: norm_phase(P, 1, P.in[I_NORM_FFN] + l * D); break;
      case 7: gemm_phase<EPI_SWIGLU>(P, smem, WSP(bf16_t, OFF_ACT), 1024, WSP(bf16_t, wt_gu_off(l)), 1024, 44, 1, 5632);
              gemm_sample<EPI_SWIGLU>(P, smem, WSP(bf16_t, OFF_ACT), 1024, WSP(bf16_t, wt_gu_off(l)), 1024, 176, 1); break;
      default: gemm_phase<EPI_RES>(P, smem, WSP(bf16_t, OFF_P), DFF, WSP(bf16_t, wt_dn_off(l)), DFF, 8, 1, 1024);
               gemm_sample<EPI_RES>(P, smem, WSP(bf16_t, OFF_P), DFF, WSP(bf16_t, wt_dn_off(l)), DFF, 64, 1); break;
    }
    if (step == 0) grid.sync();
    else xcd_barrier(xb);
  }
  final_norm_phase(P);
}

extern "C" void kernel_launch(void* const* d_in, const int* in_sizes, int n_in,
                              void* d_out, int out_size, void* d_ws, size_t ws_size,
                              hipStream_t stream) {
  static int grid_blocks = 0;
  if (!grid_blocks) {
    int dev = 0, cus = 0, per_cu = 0;
    (void)hipGetDevice(&dev);
    (void)hipDeviceGetAttribute(&cus, hipDeviceAttributeMultiprocessorCount, dev);
    (void)hipOccupancyMaxActiveBlocksPerMultiprocessor(&per_cu, hybrid_fwd, 512, 0);
    if (per_cu > 1) per_cu = 1;
    if (per_cu < 1) per_cu = 1;
    grid_blocks = cus * per_cu;
  }
  if (ws_size < WS_NEED) { fprintf(stderr, "workspace too small: %zu < %zu\n", ws_size, (size_t)WS_NEED); return; }
  Params p{};
  for (int i = 0; i < N_IN; ++i) p.in[i] = (const float*)d_in[i];
  p.out = (float*)d_out;
  p.ws = (unsigned char*)d_ws;
  (void)hipMemsetAsync((unsigned char*)d_ws + OFF_BAR, 0, BAR_BYTES, stream);
  void* args[] = {&p};
  hipError_t e = hipLaunchCooperativeKernel((void*)hybrid_fwd, dim3(grid_blocks), dim3(512), args, 0, stream);
  if (e != hipSuccess) fprintf(stderr, "cooperative launch failed: %s (grid %d)\n", hipGetErrorString(e), grid_blocks);
}
```

```cpp
#include <hip/hip_runtime.h>
#include <hip/hip_cooperative_groups.h>
#include <cstdio>
namespace cg = cooperative_groups;

typedef unsigned short bf16_t;
typedef short bf16x8 __attribute__((ext_vector_type(8)));
typedef float f32x4 __attribute__((ext_vector_type(4)));
typedef unsigned u32x4 __attribute__((ext_vector_type(4)));
typedef unsigned u32x2 __attribute__((ext_vector_type(2)));

constexpr int D = 1024, NTP = 16384, NTS = 128, NTOK = 16512, TSEQ = 2048, NLAYER = 4;
constexpr int IN_COLS = 3980, PSTR = 3984, DFF = 2816;
constexpr int PB = 1548, PC = 2956;

enum { I_XP = 0, I_XS, I_SGDN, I_SCONV, I_SRWKV, I_SSHIFT, I_SHGRN, I_NORM_MIX, I_WIN, I_WOUT, I_CONVW, I_ALOG, I_DTB, I_GNW,
       I_MU, I_W0, I_W2, I_A0, I_A2, I_G2, I_V0, I_V1, I_V2, I_KK, I_KA, I_RK, I_LNW, I_LNB, I_HLB, I_HNW, I_NORM_FFN,
       I_WG, I_WU, I_WD, I_NORM_FINAL, N_IN };

constexpr size_t O_YP = 0, O_YS = 16777216, O_GDN_P = 16908288, O_GDN_S = 17694720, O_CONV_P = 30277632, O_CONV_S = 30388224,
                 O_RWKV_P = 32157696, O_RWKV_S = 32944128, O_SHIFT_P = 45527040, O_SHIFT_S = 45572096, O_HGRN_P = 46292992,
                 O_HGRN_S = 46817280;

constexpr size_t SZ_WTIN = (size_t)4096 * 1024 * 2, SZ_WTOUT = (size_t)1024 * 1024 * 2, SZ_WTGU = (size_t)5632 * 1024 * 2,
                 SZ_WTDN = (size_t)1024 * 2816 * 2, SZ_P = (size_t)NTOK * PSTR * 2, SZ_ACT = (size_t)NTOK * 1024 * 2,
                 SZ_T384 = (size_t)NTOK * 384 * 2, SZ_T8F = (size_t)NTOK * 8 * 4, SZ_T256 = (size_t)NTOK * 256 * 2,
                 SZ_T384F = (size_t)NTOK * 384 * 4;
constexpr size_t OFF_WTIN = 0, OFF_WTOUT = OFF_WTIN + SZ_WTIN, OFF_WTGU = OFF_WTOUT + SZ_WTOUT, OFF_WTDN = OFF_WTGU + SZ_WTGU,
                 OFF_P = OFF_WTDN + SZ_WTDN, OFF_ACT = OFF_P + SZ_P, OFF_GQ = OFF_ACT + SZ_ACT, OFF_GK = OFF_GQ + SZ_T384,
                 OFF_GV = OFF_GK + SZ_T384, OFF_GDEC = OFF_GV + SZ_T384, OFF_GBETA = OFF_GDEC + SZ_T8F, OFF_HQ = OFF_GBETA + SZ_T8F,
                 OFF_HK = OFF_HQ + SZ_T256, OFF_RR = OFF_HK + SZ_T256, OFF_RK = OFF_RR + SZ_T384, OFF_RV = OFF_RK + SZ_T384,
                 OFF_RKK = OFF_RV + SZ_T384, OFF_RB = OFF_RKK + SZ_T384, OFF_RG = OFF_RB + SZ_T384, OFF_RW = OFF_RG + SZ_T384,
                 OFF_VF = OFF_RW + SZ_T384F, OFF_LORA = OFF_VF + SZ_T384, OFF_WTOUT2 = OFF_LORA + 245760, OFF_WTGU2 = OFF_WTOUT2 + SZ_WTOUT, OFF_WTDN2 = OFF_WTGU2 + SZ_WTGU, OFF_BAR = OFF_WTDN2 + SZ_WTDN, OFF_CUTAB = OFF_BAR + 16384, OFF_QUEUE = OFF_CUTAB + 16384, BAR_BYTES = 16384 + 16384 + 4096, WS_NEED = OFF_BAR + BAR_BYTES;
constexpr int W2T = 0, A2T = 24576, G2T = 49152, V1T = 98304, V2T = 110592;

struct Params {
  const float* in[N_IN];
  float* out;
  unsigned char* ws;
};

#define WSP(T, off) ((T*)(P.ws + (off)))

__device__ __forceinline__ int otid() { int t = __builtin_amdgcn_workitem_id_x(); asm volatile("" : "+v"(t)); return t; }
__device__ __forceinline__ int obid() { int b = __builtin_amdgcn_workgroup_id_x(); asm volatile("" : "+s"(b)); return b; }
template <class T> __device__ __forceinline__ const T* opq(const T* p) { asm volatile("" : "+s"(p)); return p; }
__device__ __forceinline__ float bf2f(bf16_t h) { return __uint_as_float(((unsigned)h) << 16); }
typedef float f32x2_t __attribute__((ext_vector_type(2)));
typedef __bf16 bf16x2_t __attribute__((ext_vector_type(2)));
__device__ __forceinline__ unsigned pk2(float lo, float hi) {
  const f32x2_t v = {lo, hi};
  return __builtin_bit_cast(unsigned, __builtin_convertvector(v, bf16x2_t));
}
__device__ __forceinline__ bf16_t f2bf(float f) { return (bf16_t)(pk2(f, 0.f) & 0xffffu); }
__device__ __forceinline__ float sigm(float x) { return 1.f / (1.f + __expf(-x)); }
__device__ __forceinline__ float silu(float x) { return x / (1.f + __expf(-x)); }
__device__ __forceinline__ float softplus(float x) { return x > 20.f ? x : log1pf(__expf(x)); }
template <int CTRL> __device__ __forceinline__ float dppf(float x) {
  return __builtin_bit_cast(float, __builtin_amdgcn_mov_dpp(__builtin_bit_cast(int, x), CTRL, 0xf, 0xf, true));
}
__device__ __forceinline__ float wave_sum(float v) {
  v += dppf<0xB1>(v); v += dppf<0x4E>(v); v += dppf<0x141>(v); v += dppf<0x140>(v);
  const int iv = __builtin_bit_cast(int, v);
  const float s0 = __builtin_bit_cast(float, __builtin_amdgcn_readlane(iv, 0)), s1 = __builtin_bit_cast(float, __builtin_amdgcn_readlane(iv, 16));
  const float s2 = __builtin_bit_cast(float, __builtin_amdgcn_readlane(iv, 32)), s3 = __builtin_bit_cast(float, __builtin_amdgcn_readlane(iv, 48));
  return (s0 + s1) + (s2 + s3);
}
typedef float f32x2 __attribute__((ext_vector_type(2)));
__device__ __forceinline__ float row_sum16(float v) { v += dppf<0xB1>(v); v += dppf<0x4E>(v); v += dppf<0x141>(v); v += dppf<0x140>(v); return v; }
__device__ __forceinline__ float half_sum(float v) { v = row_sum16(v); return v + __shfl_xor(v, 16); }
__device__ __forceinline__ float reduce8(float x) { x += dppf<0xB1>(x); x += dppf<0x4E>(x); x += dppf<0x141>(x); return x; }

__device__ __forceinline__ f32x4 unpack4(u32x2 w) {
  f32x4 f; f[0] = __uint_as_float(w[0] << 16); f[1] = __uint_as_float(w[0] & 0xffff0000u);
  f[2] = __uint_as_float(w[1] << 16); f[3] = __uint_as_float(w[1] & 0xffff0000u); return f;
}
__device__ __forceinline__ bf16x8 pack8(f32x4 a, f32x4 b) {
  u32x4 u; u[0] = pk2(a[0], a[1]); u[1] = pk2(a[2], a[3]); u[2] = pk2(b[0], b[1]); u[3] = pk2(b[2], b[3]);
  return __builtin_bit_cast(bf16x8, u);
}
__device__ __forceinline__ u32x2 pack4(f32x4 a) { u32x2 u; u[0] = pk2(a[0], a[1]); u[1] = pk2(a[2], a[3]); return u; }
__device__ __forceinline__ float dot4(f32x4 a, f32x4 b) { return (a[0] * b[0] + a[1] * b[1]) + (a[2] * b[2] + a[3] * b[3]); }
__device__ __forceinline__ const float* xin_row(const Params& P, int l, int row) {
  const float* po = opq((const float*)P.out); const float* pp = opq(P.in[I_XP]); const float* ps = opq(P.in[I_XS]);
  if (l > 0) return po + (size_t)row * D;
  return row < NTP ? pp + (size_t)row * D : ps + (size_t)(row - NTP) * D;
}

__device__ __forceinline__ int gu_row(int c, int up) { return (c >> 7) * 256 + up * 128 + (c & 127); }
__device__ __forceinline__ void xpose_tile(unsigned char* smem, const float* __restrict__ W, int N, int kt, int ntl, bf16_t* __restrict__ dst, int dstK, int mode) {
  float (*tile)[65] = (float (*)[65])smem;
  const int tid = otid();
  __syncthreads();
#pragma unroll 4
  for (int i = 0; i < 8; ++i) {
    const int k = i * 8 + (tid >> 6), n = tid & 63, gn = ntl * 64 + n;
    tile[k][n] = gn < N ? W[(size_t)(kt * 64 + k) * N + gn] : 0.f;
  }
  __syncthreads();
#pragma unroll 4
  for (int i = 0; i < 4; ++i) {
    const int n = i * 16 + (tid >> 5), k = (tid & 31) * 2, gn = ntl * 64 + n;
    const int drow = mode == 0 ? gn : gu_row(gn, mode - 1);
    *(unsigned*)(dst + (size_t)drow * dstK + kt * 64 + k) = pk2(tile[k][n], tile[k + 1][n]);
  }
}
constexpr int WCONV_JOBS = 3392 + 480;
__device__ __forceinline__ size_t wt_out_off(int l) { return (l & 1) ? OFF_WTOUT2 : OFF_WTOUT; }
__device__ __forceinline__ size_t wt_gu_off(int l) { return (l & 1) ? OFF_WTGU2 : OFF_WTGU; }
__device__ __forceinline__ size_t wt_dn_off(int l) { return (l & 1) ? OFF_WTDN2 : OFF_WTDN; }
__device__ __forceinline__ void wconv_job(const Params& P, unsigned char* smem, int l, int job) {
  if (job < 1024) xpose_tile(smem, P.in[I_WIN] + (size_t)l * 1024 * IN_COLS, IN_COLS, job & 15, job >> 4, WSP(bf16_t, OFF_WTIN), 1024, 0);
  else if (job < 1280) { const int j = job - 1024; xpose_tile(smem, P.in[I_WOUT] + (size_t)l * 1024 * 1024, 1024, j & 15, j >> 4, WSP(bf16_t, wt_out_off(l)), 1024, 0); }
  else if (job < 1984) { const int j = job - 1280; xpose_tile(smem, P.in[I_WG] + (size_t)l * 1024 * DFF, DFF, j & 15, j >> 4, WSP(bf16_t, wt_gu_off(l)), 1024, 1); }
  else if (job < 2688) { const int j = job - 1984; xpose_tile(smem, P.in[I_WU] + (size_t)l * 1024 * DFF, DFF, j & 15, j >> 4, WSP(bf16_t, wt_gu_off(l)), 1024, 2); }
  else if (job < 3392) { const int j = job - 2688; xpose_tile(smem, P.in[I_WD] + (size_t)l * DFF * 1024, 1024, j % 44, j / 44, WSP(bf16_t, wt_dn_off(l)), DFF, 0); }
  else {
    bf16_t* lw = WSP(bf16_t, OFF_LORA);
    const int idx = (job - 3392) * 256 + (otid() & 255);
    float v = 0.f;
    const float* pw2 = opq(P.in[I_W2]); const float* pa2 = opq(P.in[I_A2]); const float* pg2 = opq(P.in[I_G2]);
    const float* pv1 = opq(P.in[I_V1]); const float* pv2 = opq(P.in[I_V2]);
    if (idx < A2T) { const int n = idx >> 6, k = idx & 63; v = pw2[(size_t)l * 64 * 384 + k * 384 + n]; }
    else if (idx < G2T) { const int i = idx - A2T, n = i >> 6, k = i & 63; v = pa2[(size_t)l * 64 * 384 + k * 384 + n]; }
    else if (idx < V1T) { const int i = idx - G2T, n = i >> 7, k = i & 127; v = pg2[(size_t)l * 128 * 384 + k * 384 + n]; }
    else if (idx < V2T) { if (l > 0) { const int i = idx - V1T, n = i / 384, k = i - n * 384; v = pv1[(size_t)(l - 1) * 384 * 32 + k * 32 + n]; } }
    else { if (l > 0) { const int i = idx - V2T, n = i >> 5, k = i & 31; v = pv2[(size_t)(l - 1) * 32 * 384 + k * 384 + n]; } }
    if (otid() < 256) lw[idx] = f2bf(v);
  }
}
__device__ __forceinline__ void wconv_phase(const Params& P, unsigned char* smem, int l) {
  for (int j = obid(); j < 1024 + 480; j += gridDim.x) wconv_job(P, smem, l, j < 1024 ? j : j + 2368);
}

__device__ __forceinline__ void norm_phase(const Params& P, int l_in, const float* __restrict__ w) {
  bf16_t* act = WSP(bf16_t, OFF_ACT);
  const int lane = otid() & 63, wid = otid() >> 6;
  f32x4 wv[4];
#pragma unroll
  for (int i = 0; i < 4; ++i) wv[i] = *(const f32x4*)(w + i * 256 + lane * 4);
  for (int r0 = (obid() * 8 + wid) * 4; r0 < NTOK; r0 += gridDim.x * 32) {
    f32x4 v[4][4];
#pragma unroll
    for (int r = 0; r < 4; ++r) {
      const float* xr = xin_row(P, l_in, r0 + r);
#pragma unroll
      for (int i = 0; i < 4; ++i) v[r][i] = *(const f32x4*)(xr + i * 256 + lane * 4);
    }
#pragma unroll
    for (int r = 0; r < 4; ++r) {
      float ss = 0.f;
#pragma unroll
      for (int i = 0; i < 4; ++i) ss += dot4(v[r][i], v[r][i]);
      const float rstd = rsqrtf(wave_sum(ss) * (1.f / 1024.f) + 1e-6f);
#pragma unroll
      for (int i = 0; i < 4; ++i) *(u32x2*)(act + (size_t)(r0 + r) * 1024 + i * 256 + lane * 4) = pack4(v[r][i] * rstd * wv[i]);
    }
  }
}
__device__ __forceinline__ void final_norm_phase(const Params& P) {
  const float* w = P.in[I_NORM_FINAL];
  const int lane = otid() & 63, wid = otid() >> 6;
  f32x4 wv[4];
#pragma unroll
  for (int i = 0; i < 4; ++i) wv[i] = *(const f32x4*)(w + i * 256 + lane * 4);
  for (int r0 = (obid() * 8 + wid) * 4; r0 < NTOK; r0 += gridDim.x * 32) {
    f32x4 v[4][4];
#pragma unroll
    for (int r = 0; r < 4; ++r)
#pragma unroll
      for (int i = 0; i < 4; ++i) v[r][i] = *(const f32x4*)(P.out + (size_t)(r0 + r) * D + i * 256 + lane * 4);
#pragma unroll
    for (int r = 0; r < 4; ++r) {
      float ss = 0.f;
#pragma unroll
      for (int i = 0; i < 4; ++i) ss += dot4(v[r][i], v[r][i]);
      const float rstd = rsqrtf(wave_sum(ss) * (1.f / 1024.f) + 1e-6f);
#pragma unroll
      for (int i = 0; i < 4; ++i) *(f32x4*)(P.out + (size_t)(r0 + r) * D + i * 256 + lane * 4) = v[r][i] * rstd * wv[i];
    }
  }
}

enum { EPI_P = 0, EPI_RES = 1, EPI_SWIGLU = 2 };
namespace pg8 {
constexpr int BM = 256, BK = 64, HALF = 128, HTB = HALF * BK * 2, NXCD = 8, WGM = 8;
__device__ __forceinline__ int lds_byte(int r, int c) { const int st = (r >> 4) * 2 + (c >> 5), rr = r & 15, cc = c & 31, ob = rr * 64 + cc * 2; return st * 1024 + (ob ^ (((ob >> 9) & 1) << 5)); }
__device__ __forceinline__ void stage_rc(int b, int& R, int& C) { const int st = b / 1024, sb = b % 1024, swz = sb ^ (((sb >> 9) & 1) << 5); R = (st >> 1) * 16 + swz / 64; C = (st & 1) * 32 + (swz % 64) / 2; }
__device__ __forceinline__ int perm32(int rho) { const int n = rho >> 4, i = rho & 15; return 8 * (i >> 2) + 4 * n + (i & 3); }
struct Unit { int pm, pn; };
struct StaticOrder {
  int nM, nN, nwg, G, c;
  __device__ __forceinline__ void init(int M, int N, int G_, int c_) { nM = M / BM; nN = N / BM; nwg = nM * nN; G = G_; c = c_; }
  __device__ __forceinline__ bool next(int i, Unit& u) const {
    const long L = (long)i * G + c; if (L >= nwg) return false;
    int wgid = (int)L; { const int q = nwg / NXCD, r = nwg % NXCD, xcd = wgid % NXCD, off = wgid / NXCD; wgid = (xcd < r ? xcd * (q + 1) : r * (q + 1) + (xcd - r) * q) + off; }
    const int nig = WGM * nN, gid = wgid / nig, fm = gid * WGM, gsz = (nM - fm) < WGM ? (nM - fm) : WGM;
    u.pm = fm + ((wgid % nig) % gsz); u.pn = (wgid % nig) / gsz; return true;
  }
};
}

template <int EPI>
__device__ __forceinline__ void gemm_epilogue(const Params& P, const f32x4 (&acc)[2][2][4][2], const pg8::Unit& u, int wr, int wc, int fr, int fq, int l) {
#pragma unroll
  for (int ai = 0; ai < 2; ++ai)
#pragma unroll
    for (int m = 0; m < 4; ++m) {
      const int row = u.pm * 256 + ai * 128 + wr * 64 + m * 16 + fr;
      if (EPI == EPI_P) {
        bf16_t* pr = WSP(bf16_t, OFF_P) + (size_t)row * PSTR;
#pragma unroll
        for (int bj = 0; bj < 2; ++bj) {
          const int col = u.pn * 256 + bj * 128 + wc * 32 + fq * 8;
          if (col < PSTR) { const u32x2 lo = pack4(acc[ai][bj][m][0]), hi = pack4(acc[ai][bj][m][1]); *(u32x4*)(pr + col) = (u32x4){lo[0], lo[1], hi[0], hi[1]}; }
        }
      } else if (EPI == EPI_RES) {
        const float* xi = xin_row(P, l, row);
        float* xo = P.out + (size_t)row * D;
#pragma unroll
        for (int bj = 0; bj < 2; ++bj)
#pragma unroll
          for (int n = 0; n < 2; ++n) {
            const int col = u.pn * 256 + bj * 128 + wc * 32 + n * 16 + fq * 4;
            *(f32x4*)(xo + col) = *(const f32x4*)(xi + col) + acc[ai][bj][m][n];
          }
      } else {
        bf16_t* ur = WSP(bf16_t, OFF_P) + (size_t)row * DFF;
        {
          const int col = u.pn * 128 + wc * 32 + fq * 8;
          f32x4 r0, r1;
#pragma unroll
          for (int j = 0; j < 4; ++j) { r0[j] = silu(acc[ai][0][m][0][j]) * acc[ai][1][m][0][j]; r1[j] = silu(acc[ai][0][m][1][j]) * acc[ai][1][m][1][j]; }
          const u32x2 lo = pack4(r0), hi = pack4(r1);
          *(u32x4*)(ur + col) = (u32x4){lo[0], lo[1], hi[0], hi[1]};
        }
      }
    }
}

#define PG8_LAS __attribute__((address_space(3)))
template <int EPI>
__device__ __forceinline__ void gemm_phase(const Params& P, unsigned char* smem, const bf16_t* __restrict__ Ag, int lda_unused, const bf16_t* __restrict__ Btg, int K, int nN128_unused, int l, int N) {
  using namespace pg8;
  PG8_LAS unsigned char* lds = (PG8_LAS unsigned char*)smem;
  const int tid = otid(), wid = __builtin_amdgcn_readfirstlane(tid >> 6), lane = tid & 63, wr = wid >> 2, wc = wid & 3, fr = lane & 15, fq = lane >> 4;
  const int nt = K / BK;
  StaticOrder S; S.init(NTP, N, (int)gridDim.x, obid());
  unsigned voffA[2], voffB[2];
#pragma unroll
  for (int i = 0; i < 2; ++i) { int R, C; stage_rc(tid * 16 + i * 8192, R, C); const int Rb = EPI == EPI_RES ? R : ((R & ~31) + perm32(R & 31));
    voffA[i] = (unsigned)(R * K + C) * 2u; voffB[i] = (unsigned)(Rb * K + C) * 2u; }
  const size_t kstep = (size_t)(BK * 2);
  const size_t hstep = (size_t)HALF * K * 2;
  const size_t tstep = 2 * hstep;
  const unsigned ldsw = (unsigned)wid * 1024u;
  const int aoff = lds_byte(wr * 64 + fr, fq * 8), boff = lds_byte(wc * 32 + fr, fq * 8);
#define PG8_SA(b, h) (((b) * 2 + (h)) * HTB)
#define PG8_SB(b, h) ((4 + (b) * 2 + (h)) * HTB)
#define PG8_STAGE(bufoff, gbase, voff) do { _Pragma("unroll") for (int _i = 0; _i < 2; ++_i) \
        __builtin_amdgcn_global_load_lds((const unsigned*)((const char*)(gbase) + (voff)[_i]), (PG8_LAS unsigned*)(lds + (bufoff) + ldsw + _i * 8192), 16, 0, 0); } while (0)
#define PG8_LDA(dst, b, h) do { _Pragma("unroll") for (int m = 0; m < 4; ++m) _Pragma("unroll") for (int k = 0; k < 2; ++k) dst[m][k] = *(const PG8_LAS bf16x8*)(lds + PG8_SA(b, h) + aoff + m * 2048 + k * 1024); } while (0)
#define PG8_LDB(dst, b, h) do { _Pragma("unroll") for (int n = 0; n < 2; ++n) _Pragma("unroll") for (int k = 0; k < 2; ++k) dst[n][k] = *(const PG8_LAS bf16x8*)(lds + PG8_SB(b, h) + boff + n * 2048 + k * 1024); } while (0)
#define PG8_MMA(ai, bj, At, Bt) do { __builtin_amdgcn_s_setprio(1); _Pragma("unroll") for (int m = 0; m < 4; ++m) _Pragma("unroll") for (int n = 0; n < 2; ++n) _Pragma("unroll") for (int k = 0; k < 2; ++k) \
        acc[ai][bj][m][n] = __builtin_amdgcn_mfma_f32_16x16x32_bf16(Bt[n][k], At[m][k], acc[ai][bj][m][n], 0, 0, 0); __builtin_amdgcn_s_setprio(0); } while (0)
#define PG8_WAIT_V(n) asm volatile("s_waitcnt vmcnt(" #n ")" ::: "memory")
#define PG8_WAIT_L(n) asm volatile("s_waitcnt lgkmcnt(" #n ")" ::: "memory")
#define PG8_BAR __builtin_amdgcn_s_barrier()
#define PG8_SCHED __builtin_amdgcn_sched_barrier(0)
  Unit cur, nxt; int ui = 0;
  if (!S.next(0, cur)) return;
  f32x4 acc[2][2][4][2];
#pragma unroll
  for (int a = 0; a < 2; ++a)
#pragma unroll
    for (int b = 0; b < 2; ++b)
#pragma unroll
      for (int m = 0; m < 4; ++m)
#pragma unroll
        for (int n = 0; n < 2; ++n) acc[a][b][m][n] = (f32x4){0.f, 0.f, 0.f, 0.f};
  bf16x8 At[4][2], B0[2][2], B1[2][2];
  const char* cA = (const char*)Ag + (size_t)cur.pm * tstep; const char* cB = (const char*)Btg + (size_t)cur.pn * tstep;
  PG8_STAGE(PG8_SB(0, 0), cB, voffB); PG8_STAGE(PG8_SA(0, 0), cA, voffA); PG8_STAGE(PG8_SB(0, 1), cB + hstep, voffB); PG8_STAGE(PG8_SA(0, 1), cA + hstep, voffA);
  if (wr == 1) PG8_BAR;
  PG8_WAIT_V(4); PG8_BAR;
  PG8_STAGE(PG8_SB(1, 0), cB + kstep, voffB); PG8_STAGE(PG8_SA(1, 0), cA + kstep, voffA); PG8_STAGE(PG8_SB(1, 1), cB + hstep + kstep, voffB);
  PG8_WAIT_V(6); PG8_BAR;
  for (;;) {
    const bool has_next = S.next(ui + 1, nxt);
    const char* nA = has_next ? (const char*)Ag + (size_t)nxt.pm * tstep : cA; const char* nB = has_next ? (const char*)Btg + (size_t)nxt.pn * tstep : cB;
    for (int t = 0; t < nt; t += 2) {
      const bool last = (t == nt - 2);
      const char* a1 = cA + (size_t)(t + 1) * kstep;
      const char* a2 = last ? nA : cA + (size_t)(t + 2) * kstep; const char* b2 = last ? nB : cB + (size_t)(t + 2) * kstep;
      const char* a3 = a2 + kstep; const char* b3 = b2 + kstep;
      PG8_LDB(B0, 0, 0); PG8_SCHED; PG8_LDA(At, 0, 0); PG8_STAGE(PG8_SA(1, 1), a1 + hstep, voffA);
      PG8_WAIT_L(8); PG8_BAR; PG8_WAIT_L(0); PG8_MMA(0, 0, At, B0); PG8_BAR; PG8_SCHED;
      PG8_LDB(B1, 0, 1); PG8_STAGE(PG8_SB(0, 0), b2, voffB);
      PG8_BAR; PG8_WAIT_L(0); PG8_MMA(0, 1, At, B1); PG8_BAR;
      PG8_LDA(At, 0, 1); PG8_STAGE(PG8_SA(0, 0), a2, voffA);
      PG8_BAR; PG8_WAIT_L(0); PG8_MMA(1, 0, At, B0); PG8_BAR; PG8_SCHED;
      PG8_STAGE(PG8_SB(0, 1), b2 + hstep, voffB);
      PG8_WAIT_V(6); PG8_BAR; PG8_MMA(1, 1, At, B1); PG8_BAR;
      PG8_LDB(B0, 1, 0); PG8_SCHED; PG8_LDA(At, 1, 0); PG8_STAGE(PG8_SA(0, 1), a2 + hstep, voffA);
      PG8_WAIT_L(8); PG8_BAR; PG8_WAIT_L(0); PG8_MMA(0, 0, At, B0); PG8_BAR; PG8_SCHED;
      PG8_LDB(B1, 1, 1); PG8_STAGE(PG8_SB(1, 0), b3, voffB);
      PG8_BAR; PG8_WAIT_L(0); PG8_MMA(0, 1, At, B1); PG8_BAR;
      PG8_LDA(At, 1, 1); PG8_STAGE(PG8_SA(1, 0), a3, voffA);
      PG8_BAR; PG8_WAIT_L(0); PG8_MMA(1, 0, At, B0); PG8_BAR; PG8_SCHED;
      PG8_STAGE(PG8_SB(1, 1), b3 + hstep, voffB);
      PG8_WAIT_V(6); PG8_BAR; PG8_MMA(1, 1, At, B1); PG8_BAR;
    }
    gemm_epilogue<EPI>(P, acc, cur, wr, wc, fr, fq, l);
    if (!has_next) break;
#pragma unroll
    for (int a = 0; a < 2; ++a)
#pragma unroll
      for (int b = 0; b < 2; ++b)
#pragma unroll
        for (int m = 0; m < 4; ++m)
#pragma unroll
          for (int n = 0; n < 2; ++n) acc[a][b][m][n] = (f32x4){0.f, 0.f, 0.f, 0.f};
    cur = nxt; cA = nA; cB = nB; ++ui;
  }
  PG8_WAIT_V(0);
  if (wr == 0) PG8_BAR;
  PG8_BAR;
#undef PG8_SA
#undef PG8_SB
#undef PG8_STAGE
#undef PG8_LDA
#undef PG8_LDB
#undef PG8_MMA
#undef PG8_WAIT_V
#undef PG8_WAIT_L
#undef PG8_BAR
#undef PG8_SCHED
}

template <int EPI>
__device__ __forceinline__ void gemm_sample(const Params& P, unsigned char* smem, const bf16_t* __restrict__ A, int lda, const bf16_t* __restrict__ Bt, int K, int nunits, int l) {
  const int tid = otid(), lane = tid & 63, wid = tid >> 6, fr = lane & 15, fq = lane >> 4;
  const int kslice = K >> 3;
  for (int u = (int)gridDim.x - 1 - obid(); u < nunits; u += gridDim.x) {
    const int brow0 = EPI == EPI_SWIGLU ? gu_row(u * 16 + fr, 0) : u * 16 + fr;
    const int brow1 = EPI == EPI_SWIGLU ? gu_row(u * 16 + fr, 1) : 0;
    const bf16_t* ap = A + (size_t)(NTP + fr) * lda + wid * kslice + fq * 8;
    const bf16_t* b0p = Bt + (size_t)brow0 * K + wid * kslice + fq * 8;
    const bf16_t* b1p = Bt + (size_t)brow1 * K + wid * kslice + fq * 8;
    f32x4 c0[8], c1[8];
#pragma unroll
    for (int m = 0; m < 8; ++m) { c0[m] = (f32x4){0.f, 0.f, 0.f, 0.f}; c1[m] = c0[m]; }
#pragma unroll 2
    for (int ks = 0; ks < kslice; ks += 32) {
      bf16x8 Af[8];
#pragma unroll
      for (int m = 0; m < 8; ++m) Af[m] = *(const bf16x8*)(ap + (size_t)m * 16 * lda + ks);
      const bf16x8 B0 = *(const bf16x8*)(b0p + ks);
      bf16x8 B1 = B0;
      if (EPI == EPI_SWIGLU) B1 = *(const bf16x8*)(b1p + ks);
#pragma unroll
      for (int m = 0; m < 8; ++m) {
        c0[m] = __builtin_amdgcn_mfma_f32_16x16x32_bf16(B0, Af[m], c0[m], 0, 0, 0);
        if (EPI == EPI_SWIGLU) c1[m] = __builtin_amdgcn_mfma_f32_16x16x32_bf16(B1, Af[m], c1[m], 0, 0, 0);
      }
    }
    __syncthreads();
#pragma unroll
    for (int m = 0; m < 8; ++m) {
      *(f32x4*)(smem + ((wid * 8 + m) * 64 + lane) * 16) = c0[m];
      if (EPI == EPI_SWIGLU) *(f32x4*)(smem + 65536 + ((wid * 8 + m) * 64 + lane) * 16) = c1[m];
    }
    __syncthreads();
    f32x4 g = (f32x4){0.f, 0.f, 0.f, 0.f}, up = g;
#pragma unroll
    for (int w = 0; w < 8; ++w) {
      g += *(const f32x4*)(smem + ((w * 8 + wid) * 64 + lane) * 16);
      if (EPI == EPI_SWIGLU) up += *(const f32x4*)(smem + 65536 + ((w * 8 + wid) * 64 + lane) * 16);
    }
    {
      const int row = NTP + wid * 16 + fr, col = u * 16 + fq * 4;
      if (EPI == EPI_P) {
        if (col < IN_COLS) *(u32x2*)(WSP(bf16_t, OFF_P) + (size_t)row * PSTR + col) = pack4(g);
      } else if (EPI == EPI_RES) {
        const float* xi = xin_row(P, l, row);
        *(f32x4*)(P.out + (size_t)row * D + col) = *(const f32x4*)(xi + col) + g;
      } else {
        f32x4 r;
#pragma unroll
        for (int j = 0; j < 4; ++j) r[j] = silu(g[j]) * up[j];
        *(u32x2*)(WSP(bf16_t, OFF_P) + (size_t)row * DFF + col) = pack4(r);
      }
    }
  }
}

__device__ __forceinline__ float lbval(const Params& P, int l, int c) {
  const float* hb = P.in[I_HLB];
  const float a0 = hb[c], a1 = hb[256 + c], a2 = hb[512 + c], a3 = hb[768 + c];
  const float m = fmaxf(fmaxf(a0, a1), fmaxf(a2, a3));
  const float e0 = __expf(a0 - m), e1 = __expf(a1 - m), e2 = __expf(a2 - m), e3 = __expf(a3 - m);
  const float inv = 1.f / (e0 + e1 + e2 + e3);
  float s = 0.f;
  if (l >= 1) s += e1; if (l >= 2) s += e2; if (l >= 3) s += e3;
  return s * inv;
}

__device__ __forceinline__ void gdn_conv_emit2(const Params& P, int g, int c2, int row, float s0, float s1) {
  const int h = g % 6;
  if (g < 12) {
    const float rn = rsqrtf(half_sum(s0 * s0 + s1 * s1) + 1e-6f) * (g < 6 ? 0.125f : 1.f);
    *(unsigned*)((g < 6 ? WSP(bf16_t, OFF_GQ) : WSP(bf16_t, OFF_GK)) + (size_t)row * 384 + h * 64 + c2) = pk2(s0 * rn, s1 * rn);
  } else {
    *(unsigned*)(WSP(bf16_t, OFF_GV) + (size_t)row * 384 + h * 64 + c2) = pk2(s0, s1);
  }
}
__device__ __forceinline__ void gdn_gate_emit(const Params& P, int l, int h, int row) {
  const bf16_t* pr = WSP(bf16_t, OFF_P) + (size_t)row * PSTR;
  const float braw = bf2f(pr[1536 + h]), araw = bf2f(pr[1542 + h]);
  const float gg = -__expf(P.in[I_ALOG][l * 6 + h]) * softplus(araw + P.in[I_DTB][l * 6 + h]);
  WSP(float, OFF_GDEC)[(size_t)row * 8 + h] = __expf(gg);
  WSP(float, OFF_GBETA)[(size_t)row * 8 + h] = sigm(braw);
}
__device__ __forceinline__ void prep_gdn_prompt(const Params& P, int l, int ci) {
  const int lane = otid() & 63, wid = otid() >> 6, hl = lane >> 5, c2 = (lane & 31) * 2;
  const int r0 = ci * 32, b = r0 / TSEQ, t0 = r0 % TSEQ;
  const bf16_t* p = WSP(bf16_t, OFF_P);
  for (int gp = wid; gp < 9; gp += 8) {
    const int g = gp * 2 + hl, col = g * 64 + c2;
    const float* cw = P.in[I_CONVW] + (size_t)l * 4 * 1152 + col;
    const f32x2 w0 = *(const f32x2*)cw, w1 = *(const f32x2*)(cw + 1152), w2 = *(const f32x2*)(cw + 2304), w3 = *(const f32x2*)(cw + 3456);
    unsigned xr[35];
#pragma unroll
    for (int t = 0; t < 35; ++t) xr[t] = (t >= 3 || t0 > 0) ? *(const unsigned*)(p + (size_t)(r0 - 3 + t) * PSTR + col) : 0u;
    f32x2 x3 = {__uint_as_float(xr[0] << 16), __uint_as_float(xr[0] & 0xffff0000u)};
    f32x2 x2 = {__uint_as_float(xr[1] << 16), __uint_as_float(xr[1] & 0xffff0000u)};
    f32x2 x1 = {__uint_as_float(xr[2] << 16), __uint_as_float(xr[2] & 0xffff0000u)};
#pragma unroll
    for (int t = 0; t < 32; ++t) {
      const f32x2 x0 = {__uint_as_float(xr[t + 3] << 16), __uint_as_float(xr[t + 3] & 0xffff0000u)};
      const f32x2 y = w0 * x3 + w1 * x2 + w2 * x1 + w3 * x0;
      gdn_conv_emit2(P, g, c2, r0 + t, silu(y[0]), silu(y[1]));
      x3 = x2; x2 = x1; x1 = x0;
    }
    if (t0 + 32 == TSEQ) {
      float* cp = P.out + O_CONV_P + (size_t)(l * 8 + b) * 3 * 1152 + col;
      *(f32x2*)cp = x3; *(f32x2*)(cp + 1152) = x2; *(f32x2*)(cp + 2304) = x1;
    }
    if (g < 6) gdn_gate_emit(P, l, g, r0 + (lane & 31));
  }
}
__device__ __forceinline__ void prep_gdn_sample(const Params& P, int l, int si) {
  const int lane = otid() & 63, wid = otid() >> 6, hl = lane >> 5, c2 = (lane & 31) * 2;
  const bf16_t* p = WSP(bf16_t, OFF_P);
  for (int u = wid; u < 18; u += 8) {
    const int s = si * 2 + u / 9, g = (u % 9) * 2 + hl, col = g * 64 + c2, row = NTP + s;
    const float* cw = P.in[I_CONVW] + (size_t)l * 4 * 1152 + col;
    const f32x2 w0 = *(const f32x2*)cw, w1 = *(const f32x2*)(cw + 1152), w2 = *(const f32x2*)(cw + 2304), w3 = *(const f32x2*)(cw + 3456);
    const float* cb = P.in[I_SCONV] + (size_t)(l * 128 + s) * 3 * 1152 + col;
    const f32x2 x3 = *(const f32x2*)cb, x2 = *(const f32x2*)(cb + 1152), x1 = *(const f32x2*)(cb + 2304);
    const unsigned xw = *(const unsigned*)(p + (size_t)row * PSTR + col);
    const f32x2 x0 = {__uint_as_float(xw << 16), __uint_as_float(xw & 0xffff0000u)};
    const f32x2 y = w0 * x3 + w1 * x2 + w2 * x1 + w3 * x0;
    gdn_conv_emit2(P, g, c2, row, silu(y[0]), silu(y[1]));
    float* cp = P.out + O_CONV_S + (size_t)(l * 128 + s) * 3 * 1152 + col;
    *(f32x2*)cp = x2; *(f32x2*)(cp + 1152) = x1; *(f32x2*)(cp + 2304) = x0;
    if (g < 6 && (lane & 31) == 0) gdn_gate_emit(P, l, g, row);
  }
}
__device__ __forceinline__ void prep_hgrn(const Params& P, int l, int ti) {
  const int c2 = (otid() & 127) * 2, tg = otid() >> 7;
  const float oml0 = 1.f - lbval(P, l, c2), oml1 = 1.f - lbval(P, l, c2 + 1);
  const bf16_t* p = WSP(bf16_t, OFF_P);
  bf16_t* hq = WSP(bf16_t, OFF_HQ); bf16_t* hk = WSP(bf16_t, OFF_HK);
  for (int t0 = tg * 16; t0 < tg * 16 + 16; t0 += 8) {
    unsigned q[8], f[8];
#pragma unroll
    for (int i = 0; i < 8; ++i) { const int row = ti * 64 + t0 + i; q[i] = *(const unsigned*)(p + (size_t)row * PSTR + PC + c2); f[i] = *(const unsigned*)(p + (size_t)row * PSTR + PC + 256 + c2); }
#pragma unroll
    for (int i = 0; i < 8; ++i) {
      const int row = ti * 64 + t0 + i;
      const float q0 = __uint_as_float(q[i] << 16), q1 = __uint_as_float(q[i] & 0xffff0000u);
      const float f0 = __uint_as_float(f[i] << 16), f1 = __uint_as_float(f[i] & 0xffff0000u);
      *(unsigned*)(hq + (size_t)row * 256 + c2) = pk2(silu(q0) * 0.125f, silu(q1) * 0.125f);
      *(unsigned*)(hk + (size_t)row * 256 + c2) = pk2(oml0 * sigm(-f0), oml1 * sigm(-f1));
    }
  }
}
template <bool SAMP>
__device__ __forceinline__ f32x4 xs4t(const Params& P, int l, int row, int col0) {
  const bf16_t* p = WSP(bf16_t, OFF_P);
  const f32x4 pv = unpack4(*(const u32x2*)(p + (size_t)row * PSTR + PB + col0));
  f32x4 prev;
  if (SAMP) prev = *(const f32x4*)(P.in[I_SSHIFT] + (size_t)(l * 128 + (row - NTP)) * 1408 + col0);
  else {
    const bool first = (row & (TSEQ - 1)) == 0;
    prev = unpack4(*(const u32x2*)(p + (size_t)(row - (first ? 0 : 1)) * PSTR + PB + col0)) * (first ? 0.f : 1.f);
  }
  const f32x4 mu = *(const f32x4*)(P.in[I_MU] + l * 1408 + col0);
  return pv + (prev - pv) * mu;
}
__device__ __forceinline__ float tanh_fast(float x) { return 1.f - 2.f / (__expf(2.f * x) + 1.f); }

template <int ROWB>
__device__ __forceinline__ void stage_lora(unsigned char* smem, const bf16_t* __restrict__ src) {
  constexpr int CPR = ROWB / 16, NCH = 384 * CPR;
  __syncthreads();
  u32x4 t[NCH / 512];
#pragma unroll
  for (int i = 0; i < NCH / 512; ++i) t[i] = *(const u32x4*)((const unsigned char*)src + (size_t)(otid() + i * 512) * 16);
#pragma unroll
  for (int i = 0; i < NCH / 512; ++i) { const int idx = otid() + i * 512, r = idx / CPR, c = idx - r * CPR; *(u32x4*)(smem + r * (ROWB + 16) + c * 16) = t[i]; }
  __syncthreads();
}
template <int ROWB>
__device__ __forceinline__ void stage_lora_open(unsigned char* smem, const bf16_t* __restrict__ src) {
  constexpr int CPR = ROWB / 16, NCH = 384 * CPR;
  __syncthreads();
  u32x4 t[NCH / 512];
#pragma unroll
  for (int i = 0; i < NCH / 512; ++i) t[i] = *(const u32x4*)((const unsigned char*)src + (size_t)(otid() + i * 512) * 16);
#pragma unroll
  for (int i = 0; i < NCH / 512; ++i) { const int idx = otid() + i * 512, r = idx / CPR, c = idx - r * CPR; *(u32x4*)(smem + r * (ROWB + 16) + c * 16) = t[i]; }
}
constexpr int EXCH_OFF = 110592;
__device__ __forceinline__ unsigned char* exch_slot(unsigned char* smem, int wid, int slot, int lane) { return smem + EXCH_OFF + ((wid * 2 + slot) * 64 + lane) * 16; }
template <bool SAMP>
__device__ __forceinline__ void prep_rwkv_unit(const Params& P, unsigned char* smem, int l, int mt, int hh) {
  const int lane = otid() & 63, fr = lane & 15, fq = lane >> 4, wid = otid() >> 6;
  const int row = mt * 16 + fr, cb = hh * 192;
  const bf16_t* lw = WSP(bf16_t, OFF_LORA);
  const size_t ro = (size_t)row * 384;
  f32x4 acc[12];
  {
    bf16x8 Bf[2][12];
    f32x4 x0 = xs4t<SAMP>(P, l, row, 1152 + hh * 32 + fq * 8), x1 = xs4t<SAMP>(P, l, row, 1152 + hh * 32 + fq * 8 + 4);
    stage_lora_open<128>(smem, lw + W2T);
#pragma unroll
    for (int j = 0; j < 4; ++j) { x0[j] = tanh_fast(x0[j]); x1[j] = tanh_fast(x1[j]); }
    const bf16x8 Am = pack8(x0, x1);
    *(bf16x8*)exch_slot(smem, wid, 0, lane) = Am;
    __syncthreads();
    const bf16x8 Ao = *(const bf16x8*)exch_slot(smem, wid ^ 1, 0, lane);
    bf16x8 Aw[2]; Aw[0] = hh ? Ao : Am; Aw[1] = hh ? Am : Ao;
#pragma unroll
    for (int ks = 0; ks < 2; ++ks)
#pragma unroll
      for (int nf = 0; nf < 12; ++nf) Bf[ks][nf] = *(const bf16x8*)(smem + (cb + nf * 16 + fr) * 144 + ks * 64 + fq * 16);
#pragma unroll
    for (int nf = 0; nf < 12; ++nf) acc[nf] = (f32x4){0.f, 0.f, 0.f, 0.f};
#pragma unroll
    for (int ks = 0; ks < 2; ++ks) {
#pragma unroll
      for (int nf = 0; nf < 12; ++nf) acc[nf] = __builtin_amdgcn_mfma_f32_16x16x32_bf16(Bf[ks][nf], Aw[ks], acc[nf], 0, 0, 0);
    }
    f32x4 w0v[12];
#pragma unroll
    for (int nf = 0; nf < 12; ++nf) w0v[nf] = *(const f32x4*)(P.in[I_W0] + l * 384 + cb + nf * 16 + fq * 4);
#pragma unroll
    for (int nf = 0; nf < 12; ++nf) {
      f32x4 d;
#pragma unroll
      for (int j = 0; j < 4; ++j) {
        const float xx = -(w0v[nf][j] + acc[nf][j]);
        const float sp = xx > 15.f ? xx : __logf(1.f + __expf(xx));
        d[j] = __expf(-__expf(-sp - 0.5f));
      }
      *(f32x4*)(WSP(float, OFF_RW) + ro + cb + nf * 16 + fq * 4) = d;
    }
  }
  {
    bf16x8 Bf[2][12];
    const f32x4 x0 = xs4t<SAMP>(P, l, row, 1216 + hh * 32 + fq * 8), x1 = xs4t<SAMP>(P, l, row, 1216 + hh * 32 + fq * 8 + 4);
    stage_lora_open<128>(smem, lw + A2T);
    const bf16x8 Am = pack8(x0, x1);
    *(bf16x8*)exch_slot(smem, wid, 0, lane) = Am;
    __syncthreads();
    const bf16x8 Ao = *(const bf16x8*)exch_slot(smem, wid ^ 1, 0, lane);
    bf16x8 Aw[2]; Aw[0] = hh ? Ao : Am; Aw[1] = hh ? Am : Ao;
#pragma unroll
    for (int ks = 0; ks < 2; ++ks)
#pragma unroll
      for (int nf = 0; nf < 12; ++nf) Bf[ks][nf] = *(const bf16x8*)(smem + (cb + nf * 16 + fr) * 144 + ks * 64 + fq * 16);
#pragma unroll
    for (int nf = 0; nf < 12; ++nf) acc[nf] = (f32x4){0.f, 0.f, 0.f, 0.f};
#pragma unroll
    for (int ks = 0; ks < 2; ++ks) {
#pragma unroll
      for (int nf = 0; nf < 12; ++nf) acc[nf] = __builtin_amdgcn_mfma_f32_16x16x32_bf16(Bf[ks][nf], Aw[ks], acc[nf], 0, 0, 0);
    }
  }
#pragma unroll
  for (int hl = 0; hl < 3; ++hl) {
    f32x4 kr[4], rr[4], kkw[4], a0[4], ka[4];
#pragma unroll
    for (int q = 0; q < 4; ++q) {
      const int c = cb + (hl * 4 + q) * 16 + fq * 4;
      kr[q] = xs4t<SAMP>(P, l, row, 384 + c); rr[q] = xs4t<SAMP>(P, l, row, c);
      kkw[q] = *(const f32x4*)(P.in[I_KK] + l * 384 + c); a0[q] = *(const f32x4*)(P.in[I_A0] + l * 384 + c); ka[q] = *(const f32x4*)(P.in[I_KA] + l * 384 + c);
    }
    float ss = 0.f;
#pragma unroll
    for (int q = 0; q < 4; ++q) { kkw[q] = kr[q] * kkw[q]; ss += dot4(kkw[q], kkw[q]); }
    ss += __shfl_xor(ss, 16); ss += __shfl_xor(ss, 32);
    const float rn = rsqrtf(ss + 1e-6f);
#pragma unroll
    for (int q = 0; q < 4; ++q) {
      const int nf = hl * 4 + q, c = cb + nf * 16 + fq * 4;
      f32x4 kn, kk, kb;
#pragma unroll
      for (int j = 0; j < 4; ++j) {
        const float a = sigm(a0[q][j] + acc[nf][j]);
        kk[j] = kkw[q][j] * rn; kb[j] = kk[j] * a; kn[j] = kr[q][j] * (1.f + (a - 1.f) * ka[q][j]);
      }
      *(u32x2*)(WSP(bf16_t, OFF_RK) + ro + c) = pack4(kn);
      *(u32x2*)(WSP(bf16_t, OFF_RKK) + ro + c) = pack4(kk);
      *(u32x2*)(WSP(bf16_t, OFF_RB) + ro + c) = pack4(kb);
      *(u32x2*)(WSP(bf16_t, OFF_RR) + ro + c) = pack4(rr[q]);
    }
  }
  {
    f32x4 x[2][2];
#pragma unroll
    for (int k2 = 0; k2 < 2; ++k2) { x[k2][0] = xs4t<SAMP>(P, l, row, 1280 + (hh * 2 + k2) * 32 + fq * 8); x[k2][1] = xs4t<SAMP>(P, l, row, 1280 + (hh * 2 + k2) * 32 + fq * 8 + 4); }
    stage_lora_open<256>(smem, lw + G2T);
    bf16x8 Am[2], Ao[2];
#pragma unroll
    for (int k2 = 0; k2 < 2; ++k2) {
#pragma unroll
      for (int j = 0; j < 4; ++j) { x[k2][0][j] = sigm(x[k2][0][j]); x[k2][1][j] = sigm(x[k2][1][j]); }
      Am[k2] = pack8(x[k2][0], x[k2][1]);
      *(bf16x8*)exch_slot(smem, wid, k2, lane) = Am[k2];
    }
    __syncthreads();
#pragma unroll
    for (int k2 = 0; k2 < 2; ++k2) Ao[k2] = *(const bf16x8*)exch_slot(smem, wid ^ 1, k2, lane);
    bf16x8 A[4];
    A[0] = hh ? Ao[0] : Am[0]; A[1] = hh ? Ao[1] : Am[1]; A[2] = hh ? Am[0] : Ao[0]; A[3] = hh ? Am[1] : Ao[1];
#pragma unroll
    for (int hf = 0; hf < 2; ++hf) {
      bf16x8 Bf[4][6];
#pragma unroll
      for (int ks = 0; ks < 4; ++ks)
#pragma unroll
        for (int n6 = 0; n6 < 6; ++n6) Bf[ks][n6] = *(const bf16x8*)(smem + (cb + (hf * 6 + n6) * 16 + fr) * 272 + ks * 64 + fq * 16);
#pragma unroll
      for (int n6 = 0; n6 < 6; ++n6) {
        f32x4 g = (f32x4){0.f, 0.f, 0.f, 0.f};
#pragma unroll
        for (int ks = 0; ks < 4; ++ks) g = __builtin_amdgcn_mfma_f32_16x16x32_bf16(Bf[ks][n6], A[ks], g, 0, 0, 0);
        *(u32x2*)(WSP(bf16_t, OFF_RG) + ro + cb + (hf * 6 + n6) * 16 + fq * 4) = pack4(g);
      }
    }
  }
  if (l == 0) {
    f32x4 v[12];
#pragma unroll
    for (int nf = 0; nf < 12; ++nf) v[nf] = xs4t<SAMP>(P, l, row, 768 + cb + nf * 16 + fq * 4);
#pragma unroll
    for (int nf = 0; nf < 12; ++nf) {
      const int c = cb + nf * 16 + fq * 4;
      const u32x2 o = pack4(v[nf]);
      *(u32x2*)(WSP(bf16_t, OFF_RV) + ro + c) = o;
      *(u32x2*)(WSP(bf16_t, OFF_VF) + ro + c) = o;
    }
  } else {
    f32x4 lo0 = (f32x4){0.f, 0.f, 0.f, 0.f}, lo1 = lo0;
    {
      const int hf = hh;
      f32x4 x[6][2]; bf16x8 B0[6], B1[6];
#pragma unroll
      for (int k6 = 0; k6 < 6; ++k6) {
        const int ks = hf * 6 + k6;
        x[k6][0] = xs4t<SAMP>(P, l, row, 768 + ks * 32 + fq * 8); x[k6][1] = xs4t<SAMP>(P, l, row, 768 + ks * 32 + fq * 8 + 4);
        B0[k6] = *(const bf16x8*)(lw + V1T + fr * 384 + ks * 32 + fq * 8);
        B1[k6] = *(const bf16x8*)(lw + V1T + (16 + fr) * 384 + ks * 32 + fq * 8);
      }
#pragma unroll
      for (int k6 = 0; k6 < 6; ++k6) {
        const bf16x8 A = pack8(x[k6][0], x[k6][1]);
        lo0 = __builtin_amdgcn_mfma_f32_16x16x32_bf16(B0[k6], A, lo0, 0, 0, 0);
        lo1 = __builtin_amdgcn_mfma_f32_16x16x32_bf16(B1[k6], A, lo1, 0, 0, 0);
      }
    }
    __syncthreads();
    *(f32x4*)exch_slot(smem, wid, 0, lane) = lo0; *(f32x4*)exch_slot(smem, wid, 1, lane) = lo1;
    __syncthreads();
    lo0 += *(const f32x4*)exch_slot(smem, wid ^ 1, 0, lane); lo1 += *(const f32x4*)exch_slot(smem, wid ^ 1, 1, lane);
    const bf16x8 A2 = pack8(lo0, lo1);
#pragma unroll
    for (int hf = 0; hf < 2; ++hf) {
      u32x4 bw[6]; f32x4 v0[6], v[6]; u32x2 vf[6];
#pragma unroll
      for (int n6 = 0; n6 < 6; ++n6) {
        const int nf = hf * 6 + n6, c = cb + nf * 16 + fq * 4;
        const bf16_t* vr = lw + V2T + (cb + nf * 16 + fr) * 32;
        const u32x2 b0 = *(const u32x2*)(vr + fq * 4), b1 = *(const u32x2*)(vr + 16 + fq * 4);
        bw[n6][0] = b0[0]; bw[n6][1] = b0[1]; bw[n6][2] = b1[0]; bw[n6][3] = b1[1];
        v0[n6] = *(const f32x4*)(P.in[I_V0] + (l - 1) * 384 + c);
        v[n6] = xs4t<SAMP>(P, l, row, 768 + c);
        vf[n6] = *(const u32x2*)(WSP(bf16_t, OFF_VF) + ro + c);
      }
#pragma unroll
      for (int n6 = 0; n6 < 6; ++n6) {
        const int c = cb + (hf * 6 + n6) * 16 + fq * 4;
        const f32x4 mv = __builtin_amdgcn_mfma_f32_16x16x32_bf16(__builtin_bit_cast(bf16x8, bw[n6]), A2, (f32x4){0.f, 0.f, 0.f, 0.f}, 0, 0, 0);
        const f32x4 vfv = unpack4(vf[n6]);
        f32x4 o;
#pragma unroll
        for (int j = 0; j < 4; ++j) o[j] = v[n6][j] + (vfv[j] - v[n6][j]) * sigm(v0[n6][j] + mv[j]);
        *(u32x2*)(WSP(bf16_t, OFF_RV) + ro + c) = pack4(o);
      }
    }
  }
}
__device__ __forceinline__ void prep_phase(const Params& P, unsigned char* smem, int l, volatile unsigned* blk  ) {
  unsigned* q = WSP(unsigned, OFF_QUEUE) + l * 128 + 80;
  for (;;) {
    __syncthreads();
    if (threadIdx.x == 0) blk[3] = __hip_atomic_fetch_add(q, 1u, __ATOMIC_RELAXED, __HIP_MEMORY_SCOPE_AGENT);
    __syncthreads();
    const int it = (int)blk[3];
    if (it >= 1092) break;
    if (it < 2) { const int wid = otid() >> 6; prep_rwkv_unit<true>(P, smem, l, (256 + it) * 4 + (wid >> 1), wid & 1); }
    else if (it < 258) { const int wid = otid() >> 6; prep_rwkv_unit<false>(P, smem, l, (it - 2) * 4 + (wid >> 1), wid & 1); }
    else if (it < 770) prep_gdn_prompt(P, l, it - 258);
    else if (it < 834) prep_gdn_sample(P, l, it - 770);
    else prep_hgrn(P, l, it - 834);
  }
  const bf16_t* p = WSP(bf16_t, OFF_P);
  for (int idx = obid() * 512 + otid(); idx < 136 * 1408; idx += gridDim.x * 512) {
    const int q = idx / 1408, col = idx - q * 1408;
    if (q < 8) P.out[O_SHIFT_P + (size_t)(l * 8 + q) * 1408 + col] = bf2f(p[(size_t)(q * TSEQ + TSEQ - 1) * PSTR + PB + col]);
    else P.out[O_SHIFT_S + (size_t)(l * 128 + (q - 8)) * 1408 + col] = bf2f(p[(size_t)(NTP + q - 8) * PSTR + PB + col]);
  }
}

template <int KIND> struct ScanCfg { static constexpr int STRIDE = KIND == 1 ? 356 : 164; };

template <int KIND> struct ScanPre { u32x2 a, b, c, d, v; f32x4 w; float g; };

template <int KIND>
__device__ __forceinline__ void scan_load(const Params& P, ScanPre<KIND>& r, int tid, int h, int half, int rowbase, int nvalid) {
  const int s = tid >> 4, j4 = (tid & 15) * 4;
  const int s2 = (tid >> 3) & 15, j2 = (tid & 7) * 4;
  const u32x2 z2 = {0u, 0u};
  const bool ok = s < nvalid, ok2 = (tid < 128) && (s2 < nvalid);
  if (KIND == 0) {
    const size_t o = (size_t)(rowbase + s) * 384 + h * 64 + j4;
    r.a = ok ? *(const u32x2*)(WSP(bf16_t, OFF_GK) + o) : z2;
    r.b = ok ? *(const u32x2*)(WSP(bf16_t, OFF_GQ) + o) : z2;
    r.v = ok2 ? *(const u32x2*)(WSP(bf16_t, OFF_GV) + (size_t)(rowbase + s2) * 384 + h * 64 + half * 32 + j2) : z2;
    const int sg = (tid >> 1) & 15;
    r.g = (tid < 32 && sg < nvalid) ? ((tid & 1) ? WSP(float, OFF_GBETA) : WSP(float, OFF_GDEC))[(size_t)(rowbase + sg) * 8 + h] : 0.f;
  } else if (KIND == 1) {
    const size_t o = (size_t)(rowbase + s) * 384 + h * 64 + j4;
    r.a = ok ? *(const u32x2*)(WSP(bf16_t, OFF_RR) + o) : z2;
    r.w = ok ? *(const f32x4*)(WSP(float, OFF_RW) + o) : (f32x4){0.f, 0.f, 0.f, 0.f};
    r.b = ok ? *(const u32x2*)(WSP(bf16_t, OFF_RK) + o) : z2;
    r.c = ok ? *(const u32x2*)(WSP(bf16_t, OFF_RKK) + o) : z2;
    r.d = ok ? *(const u32x2*)(WSP(bf16_t, OFF_RB) + o) : z2;
    r.v = ok2 ? *(const u32x2*)(WSP(bf16_t, OFF_RV) + (size_t)(rowbase + s2) * 384 + h * 64 + half * 32 + j2) : z2;
  } else {
    const size_t o = (size_t)(rowbase + s) * 256 + h * 64 + j4;
    r.a = ok ? *(const u32x2*)(WSP(bf16_t, OFF_HQ) + o) : z2;
    r.b = ok ? *(const u32x2*)(WSP(bf16_t, OFF_HK) + o) : z2;
    r.v = ok2 ? *(const u32x2*)(WSP(bf16_t, OFF_P) + (size_t)(rowbase + s2) * PSTR + PC + 512 + h * 64 + half * 32 + j2) : z2;
  }
}
template <int KIND>
__device__ __forceinline__ void scan_store(const ScanPre<KIND>& r, int tid, float* buf) {
  constexpr int STRIDE = ScanCfg<KIND>::STRIDE;
  const int s = tid >> 4, j4 = (tid & 15) * 4;
  const int s2 = (tid >> 3) & 15, j2 = (tid & 7) * 4;
  float* bs = buf + s * STRIDE + j4;
  if (KIND == 0) {
    const f32x4 k = unpack4(r.a), q = unpack4(r.b);
    *(f32x4*)(bs) = k; *(f32x4*)(bs + 64) = q;
    const float qk = row_sum16(dot4(q, k));
    if ((tid & 15) == 0) buf[s * STRIDE + 162] = qk;
    if (tid < 128) *(f32x4*)(buf + s2 * STRIDE + 128 + j2) = unpack4(r.v);
    if (tid < 32) buf[((tid >> 1) & 15) * STRIDE + 160 + (tid & 1)] = r.g;
  } else if (KIND == 1) {
    const f32x4 rr = unpack4(r.a), k = unpack4(r.b), kk = unpack4(r.c), bb = unpack4(r.d);
    *(f32x4*)(bs) = r.w * rr; *(f32x4*)(bs + 64) = r.w; *(f32x4*)(bs + 128) = k;
    *(f32x4*)(bs + 192) = kk; *(f32x4*)(bs + 256) = bb;
    const float br = row_sum16(dot4(bb, rr)), kr = row_sum16(dot4(k, rr));
    if ((tid & 15) == 0) { buf[s * STRIDE + 352] = br; buf[s * STRIDE + 353] = kr; }
    if (tid < 128) *(f32x4*)(buf + s2 * STRIDE + 320 + j2) = unpack4(r.v);
  } else {
    const f32x4 q = unpack4(r.a), k = unpack4(r.b);
    *(f32x4*)(bs) = q * (1.f - k); *(f32x4*)(bs + 64) = k;
    const float qk = row_sum16(dot4(q, k));
    if ((tid & 15) == 0) buf[s * STRIDE + 160] = qk;
    if (tid < 128) *(f32x4*)(buf + s2 * STRIDE + 128 + j2) = unpack4(r.v);
  }
}

template <int KIND> struct StepOps { f32x2 a[4], b[4], c[4], d[4], e[4]; float v, s0, s1, s2; };
template <int KIND>
__device__ __forceinline__ void step_load(StepOps<KIND>& o, const float* bs, int e0, int cl) {
#define LD8(dst, off) { const f32x4 _x = *(const f32x4*)(bs + (off) + e0), _y = *(const f32x4*)(bs + (off) + e0 + 4); \
    dst[0] = (f32x2){_x[0], _x[1]}; dst[1] = (f32x2){_x[2], _x[3]}; dst[2] = (f32x2){_y[0], _y[1]}; dst[3] = (f32x2){_y[2], _y[3]}; }
  if (KIND == 0) {
    LD8(o.a, 0) LD8(o.b, 64)
    o.v = bs[128 + cl];
    const f32x4 sc = *(const f32x4*)(bs + 160); o.s0 = sc[0]; o.s1 = sc[1]; o.s2 = sc[2];
  } else if (KIND == 1) {
    LD8(o.a, 0) LD8(o.b, 64) LD8(o.c, 128) LD8(o.d, 192) LD8(o.e, 256)
    o.v = bs[320 + cl];
    const f32x2 sc = *(const f32x2*)(bs + 352); o.s0 = sc[0]; o.s1 = sc[1];
  } else {
    LD8(o.a, 0) LD8(o.b, 64)
    o.v = bs[128 + cl]; o.s0 = bs[160];
  }
#undef LD8
}
template <int KIND>
__device__ __forceinline__ float step_compute(const StepOps<KIND>& o, f32x2 (&S)[4]) {
  if (KIND == 0) {
    f32x2 ks2 = o.a[0] * S[0], qs2 = o.b[0] * S[0];
#pragma unroll
    for (int i = 1; i < 4; ++i) { ks2 += o.a[i] * S[i]; qs2 += o.b[i] * S[i]; }
    float ks = ks2[0] + ks2[1], qs = qs2[0] + qs2[1];
    ks += dppf<0xB1>(ks); qs += dppf<0xB1>(qs); ks += dppf<0x4E>(ks); qs += dppf<0x4E>(qs); ks += dppf<0x141>(ks); qs += dppf<0x141>(qs);
    const float dec = o.s0, vn = o.s1 * (o.v - dec * ks);
#pragma unroll
    for (int i = 0; i < 4; ++i) S[i] = S[i] * dec + o.a[i] * vn;
    return dec * qs + vn * o.s2;
  } else if (KIND == 1) {
    f32x2 sa2 = o.d[0] * S[0], p2 = o.a[0] * S[0];
#pragma unroll
    for (int i = 1; i < 4; ++i) { sa2 += o.d[i] * S[i]; p2 += o.a[i] * S[i]; }
    float sa = sa2[0] + sa2[1], p1 = p2[0] + p2[1];
    sa += dppf<0xB1>(sa); p1 += dppf<0xB1>(p1); sa += dppf<0x4E>(sa); p1 += dppf<0x4E>(p1); sa += dppf<0x141>(sa); p1 += dppf<0x141>(p1);
    sa = -sa;
#pragma unroll
    for (int i = 0; i < 4; ++i) S[i] = S[i] * o.b[i] + (o.e[i] * sa + o.c[i] * o.v);
    return p1 + sa * o.s0 + o.v * o.s1;
  } else {
    f32x2 p2 = o.a[0] * S[0];
#pragma unroll
    for (int i = 1; i < 4; ++i) p2 += o.a[i] * S[i];
    float p1 = p2[0] + p2[1];
    p1 += dppf<0xB1>(p1); p1 += dppf<0x4E>(p1); p1 += dppf<0x141>(p1);
#pragma unroll
    for (int i = 0; i < 4; ++i) S[i] = S[i] + o.b[i] * (o.v - S[i]);
    return p1 + o.v * o.s0;
  }
}

template <int KIND>
__device__ __forceinline__ void scan_task(const Params& P, unsigned char* smem, int l, int seq, int h, int half, int mode) {
  constexpr int STRIDE = ScanCfg<KIND>::STRIDE, NEL = 16 * STRIDE;
  constexpr int NH = KIND == 2 ? 4 : 6;
  float* buf = (float*)smem;
  float* obuf = buf + 2 * NEL;
  const bool do_comp = mode != 2, do_stage = mode != 1;
  const int tid = otid() & 255, lane = tid & 63, wid = tid >> 6;
  const int col_l = lane >> 3, sub = lane & 7, cl = wid * 8 + col_l, col = half * 32 + cl, e0 = sub * 8;
  const bool sample = seq >= 8;
  const int R0 = sample ? NTP + (seq - 8) : seq * TSEQ, T = sample ? 1 : TSEQ;
  const int ocol = (KIND == 0 ? 0 : (KIND == 1 ? 384 : 768)) + h * 64 + half * 32;
  const size_t O_P = KIND == 0 ? O_GDN_P : (KIND == 1 ? O_RWKV_P : O_HGRN_P);
  const size_t O_S = KIND == 0 ? O_GDN_S : (KIND == 1 ? O_RWKV_S : O_HGRN_S);
  const int I_ST = KIND == 0 ? I_SGDN : (KIND == 1 ? I_SRWKV : I_SHGRN);
  const int nchunks = (T + 15) >> 4;
  bf16_t* oraw = WSP(bf16_t, OFF_P);
  f32x2 S[4];
#pragma unroll
  for (int i = 0; i < 4; ++i) S[i] = (f32x2){0.f, 0.f};
  if (sample && do_comp) {
    const float* st = P.in[I_ST] + ((size_t)(l * 128 + (seq - 8)) * NH + h) * 4096;
#pragma unroll
    for (int i = 0; i < 8; ++i) S[i >> 1][i & 1] = KIND == 1 ? st[col * 64 + e0 + i] : st[(e0 + i) * 64 + col];
  }
#pragma unroll
  for (int i = 0; i < 4; ++i) asm volatile("" : "+v"(S[i]));
  ScanPre<KIND> pre;
  __syncthreads();
  if (do_stage) {
    scan_load<KIND>(P, pre, tid, h, half, R0, T); scan_store<KIND>(pre, tid, buf);
    if (nchunks > 1) scan_load<KIND>(P, pre, tid, h, half, R0 + 16, T - 16);
  }
  __syncthreads();
  for (int c = 0; c < nchunks; ++c) {
    const int t0 = c * 16, n = (T - t0) < 16 ? (T - t0) : 16;
    if (do_stage) {
      if (c + 1 < nchunks) scan_store<KIND>(pre, tid, buf + ((c + 1) & 1) * NEL);
      if (c > 0) {
        const float* pob = obuf + ((c - 1) & 1) * 512;
        const int s = tid >> 4, cc = (tid & 15) * 2;
        const f32x2 ov = *(const f32x2*)(pob + s * 32 + cc);
        *(unsigned*)(oraw + (size_t)(R0 + t0 - 16 + s) * PSTR + ocol + cc) = pk2(ov[0], ov[1]);
      }
      if (c + 2 < nchunks) scan_load<KIND>(P, pre, tid, h, half, R0 + t0 + 32, T - t0 - 32);
    }
    if (do_comp) {
      const float* b = buf + (c & 1) * NEL;
      float* ob = obuf + (c & 1) * 512;
      if (n == 16) {
        StepOps<KIND> A, B;
        step_load<KIND>(A, b, e0, cl);
#pragma unroll
        for (int s = 0; s < 16; s += 2) {
          step_load<KIND>(B, b + (s + 1) * STRIDE, e0, cl);
          const float o0 = step_compute<KIND>(A, S);
          ob[s * 32 + cl] = o0;
          step_load<KIND>(A, b + (s + 2 < 16 ? s + 2 : 15) * STRIDE, e0, cl);
          const float o1 = step_compute<KIND>(B, S);
          ob[(s + 1) * 32 + cl] = o1;
        }
      } else {
        for (int s = 0; s < n; ++s) {
          StepOps<KIND> A;
          step_load<KIND>(A, b + s * STRIDE, e0, cl);
          const float o0 = step_compute<KIND>(A, S);
          ob[s * 32 + cl] = o0;
        }
      }
    }
    __syncthreads();
  }
  if (do_stage) {
    const int c = nchunks - 1, t0 = c * 16, n = T - t0;
    const float* pob = obuf + (c & 1) * 512;
    const int s = tid >> 4, cc = (tid & 15) * 2;
    const f32x2 ov = *(const f32x2*)(pob + s * 32 + cc);
    if (s < n) *(unsigned*)(oraw + (size_t)(R0 + t0 + s) * PSTR + ocol + cc) = pk2(ov[0], ov[1]);
  }
  if (do_comp) {
    float* so = P.out + (sample ? O_S + ((size_t)(l * 128 + (seq - 8)) * NH + h) * 4096 : O_P + ((size_t)(l * 8 + seq) * NH + h) * 4096);
#pragma unroll
    for (int i = 0; i < 8; ++i) { if (KIND == 1) so[col * 64 + e0 + i] = S[i >> 1][i & 1]; else so[(e0 + i) * 64 + col] = S[i >> 1][i & 1]; }
  }
}

__device__ __forceinline__ void scan_phase(const Params& P, unsigned char* smem, int l, volatile unsigned* blk  ) {
  unsigned* q = WSP(unsigned, OFF_QUEUE) + l * 128;
  const int grp = otid() >> 8;
  for (int pass = 0; pass < 2; ++pass) {
    unsigned* qq = pass == 1 ? q + 64 : q;
    const unsigned ntask = pass == 1 ? 2048u : 256u;
    for (;;) {
      __syncthreads();
      if (threadIdx.x == 0) blk[3] = __hip_atomic_fetch_add(qq, 1u, __ATOMIC_RELAXED, __HIP_MEMORY_SCOPE_AGENT);
      __syncthreads();
      const int t = (int)blk[3];
      if (t >= (int)ntask) break;
      int kind, seq, h, half, act; unsigned char* sm;
      if (pass == 0) {
        act = grp == 0 ? 1 : 2; sm = smem; half = t & 1;
        if (t < 96) { kind = 1; const int bh = t >> 1; seq = bh / 6; h = bh % 6; }
        else if (t < 192) { kind = 0; const int bh = (t - 96) >> 1; seq = bh / 6; h = bh % 6; }
        else { kind = 2; const int bh = (t - 192) >> 1; seq = bh / 4; h = bh % 4; }
      } else {
        const int hh = t & 15;
        act = 0; sm = smem + grp * 51200; half = grp; seq = 8 + (t >> 4);
        if (hh < 6) { kind = 0; h = hh; } else if (hh < 12) { kind = 1; h = hh - 6; } else { kind = 2; h = hh - 12; }
      }
      if (kind == 0) scan_task<0>(P, sm, l, seq, h, half, act);
      else if (kind == 1) scan_task<1>(P, sm, l, seq, h, half, act);
      else scan_task<2>(P, sm, l, seq, h, half, act);
    }
  }
  if (l + 1 < NLAYER) {
    for (;;) {
      __syncthreads();
      if (threadIdx.x == 0) blk[3] = __hip_atomic_fetch_add(q + 96, 1u, __ATOMIC_RELAXED, __HIP_MEMORY_SCOPE_AGENT);
      __syncthreads();
      const unsigned t = blk[3];
      if (t >= (unsigned)WCONV_JOBS) break;
      wconv_job(P, smem, l + 1, (int)t);
    }
  }
  if (l == 0) {
    for (;;) {
      __syncthreads();
      if (threadIdx.x == 0) blk[3] = __hip_atomic_fetch_add(q + 112, 1u, __ATOMIC_RELAXED, __HIP_MEMORY_SCOPE_AGENT);
      __syncthreads();
      const unsigned t = blk[3];
      if (t >= 2368u) break;
      wconv_job(P, smem, 0, 1024 + (int)t);
    }
  }
}

__device__ __forceinline__ void post_phase(const Params& P, int l) {
  const int lane = otid() & 63, wid = otid() >> 6, hl = lane >> 5, c2 = (lane & 31) * 2;
  const bf16_t* p = WSP(bf16_t, OFF_P);
  bf16_t* act = WSP(bf16_t, OFF_ACT);
  const int gw = obid() * 8 + wid, nw = gridDim.x * 8;
  const f32x2 gnw = *(const f32x2*)(P.in[I_GNW] + l * 64 + c2), hnw = *(const f32x2*)(P.in[I_HNW] + l * 64 + c2);
  for (int u0 = gw * 8; u0 < NTOK * 10; u0 += nw * 8) {
    unsigned o[4], z[4]; int oc[4]; size_t rb[4];
#pragma unroll
    for (int k = 0; k < 4; ++k) {
      const int u = u0 + 2 * k + hl, row = u / 10, q = u - row * 10;
      oc[k] = q < 6 ? q * 64 : 768 + (q - 6) * 64;
      const int zc = q < 6 ? 1152 + q * 64 : PC + 768 + (q - 6) * 64;
      rb[k] = (size_t)row;
      o[k] = *(const unsigned*)(p + (size_t)row * PSTR + oc[k] + c2);
      z[k] = *(const unsigned*)(p + (size_t)row * PSTR + zc + c2);
    }
#pragma unroll
    for (int k = 0; k < 4; ++k) {
      const float o0 = __uint_as_float(o[k] << 16), o1 = __uint_as_float(o[k] & 0xffff0000u);
      const float z0 = __uint_as_float(z[k] << 16), z1 = __uint_as_float(z[k] & 0xffff0000u);
      const float rn = rsqrtf(half_sum(o0 * o0 + o1 * o1) * (1.f / 64.f) + 1e-6f);
      const f32x2 w = oc[k] < 384 ? gnw : hnw;
      *(unsigned*)(act + rb[k] * 1024 + oc[k] + c2) = pk2(o0 * rn * w[0] * silu(z0), o1 * rn * w[1] * silu(z1));
    }
  }
  for (int u0 = gw * 4; u0 < NTOK * 6; u0 += nw * 4) {
    unsigned o[2], r[2], kx[2], v[2], g[2]; int hh[2]; size_t rb[2];
#pragma unroll
    for (int k = 0; k < 2; ++k) {
      const int u = u0 + 2 * k + hl, row = u / 6, h = u - row * 6;
      const size_t idx = (size_t)row * 384 + h * 64 + c2;
      hh[k] = h; rb[k] = (size_t)row;
      o[k] = *(const unsigned*)(p + (size_t)row * PSTR + 384 + h * 64 + c2);
      r[k] = *(const unsigned*)(WSP(bf16_t, OFF_RR) + idx); kx[k] = *(const unsigned*)(WSP(bf16_t, OFF_RK) + idx);
      v[k] = *(const unsigned*)(WSP(bf16_t, OFF_RV) + idx); g[k] = *(const unsigned*)(WSP(bf16_t, OFF_RG) + idx);
    }
#pragma unroll
    for (int k = 0; k < 2; ++k) {
      const int hc = l * 384 + hh[k] * 64 + c2;
      const f32x2 lw = *(const f32x2*)(P.in[I_LNW] + hc), lb = *(const f32x2*)(P.in[I_LNB] + hc), rkw = *(const f32x2*)(P.in[I_RK] + hc);
      const float o0 = __uint_as_float(o[k] << 16), o1 = __uint_as_float(o[k] & 0xffff0000u);
      const float r0 = __uint_as_float(r[k] << 16), r1 = __uint_as_float(r[k] & 0xffff0000u);
      const float k0 = __uint_as_float(kx[k] << 16), k1 = __uint_as_float(kx[k] & 0xffff0000u);
      const float v0 = __uint_as_float(v[k] << 16), v1 = __uint_as_float(v[k] & 0xffff0000u);
      const float g0 = __uint_as_float(g[k] << 16), g1 = __uint_as_float(g[k] & 0xffff0000u);
      const float mu = half_sum(o0 + o1) * (1.f / 64.f);
      const float y0 = o0 - mu, y1 = o1 - mu;
      const float rn = rsqrtf(half_sum(y0 * y0 + y1 * y1) * (1.f / 64.f) + 64e-5f);
      const float rk = half_sum(r0 * k0 * rkw[0] + r1 * k1 * rkw[1]);
      *(unsigned*)(act + rb[k] * 1024 + 384 + hh[k] * 64 + c2) = pk2((y0 * rn * lw[0] + lb[0] + rk * v0) * g0, (y1 * rn * lw[1] + lb[1] + rk * v1) * g1);
    }
  }
}

#define XB_TMO      128
#define XB_XCNT(j)  (256  + 64 * (j))
#define XB_XSUB(j)  (1280 + 64 * (j))
#define XB_XGEN(j)  (2304 + 64 * (j))
#define XB_TOP      3328
#define XB_TOPGEN   3392
#define XCD_BAR_WORDS 3456
#define XB_SPIN_CAP (1u << 20)
#define LAS __attribute__((address_space(3)))
__device__ __forceinline__ unsigned xb_ld(unsigned* p)              { return __hip_atomic_load(p, __ATOMIC_RELAXED, __HIP_MEMORY_SCOPE_AGENT); }
__device__ __forceinline__ unsigned xb_add(unsigned* p, unsigned v) { return __hip_atomic_fetch_add(p, v, __ATOMIC_RELAXED, __HIP_MEMORY_SCOPE_AGENT); }
__device__ __forceinline__ unsigned xb_xcc_id() { return (unsigned)__builtin_amdgcn_s_getreg((3 << 11) | 20) & 0xFu; }
#define XB_SPIN(cond, bar) do { unsigned _sp = 0; while (cond) { __builtin_amdgcn_s_sleep(1); \
    if ((++_sp & 255u) == 0u) { if (xb_ld(&(bar)[XB_TMO])) break; if (_sp > XB_SPIN_CAP) { atomicAdd(&(bar)[XB_TMO], 1u); break; } } } } while (0)
struct XcdBarrier { unsigned* bar; unsigned x; volatile LAS unsigned* st; };
__device__ __forceinline__ XcdBarrier xcd_barrier_post(unsigned* bar, volatile LAS unsigned* st) {
  XcdBarrier b; b.bar = bar; b.x = xb_xcc_id(); b.st = st;
  if (threadIdx.x == 0) (void)xb_add(&bar[XB_XCNT(b.x)], 1u);
  return b;
}
__device__ __forceinline__ void xcd_barrier_complete(unsigned* bar, unsigned x, unsigned& nloc, unsigned& nx) {
  const unsigned G = gridDim.x * gridDim.y * gridDim.z;
  unsigned sum, cnt, mine, sp = 0u;
  for (;;) {
    sum = 0u; cnt = 0u; mine = 0u;
#pragma unroll
    for (unsigned j = 0; j < 16; ++j) { const unsigned c = xb_ld(&bar[XB_XCNT(j)]); sum += c; cnt += (c > 0u) ? 1u : 0u; mine = (j == x) ? c : mine; }
    if (sum == G) break;
    __builtin_amdgcn_s_sleep(1);
    if ((++sp & 255u) == 0u) { if (xb_ld(&bar[XB_TMO])) break; if (sp > XB_SPIN_CAP) { atomicAdd(&bar[XB_TMO], 1u); break; } }
  }
  nloc = mine > 0u ? mine : 1u; nx = cnt > 0u ? cnt : 1u;
}
__device__ __forceinline__ void xcd_barrier(const XcdBarrier& b) {
  asm volatile("s_waitcnt vmcnt(0)" ::: "memory");
  __syncthreads();
  if (threadIdx.x == 0) {
    unsigned* bar = b.bar;
    __builtin_amdgcn_s_waitcnt(0);
    unsigned nloc = b.st[0], nx = b.st[1];
    if (nloc == 0u) { xcd_barrier_complete(bar, b.x, nloc, nx); b.st[0] = nloc; b.st[1] = nx; }
    const unsigned old = xb_add(&bar[XB_XSUB(b.x)], 1u);
    const unsigned gen = old / nloc;
    if (old + 1u == (gen + 1u) * nloc) {
      __builtin_amdgcn_fence(__ATOMIC_RELEASE, "agent");
      asm volatile("s_waitcnt vmcnt(0)" ::: "memory");
      const unsigned og = xb_add(&bar[XB_TOP], 1u);
      const unsigned tg = og / nx;
      if (og + 1u == (tg + 1u) * nx) xb_add(&bar[XB_TOPGEN], 1u);
      else XB_SPIN(xb_ld(&bar[XB_TOPGEN]) == tg, bar);
      __builtin_amdgcn_fence(__ATOMIC_ACQUIRE, "agent");
      xb_add(&bar[XB_XGEN(b.x)], 1u);
      asm volatile("s_waitcnt vmcnt(0)" ::: "memory");
    } else {
      XB_SPIN(xb_ld(&bar[XB_XGEN(b.x)]) == gen, bar);
      __builtin_amdgcn_fence(__ATOMIC_ACQUIRE, "agent");
      asm volatile("s_waitcnt vmcnt(0)" ::: "memory");
    }
  }
  __syncthreads();
}

__global__ void __launch_bounds__(512, 2) hybrid_fwd(Params P) {
  cg::grid_group grid = cg::this_grid();
  __shared__ __attribute__((aligned(16))) unsigned char smem[131072 + 64];
  uint4& xb_words = *(uint4*)(smem + 131072);
  if (threadIdx.x == 0) xb_words = make_uint4(0u, 0u, 0u, 0u);
  __syncthreads();
  const XcdBarrier xb = xcd_barrier_post(WSP(unsigned, OFF_BAR), (volatile LAS unsigned*)&xb_words);
  if (threadIdx.x == 0) {
    const unsigned hw = (unsigned)__builtin_amdgcn_s_getreg((7 << 11) | (8 << 6) | 4) & 0xffu;
    const unsigned key = (xb.x << 8) | hw;
    ((volatile unsigned*)&xb_words)[2] = __hip_atomic_fetch_add(WSP(unsigned, OFF_CUTAB) + key, 1u, __ATOMIC_RELAXED, __HIP_MEMORY_SCOPE_AGENT);
  }
  __syncthreads();
#pragma unroll 1
  for (int step = 0; step < NLAYER * 9; ++step) {
    const int l = step / 9, ph = step - l * 9;
    switch (ph) {
      case 0: if (l == 0) wconv_phase(P, smem, 0); norm_phase(P, l, P.in[I_NORM_MIX] + l * D); break;
      case 1: gemm_phase<EPI_P>(P, smem, WSP(bf16_t, OFF_ACT), 1024, WSP(bf16_t, OFF_WTIN), 1024, 32, l, 4096);
              gemm_sample<EPI_P>(P, smem, WSP(bf16_t, OFF_ACT), 1024, WSP(bf16_t, OFF_WTIN), 1024, 249, l); break;
      case 2: prep_phase(P, smem, l, (volatile unsigned*)&xb_words); break;
      case 3: scan_phase(P, smem, l, (volatile unsigned*)&xb_words); break;
      case 4: post_phase(P, l); break;
      case 5: gemm_phase<EPI_RES>(P, smem, WSP(bf16_t, OFF_ACT), 1024, WSP(bf16_t, wt_out_off(l)), 1024, 8, l, 1024);
              gemm_sample<EPI_RES>(P, smem, WSP(bf16_t, OFF_ACT), 1024, WSP(bf16_t, wt_out_off(l)), 1024, 64, l); break;
      case 6: norm_phase(P, 1, P.in[I_NORM_FFN] + l * D); break;
      case 7: gemm_phase<EPI_SWIGLU>(P, smem, WSP(bf16_t, OFF_ACT), 1024, WSP(bf16_t, wt_gu_off(l)), 1024, 44, 1, 5632);
              gemm_sample<EPI_SWIGLU>(P, smem, WSP(bf16_t, OFF_ACT), 1024, WSP(bf16_t, wt_gu_off(l)), 1024, 176, 1); break;
      default: gemm_phase<EPI_RES>(P, smem, WSP(bf16_t, OFF_P), DFF, WSP(bf16_t, wt_dn_off(l)), DFF, 8, 1, 1024);
               gemm_sample<EPI_RES>(P, smem, WSP(bf16_t, OFF_P), DFF, WSP(bf16_t, wt_dn_off(l)), DFF, 64, 1); break;
    }
    if (step == 0) grid.sync();
    else xcd_barrier(xb);
  }
  final_norm_phase(P);
}

extern "C" void kernel_launch(void* const* d_in, const int* in_sizes, int n_in,
                              void* d_out, int out_size, void* d_ws, size_t ws_size,
                              hipStream_t stream) {
  static int grid_blocks = 0;
  if (!grid_blocks) {
    int dev = 0, cus = 0, per_cu = 0;
    (void)hipGetDevice(&dev);
    (void)hipDeviceGetAttribute(&cus, hipDeviceAttributeMultiprocessorCount, dev);
    (void)hipOccupancyMaxActiveBlocksPerMultiprocessor(&per_cu, hybrid_fwd, 512, 0);
    if (per_cu > 1) per_cu = 1;
    if (per_cu < 1) per_cu = 1;
    grid_blocks = cus * per_cu;
  }
  if (ws_size < WS_NEED) { fprintf(stderr, "workspace too small: %zu < %zu\n", ws_size, (size_t)WS_NEED); return; }
  Params p{};
  for (int i = 0; i < N_IN; ++i) p.in[i] = (const float*)d_in[i];
  p.out = (float*)d_out;
  p.ws = (unsigned char*)d_ws;
  (void)hipMemsetAsync((unsigned char*)d_ws + OFF_BAR, 0, BAR_BYTES, stream);
  void* args[] = {&p};
  hipError_t e = hipLaunchCooperativeKernel((void*)hybrid_fwd, dim3(grid_blocks), dim3(512), args, 0, stream);
  if (e != hipSuccess) fprintf(stderr, "cooperative launch failed: %s (grid %d)\n", hipGetErrorString(e), grid_blocks);
}
```

```cpp
#include <hip/hip_runtime.h>
#include <hip/hip_cooperative_groups.h>
#include <cstdio>
namespace cg = cooperative_groups;

typedef unsigned short bf16_t;
typedef short bf16x8 __attribute__((ext_vector_type(8)));
typedef float f32x4 __attribute__((ext_vector_type(4)));
typedef unsigned u32x4 __attribute__((ext_vector_type(4)));
typedef unsigned u32x2 __attribute__((ext_vector_type(2)));

constexpr int D = 1024, NTP = 16384, NTS = 128, NTOK = 16512, TSEQ = 2048, NLAYER = 4;
constexpr int IN_COLS = 3980, PSTR = 3984, DFF = 2816;
constexpr int PB = 1548, PC = 2956;

enum { I_XP = 0, I_XS, I_SGDN, I_SCONV, I_SRWKV, I_SSHIFT, I_SHGRN, I_NORM_MIX, I_WIN, I_WOUT, I_CONVW, I_ALOG, I_DTB, I_GNW,
       I_MU, I_W0, I_W2, I_A0, I_A2, I_G2, I_V0, I_V1, I_V2, I_KK, I_KA, I_RK, I_LNW, I_LNB, I_HLB, I_HNW, I_NORM_FFN,
       I_WG, I_WU, I_WD, I_NORM_FINAL, N_IN };

constexpr size_t O_YP = 0, O_YS = 16777216, O_GDN_P = 16908288, O_GDN_S = 17694720, O_CONV_P = 30277632, O_CONV_S = 30388224,
                 O_RWKV_P = 32157696, O_RWKV_S = 32944128, O_SHIFT_P = 45527040, O_SHIFT_S = 45572096, O_HGRN_P = 46292992,
                 O_HGRN_S = 46817280;

constexpr size_t SZ_WTIN = (size_t)4096 * 1024 * 2, SZ_WTOUT = (size_t)1024 * 1024 * 2, SZ_WTGU = (size_t)5632 * 1024 * 2,
                 SZ_WTDN = (size_t)1024 * 2816 * 2, SZ_P = (size_t)NTOK * PSTR * 2, SZ_ACT = (size_t)NTOK * 1024 * 2,
                 SZ_T384 = (size_t)NTOK * 384 * 2, SZ_T8F = (size_t)NTOK * 8 * 4, SZ_T256 = (size_t)NTOK * 256 * 2,
                 SZ_T384F = (size_t)NTOK * 384 * 4;
constexpr size_t OFF_WTIN = 0, OFF_WTOUT = OFF_WTIN + SZ_WTIN, OFF_WTGU = OFF_WTOUT + SZ_WTOUT, OFF_WTDN = OFF_WTGU + SZ_WTGU,
                 OFF_P = OFF_WTDN + SZ_WTDN, OFF_ACT = OFF_P + SZ_P, OFF_GQ = OFF_ACT + SZ_ACT, OFF_GK = OFF_GQ + SZ_T384,
                 OFF_GV = OFF_GK + SZ_T384, OFF_GDEC = OFF_GV + SZ_T384, OFF_GBETA = OFF_GDEC + SZ_T8F, OFF_HQ = OFF_GBETA + SZ_T8F,
                 OFF_HK = OFF_HQ + SZ_T256, OFF_RR = OFF_HK + SZ_T256, OFF_RK = OFF_RR + SZ_T384, OFF_RV = OFF_RK + SZ_T384,
                 OFF_RKK = OFF_RV + SZ_T384, OFF_RB = OFF_RKK + SZ_T384, OFF_RG = OFF_RB + SZ_T384, OFF_RW = OFF_RG + SZ_T384,
                 OFF_VF = OFF_RW + SZ_T384F, OFF_LORA = OFF_VF + SZ_T384, OFF_WTOUT2 = OFF_LORA + 245760, OFF_WTGU2 = OFF_WTOUT2 + SZ_WTOUT, OFF_WTDN2 = OFF_WTGU2 + SZ_WTGU, OFF_BAR = OFF_WTDN2 + SZ_WTDN, OFF_CUTAB = OFF_BAR + 16384, OFF_QUEUE = OFF_CUTAB + 16384, BAR_BYTES = 16384 + 16384 + 4096, WS_NEED = OFF_BAR + BAR_BYTES;
constexpr int W2T = 0, A2T = 24576, G2T = 49152, V1T = 98304, V2T = 110592;

struct Params {
  const float* in[N_IN];
  float* out;
  unsigned char* ws;
};

#define WSP(T, off) ((T*)(P.ws + (off)))

__device__ __forceinline__ int otid() { int t = __builtin_amdgcn_workitem_id_x(); asm volatile("" : "+v"(t)); return t; }
__device__ __forceinline__ int obid() { int b = __builtin_amdgcn_workgroup_id_x(); asm volatile("" : "+s"(b)); return b; }
template <class T> __device__ __forceinline__ const T* opq(const T* p) { asm volatile("" : "+s"(p)); return p; }
__device__ __forceinline__ float bf2f(bf16_t h) { return __uint_as_float(((unsigned)h) << 16); }
typedef float f32x2_t __attribute__((ext_vector_type(2)));
typedef __bf16 bf16x2_t __attribute__((ext_vector_type(2)));
__device__ __forceinline__ unsigned pk2(float lo, float hi) {
  const f32x2_t v = {lo, hi};
  return __builtin_bit_cast(unsigned, __builtin_convertvector(v, bf16x2_t));
}
__device__ __forceinline__ bf16_t f2bf(float f) { return (bf16_t)(pk2(f, 0.f) & 0xffffu); }
__device__ __forceinline__ float sigm(float x) { return 1.f / (1.f + __expf(-x)); }
__device__ __forceinline__ float silu(float x) { return x / (1.f + __expf(-x)); }
__device__ __forceinline__ float softplus(float x) { return x > 20.f ? x : log1pf(__expf(x)); }
template <int CTRL> __device__ __forceinline__ float dppf(float x) {
  return __builtin_bit_cast(float, __builtin_amdgcn_mov_dpp(__builtin_bit_cast(int, x), CTRL, 0xf, 0xf, true));
}
__device__ __forceinline__ float wave_sum(float v) {
  v += dppf<0xB1>(v); v += dppf<0x4E>(v); v += dppf<0x141>(v); v += dppf<0x140>(v);
  const int iv = __builtin_bit_cast(int, v);
  const float s0 = __builtin_bit_cast(float, __builtin_amdgcn_readlane(iv, 0)), s1 = __builtin_bit_cast(float, __builtin_amdgcn_readlane(iv, 16));
  const float s2 = __builtin_bit_cast(float, __builtin_amdgcn_readlane(iv, 32)), s3 = __builtin_bit_cast(float, __builtin_amdgcn_readlane(iv, 48));
  return (s0 + s1) + (s2 + s3);
}
typedef float f32x2 __attribute__((ext_vector_type(2)));
__device__ __forceinline__ float row_sum16(float v) { v += dppf<0xB1>(v); v += dppf<0x4E>(v); v += dppf<0x141>(v); v += dppf<0x140>(v); return v; }
__device__ __forceinline__ float half_sum(float v) { v = row_sum16(v); return v + __shfl_xor(v, 16); }
__device__ __forceinline__ float reduce8(float x) { x += dppf<0xB1>(x); x += dppf<0x4E>(x); x += dppf<0x141>(x); return x; }

__device__ __forceinline__ f32x4 unpack4(u32x2 w) {
  f32x4 f; f[0] = __uint_as_float(w[0] << 16); f[1] = __uint_as_float(w[0] & 0xffff0000u);
  f[2] = __uint_as_float(w[1] << 16); f[3] = __uint_as_float(w[1] & 0xffff0000u); return f;
}
__device__ __forceinline__ bf16x8 pack8(f32x4 a, f32x4 b) {
  u32x4 u; u[0] = pk2(a[0], a[1]); u[1] = pk2(a[2], a[3]); u[2] = pk2(b[0], b[1]); u[3] = pk2(b[2], b[3]);
  return __builtin_bit_cast(bf16x8, u);
}
__device__ __forceinline__ u32x2 pack4(f32x4 a) { u32x2 u; u[0] = pk2(a[0], a[1]); u[1] = pk2(a[2], a[3]); return u; }
__device__ __forceinline__ float dot4(f32x4 a, f32x4 b) { return (a[0] * b[0] + a[1] * b[1]) + (a[2] * b[2] + a[3] * b[3]); }
__device__ __forceinline__ const float* xin_row(const Params& P, int l, int row) {
  const float* po = opq((const float*)P.out); const float* pp = opq(P.in[I_XP]); const float* ps = opq(P.in[I_XS]);
  if (l > 0) return po + (size_t)row * D;
  return row < NTP ? pp + (size_t)row * D : ps + (size_t)(row - NTP) * D;
}

__device__ __forceinline__ int gu_row(int c, int up) { return (c >> 7) * 256 + up * 128 + (c & 127); }
__device__ __forceinline__ void xpose_tile(unsigned char* smem, const float* __restrict__ W, int N, int kt, int ntl, bf16_t* __restrict__ dst, int dstK, int mode) {
  float (*tile)[65] = (float (*)[65])smem;
  const int tid = otid();
  __syncthreads();
#pragma unroll 4
  for (int i = 0; i < 8; ++i) {
    const int k = i * 8 + (tid >> 6), n = tid & 63, gn = ntl * 64 + n;
    tile[k][n] = gn < N ? W[(size_t)(kt * 64 + k) * N + gn] : 0.f;
  }
  __syncthreads();
#pragma unroll 4
  for (int i = 0; i < 4; ++i) {
    const int n = i * 16 + (tid >> 5), k = (tid & 31) * 2, gn = ntl * 64 + n;
    const int drow = mode == 0 ? gn : gu_row(gn, mode - 1);
    *(unsigned*)(dst + (size_t)drow * dstK + kt * 64 + k) = pk2(tile[k][n], tile[k + 1][n]);
  }
}
constexpr int WCONV_JOBS = 3392 + 480;
__device__ __forceinline__ size_t wt_out_off(int l) { return (l & 1) ? OFF_WTOUT2 : OFF_WTOUT; }
__device__ __forceinline__ size_t wt_gu_off(int l) { return (l & 1) ? OFF_WTGU2 : OFF_WTGU; }
__device__ __forceinline__ size_t wt_dn_off(int l) { return (l & 1) ? OFF_WTDN2 : OFF_WTDN; }
__device__ __forceinline__ void wconv_job(const Params& P, unsigned char* smem, int l, int job) {
  if (job < 1024) xpose_tile(smem, P.in[I_WIN] + (size_t)l * 1024 * IN_COLS, IN_COLS, job & 15, job >> 4, WSP(bf16_t, OFF_WTIN), 1024, 0);
  else if (job < 1280) { const int j = job - 1024; xpose_tile(smem, P.in[I_WOUT] + (size_t)l * 1024 * 1024, 1024, j & 15, j >> 4, WSP(bf16_t, wt_out_off(l)), 1024, 0); }
  else if (job < 1984) { const int j = job - 1280; xpose_tile(smem, P.in[I_WG] + (size_t)l * 1024 * DFF, DFF, j & 15, j >> 4, WSP(bf16_t, wt_gu_off(l)), 1024, 1); }
  else if (job < 2688) { const int j = job - 1984; xpose_tile(smem, P.in[I_WU] + (size_t)l * 1024 * DFF, DFF, j & 15, j >> 4, WSP(bf16_t, wt_gu_off(l)), 1024, 2); }
  else if (job < 3392) { const int j = job - 2688; xpose_tile(smem, P.in[I_WD] + (size_t)l * DFF * 1024, 1024, j % 44, j / 44, WSP(bf16_t, wt_dn_off(l)), DFF, 0); }
  else {
    bf16_t* lw = WSP(bf16_t, OFF_LORA);
    const int idx = (job - 3392) * 256 + (otid() & 255);
    float v = 0.f;
    const float* pw2 = opq(P.in[I_W2]); const float* pa2 = opq(P.in[I_A2]); const float* pg2 = opq(P.in[I_G2]);
    const float* pv1 = opq(P.in[I_V1]); const float* pv2 = opq(P.in[I_V2]);
    if (idx < A2T) { const int n = idx >> 6, k = idx & 63; v = pw2[(size_t)l * 64 * 384 + k * 384 + n]; }
    else if (idx < G2T) { const int i = idx - A2T, n = i >> 6, k = i & 63; v = pa2[(size_t)l * 64 * 384 + k * 384 + n]; }
    else if (idx < V1T) { const int i = idx - G2T, n = i >> 7, k = i & 127; v = pg2[(size_t)l * 128 * 384 + k * 384 + n]; }
    else if (idx < V2T) { if (l > 0) { const int i = idx - V1T, n = i / 384, k = i - n * 384; v = pv1[(size_t)(l - 1) * 384 * 32 + k * 32 + n]; } }
    else { if (l > 0) { const int i = idx - V2T, n = i >> 5, k = i & 31; v = pv2[(size_t)(l - 1) * 32 * 384 + k * 384 + n]; } }
    if (otid() < 256) lw[idx] = f2bf(v);
  }
}
__device__ __forceinline__ void wconv_phase(const Params& P, unsigned char* smem, int l) {
  for (int j = obid(); j < 1024 + 480; j += gridDim.x) wconv_job(P, smem, l, j < 1024 ? j : j + 2368);
}

__device__ __forceinline__ void norm_phase(const Params& P, int l_in, const float* __restrict__ w) {
  bf16_t* act = WSP(bf16_t, OFF_ACT);
  const int lane = otid() & 63, wid = otid() >> 6;
  f32x4 wv[4];
#pragma unroll
  for (int i = 0; i < 4; ++i) wv[i] = *(const f32x4*)(w + i * 256 + lane * 4);
  for (int r0 = (obid() * 8 + wid) * 4; r0 < NTOK; r0 += gridDim.x * 32) {
    f32x4 v[4][4];
#pragma unroll
    for (int r = 0; r < 4; ++r) {
      const float* xr = xin_row(P, l_in, r0 + r);
#pragma unroll
      for (int i = 0; i < 4; ++i) v[r][i] = *(const f32x4*)(xr + i * 256 + lane * 4);
    }
#pragma unroll
    for (int r = 0; r < 4; ++r) {
      float ss = 0.f;
#pragma unroll
      for (int i = 0; i < 4; ++i) ss += dot4(v[r][i], v[r][i]);
      const float rstd = rsqrtf(wave_sum(ss) * (1.f / 1024.f) + 1e-6f);
#pragma unroll
      for (int i = 0; i < 4; ++i) *(u32x2*)(act + (size_t)(r0 + r) * 1024 + i * 256 + lane * 4) = pack4(v[r][i] * rstd * wv[i]);
    }
  }
}
__device__ __forceinline__ void final_norm_phase(const Params& P) {
  const float* w = P.in[I_NORM_FINAL];
  const int lane = otid() & 63, wid = otid() >> 6;
  f32x4 wv[4];
#pragma unroll
  for (int i = 0; i < 4; ++i) wv[i] = *(const f32x4*)(w + i * 256 + lane * 4);
  for (int r0 = (obid() * 8 + wid) * 4; r0 < NTOK; r0 += gridDim.x * 32) {
    f32x4 v[4][4];
#pragma unroll
    for (int r = 0; r < 4; ++r)
#pragma unroll
      for (int i = 0; i < 4; ++i) v[r][i] = *(const f32x4*)(P.out + (size_t)(r0 + r) * D + i * 256 + lane * 4);
#pragma unroll
    for (int r = 0; r < 4; ++r) {
      float ss = 0.f;
#pragma unroll
      for (int i = 0; i < 4; ++i) ss += dot4(v[r][i], v[r][i]);
      const float rstd = rsqrtf(wave_sum(ss) * (1.f / 1024.f) + 1e-6f);
#pragma unroll
      for (int i = 0; i < 4; ++i) *(f32x4*)(P.out + (size_t)(r0 + r) * D + i * 256 + lane * 4) = v[r][i] * rstd * wv[i];
    }
  }
}

enum { EPI_P = 0, EPI_RES = 1, EPI_SWIGLU = 2 };
namespace pg8 {
constexpr int BM = 256, BK = 64, HALF = 128, HTB = HALF * BK * 2, NXCD = 8, WGM = 8;
__device__ __forceinline__ int lds_byte(int r, int c) { const int st = (r >> 4) * 2 + (c >> 5), rr = r & 15, cc = c & 31, ob = rr * 64 + cc * 2; return st * 1024 + (ob ^ (((ob >> 9) & 1) << 5)); }
__device__ __forceinline__ void stage_rc(int b, int& R, int& C) { const int st = b / 1024, sb = b % 1024, swz = sb ^ (((sb >> 9) & 1) << 5); R = (st >> 1) * 16 + swz / 64; C = (st & 1) * 32 + (swz % 64) / 2; }
__device__ __forceinline__ int perm32(int rho) { const int n = rho >> 4, i = rho & 15; return 8 * (i >> 2) + 4 * n + (i & 3); }
struct Unit { int pm, pn; };
struct StaticOrder {
  int nM, nN, nwg, G, c;
  __device__ __forceinline__ void init(int M, int N, int G_, int c_) { nM = M / BM; nN = N / BM; nwg = nM * nN; G = G_; c = c_; }
  __device__ __forceinline__ bool next(int i, Unit& u) const {
    const long L = (long)i * G + c; if (L >= nwg) return false;
    int wgid = (int)L; { const int q = nwg / NXCD, r = nwg % NXCD, xcd = wgid % NXCD, off = wgid / NXCD; wgid = (xcd < r ? xcd * (q + 1) : r * (q + 1) + (xcd - r) * q) + off; }
    const int nig = WGM * nN, gid = wgid / nig, fm = gid * WGM, gsz = (nM - fm) < WGM ? (nM - fm) : WGM;
    u.pm = fm + ((wgid % nig) % gsz); u.pn = (wgid % nig) / gsz; return true;
  }
};
}

template <int EPI>
__device__ __forceinline__ void gemm_epilogue(const Params& P, const f32x4 (&acc)[2][2][4][2], const pg8::Unit& u, int wr, int wc, int fr, int fq, int l) {
#pragma unroll
  for (int ai = 0; ai < 2; ++ai)
#pragma unroll
    for (int m = 0; m < 4; ++m) {
      const int row = u.pm * 256 + ai * 128 + wr * 64 + m * 16 + fr;
      if (EPI == EPI_P) {
        bf16_t* pr = WSP(bf16_t, OFF_P) + (size_t)row * PSTR;
#pragma unroll
        for (int bj = 0; bj < 2; ++bj) {
          const int col = u.pn * 256 + bj * 128 + wc * 32 + fq * 8;
          if (col < PSTR) { const u32x2 lo = pack4(acc[ai][bj][m][0]), hi = pack4(acc[ai][bj][m][1]); *(u32x4*)(pr + col) = (u32x4){lo[0], lo[1], hi[0], hi[1]}; }
        }
      } else if (EPI == EPI_RES) {
        const float* xi = xin_row(P, l, row);
        float* xo = P.out + (size_t)row * D;
#pragma unroll
        for (int bj = 0; bj < 2; ++bj)
#pragma unroll
          for (int n = 0; n < 2; ++n) {
            const int col = u.pn * 256 + bj * 128 + wc * 32 + n * 16 + fq * 4;
            *(f32x4*)(xo + col) = *(const f32x4*)(xi + col) + acc[ai][bj][m][n];
          }
      } else {
        bf16_t* ur = WSP(bf16_t, OFF_P) + (size_t)row * DFF;
        {
          const int col = u.pn * 128 + wc * 32 + fq * 8;
          f32x4 r0, r1;
#pragma unroll
          for (int j = 0; j < 4; ++j) { r0[j] = silu(acc[ai][0][m][0][j]) * acc[ai][1][m][0][j]; r1[j] = silu(acc[ai][0][m][1][j]) * acc[ai][1][m][1][j]; }
          const u32x2 lo = pack4(r0), hi = pack4(r1);
          *(u32x4*)(ur + col) = (u32x4){lo[0], lo[1], hi[0], hi[1]};
        }
      }
    }
}

#define PG8_LAS __attribute__((address_space(3)))
template <int EPI>
__device__ __forceinline__ void gemm_phase(const Params& P, unsigned char* smem, const bf16_t* __restrict__ Ag, int lda_unused, const bf16_t* __restrict__ Btg, int K, int nN128_unused, int l, int N) {
  using namespace pg8;
  PG8_LAS unsigned char* lds = (PG8_LAS unsigned char*)smem;
  const int tid = otid(), wid = __builtin_amdgcn_readfirstlane(tid >> 6), lane = tid & 63, wr = wid >> 2, wc = wid & 3, fr = lane & 15, fq = lane >> 4;
  const int nt = K / BK;
  StaticOrder S; S.init(NTP, N, (int)gridDim.x, obid());
  unsigned voffA[2], voffB[2];
#pragma unroll
  for (int i = 0; i < 2; ++i) { int R, C; stage_rc(tid * 16 + i * 8192, R, C); const int Rb = EPI == EPI_RES ? R : ((R & ~31) + perm32(R & 31));
    voffA[i] = (unsigned)(R * K + C) * 2u; voffB[i] = (unsigned)(Rb * K + C) * 2u; }
  const size_t kstep = (size_t)(BK * 2);
  const size_t hstep = (size_t)HALF * K * 2;
  const size_t tstep = 2 * hstep;
  const unsigned ldsw = (unsigned)wid * 1024u;
  const int aoff = lds_byte(wr * 64 + fr, fq * 8), boff = lds_byte(wc * 32 + fr, fq * 8);
#define PG8_SA(b, h) (((b) * 2 + (h)) * HTB)
#define PG8_SB(b, h) ((4 + (b) * 2 + (h)) * HTB)
#define PG8_STAGE(bufoff, gbase, voff) do { _Pragma("unroll") for (int _i = 0; _i < 2; ++_i) \
        __builtin_amdgcn_global_load_lds((const unsigned*)((const char*)(gbase) + (voff)[_i]), (PG8_LAS unsigned*)(lds + (bufoff) + ldsw + _i * 8192), 16, 0, 0); } while (0)
#define PG8_LDA(dst, b, h) do { _Pragma("unroll") for (int m = 0; m < 4; ++m) _Pragma("unroll") for (int k = 0; k < 2; ++k) dst[m][k] = *(const PG8_LAS bf16x8*)(lds + PG8_SA(b, h) + aoff + m * 2048 + k * 1024); } while (0)
#define PG8_LDB(dst, b, h) do { _Pragma("unroll") for (int n = 0; n < 2; ++n) _Pragma("unroll") for (int k = 0; k < 2; ++k) dst[n][k] = *(const PG8_LAS bf16x8*)(lds + PG8_SB(b, h) + boff + n * 2048 + k * 1024); } while (0)
#define PG8_MMA(ai, bj, At, Bt) do { __builtin_amdgcn_s_setprio(1); _Pragma("unroll") for (int m = 0; m < 4; ++m) _Pragma("unroll") for (int n = 0; n < 2; ++n) _Pragma("unroll") for (int k = 0; k < 2; ++k) \
        acc[ai][bj][m][n] = __builtin_amdgcn_mfma_f32_16x16x32_bf16(Bt[n][k], At[m][k], acc[ai][bj][m][n], 0, 0, 0); __builtin_amdgcn_s_setprio(0); } while (0)
#define PG8_WAIT_V(n) asm volatile("s_waitcnt vmcnt(" #n ")" ::: "memory")
#define PG8_WAIT_L(n) asm volatile("s_waitcnt lgkmcnt(" #n ")" ::: "memory")
#define PG8_BAR __builtin_amdgcn_s_barrier()
#define PG8_SCHED __builtin_amdgcn_sched_barrier(0)
  Unit cur, nxt; int ui = 0;
  if (!S.next(0, cur)) return;
  f32x4 acc[2][2][4][2];
#pragma unroll
  for (int a = 0; a < 2; ++a)
#pragma unroll
    for (int b = 0; b < 2; ++b)
#pragma unroll
      for (int m = 0; m < 4; ++m)
#pragma unroll
        for (int n = 0; n < 2; ++n) acc[a][b][m][n] = (f32x4){0.f, 0.f, 0.f, 0.f};
  bf16x8 At[4][2], B0[2][2], B1[2][2];
  const char* cA = (const char*)Ag + (size_t)cur.pm * tstep; const char* cB = (const char*)Btg + (size_t)cur.pn * tstep;
  PG8_STAGE(PG8_SB(0, 0), cB, voffB); PG8_STAGE(PG8_SA(0, 0), cA, voffA); PG8_STAGE(PG8_SB(0, 1), cB + hstep, voffB); PG8_STAGE(PG8_SA(0, 1), cA + hstep, voffA);
  if (wr == 1) PG8_BAR;
  PG8_WAIT_V(4); PG8_BAR;
  PG8_STAGE(PG8_SB(1, 0), cB + kstep, voffB); PG8_STAGE(PG8_SA(1, 0), cA + kstep, voffA); PG8_STAGE(PG8_SB(1, 1), cB + hstep + kstep, voffB);
  PG8_WAIT_V(6); PG8_BAR;
  for (;;) {
    const bool has_next = S.next(ui + 1, nxt);
    const char* nA = has_next ? (const char*)Ag + (size_t)nxt.pm * tstep : cA; const char* nB = has_next ? (const char*)Btg + (size_t)nxt.pn * tstep : cB;
    for (int t = 0; t < nt; t += 2) {
      const bool last = (t == nt - 2);
      const char* a1 = cA + (size_t)(t + 1) * kstep;
      const char* a2 = last ? nA : cA + (size_t)(t + 2) * kstep; const char* b2 = last ? nB : cB + (size_t)(t + 2) * kstep;
      const char* a3 = a2 + kstep; const char* b3 = b2 + kstep;
      PG8_LDB(B0, 0, 0); PG8_SCHED; PG8_LDA(At, 0, 0); PG8_STAGE(PG8_SA(1, 1), a1 + hstep, voffA);
      PG8_WAIT_L(8); PG8_BAR; PG8_WAIT_L(0); PG8_MMA(0, 0, At, B0); PG8_BAR; PG8_SCHED;
      PG8_LDB(B1, 0, 1); PG8_STAGE(PG8_SB(0, 0), b2, voffB);
      PG8_BAR; PG8_WAIT_L(0); PG8_MMA(0, 1, At, B1); PG8_BAR;
      PG8_LDA(At, 0, 1); PG8_STAGE(PG8_SA(0, 0), a2, voffA);
      PG8_BAR; PG8_WAIT_L(0); PG8_MMA(1, 0, At, B0); PG8_BAR; PG8_SCHED;
      PG8_STAGE(PG8_SB(0, 1), b2 + hstep, voffB);
      PG8_WAIT_V(6); PG8_BAR; PG8_MMA(1, 1, At, B1); PG8_BAR;
      PG8_LDB(B0, 1, 0); PG8_SCHED; PG8_LDA(At, 1, 0); PG8_STAGE(PG8_SA(0, 1), a2 + hstep, voffA);
      PG8_WAIT_L(8); PG8_BAR; PG8_WAIT_L(0); PG8_MMA(0, 0, At, B0); PG8_BAR; PG8_SCHED;
      PG8_LDB(B1, 1, 1); PG8_STAGE(PG8_SB(1, 0), b3, voffB);
      PG8_BAR; PG8_WAIT_L(0); PG8_MMA(0, 1, At, B1); PG8_BAR;
      PG8_LDA(At, 1, 1); PG8_STAGE(PG8_SA(1, 0), a3, voffA);
      PG8_BAR; PG8_WAIT_L(0); PG8_MMA(1, 0, At, B0); PG8_BAR; PG8_SCHED;
      PG8_STAGE(PG8_SB(1, 1), b3 + hstep, voffB);
      PG8_WAIT_V(6); PG8_BAR; PG8_MMA(1, 1, At, B1); PG8_BAR;
    }
    gemm_epilogue<EPI>(P, acc, cur, wr, wc, fr, fq, l);
    if (!has_next) break;
#pragma unroll
    for (int a = 0; a < 2; ++a)
#pragma unroll
      for (int b = 0; b < 2; ++b)
#pragma unroll
        for (int m = 0; m < 4; ++m)
#pragma unroll
          for (int n = 0; n < 2; ++n) acc[a][b][m][n] = (f32x4){0.f, 0.f, 0.f, 0.f};
    cur = nxt; cA = nA; cB = nB; ++ui;
  }
  PG8_WAIT_V(0);
  if (wr == 0) PG8_BAR;
  PG8_BAR;
#undef PG8_SA
#undef PG8_SB
#undef PG8_STAGE
#undef PG8_LDA
#undef PG8_LDB
#undef PG8_MMA
#undef PG8_WAIT_V
#undef PG8_WAIT_L
#undef PG8_BAR
#undef PG8_SCHED
}

template <int EPI>
__device__ __forceinline__ void gemm_sample(const Params& P, unsigned char* smem, const bf16_t* __restrict__ A, int lda, const bf16_t* __restrict__ Bt, int K, int nunits, int l) {
  const int tid = otid(), lane = tid & 63, wid = tid >> 6, fr = lane & 15, fq = lane >> 4;
  const int kslice = K >> 3;
  for (int u = (int)gridDim.x - 1 - obid(); u < nunits; u += gridDim.x) {
    const int brow0 = EPI == EPI_SWIGLU ? gu_row(u * 16 + fr, 0) : u * 16 + fr;
    const int brow1 = EPI == EPI_SWIGLU ? gu_row(u * 16 + fr, 1) : 0;
    const bf16_t* ap = A + (size_t)(NTP + fr) * lda + wid * kslice + fq * 8;
    const bf16_t* b0p = Bt + (size_t)brow0 * K + wid * kslice + fq * 8;
    const bf16_t* b1p = Bt + (size_t)brow1 * K + wid * kslice + fq * 8;
    f32x4 c0[8], c1[8];
#pragma unroll
    for (int m = 0; m < 8; ++m) { c0[m] = (f32x4){0.f, 0.f, 0.f, 0.f}; c1[m] = c0[m]; }
#pragma unroll 2
    for (int ks = 0; ks < kslice; ks += 32) {
      bf16x8 Af[8];
#pragma unroll
      for (int m = 0; m < 8; ++m) Af[m] = *(const bf16x8*)(ap + (size_t)m * 16 * lda + ks);
      const bf16x8 B0 = *(const bf16x8*)(b0p + ks);
      bf16x8 B1 = B0;
      if (EPI == EPI_SWIGLU) B1 = *(const bf16x8*)(b1p + ks);
#pragma unroll
      for (int m = 0; m < 8; ++m) {
        c0[m] = __builtin_amdgcn_mfma_f32_16x16x32_bf16(B0, Af[m], c0[m], 0, 0, 0);
        if (EPI == EPI_SWIGLU) c1[m] = __builtin_amdgcn_mfma_f32_16x16x32_bf16(B1, Af[m], c1[m], 0, 0, 0);
      }
    }
    __syncthreads();
#pragma unroll
    for (int m = 0; m < 8; ++m) {
      *(f32x4*)(smem + ((wid * 8 + m) * 64 + lane) * 16) = c0[m];
      if (EPI == EPI_SWIGLU) *(f32x4*)(smem + 65536 + ((wid * 8 + m) * 64 + lane) * 16) = c1[m];
    }
    __syncthreads();
    f32x4 g = (f32x4){0.f, 0.f, 0.f, 0.f}, up = g;
#pragma unroll
    for (int w = 0; w < 8; ++w) {
      g += *(const f32x4*)(smem + ((w * 8 + wid) * 64 + lane) * 16);
      if (EPI == EPI_SWIGLU) up += *(const f32x4*)(smem + 65536 + ((w * 8 + wid) * 64 + lane) * 16);
    }
    {
      const int row = NTP + wid * 16 + fr, col = u * 16 + fq * 4;
      if (EPI == EPI_P) {
        if (col < IN_COLS) *(u32x2*)(WSP(bf16_t, OFF_P) + (size_t)row * PSTR + col) = pack4(g);
      } else if (EPI == EPI_RES) {
        const float* xi = xin_row(P, l, row);
        *(f32x4*)(P.out + (size_t)row * D + col) = *(const f32x4*)(xi + col) + g;
      } else {
        f32x4 r;
#pragma unroll
        for (int j = 0; j < 4; ++j) r[j] = silu(g[j]) * up[j];
        *(u32x2*)(WSP(bf16_t, OFF_P) + (size_t)row * DFF + col) = pack4(r);
      }
    }
  }
}

__device__ __forceinline__ float lbval(const Params& P, int l, int c) {
  const float* hb = P.in[I_HLB];
  const float a0 = hb[c], a1 = hb[256 + c], a2 = hb[512 + c], a3 = hb[768 + c];
  const float m = fmaxf(fmaxf(a0, a1), fmaxf(a2, a3));
  const float e0 = __expf(a0 - m), e1 = __expf(a1 - m), e2 = __expf(a2 - m), e3 = __expf(a3 - m);
  const float inv = 1.f / (e0 + e1 + e2 + e3);
  float s = 0.f;
  if (l >= 1) s += e1; if (l >= 2) s += e2; if (l >= 3) s += e3;
  return s * inv;
}

__device__ __forceinline__ void gdn_conv_emit2(const Params& P, int g, int c2, int row, float s0, float s1) {
  const int h = g % 6;
  if (g < 12) {
    const float rn = rsqrtf(half_sum(s0 * s0 + s1 * s1) + 1e-6f) * (g < 6 ? 0.125f : 1.f);
    *(unsigned*)((g < 6 ? WSP(bf16_t, OFF_GQ) : WSP(bf16_t, OFF_GK)) + (size_t)row * 384 + h * 64 + c2) = pk2(s0 * rn, s1 * rn);
  } else {
    *(unsigned*)(WSP(bf16_t, OFF_GV) + (size_t)row * 384 + h * 64 + c2) = pk2(s0, s1);
  }
}
__device__ __forceinline__ void gdn_gate_emit(const Params& P, int l, int h, int row) {
  const bf16_t* pr = WSP(bf16_t, OFF_P) + (size_t)row * PSTR;
  const float braw = bf2f(pr[1536 + h]), araw = bf2f(pr[1542 + h]);
  const float gg = -__expf(P.in[I_ALOG][l * 6 + h]) * softplus(araw + P.in[I_DTB][l * 6 + h]);
  WSP(float, OFF_GDEC)[(size_t)row * 8 + h] = __expf(gg);
  WSP(float, OFF_GBETA)[(size_t)row * 8 + h] = sigm(braw);
}
__device__ __forceinline__ void prep_gdn_prompt(const Params& P, int l, int ci) {
  const int lane = otid() & 63, wid = otid() >> 6, hl = lane >> 5, c2 = (lane & 31) * 2;
  const int r0 = ci * 32, b = r0 / TSEQ, t0 = r0 % TSEQ;
  const bf16_t* p = WSP(bf16_t, OFF_P);
  for (int gp = wid; gp < 9; gp += 8) {
    const int g = gp * 2 + hl, col = g * 64 + c2;
    const float* cw = P.in[I_CONVW] + (size_t)l * 4 * 1152 + col;
    const f32x2 w0 = *(const f32x2*)cw, w1 = *(const f32x2*)(cw + 1152), w2 = *(const f32x2*)(cw + 2304), w3 = *(const f32x2*)(cw + 3456);
    unsigned xr[35];
#pragma unroll
    for (int t = 0; t < 35; ++t) xr[t] = (t >= 3 || t0 > 0) ? *(const unsigned*)(p + (size_t)(r0 - 3 + t) * PSTR + col) : 0u;
    f32x2 x3 = {__uint_as_float(xr[0] << 16), __uint_as_float(xr[0] & 0xffff0000u)};
    f32x2 x2 = {__uint_as_float(xr[1] << 16), __uint_as_float(xr[1] & 0xffff0000u)};
    f32x2 x1 = {__uint_as_float(xr[2] << 16), __uint_as_float(xr[2] & 0xffff0000u)};
#pragma unroll
    for (int t = 0; t < 32; ++t) {
      const f32x2 x0 = {__uint_as_float(xr[t + 3] << 16), __uint_as_float(xr[t + 3] & 0xffff0000u)};
      const f32x2 y = w0 * x3 + w1 * x2 + w2 * x1 + w3 * x0;
      gdn_conv_emit2(P, g, c2, r0 + t, silu(y[0]), silu(y[1]));
      x3 = x2; x2 = x1; x1 = x0;
    }
    if (t0 + 32 == TSEQ) {
      float* cp = P.out + O_CONV_P + (size_t)(l * 8 + b) * 3 * 1152 + col;
      *(f32x2*)cp = x3; *(f32x2*)(cp + 1152) = x2; *(f32x2*)(cp + 2304) = x1;
    }
    if (g < 6) gdn_gate_emit(P, l, g, r0 + (lane & 31));
  }
}
__device__ __forceinline__ void prep_gdn_sample(const Params& P, int l, int si) {
  const int lane = otid() & 63, wid = otid() >> 6, hl = lane >> 5, c2 = (lane & 31) * 2;
  const bf16_t* p = WSP(bf16_t, OFF_P);
  for (int u = wid; u < 18; u += 8) {
    const int s = si * 2 + u / 9, g = (u % 9) * 2 + hl, col = g * 64 + c2, row = NTP + s;
    const float* cw = P.in[I_CONVW] + (size_t)l * 4 * 1152 + col;
    const f32x2 w0 = *(const f32x2*)cw, w1 = *(const f32x2*)(cw + 1152), w2 = *(const f32x2*)(cw + 2304), w3 = *(const f32x2*)(cw + 3456);
    const float* cb = P.in[I_SCONV] + (size_t)(l * 128 + s) * 3 * 1152 + col;
    const f32x2 x3 = *(const f32x2*)cb, x2 = *(const f32x2*)(cb + 1152), x1 = *(const f32x2*)(cb + 2304);
    const unsigned xw = *(const unsigned*)(p + (size_t)row * PSTR + col);
    const f32x2 x0 = {__uint_as_float(xw << 16), __uint_as_float(xw & 0xffff0000u)};
    const f32x2 y = w0 * x3 + w1 * x2 + w2 * x1 + w3 * x0;
    gdn_conv_emit2(P, g, c2, row, silu(y[0]), silu(y[1]));
    float* cp = P.out + O_CONV_S + (size_t)(l * 128 + s) * 3 * 1152 + col;
    *(f32x2*)cp = x2; *(f32x2*)(cp + 1152) = x1; *(f32x2*)(cp + 2304) = x0;
    if (g < 6 && (lane & 31) == 0) gdn_gate_emit(P, l, g, row);
  }
}
__device__ __forceinline__ void prep_hgrn(const Params& P, int l, int ti) {
  const int c2 = (otid() & 127) * 2, tg = otid() >> 7;
  const float oml0 = 1.f - lbval(P, l, c2), oml1 = 1.f - lbval(P, l, c2 + 1);
  const bf16_t* p = WSP(bf16_t, OFF_P);
  bf16_t* hq = WSP(bf16_t, OFF_HQ); bf16_t* hk = WSP(bf16_t, OFF_HK);
  for (int t0 = tg * 16; t0 < tg * 16 + 16; t0 += 8) {
    unsigned q[8], f[8];
#pragma unroll
    for (int i = 0; i < 8; ++i) { const int row = ti * 64 + t0 + i; q[i] = *(const unsigned*)(p + (size_t)row * PSTR + PC + c2); f[i] = *(const unsigned*)(p + (size_t)row * PSTR + PC + 256 + c2); }
#pragma unroll
    for (int i = 0; i < 8; ++i) {
      const int row = ti * 64 + t0 + i;
      const float q0 = __uint_as_float(q[i] << 16), q1 = __uint_as_float(q[i] & 0xffff0000u);
      const float f0 = __uint_as_float(f[i] << 16), f1 = __uint_as_float(f[i] & 0xffff0000u);
      *(unsigned*)(hq + (size_t)row * 256 + c2) = pk2(silu(q0) * 0.125f, silu(q1) * 0.125f);
      *(unsigned*)(hk + (size_t)row * 256 + c2) = pk2(oml0 * sigm(-f0), oml1 * sigm(-f1));
    }
  }
}
template <bool SAMP>
__device__ __forceinline__ f32x4 xs4t(const Params& P, int l, int row, int col0) {
  const bf16_t* p = WSP(bf16_t, OFF_P);
  const f32x4 pv = unpack4(*(const u32x2*)(p + (size_t)row * PSTR + PB + col0));
  f32x4 prev;
  if (SAMP) prev = *(const f32x4*)(P.in[I_SSHIFT] + (size_t)(l * 128 + (row - NTP)) * 1408 + col0);
  else {
    const bool first = (row & (TSEQ - 1)) == 0;
    prev = unpack4(*(const u32x2*)(p + (size_t)(row - (first ? 0 : 1)) * PSTR + PB + col0)) * (first ? 0.f : 1.f);
  }
  const f32x4 mu = *(const f32x4*)(P.in[I_MU] + l * 1408 + col0);
  return pv + (prev - pv) * mu;
}
__device__ __forceinline__ float tanh_fast(float x) { return 1.f - 2.f / (__expf(2.f * x) + 1.f); }

template <int ROWB>
__device__ __forceinline__ void stage_lora(unsigned char* smem, const bf16_t* __restrict__ src) {
  constexpr int CPR = ROWB / 16, NCH = 384 * CPR;
  __syncthreads();
  u32x4 t[NCH / 512];
#pragma unroll
  for (int i = 0; i < NCH / 512; ++i) t[i] = *(const u32x4*)((const unsigned char*)src + (size_t)(otid() + i * 512) * 16);
#pragma unroll
  for (int i = 0; i < NCH / 512; ++i) { const int idx = otid() + i * 512, r = idx / CPR, c = idx - r * CPR; *(u32x4*)(smem + r * (ROWB + 16) + c * 16) = t[i]; }
  __syncthreads();
}
template <int ROWB>
__device__ __forceinline__ void stage_lora_open(unsigned char* smem, const bf16_t* __restrict__ src) {
  constexpr int CPR = ROWB / 16, NCH = 384 * CPR;
  __syncthreads();
  u32x4 t[NCH / 512];
#pragma unroll
  for (int i = 0; i < NCH / 512; ++i) t[i] = *(const u32x4*)((const unsigned char*)src + (size_t)(otid() + i * 512) * 16);
#pragma unroll
  for (int i = 0; i < NCH / 512; ++i) { const int idx = otid() + i * 512, r = idx / CPR, c = idx - r * CPR; *(u32x4*)(smem + r * (ROWB + 16) + c * 16) = t[i]; }
}
constexpr int EXCH_OFF = 110592;
__device__ __forceinline__ unsigned char* exch_slot(unsigned char* smem, int wid, int slot, int lane) { return smem + EXCH_OFF + ((wid * 2 + slot) * 64 + lane) * 16; }
template <bool SAMP>
__device__ __forceinline__ void prep_rwkv_unit(const Params& P, unsigned char* smem, int l, int mt, int hh) {
  const int lane = otid() & 63, fr = lane & 15, fq = lane >> 4, wid = otid() >> 6;
  const int row = mt * 16 + fr, cb = hh * 192;
  const bf16_t* lw = WSP(bf16_t, OFF_LORA);
  const size_t ro = (size_t)row * 384;
  f32x4 acc[12];
  {
    bf16x8 Bf[2][12];
    f32x4 x0 = xs4t<SAMP>(P, l, row, 1152 + hh * 32 + fq * 8), x1 = xs4t<SAMP>(P, l, row, 1152 + hh * 32 + fq * 8 + 4);
    stage_lora_open<128>(smem, lw + W2T);
#pragma unroll
    for (int j = 0; j < 4; ++j) { x0[j] = tanh_fast(x0[j]); x1[j] = tanh_fast(x1[j]); }
    const bf16x8 Am = pack8(x0, x1);
    *(bf16x8*)exch_slot(smem, wid, 0, lane) = Am;
    __syncthreads();
    const bf16x8 Ao = *(const bf16x8*)exch_slot(smem, wid ^ 1, 0, lane);
    bf16x8 Aw[2]; Aw[0] = hh ? Ao : Am; Aw[1] = hh ? Am : Ao;
#pragma unroll
    for (int ks = 0; ks < 2; ++ks)
#pragma unroll
      for (int nf = 0; nf < 12; ++nf) Bf[ks][nf] = *(const bf16x8*)(smem + (cb + nf * 16 + fr) * 144 + ks * 64 + fq * 16);
#pragma unroll
    for (int nf = 0; nf < 12; ++nf) acc[nf] = (f32x4){0.f, 0.f, 0.f, 0.f};
#pragma unroll
    for (int ks = 0; ks < 2; ++ks) {
#pragma unroll
      for (int nf = 0; nf < 12; ++nf) acc[nf] = __builtin_amdgcn_mfma_f32_16x16x32_bf16(Bf[ks][nf], Aw[ks], acc[nf], 0, 0, 0);
    }
    f32x4 w0v[12];
#pragma unroll
    for (int nf = 0; nf < 12; ++nf) w0v[nf] = *(const f32x4*)(P.in[I_W0] + l * 384 + cb + nf * 16 + fq * 4);
#pragma unroll
    for (int nf = 0; nf < 12; ++nf) {
      f32x4 d;
#pragma unroll
      for (int j = 0; j < 4; ++j) {
        const float xx = -(w0v[nf][j] + acc[nf][j]);
        const float sp = xx > 15.f ? xx : __logf(1.f + __expf(xx));
        d[j] = __expf(-__expf(-sp - 0.5f));
      }
      *(f32x4*)(WSP(float, OFF_RW) + ro + cb + nf * 16 + fq * 4) = d;
    }
  }
  {
    bf16x8 Bf[2][12];
    const f32x4 x0 = xs4t<SAMP>(P, l, row, 1216 + hh * 32 + fq * 8), x1 = xs4t<SAMP>(P, l, row, 1216 + hh * 32 + fq * 8 + 4);
    stage_lora_open<128>(smem, lw + A2T);
    const bf16x8 Am = pack8(x0, x1);
    *(bf16x8*)exch_slot(smem, wid, 0, lane) = Am;
    __syncthreads();
    const bf16x8 Ao = *(const bf16x8*)exch_slot(smem, wid ^ 1, 0, lane);
    bf16x8 Aw[2]; Aw[0] = hh ? Ao : Am; Aw[1] = hh ? Am : Ao;
#pragma unroll
    for (int ks = 0; ks < 2; ++ks)
#pragma unroll
      for (int nf = 0; nf < 12; ++nf) Bf[ks][nf] = *(const bf16x8*)(smem + (cb + nf * 16 + fr) * 144 + ks * 64 + fq * 16);
#pragma unroll
    for (int nf = 0; nf < 12; ++nf) acc[nf] = (f32x4){0.f, 0.f, 0.f, 0.f};
#pragma unroll
    for (int ks = 0; ks < 2; ++ks) {
#pragma unroll
      for (int nf = 0; nf < 12; ++nf) acc[nf] = __builtin_amdgcn_mfma_f32_16x16x32_bf16(Bf[ks][nf], Aw[ks], acc[nf], 0, 0, 0);
    }
  }
#pragma unroll
  for (int hl = 0; hl < 3; ++hl) {
    f32x4 kr[4], rr[4], kkw[4], a0[4], ka[4];
#pragma unroll
    for (int q = 0; q < 4; ++q) {
      const int c = cb + (hl * 4 + q) * 16 + fq * 4;
      kr[q] = xs4t<SAMP>(P, l, row, 384 + c); rr[q] = xs4t<SAMP>(P, l, row, c);
      kkw[q] = *(const f32x4*)(P.in[I_KK] + l * 384 + c); a0[q] = *(const f32x4*)(P.in[I_A0] + l * 384 + c); ka[q] = *(const f32x4*)(P.in[I_KA] + l * 384 + c);
    }
    float ss = 0.f;
#pragma unroll
    for (int q = 0; q < 4; ++q) { kkw[q] = kr[q] * kkw[q]; ss += dot4(kkw[q], kkw[q]); }
    ss += __shfl_xor(ss, 16); ss += __shfl_xor(ss, 32);
    const float rn = rsqrtf(ss + 1e-6f);
#pragma unroll
    for (int q = 0; q < 4; ++q) {
      const int nf = hl * 4 + q, c = cb + nf * 16 + fq * 4;
      f32x4 kn, kk, kb;
#pragma unroll
      for (int j = 0; j < 4; ++j) {
        const float a = sigm(a0[q][j] + acc[nf][j]);
        kk[j] = kkw[q][j] * rn; kb[j] = kk[j] * a; kn[j] = kr[q][j] * (1.f + (a - 1.f) * ka[q][j]);
      }
      *(u32x2*)(WSP(bf16_t, OFF_RK) + ro + c) = pack4(kn);
      *(u32x2*)(WSP(bf16_t, OFF_RKK) + ro + c) = pack4(kk);
      *(u32x2*)(WSP(bf16_t, OFF_RB) + ro + c) = pack4(kb);
      *(u32x2*)(WSP(bf16_t, OFF_RR) + ro + c) = pack4(rr[q]);
    }
  }
  {
    f32x4 x[2][2];
#pragma unroll
    for (int k2 = 0; k2 < 2; ++k2) { x[k2][0] = xs4t<SAMP>(P, l, row, 1280 + (hh * 2 + k2) * 32 + fq * 8); x[k2][1] = xs4t<SAMP>(P, l, row, 1280 + (hh * 2 + k2) * 32 + fq * 8 + 4); }
    stage_lora_open<256>(smem, lw + G2T);
    bf16x8 Am[2], Ao[2];
#pragma unroll
    for (int k2 = 0; k2 < 2; ++k2) {
#pragma unroll
      for (int j = 0; j < 4; ++j) { x[k2][0][j] = sigm(x[k2][0][j]); x[k2][1][j] = sigm(x[k2][1][j]); }
      Am[k2] = pack8(x[k2][0], x[k2][1]);
      *(bf16x8*)exch_slot(smem, wid, k2, lane) = Am[k2];
    }
    __syncthreads();
#pragma unroll
    for (int k2 = 0; k2 < 2; ++k2) Ao[k2] = *(const bf16x8*)exch_slot(smem, wid ^ 1, k2, lane);
    bf16x8 A[4];
    A[0] = hh ? Ao[0] : Am[0]; A[1] = hh ? Ao[1] : Am[1]; A[2] = hh ? Am[0] : Ao[0]; A[3] = hh ? Am[1] : Ao[1];
#pragma unroll
    for (int hf = 0; hf < 2; ++hf) {
      bf16x8 Bf[4][6];
#pragma unroll
      for (int ks = 0; ks < 4; ++ks)
#pragma unroll
        for (int n6 = 0; n6 < 6; ++n6) Bf[ks][n6] = *(const bf16x8*)(smem + (cb + (hf * 6 + n6) * 16 + fr) * 272 + ks * 64 + fq * 16);
#pragma unroll
      for (int n6 = 0; n6 < 6; ++n6) {
        f32x4 g = (f32x4){0.f, 0.f, 0.f, 0.f};
#pragma unroll
        for (int ks = 0; ks < 4; ++ks) g = __builtin_amdgcn_mfma_f32_16x16x32_bf16(Bf[ks][n6], A[ks], g, 0, 0, 0);
        *(u32x2*)(WSP(bf16_t, OFF_RG) + ro + cb + (hf * 6 + n6) * 16 + fq * 4) = pack4(g);
      }
    }
  }
  if (l == 0) {
    f32x4 v[12];
#pragma unroll
    for (int nf = 0; nf < 12; ++nf) v[nf] = xs4t<SAMP>(P, l, row, 768 + cb + nf * 16 + fq * 4);
#pragma unroll
    for (int nf = 0; nf < 12; ++nf) {
      const int c = cb + nf * 16 + fq * 4;
      const u32x2 o = pack4(v[nf]);
      *(u32x2*)(WSP(bf16_t, OFF_RV) + ro + c) = o;
      *(u32x2*)(WSP(bf16_t, OFF_VF) + ro + c) = o;
    }
  } else {
    f32x4 lo0 = (f32x4){0.f, 0.f, 0.f, 0.f}, lo1 = lo0;
    {
      const int hf = hh;
      f32x4 x[6][2]; bf16x8 B0[6], B1[6];
#pragma unroll
      for (int k6 = 0; k6 < 6; ++k6) {
        const int ks = hf * 6 + k6;
        x[k6][0] = xs4t<SAMP>(P, l, row, 768 + ks * 32 + fq * 8); x[k6][1] = xs4t<SAMP>(P, l, row, 768 + ks * 32 + fq * 8 + 4);
        B0[k6] = *(const bf16x8*)(lw + V1T + fr * 384 + ks * 32 + fq * 8);
        B1[k6] = *(const bf16x8*)(lw + V1T + (16 + fr) * 384 + ks * 32 + fq * 8);
      }
#pragma unroll
      for (int k6 = 0; k6 < 6; ++k6) {
        const bf16x8 A = pack8(x[k6][0], x[k6][1]);
        lo0 = __builtin_amdgcn_mfma_f32_16x16x32_bf16(B0[k6], A, lo0, 0, 0, 0);
        lo1 = __builtin_amdgcn_mfma_f32_16x16x32_bf16(B1[k6], A, lo1, 0, 0, 0);
      }
    }
    __syncthreads();
    *(f32x4*)exch_slot(smem, wid, 0, lane) = lo0; *(f32x4*)exch_slot(smem, wid, 1, lane) = lo1;
    __syncthreads();
    lo0 += *(const f32x4*)exch_slot(smem, wid ^ 1, 0, lane); lo1 += *(const f32x4*)exch_slot(smem, wid ^ 1, 1, lane);
    const bf16x8 A2 = pack8(lo0, lo1);
#pragma unroll
    for (int hf = 0; hf < 2; ++hf) {
      u32x4 bw[6]; f32x4 v0[6], v[6]; u32x2 vf[6];
#pragma unroll
      for (int n6 = 0; n6 < 6; ++n6) {
        const int nf = hf * 6 + n6, c = cb + nf * 16 + fq * 4;
        const bf16_t* vr = lw + V2T + (cb + nf * 16 + fr) * 32;
        const u32x2 b0 = *(const u32x2*)(vr + fq * 4), b1 = *(const u32x2*)(vr + 16 + fq * 4);
        bw[n6][0] = b0[0]; bw[n6][1] = b0[1]; bw[n6][2] = b1[0]; bw[n6][3] = b1[1];
        v0[n6] = *(const f32x4*)(P.in[I_V0] + (l - 1) * 384 + c);
        v[n6] = xs4t<SAMP>(P, l, row, 768 + c);
        vf[n6] = *(const u32x2*)(WSP(bf16_t, OFF_VF) + ro + c);
      }
#pragma unroll
      for (int n6 = 0; n6 < 6; ++n6) {
        const int c = cb + (hf * 6 + n6) * 16 + fq * 4;
        const f32x4 mv = __builtin_amdgcn_mfma_f32_16x16x32_bf16(__builtin_bit_cast(bf16x8, bw[n6]), A2, (f32x4){0.f, 0.f, 0.f, 0.f}, 0, 0, 0);
        const f32x4 vfv = unpack4(vf[n6]);
        f32x4 o;
#pragma unroll
        for (int j = 0; j < 4; ++j) o[j] = v[n6][j] + (vfv[j] - v[n6][j]) * sigm(v0[n6][j] + mv[j]);
        *(u32x2*)(WSP(bf16_t, OFF_RV) + ro + c) = pack4(o);
      }
    }
  }
}
__device__ __forceinline__ void prep_phase(const Params& P, unsigned char* smem, int l, volatile unsigned* blk  ) {
  unsigned* q = WSP(unsigned, OFF_QUEUE) + l * 128 + 80;
  for (;;) {
    __syncthreads();
    if (threadIdx.x == 0) blk[3] = __hip_atomic_fetch_add(q, 1u, __ATOMIC_RELAXED, __HIP_MEMORY_SCOPE_AGENT);
    __syncthreads();
    const int it = (int)blk[3];
    if (it >= 1090) break;
    if (it < 256) { const int wid = otid() >> 6; prep_rwkv_unit<false>(P, smem, l, it * 4 + (wid >> 1), wid & 1); }
    else if (it < 768) prep_gdn_prompt(P, l, it - 256);
    else if (it < 832) prep_gdn_sample(P, l, it - 768);
    else prep_hgrn(P, l, it - 832);
  }
  const bf16_t* p = WSP(bf16_t, OFF_P);
  for (int idx = obid() * 512 + otid(); idx < 136 * 1408; idx += gridDim.x * 512) {
    const int q = idx / 1408, col = idx - q * 1408;
    if (q < 8) P.out[O_SHIFT_P + (size_t)(l * 8 + q) * 1408 + col] = bf2f(p[(size_t)(q * TSEQ + TSEQ - 1) * PSTR + PB + col]);
    else P.out[O_SHIFT_S + (size_t)(l * 128 + (q - 8)) * 1408 + col] = bf2f(p[(size_t)(NTP + q - 8) * PSTR + PB + col]);
  }
}

template <int KIND> struct ScanCfg { static constexpr int STRIDE = KIND == 1 ? 356 : 164; };

template <int KIND> struct ScanPre { u32x2 a, b, c, d, v; f32x4 w; float g; };

template <int KIND>
__device__ __forceinline__ void scan_load(const Params& P, ScanPre<KIND>& r, int tid, int h, int half, int rowbase, int nvalid) {
  const int s = tid >> 4, j4 = (tid & 15) * 4;
  const int s2 = (tid >> 3) & 15, j2 = (tid & 7) * 4;
  const u32x2 z2 = {0u, 0u};
  const bool ok = s < nvalid, ok2 = (tid < 128) && (s2 < nvalid);
  if (KIND == 0) {
    const size_t o = (size_t)(rowbase + s) * 384 + h * 64 + j4;
    r.a = ok ? *(const u32x2*)(WSP(bf16_t, OFF_GK) + o) : z2;
    r.b = ok ? *(const u32x2*)(WSP(bf16_t, OFF_GQ) + o) : z2;
    r.v = ok2 ? *(const u32x2*)(WSP(bf16_t, OFF_GV) + (size_t)(rowbase + s2) * 384 + h * 64 + half * 32 + j2) : z2;
    const int sg = (tid >> 1) & 15;
    r.g = (tid < 32 && sg < nvalid) ? ((tid & 1) ? WSP(float, OFF_GBETA) : WSP(float, OFF_GDEC))[(size_t)(rowbase + sg) * 8 + h] : 0.f;
  } else if (KIND == 1) {
    const size_t o = (size_t)(rowbase + s) * 384 + h * 64 + j4;
    r.a = ok ? *(const u32x2*)(WSP(bf16_t, OFF_RR) + o) : z2;
    r.w = ok ? *(const f32x4*)(WSP(float, OFF_RW) + o) : (f32x4){0.f, 0.f, 0.f, 0.f};
    r.b = ok ? *(const u32x2*)(WSP(bf16_t, OFF_RK) + o) : z2;
    r.c = ok ? *(const u32x2*)(WSP(bf16_t, OFF_RKK) + o) : z2;
    r.d = ok ? *(const u32x2*)(WSP(bf16_t, OFF_RB) + o) : z2;
    r.v = ok2 ? *(const u32x2*)(WSP(bf16_t, OFF_RV) + (size_t)(rowbase + s2) * 384 + h * 64 + half * 32 + j2) : z2;
  } else {
    const size_t o = (size_t)(rowbase + s) * 256 + h * 64 + j4;
    r.a = ok ? *(const u32x2*)(WSP(bf16_t, OFF_HQ) + o) : z2;
    r.b = ok ? *(const u32x2*)(WSP(bf16_t, OFF_HK) + o) : z2;
    r.v = ok2 ? *(const u32x2*)(WSP(bf16_t, OFF_P) + (size_t)(rowbase + s2) * PSTR + PC + 512 + h * 64 + half * 32 + j2) : z2;
  }
}
template <int KIND>
__device__ __forceinline__ void scan_store(const ScanPre<KIND>& r, int tid, float* buf) {
  constexpr int STRIDE = ScanCfg<KIND>::STRIDE;
  const int s = tid >> 4, j4 = (tid & 15) * 4;
  const int s2 = (tid >> 3) & 15, j2 = (tid & 7) * 4;
  float* bs = buf + s * STRIDE + j4;
  if (KIND == 0) {
    const f32x4 k = unpack4(r.a), q = unpack4(r.b);
    *(f32x4*)(bs) = k; *(f32x4*)(bs + 64) = q;
    const float qk = row_sum16(dot4(q, k));
    if ((tid & 15) == 0) buf[s * STRIDE + 162] = qk;
    if (tid < 128) *(f32x4*)(buf + s2 * STRIDE + 128 + j2) = unpack4(r.v);
    if (tid < 32) buf[((tid >> 1) & 15) * STRIDE + 160 + (tid & 1)] = r.g;
  } else if (KIND == 1) {
    const f32x4 rr = unpack4(r.a), k = unpack4(r.b), kk = unpack4(r.c), bb = unpack4(r.d);
    *(f32x4*)(bs) = r.w * rr; *(f32x4*)(bs + 64) = r.w; *(f32x4*)(bs + 128) = k;
    *(f32x4*)(bs + 192) = kk; *(f32x4*)(bs + 256) = bb;
    const float br = row_sum16(dot4(bb, rr)), kr = row_sum16(dot4(k, rr));
    if ((tid & 15) == 0) { buf[s * STRIDE + 352] = br; buf[s * STRIDE + 353] = kr; }
    if (tid < 128) *(f32x4*)(buf + s2 * STRIDE + 320 + j2) = unpack4(r.v);
  } else {
    const f32x4 q = unpack4(r.a), k = unpack4(r.b);
    *(f32x4*)(bs) = q * (1.f - k); *(f32x4*)(bs + 64) = k;
    const float qk = row_sum16(dot4(q, k));
    if ((tid & 15) == 0) buf[s * STRIDE + 160] = qk;
    if (tid < 128) *(f32x4*)(buf + s2 * STRIDE + 128 + j2) = unpack4(r.v);
  }
}

template <int KIND> struct StepOps { f32x2 a[4], b[4], c[4], d[4], e[4]; float v, s0, s1, s2; };
template <int KIND>
__device__ __forceinline__ void step_load(StepOps<KIND>& o, const float* bs, int e0, int cl) {
#define LD8(dst, off) { const f32x4 _x = *(const f32x4*)(bs + (off) + e0), _y = *(const f32x4*)(bs + (off) + e0 + 4); \
    dst[0] = (f32x2){_x[0], _x[1]}; dst[1] = (f32x2){_x[2], _x[3]}; dst[2] = (f32x2){_y[0], _y[1]}; dst[3] = (f32x2){_y[2], _y[3]}; }
  if (KIND == 0) {
    LD8(o.a, 0) LD8(o.b, 64)
    o.v = bs[128 + cl];
    const f32x4 sc = *(const f32x4*)(bs + 160); o.s0 = sc[0]; o.s1 = sc[1]; o.s2 = sc[2];
  } else if (KIND == 1) {
    LD8(o.a, 0) LD8(o.b, 64) LD8(o.c, 128) LD8(o.d, 192) LD8(o.e, 256)
    o.v = bs[320 + cl];
    const f32x2 sc = *(const f32x2*)(bs + 352); o.s0 = sc[0]; o.s1 = sc[1];
  } else {
    LD8(o.a, 0) LD8(o.b, 64)
    o.v = bs[128 + cl]; o.s0 = bs[160];
  }
#undef LD8
}
template <int KIND>
__device__ __forceinline__ float step_compute(const StepOps<KIND>& o, f32x2 (&S)[4]) {
  if (KIND == 0) {
    f32x2 ks2 = o.a[0] * S[0], qs2 = o.b[0] * S[0];
#pragma unroll
    for (int i = 1; i < 4; ++i) { ks2 += o.a[i] * S[i]; qs2 += o.b[i] * S[i]; }
    float ks = ks2[0] + ks2[1], qs = qs2[0] + qs2[1];
    ks += dppf<0xB1>(ks); qs += dppf<0xB1>(qs); ks += dppf<0x4E>(ks); qs += dppf<0x4E>(qs); ks += dppf<0x141>(ks); qs += dppf<0x141>(qs);
    const float dec = o.s0, vn = o.s1 * (o.v - dec * ks);
#pragma unroll
    for (int i = 0; i < 4; ++i) S[i] = S[i] * dec + o.a[i] * vn;
    return dec * qs + vn * o.s2;
  } else if (KIND == 1) {
    f32x2 sa2 = o.d[0] * S[0], p2 = o.a[0] * S[0];
#pragma unroll
    for (int i = 1; i < 4; ++i) { sa2 += o.d[i] * S[i]; p2 += o.a[i] * S[i]; }
    float sa = sa2[0] + sa2[1], p1 = p2[0] + p2[1];
    sa += dppf<0xB1>(sa); p1 += dppf<0xB1>(p1); sa += dppf<0x4E>(sa); p1 += dppf<0x4E>(p1); sa += dppf<0x141>(sa); p1 += dppf<0x141>(p1);
    sa = -sa;
#pragma unroll
    for (int i = 0; i < 4; ++i) S[i] = S[i] * o.b[i] + (o.e[i] * sa + o.c[i] * o.v);
    return p1 + sa * o.s0 + o.v * o.s1;
  } else {
    f32x2 p2 = o.a[0] * S[0];
#pragma unroll
    for (int i = 1; i < 4; ++i) p2 += o.a[i] * S[i];
    float p1 = p2[0] + p2[1];
    p1 += dppf<0xB1>(p1); p1 += dppf<0x4E>(p1); p1 += dppf<0x141>(p1);
#pragma unroll
    for (int i = 0; i < 4; ++i) S[i] = S[i] + o.b[i] * (o.v - S[i]);
    return p1 + o.v * o.s0;
  }
}

template <int KIND>
__device__ __forceinline__ void scan_task(const Params& P, unsigned char* smem, int l, int seq, int h, int half, int mode) {
  constexpr int STRIDE = ScanCfg<KIND>::STRIDE, NEL = 16 * STRIDE;
  constexpr int NH = KIND == 2 ? 4 : 6;
  float* buf = (float*)smem;
  float* obuf = buf + 2 * NEL;
  const bool do_comp = mode != 2, do_stage = mode != 1;
  const int tid = otid() & 255, lane = tid & 63, wid = tid >> 6;
  const int col_l = lane >> 3, sub = lane & 7, cl = wid * 8 + col_l, col = half * 32 + cl, e0 = sub * 8;
  const bool sample = seq >= 8;
  const int R0 = sample ? NTP + (seq - 8) : seq * TSEQ, T = sample ? 1 : TSEQ;
  const int ocol = (KIND == 0 ? 0 : (KIND == 1 ? 384 : 768)) + h * 64 + half * 32;
  const size_t O_P = KIND == 0 ? O_GDN_P : (KIND == 1 ? O_RWKV_P : O_HGRN_P);
  const size_t O_S = KIND == 0 ? O_GDN_S : (KIND == 1 ? O_RWKV_S : O_HGRN_S);
  const int I_ST = KIND == 0 ? I_SGDN : (KIND == 1 ? I_SRWKV : I_SHGRN);
  const int nchunks = (T + 15) >> 4;
  bf16_t* oraw = WSP(bf16_t, OFF_P);
  f32x2 S[4];
#pragma unroll
  for (int i = 0; i < 4; ++i) S[i] = (f32x2){0.f, 0.f};
  if (sample && do_comp) {
    const float* st = P.in[I_ST] + ((size_t)(l * 128 + (seq - 8)) * NH + h) * 4096;
#pragma unroll
    for (int i = 0; i < 8; ++i) S[i >> 1][i & 1] = KIND == 1 ? st[col * 64 + e0 + i] : st[(e0 + i) * 64 + col];
  }
#pragma unroll
  for (int i = 0; i < 4; ++i) asm volatile("" : "+v"(S[i]));
  ScanPre<KIND> pre;
  __syncthreads();
  if (do_stage) {
    scan_load<KIND>(P, pre, tid, h, half, R0, T); scan_store<KIND>(pre, tid, buf);
    if (nchunks > 1) scan_load<KIND>(P, pre, tid, h, half, R0 + 16, T - 16);
  }
  __syncthreads();
  for (int c = 0; c < nchunks; ++c) {
    const int t0 = c * 16, n = (T - t0) < 16 ? (T - t0) : 16;
    if (do_stage) {
      if (c + 1 < nchunks) scan_store<KIND>(pre, tid, buf + ((c + 1) & 1) * NEL);
      if (c > 0) {
        const float* pob = obuf + ((c - 1) & 1) * 512;
        const int s = tid >> 4, cc = (tid & 15) * 2;
        const f32x2 ov = *(const f32x2*)(pob + s * 32 + cc);
        *(unsigned*)(oraw + (size_t)(R0 + t0 - 16 + s) * PSTR + ocol + cc) = pk2(ov[0], ov[1]);
      }
      if (c + 2 < nchunks) scan_load<KIND>(P, pre, tid, h, half, R0 + t0 + 32, T - t0 - 32);
    }
    if (do_comp) {
      const float* b = buf + (c & 1) * NEL;
      float* ob = obuf + (c & 1) * 512;
      if (n == 16) {
        StepOps<KIND> A, B;
        step_load<KIND>(A, b, e0, cl);
#pragma unroll
        for (int s = 0; s < 16; s += 2) {
          step_load<KIND>(B, b + (s + 1) * STRIDE, e0, cl);
          const float o0 = step_compute<KIND>(A, S);
          ob[s * 32 + cl] = o0;
          step_load<KIND>(A, b + (s + 2 < 16 ? s + 2 : 15) * STRIDE, e0, cl);
          const float o1 = step_compute<KIND>(B, S);
          ob[(s + 1) * 32 + cl] = o1;
        }
      } else {
        for (int s = 0; s < n; ++s) {
          StepOps<KIND> A;
          step_load<KIND>(A, b + s * STRIDE, e0, cl);
          const float o0 = step_compute<KIND>(A, S);
          ob[s * 32 + cl] = o0;
        }
      }
    }
    __syncthreads();
  }
  if (do_stage) {
    const int c = nchunks - 1, t0 = c * 16, n = T - t0;
    const float* pob = obuf + (c & 1) * 512;
    const int s = tid >> 4, cc = (tid & 15) * 2;
    const f32x2 ov = *(const f32x2*)(pob + s * 32 + cc);
    if (s < n) *(unsigned*)(oraw + (size_t)(R0 + t0 + s) * PSTR + ocol + cc) = pk2(ov[0], ov[1]);
  }
  if (do_comp) {
    float* so = P.out + (sample ? O_S + ((size_t)(l * 128 + (seq - 8)) * NH + h) * 4096 : O_P + ((size_t)(l * 8 + seq) * NH + h) * 4096);
#pragma unroll
    for (int i = 0; i < 8; ++i) { if (KIND == 1) so[col * 64 + e0 + i] = S[i >> 1][i & 1]; else so[(e0 + i) * 64 + col] = S[i >> 1][i & 1]; }
  }
}

__device__ __forceinline__ void scan_phase(const Params& P, unsigned char* smem, int l, volatile unsigned* blk  ) {
  unsigned* q = WSP(unsigned, OFF_QUEUE) + l * 128;
  const int grp = otid() >> 8;
  for (int pass = 0; pass < 2; ++pass) {
    unsigned* qq = pass == 1 ? q + 64 : q;
    const unsigned ntask = pass == 1 ? 2050u : 256u;
    for (;;) {
      __syncthreads();
      if (threadIdx.x == 0) blk[3] = __hip_atomic_fetch_add(qq, 1u, __ATOMIC_RELAXED, __HIP_MEMORY_SCOPE_AGENT);
      __syncthreads();
      const int t = (int)blk[3];
      if (t >= (int)ntask) break;
      int kind, seq, h, half, act; unsigned char* sm;
      if (pass == 0) {
        act = grp == 0 ? 1 : 2; sm = smem; half = t & 1;
        if (t < 96) { kind = 1; const int bh = t >> 1; seq = bh / 6; h = bh % 6; }
        else if (t < 192) { kind = 0; const int bh = (t - 96) >> 1; seq = bh / 6; h = bh % 6; }
        else { kind = 2; const int bh = (t - 192) >> 1; seq = bh / 4; h = bh % 4; }
      } else if (t < 2) {
        { const int wid = otid() >> 6; prep_rwkv_unit<true>(P, smem, l, (256 + t) * 4 + (wid >> 1), wid & 1); }
        asm volatile("s_waitcnt vmcnt(0)" ::: "memory");
        __syncthreads();
        if (threadIdx.x == 0) {
          __builtin_amdgcn_fence(__ATOMIC_RELEASE, "agent");
          asm volatile("s_waitcnt vmcnt(0)" ::: "memory");
          __hip_atomic_fetch_add(q + 88, 1u, __ATOMIC_RELAXED, __HIP_MEMORY_SCOPE_AGENT);
        }
        continue;
      } else {
        const int st = t - 2;
        act = 0; sm = smem + grp * 51200; half = grp;
        if (st < 1280) { const int s = st / 10, j = st - s * 10; seq = 8 + s; if (j < 6) { kind = 0; h = j; } else { kind = 2; h = j - 6; } }
        else {
          const int x = st - 1280, s = x / 6; seq = 8 + s; kind = 1; h = x - s * 6;
          if (threadIdx.x == 0) {
            unsigned sp = 0;
            while (__hip_atomic_load(q + 88, __ATOMIC_RELAXED, __HIP_MEMORY_SCOPE_AGENT) < 2u && ++sp < (1u << 22)) __builtin_amdgcn_s_sleep(2);
            __builtin_amdgcn_fence(__ATOMIC_ACQUIRE, "agent");
            asm volatile("s_waitcnt vmcnt(0)" ::: "memory");
          }
          __syncthreads();
        }
      }
      if (kind == 0) scan_task<0>(P, sm, l, seq, h, half, act);
      else if (kind == 1) scan_task<1>(P, sm, l, seq, h, half, act);
      else scan_task<2>(P, sm, l, seq, h, half, act);
    }
  }
  if (l + 1 < NLAYER) {
    for (;;) {
      __syncthreads();
      if (threadIdx.x == 0) blk[3] = __hip_atomic_fetch_add(q + 96, 1u, __ATOMIC_RELAXED, __HIP_MEMORY_SCOPE_AGENT);
      __syncthreads();
      const unsigned t = blk[3];
      if (t >= (unsigned)WCONV_JOBS) break;
      wconv_job(P, smem, l + 1, (int)t);
    }
  }
  if (l == 0) {
    for (;;) {
      __syncthreads();
      if (threadIdx.x == 0) blk[3] = __hip_atomic_fetch_add(q + 112, 1u, __ATOMIC_RELAXED, __HIP_MEMORY_SCOPE_AGENT);
      __syncthreads();
      const unsigned t = blk[3];
      if (t >= 2368u) break;
      wconv_job(P, smem, 0, 1024 + (int)t);
    }
  }
}

__device__ __forceinline__ void post_phase(const Params& P, int l) {
  const int lane = otid() & 63, wid = otid() >> 6, hl = lane >> 5, c2 = (lane & 31) * 2;
  const bf16_t* p = WSP(bf16_t, OFF_P);
  bf16_t* act = WSP(bf16_t, OFF_ACT);
  const int gw = obid() * 8 + wid, nw = gridDim.x * 8;
  const f32x2 gnw = *(const f32x2*)(P.in[I_GNW] + l * 64 + c2), hnw = *(const f32x2*)(P.in[I_HNW] + l * 64 + c2);
  for (int u0 = gw * 8; u0 < NTOK * 10; u0 += nw * 8) {
    unsigned o[4], z[4]; int oc[4]; size_t rb[4];
#pragma unroll
    for (int k = 0; k < 4; ++k) {
      const int u = u0 + 2 * k + hl, row = u / 10, q = u - row * 10;
      oc[k] = q < 6 ? q * 64 : 768 + (q - 6) * 64;
      const int zc = q < 6 ? 1152 + q * 64 : PC + 768 + (q - 6) * 64;
      rb[k] = (size_t)row;
      o[k] = *(const unsigned*)(p + (size_t)row * PSTR + oc[k] + c2);
      z[k] = *(const unsigned*)(p + (size_t)row * PSTR + zc + c2);
    }
#pragma unroll
    for (int k = 0; k < 4; ++k) {
      const float o0 = __uint_as_float(o[k] << 16), o1 = __uint_as_float(o[k] & 0xffff0000u);
      const float z0 = __uint_as_float(z[k] << 16), z1 = __uint_as_float(z[k] & 0xffff0000u);
      const float rn = rsqrtf(half_sum(o0 * o0 + o1 * o1) * (1.f / 64.f) + 1e-6f);
      const f32x2 w = oc[k] < 384 ? gnw : hnw;
      *(unsigned*)(act + rb[k] * 1024 + oc[k] + c2) = pk2(o0 * rn * w[0] * silu(z0), o1 * rn * w[1] * silu(z1));
    }
  }
  for (int u0 = gw * 4; u0 < NTOK * 6; u0 += nw * 4) {
    unsigned o[2], r[2], kx[2], v[2], g[2]; int hh[2]; size_t rb[2];
#pragma unroll
    for (int k = 0; k < 2; ++k) {
      const int u = u0 + 2 * k + hl, row = u / 6, h = u - row * 6;
      const size_t idx = (size_t)row * 384 + h * 64 + c2;
      hh[k] = h; rb[k] = (size_t)row;
      o[k] = *(const unsigned*)(p + (size_t)row * PSTR + 384 + h * 64 + c2);
      r[k] = *(const unsigned*)(WSP(bf16_t, OFF_RR) + idx); kx[k] = *(const unsigned*)(WSP(bf16_t, OFF_RK) + idx);
      v[k] = *(const unsigned*)(WSP(bf16_t, OFF_RV) + idx); g[k] = *(const unsigned*)(WSP(bf16_t, OFF_RG) + idx);
    }
#pragma unroll
    for (int k = 0; k < 2; ++k) {
      const int hc = l * 384 + hh[k] * 64 + c2;
      const f32x2 lw = *(const f32x2*)(P.in[I_LNW] + hc), lb = *(const f32x2*)(P.in[I_LNB] + hc), rkw = *(const f32x2*)(P.in[I_RK] + hc);
      const float o0 = __uint_as_float(o[k] << 16), o1 = __uint_as_float(o[k] & 0xffff0000u);
      const float r0 = __uint_as_float(r[k] << 16), r1 = __uint_as_float(r[k] & 0xffff0000u);
      const float k0 = __uint_as_float(kx[k] << 16), k1 = __uint_as_float(kx[k] & 0xffff0000u);
      const float v0 = __uint_as_float(v[k] << 16), v1 = __uint_as_float(v[k] & 0xffff0000u);
      const float g0 = __uint_as_float(g[k] << 16), g1 = __uint_as_float(g[k] & 0xffff0000u);
      const float mu = half_sum(o0 + o1) * (1.f / 64.f);
      const float y0 = o0 - mu, y1 = o1 - mu;
      const float rn = rsqrtf(half_sum(y0 * y0 + y1 * y1) * (1.f / 64.f) + 64e-5f);
      const float rk = half_sum(r0 * k0 * rkw[0] + r1 * k1 * rkw[1]);
      *(unsigned*)(act + rb[k] * 1024 + 384 + hh[k] * 64 + c2) = pk2((y0 * rn * lw[0] + lb[0] + rk * v0) * g0, (y1 * rn * lw[1] + lb[1] + rk * v1) * g1);
    }
  }
}

#define XB_TMO      128
#define XB_XCNT(j)  (256  + 64 * (j))
#define XB_XSUB(j)  (1280 + 64 * (j))
#define XB_XGEN(j)  (2304 + 64 * (j))
#define XB_TOP      3328
#define XB_TOPGEN   3392
#define XCD_BAR_WORDS 3456
#define XB_SPIN_CAP (1u << 20)
#define LAS __attribute__((address_space(3)))
__device__ __forceinline__ unsigned xb_ld(unsigned* p)              { return __hip_atomic_load(p, __ATOMIC_RELAXED, __HIP_MEMORY_SCOPE_AGENT); }
__device__ __forceinline__ unsigned xb_add(unsigned* p, unsigned v) { return __hip_atomic_fetch_add(p, v, __ATOMIC_RELAXED, __HIP_MEMORY_SCOPE_AGENT); }
__device__ __forceinline__ unsigned xb_xcc_id() { return (unsigned)__builtin_amdgcn_s_getreg((3 << 11) | 20) & 0xFu; }
#define XB_SPIN(cond, bar) do { unsigned _sp = 0; while (cond) { __builtin_amdgcn_s_sleep(1); \
    if ((++_sp & 255u) == 0u) { if (xb_ld(&(bar)[XB_TMO])) break; if (_sp > XB_SPIN_CAP) { atomicAdd(&(bar)[XB_TMO], 1u); break; } } } } while (0)
struct XcdBarrier { unsigned* bar; unsigned x; volatile LAS unsigned* st; };
__device__ __forceinline__ XcdBarrier xcd_barrier_post(unsigned* bar, volatile LAS unsigned* st) {
  XcdBarrier b; b.bar = bar; b.x = xb_xcc_id(); b.st = st;
  if (threadIdx.x == 0) (void)xb_add(&bar[XB_XCNT(b.x)], 1u);
  return b;
}
__device__ __forceinline__ void xcd_barrier_complete(unsigned* bar, unsigned x, unsigned& nloc, unsigned& nx) {
  const unsigned G = gridDim.x * gridDim.y * gridDim.z;
  unsigned sum, cnt, mine, sp = 0u;
  for (;;) {
    sum = 0u; cnt = 0u; mine = 0u;
#pragma unroll
    for (unsigned j = 0; j < 16; ++j) { const unsigned c = xb_ld(&bar[XB_XCNT(j)]); sum += c; cnt += (c > 0u) ? 1u : 0u; mine = (j == x) ? c : mine; }
    if (sum == G) break;
    __builtin_amdgcn_s_sleep(1);
    if ((++sp & 255u) == 0u) { if (xb_ld(&bar[XB_TMO])) break; if (sp > XB_SPIN_CAP) { atomicAdd(&bar[XB_TMO], 1u); break; } }
  }
  nloc = mine > 0u ? mine : 1u; nx = cnt > 0u ? cnt : 1u;
}
__device__ __forceinline__ void xcd_barrier(const XcdBarrier& b) {
  asm volatile("s_waitcnt vmcnt(0)" ::: "memory");
  __syncthreads();
  if (threadIdx.x == 0) {
    unsigned* bar = b.bar;
    __builtin_amdgcn_s_waitcnt(0);
    unsigned nloc = b.st[0], nx = b.st[1];
    if (nloc == 0u) { xcd_barrier_complete(bar, b.x, nloc, nx); b.st[0] = nloc; b.st[1] = nx; }
    const unsigned old = xb_add(&bar[XB_XSUB(b.x)], 1u);
    const unsigned gen = old / nloc;
    if (old + 1u == (gen + 1u) * nloc) {
      __builtin_amdgcn_fence(__ATOMIC_RELEASE, "agent");
      asm volatile("s_waitcnt vmcnt(0)" ::: "memory");
      const unsigned og = xb_add(&bar[XB_TOP], 1u);
      const unsigned tg = og / nx;
      if (og + 1u == (tg + 1u) * nx) xb_add(&bar[XB_TOPGEN], 1u);
      else XB_SPIN(xb_ld(&bar[XB_TOPGEN]) == tg, bar);
      __builtin_amdgcn_fence(__ATOMIC_ACQUIRE, "agent");
      xb_add(&bar[XB_XGEN(b.x)], 1u);
      asm volatile("s_waitcnt vmcnt(0)" ::: "memory");
    } else {
      XB_SPIN(xb_ld(&bar[XB_XGEN(b.x)]) == gen, bar);
      __builtin_amdgcn_fence(__ATOMIC_ACQUIRE, "agent");
      asm volatile("s_waitcnt vmcnt(0)" ::: "memory");
    }
  }
  __syncthreads();
}

__global__ void __launch_bounds__(512, 2) hybrid_fwd(Params P) {
  cg::grid_group grid = cg::this_grid();
  __shared__ __attribute__((aligned(16))) unsigned char smem[131072 + 64];
  uint4& xb_words = *(uint4*)(smem + 131072);
  if (threadIdx.x == 0) xb_words = make_uint4(0u, 0u, 0u, 0u);
  __syncthreads();
  const XcdBarrier xb = xcd_barrier_post(WSP(unsigned, OFF_BAR), (volatile LAS unsigned*)&xb_words);
  if (threadIdx.x == 0) {
    const unsigned hw = (unsigned)__builtin_amdgcn_s_getreg((7 << 11) | (8 << 6) | 4) & 0xffu;
    const unsigned key = (xb.x << 8) | hw;
    ((volatile unsigned*)&xb_words)[2] = __hip_atomic_fetch_add(WSP(unsigned, OFF_CUTAB) + key, 1u, __ATOMIC_RELAXED, __HIP_MEMORY_SCOPE_AGENT);
  }
  __syncthreads();
#pragma unroll 1
  for (int step = 0; step < NLAYER * 9; ++step) {
    const int l = step / 9, ph = step - l * 9;
    switch (ph) {
      case 0: if (l == 0) wconv_phase(P, smem, 0); norm_phase(P, l, P.in[I_NORM_MIX] + l * D); break;
      case 1: gemm_phase<EPI_P>(P, smem, WSP(bf16_t, OFF_ACT), 1024, WSP(bf16_t, OFF_WTIN), 1024, 32, l, 4096);
              gemm_sample<EPI_P>(P, smem, WSP(bf16_t, OFF_ACT), 1024, WSP(bf16_t, OFF_WTIN), 1024, 249, l); break;
      case 2: prep_phase(P, smem, l, (volatile unsigned*)&xb_words); break;
      case 3: scan_phase(P, smem, l, (volatile unsigned*)&xb_words); break;
      case 4: post_phase(P, l); break;
      case 5: gemm_phase<EPI_RES>(P, smem, WSP(bf16_t, OFF_ACT), 1024, WSP(bf16_t, wt_out_off(l)), 1024, 8, l, 1024);
              gemm_sample<EPI_RES>(P, smem, WSP(bf16_t, OFF_ACT), 1024, WSP(bf16_t, wt_out_off(l)), 1024, 64, l); break;
      case 6: norm_phase(P, 1, P.in[I_NORM_FFN] + l * D); break;
      case 7: gemm_phase<EPI_SWIGLU>(P, smem, WSP(bf16_t, OFF_ACT), 1024, WSP(bf16_t, wt_gu_off(l)), 1024, 44, 1, 5632);
              gemm_sample<EPI_SWIGLU>(P, smem, WSP(bf16_t, OFF_ACT), 1024, WSP(bf16_t, wt_gu_off(l)), 1024, 176, 1); break;
      default: gemm_phase<EPI_RES>(P, smem, WSP(bf16_t, OFF_P), DFF, WSP(bf16_t, wt_dn_off(l)), DFF, 8, 1, 1024);
               gemm_sample<EPI_RES>(P, smem, WSP(bf16_t, OFF_P), DFF, WSP(bf16_t, wt_dn_off(l)), DFF, 64, 1); break;
    }
    if (step == 0) grid.sync();
    else xcd_barrier(xb);
  }
  final_norm_phase(P);
}

extern "C" void kernel_launch(void* const* d_in, const int* in_sizes, int n_in,
                              void* d_out, int out_size, void* d_ws, size_t ws_size,
                              hipStream_t stream) {
  static int grid_blocks = 0;
  if (!grid_blocks) {
    int dev = 0, cus = 0, per_cu = 0;
    (void)hipGetDevice(&dev);
    (void)hipDeviceGetAttribute(&cus, hipDeviceAttributeMultiprocessorCount, dev);
    (void)hipOccupancyMaxActiveBlocksPerMultiprocessor(&per_cu, hybrid_fwd, 512, 0);
    if (per_cu > 1) per_cu = 1;
    if (per_cu < 1) per_cu = 1;
    grid_blocks = cus * per_cu;
  }
  if (ws_size < WS_NEED) { fprintf(stderr, "workspace too small: %zu < %zu\n", ws_size, (size_t)WS_NEED); return; }
  Params p{};
  for (int i = 0; i < N_IN; ++i) p.in[i] = (const float*)d_in[i];
  p.out = (float*)d_out;
  p.ws = (unsigned char*)d_ws;
  (void)hipMemsetAsync((unsigned char*)d_ws + OFF_BAR, 0, BAR_BYTES, stream);
  void* args[] = {&p};
  hipError_t e = hipLaunchCooperativeKernel((void*)hybrid_fwd, dim3(grid_blocks), dim3(512), args, 0, stream);
  if (e != hipSuccess) fprintf(stderr, "cooperative launch failed: %s (grid %d)\n", hipGetErrorString(e), grid_blocks);
}
```

```cpp
#include <hip/hip_runtime.h>
#include <hip/hip_cooperative_groups.h>
#include <cstdio>
namespace cg = cooperative_groups;

typedef unsigned short bf16_t;
typedef short bf16x8 __attribute__((ext_vector_type(8)));
typedef float f32x4 __attribute__((ext_vector_type(4)));
typedef unsigned u32x4 __attribute__((ext_vector_type(4)));
typedef unsigned u32x2 __attribute__((ext_vector_type(2)));

constexpr int D = 1024, NTP = 16384, NTS = 128, NTOK = 16512, TSEQ = 2048, NLAYER = 4;
constexpr int IN_COLS = 3980, PSTR = 3984, DFF = 2816;
constexpr int PB = 1548, PC = 2956;

enum { I_XP = 0, I_XS, I_SGDN, I_SCONV, I_SRWKV, I_SSHIFT, I_SHGRN, I_NORM_MIX, I_WIN, I_WOUT, I_CONVW, I_ALOG, I_DTB, I_GNW,
       I_MU, I_W0, I_W2, I_A0, I_A2, I_G2, I_V0, I_V1, I_V2, I_KK, I_KA, I_RK, I_LNW, I_LNB, I_HLB, I_HNW, I_NORM_FFN,
       I_WG, I_WU, I_WD, I_NORM_FINAL, N_IN };

constexpr size_t O_YP = 0, O_YS = 16777216, O_GDN_P = 16908288, O_GDN_S = 17694720, O_CONV_P = 30277632, O_CONV_S = 30388224,
                 O_RWKV_P = 32157696, O_RWKV_S = 32944128, O_SHIFT_P = 45527040, O_SHIFT_S = 45572096, O_HGRN_P = 46292992,
                 O_HGRN_S = 46817280;

constexpr size_t SZ_WTIN = (size_t)4096 * 1024 * 2, SZ_WTOUT = (size_t)1024 * 1024 * 2, SZ_WTGU = (size_t)5632 * 1024 * 2,
                 SZ_WTDN = (size_t)1024 * 2816 * 2, SZ_P = (size_t)NTOK * PSTR * 2, SZ_ACT = (size_t)NTOK * 1024 * 2,
                 SZ_T384 = (size_t)NTOK * 384 * 2, SZ_T8F = (size_t)NTOK * 8 * 4, SZ_T256 = (size_t)NTOK * 256 * 2,
                 SZ_T384F = (size_t)NTOK * 384 * 4;
constexpr size_t OFF_WTIN = 0, OFF_WTOUT = OFF_WTIN + SZ_WTIN, OFF_WTGU = OFF_WTOUT + SZ_WTOUT, OFF_WTDN = OFF_WTGU + SZ_WTGU,
                 OFF_P = OFF_WTDN + SZ_WTDN, OFF_ACT = OFF_P + SZ_P, OFF_GQ = OFF_ACT + SZ_ACT, OFF_GK = OFF_GQ + SZ_T384,
                 OFF_GV = OFF_GK + SZ_T384, OFF_GDEC = OFF_GV + SZ_T384, OFF_GBETA = OFF_GDEC + SZ_T8F, OFF_HQ = OFF_GBETA + SZ_T8F,
                 OFF_HK = OFF_HQ + SZ_T256, OFF_RR = OFF_HK + SZ_T256, OFF_RK = OFF_RR + SZ_T384, OFF_RV = OFF_RK + SZ_T384,
                 OFF_RKK = OFF_RV + SZ_T384, OFF_RB = OFF_RKK + SZ_T384, OFF_RG = OFF_RB + SZ_T384, OFF_RW = OFF_RG + SZ_T384,
                 OFF_VF = OFF_RW + SZ_T384F, OFF_LORA = OFF_VF + SZ_T384, OFF_WTOUT2 = OFF_LORA + 245760, OFF_WTGU2 = OFF_WTOUT2 + SZ_WTOUT, OFF_WTDN2 = OFF_WTGU2 + SZ_WTGU, OFF_BAR = OFF_WTDN2 + SZ_WTDN, OFF_CUTAB = OFF_BAR + 16384, OFF_QUEUE = OFF_CUTAB + 16384, BAR_BYTES = 16384 + 16384 + 4096, WS_NEED = OFF_BAR + BAR_BYTES;
constexpr int W2T = 0, A2T = 24576, G2T = 49152, V1T = 98304, V2T = 110592;

struct Params {
  const float* in[N_IN];
  float* out;
  unsigned char* ws;
};

#define WSP(T, off) ((T*)(P.ws + (off)))

__device__ __forceinline__ int otid() { int t = __builtin_amdgcn_workitem_id_x(); asm volatile("" : "+v"(t)); return t; }
__device__ __forceinline__ int obid() { int b = __builtin_amdgcn_workgroup_id_x(); asm volatile("" : "+s"(b)); return b; }
template <class T> __device__ __forceinline__ const T* opq(const T* p) { asm volatile("" : "+s"(p)); return p; }
__device__ __forceinline__ float bf2f(bf16_t h) { return __uint_as_float(((unsigned)h) << 16); }
typedef float f32x2_t __attribute__((ext_vector_type(2)));
typedef __bf16 bf16x2_t __attribute__((ext_vector_type(2)));
__device__ __forceinline__ unsigned pk2(float lo, float hi) {
  const f32x2_t v = {lo, hi};
  return __builtin_bit_cast(unsigned, __builtin_convertvector(v, bf16x2_t));
}
__device__ __forceinline__ bf16_t f2bf(float f) { return (bf16_t)(pk2(f, 0.f) & 0xffffu); }
__device__ __forceinline__ float sigm(float x) { return 1.f / (1.f + __expf(-x)); }
__device__ __forceinline__ float silu(float x) { return x / (1.f + __expf(-x)); }
__device__ __forceinline__ float softplus(float x) { return x > 20.f ? x : log1pf(__expf(x)); }
template <int CTRL> __device__ __forceinline__ float dppf(float x) {
  return __builtin_bit_cast(float, __builtin_amdgcn_mov_dpp(__builtin_bit_cast(int, x), CTRL, 0xf, 0xf, true));
}
__device__ __forceinline__ float wave_sum(float v) {
  v += dppf<0xB1>(v); v += dppf<0x4E>(v); v += dppf<0x141>(v); v += dppf<0x140>(v);
  const int iv = __builtin_bit_cast(int, v);
  const float s0 = __builtin_bit_cast(float, __builtin_amdgcn_readlane(iv, 0)), s1 = __builtin_bit_cast(float, __builtin_amdgcn_readlane(iv, 16));
  const float s2 = __builtin_bit_cast(float, __builtin_amdgcn_readlane(iv, 32)), s3 = __builtin_bit_cast(float, __builtin_amdgcn_readlane(iv, 48));
  return (s0 + s1) + (s2 + s3);
}
typedef float f32x2 __attribute__((ext_vector_type(2)));
__device__ __forceinline__ float row_sum16(float v) { v += dppf<0xB1>(v); v += dppf<0x4E>(v); v += dppf<0x141>(v); v += dppf<0x140>(v); return v; }
__device__ __forceinline__ float half_sum(float v) { v = row_sum16(v); return v + __shfl_xor(v, 16); }
__device__ __forceinline__ float reduce8(float x) { x += dppf<0xB1>(x); x += dppf<0x4E>(x); x += dppf<0x141>(x); return x; }

__device__ __forceinline__ f32x4 unpack4(u32x2 w) {
  f32x4 f; f[0] = __uint_as_float(w[0] << 16); f[1] = __uint_as_float(w[0] & 0xffff0000u);
  f[2] = __uint_as_float(w[1] << 16); f[3] = __uint_as_float(w[1] & 0xffff0000u); return f;
}
__device__ __forceinline__ bf16x8 pack8(f32x4 a, f32x4 b) {
  u32x4 u; u[0] = pk2(a[0], a[1]); u[1] = pk2(a[2], a[3]); u[2] = pk2(b[0], b[1]); u[3] = pk2(b[2], b[3]);
  return __builtin_bit_cast(bf16x8, u);
}
__device__ __forceinline__ u32x2 pack4(f32x4 a) { u32x2 u; u[0] = pk2(a[0], a[1]); u[1] = pk2(a[2], a[3]); return u; }
__device__ __forceinline__ float dot4(f32x4 a, f32x4 b) { return (a[0] * b[0] + a[1] * b[1]) + (a[2] * b[2] + a[3] * b[3]); }
__device__ __forceinline__ const float* xin_row(const Params& P, int l, int row) {
  const float* po = opq((const float*)P.out); const float* pp = opq(P.in[I_XP]); const float* ps = opq(P.in[I_XS]);
  if (l > 0) return po + (size_t)row * D;
  return row < NTP ? pp + (size_t)row * D : ps + (size_t)(row - NTP) * D;
}

__device__ __forceinline__ int gu_row(int c, int up) { return (c >> 7) * 256 + up * 128 + (c & 127); }
__device__ __forceinline__ void xpose_tile(unsigned char* smem, const float* __restrict__ W, int N, int kt, int ntl, bf16_t* __restrict__ dst, int dstK, int mode) {
  float (*tile)[65] = (float (*)[65])smem;
  const int tid = otid();
  __syncthreads();
#pragma unroll 4
  for (int i = 0; i < 8; ++i) {
    const int k = i * 8 + (tid >> 6), n = tid & 63, gn = ntl * 64 + n;
    tile[k][n] = gn < N ? W[(size_t)(kt * 64 + k) * N + gn] : 0.f;
  }
  __syncthreads();
#pragma unroll 4
  for (int i = 0; i < 4; ++i) {
    const int n = i * 16 + (tid >> 5), k = (tid & 31) * 2, gn = ntl * 64 + n;
    const int drow = mode == 0 ? gn : gu_row(gn, mode - 1);
    *(unsigned*)(dst + (size_t)drow * dstK + kt * 64 + k) = pk2(tile[k][n], tile[k + 1][n]);
  }
}
constexpr int WCONV_JOBS = 3392 + 480;
__device__ __forceinline__ size_t wt_out_off(int l) { return (l & 1) ? OFF_WTOUT2 : OFF_WTOUT; }
__device__ __forceinline__ size_t wt_gu_off(int l) { return (l & 1) ? OFF_WTGU2 : OFF_WTGU; }
__device__ __forceinline__ size_t wt_dn_off(int l) { return (l & 1) ? OFF_WTDN2 : OFF_WTDN; }
__device__ __forceinline__ void wconv_job(const Params& P, unsigned char* smem, int l, int job) {
  if (job < 1024) xpose_tile(smem, P.in[I_WIN] + (size_t)l * 1024 * IN_COLS, IN_COLS, job & 15, job >> 4, WSP(bf16_t, OFF_WTIN), 1024, 0);
  else if (job < 1280) { const int j = job - 1024; xpose_tile(smem, P.in[I_WOUT] + (size_t)l * 1024 * 1024, 1024, j & 15, j >> 4, WSP(bf16_t, wt_out_off(l)), 1024, 0); }
  else if (job < 1984) { const int j = job - 1280; xpose_tile(smem, P.in[I_WG] + (size_t)l * 1024 * DFF, DFF, j & 15, j >> 4, WSP(bf16_t, wt_gu_off(l)), 1024, 1); }
  else if (job < 2688) { const int j = job - 1984; xpose_tile(smem, P.in[I_WU] + (size_t)l * 1024 * DFF, DFF, j & 15, j >> 4, WSP(bf16_t, wt_gu_off(l)), 1024, 2); }
  else if (job < 3392) { const int j = job - 2688; xpose_tile(smem, P.in[I_WD] + (size_t)l * DFF * 1024, 1024, j % 44, j / 44, WSP(bf16_t, wt_dn_off(l)), DFF, 0); }
  else {
    bf16_t* lw = WSP(bf16_t, OFF_LORA);
    const int idx = (job - 3392) * 256 + (otid() & 255);
    float v = 0.f;
    const float* pw2 = opq(P.in[I_W2]); const float* pa2 = opq(P.in[I_A2]); const float* pg2 = opq(P.in[I_G2]);
    const float* pv1 = opq(P.in[I_V1]); const float* pv2 = opq(P.in[I_V2]);
    if (idx < A2T) { const int n = idx >> 6, k = idx & 63; v = pw2[(size_t)l * 64 * 384 + k * 384 + n]; }
    else if (idx < G2T) { const int i = idx - A2T, n = i >> 6, k = i & 63; v = pa2[(size_t)l * 64 * 384 + k * 384 + n]; }
    else if (idx < V1T) { const int i = idx - G2T, n = i >> 7, k = i & 127; v = pg2[(size_t)l * 128 * 384 + k * 384 + n]; }
    else if (idx < V2T) { if (l > 0) { const int i = idx - V1T, n = i / 384, k = i - n * 384; v = pv1[(size_t)(l - 1) * 384 * 32 + k * 32 + n]; } }
    else { if (l > 0) { const int i = idx - V2T, n = i >> 5, k = i & 31; v = pv2[(size_t)(l - 1) * 32 * 384 + k * 384 + n]; } }
    if (otid() < 256) lw[idx] = f2bf(v);
  }
}
__device__ __forceinline__ void wconv_phase(const Params& P, unsigned char* smem, int l) {
  for (int j = obid(); j < 1024 + 480; j += gridDim.x) wconv_job(P, smem, l, j < 1024 ? j : j + 2368);
}

template <int NR, bool FINAL>
__device__ __forceinline__ void norm_rows(const Params& P, int l_in, const f32x4 (&wv)[4], int lane, int r0, int extra_row) {
  f32x4 v[NR][4];
#pragma unroll
  for (int r = 0; r < NR; ++r) {
    const int row = (NR == 5 && r == 4) ? extra_row : r0 + r;
    const float* xr = FINAL ? (const float*)(P.out + (size_t)row * D) : xin_row(P, l_in, row);
#pragma unroll
    for (int i = 0; i < 4; ++i) v[r][i] = *(const f32x4*)(xr + i * 256 + lane * 4);
  }
#pragma unroll
  for (int r = 0; r < NR; ++r) {
    const int row = (NR == 5 && r == 4) ? extra_row : r0 + r;
    float ss = 0.f;
#pragma unroll
    for (int i = 0; i < 4; ++i) ss += dot4(v[r][i], v[r][i]);
    const float rstd = rsqrtf(wave_sum(ss) * (1.f / 1024.f) + 1e-6f);
#pragma unroll
    for (int i = 0; i < 4; ++i) {
      if (FINAL) *(f32x4*)(P.out + (size_t)row * D + i * 256 + lane * 4) = v[r][i] * rstd * wv[i];
      else *(u32x2*)(WSP(bf16_t, OFF_ACT) + (size_t)row * 1024 + i * 256 + lane * 4) = pack4(v[r][i] * rstd * wv[i]);
    }
  }
}
template <bool FINAL>
__device__ __forceinline__ void norm_any(const Params& P, int l_in, const float* __restrict__ w) {
  const int lane = otid() & 63, wid = otid() >> 6;
  f32x4 wv[4];
#pragma unroll
  for (int i = 0; i < 4; ++i) wv[i] = *(const f32x4*)(w + i * 256 + lane * 4);
  const int nw = gridDim.x * 8;
  for (int gw = obid() * 8 + wid; gw * 8 < NTP; gw += nw) {
    norm_rows<4, FINAL>(P, l_in, wv, lane, gw * 8, 0);
    if (gw < NTS) norm_rows<5, FINAL>(P, l_in, wv, lane, gw * 8 + 4, NTP + gw);
    else norm_rows<4, FINAL>(P, l_in, wv, lane, gw * 8 + 4, 0);
  }
}
__device__ __forceinline__ void norm_phase(const Params& P, int l_in, const float* __restrict__ w) { norm_any<false>(P, l_in, w); }
__device__ __forceinline__ void final_norm_phase(const Params& P) { norm_any<true>(P, 1, P.in[I_NORM_FINAL]); }

enum { EPI_P = 0, EPI_RES = 1, EPI_SWIGLU = 2 };
namespace pg8 {
constexpr int BM = 256, BK = 64, HALF = 128, HTB = HALF * BK * 2, NXCD = 8, WGM = 8;
__device__ __forceinline__ int lds_byte(int r, int c) { const int st = (r >> 4) * 2 + (c >> 5), rr = r & 15, cc = c & 31, ob = rr * 64 + cc * 2; return st * 1024 + (ob ^ (((ob >> 9) & 1) << 5)); }
__device__ __forceinline__ void stage_rc(int b, int& R, int& C) { const int st = b / 1024, sb = b % 1024, swz = sb ^ (((sb >> 9) & 1) << 5); R = (st >> 1) * 16 + swz / 64; C = (st & 1) * 32 + (swz % 64) / 2; }
__device__ __forceinline__ int perm32(int rho) { const int n = rho >> 4, i = rho & 15; return 8 * (i >> 2) + 4 * n + (i & 3); }
struct Unit { int pm, pn; };
struct StaticOrder {
  int nM, nN, nwg, G, c;
  __device__ __forceinline__ void init(int M, int N, int G_, int c_) { nM = M / BM; nN = N / BM; nwg = nM * nN; G = G_; c = c_; }
  __device__ __forceinline__ bool next(int i, Unit& u) const {
    const long L = (long)i * G + c; if (L >= nwg) return false;
    int wgid = (int)L; { const int q = nwg / NXCD, r = nwg % NXCD, xcd = wgid % NXCD, off = wgid / NXCD; wgid = (xcd < r ? xcd * (q + 1) : r * (q + 1) + (xcd - r) * q) + off; }
    const int nig = WGM * nN, gid = wgid / nig, fm = gid * WGM, gsz = (nM - fm) < WGM ? (nM - fm) : WGM;
    u.pm = fm + ((wgid % nig) % gsz); u.pn = (wgid % nig) / gsz; return true;
  }
};
}

template <int EPI>
__device__ __forceinline__ void gemm_epilogue(const Params& P, const f32x4 (&acc)[2][2][4][2], const pg8::Unit& u, int wr, int wc, int fr, int fq, int l) {
#pragma unroll
  for (int ai = 0; ai < 2; ++ai)
#pragma unroll
    for (int m = 0; m < 4; ++m) {
      const int row = u.pm * 256 + ai * 128 + wr * 64 + m * 16 + fr;
      if (EPI == EPI_P) {
        bf16_t* pr = WSP(bf16_t, OFF_P) + (size_t)row * PSTR;
#pragma unroll
        for (int bj = 0; bj < 2; ++bj) {
          const int col = u.pn * 256 + bj * 128 + wc * 32 + fq * 8;
          if (col < PSTR) { const u32x2 lo = pack4(acc[ai][bj][m][0]), hi = pack4(acc[ai][bj][m][1]); *(u32x4*)(pr + col) = (u32x4){lo[0], lo[1], hi[0], hi[1]}; }
        }
      } else if (EPI == EPI_RES) {
        const float* xi = xin_row(P, l, row);
        float* xo = P.out + (size_t)row * D;
#pragma unroll
        for (int bj = 0; bj < 2; ++bj)
#pragma unroll
          for (int n = 0; n < 2; ++n) {
            const int col = u.pn * 256 + bj * 128 + wc * 32 + n * 16 + fq * 4;
            *(f32x4*)(xo + col) = *(const f32x4*)(xi + col) + acc[ai][bj][m][n];
          }
      } else {
        bf16_t* ur = WSP(bf16_t, OFF_P) + (size_t)row * DFF;
        {
          const int col = u.pn * 128 + wc * 32 + fq * 8;
          f32x4 r0, r1;
#pragma unroll
          for (int j = 0; j < 4; ++j) { r0[j] = silu(acc[ai][0][m][0][j]) * acc[ai][1][m][0][j]; r1[j] = silu(acc[ai][0][m][1][j]) * acc[ai][1][m][1][j]; }
          const u32x2 lo = pack4(r0), hi = pack4(r1);
          *(u32x4*)(ur + col) = (u32x4){lo[0], lo[1], hi[0], hi[1]};
        }
      }
    }
}

#define PG8_LAS __attribute__((address_space(3)))
template <int EPI>
__device__ __forceinline__ void gemm_phase(const Params& P, unsigned char* smem, const bf16_t* __restrict__ Ag, int lda_unused, const bf16_t* __restrict__ Btg, int K, int nN128_unused, int l, int N) {
  using namespace pg8;
  PG8_LAS unsigned char* lds = (PG8_LAS unsigned char*)smem;
  const int tid = otid(), wid = __builtin_amdgcn_readfirstlane(tid >> 6), lane = tid & 63, wr = wid >> 2, wc = wid & 3, fr = lane & 15, fq = lane >> 4;
  const int nt = K / BK;
  StaticOrder S; S.init(NTP, N, (int)gridDim.x, obid());
  unsigned voffA[2], voffB[2];
#pragma unroll
  for (int i = 0; i < 2; ++i) { int R, C; stage_rc(tid * 16 + i * 8192, R, C); const int Rb = EPI == EPI_RES ? R : ((R & ~31) + perm32(R & 31));
    voffA[i] = (unsigned)(R * K + C) * 2u; voffB[i] = (unsigned)(Rb * K + C) * 2u; }
  const size_t kstep = (size_t)(BK * 2);
  const size_t hstep = (size_t)HALF * K * 2;
  const size_t tstep = 2 * hstep;
  const unsigned ldsw = (unsigned)wid * 1024u;
  const int aoff = lds_byte(wr * 64 + fr, fq * 8), boff = lds_byte(wc * 32 + fr, fq * 8);
#define PG8_SA(b, h) (((b) * 2 + (h)) * HTB)
#define PG8_SB(b, h) ((4 + (b) * 2 + (h)) * HTB)
#define PG8_STAGE(bufoff, gbase, voff) do { _Pragma("unroll") for (int _i = 0; _i < 2; ++_i) \
        __builtin_amdgcn_global_load_lds((const unsigned*)((const char*)(gbase) + (voff)[_i]), (PG8_LAS unsigned*)(lds + (bufoff) + ldsw + _i * 8192), 16, 0, 0); } while (0)
#define PG8_LDA(dst, b, h) do { _Pragma("unroll") for (int m = 0; m < 4; ++m) _Pragma("unroll") for (int k = 0; k < 2; ++k) dst[m][k] = *(const PG8_LAS bf16x8*)(lds + PG8_SA(b, h) + aoff + m * 2048 + k * 1024); } while (0)
#define PG8_LDB(dst, b, h) do { _Pragma("unroll") for (int n = 0; n < 2; ++n) _Pragma("unroll") for (int k = 0; k < 2; ++k) dst[n][k] = *(const PG8_LAS bf16x8*)(lds + PG8_SB(b, h) + boff + n * 2048 + k * 1024); } while (0)
#define PG8_MMA(ai, bj, At, Bt) do { __builtin_amdgcn_s_setprio(1); _Pragma("unroll") for (int m = 0; m < 4; ++m) _Pragma("unroll") for (int n = 0; n < 2; ++n) _Pragma("unroll") for (int k = 0; k < 2; ++k) \
        acc[ai][bj][m][n] = __builtin_amdgcn_mfma_f32_16x16x32_bf16(Bt[n][k], At[m][k], acc[ai][bj][m][n], 0, 0, 0); __builtin_amdgcn_s_setprio(0); } while (0)
#define PG8_WAIT_V(n) asm volatile("s_waitcnt vmcnt(" #n ")" ::: "memory")
#define PG8_WAIT_L(n) asm volatile("s_waitcnt lgkmcnt(" #n ")" ::: "memory")
#define PG8_BAR __builtin_amdgcn_s_barrier()
#define PG8_SCHED __builtin_amdgcn_sched_barrier(0)
  Unit cur, nxt; int ui = 0;
  if (!S.next(0, cur)) return;
  f32x4 acc[2][2][4][2];
#pragma unroll
  for (int a = 0; a < 2; ++a)
#pragma unroll
    for (int b = 0; b < 2; ++b)
#pragma unroll
      for (int m = 0; m < 4; ++m)
#pragma unroll
        for (int n = 0; n < 2; ++n) acc[a][b][m][n] = (f32x4){0.f, 0.f, 0.f, 0.f};
  bf16x8 At[4][2], B0[2][2], B1[2][2];
  const char* cA = (const char*)Ag + (size_t)cur.pm * tstep; const char* cB = (const char*)Btg + (size_t)cur.pn * tstep;
  PG8_STAGE(PG8_SB(0, 0), cB, voffB); PG8_STAGE(PG8_SA(0, 0), cA, voffA); PG8_STAGE(PG8_SB(0, 1), cB + hstep, voffB); PG8_STAGE(PG8_SA(0, 1), cA + hstep, voffA);
  if (wr == 1) PG8_BAR;
  PG8_WAIT_V(4); PG8_BAR;
  PG8_STAGE(PG8_SB(1, 0), cB + kstep, voffB); PG8_STAGE(PG8_SA(1, 0), cA + kstep, voffA); PG8_STAGE(PG8_SB(1, 1), cB + hstep + kstep, voffB);
  PG8_WAIT_V(6); PG8_BAR;
  for (;;) {
    const bool has_next = S.next(ui + 1, nxt);
    const char* nA = has_next ? (const char*)Ag + (size_t)nxt.pm * tstep : cA; const char* nB = has_next ? (const char*)Btg + (size_t)nxt.pn * tstep : cB;
    for (int t = 0; t < nt; t += 2) {
      const bool last = (t == nt - 2);
      const char* a1 = cA + (size_t)(t + 1) * kstep;
      const char* a2 = last ? nA : cA + (size_t)(t + 2) * kstep; const char* b2 = last ? nB : cB + (size_t)(t + 2) * kstep;
      const char* a3 = a2 + kstep; const char* b3 = b2 + kstep;
      PG8_LDB(B0, 0, 0); PG8_SCHED; PG8_LDA(At, 0, 0); PG8_STAGE(PG8_SA(1, 1), a1 + hstep, voffA);
      PG8_WAIT_L(8); PG8_BAR; PG8_WAIT_L(0); PG8_MMA(0, 0, At, B0); PG8_BAR; PG8_SCHED;
      PG8_LDB(B1, 0, 1); PG8_STAGE(PG8_SB(0, 0), b2, voffB);
      PG8_BAR; PG8_WAIT_L(0); PG8_MMA(0, 1, At, B1); PG8_BAR;
      PG8_LDA(At, 0, 1); PG8_STAGE(PG8_SA(0, 0), a2, voffA);
      PG8_BAR; PG8_WAIT_L(0); PG8_MMA(1, 0, At, B0); PG8_BAR; PG8_SCHED;
      PG8_STAGE(PG8_SB(0, 1), b2 + hstep, voffB);
      PG8_WAIT_V(6); PG8_BAR; PG8_MMA(1, 1, At, B1); PG8_BAR;
      PG8_LDB(B0, 1, 0); PG8_SCHED; PG8_LDA(At, 1, 0); PG8_STAGE(PG8_SA(0, 1), a2 + hstep, voffA);
      PG8_WAIT_L(8); PG8_BAR; PG8_WAIT_L(0); PG8_MMA(0, 0, At, B0); PG8_BAR; PG8_SCHED;
      PG8_LDB(B1, 1, 1); PG8_STAGE(PG8_SB(1, 0), b3, voffB);
      PG8_BAR; PG8_WAIT_L(0); PG8_MMA(0, 1, At, B1); PG8_BAR;
      PG8_LDA(At, 1, 1); PG8_STAGE(PG8_SA(1, 0), a3, voffA);
      PG8_BAR; PG8_WAIT_L(0); PG8_MMA(1, 0, At, B0); PG8_BAR; PG8_SCHED;
      PG8_STAGE(PG8_SB(1, 1), b3 + hstep, voffB);
      PG8_WAIT_V(6); PG8_BAR; PG8_MMA(1, 1, At, B1); PG8_BAR;
    }
    gemm_epilogue<EPI>(P, acc, cur, wr, wc, fr, fq, l);
    if (!has_next) break;
#pragma unroll
    for (int a = 0; a < 2; ++a)
#pragma unroll
      for (int b = 0; b < 2; ++b)
#pragma unroll
        for (int m = 0; m < 4; ++m)
#pragma unroll
          for (int n = 0; n < 2; ++n) acc[a][b][m][n] = (f32x4){0.f, 0.f, 0.f, 0.f};
    cur = nxt; cA = nA; cB = nB; ++ui;
  }
  PG8_WAIT_V(0);
  if (wr == 0) PG8_BAR;
  PG8_BAR;
#undef PG8_SA
#undef PG8_SB
#undef PG8_STAGE
#undef PG8_LDA
#undef PG8_LDB
#undef PG8_MMA
#undef PG8_WAIT_V
#undef PG8_WAIT_L
#undef PG8_BAR
#undef PG8_SCHED
}

template <int EPI>
__device__ __forceinline__ void gemm_sample(const Params& P, unsigned char* smem, const bf16_t* __restrict__ A, int lda, const bf16_t* __restrict__ Bt, int K, int nunits, int l) {
  const int tid = otid(), lane = tid & 63, wid = tid >> 6, fr = lane & 15, fq = lane >> 4;
  const int kslice = K >> 3;
  for (int u = (int)gridDim.x - 1 - obid(); u < nunits; u += gridDim.x) {
    const int brow0 = EPI == EPI_SWIGLU ? gu_row(u * 16 + fr, 0) : u * 16 + fr;
    const int brow1 = EPI == EPI_SWIGLU ? gu_row(u * 16 + fr, 1) : 0;
    const bf16_t* ap = A + (size_t)(NTP + fr) * lda + wid * kslice + fq * 8;
    const bf16_t* b0p = Bt + (size_t)brow0 * K + wid * kslice + fq * 8;
    const bf16_t* b1p = Bt + (size_t)brow1 * K + wid * kslice + fq * 8;
    f32x4 c0[8], c1[8];
#pragma unroll
    for (int m = 0; m < 8; ++m) { c0[m] = (f32x4){0.f, 0.f, 0.f, 0.f}; c1[m] = c0[m]; }
#pragma unroll 2
    for (int ks = 0; ks < kslice; ks += 32) {
      bf16x8 Af[8];
#pragma unroll
      for (int m = 0; m < 8; ++m) Af[m] = *(const bf16x8*)(ap + (size_t)m * 16 * lda + ks);
      const bf16x8 B0 = *(const bf16x8*)(b0p + ks);
      bf16x8 B1 = B0;
      if (EPI == EPI_SWIGLU) B1 = *(const bf16x8*)(b1p + ks);
#pragma unroll
      for (int m = 0; m < 8; ++m) {
        c0[m] = __builtin_amdgcn_mfma_f32_16x16x32_bf16(B0, Af[m], c0[m], 0, 0, 0);
        if (EPI == EPI_SWIGLU) c1[m] = __builtin_amdgcn_mfma_f32_16x16x32_bf16(B1, Af[m], c1[m], 0, 0, 0);
      }
    }
    __syncthreads();
#pragma unroll
    for (int m = 0; m < 8; ++m) {
      *(f32x4*)(smem + ((wid * 8 + m) * 64 + lane) * 16) = c0[m];
      if (EPI == EPI_SWIGLU) *(f32x4*)(smem + 65536 + ((wid * 8 + m) * 64 + lane) * 16) = c1[m];
    }
    __syncthreads();
    f32x4 g = (f32x4){0.f, 0.f, 0.f, 0.f}, up = g;
#pragma unroll
    for (int w = 0; w < 8; ++w) {
      g += *(const f32x4*)(smem + ((w * 8 + wid) * 64 + lane) * 16);
      if (EPI == EPI_SWIGLU) up += *(const f32x4*)(smem + 65536 + ((w * 8 + wid) * 64 + lane) * 16);
    }
    {
      const int row = NTP + wid * 16 + fr, col = u * 16 + fq * 4;
      if (EPI == EPI_P) {
        if (col < IN_COLS) *(u32x2*)(WSP(bf16_t, OFF_P) + (size_t)row * PSTR + col) = pack4(g);
      } else if (EPI == EPI_RES) {
        const float* xi = xin_row(P, l, row);
        *(f32x4*)(P.out + (size_t)row * D + col) = *(const f32x4*)(xi + col) + g;
      } else {
        f32x4 r;
#pragma unroll
        for (int j = 0; j < 4; ++j) r[j] = silu(g[j]) * up[j];
        *(u32x2*)(WSP(bf16_t, OFF_P) + (size_t)row * DFF + col) = pack4(r);
      }
    }
  }
}

__device__ __forceinline__ float lbval(const Params& P, int l, int c) {
  const float* hb = P.in[I_HLB];
  const float a0 = hb[c], a1 = hb[256 + c], a2 = hb[512 + c], a3 = hb[768 + c];
  const float m = fmaxf(fmaxf(a0, a1), fmaxf(a2, a3));
  const float e0 = __expf(a0 - m), e1 = __expf(a1 - m), e2 = __expf(a2 - m), e3 = __expf(a3 - m);
  const float inv = 1.f / (e0 + e1 + e2 + e3);
  float s = 0.f;
  if (l >= 1) s += e1; if (l >= 2) s += e2; if (l >= 3) s += e3;
  return s * inv;
}

__device__ __forceinline__ void gdn_conv_emit2(const Params& P, int g, int c2, int row, float s0, float s1) {
  const int h = g % 6;
  if (g < 12) {
    const float rn = rsqrtf(half_sum(s0 * s0 + s1 * s1) + 1e-6f) * (g < 6 ? 0.125f : 1.f);
    *(unsigned*)((g < 6 ? WSP(bf16_t, OFF_GQ) : WSP(bf16_t, OFF_GK)) + (size_t)row * 384 + h * 64 + c2) = pk2(s0 * rn, s1 * rn);
  } else {
    *(unsigned*)(WSP(bf16_t, OFF_GV) + (size_t)row * 384 + h * 64 + c2) = pk2(s0, s1);
  }
}
__device__ __forceinline__ void gdn_gate_emit(const Params& P, int l, int h, int row) {
  const bf16_t* pr = WSP(bf16_t, OFF_P) + (size_t)row * PSTR;
  const float braw = bf2f(pr[1536 + h]), araw = bf2f(pr[1542 + h]);
  const float gg = -__expf(P.in[I_ALOG][l * 6 + h]) * softplus(araw + P.in[I_DTB][l * 6 + h]);
  WSP(float, OFF_GDEC)[(size_t)row * 8 + h] = __expf(gg);
  WSP(float, OFF_GBETA)[(size_t)row * 8 + h] = sigm(braw);
}
__device__ __forceinline__ void prep_gdn_prompt(const Params& P, int l, int ci) {
  const int lane = otid() & 63, wid = otid() >> 6, hl = lane >> 5, c2 = (lane & 31) * 2;
  const int r0 = ci * 32, b = r0 / TSEQ, t0 = r0 % TSEQ;
  const bf16_t* p = WSP(bf16_t, OFF_P);
  for (int gp = wid; gp < 9; gp += 8) {
    const int g = gp * 2 + hl, col = g * 64 + c2;
    const float* cw = P.in[I_CONVW] + (size_t)l * 4 * 1152 + col;
    const f32x2 w0 = *(const f32x2*)cw, w1 = *(const f32x2*)(cw + 1152), w2 = *(const f32x2*)(cw + 2304), w3 = *(const f32x2*)(cw + 3456);
    unsigned xr[35];
#pragma unroll
    for (int t = 0; t < 35; ++t) xr[t] = (t >= 3 || t0 > 0) ? *(const unsigned*)(p + (size_t)(r0 - 3 + t) * PSTR + col) : 0u;
    f32x2 x3 = {__uint_as_float(xr[0] << 16), __uint_as_float(xr[0] & 0xffff0000u)};
    f32x2 x2 = {__uint_as_float(xr[1] << 16), __uint_as_float(xr[1] & 0xffff0000u)};
    f32x2 x1 = {__uint_as_float(xr[2] << 16), __uint_as_float(xr[2] & 0xffff0000u)};
#pragma unroll
    for (int t = 0; t < 32; ++t) {
      const f32x2 x0 = {__uint_as_float(xr[t + 3] << 16), __uint_as_float(xr[t + 3] & 0xffff0000u)};
      const f32x2 y = w0 * x3 + w1 * x2 + w2 * x1 + w3 * x0;
      gdn_conv_emit2(P, g, c2, r0 + t, silu(y[0]), silu(y[1]));
      x3 = x2; x2 = x1; x1 = x0;
    }
    if (t0 + 32 == TSEQ) {
      float* cp = P.out + O_CONV_P + (size_t)(l * 8 + b) * 3 * 1152 + col;
      *(f32x2*)cp = x3; *(f32x2*)(cp + 1152) = x2; *(f32x2*)(cp + 2304) = x1;
    }
    if (g < 6) gdn_gate_emit(P, l, g, r0 + (lane & 31));
  }
}
__device__ __forceinline__ void prep_gdn_sample(const Params& P, int l, int si) {
  const int lane = otid() & 63, wid = otid() >> 6, hl = lane >> 5, c2 = (lane & 31) * 2;
  const bf16_t* p = WSP(bf16_t, OFF_P);
  for (int u = wid; u < 18; u += 8) {
    const int s = si * 2 + u / 9, g = (u % 9) * 2 + hl, col = g * 64 + c2, row = NTP + s;
    const float* cw = P.in[I_CONVW] + (size_t)l * 4 * 1152 + col;
    const f32x2 w0 = *(const f32x2*)cw, w1 = *(const f32x2*)(cw + 1152), w2 = *(const f32x2*)(cw + 2304), w3 = *(const f32x2*)(cw + 3456);
    const float* cb = P.in[I_SCONV] + (size_t)(l * 128 + s) * 3 * 1152 + col;
    const f32x2 x3 = *(const f32x2*)cb, x2 = *(const f32x2*)(cb + 1152), x1 = *(const f32x2*)(cb + 2304);
    const unsigned xw = *(const unsigned*)(p + (size_t)row * PSTR + col);
    const f32x2 x0 = {__uint_as_float(xw << 16), __uint_as_float(xw & 0xffff0000u)};
    const f32x2 y = w0 * x3 + w1 * x2 + w2 * x1 + w3 * x0;
    gdn_conv_emit2(P, g, c2, row, silu(y[0]), silu(y[1]));
    float* cp = P.out + O_CONV_S + (size_t)(l * 128 + s) * 3 * 1152 + col;
    *(f32x2*)cp = x2; *(f32x2*)(cp + 1152) = x1; *(f32x2*)(cp + 2304) = x0;
    if (g < 6 && (lane & 31) == 0) gdn_gate_emit(P, l, g, row);
  }
}
__device__ __forceinline__ void prep_hgrn(const Params& P, int l, int ti) {
  const int c2 = (otid() & 127) * 2, tg = otid() >> 7;
  const float oml0 = 1.f - lbval(P, l, c2), oml1 = 1.f - lbval(P, l, c2 + 1);
  const bf16_t* p = WSP(bf16_t, OFF_P);
  bf16_t* hq = WSP(bf16_t, OFF_HQ); bf16_t* hk = WSP(bf16_t, OFF_HK);
  for (int t0 = tg * 16; t0 < tg * 16 + 16; t0 += 8) {
    unsigned q[8], f[8];
#pragma unroll
    for (int i = 0; i < 8; ++i) { const int row = ti * 64 + t0 + i; q[i] = *(const unsigned*)(p + (size_t)row * PSTR + PC + c2); f[i] = *(const unsigned*)(p + (size_t)row * PSTR + PC + 256 + c2); }
#pragma unroll
    for (int i = 0; i < 8; ++i) {
      const int row = ti * 64 + t0 + i;
      const float q0 = __uint_as_float(q[i] << 16), q1 = __uint_as_float(q[i] & 0xffff0000u);
      const float f0 = __uint_as_float(f[i] << 16), f1 = __uint_as_float(f[i] & 0xffff0000u);
      *(unsigned*)(hq + (size_t)row * 256 + c2) = pk2(silu(q0) * 0.125f, silu(q1) * 0.125f);
      *(unsigned*)(hk + (size_t)row * 256 + c2) = pk2(oml0 * sigm(-f0), oml1 * sigm(-f1));
    }
  }
}
template <bool SAMP>
__device__ __forceinline__ f32x4 xs4t(const Params& P, int l, int row, int col0) {
  const bf16_t* p = WSP(bf16_t, OFF_P);
  const f32x4 pv = unpack4(*(const u32x2*)(p + (size_t)row * PSTR + PB + col0));
  f32x4 prev;
  if (SAMP) prev = *(const f32x4*)(P.in[I_SSHIFT] + (size_t)(l * 128 + (row - NTP)) * 1408 + col0);
  else {
    const bool first = (row & (TSEQ - 1)) == 0;
    prev = unpack4(*(const u32x2*)(p + (size_t)(row - (first ? 0 : 1)) * PSTR + PB + col0)) * (first ? 0.f : 1.f);
  }
  const f32x4 mu = *(const f32x4*)(P.in[I_MU] + l * 1408 + col0);
  return pv + (prev - pv) * mu;
}
__device__ __forceinline__ float tanh_fast(float x) { return 1.f - 2.f / (__expf(2.f * x) + 1.f); }

template <int ROWB>
__device__ __forceinline__ void stage_lora(unsigned char* smem, const bf16_t* __restrict__ src) {
  constexpr int CPR = ROWB / 16, NCH = 384 * CPR;
  __syncthreads();
  u32x4 t[NCH / 512];
#pragma unroll
  for (int i = 0; i < NCH / 512; ++i) t[i] = *(const u32x4*)((const unsigned char*)src + (size_t)(otid() + i * 512) * 16);
#pragma unroll
  for (int i = 0; i < NCH / 512; ++i) { const int idx = otid() + i * 512, r = idx / CPR, c = idx - r * CPR; *(u32x4*)(smem + r * (ROWB + 16) + c * 16) = t[i]; }
  __syncthreads();
}
template <int ROWB>
__device__ __forceinline__ void stage_lora_open(unsigned char* smem, const bf16_t* __restrict__ src) {
  constexpr int CPR = ROWB / 16, NCH = 384 * CPR;
  __syncthreads();
  u32x4 t[NCH / 512];
#pragma unroll
  for (int i = 0; i < NCH / 512; ++i) t[i] = *(const u32x4*)((const unsigned char*)src + (size_t)(otid() + i * 512) * 16);
#pragma unroll
  for (int i = 0; i < NCH / 512; ++i) { const int idx = otid() + i * 512, r = idx / CPR, c = idx - r * CPR; *(u32x4*)(smem + r * (ROWB + 16) + c * 16) = t[i]; }
}
constexpr int EXCH_OFF = 110592;
__device__ __forceinline__ unsigned char* exch_slot(unsigned char* smem, int wid, int slot, int lane) { return smem + EXCH_OFF + ((wid * 2 + slot) * 64 + lane) * 16; }
template <bool SAMP>
__device__ __forceinline__ void prep_rwkv_unit(const Params& P, unsigned char* smem, int l, int mt, int hh) {
  const int lane = otid() & 63, fr = lane & 15, fq = lane >> 4, wid = otid() >> 6;
  const int row = mt * 16 + fr, cb = hh * 192;
  const bf16_t* lw = WSP(bf16_t, OFF_LORA);
  const size_t ro = (size_t)row * 384;
  f32x4 acc[12];
  {
    bf16x8 Bf[2][12];
    f32x4 x0 = xs4t<SAMP>(P, l, row, 1152 + hh * 32 + fq * 8), x1 = xs4t<SAMP>(P, l, row, 1152 + hh * 32 + fq * 8 + 4);
    stage_lora_open<128>(smem, lw + W2T);
#pragma unroll
    for (int j = 0; j < 4; ++j) { x0[j] = tanh_fast(x0[j]); x1[j] = tanh_fast(x1[j]); }
    const bf16x8 Am = pack8(x0, x1);
    *(bf16x8*)exch_slot(smem, wid, 0, lane) = Am;
    __syncthreads();
    const bf16x8 Ao = *(const bf16x8*)exch_slot(smem, wid ^ 1, 0, lane);
    bf16x8 Aw[2]; Aw[0] = hh ? Ao : Am; Aw[1] = hh ? Am : Ao;
#pragma unroll
    for (int ks = 0; ks < 2; ++ks)
#pragma unroll
      for (int nf = 0; nf < 12; ++nf) Bf[ks][nf] = *(const bf16x8*)(smem + (cb + nf * 16 + fr) * 144 + ks * 64 + fq * 16);
#pragma unroll
    for (int nf = 0; nf < 12; ++nf) acc[nf] = (f32x4){0.f, 0.f, 0.f, 0.f};
#pragma unroll
    for (int ks = 0; ks < 2; ++ks) {
#pragma unroll
      for (int nf = 0; nf < 12; ++nf) acc[nf] = __builtin_amdgcn_mfma_f32_16x16x32_bf16(Bf[ks][nf], Aw[ks], acc[nf], 0, 0, 0);
    }
    f32x4 w0v[12];
#pragma unroll
    for (int nf = 0; nf < 12; ++nf) w0v[nf] = *(const f32x4*)(P.in[I_W0] + l * 384 + cb + nf * 16 + fq * 4);
#pragma unroll
    for (int nf = 0; nf < 12; ++nf) {
      f32x4 d;
#pragma unroll
      for (int j = 0; j < 4; ++j) {
        const float xx = -(w0v[nf][j] + acc[nf][j]);
        const float sp = xx > 15.f ? xx : __logf(1.f + __expf(xx));
        d[j] = __expf(-__expf(-sp - 0.5f));
      }
      *(f32x4*)(WSP(float, OFF_RW) + ro + cb + nf * 16 + fq * 4) = d;
    }
  }
  {
    bf16x8 Bf[2][12];
    const f32x4 x0 = xs4t<SAMP>(P, l, row, 1216 + hh * 32 + fq * 8), x1 = xs4t<SAMP>(P, l, row, 1216 + hh * 32 + fq * 8 + 4);
    stage_lora_open<128>(smem, lw + A2T);
    const bf16x8 Am = pack8(x0, x1);
    *(bf16x8*)exch_slot(smem, wid, 0, lane) = Am;
    __syncthreads();
    const bf16x8 Ao = *(const bf16x8*)exch_slot(smem, wid ^ 1, 0, lane);
    bf16x8 Aw[2]; Aw[0] = hh ? Ao : Am; Aw[1] = hh ? Am : Ao;
#pragma unroll
    for (int ks = 0; ks < 2; ++ks)
#pragma unroll
      for (int nf = 0; nf < 12; ++nf) Bf[ks][nf] = *(const bf16x8*)(smem + (cb + nf * 16 + fr) * 144 + ks * 64 + fq * 16);
#pragma unroll
    for (int nf = 0; nf < 12; ++nf) acc[nf] = (f32x4){0.f, 0.f, 0.f, 0.f};
#pragma unroll
    for (int ks = 0; ks < 2; ++ks) {
#pragma unroll
      for (int nf = 0; nf < 12; ++nf) acc[nf] = __builtin_amdgcn_mfma_f32_16x16x32_bf16(Bf[ks][nf], Aw[ks], acc[nf], 0, 0, 0);
    }
  }
#pragma unroll
  for (int hl = 0; hl < 3; ++hl) {
    f32x4 kr[4], rr[4], kkw[4], a0[4], ka[4];
#pragma unroll
    for (int q = 0; q < 4; ++q) {
      const int c = cb + (hl * 4 + q) * 16 + fq * 4;
      kr[q] = xs4t<SAMP>(P, l, row, 384 + c); rr[q] = xs4t<SAMP>(P, l, row, c);
      kkw[q] = *(const f32x4*)(P.in[I_KK] + l * 384 + c); a0[q] = *(const f32x4*)(P.in[I_A0] + l * 384 + c); ka[q] = *(const f32x4*)(P.in[I_KA] + l * 384 + c);
    }
    float ss = 0.f;
#pragma unroll
    for (int q = 0; q < 4; ++q) { kkw[q] = kr[q] * kkw[q]; ss += dot4(kkw[q], kkw[q]); }
    ss += __shfl_xor(ss, 16); ss += __shfl_xor(ss, 32);
    const float rn = rsqrtf(ss + 1e-6f);
#pragma unroll
    for (int q = 0; q < 4; ++q) {
      const int nf = hl * 4 + q, c = cb + nf * 16 + fq * 4;
      f32x4 kn, kk, kb;
#pragma unroll
      for (int j = 0; j < 4; ++j) {
        const float a = sigm(a0[q][j] + acc[nf][j]);
        kk[j] = kkw[q][j] * rn; kb[j] = kk[j] * a; kn[j] = kr[q][j] * (1.f + (a - 1.f) * ka[q][j]);
      }
      *(u32x2*)(WSP(bf16_t, OFF_RK) + ro + c) = pack4(kn);
      *(u32x2*)(WSP(bf16_t, OFF_RKK) + ro + c) = pack4(kk);
      *(u32x2*)(WSP(bf16_t, OFF_RB) + ro + c) = pack4(kb);
      *(u32x2*)(WSP(bf16_t, OFF_RR) + ro + c) = pack4(rr[q]);
    }
  }
  {
    f32x4 x[2][2];
#pragma unroll
    for (int k2 = 0; k2 < 2; ++k2) { x[k2][0] = xs4t<SAMP>(P, l, row, 1280 + (hh * 2 + k2) * 32 + fq * 8); x[k2][1] = xs4t<SAMP>(P, l, row, 1280 + (hh * 2 + k2) * 32 + fq * 8 + 4); }
    stage_lora_open<256>(smem, lw + G2T);
    bf16x8 Am[2], Ao[2];
#pragma unroll
    for (int k2 = 0; k2 < 2; ++k2) {
#pragma unroll
      for (int j = 0; j < 4; ++j) { x[k2][0][j] = sigm(x[k2][0][j]); x[k2][1][j] = sigm(x[k2][1][j]); }
      Am[k2] = pack8(x[k2][0], x[k2][1]);
      *(bf16x8*)exch_slot(smem, wid, k2, lane) = Am[k2];
    }
    __syncthreads();
#pragma unroll
    for (int k2 = 0; k2 < 2; ++k2) Ao[k2] = *(const bf16x8*)exch_slot(smem, wid ^ 1, k2, lane);
    bf16x8 A[4];
    A[0] = hh ? Ao[0] : Am[0]; A[1] = hh ? Ao[1] : Am[1]; A[2] = hh ? Am[0] : Ao[0]; A[3] = hh ? Am[1] : Ao[1];
#pragma unroll
    for (int hf = 0; hf < 2; ++hf) {
      bf16x8 Bf[4][6];
#pragma unroll
      for (int ks = 0; ks < 4; ++ks)
#pragma unroll
        for (int n6 = 0; n6 < 6; ++n6) Bf[ks][n6] = *(const bf16x8*)(smem + (cb + (hf * 6 + n6) * 16 + fr) * 272 + ks * 64 + fq * 16);
#pragma unroll
      for (int n6 = 0; n6 < 6; ++n6) {
        f32x4 g = (f32x4){0.f, 0.f, 0.f, 0.f};
#pragma unroll
        for (int ks = 0; ks < 4; ++ks) g = __builtin_amdgcn_mfma_f32_16x16x32_bf16(Bf[ks][n6], A[ks], g, 0, 0, 0);
        *(u32x2*)(WSP(bf16_t, OFF_RG) + ro + cb + (hf * 6 + n6) * 16 + fq * 4) = pack4(g);
      }
    }
  }
  if (l == 0) {
    f32x4 v[12];
#pragma unroll
    for (int nf = 0; nf < 12; ++nf) v[nf] = xs4t<SAMP>(P, l, row, 768 + cb + nf * 16 + fq * 4);
#pragma unroll
    for (int nf = 0; nf < 12; ++nf) {
      const int c = cb + nf * 16 + fq * 4;
      const u32x2 o = pack4(v[nf]);
      *(u32x2*)(WSP(bf16_t, OFF_RV) + ro + c) = o;
      *(u32x2*)(WSP(bf16_t, OFF_VF) + ro + c) = o;
    }
  } else {
    f32x4 lo0 = (f32x4){0.f, 0.f, 0.f, 0.f}, lo1 = lo0;
    {
      const int hf = hh;
      f32x4 x[6][2]; bf16x8 B0[6], B1[6];
#pragma unroll
      for (int k6 = 0; k6 < 6; ++k6) {
        const int ks = hf * 6 + k6;
        x[k6][0] = xs4t<SAMP>(P, l, row, 768 + ks * 32 + fq * 8); x[k6][1] = xs4t<SAMP>(P, l, row, 768 + ks * 32 + fq * 8 + 4);
        B0[k6] = *(const bf16x8*)(lw + V1T + fr * 384 + ks * 32 + fq * 8);
        B1[k6] = *(const bf16x8*)(lw + V1T + (16 + fr) * 384 + ks * 32 + fq * 8);
      }
#pragma unroll
      for (int k6 = 0; k6 < 6; ++k6) {
        const bf16x8 A = pack8(x[k6][0], x[k6][1]);
        lo0 = __builtin_amdgcn_mfma_f32_16x16x32_bf16(B0[k6], A, lo0, 0, 0, 0);
        lo1 = __builtin_amdgcn_mfma_f32_16x16x32_bf16(B1[k6], A, lo1, 0, 0, 0);
      }
    }
    __syncthreads();
    *(f32x4*)exch_slot(smem, wid, 0, lane) = lo0; *(f32x4*)exch_slot(smem, wid, 1, lane) = lo1;
    __syncthreads();
    lo0 += *(const f32x4*)exch_slot(smem, wid ^ 1, 0, lane); lo1 += *(const f32x4*)exch_slot(smem, wid ^ 1, 1, lane);
    const bf16x8 A2 = pack8(lo0, lo1);
#pragma unroll
    for (int hf = 0; hf < 2; ++hf) {
      u32x4 bw[6]; f32x4 v0[6], v[6]; u32x2 vf[6];
#pragma unroll
      for (int n6 = 0; n6 < 6; ++n6) {
        const int nf = hf * 6 + n6, c = cb + nf * 16 + fq * 4;
        const bf16_t* vr = lw + V2T + (cb + nf * 16 + fr) * 32;
        const u32x2 b0 = *(const u32x2*)(vr + fq * 4), b1 = *(const u32x2*)(vr + 16 + fq * 4);
        bw[n6][0] = b0[0]; bw[n6][1] = b0[1]; bw[n6][2] = b1[0]; bw[n6][3] = b1[1];
        v0[n6] = *(const f32x4*)(P.in[I_V0] + (l - 1) * 384 + c);
        v[n6] = xs4t<SAMP>(P, l, row, 768 + c);
        vf[n6] = *(const u32x2*)(WSP(bf16_t, OFF_VF) + ro + c);
      }
#pragma unroll
      for (int n6 = 0; n6 < 6; ++n6) {
        const int c = cb + (hf * 6 + n6) * 16 + fq * 4;
        const f32x4 mv = __builtin_amdgcn_mfma_f32_16x16x32_bf16(__builtin_bit_cast(bf16x8, bw[n6]), A2, (f32x4){0.f, 0.f, 0.f, 0.f}, 0, 0, 0);
        const f32x4 vfv = unpack4(vf[n6]);
        f32x4 o;
#pragma unroll
        for (int j = 0; j < 4; ++j) o[j] = v[n6][j] + (vfv[j] - v[n6][j]) * sigm(v0[n6][j] + mv[j]);
        *(u32x2*)(WSP(bf16_t, OFF_RV) + ro + c) = pack4(o);
      }
    }
  }
}
__device__ __forceinline__ void prep_phase(const Params& P, unsigned char* smem, int l, volatile unsigned* blk  ) {
  unsigned* q = WSP(unsigned, OFF_QUEUE) + l * 128 + 80;
  for (;;) {
    __syncthreads();
    if (threadIdx.x == 0) blk[3] = __hip_atomic_fetch_add(q, 1u, __ATOMIC_RELAXED, __HIP_MEMORY_SCOPE_AGENT);
    __syncthreads();
    const int it = (int)blk[3];
    if (it >= 1090) break;
    if (it < 256) { const int wid = otid() >> 6; prep_rwkv_unit<false>(P, smem, l, it * 4 + (wid >> 1), wid & 1); }
    else if (it < 768) prep_gdn_prompt(P, l, it - 256);
    else if (it < 832) prep_gdn_sample(P, l, it - 768);
    else prep_hgrn(P, l, it - 832);
  }
  const bf16_t* p = WSP(bf16_t, OFF_P);
  for (int idx = obid() * 512 + otid(); idx < 136 * 1408; idx += gridDim.x * 512) {
    const int q = idx / 1408, col = idx - q * 1408;
    if (q < 8) P.out[O_SHIFT_P + (size_t)(l * 8 + q) * 1408 + col] = bf2f(p[(size_t)(q * TSEQ + TSEQ - 1) * PSTR + PB + col]);
    else P.out[O_SHIFT_S + (size_t)(l * 128 + (q - 8)) * 1408 + col] = bf2f(p[(size_t)(NTP + q - 8) * PSTR + PB + col]);
  }
}

template <int KIND> struct ScanCfg { static constexpr int STRIDE = KIND == 1 ? 356 : 164; };

template <int KIND> struct ScanPre { u32x2 a, b, c, d, v; f32x4 w; float g; };

template <int KIND>
__device__ __forceinline__ void scan_load(const Params& P, ScanPre<KIND>& r, int tid, int h, int half, int rowbase, int nvalid) {
  const int s = tid >> 4, j4 = (tid & 15) * 4;
  const int s2 = (tid >> 3) & 15, j2 = (tid & 7) * 4;
  const u32x2 z2 = {0u, 0u};
  const bool ok = s < nvalid, ok2 = (tid < 128) && (s2 < nvalid);
  if (KIND == 0) {
    const size_t o = (size_t)(rowbase + s) * 384 + h * 64 + j4;
    r.a = ok ? *(const u32x2*)(WSP(bf16_t, OFF_GK) + o) : z2;
    r.b = ok ? *(const u32x2*)(WSP(bf16_t, OFF_GQ) + o) : z2;
    r.v = ok2 ? *(const u32x2*)(WSP(bf16_t, OFF_GV) + (size_t)(rowbase + s2) * 384 + h * 64 + half * 32 + j2) : z2;
    const int sg = (tid >> 1) & 15;
    r.g = (tid < 32 && sg < nvalid) ? ((tid & 1) ? WSP(float, OFF_GBETA) : WSP(float, OFF_GDEC))[(size_t)(rowbase + sg) * 8 + h] : 0.f;
  } else if (KIND == 1) {
    const size_t o = (size_t)(rowbase + s) * 384 + h * 64 + j4;
    r.a = ok ? *(const u32x2*)(WSP(bf16_t, OFF_RR) + o) : z2;
    r.w = ok ? *(const f32x4*)(WSP(float, OFF_RW) + o) : (f32x4){0.f, 0.f, 0.f, 0.f};
    r.b = ok ? *(const u32x2*)(WSP(bf16_t, OFF_RK) + o) : z2;
    r.c = ok ? *(const u32x2*)(WSP(bf16_t, OFF_RKK) + o) : z2;
    r.d = ok ? *(const u32x2*)(WSP(bf16_t, OFF_RB) + o) : z2;
    r.v = ok2 ? *(const u32x2*)(WSP(bf16_t, OFF_RV) + (size_t)(rowbase + s2) * 384 + h * 64 + half * 32 + j2) : z2;
  } else {
    const size_t o = (size_t)(rowbase + s) * 256 + h * 64 + j4;
    r.a = ok ? *(const u32x2*)(WSP(bf16_t, OFF_HQ) + o) : z2;
    r.b = ok ? *(const u32x2*)(WSP(bf16_t, OFF_HK) + o) : z2;
    r.v = ok2 ? *(const u32x2*)(WSP(bf16_t, OFF_P) + (size_t)(rowbase + s2) * PSTR + PC + 512 + h * 64 + half * 32 + j2) : z2;
  }
}
template <int KIND>
__device__ __forceinline__ void scan_store(const ScanPre<KIND>& r, int tid, float* buf) {
  constexpr int STRIDE = ScanCfg<KIND>::STRIDE;
  const int s = tid >> 4, j4 = (tid & 15) * 4;
  const int s2 = (tid >> 3) & 15, j2 = (tid & 7) * 4;
  float* bs = buf + s * STRIDE + j4;
  if (KIND == 0) {
    const f32x4 k = unpack4(r.a), q = unpack4(r.b);
    *(f32x4*)(bs) = k; *(f32x4*)(bs + 64) = q;
    const float qk = row_sum16(dot4(q, k));
    if ((tid & 15) == 0) buf[s * STRIDE + 162] = qk;
    if (tid < 128) *(f32x4*)(buf + s2 * STRIDE + 128 + j2) = unpack4(r.v);
    if (tid < 32) buf[((tid >> 1) & 15) * STRIDE + 160 + (tid & 1)] = r.g;
  } else if (KIND == 1) {
    const f32x4 rr = unpack4(r.a), k = unpack4(r.b), kk = unpack4(r.c), bb = unpack4(r.d);
    *(f32x4*)(bs) = r.w * rr; *(f32x4*)(bs + 64) = r.w; *(f32x4*)(bs + 128) = k;
    *(f32x4*)(bs + 192) = kk; *(f32x4*)(bs + 256) = bb;
    const float br = row_sum16(dot4(bb, rr)), kr = row_sum16(dot4(k, rr));
    if ((tid & 15) == 0) { buf[s * STRIDE + 352] = br; buf[s * STRIDE + 353] = kr; }
    if (tid < 128) *(f32x4*)(buf + s2 * STRIDE + 320 + j2) = unpack4(r.v);
  } else {
    const f32x4 q = unpack4(r.a), k = unpack4(r.b);
    *(f32x4*)(bs) = q * (1.f - k); *(f32x4*)(bs + 64) = k;
    const float qk = row_sum16(dot4(q, k));
    if ((tid & 15) == 0) buf[s * STRIDE + 160] = qk;
    if (tid < 128) *(f32x4*)(buf + s2 * STRIDE + 128 + j2) = unpack4(r.v);
  }
}

template <int KIND> struct StepOps { f32x2 a[4], b[4], c[4], d[4], e[4]; float v, s0, s1, s2; };
template <int KIND>
__device__ __forceinline__ void step_load(StepOps<KIND>& o, const float* bs, int e0, int cl) {
#define LD8(dst, off) { const f32x4 _x = *(const f32x4*)(bs + (off) + e0), _y = *(const f32x4*)(bs + (off) + e0 + 4); \
    dst[0] = (f32x2){_x[0], _x[1]}; dst[1] = (f32x2){_x[2], _x[3]}; dst[2] = (f32x2){_y[0], _y[1]}; dst[3] = (f32x2){_y[2], _y[3]}; }
  if (KIND == 0) {
    LD8(o.a, 0) LD8(o.b, 64)
    o.v = bs[128 + cl];
    const f32x4 sc = *(const f32x4*)(bs + 160); o.s0 = sc[0]; o.s1 = sc[1]; o.s2 = sc[2];
  } else if (KIND == 1) {
    LD8(o.a, 0) LD8(o.b, 64) LD8(o.c, 128) LD8(o.d, 192) LD8(o.e, 256)
    o.v = bs[320 + cl];
    const f32x2 sc = *(const f32x2*)(bs + 352); o.s0 = sc[0]; o.s1 = sc[1];
  } else {
    LD8(o.a, 0) LD8(o.b, 64)
    o.v = bs[128 + cl]; o.s0 = bs[160];
  }
#undef LD8
}
template <int KIND>
__device__ __forceinline__ float step_compute(const StepOps<KIND>& o, f32x2 (&S)[4]) {
  if (KIND == 0) {
    f32x2 ks2 = o.a[0] * S[0], qs2 = o.b[0] * S[0];
#pragma unroll
    for (int i = 1; i < 4; ++i) { ks2 += o.a[i] * S[i]; qs2 += o.b[i] * S[i]; }
    float ks = ks2[0] + ks2[1], qs = qs2[0] + qs2[1];
    ks += dppf<0xB1>(ks); qs += dppf<0xB1>(qs); ks += dppf<0x4E>(ks); qs += dppf<0x4E>(qs); ks += dppf<0x141>(ks); qs += dppf<0x141>(qs);
    const float dec = o.s0, vn = o.s1 * (o.v - dec * ks);
#pragma unroll
    for (int i = 0; i < 4; ++i) S[i] = S[i] * dec + o.a[i] * vn;
    return dec * qs + vn * o.s2;
  } else if (KIND == 1) {
    f32x2 sa2 = o.d[0] * S[0], p2 = o.a[0] * S[0];
#pragma unroll
    for (int i = 1; i < 4; ++i) { sa2 += o.d[i] * S[i]; p2 += o.a[i] * S[i]; }
    float sa = sa2[0] + sa2[1], p1 = p2[0] + p2[1];
    sa += dppf<0xB1>(sa); p1 += dppf<0xB1>(p1); sa += dppf<0x4E>(sa); p1 += dppf<0x4E>(p1); sa += dppf<0x141>(sa); p1 += dppf<0x141>(p1);
    sa = -sa;
#pragma unroll
    for (int i = 0; i < 4; ++i) S[i] = S[i] * o.b[i] + (o.e[i] * sa + o.c[i] * o.v);
    return p1 + sa * o.s0 + o.v * o.s1;
  } else {
    f32x2 p2 = o.a[0] * S[0];
#pragma unroll
    for (int i = 1; i < 4; ++i) p2 += o.a[i] * S[i];
    float p1 = p2[0] + p2[1];
    p1 += dppf<0xB1>(p1); p1 += dppf<0x4E>(p1); p1 += dppf<0x141>(p1);
#pragma unroll
    for (int i = 0; i < 4; ++i) S[i] = S[i] + o.b[i] * (o.v - S[i]);
    return p1 + o.v * o.s0;
  }
}

template <int KIND>
__device__ __forceinline__ void scan_task(const Params& P, unsigned char* smem, int l, int seq, int h, int half, int mode) {
  constexpr int STRIDE = ScanCfg<KIND>::STRIDE, NEL = 16 * STRIDE;
  constexpr int NH = KIND == 2 ? 4 : 6;
  float* buf = (float*)smem;
  float* obuf = buf + 2 * NEL;
  const bool do_comp = mode != 2, do_stage = mode != 1;
  const int tid = otid() & 255, lane = tid & 63, wid = tid >> 6;
  const int col_l = lane >> 3, sub = lane & 7, cl = wid * 8 + col_l, col = half * 32 + cl, e0 = sub * 8;
  const bool sample = seq >= 8;
  const int R0 = sample ? NTP + (seq - 8) : seq * TSEQ, T = sample ? 1 : TSEQ;
  const int ocol = (KIND == 0 ? 0 : (KIND == 1 ? 384 : 768)) + h * 64 + half * 32;
  const size_t O_P = KIND == 0 ? O_GDN_P : (KIND == 1 ? O_RWKV_P : O_HGRN_P);
  const size_t O_S = KIND == 0 ? O_GDN_S : (KIND == 1 ? O_RWKV_S : O_HGRN_S);
  const int I_ST = KIND == 0 ? I_SGDN : (KIND == 1 ? I_SRWKV : I_SHGRN);
  const int nchunks = (T + 15) >> 4;
  bf16_t* oraw = WSP(bf16_t, OFF_P);
  f32x2 S[4];
#pragma unroll
  for (int i = 0; i < 4; ++i) S[i] = (f32x2){0.f, 0.f};
  if (sample && do_comp) {
    const float* st = P.in[I_ST] + ((size_t)(l * 128 + (seq - 8)) * NH + h) * 4096;
#pragma unroll
    for (int i = 0; i < 8; ++i) S[i >> 1][i & 1] = KIND == 1 ? st[col * 64 + e0 + i] : st[(e0 + i) * 64 + col];
  }
#pragma unroll
  for (int i = 0; i < 4; ++i) asm volatile("" : "+v"(S[i]));
  ScanPre<KIND> pre;
  __syncthreads();
  if (do_stage) {
    scan_load<KIND>(P, pre, tid, h, half, R0, T); scan_store<KIND>(pre, tid, buf);
    if (nchunks > 1) scan_load<KIND>(P, pre, tid, h, half, R0 + 16, T - 16);
  }
  __syncthreads();
  for (int c = 0; c < nchunks; ++c) {
    const int t0 = c * 16, n = (T - t0) < 16 ? (T - t0) : 16;
    if (do_stage) {
      if (c + 1 < nchunks) scan_store<KIND>(pre, tid, buf + ((c + 1) & 1) * NEL);
      if (c > 0) {
        const float* pob = obuf + ((c - 1) & 1) * 512;
        const int s = tid >> 4, cc = (tid & 15) * 2;
        const f32x2 ov = *(const f32x2*)(pob + s * 32 + cc);
        *(unsigned*)(oraw + (size_t)(R0 + t0 - 16 + s) * PSTR + ocol + cc) = pk2(ov[0], ov[1]);
      }
      if (c + 2 < nchunks) scan_load<KIND>(P, pre, tid, h, half, R0 + t0 + 32, T - t0 - 32);
    }
    if (do_comp) {
      const float* b = buf + (c & 1) * NEL;
      float* ob = obuf + (c & 1) * 512;
      if (n == 16) {
        StepOps<KIND> A, B;
        step_load<KIND>(A, b, e0, cl);
#pragma unroll
        for (int s = 0; s < 16; s += 2) {
          step_load<KIND>(B, b + (s + 1) * STRIDE, e0, cl);
          const float o0 = step_compute<KIND>(A, S);
          ob[s * 32 + cl] = o0;
          step_load<KIND>(A, b + (s + 2 < 16 ? s + 2 : 15) * STRIDE, e0, cl);
          const float o1 = step_compute<KIND>(B, S);
          ob[(s + 1) * 32 + cl] = o1;
        }
      } else {
        for (int s = 0; s < n; ++s) {
          StepOps<KIND> A;
          step_load<KIND>(A, b + s * STRIDE, e0, cl);
          const float o0 = step_compute<KIND>(A, S);
          ob[s * 32 + cl] = o0;
        }
      }
    }
    __syncthreads();
  }
  if (do_stage) {
    const int c = nchunks - 1, t0 = c * 16, n = T - t0;
    const float* pob = obuf + (c & 1) * 512;
    const int s = tid >> 4, cc = (tid & 15) * 2;
    const f32x2 ov = *(const f32x2*)(pob + s * 32 + cc);
    if (s < n) *(unsigned*)(oraw + (size_t)(R0 + t0 + s) * PSTR + ocol + cc) = pk2(ov[0], ov[1]);
  }
  if (do_comp) {
    float* so = P.out + (sample ? O_S + ((size_t)(l * 128 + (seq - 8)) * NH + h) * 4096 : O_P + ((size_t)(l * 8 + seq) * NH + h) * 4096);
#pragma unroll
    for (int i = 0; i < 8; ++i) { if (KIND == 1) so[col * 64 + e0 + i] = S[i >> 1][i & 1]; else so[(e0 + i) * 64 + col] = S[i >> 1][i & 1]; }
  }
}

__device__ __forceinline__ void scan_phase(const Params& P, unsigned char* smem, int l, volatile unsigned* blk  ) {
  unsigned* q = WSP(unsigned, OFF_QUEUE) + l * 128;
  const int grp = otid() >> 8;
  for (int pass = 0; pass < 2; ++pass) {
    unsigned* qq = pass == 1 ? q + 64 : q;
    const unsigned ntask = pass == 1 ? 2050u : 256u;
    for (;;) {
      __syncthreads();
      if (threadIdx.x == 0) blk[3] = __hip_atomic_fetch_add(qq, 1u, __ATOMIC_RELAXED, __HIP_MEMORY_SCOPE_AGENT);
      __syncthreads();
      const int t = (int)blk[3];
      if (t >= (int)ntask) break;
      int kind, seq, h, half, act; unsigned char* sm;
      if (pass == 0) {
        act = grp == 0 ? 1 : 2; sm = smem; half = t & 1;
        if (t < 96) { kind = 1; const int bh = t >> 1; seq = bh / 6; h = bh % 6; }
        else if (t < 192) { kind = 0; const int bh = (t - 96) >> 1; seq = bh / 6; h = bh % 6; }
        else { kind = 2; const int bh = (t - 192) >> 1; seq = bh / 4; h = bh % 4; }
      } else if (t < 2) {
        { const int wid = otid() >> 6; prep_rwkv_unit<true>(P, smem, l, (256 + t) * 4 + (wid >> 1), wid & 1); }
        asm volatile("s_waitcnt vmcnt(0)" ::: "memory");
        __syncthreads();
        if (threadIdx.x == 0) {
          __builtin_amdgcn_fence(__ATOMIC_RELEASE, "agent");
          asm volatile("s_waitcnt vmcnt(0)" ::: "memory");
          __hip_atomic_fetch_add(q + 88, 1u, __ATOMIC_RELAXED, __HIP_MEMORY_SCOPE_AGENT);
        }
        continue;
      } else {
        const int st = t - 2;
        act = 0; sm = smem + grp * 51200; half = grp;
        if (st < 1280) { const int s = st / 10, j = st - s * 10; seq = 8 + s; if (j < 6) { kind = 0; h = j; } else { kind = 2; h = j - 6; } }
        else {
          const int x = st - 1280, s = x / 6; seq = 8 + s; kind = 1; h = x - s * 6;
          if (threadIdx.x == 0) {
            unsigned sp = 0;
            while (__hip_atomic_load(q + 88, __ATOMIC_RELAXED, __HIP_MEMORY_SCOPE_AGENT) < 2u && ++sp < (1u << 22)) __builtin_amdgcn_s_sleep(2);
            __builtin_amdgcn_fence(__ATOMIC_ACQUIRE, "agent");
            asm volatile("s_waitcnt vmcnt(0)" ::: "memory");
          }
          __syncthreads();
        }
      }
      if (kind == 0) scan_task<0>(P, sm, l, seq, h, half, act);
      else if (kind == 1) scan_task<1>(P, sm, l, seq, h, half, act);
      else scan_task<2>(P, sm, l, seq, h, half, act);
    }
  }
  if (l + 1 < NLAYER) {
    for (;;) {
      __syncthreads();
      if (threadIdx.x == 0) blk[3] = __hip_atomic_fetch_add(q + 96, 1u, __ATOMIC_RELAXED, __HIP_MEMORY_SCOPE_AGENT);
      __syncthreads();
      const unsigned t = blk[3];
      if (t >= (unsigned)WCONV_JOBS) break;
      wconv_job(P, smem, l + 1, (int)t);
    }
  }
  if (l == 0) {
    for (;;) {
      __syncthreads();
      if (threadIdx.x == 0) blk[3] = __hip_atomic_fetch_add(q + 112, 1u, __ATOMIC_RELAXED, __HIP_MEMORY_SCOPE_AGENT);
      __syncthreads();
      const unsigned t = blk[3];
      if (t >= 2368u) break;
      wconv_job(P, smem, 0, 1024 + (int)t);
    }
  }
}

__device__ __forceinline__ void post_phase(const Params& P, int l) {
  const int lane = otid() & 63, wid = otid() >> 6, hl = lane >> 5, c2 = (lane & 31) * 2;
  const bf16_t* p = WSP(bf16_t, OFF_P);
  bf16_t* act = WSP(bf16_t, OFF_ACT);
  const int gw = obid() * 8 + wid, nw = gridDim.x * 8;
  const f32x2 gnw = *(const f32x2*)(P.in[I_GNW] + l * 64 + c2), hnw = *(const f32x2*)(P.in[I_HNW] + l * 64 + c2);
  for (int u0 = gw * 8; u0 < NTOK * 10; u0 += nw * 8) {
    unsigned o[4], z[4]; int oc[4]; size_t rb[4];
#pragma unroll
    for (int k = 0; k < 4; ++k) {
      const int u = u0 + 2 * k + hl, row = u / 10, q = u - row * 10;
      oc[k] = q < 6 ? q * 64 : 768 + (q - 6) * 64;
      const int zc = q < 6 ? 1152 + q * 64 : PC + 768 + (q - 6) * 64;
      rb[k] = (size_t)row;
      o[k] = *(const unsigned*)(p + (size_t)row * PSTR + oc[k] + c2);
      z[k] = *(const unsigned*)(p + (size_t)row * PSTR + zc + c2);
    }
#pragma unroll
    for (int k = 0; k < 4; ++k) {
      const float o0 = __uint_as_float(o[k] << 16), o1 = __uint_as_float(o[k] & 0xffff0000u);
      const float z0 = __uint_as_float(z[k] << 16), z1 = __uint_as_float(z[k] & 0xffff0000u);
      const float rn = rsqrtf(half_sum(o0 * o0 + o1 * o1) * (1.f / 64.f) + 1e-6f);
      const f32x2 w = oc[k] < 384 ? gnw : hnw;
      *(unsigned*)(act + rb[k] * 1024 + oc[k] + c2) = pk2(o0 * rn * w[0] * silu(z0), o1 * rn * w[1] * silu(z1));
    }
  }
  for (int u0 = gw * 4; u0 < NTOK * 6; u0 += nw * 4) {
    unsigned o[2], r[2], kx[2], v[2], g[2]; int hh[2]; size_t rb[2];
#pragma unroll
    for (int k = 0; k < 2; ++k) {
      const int u = u0 + 2 * k + hl, row = u / 6, h = u - row * 6;
      const size_t idx = (size_t)row * 384 + h * 64 + c2;
      hh[k] = h; rb[k] = (size_t)row;
      o[k] = *(const unsigned*)(p + (size_t)row * PSTR + 384 + h * 64 + c2);
      r[k] = *(const unsigned*)(WSP(bf16_t, OFF_RR) + idx); kx[k] = *(const unsigned*)(WSP(bf16_t, OFF_RK) + idx);
      v[k] = *(const unsigned*)(WSP(bf16_t, OFF_RV) + idx); g[k] = *(const unsigned*)(WSP(bf16_t, OFF_RG) + idx);
    }
#pragma unroll
    for (int k = 0; k < 2; ++k) {
      const int hc = l * 384 + hh[k] * 64 + c2;
      const f32x2 lw = *(const f32x2*)(P.in[I_LNW] + hc), lb = *(const f32x2*)(P.in[I_LNB] + hc), rkw = *(const f32x2*)(P.in[I_RK] + hc);
      const float o0 = __uint_as_float(o[k] << 16), o1 = __uint_as_float(o[k] & 0xffff0000u);
      const float r0 = __uint_as_float(r[k] << 16), r1 = __uint_as_float(r[k] & 0xffff0000u);
      const float k0 = __uint_as_float(kx[k] << 16), k1 = __uint_as_float(kx[k] & 0xffff0000u);
      const float v0 = __uint_as_float(v[k] << 16), v1 = __uint_as_float(v[k] & 0xffff0000u);
      const float g0 = __uint_as_float(g[k] << 16), g1 = __uint_as_float(g[k] & 0xffff0000u);
      const float mu = half_sum(o0 + o1) * (1.f / 64.f);
      const float y0 = o0 - mu, y1 = o1 - mu;
      const float rn = rsqrtf(half_sum(y0 * y0 + y1 * y1) * (1.f / 64.f) + 64e-5f);
      const float rk = half_sum(r0 * k0 * rkw[0] + r1 * k1 * rkw[1]);
      *(unsigned*)(act + rb[k] * 1024 + 384 + hh[k] * 64 + c2) = pk2((y0 * rn * lw[0] + lb[0] + rk * v0) * g0, (y1 * rn * lw[1] + lb[1] + rk * v1) * g1);
    }
  }
}

#define XB_TMO      128
#define XB_XCNT(j)  (256  + 64 * (j))
#define XB_XSUB(j)  (1280 + 64 * (j))
#define XB_XGEN(j)  (2304 + 64 * (j))
#define XB_TOP      3328
#define XB_TOPGEN   3392
#define XCD_BAR_WORDS 3456
#define XB_SPIN_CAP (1u << 20)
#define LAS __attribute__((address_space(3)))
__device__ __forceinline__ unsigned xb_ld(unsigned* p)              { return __hip_atomic_load(p, __ATOMIC_RELAXED, __HIP_MEMORY_SCOPE_AGENT); }
__device__ __forceinline__ unsigned xb_add(unsigned* p, unsigned v) { return __hip_atomic_fetch_add(p, v, __ATOMIC_RELAXED, __HIP_MEMORY_SCOPE_AGENT); }
__device__ __forceinline__ unsigned xb_xcc_id() { return (unsigned)__builtin_amdgcn_s_getreg((3 << 11) | 20) & 0xFu; }
#define XB_SPIN(cond, bar) do { unsigned _sp = 0; while (cond) { __builtin_amdgcn_s_sleep(1); \
    if ((++_sp & 255u) == 0u) { if (xb_ld(&(bar)[XB_TMO])) break; if (_sp > XB_SPIN_CAP) { atomicAdd(&(bar)[XB_TMO], 1u); break; } } } } while (0)
struct XcdBarrier { unsigned* bar; unsigned x; volatile LAS unsigned* st; };
__device__ __forceinline__ XcdBarrier xcd_barrier_post(unsigned* bar, volatile LAS unsigned* st) {
  XcdBarrier b; b.bar = bar; b.x = xb_xcc_id(); b.st = st;
  if (threadIdx.x == 0) (void)xb_add(&bar[XB_XCNT(b.x)], 1u);
  return b;
}
__device__ __forceinline__ void xcd_barrier_complete(unsigned* bar, unsigned x, unsigned& nloc, unsigned& nx) {
  const unsigned G = gridDim.x * gridDim.y * gridDim.z;
  unsigned sum, cnt, mine, sp = 0u;
  for (;;) {
    sum = 0u; cnt = 0u; mine = 0u;
#pragma unroll
    for (unsigned j = 0; j < 16; ++j) { const unsigned c = xb_ld(&bar[XB_XCNT(j)]); sum += c; cnt += (c > 0u) ? 1u : 0u; mine = (j == x) ? c : mine; }
    if (sum == G) break;
    __builtin_amdgcn_s_sleep(1);
    if ((++sp & 255u) == 0u) { if (xb_ld(&bar[XB_TMO])) break; if (sp > XB_SPIN_CAP) { atomicAdd(&bar[XB_TMO], 1u); break; } }
  }
  nloc = mine > 0u ? mine : 1u; nx = cnt > 0u ? cnt : 1u;
}
__device__ __forceinline__ void xcd_barrier(const XcdBarrier& b) {
  asm volatile("s_waitcnt vmcnt(0)" ::: "memory");
  __syncthreads();
  if (threadIdx.x == 0) {
    unsigned* bar = b.bar;
    __builtin_amdgcn_s_waitcnt(0);
    unsigned nloc = b.st[0], nx = b.st[1];
    if (nloc == 0u) { xcd_barrier_complete(bar, b.x, nloc, nx); b.st[0] = nloc; b.st[1] = nx; }
    const unsigned old = xb_add(&bar[XB_XSUB(b.x)], 1u);
    const unsigned gen = old / nloc;
    if (old + 1u == (gen + 1u) * nloc) {
      __builtin_amdgcn_fence(__ATOMIC_RELEASE, "agent");
      asm volatile("s_waitcnt vmcnt(0)" ::: "memory");
      const unsigned og = xb_add(&bar[XB_TOP], 1u);
      const unsigned tg = og / nx;
      if (og + 1u == (tg + 1u) * nx) xb_add(&bar[XB_TOPGEN], 1u);
      else XB_SPIN(xb_ld(&bar[XB_TOPGEN]) == tg, bar);
      __builtin_amdgcn_fence(__ATOMIC_ACQUIRE, "agent");
      xb_add(&bar[XB_XGEN(b.x)], 1u);
      asm volatile("s_waitcnt vmcnt(0)" ::: "memory");
    } else {
      XB_SPIN(xb_ld(&bar[XB_XGEN(b.x)]) == gen, bar);
      __builtin_amdgcn_fence(__ATOMIC_ACQUIRE, "agent");
      asm volatile("s_waitcnt vmcnt(0)" ::: "memory");
    }
  }
  __syncthreads();
}

__global__ void __launch_bounds__(512, 2) hybrid_fwd(Params P) {
  cg::grid_group grid = cg::this_grid();
  __shared__ __attribute__((aligned(16))) unsigned char smem[131072 + 64];
  uint4& xb_words = *(uint4*)(smem + 131072);
  if (threadIdx.x == 0) xb_words = make_uint4(0u, 0u, 0u, 0u);
  __syncthreads();
  const XcdBarrier xb = xcd_barrier_post(WSP(unsigned, OFF_BAR), (volatile LAS unsigned*)&xb_words);
  if (threadIdx.x == 0) {
    const unsigned hw = (unsigned)__builtin_amdgcn_s_getreg((7 << 11) | (8 << 6) | 4) & 0xffu;
    const unsigned key = (xb.x << 8) | hw;
    ((volatile unsigned*)&xb_words)[2] = __hip_atomic_fetch_add(WSP(unsigned, OFF_CUTAB) + key, 1u, __ATOMIC_RELAXED, __HIP_MEMORY_SCOPE_AGENT);
  }
  __syncthreads();
#pragma unroll 1
  for (int step = 0; step < NLAYER * 9; ++step) {
    const int l = step / 9, ph = step - l * 9;
    switch (ph) {
      case 0: if (l == 0) wconv_phase(P, smem, 0); norm_phase(P, l, P.in[I_NORM_MIX] + l * D); break;
      case 1: gemm_phase<EPI_P>(P, smem, WSP(bf16_t, OFF_ACT), 1024, WSP(bf16_t, OFF_WTIN), 1024, 32, l, 4096);
              gemm_sample<EPI_P>(P, smem, WSP(bf16_t, OFF_ACT), 1024, WSP(bf16_t, OFF_WTIN), 1024, 249, l); break;
      case 2: prep_phase(P, smem, l, (volatile unsigned*)&xb_words); break;
      case 3: scan_phase(P, smem, l, (volatile unsigned*)&xb_words); break;
      case 4: post_phase(P, l); break;
      case 5: gemm_phase<EPI_RES>(P, smem, WSP(bf16_t, OFF_ACT), 1024, WSP(bf16_t, wt_out_off(l)), 1024, 8, l, 1024);
              gemm_sample<EPI_RES>(P, smem, WSP(bf16_t, OFF_ACT), 1024, WSP(bf16_t, wt_out_off(l)), 1024, 64, l); break;
      case 6: norm_phase(P, 1, P.in[I_NORM_FFN] + l * D); break;
      case 7: gemm_phase<EPI_SWIGLU>(P, smem, WSP(bf16_t, OFF_ACT), 1024, WSP(bf16_t, wt_gu_off(l)), 1024, 44, 1, 5632);
              gemm_sample<EPI_SWIGLU>(P, smem, WSP(bf16_t, OFF_ACT), 1024, WSP(bf16_t, wt_gu_off(l)), 1024, 176, 1); break;
      default: gemm_phase<EPI_RES>(P, smem, WSP(bf16_t, OFF_P), DFF, WSP(bf16_t, wt_dn_off(l)), DFF, 8, 1, 1024);
               gemm_sample<EPI_RES>(P, smem, WSP(bf16_t, OFF_P), DFF, WSP(bf16_t, wt_dn_off(l)), DFF, 64, 1); break;
    }
    if (step == 0) grid.sync();
    else xcd_barrier(xb);
  }
  final_norm_phase(P);
}

extern "C" void kernel_launch(void* const* d_in, const int* in_sizes, int n_in,
                              void* d_out, int out_size, void* d_ws, size_t ws_size,
                              hipStream_t stream) {
  static int grid_blocks = 0;
  if (!grid_blocks) {
    int dev = 0, cus = 0, per_cu = 0;
    (void)hipGetDevice(&dev);
    (void)hipDeviceGetAttribute(&cus, hipDeviceAttributeMultiprocessorCount, dev);
    (void)hipOccupancyMaxActiveBlocksPerMultiprocessor(&per_cu, hybrid_fwd, 512, 0);
    if (per_cu > 1) per_cu = 1;
    if (per_cu < 1) per_cu = 1;
    grid_blocks = cus * per_cu;
  }
  if (ws_size < WS_NEED) { fprintf(stderr, "workspace too small: %zu < %zu\n", ws_size, (size_t)WS_NEED); return; }
  Params p{};
  for (int i = 0; i < N_IN; ++i) p.in[i] = (const float*)d_in[i];
  p.out = (float*)d_out;
  p.ws = (unsigned char*)d_ws;
  (void)hipMemsetAsync((unsigned char*)d_ws + OFF_BAR, 0, BAR_BYTES, stream);
  void* args[] = {&p};
  hipError_t e = hipLaunchCooperativeKernel((void*)hybrid_fwd, dim3(grid_blocks), dim3(512), args, 0, stream);
  if (e != hipSuccess) fprintf(stderr, "cooperative launch failed: %s (grid %d)\n", hipGetErrorString(e), grid_blocks);
}
```

```cpp
#include <hip/hip_runtime.h>
#include <hip/hip_cooperative_groups.h>
#include <cstdio>
namespace cg = cooperative_groups;

typedef unsigned short bf16_t;
typedef short bf16x8 __attribute__((ext_vector_type(8)));
typedef float f32x4 __attribute__((ext_vector_type(4)));
typedef unsigned u32x4 __attribute__((ext_vector_type(4)));
typedef unsigned u32x2 __attribute__((ext_vector_type(2)));

constexpr int D = 1024, NTP = 16384, NTS = 128, NTOK = 16512, TSEQ = 2048, NLAYER = 4;
constexpr int IN_COLS = 3980, PSTR = 3984, DFF = 2816;
constexpr int PB = 1548, PC = 2956;

enum { I_XP = 0, I_XS, I_SGDN, I_SCONV, I_SRWKV, I_SSHIFT, I_SHGRN, I_NORM_MIX, I_WIN, I_WOUT, I_CONVW, I_ALOG, I_DTB, I_GNW,
       I_MU, I_W0, I_W2, I_A0, I_A2, I_G2, I_V0, I_V1, I_V2, I_KK, I_KA, I_RK, I_LNW, I_LNB, I_HLB, I_HNW, I_NORM_FFN,
       I_WG, I_WU, I_WD, I_NORM_FINAL, N_IN };

constexpr size_t O_YP = 0, O_YS = 16777216, O_GDN_P = 16908288, O_GDN_S = 17694720, O_CONV_P = 30277632, O_CONV_S = 30388224,
                 O_RWKV_P = 32157696, O_RWKV_S = 32944128, O_SHIFT_P = 45527040, O_SHIFT_S = 45572096, O_HGRN_P = 46292992,
                 O_HGRN_S = 46817280;

constexpr size_t SZ_WTIN = (size_t)4096 * 1024 * 2, SZ_WTOUT = (size_t)1024 * 1024 * 2, SZ_WTGU = (size_t)5632 * 1024 * 2,
                 SZ_WTDN = (size_t)1024 * 2816 * 2, SZ_P = (size_t)NTOK * PSTR * 2, SZ_ACT = (size_t)NTOK * 1024 * 2,
                 SZ_T384 = (size_t)NTOK * 384 * 2, SZ_T8F = (size_t)NTOK * 8 * 4, SZ_T256 = (size_t)NTOK * 256 * 2,
                 SZ_T384F = (size_t)NTOK * 384 * 4;
constexpr size_t OFF_WTIN = 0, OFF_WTOUT = OFF_WTIN + SZ_WTIN, OFF_WTGU = OFF_WTOUT + SZ_WTOUT, OFF_WTDN = OFF_WTGU + SZ_WTGU,
                 OFF_P = OFF_WTDN + SZ_WTDN, OFF_ACT = OFF_P + SZ_P, OFF_GQ = OFF_ACT + SZ_ACT, OFF_GK = OFF_GQ + SZ_T384,
                 OFF_GV = OFF_GK + SZ_T384, OFF_GDEC = OFF_GV + SZ_T384, OFF_GBETA = OFF_GDEC + SZ_T8F, OFF_HQ = OFF_GBETA + SZ_T8F,
                 OFF_HK = OFF_HQ + SZ_T256, OFF_RR = OFF_HK + SZ_T256, OFF_RK = OFF_RR + SZ_T384, OFF_RV = OFF_RK + SZ_T384,
                 OFF_RKK = OFF_RV + SZ_T384, OFF_RB = OFF_RKK + SZ_T384, OFF_RG = OFF_RB + SZ_T384, OFF_RW = OFF_RG + SZ_T384,
                 OFF_VF = OFF_RW + SZ_T384F, OFF_LORA = OFF_VF + SZ_T384, OFF_WTOUT2 = OFF_LORA + 245760, OFF_WTGU2 = OFF_WTOUT2 + SZ_WTOUT, OFF_WTDN2 = OFF_WTGU2 + SZ_WTGU, OFF_BAR = OFF_WTDN2 + SZ_WTDN, OFF_CUTAB = OFF_BAR + 16384, OFF_QUEUE = OFF_CUTAB + 16384, BAR_BYTES = 16384 + 16384 + 4096, WS_NEED = OFF_BAR + BAR_BYTES;
constexpr int W2T = 0, A2T = 24576, G2T = 49152, V1T = 98304, V2T = 110592;

struct Params {
  const float* in[N_IN];
  float* out;
  unsigned char* ws;
};

#define WSP(T, off) ((T*)(P.ws + (off)))

__device__ __forceinline__ int otid() { int t = __builtin_amdgcn_workitem_id_x(); asm volatile("" : "+v"(t)); return t; }
__device__ __forceinline__ int obid() { int b = __builtin_amdgcn_workgroup_id_x(); asm volatile("" : "+s"(b)); return b; }
template <class T> __device__ __forceinline__ const T* opq(const T* p) { asm volatile("" : "+s"(p)); return p; }
__device__ __forceinline__ float bf2f(bf16_t h) { return __uint_as_float(((unsigned)h) << 16); }
typedef float f32x2_t __attribute__((ext_vector_type(2)));
typedef __bf16 bf16x2_t __attribute__((ext_vector_type(2)));
__device__ __forceinline__ unsigned pk2(float lo, float hi) {
  const f32x2_t v = {lo, hi};
  return __builtin_bit_cast(unsigned, __builtin_convertvector(v, bf16x2_t));
}
__device__ __forceinline__ bf16_t f2bf(float f) { return (bf16_t)(pk2(f, 0.f) & 0xffffu); }
__device__ __forceinline__ float sigm(float x) { return 1.f / (1.f + __expf(-x)); }
__device__ __forceinline__ float silu(float x) { return x / (1.f + __expf(-x)); }
__device__ __forceinline__ float softplus(float x) { return x > 20.f ? x : log1pf(__expf(x)); }
template <int CTRL> __device__ __forceinline__ float dppf(float x) {
  return __builtin_bit_cast(float, __builtin_amdgcn_mov_dpp(__builtin_bit_cast(int, x), CTRL, 0xf, 0xf, true));
}
__device__ __forceinline__ float wave_sum(float v) {
  v += dppf<0xB1>(v); v += dppf<0x4E>(v); v += dppf<0x141>(v); v += dppf<0x140>(v);
  const int iv = __builtin_bit_cast(int, v);
  const float s0 = __builtin_bit_cast(float, __builtin_amdgcn_readlane(iv, 0)), s1 = __builtin_bit_cast(float, __builtin_amdgcn_readlane(iv, 16));
  const float s2 = __builtin_bit_cast(float, __builtin_amdgcn_readlane(iv, 32)), s3 = __builtin_bit_cast(float, __builtin_amdgcn_readlane(iv, 48));
  return (s0 + s1) + (s2 + s3);
}
typedef float f32x2 __attribute__((ext_vector_type(2)));
__device__ __forceinline__ float row_sum16(float v) { v += dppf<0xB1>(v); v += dppf<0x4E>(v); v += dppf<0x141>(v); v += dppf<0x140>(v); return v; }
__device__ __forceinline__ float half_sum(float v) { v = row_sum16(v); return v + __shfl_xor(v, 16); }
__device__ __forceinline__ float reduce8(float x) { x += dppf<0xB1>(x); x += dppf<0x4E>(x); x += dppf<0x141>(x); return x; }

__device__ __forceinline__ f32x4 unpack4(u32x2 w) {
  f32x4 f; f[0] = __uint_as_float(w[0] << 16); f[1] = __uint_as_float(w[0] & 0xffff0000u);
  f[2] = __uint_as_float(w[1] << 16); f[3] = __uint_as_float(w[1] & 0xffff0000u); return f;
}
__device__ __forceinline__ bf16x8 pack8(f32x4 a, f32x4 b) {
  u32x4 u; u[0] = pk2(a[0], a[1]); u[1] = pk2(a[2], a[3]); u[2] = pk2(b[0], b[1]); u[3] = pk2(b[2], b[3]);
  return __builtin_bit_cast(bf16x8, u);
}
__device__ __forceinline__ u32x2 pack4(f32x4 a) { u32x2 u; u[0] = pk2(a[0], a[1]); u[1] = pk2(a[2], a[3]); return u; }
__device__ __forceinline__ float dot4(f32x4 a, f32x4 b) { return (a[0] * b[0] + a[1] * b[1]) + (a[2] * b[2] + a[3] * b[3]); }
__device__ __forceinline__ const float* xin_row(const Params& P, int l, int row) {
  const float* po = opq((const float*)P.out); const float* pp = opq(P.in[I_XP]); const float* ps = opq(P.in[I_XS]);
  if (l > 0) return po + (size_t)row * D;
  return row < NTP ? pp + (size_t)row * D : ps + (size_t)(row - NTP) * D;
}

__device__ __forceinline__ int gu_row(int c, int up) { return (c >> 7) * 256 + up * 128 + (c & 127); }
__device__ __forceinline__ void xpose_tile(unsigned char* smem, const float* __restrict__ W, int N, int kt, int ntl, bf16_t* __restrict__ dst, int dstK, int mode) {
  float (*tile)[65] = (float (*)[65])smem;
  const int tid = otid();
  __syncthreads();
#pragma unroll 4
  for (int i = 0; i < 8; ++i) {
    const int k = i * 8 + (tid >> 6), n = tid & 63, gn = ntl * 64 + n;
    tile[k][n] = gn < N ? W[(size_t)(kt * 64 + k) * N + gn] : 0.f;
  }
  __syncthreads();
#pragma unroll 4
  for (int i = 0; i < 4; ++i) {
    const int n = i * 16 + (tid >> 5), k = (tid & 31) * 2, gn = ntl * 64 + n;
    const int drow = mode == 0 ? gn : gu_row(gn, mode - 1);
    *(unsigned*)(dst + (size_t)drow * dstK + kt * 64 + k) = pk2(tile[k][n], tile[k + 1][n]);
  }
}
constexpr int WCONV_JOBS = 3392 + 480;
__device__ __forceinline__ size_t wt_out_off(int l) { return (l & 1) ? OFF_WTOUT2 : OFF_WTOUT; }
__device__ __forceinline__ size_t wt_gu_off(int l) { return (l & 1) ? OFF_WTGU2 : OFF_WTGU; }
__device__ __forceinline__ size_t wt_dn_off(int l) { return (l & 1) ? OFF_WTDN2 : OFF_WTDN; }
__device__ __forceinline__ void wconv_job(const Params& P, unsigned char* smem, int l, int job) {
  if (job < 1024) xpose_tile(smem, P.in[I_WIN] + (size_t)l * 1024 * IN_COLS, IN_COLS, job & 15, job >> 4, WSP(bf16_t, OFF_WTIN), 1024, 0);
  else if (job < 1280) { const int j = job - 1024; xpose_tile(smem, P.in[I_WOUT] + (size_t)l * 1024 * 1024, 1024, j & 15, j >> 4, WSP(bf16_t, wt_out_off(l)), 1024, 0); }
  else if (job < 1984) { const int j = job - 1280; xpose_tile(smem, P.in[I_WG] + (size_t)l * 1024 * DFF, DFF, j & 15, j >> 4, WSP(bf16_t, wt_gu_off(l)), 1024, 1); }
  else if (job < 2688) { const int j = job - 1984; xpose_tile(smem, P.in[I_WU] + (size_t)l * 1024 * DFF, DFF, j & 15, j >> 4, WSP(bf16_t, wt_gu_off(l)), 1024, 2); }
  else if (job < 3392) { const int j = job - 2688; xpose_tile(smem, P.in[I_WD] + (size_t)l * DFF * 1024, 1024, j % 44, j / 44, WSP(bf16_t, wt_dn_off(l)), DFF, 0); }
  else {
    bf16_t* lw = WSP(bf16_t, OFF_LORA);
    const int idx = (job - 3392) * 256 + (otid() & 255);
    float v = 0.f;
    const float* pw2 = opq(P.in[I_W2]); const float* pa2 = opq(P.in[I_A2]); const float* pg2 = opq(P.in[I_G2]);
    const float* pv1 = opq(P.in[I_V1]); const float* pv2 = opq(P.in[I_V2]);
    if (idx < A2T) { const int n = idx >> 6, k = idx & 63; v = pw2[(size_t)l * 64 * 384 + k * 384 + n]; }
    else if (idx < G2T) { const int i = idx - A2T, n = i >> 6, k = i & 63; v = pa2[(size_t)l * 64 * 384 + k * 384 + n]; }
    else if (idx < V1T) { const int i = idx - G2T, n = i >> 7, k = i & 127; v = pg2[(size_t)l * 128 * 384 + k * 384 + n]; }
    else if (idx < V2T) { if (l > 0) { const int i = idx - V1T, n = i / 384, k = i - n * 384; v = pv1[(size_t)(l - 1) * 384 * 32 + k * 32 + n]; } }
    else { if (l > 0) { const int i = idx - V2T, n = i >> 5, k = i & 31; v = pv2[(size_t)(l - 1) * 32 * 384 + k * 384 + n]; } }
    if (otid() < 256) lw[idx] = f2bf(v);
  }
}
__device__ __forceinline__ void wconv_phase(const Params& P, unsigned char* smem, int l) {
  for (int j = obid(); j < 1024 + 480; j += gridDim.x) wconv_job(P, smem, l, j < 1024 ? j : j + 2368);
}

template <int NR, bool FINAL>
__device__ __forceinline__ void norm_rows(const Params& P, int l_in, const f32x4 (&wv)[4], int lane, int r0, int extra_row) {
  f32x4 v[NR][4];
#pragma unroll
  for (int r = 0; r < NR; ++r) {
    const int row = (NR == 5 && r == 4) ? extra_row : r0 + r;
    const float* xr = FINAL ? (const float*)(P.out + (size_t)row * D) : xin_row(P, l_in, row);
#pragma unroll
    for (int i = 0; i < 4; ++i) v[r][i] = *(const f32x4*)(xr + i * 256 + lane * 4);
  }
#pragma unroll
  for (int r = 0; r < NR; ++r) {
    const int row = (NR == 5 && r == 4) ? extra_row : r0 + r;
    float ss = 0.f;
#pragma unroll
    for (int i = 0; i < 4; ++i) ss += dot4(v[r][i], v[r][i]);
    const float rstd = rsqrtf(wave_sum(ss) * (1.f / 1024.f) + 1e-6f);
#pragma unroll
    for (int i = 0; i < 4; ++i) {
      if (FINAL) *(f32x4*)(P.out + (size_t)row * D + i * 256 + lane * 4) = v[r][i] * rstd * wv[i];
      else *(u32x2*)(WSP(bf16_t, OFF_ACT) + (size_t)row * 1024 + i * 256 + lane * 4) = pack4(v[r][i] * rstd * wv[i]);
    }
  }
}
template <bool FINAL>
__device__ __forceinline__ void norm_any(const Params& P, int l_in, const float* __restrict__ w) {
  const int lane = otid() & 63, wid = otid() >> 6;
  f32x4 wv[4];
#pragma unroll
  for (int i = 0; i < 4; ++i) wv[i] = *(const f32x4*)(w + i * 256 + lane * 4);
  const int nw = gridDim.x * 8;
  for (int gw = obid() * 8 + wid; gw * 8 < NTP; gw += nw) {
    norm_rows<4, FINAL>(P, l_in, wv, lane, gw * 8, 0);
    if (gw < NTS) norm_rows<5, FINAL>(P, l_in, wv, lane, gw * 8 + 4, NTP + gw);
    else norm_rows<4, FINAL>(P, l_in, wv, lane, gw * 8 + 4, 0);
  }
}
__device__ __forceinline__ void norm_phase(const Params& P, int l_in, const float* __restrict__ w) { norm_any<false>(P, l_in, w); }
__device__ __forceinline__ void final_norm_phase(const Params& P) { norm_any<true>(P, 1, P.in[I_NORM_FINAL]); }

enum { EPI_P = 0, EPI_RES = 1, EPI_SWIGLU = 2 };
namespace pg8 {
constexpr int BM = 256, BK = 64, HALF = 128, HTB = HALF * BK * 2, NXCD = 8, WGM = 8;
__device__ __forceinline__ int lds_byte(int r, int c) { const int st = (r >> 4) * 2 + (c >> 5), rr = r & 15, cc = c & 31, ob = rr * 64 + cc * 2; return st * 1024 + (ob ^ (((ob >> 9) & 1) << 5)); }
__device__ __forceinline__ void stage_rc(int b, int& R, int& C) { const int st = b / 1024, sb = b % 1024, swz = sb ^ (((sb >> 9) & 1) << 5); R = (st >> 1) * 16 + swz / 64; C = (st & 1) * 32 + (swz % 64) / 2; }
__device__ __forceinline__ int perm32(int rho) { const int n = rho >> 4, i = rho & 15; return 8 * (i >> 2) + 4 * n + (i & 3); }
struct Unit { int pm, pn; };
struct StaticOrder {
  int nM, nN, nwg, G, c;
  __device__ __forceinline__ void init(int M, int N, int G_, int c_) { nM = M / BM; nN = N / BM; nwg = nM * nN; G = G_; c = c_; }
  __device__ __forceinline__ bool next(int i, Unit& u) const {
    const long L = (long)i * G + c; if (L >= nwg) return false;
    int wgid = (int)L; { const int q = nwg / NXCD, r = nwg % NXCD, xcd = wgid % NXCD, off = wgid / NXCD; wgid = (xcd < r ? xcd * (q + 1) : r * (q + 1) + (xcd - r) * q) + off; }
    const int nig = WGM * nN, gid = wgid / nig, fm = gid * WGM, gsz = (nM - fm) < WGM ? (nM - fm) : WGM;
    u.pm = fm + ((wgid % nig) % gsz); u.pn = (wgid % nig) / gsz; return true;
  }
};
}

template <int EPI>
__device__ __forceinline__ void gemm_epilogue(const Params& P, const f32x4 (&acc)[2][2][4][2], const pg8::Unit& u, int wr, int wc, int fr, int fq, int l) {
#pragma unroll
  for (int ai = 0; ai < 2; ++ai)
#pragma unroll
    for (int m = 0; m < 4; ++m) {
      const int row = u.pm * 256 + ai * 128 + wr * 64 + m * 16 + fr;
      if (EPI == EPI_P) {
        bf16_t* pr = WSP(bf16_t, OFF_P) + (size_t)row * PSTR;
#pragma unroll
        for (int bj = 0; bj < 2; ++bj) {
          const int col = u.pn * 256 + bj * 128 + wc * 32 + fq * 8;
          if (col < PSTR) { const u32x2 lo = pack4(acc[ai][bj][m][0]), hi = pack4(acc[ai][bj][m][1]); *(u32x4*)(pr + col) = (u32x4){lo[0], lo[1], hi[0], hi[1]}; }
        }
      } else if (EPI == EPI_RES) {
        const float* xi = xin_row(P, l, row);
        float* xo = P.out + (size_t)row * D;
#pragma unroll
        for (int bj = 0; bj < 2; ++bj)
#pragma unroll
          for (int n = 0; n < 2; ++n) {
            const int col = u.pn * 256 + bj * 128 + wc * 32 + n * 16 + fq * 4;
            *(f32x4*)(xo + col) = *(const f32x4*)(xi + col) + acc[ai][bj][m][n];
          }
      } else {
        bf16_t* ur = WSP(bf16_t, OFF_P) + (size_t)row * DFF;
        {
          const int col = u.pn * 128 + wc * 32 + fq * 8;
          f32x4 r0, r1;
#pragma unroll
          for (int j = 0; j < 4; ++j) { r0[j] = silu(acc[ai][0][m][0][j]) * acc[ai][1][m][0][j]; r1[j] = silu(acc[ai][0][m][1][j]) * acc[ai][1][m][1][j]; }
          const u32x2 lo = pack4(r0), hi = pack4(r1);
          *(u32x4*)(ur + col) = (u32x4){lo[0], lo[1], hi[0], hi[1]};
        }
      }
    }
}

#define PG8_LAS __attribute__((address_space(3)))
template <int EPI>
__device__ __forceinline__ void gemm_phase(const Params& P, unsigned char* smem, const bf16_t* __restrict__ Ag, int lda_unused, const bf16_t* __restrict__ Btg, int K, int nN128_unused, int l, int N) {
  using namespace pg8;
  PG8_LAS unsigned char* lds = (PG8_LAS unsigned char*)smem;
  const int tid = otid(), wid = __builtin_amdgcn_readfirstlane(tid >> 6), lane = tid & 63, wr = wid >> 2, wc = wid & 3, fr = lane & 15, fq = lane >> 4;
  const int nt = K / BK;
  StaticOrder S; S.init(NTP, N, (int)gridDim.x, obid());
  unsigned voffA[2], voffB[2];
#pragma unroll
  for (int i = 0; i < 2; ++i) { int R, C; stage_rc(tid * 16 + i * 8192, R, C); const int Rb = EPI == EPI_RES ? R : ((R & ~31) + perm32(R & 31));
    voffA[i] = (unsigned)(R * K + C) * 2u; voffB[i] = (unsigned)(Rb * K + C) * 2u; }
  const size_t kstep = (size_t)(BK * 2);
  const size_t hstep = (size_t)HALF * K * 2;
  const size_t tstep = 2 * hstep;
  const unsigned ldsw = (unsigned)wid * 1024u;
  const int aoff = lds_byte(wr * 64 + fr, fq * 8), boff = lds_byte(wc * 32 + fr, fq * 8);
#define PG8_SA(b, h) (((b) * 2 + (h)) * HTB)
#define PG8_SB(b, h) ((4 + (b) * 2 + (h)) * HTB)
#define PG8_STAGE(bufoff, gbase, voff) do { _Pragma("unroll") for (int _i = 0; _i < 2; ++_i) \
        __builtin_amdgcn_global_load_lds((const unsigned*)((const char*)(gbase) + (voff)[_i]), (PG8_LAS unsigned*)(lds + (bufoff) + ldsw + _i * 8192), 16, 0, 0); } while (0)
#define PG8_LDA(dst, b, h) do { _Pragma("unroll") for (int m = 0; m < 4; ++m) _Pragma("unroll") for (int k = 0; k < 2; ++k) dst[m][k] = *(const PG8_LAS bf16x8*)(lds + PG8_SA(b, h) + aoff + m * 2048 + k * 1024); } while (0)
#define PG8_LDB(dst, b, h) do { _Pragma("unroll") for (int n = 0; n < 2; ++n) _Pragma("unroll") for (int k = 0; k < 2; ++k) dst[n][k] = *(const PG8_LAS bf16x8*)(lds + PG8_SB(b, h) + boff + n * 2048 + k * 1024); } while (0)
#define PG8_MMA(ai, bj, At, Bt) do { __builtin_amdgcn_s_setprio(1); _Pragma("unroll") for (int m = 0; m < 4; ++m) _Pragma("unroll") for (int n = 0; n < 2; ++n) _Pragma("unroll") for (int k = 0; k < 2; ++k) \
        acc[ai][bj][m][n] = __builtin_amdgcn_mfma_f32_16x16x32_bf16(Bt[n][k], At[m][k], acc[ai][bj][m][n], 0, 0, 0); __builtin_amdgcn_s_setprio(0); } while (0)
#define PG8_WAIT_V(n) asm volatile("s_waitcnt vmcnt(" #n ")" ::: "memory")
#define PG8_WAIT_L(n) asm volatile("s_waitcnt lgkmcnt(" #n ")" ::: "memory")
#define PG8_BAR __builtin_amdgcn_s_barrier()
#define PG8_SCHED __builtin_amdgcn_sched_barrier(0)
  Unit cur, nxt; int ui = 0;
  if (!S.next(0, cur)) return;
  f32x4 acc[2][2][4][2];
#pragma unroll
  for (int a = 0; a < 2; ++a)
#pragma unroll
    for (int b = 0; b < 2; ++b)
#pragma unroll
      for (int m = 0; m < 4; ++m)
#pragma unroll
        for (int n = 0; n < 2; ++n) acc[a][b][m][n] = (f32x4){0.f, 0.f, 0.f, 0.f};
  bf16x8 At[4][2], B0[2][2], B1[2][2];
  const char* cA = (const char*)Ag + (size_t)cur.pm * tstep; const char* cB = (const char*)Btg + (size_t)cur.pn * tstep;
  PG8_STAGE(PG8_SB(0, 0), cB, voffB); PG8_STAGE(PG8_SA(0, 0), cA, voffA); PG8_STAGE(PG8_SB(0, 1), cB + hstep, voffB); PG8_STAGE(PG8_SA(0, 1), cA + hstep, voffA);
  if (wr == 1) PG8_BAR;
  PG8_WAIT_V(4); PG8_BAR;
  PG8_STAGE(PG8_SB(1, 0), cB + kstep, voffB); PG8_STAGE(PG8_SA(1, 0), cA + kstep, voffA); PG8_STAGE(PG8_SB(1, 1), cB + hstep + kstep, voffB);
  PG8_WAIT_V(6); PG8_BAR;
  for (;;) {
    const bool has_next = S.next(ui + 1, nxt);
    const char* nA = has_next ? (const char*)Ag + (size_t)nxt.pm * tstep : cA; const char* nB = has_next ? (const char*)Btg + (size_t)nxt.pn * tstep : cB;
    for (int t = 0; t < nt; t += 2) {
      const bool last = (t == nt - 2);
      const char* a1 = cA + (size_t)(t + 1) * kstep;
      const char* a2 = last ? nA : cA + (size_t)(t + 2) * kstep; const char* b2 = last ? nB : cB + (size_t)(t + 2) * kstep;
      const char* a3 = a2 + kstep; const char* b3 = b2 + kstep;
      PG8_LDB(B0, 0, 0); PG8_SCHED; PG8_LDA(At, 0, 0); PG8_STAGE(PG8_SA(1, 1), a1 + hstep, voffA);
      PG8_WAIT_L(8); PG8_BAR; PG8_WAIT_L(0); PG8_MMA(0, 0, At, B0); PG8_BAR; PG8_SCHED;
      PG8_LDB(B1, 0, 1); PG8_STAGE(PG8_SB(0, 0), b2, voffB);
      PG8_BAR; PG8_WAIT_L(0); PG8_MMA(0, 1, At, B1); PG8_BAR;
      PG8_LDA(At, 0, 1); PG8_STAGE(PG8_SA(0, 0), a2, voffA);
      PG8_BAR; PG8_WAIT_L(0); PG8_MMA(1, 0, At, B0); PG8_BAR; PG8_SCHED;
      PG8_STAGE(PG8_SB(0, 1), b2 + hstep, voffB);
      PG8_WAIT_V(6); PG8_BAR; PG8_MMA(1, 1, At, B1); PG8_BAR;
      PG8_LDB(B0, 1, 0); PG8_SCHED; PG8_LDA(At, 1, 0); PG8_STAGE(PG8_SA(0, 1), a2 + hstep, voffA);
      PG8_WAIT_L(8); PG8_BAR; PG8_WAIT_L(0); PG8_MMA(0, 0, At, B0); PG8_BAR; PG8_SCHED;
      PG8_LDB(B1, 1, 1); PG8_STAGE(PG8_SB(1, 0), b3, voffB);
      PG8_BAR; PG8_WAIT_L(0); PG8_MMA(0, 1, At, B1); PG8_BAR;
      PG8_LDA(At, 1, 1); PG8_STAGE(PG8_SA(1, 0), a3, voffA);
      PG8_BAR; PG8_WAIT_L(0); PG8_MMA(1, 0, At, B0); PG8_BAR; PG8_SCHED;
      PG8_STAGE(PG8_SB(1, 1), b3 + hstep, voffB);
      PG8_WAIT_V(6); PG8_BAR; PG8_MMA(1, 1, At, B1); PG8_BAR;
    }
    gemm_epilogue<EPI>(P, acc, cur, wr, wc, fr, fq, l);
    if (!has_next) break;
#pragma unroll
    for (int a = 0; a < 2; ++a)
#pragma unroll
      for (int b = 0; b < 2; ++b)
#pragma unroll
        for (int m = 0; m < 4; ++m)
#pragma unroll
          for (int n = 0; n < 2; ++n) acc[a][b][m][n] = (f32x4){0.f, 0.f, 0.f, 0.f};
    cur = nxt; cA = nA; cB = nB; ++ui;
  }
  PG8_WAIT_V(0);
  if (wr == 0) PG8_BAR;
  PG8_BAR;
#undef PG8_SA
#undef PG8_SB
#undef PG8_STAGE
#undef PG8_LDA
#undef PG8_LDB
#undef PG8_MMA
#undef PG8_WAIT_V
#undef PG8_WAIT_L
#undef PG8_BAR
#undef PG8_SCHED
}

template <int EPI>
__device__ __forceinline__ void gemm_sample(const Params& P, unsigned char* smem, const bf16_t* __restrict__ A, int lda, const bf16_t* __restrict__ Bt, int K, int nunits, int l) {
  const int tid = otid(), lane = tid & 63, wid = tid >> 6, fr = lane & 15, fq = lane >> 4;
  const int kslice = K >> 3;
  for (int u = (int)gridDim.x - 1 - obid(); u < nunits; u += gridDim.x) {
    const int brow0 = EPI == EPI_SWIGLU ? gu_row(u * 16 + fr, 0) : u * 16 + fr;
    const int brow1 = EPI == EPI_SWIGLU ? gu_row(u * 16 + fr, 1) : 0;
    const bf16_t* ap = A + (size_t)(NTP + fr) * lda + wid * kslice + fq * 8;
    const bf16_t* b0p = Bt + (size_t)brow0 * K + wid * kslice + fq * 8;
    const bf16_t* b1p = Bt + (size_t)brow1 * K + wid * kslice + fq * 8;
    f32x4 c0[8], c1[8];
#pragma unroll
    for (int m = 0; m < 8; ++m) { c0[m] = (f32x4){0.f, 0.f, 0.f, 0.f}; c1[m] = c0[m]; }
#pragma unroll 2
    for (int ks = 0; ks < kslice; ks += 32) {
      bf16x8 Af[8];
#pragma unroll
      for (int m = 0; m < 8; ++m) Af[m] = *(const bf16x8*)(ap + (size_t)m * 16 * lda + ks);
      const bf16x8 B0 = *(const bf16x8*)(b0p + ks);
      bf16x8 B1 = B0;
      if (EPI == EPI_SWIGLU) B1 = *(const bf16x8*)(b1p + ks);
#pragma unroll
      for (int m = 0; m < 8; ++m) {
        c0[m] = __builtin_amdgcn_mfma_f32_16x16x32_bf16(B0, Af[m], c0[m], 0, 0, 0);
        if (EPI == EPI_SWIGLU) c1[m] = __builtin_amdgcn_mfma_f32_16x16x32_bf16(B1, Af[m], c1[m], 0, 0, 0);
      }
    }
    __syncthreads();
#pragma unroll
    for (int m = 0; m < 8; ++m) {
      *(f32x4*)(smem + ((wid * 8 + m) * 64 + lane) * 16) = c0[m];
      if (EPI == EPI_SWIGLU) *(f32x4*)(smem + 65536 + ((wid * 8 + m) * 64 + lane) * 16) = c1[m];
    }
    __syncthreads();
    f32x4 g = (f32x4){0.f, 0.f, 0.f, 0.f}, up = g;
#pragma unroll
    for (int w = 0; w < 8; ++w) {
      g += *(const f32x4*)(smem + ((w * 8 + wid) * 64 + lane) * 16);
      if (EPI == EPI_SWIGLU) up += *(const f32x4*)(smem + 65536 + ((w * 8 + wid) * 64 + lane) * 16);
    }
    {
      const int row = NTP + wid * 16 + fr, col = u * 16 + fq * 4;
      if (EPI == EPI_P) {
        if (col < IN_COLS) *(u32x2*)(WSP(bf16_t, OFF_P) + (size_t)row * PSTR + col) = pack4(g);
      } else if (EPI == EPI_RES) {
        const float* xi = xin_row(P, l, row);
        *(f32x4*)(P.out + (size_t)row * D + col) = *(const f32x4*)(xi + col) + g;
      } else {
        f32x4 r;
#pragma unroll
        for (int j = 0; j < 4; ++j) r[j] = silu(g[j]) * up[j];
        *(u32x2*)(WSP(bf16_t, OFF_P) + (size_t)row * DFF + col) = pack4(r);
      }
    }
  }
}

__device__ __forceinline__ float lbval(const Params& P, int l, int c) {
  const float* hb = P.in[I_HLB];
  const float a0 = hb[c], a1 = hb[256 + c], a2 = hb[512 + c], a3 = hb[768 + c];
  const float m = fmaxf(fmaxf(a0, a1), fmaxf(a2, a3));
  const float e0 = __expf(a0 - m), e1 = __expf(a1 - m), e2 = __expf(a2 - m), e3 = __expf(a3 - m);
  const float inv = 1.f / (e0 + e1 + e2 + e3);
  float s = 0.f;
  if (l >= 1) s += e1; if (l >= 2) s += e2; if (l >= 3) s += e3;
  return s * inv;
}

__device__ __forceinline__ void gdn_conv_emit2(const Params& P, int g, int c2, int row, float s0, float s1) {
  const int h = g % 6;
  if (g < 12) {
    const float rn = rsqrtf(half_sum(s0 * s0 + s1 * s1) + 1e-6f) * (g < 6 ? 0.125f : 1.f);
    *(unsigned*)((g < 6 ? WSP(bf16_t, OFF_GQ) : WSP(bf16_t, OFF_GK)) + (size_t)row * 384 + h * 64 + c2) = pk2(s0 * rn, s1 * rn);
  } else {
    *(unsigned*)(WSP(bf16_t, OFF_GV) + (size_t)row * 384 + h * 64 + c2) = pk2(s0, s1);
  }
}
__device__ __forceinline__ void gdn_gate_emit(const Params& P, int l, int h, int row) {
  const bf16_t* pr = WSP(bf16_t, OFF_P) + (size_t)row * PSTR;
  const float braw = bf2f(pr[1536 + h]), araw = bf2f(pr[1542 + h]);
  const float gg = -__expf(P.in[I_ALOG][l * 6 + h]) * softplus(araw + P.in[I_DTB][l * 6 + h]);
  WSP(float, OFF_GDEC)[(size_t)row * 8 + h] = __expf(gg);
  WSP(float, OFF_GBETA)[(size_t)row * 8 + h] = sigm(braw);
}
__device__ __forceinline__ void prep_gdn_prompt(const Params& P, int l, int ci) {
  const int lane = otid() & 63, wid = otid() >> 6, hl = lane >> 5, c2 = (lane & 31) * 2;
  const int r0 = ci * 32, b = r0 / TSEQ, t0 = r0 % TSEQ;
  const bf16_t* p = WSP(bf16_t, OFF_P);
  for (int gp = wid; gp < 9; gp += 8) {
    const int g = gp * 2 + hl, col = g * 64 + c2;
    const float* cw = P.in[I_CONVW] + (size_t)l * 4 * 1152 + col;
    const f32x2 w0 = *(const f32x2*)cw, w1 = *(const f32x2*)(cw + 1152), w2 = *(const f32x2*)(cw + 2304), w3 = *(const f32x2*)(cw + 3456);
    unsigned xr[35];
#pragma unroll
    for (int t = 0; t < 35; ++t) xr[t] = (t >= 3 || t0 > 0) ? *(const unsigned*)(p + (size_t)(r0 - 3 + t) * PSTR + col) : 0u;
    f32x2 x3 = {__uint_as_float(xr[0] << 16), __uint_as_float(xr[0] & 0xffff0000u)};
    f32x2 x2 = {__uint_as_float(xr[1] << 16), __uint_as_float(xr[1] & 0xffff0000u)};
    f32x2 x1 = {__uint_as_float(xr[2] << 16), __uint_as_float(xr[2] & 0xffff0000u)};
#pragma unroll
    for (int t = 0; t < 32; ++t) {
      const f32x2 x0 = {__uint_as_float(xr[t + 3] << 16), __uint_as_float(xr[t + 3] & 0xffff0000u)};
      const f32x2 y = w0 * x3 + w1 * x2 + w2 * x1 + w3 * x0;
      gdn_conv_emit2(P, g, c2, r0 + t, silu(y[0]), silu(y[1]));
      x3 = x2; x2 = x1; x1 = x0;
    }
    if (t0 + 32 == TSEQ) {
      float* cp = P.out + O_CONV_P + (size_t)(l * 8 + b) * 3 * 1152 + col;
      *(f32x2*)cp = x3; *(f32x2*)(cp + 1152) = x2; *(f32x2*)(cp + 2304) = x1;
    }
    if (g < 6) gdn_gate_emit(P, l, g, r0 + (lane & 31));
  }
}
__device__ __forceinline__ void prep_gdn_sample(const Params& P, int l, int si) {
  const int lane = otid() & 63, wid = otid() >> 6, hl = lane >> 5, c2 = (lane & 31) * 2;
  const bf16_t* p = WSP(bf16_t, OFF_P);
  for (int u = wid; u < 18; u += 8) {
    const int s = si * 2 + u / 9, g = (u % 9) * 2 + hl, col = g * 64 + c2, row = NTP + s;
    const float* cw = P.in[I_CONVW] + (size_t)l * 4 * 1152 + col;
    const f32x2 w0 = *(const f32x2*)cw, w1 = *(const f32x2*)(cw + 1152), w2 = *(const f32x2*)(cw + 2304), w3 = *(const f32x2*)(cw + 3456);
    const float* cb = P.in[I_SCONV] + (size_t)(l * 128 + s) * 3 * 1152 + col;
    const f32x2 x3 = *(const f32x2*)cb, x2 = *(const f32x2*)(cb + 1152), x1 = *(const f32x2*)(cb + 2304);
    const unsigned xw = *(const unsigned*)(p + (size_t)row * PSTR + col);
    const f32x2 x0 = {__uint_as_float(xw << 16), __uint_as_float(xw & 0xffff0000u)};
    const f32x2 y = w0 * x3 + w1 * x2 + w2 * x1 + w3 * x0;
    gdn_conv_emit2(P, g, c2, row, silu(y[0]), silu(y[1]));
    float* cp = P.out + O_CONV_S + (size_t)(l * 128 + s) * 3 * 1152 + col;
    *(f32x2*)cp = x2; *(f32x2*)(cp + 1152) = x1; *(f32x2*)(cp + 2304) = x0;
    if (g < 6 && (lane & 31) == 0) gdn_gate_emit(P, l, g, row);
  }
}
__device__ __forceinline__ void prep_hgrn(const Params& P, int l, int ti) {
  const int c2 = (otid() & 127) * 2, tg = otid() >> 7;
  const float oml0 = 1.f - lbval(P, l, c2), oml1 = 1.f - lbval(P, l, c2 + 1);
  const bf16_t* p = WSP(bf16_t, OFF_P);
  bf16_t* hq = WSP(bf16_t, OFF_HQ); bf16_t* hk = WSP(bf16_t, OFF_HK);
  for (int t0 = tg * 16; t0 < tg * 16 + 16; t0 += 8) {
    unsigned q[8], f[8];
#pragma unroll
    for (int i = 0; i < 8; ++i) { const int row = ti * 64 + t0 + i; q[i] = *(const unsigned*)(p + (size_t)row * PSTR + PC + c2); f[i] = *(const unsigned*)(p + (size_t)row * PSTR + PC + 256 + c2); }
#pragma unroll
    for (int i = 0; i < 8; ++i) {
      const int row = ti * 64 + t0 + i;
      const float q0 = __uint_as_float(q[i] << 16), q1 = __uint_as_float(q[i] & 0xffff0000u);
      const float f0 = __uint_as_float(f[i] << 16), f1 = __uint_as_float(f[i] & 0xffff0000u);
      *(unsigned*)(hq + (size_t)row * 256 + c2) = pk2(silu(q0) * 0.125f, silu(q1) * 0.125f);
      *(unsigned*)(hk + (size_t)row * 256 + c2) = pk2(oml0 * sigm(-f0), oml1 * sigm(-f1));
    }
  }
}
template <bool SAMP>
__device__ __forceinline__ f32x4 xs4t(const Params& P, int l, int row, int col0) {
  const bf16_t* p = WSP(bf16_t, OFF_P);
  const f32x4 pv = unpack4(*(const u32x2*)(p + (size_t)row * PSTR + PB + col0));
  f32x4 prev;
  if (SAMP) prev = *(const f32x4*)(P.in[I_SSHIFT] + (size_t)(l * 128 + (row - NTP)) * 1408 + col0);
  else {
    const bool first = (row & (TSEQ - 1)) == 0;
    prev = unpack4(*(const u32x2*)(p + (size_t)(row - (first ? 0 : 1)) * PSTR + PB + col0)) * (first ? 0.f : 1.f);
  }
  const f32x4 mu = *(const f32x4*)(P.in[I_MU] + l * 1408 + col0);
  return pv + (prev - pv) * mu;
}
__device__ __forceinline__ float tanh_fast(float x) { return 1.f - 2.f / (__expf(2.f * x) + 1.f); }

template <int ROWB>
__device__ __forceinline__ void stage_lora(unsigned char* smem, const bf16_t* __restrict__ src) {
  constexpr int CPR = ROWB / 16, NCH = 384 * CPR;
  __syncthreads();
  u32x4 t[NCH / 512];
#pragma unroll
  for (int i = 0; i < NCH / 512; ++i) t[i] = *(const u32x4*)((const unsigned char*)src + (size_t)(otid() + i * 512) * 16);
#pragma unroll
  for (int i = 0; i < NCH / 512; ++i) { const int idx = otid() + i * 512, r = idx / CPR, c = idx - r * CPR; *(u32x4*)(smem + r * (ROWB + 16) + c * 16) = t[i]; }
  __syncthreads();
}
template <int ROWB>
__device__ __forceinline__ void stage_lora_open(unsigned char* smem, const bf16_t* __restrict__ src) {
  constexpr int CPR = ROWB / 16, NCH = 384 * CPR;
  __syncthreads();
  u32x4 t[NCH / 512];
#pragma unroll
  for (int i = 0; i < NCH / 512; ++i) t[i] = *(const u32x4*)((const unsigned char*)src + (size_t)(otid() + i * 512) * 16);
#pragma unroll
  for (int i = 0; i < NCH / 512; ++i) { const int idx = otid() + i * 512, r = idx / CPR, c = idx - r * CPR; *(u32x4*)(smem + r * (ROWB + 16) + c * 16) = t[i]; }
}
constexpr int EXCH_OFF = 110592;
__device__ __forceinline__ unsigned char* exch_slot(unsigned char* smem, int wid, int slot, int lane) { return smem + EXCH_OFF + ((wid * 2 + slot) * 64 + lane) * 16; }
template <bool SAMP>
__device__ __forceinline__ void prep_rwkv_unit(const Params& P, unsigned char* smem, int l, int mt, int hh) {
  const int lane = otid() & 63, fr = lane & 15, fq = lane >> 4, wid = otid() >> 6;
  const int row = mt * 16 + fr, cb = hh * 192;
  const bf16_t* lw = WSP(bf16_t, OFF_LORA);
  const size_t ro = (size_t)row * 384;
  f32x4 acc[12];
  {
    bf16x8 Bf[2][12];
    f32x4 x0 = xs4t<SAMP>(P, l, row, 1152 + hh * 32 + fq * 8), x1 = xs4t<SAMP>(P, l, row, 1152 + hh * 32 + fq * 8 + 4);
    stage_lora_open<128>(smem, lw + W2T);
#pragma unroll
    for (int j = 0; j < 4; ++j) { x0[j] = tanh_fast(x0[j]); x1[j] = tanh_fast(x1[j]); }
    const bf16x8 Am = pack8(x0, x1);
    *(bf16x8*)exch_slot(smem, wid, 0, lane) = Am;
    __syncthreads();
    const bf16x8 Ao = *(const bf16x8*)exch_slot(smem, wid ^ 1, 0, lane);
    bf16x8 Aw[2]; Aw[0] = hh ? Ao : Am; Aw[1] = hh ? Am : Ao;
#pragma unroll
    for (int ks = 0; ks < 2; ++ks)
#pragma unroll
      for (int nf = 0; nf < 12; ++nf) Bf[ks][nf] = *(const bf16x8*)(smem + (cb + nf * 16 + fr) * 144 + ks * 64 + fq * 16);
#pragma unroll
    for (int nf = 0; nf < 12; ++nf) acc[nf] = (f32x4){0.f, 0.f, 0.f, 0.f};
#pragma unroll
    for (int ks = 0; ks < 2; ++ks) {
#pragma unroll
      for (int nf = 0; nf < 12; ++nf) acc[nf] = __builtin_amdgcn_mfma_f32_16x16x32_bf16(Bf[ks][nf], Aw[ks], acc[nf], 0, 0, 0);
    }
    f32x4 w0v[12];
#pragma unroll
    for (int nf = 0; nf < 12; ++nf) w0v[nf] = *(const f32x4*)(P.in[I_W0] + l * 384 + cb + nf * 16 + fq * 4);
#pragma unroll
    for (int nf = 0; nf < 12; ++nf) {
      f32x4 d;
#pragma unroll
      for (int j = 0; j < 4; ++j) {
        const float xx = -(w0v[nf][j] + acc[nf][j]);
        const float sp = xx > 15.f ? xx : __logf(1.f + __expf(xx));
        d[j] = __expf(-__expf(-sp - 0.5f));
      }
      *(f32x4*)(WSP(float, OFF_RW) + ro + cb + nf * 16 + fq * 4) = d;
    }
  }
  {
    bf16x8 Bf[2][12];
    const f32x4 x0 = xs4t<SAMP>(P, l, row, 1216 + hh * 32 + fq * 8), x1 = xs4t<SAMP>(P, l, row, 1216 + hh * 32 + fq * 8 + 4);
    stage_lora_open<128>(smem, lw + A2T);
    const bf16x8 Am = pack8(x0, x1);
    *(bf16x8*)exch_slot(smem, wid, 0, lane) = Am;
    __syncthreads();
    const bf16x8 Ao = *(const bf16x8*)exch_slot(smem, wid ^ 1, 0, lane);
    bf16x8 Aw[2]; Aw[0] = hh ? Ao : Am; Aw[1] = hh ? Am : Ao;
#pragma unroll
    for (int ks = 0; ks < 2; ++ks)
#pragma unroll
      for (int nf = 0; nf < 12; ++nf) Bf[ks][nf] = *(const bf16x8*)(smem + (cb + nf * 16 + fr) * 144 + ks * 64 + fq * 16);
#pragma unroll
    for (int nf = 0; nf < 12; ++nf) acc[nf] = (f32x4){0.f, 0.f, 0.f, 0.f};
#pragma unroll
    for (int ks = 0; ks < 2; ++ks) {
#pragma unroll
      for (int nf = 0; nf < 12; ++nf) acc[nf] = __builtin_amdgcn_mfma_f32_16x16x32_bf16(Bf[ks][nf], Aw[ks], acc[nf], 0, 0, 0);
    }
  }
#pragma unroll
  for (int hl = 0; hl < 3; ++hl) {
    f32x4 kr[4], rr[4], kkw[4], a0[4], ka[4];
#pragma unroll
    for (int q = 0; q < 4; ++q) {
      const int c = cb + (hl * 4 + q) * 16 + fq * 4;
      kr[q] = xs4t<SAMP>(P, l, row, 384 + c); rr[q] = xs4t<SAMP>(P, l, row, c);
      kkw[q] = *(const f32x4*)(P.in[I_KK] + l * 384 + c); a0[q] = *(const f32x4*)(P.in[I_A0] + l * 384 + c); ka[q] = *(const f32x4*)(P.in[I_KA] + l * 384 + c);
    }
    float ss = 0.f;
#pragma unroll
    for (int q = 0; q < 4; ++q) { kkw[q] = kr[q] * kkw[q]; ss += dot4(kkw[q], kkw[q]); }
    ss += __shfl_xor(ss, 16); ss += __shfl_xor(ss, 32);
    const float rn = rsqrtf(ss + 1e-6f);
#pragma unroll
    for (int q = 0; q < 4; ++q) {
      const int nf = hl * 4 + q, c = cb + nf * 16 + fq * 4;
      f32x4 kn, kk, kb;
#pragma unroll
      for (int j = 0; j < 4; ++j) {
        const float a = sigm(a0[q][j] + acc[nf][j]);
        kk[j] = kkw[q][j] * rn; kb[j] = kk[j] * a; kn[j] = kr[q][j] * (1.f + (a - 1.f) * ka[q][j]);
      }
      *(u32x2*)(WSP(bf16_t, OFF_RK) + ro + c) = pack4(kn);
      *(u32x2*)(WSP(bf16_t, OFF_RKK) + ro + c) = pack4(kk);
      *(u32x2*)(WSP(bf16_t, OFF_RB) + ro + c) = pack4(kb);
      *(u32x2*)(WSP(bf16_t, OFF_RR) + ro + c) = pack4(rr[q]);
    }
  }
  {
    f32x4 x[2][2];
#pragma unroll
    for (int k2 = 0; k2 < 2; ++k2) { x[k2][0] = xs4t<SAMP>(P, l, row, 1280 + (hh * 2 + k2) * 32 + fq * 8); x[k2][1] = xs4t<SAMP>(P, l, row, 1280 + (hh * 2 + k2) * 32 + fq * 8 + 4); }
    stage_lora_open<256>(smem, lw + G2T);
    bf16x8 Am[2], Ao[2];
#pragma unroll
    for (int k2 = 0; k2 < 2; ++k2) {
#pragma unroll
      for (int j = 0; j < 4; ++j) { x[k2][0][j] = sigm(x[k2][0][j]); x[k2][1][j] = sigm(x[k2][1][j]); }
      Am[k2] = pack8(x[k2][0], x[k2][1]);
      *(bf16x8*)exch_slot(smem, wid, k2, lane) = Am[k2];
    }
    __syncthreads();
#pragma unroll
    for (int k2 = 0; k2 < 2; ++k2) Ao[k2] = *(const bf16x8*)exch_slot(smem, wid ^ 1, k2, lane);
    bf16x8 A[4];
    A[0] = hh ? Ao[0] : Am[0]; A[1] = hh ? Ao[1] : Am[1]; A[2] = hh ? Am[0] : Ao[0]; A[3] = hh ? Am[1] : Ao[1];
#pragma unroll
    for (int hf = 0; hf < 2; ++hf) {
      bf16x8 Bf[4][6];
#pragma unroll
      for (int ks = 0; ks < 4; ++ks)
#pragma unroll
        for (int n6 = 0; n6 < 6; ++n6) Bf[ks][n6] = *(const bf16x8*)(smem + (cb + (hf * 6 + n6) * 16 + fr) * 272 + ks * 64 + fq * 16);
#pragma unroll
      for (int n6 = 0; n6 < 6; ++n6) {
        f32x4 g = (f32x4){0.f, 0.f, 0.f, 0.f};
#pragma unroll
        for (int ks = 0; ks < 4; ++ks) g = __builtin_amdgcn_mfma_f32_16x16x32_bf16(Bf[ks][n6], A[ks], g, 0, 0, 0);
        *(u32x2*)(WSP(bf16_t, OFF_RG) + ro + cb + (hf * 6 + n6) * 16 + fq * 4) = pack4(g);
      }
    }
  }
  if (l == 0) {
    f32x4 v[12];
#pragma unroll
    for (int nf = 0; nf < 12; ++nf) v[nf] = xs4t<SAMP>(P, l, row, 768 + cb + nf * 16 + fq * 4);
#pragma unroll
    for (int nf = 0; nf < 12; ++nf) {
      const int c = cb + nf * 16 + fq * 4;
      const u32x2 o = pack4(v[nf]);
      *(u32x2*)(WSP(bf16_t, OFF_RV) + ro + c) = o;
      *(u32x2*)(WSP(bf16_t, OFF_VF) + ro + c) = o;
    }
  } else {
    f32x4 lo0 = (f32x4){0.f, 0.f, 0.f, 0.f}, lo1 = lo0;
    {
      const int hf = hh;
      f32x4 x[6][2]; bf16x8 B0[6], B1[6];
#pragma unroll
      for (int k6 = 0; k6 < 6; ++k6) {
        const int ks = hf * 6 + k6;
        x[k6][0] = xs4t<SAMP>(P, l, row, 768 + ks * 32 + fq * 8); x[k6][1] = xs4t<SAMP>(P, l, row, 768 + ks * 32 + fq * 8 + 4);
        B0[k6] = *(const bf16x8*)(lw + V1T + fr * 384 + ks * 32 + fq * 8);
        B1[k6] = *(const bf16x8*)(lw + V1T + (16 + fr) * 384 + ks * 32 + fq * 8);
      }
#pragma unroll
      for (int k6 = 0; k6 < 6; ++k6) {
        const bf16x8 A = pack8(x[k6][0], x[k6][1]);
        lo0 = __builtin_amdgcn_mfma_f32_16x16x32_bf16(B0[k6], A, lo0, 0, 0, 0);
        lo1 = __builtin_amdgcn_mfma_f32_16x16x32_bf16(B1[k6], A, lo1, 0, 0, 0);
      }
    }
    __syncthreads();
    *(f32x4*)exch_slot(smem, wid, 0, lane) = lo0; *(f32x4*)exch_slot(smem, wid, 1, lane) = lo1;
    __syncthreads();
    lo0 += *(const f32x4*)exch_slot(smem, wid ^ 1, 0, lane); lo1 += *(const f32x4*)exch_slot(smem, wid ^ 1, 1, lane);
    const bf16x8 A2 = pack8(lo0, lo1);
#pragma unroll
    for (int hf = 0; hf < 2; ++hf) {
      u32x4 bw[6]; f32x4 v0[6], v[6]; u32x2 vf[6];
#pragma unroll
      for (int n6 = 0; n6 < 6; ++n6) {
        const int nf = hf * 6 + n6, c = cb + nf * 16 + fq * 4;
        const bf16_t* vr = lw + V2T + (cb + nf * 16 + fr) * 32;
        const u32x2 b0 = *(const u32x2*)(vr + fq * 4), b1 = *(const u32x2*)(vr + 16 + fq * 4);
        bw[n6][0] = b0[0]; bw[n6][1] = b0[1]; bw[n6][2] = b1[0]; bw[n6][3] = b1[1];
        v0[n6] = *(const f32x4*)(P.in[I_V0] + (l - 1) * 384 + c);
        v[n6] = xs4t<SAMP>(P, l, row, 768 + c);
        vf[n6] = *(const u32x2*)(WSP(bf16_t, OFF_VF) + ro + c);
      }
#pragma unroll
      for (int n6 = 0; n6 < 6; ++n6) {
        const int c = cb + (hf * 6 + n6) * 16 + fq * 4;
        const f32x4 mv = __builtin_amdgcn_mfma_f32_16x16x32_bf16(__builtin_bit_cast(bf16x8, bw[n6]), A2, (f32x4){0.f, 0.f, 0.f, 0.f}, 0, 0, 0);
        const f32x4 vfv = unpack4(vf[n6]);
        f32x4 o;
#pragma unroll
        for (int j = 0; j < 4; ++j) o[j] = v[n6][j] + (vfv[j] - v[n6][j]) * sigm(v0[n6][j] + mv[j]);
        *(u32x2*)(WSP(bf16_t, OFF_RV) + ro + c) = pack4(o);
      }
    }
  }
}
__device__ __forceinline__ void prep_phase(const Params& P, unsigned char* smem, int l, volatile unsigned* blk  ) {
  unsigned* q = WSP(unsigned, OFF_QUEUE) + l * 128 + 80;
  for (;;) {
    __syncthreads();
    if (threadIdx.x == 0) blk[3] = __hip_atomic_fetch_add(q, 1u, __ATOMIC_RELAXED, __HIP_MEMORY_SCOPE_AGENT);
    __syncthreads();
    const int it = (int)blk[3];
    if (it >= 1090) break;
    if (it < 256) { const int wid = otid() >> 6; prep_rwkv_unit<false>(P, smem, l, it * 4 + (wid >> 1), wid & 1); }
    else if (it < 768) prep_gdn_prompt(P, l, it - 256);
    else if (it < 832) prep_gdn_sample(P, l, it - 768);
    else prep_hgrn(P, l, it - 832);
  }
  const bf16_t* p = WSP(bf16_t, OFF_P);
  for (int idx = obid() * 512 + otid(); idx < 136 * 1408; idx += gridDim.x * 512) {
    const int q = idx / 1408, col = idx - q * 1408;
    if (q < 8) P.out[O_SHIFT_P + (size_t)(l * 8 + q) * 1408 + col] = bf2f(p[(size_t)(q * TSEQ + TSEQ - 1) * PSTR + PB + col]);
    else P.out[O_SHIFT_S + (size_t)(l * 128 + (q - 8)) * 1408 + col] = bf2f(p[(size_t)(NTP + q - 8) * PSTR + PB + col]);
  }
}

template <int KIND> struct ScanCfg { static constexpr int STRIDE = KIND == 1 ? 356 : 164; };

template <int KIND> struct ScanPre { u32x2 a, b, c, d, v; f32x4 w; float g; };

template <int KIND>
__device__ __forceinline__ void scan_load(const Params& P, ScanPre<KIND>& r, int tid, int h, int half, int rowbase, int nvalid) {
  const int s = tid >> 4, j4 = (tid & 15) * 4;
  const int s2 = (tid >> 3) & 15, j2 = (tid & 7) * 4;
  const u32x2 z2 = {0u, 0u};
  const bool ok = s < nvalid, ok2 = (tid < 128) && (s2 < nvalid);
  if (KIND == 0) {
    const size_t o = (size_t)(rowbase + s) * 384 + h * 64 + j4;
    r.a = ok ? *(const u32x2*)(WSP(bf16_t, OFF_GK) + o) : z2;
    r.b = ok ? *(const u32x2*)(WSP(bf16_t, OFF_GQ) + o) : z2;
    r.v = ok2 ? *(const u32x2*)(WSP(bf16_t, OFF_GV) + (size_t)(rowbase + s2) * 384 + h * 64 + half * 32 + j2) : z2;
    const int sg = (tid >> 1) & 15;
    r.g = (tid < 32 && sg < nvalid) ? ((tid & 1) ? WSP(float, OFF_GBETA) : WSP(float, OFF_GDEC))[(size_t)(rowbase + sg) * 8 + h] : 0.f;
  } else if (KIND == 1) {
    const size_t o = (size_t)(rowbase + s) * 384 + h * 64 + j4;
    r.a = ok ? *(const u32x2*)(WSP(bf16_t, OFF_RR) + o) : z2;
    r.w = ok ? *(const f32x4*)(WSP(float, OFF_RW) + o) : (f32x4){0.f, 0.f, 0.f, 0.f};
    r.b = ok ? *(const u32x2*)(WSP(bf16_t, OFF_RK) + o) : z2;
    r.c = ok ? *(const u32x2*)(WSP(bf16_t, OFF_RKK) + o) : z2;
    r.d = ok ? *(const u32x2*)(WSP(bf16_t, OFF_RB) + o) : z2;
    r.v = ok2 ? *(const u32x2*)(WSP(bf16_t, OFF_RV) + (size_t)(rowbase + s2) * 384 + h * 64 + half * 32 + j2) : z2;
  } else {
    const size_t o = (size_t)(rowbase + s) * 256 + h * 64 + j4;
    r.a = ok ? *(const u32x2*)(WSP(bf16_t, OFF_HQ) + o) : z2;
    r.b = ok ? *(const u32x2*)(WSP(bf16_t, OFF_HK) + o) : z2;
    r.v = ok2 ? *(const u32x2*)(WSP(bf16_t, OFF_P) + (size_t)(rowbase + s2) * PSTR + PC + 512 + h * 64 + half * 32 + j2) : z2;
  }
}
template <int KIND>
__device__ __forceinline__ void scan_store(const ScanPre<KIND>& r, int tid, float* buf, float* side = nullptr) {
  constexpr int STRIDE = ScanCfg<KIND>::STRIDE;
  const int s = tid >> 4, j4 = (tid & 15) * 4;
  const int s2 = (tid >> 3) & 15, j2 = (tid & 7) * 4;
  float* bs = buf + s * STRIDE + j4;
  if (KIND == 0) {
    const f32x4 k = unpack4(r.a), q = unpack4(r.b);
    *(f32x4*)(bs) = k; *(f32x4*)(bs + 64) = q;
    const float qk = row_sum16(dot4(q, k));
    if ((tid & 15) == 0) buf[s * STRIDE + 162] = qk;
    if (tid < 128) *(f32x4*)(buf + s2 * STRIDE + 128 + j2) = unpack4(r.v);
    if (tid < 32) buf[((tid >> 1) & 15) * STRIDE + 160 + (tid & 1)] = r.g;
  } else if (KIND == 1) {
    const f32x4 rr = unpack4(r.a), k = unpack4(r.b), kk = unpack4(r.c), bb = unpack4(r.d);
    *(f32x4*)(bs) = r.w * rr; *(f32x4*)(bs + 64) = r.w; *(f32x4*)(bs + 128) = k;
    *(f32x4*)(bs + 192) = kk; *(f32x4*)(bs + 256) = bb;
    const float br = row_sum16(dot4(bb, rr)), kr = row_sum16(dot4(k, rr));
    if ((tid & 15) == 0) { buf[s * STRIDE + 352] = br; buf[s * STRIDE + 353] = kr; if (side) { side[s * 36 + 32] = br; side[s * 36 + 33] = kr; } }
    if (tid < 128) { const f32x4 vv = unpack4(r.v); *(f32x4*)(buf + s2 * STRIDE + 320 + j2) = vv; if (side) *(f32x4*)(side + s2 * 36 + j2) = vv; }
  } else {
    const f32x4 q = unpack4(r.a), k = unpack4(r.b);
    *(f32x4*)(bs) = q * (1.f - k); *(f32x4*)(bs + 64) = k;
    const float qk = row_sum16(dot4(q, k));
    if ((tid & 15) == 0) buf[s * STRIDE + 160] = qk;
    if (tid < 128) *(f32x4*)(buf + s2 * STRIDE + 128 + j2) = unpack4(r.v);
  }
}

template <int KIND> struct StepOps { f32x2 a[4], b[4], c[4], d[4], e[4]; float v, s0, s1, s2; };
template <int KIND, bool DEFER = false>
__device__ __forceinline__ void step_load(StepOps<KIND>& o, const float* bs, int e0, int cl) {
#define LD8(dst, off) { const f32x4 _x = *(const f32x4*)(bs + (off) + e0), _y = *(const f32x4*)(bs + (off) + e0 + 4); \
    dst[0] = (f32x2){_x[0], _x[1]}; dst[1] = (f32x2){_x[2], _x[3]}; dst[2] = (f32x2){_y[0], _y[1]}; dst[3] = (f32x2){_y[2], _y[3]}; }
  if (KIND == 0) {
    LD8(o.a, 0) LD8(o.b, 64)
    o.v = bs[128 + cl];
    const f32x4 sc = *(const f32x4*)(bs + 160); o.s0 = sc[0]; o.s1 = sc[1]; o.s2 = sc[2];
  } else if (KIND == 1) {
    LD8(o.a, 0) LD8(o.b, 64) LD8(o.c, 128) LD8(o.d, 192) LD8(o.e, 256)
    o.v = bs[320 + cl];
    if (!DEFER) { const f32x2 sc = *(const f32x2*)(bs + 352); o.s0 = sc[0]; o.s1 = sc[1]; }
  } else {
    LD8(o.a, 0) LD8(o.b, 64)
    o.v = bs[128 + cl]; o.s0 = bs[160];
  }
#undef LD8
}
template <int KIND>
__device__ __forceinline__ float step_compute(const StepOps<KIND>& o, f32x2 (&S)[4]) {
  if (KIND == 0) {
    f32x2 ks2 = o.a[0] * S[0], qs2 = o.b[0] * S[0];
#pragma unroll
    for (int i = 1; i < 4; ++i) { ks2 += o.a[i] * S[i]; qs2 += o.b[i] * S[i]; }
    float ks = ks2[0] + ks2[1], qs = qs2[0] + qs2[1];
    ks += dppf<0xB1>(ks); qs += dppf<0xB1>(qs); ks += dppf<0x4E>(ks); qs += dppf<0x4E>(qs); ks += dppf<0x141>(ks); qs += dppf<0x141>(qs);
    const float dec = o.s0, vn = o.s1 * (o.v - dec * ks);
#pragma unroll
    for (int i = 0; i < 4; ++i) S[i] = S[i] * dec + o.a[i] * vn;
    return dec * qs + vn * o.s2;
  } else if (KIND == 1) {
    f32x2 sa2 = o.d[0] * S[0], p2 = o.a[0] * S[0];
#pragma unroll
    for (int i = 1; i < 4; ++i) { sa2 += o.d[i] * S[i]; p2 += o.a[i] * S[i]; }
    float sa = sa2[0] + sa2[1], p1 = p2[0] + p2[1];
    sa += dppf<0xB1>(sa); p1 += dppf<0xB1>(p1); sa += dppf<0x4E>(sa); p1 += dppf<0x4E>(p1); sa += dppf<0x141>(sa); p1 += dppf<0x141>(p1);
    sa = -sa;
#pragma unroll
    for (int i = 0; i < 4; ++i) S[i] = S[i] * o.b[i] + (o.e[i] * sa + o.c[i] * o.v);
    return p1 + sa * o.s0 + o.v * o.s1;
  } else {
    f32x2 p2 = o.a[0] * S[0];
#pragma unroll
    for (int i = 1; i < 4; ++i) p2 += o.a[i] * S[i];
    float p1 = p2[0] + p2[1];
    p1 += dppf<0xB1>(p1); p1 += dppf<0x4E>(p1); p1 += dppf<0x141>(p1);
#pragma unroll
    for (int i = 0; i < 4; ++i) S[i] = S[i] + o.b[i] * (o.v - S[i]);
    return p1 + o.v * o.s0;
  }
}

__device__ __forceinline__ f32x2 step_compute_rwkv_defer(const StepOps<1>& o, f32x2 (&S)[4]) {
  f32x2 sa2 = o.d[0] * S[0], p2 = o.a[0] * S[0];
#pragma unroll
  for (int i = 1; i < 4; ++i) { sa2 += o.d[i] * S[i]; p2 += o.a[i] * S[i]; }
  float sa = sa2[0] + sa2[1], p1 = p2[0] + p2[1];
  sa += dppf<0xB1>(sa); p1 += dppf<0xB1>(p1); sa += dppf<0x4E>(sa); p1 += dppf<0x4E>(p1); sa += dppf<0x141>(sa); p1 += dppf<0x141>(p1);
  sa = -sa;
#pragma unroll
  for (int i = 0; i < 4; ++i) S[i] = S[i] * o.b[i] + (o.e[i] * sa + o.c[i] * o.v);
  return (f32x2){p1, sa};
}

template <int KIND>
__device__ __forceinline__ void scan_task(const Params& P, unsigned char* smem, int l, int seq, int h, int half, int mode) {
  constexpr int STRIDE = ScanCfg<KIND>::STRIDE, NEL = 16 * STRIDE;
  constexpr int NH = KIND == 2 ? 4 : 6;
  float* buf = (float*)smem;
  float* obuf = buf + 2 * NEL;
  const bool do_comp = mode != 2, do_stage = mode != 1;
  const bool defer = (KIND == 1) && (mode != 0);
  const int OBS = defer ? 1024 : 512;
  float* side = obuf + 2048;
  const int tid = otid() & 255, lane = tid & 63, wid = tid >> 6;
  const int col_l = lane >> 3, sub = lane & 7, cl = wid * 8 + col_l, col = half * 32 + cl, e0 = sub * 8;
  const bool sample = seq >= 8;
  const int R0 = sample ? NTP + (seq - 8) : seq * TSEQ, T = sample ? 1 : TSEQ;
  const int ocol = (KIND == 0 ? 0 : (KIND == 1 ? 384 : 768)) + h * 64 + half * 32;
  const size_t O_P = KIND == 0 ? O_GDN_P : (KIND == 1 ? O_RWKV_P : O_HGRN_P);
  const size_t O_S = KIND == 0 ? O_GDN_S : (KIND == 1 ? O_RWKV_S : O_HGRN_S);
  const int I_ST = KIND == 0 ? I_SGDN : (KIND == 1 ? I_SRWKV : I_SHGRN);
  const int nchunks = (T + 15) >> 4;
  bf16_t* oraw = WSP(bf16_t, OFF_P);
  f32x2 S[4];
#pragma unroll
  for (int i = 0; i < 4; ++i) S[i] = (f32x2){0.f, 0.f};
  if (sample && do_comp) {
    const float* st = P.in[I_ST] + ((size_t)(l * 128 + (seq - 8)) * NH + h) * 4096;
#pragma unroll
    for (int i = 0; i < 8; ++i) S[i >> 1][i & 1] = KIND == 1 ? st[col * 64 + e0 + i] : st[(e0 + i) * 64 + col];
  }
#pragma unroll
  for (int i = 0; i < 4; ++i) asm volatile("" : "+v"(S[i]));
  ScanPre<KIND> pre;
  __syncthreads();
  if (do_stage) {
    scan_load<KIND>(P, pre, tid, h, half, R0, T); scan_store<KIND>(pre, tid, buf, defer ? side : nullptr);
    if (nchunks > 1) scan_load<KIND>(P, pre, tid, h, half, R0 + 16, T - 16);
  }
  __syncthreads();
  for (int c = 0; c < nchunks; ++c) {
    const int t0 = c * 16, n = (T - t0) < 16 ? (T - t0) : 16;
    if (do_stage) {
      if (c + 1 < nchunks) scan_store<KIND>(pre, tid, buf + ((c + 1) & 1) * NEL, defer ? side + ((c + 1) % 3) * 576 : nullptr);
      if (c > 0) {
        const float* pob = obuf + ((c - 1) & 1) * OBS;
        const int s = tid >> 4, cc = (tid & 15) * 2;
        f32x2 ov;
        if (defer) {
          const f32x4 ps = *(const f32x4*)(pob + (s * 32 + cc) * 2);
          const float* sd = side + ((c - 1) % 3) * 576 + s * 36;
          const f32x2 vv = *(const f32x2*)(sd + cc), sc = *(const f32x2*)(sd + 32);
          ov[0] = ps[0] + ps[1] * sc[0] + vv[0] * sc[1]; ov[1] = ps[2] + ps[3] * sc[0] + vv[1] * sc[1];
        } else ov = *(const f32x2*)(pob + s * 32 + cc);
        *(unsigned*)(oraw + (size_t)(R0 + t0 - 16 + s) * PSTR + ocol + cc) = pk2(ov[0], ov[1]);
      }
      if (c + 2 < nchunks) scan_load<KIND>(P, pre, tid, h, half, R0 + t0 + 32, T - t0 - 32);
    }
    if (do_comp) {
      const float* b = buf + (c & 1) * NEL;
      float* ob = obuf + (c & 1) * OBS;
      if (KIND == 1 && n == 16 && defer) {
        StepOps<1> A, B;
        step_load<1, true>((StepOps<1>&)A, b, e0, cl);
#pragma unroll
        for (int s = 0; s < 16; s += 2) {
          step_load<1, true>(B, b + (s + 1) * STRIDE, e0, cl);
          *(f32x2*)(ob + (s * 32 + cl) * 2) = step_compute_rwkv_defer(A, S);
          step_load<1, true>(A, b + (s + 2 < 16 ? s + 2 : 15) * STRIDE, e0, cl);
          *(f32x2*)(ob + ((s + 1) * 32 + cl) * 2) = step_compute_rwkv_defer(B, S);
        }
      } else if (n == 16) {
        StepOps<KIND> A, B;
        step_load<KIND>(A, b, e0, cl);
#pragma unroll
        for (int s = 0; s < 16; s += 2) {
          step_load<KIND>(B, b + (s + 1) * STRIDE, e0, cl);
          const float o0 = step_compute<KIND>(A, S);
          ob[s * 32 + cl] = o0;
          step_load<KIND>(A, b + (s + 2 < 16 ? s + 2 : 15) * STRIDE, e0, cl);
          const float o1 = step_compute<KIND>(B, S);
          ob[(s + 1) * 32 + cl] = o1;
        }
      } else {
        for (int s = 0; s < n; ++s) {
          StepOps<KIND> A;
          step_load<KIND>(A, b + s * STRIDE, e0, cl);
          const float o0 = step_compute<KIND>(A, S);
          ob[s * 32 + cl] = o0;
        }
      }
    }
    __syncthreads();
  }
  if (do_stage) {
    const int c = nchunks - 1, t0 = c * 16, n = T - t0;
    const float* pob = obuf + (c & 1) * OBS;
    const int s = tid >> 4, cc = (tid & 15) * 2;
    f32x2 ov;
    if (defer) {
      const f32x4 ps = *(const f32x4*)(pob + (s * 32 + cc) * 2);
      const float* sd = side + (c % 3) * 576 + s * 36;
      const f32x2 vv = *(const f32x2*)(sd + cc), sc = *(const f32x2*)(sd + 32);
      ov[0] = ps[0] + ps[1] * sc[0] + vv[0] * sc[1]; ov[1] = ps[2] + ps[3] * sc[0] + vv[1] * sc[1];
    } else ov = *(const f32x2*)(pob + s * 32 + cc);
    if (s < n) *(unsigned*)(oraw + (size_t)(R0 + t0 + s) * PSTR + ocol + cc) = pk2(ov[0], ov[1]);
  }
  if (do_comp) {
    float* so = P.out + (sample ? O_S + ((size_t)(l * 128 + (seq - 8)) * NH + h) * 4096 : O_P + ((size_t)(l * 8 + seq) * NH + h) * 4096);
#pragma unroll
    for (int i = 0; i < 8; ++i) { if (KIND == 1) so[col * 64 + e0 + i] = S[i >> 1][i & 1]; else so[(e0 + i) * 64 + col] = S[i >> 1][i & 1]; }
  }
}

__device__ __forceinline__ void scan_phase(const Params& P, unsigned char* smem, int l, volatile unsigned* blk  ) {
  unsigned* q = WSP(unsigned, OFF_QUEUE) + l * 128;
  const int grp = otid() >> 8;
  for (int pass = 0; pass < 2; ++pass) {
    unsigned* qq = pass == 1 ? q + 64 : q;
    const unsigned ntask = pass == 1 ? 2050u : 256u;
    for (;;) {
      __syncthreads();
      if (threadIdx.x == 0) blk[3] = __hip_atomic_fetch_add(qq, 1u, __ATOMIC_RELAXED, __HIP_MEMORY_SCOPE_AGENT);
      __syncthreads();
      const int t = (int)blk[3];
      if (t >= (int)ntask) break;
      int kind, seq, h, half, act; unsigned char* sm;
      if (pass == 0) {
        act = grp == 0 ? 1 : 2; sm = smem; half = t & 1;
        if (t < 96) { kind = 1; const int bh = t >> 1; seq = bh / 6; h = bh % 6; }
        else if (t < 192) { kind = 0; const int bh = (t - 96) >> 1; seq = bh / 6; h = bh % 6; }
        else { kind = 2; const int bh = (t - 192) >> 1; seq = bh / 4; h = bh % 4; }
      } else if (t < 2) {
        { const int wid = otid() >> 6; prep_rwkv_unit<true>(P, smem, l, (256 + t) * 4 + (wid >> 1), wid & 1); }
        asm volatile("s_waitcnt vmcnt(0)" ::: "memory");
        __syncthreads();
        if (threadIdx.x == 0) {
          __builtin_amdgcn_fence(__ATOMIC_RELEASE, "agent");
          asm volatile("s_waitcnt vmcnt(0)" ::: "memory");
          __hip_atomic_fetch_add(q + 88, 1u, __ATOMIC_RELAXED, __HIP_MEMORY_SCOPE_AGENT);
        }
        continue;
      } else {
        const int st = t - 2;
        act = 0; sm = smem + grp * 51200; half = grp;
        if (st < 1280) { const int s = st / 10, j = st - s * 10; seq = 8 + s; if (j < 6) { kind = 0; h = j; } else { kind = 2; h = j - 6; } }
        else {
          const int x = st - 1280, s = x / 6; seq = 8 + s; kind = 1; h = x - s * 6;
          if (threadIdx.x == 0) {
            unsigned sp = 0;
            while (__hip_atomic_load(q + 88, __ATOMIC_RELAXED, __HIP_MEMORY_SCOPE_AGENT) < 2u && ++sp < (1u << 22)) __builtin_amdgcn_s_sleep(2);
            __builtin_amdgcn_fence(__ATOMIC_ACQUIRE, "agent");
            asm volatile("s_waitcnt vmcnt(0)" ::: "memory");
          }
          __syncthreads();
        }
      }
      if (kind == 0) scan_task<0>(P, sm, l, seq, h, half, act);
      else if (kind == 1) scan_task<1>(P, sm, l, seq, h, half, act);
      else scan_task<2>(P, sm, l, seq, h, half, act);
    }
  }
  if (l + 1 < NLAYER) {
    for (;;) {
      __syncthreads();
      if (threadIdx.x == 0) blk[3] = __hip_atomic_fetch_add(q + 96, 1u, __ATOMIC_RELAXED, __HIP_MEMORY_SCOPE_AGENT);
      __syncthreads();
      const unsigned t = blk[3];
      if (t >= (unsigned)WCONV_JOBS) break;
      wconv_job(P, smem, l + 1, (int)t);
    }
  }
  if (l == 0) {
    for (;;) {
      __syncthreads();
      if (threadIdx.x == 0) blk[3] = __hip_atomic_fetch_add(q + 112, 1u, __ATOMIC_RELAXED, __HIP_MEMORY_SCOPE_AGENT);
      __syncthreads();
      const unsigned t = blk[3];
      if (t >= 2368u) break;
      wconv_job(P, smem, 0, 1024 + (int)t);
    }
  }
}

__device__ __forceinline__ void post_phase(const Params& P, int l) {
  const int lane = otid() & 63, wid = otid() >> 6, hl = lane >> 5, c2 = (lane & 31) * 2;
  const bf16_t* p = WSP(bf16_t, OFF_P);
  bf16_t* act = WSP(bf16_t, OFF_ACT);
  const int gw = obid() * 8 + wid, nw = gridDim.x * 8;
  const f32x2 gnw = *(const f32x2*)(P.in[I_GNW] + l * 64 + c2), hnw = *(const f32x2*)(P.in[I_HNW] + l * 64 + c2);
  for (int u0 = gw * 8; u0 < NTOK * 10; u0 += nw * 8) {
    unsigned o[4], z[4]; int oc[4]; size_t rb[4];
#pragma unroll
    for (int k = 0; k < 4; ++k) {
      const int u = u0 + 2 * k + hl, row = u / 10, q = u - row * 10;
      oc[k] = q < 6 ? q * 64 : 768 + (q - 6) * 64;
      const int zc = q < 6 ? 1152 + q * 64 : PC + 768 + (q - 6) * 64;
      rb[k] = (size_t)row;
      o[k] = *(const unsigned*)(p + (size_t)row * PSTR + oc[k] + c2);
      z[k] = *(const unsigned*)(p + (size_t)row * PSTR + zc + c2);
    }
#pragma unroll
    for (int k = 0; k < 4; ++k) {
      const float o0 = __uint_as_float(o[k] << 16), o1 = __uint_as_float(o[k] & 0xffff0000u);
      const float z0 = __uint_as_float(z[k] << 16), z1 = __uint_as_float(z[k] & 0xffff0000u);
      const float rn = rsqrtf(half_sum(o0 * o0 + o1 * o1) * (1.f / 64.f) + 1e-6f);
      const f32x2 w = oc[k] < 384 ? gnw : hnw;
      *(unsigned*)(act + rb[k] * 1024 + oc[k] + c2) = pk2(o0 * rn * w[0] * silu(z0), o1 * rn * w[1] * silu(z1));
    }
  }
  for (int u0 = gw * 4; u0 < NTOK * 6; u0 += nw * 4) {
    unsigned o[2], r[2], kx[2], v[2], g[2]; int hh[2]; size_t rb[2];
#pragma unroll
    for (int k = 0; k < 2; ++k) {
      const int u = u0 + 2 * k + hl, row = u / 6, h = u - row * 6;
      const size_t idx = (size_t)row * 384 + h * 64 + c2;
      hh[k] = h; rb[k] = (size_t)row;
      o[k] = *(const unsigned*)(p + (size_t)row * PSTR + 384 + h * 64 + c2);
      r[k] = *(const unsigned*)(WSP(bf16_t, OFF_RR) + idx); kx[k] = *(const unsigned*)(WSP(bf16_t, OFF_RK) + idx);
      v[k] = *(const unsigned*)(WSP(bf16_t, OFF_RV) + idx); g[k] = *(const unsigned*)(WSP(bf16_t, OFF_RG) + idx);
    }
#pragma unroll
    for (int k = 0; k < 2; ++k) {
      const int hc = l * 384 + hh[k] * 64 + c2;
      const f32x2 lw = *(const f32x2*)(P.in[I_LNW] + hc), lb = *(const f32x2*)(P.in[I_LNB] + hc), rkw = *(const f32x2*)(P.in[I_RK] + hc);
      const float o0 = __uint_as_float(o[k] << 16), o1 = __uint_as_float(o[k] & 0xffff0000u);
      const float r0 = __uint_as_float(r[k] << 16), r1 = __uint_as_float(r[k] & 0xffff0000u);
      const float k0 = __uint_as_float(kx[k] << 16), k1 = __uint_as_float(kx[k] & 0xffff0000u);
      const float v0 = __uint_as_float(v[k] << 16), v1 = __uint_as_float(v[k] & 0xffff0000u);
      const float g0 = __uint_as_float(g[k] << 16), g1 = __uint_as_float(g[k] & 0xffff0000u);
      const float mu = half_sum(o0 + o1) * (1.f / 64.f);
      const float y0 = o0 - mu, y1 = o1 - mu;
      const float rn = rsqrtf(half_sum(y0 * y0 + y1 * y1) * (1.f / 64.f) + 64e-5f);
      const float rk = half_sum(r0 * k0 * rkw[0] + r1 * k1 * rkw[1]);
      *(unsigned*)(act + rb[k] * 1024 + 384 + hh[k] * 64 + c2) = pk2((y0 * rn * lw[0] + lb[0] + rk * v0) * g0, (y1 * rn * lw[1] + lb[1] + rk * v1) * g1);
    }
  }
}

#define XB_TMO      128
#define XB_XCNT(j)  (256  + 64 * (j))
#define XB_XSUB(j)  (1280 + 64 * (j))
#define XB_XGEN(j)  (2304 + 64 * (j))
#define XB_TOP      3328
#define XB_TOPGEN   3392
#define XCD_BAR_WORDS 3456
#define XB_SPIN_CAP (1u << 20)
#define LAS __attribute__((address_space(3)))
__device__ __forceinline__ unsigned xb_ld(unsigned* p)              { return __hip_atomic_load(p, __ATOMIC_RELAXED, __HIP_MEMORY_SCOPE_AGENT); }
__device__ __forceinline__ unsigned xb_add(unsigned* p, unsigned v) { return __hip_atomic_fetch_add(p, v, __ATOMIC_RELAXED, __HIP_MEMORY_SCOPE_AGENT); }
__device__ __forceinline__ unsigned xb_xcc_id() { return (unsigned)__builtin_amdgcn_s_getreg((3 << 11) | 20) & 0xFu; }
#define XB_SPIN(cond, bar) do { unsigned _sp = 0; while (cond) { __builtin_amdgcn_s_sleep(1); \
    if ((++_sp & 255u) == 0u) { if (xb_ld(&(bar)[XB_TMO])) break; if (_sp > XB_SPIN_CAP) { atomicAdd(&(bar)[XB_TMO], 1u); break; } } } } while (0)
struct XcdBarrier { unsigned* bar; unsigned x; volatile LAS unsigned* st; };
__device__ __forceinline__ XcdBarrier xcd_barrier_post(unsigned* bar, volatile LAS unsigned* st) {
  XcdBarrier b; b.bar = bar; b.x = xb_xcc_id(); b.st = st;
  if (threadIdx.x == 0) (void)xb_add(&bar[XB_XCNT(b.x)], 1u);
  return b;
}
__device__ __forceinline__ void xcd_barrier_complete(unsigned* bar, unsigned x, unsigned& nloc, unsigned& nx) {
  const unsigned G = gridDim.x * gridDim.y * gridDim.z;
  unsigned sum, cnt, mine, sp = 0u;
  for (;;) {
    sum = 0u; cnt = 0u; mine = 0u;
#pragma unroll
    for (unsigned j = 0; j < 16; ++j) { const unsigned c = xb_ld(&bar[XB_XCNT(j)]); sum += c; cnt += (c > 0u) ? 1u : 0u; mine = (j == x) ? c : mine; }
    if (sum == G) break;
    __builtin_amdgcn_s_sleep(1);
    if ((++sp & 255u) == 0u) { if (xb_ld(&bar[XB_TMO])) break; if (sp > XB_SPIN_CAP) { atomicAdd(&bar[XB_TMO], 1u); break; } }
  }
  nloc = mine > 0u ? mine : 1u; nx = cnt > 0u ? cnt : 1u;
}
__device__ __forceinline__ void xcd_barrier(const XcdBarrier& b) {
  asm volatile("s_waitcnt vmcnt(0)" ::: "memory");
  __syncthreads();
  if (threadIdx.x == 0) {
    unsigned* bar = b.bar;
    __builtin_amdgcn_s_waitcnt(0);
    unsigned nloc = b.st[0], nx = b.st[1];
    if (nloc == 0u) { xcd_barrier_complete(bar, b.x, nloc, nx); b.st[0] = nloc; b.st[1] = nx; }
    const unsigned old = xb_add(&bar[XB_XSUB(b.x)], 1u);
    const unsigned gen = old / nloc;
    if (old + 1u == (gen + 1u) * nloc) {
      __builtin_amdgcn_fence(__ATOMIC_RELEASE, "agent");
      asm volatile("s_waitcnt vmcnt(0)" ::: "memory");
      const unsigned og = xb_add(&bar[XB_TOP], 1u);
      const unsigned tg = og / nx;
      if (og + 1u == (tg + 1u) * nx) xb_add(&bar[XB_TOPGEN], 1u);
      else XB_SPIN(xb_ld(&bar[XB_TOPGEN]) == tg, bar);
      __builtin_amdgcn_fence(__ATOMIC_ACQUIRE, "agent");
      xb_add(&bar[XB_XGEN(b.x)], 1u);
      asm volatile("s_waitcnt vmcnt(0)" ::: "memory");
    } else {
      XB_SPIN(xb_ld(&bar[XB_XGEN(b.x)]) == gen, bar);
      __builtin_amdgcn_fence(__ATOMIC_ACQUIRE, "agent");
      asm volatile("s_waitcnt vmcnt(0)" ::: "memory");
    }
  }
  __syncthreads();
}

__global__ void __launch_bounds__(512, 2) hybrid_fwd(Params P) {
  cg::grid_group grid = cg::this_grid();
  __shared__ __attribute__((aligned(16))) unsigned char smem[131072 + 64];
  uint4& xb_words = *(uint4*)(smem + 131072);
  if (threadIdx.x == 0) xb_words = make_uint4(0u, 0u, 0u, 0u);
  __syncthreads();
  const XcdBarrier xb = xcd_barrier_post(WSP(unsigned, OFF_BAR), (volatile LAS unsigned*)&xb_words);
  if (threadIdx.x == 0) {
    const unsigned hw = (unsigned)__builtin_amdgcn_s_getreg((7 << 11) | (8 << 6) | 4) & 0xffu;
    const unsigned key = (xb.x << 8) | hw;
    ((volatile unsigned*)&xb_words)[2] = __hip_atomic_fetch_add(WSP(unsigned, OFF_CUTAB) + key, 1u, __ATOMIC_RELAXED, __HIP_MEMORY_SCOPE_AGENT);
  }
  __syncthreads();
#pragma unroll 1
  for (int step = 0; step < NLAYER * 9; ++step) {
    const int l = step / 9, ph = step - l * 9;
    switch (ph) {
      case 0: if (l == 0) wconv_phase(P, smem, 0); norm_phase(P, l, P.in[I_NORM_MIX] + l * D); break;
      case 1: gemm_phase<EPI_P>(P, smem, WSP(bf16_t, OFF_ACT), 1024, WSP(bf16_t, OFF_WTIN), 1024, 32, l, 4096);
              gemm_sample<EPI_P>(P, smem, WSP(bf16_t, OFF_ACT), 1024, WSP(bf16_t, OFF_WTIN), 1024, 249, l); break;
      case 2: prep_phase(P, smem, l, (volatile unsigned*)&xb_words); break;
      case 3: scan_phase(P, smem, l, (volatile unsigned*)&xb_words); break;
      case 4: post_phase(P, l); break;
      case 5: gemm_phase<EPI_RES>(P, smem, WSP(bf16_t, OFF_ACT), 1024, WSP(bf16_t, wt_out_off(l)), 1024, 8, l, 1024);
              gemm_sample<EPI_RES>(P, smem, WSP(bf16_t, OFF_ACT), 1024, WSP(bf16_t, wt_out_off(l)), 1024, 64, l); break;
      case 6: norm_phase(P, 1, P.in[I_NORM_FFN] + l * D); break;
      case 7: gemm_phase<EPI_SWIGLU>(P, smem, WSP(bf16_t, OFF_ACT), 1024, WSP(bf16_t, wt_gu_off(l)), 1024, 44, 1, 5632);
              gemm_sample<EPI_SWIGLU>(P, smem, WSP(bf16_t, OFF_ACT), 1024, WSP(bf16_t, wt_gu_off(l)), 1024, 176, 1); break;
      default: gemm_phase<EPI_RES>(P, smem, WSP(bf16_t, OFF_P), DFF, WSP(bf16_t, wt_dn_off(l)), DFF, 8, 1, 1024);
               gemm_sample<EPI_RES>(P, smem, WSP(bf16_t, OFF_P), DFF, WSP(bf16_t, wt_dn_off(l)), DFF, 64, 1); break;
    }
    if (step == 0) grid.sync();
    else xcd_barrier(xb);
  }
  final_norm_phase(P);
}

extern "C" void kernel_launch(void* const* d_in, const int* in_sizes, int n_in,
                              void* d_out, int out_size, void* d_ws, size_t ws_size,
                              hipStream_t stream) {
  static int grid_blocks = 0;
  if (!grid_blocks) {
    int dev = 0, cus = 0, per_cu = 0;
    (void)hipGetDevice(&dev);
    (void)hipDeviceGetAttribute(&cus, hipDeviceAttributeMultiprocessorCount, dev);
    (void)hipOccupancyMaxActiveBlocksPerMultiprocessor(&per_cu, hybrid_fwd, 512, 0);
    if (per_cu > 1) per_cu = 1;
    if (per_cu < 1) per_cu = 1;
    grid_blocks = cus * per_cu;
  }
  if (ws_size < WS_NEED) { fprintf(stderr, "workspace too small: %zu < %zu\n", ws_size, (size_t)WS_NEED); return; }
  Params p{};
  for (int i = 0; i < N_IN; ++i) p.in[i] = (const float*)d_in[i];
  p.out = (float*)d_out;
  p.ws = (unsigned char*)d_ws;
  (void)hipMemsetAsync((unsigned char*)d_ws + OFF_BAR, 0, BAR_BYTES, stream);
  void* args[] = {&p};
  hipError_t e = hipLaunchCooperativeKernel((void*)hybrid_fwd, dim3(grid_blocks), dim3(512), args, 0, stream);
  if (e != hipSuccess) fprintf(stderr, "cooperative launch failed: %s (grid %d)\n", hipGetErrorString(e), grid_blocks);
}
```

```cpp
#include <hip/hip_runtime.h>
#include <hip/hip_cooperative_groups.h>
#include <cstdio>
namespace cg = cooperative_groups;

typedef unsigned short bf16_t;
typedef short bf16x8 __attribute__((ext_vector_type(8)));
typedef float f32x4 __attribute__((ext_vector_type(4)));
typedef unsigned u32x4 __attribute__((ext_vector_type(4)));
typedef unsigned u32x2 __attribute__((ext_vector_type(2)));

constexpr int D = 1024, NTP = 16384, NTS = 128, NTOK = 16512, TSEQ = 2048, NLAYER = 4;
constexpr int IN_COLS = 3980, PSTR = 3984, DFF = 2816;
constexpr int PB = 1548, PC = 2956;

enum { I_XP = 0, I_XS, I_SGDN, I_SCONV, I_SRWKV, I_SSHIFT, I_SHGRN, I_NORM_MIX, I_WIN, I_WOUT, I_CONVW, I_ALOG, I_DTB, I_GNW,
       I_MU, I_W0, I_W2, I_A0, I_A2, I_G2, I_V0, I_V1, I_V2, I_KK, I_KA, I_RK, I_LNW, I_LNB, I_HLB, I_HNW, I_NORM_FFN,
       I_WG, I_WU, I_WD, I_NORM_FINAL, N_IN };

constexpr size_t O_YP = 0, O_YS = 16777216, O_GDN_P = 16908288, O_GDN_S = 17694720, O_CONV_P = 30277632, O_CONV_S = 30388224,
                 O_RWKV_P = 32157696, O_RWKV_S = 32944128, O_SHIFT_P = 45527040, O_SHIFT_S = 45572096, O_HGRN_P = 46292992,
                 O_HGRN_S = 46817280;

constexpr size_t SZ_WTIN = (size_t)4096 * 1024 * 2, SZ_WTOUT = (size_t)1024 * 1024 * 2, SZ_WTGU = (size_t)5632 * 1024 * 2,
                 SZ_WTDN = (size_t)1024 * 2816 * 2, SZ_P = (size_t)NTOK * PSTR * 2, SZ_ACT = (size_t)NTOK * 1024 * 2,
                 SZ_T384 = (size_t)NTOK * 384 * 2, SZ_T8F = (size_t)NTOK * 8 * 4, SZ_T256 = (size_t)NTOK * 256 * 2,
                 SZ_T384F = (size_t)NTOK * 384 * 4;
constexpr size_t OFF_WTIN = 0, OFF_WTOUT = OFF_WTIN + SZ_WTIN, OFF_WTGU = OFF_WTOUT + SZ_WTOUT, OFF_WTDN = OFF_WTGU + SZ_WTGU,
                 OFF_P = OFF_WTDN + SZ_WTDN, OFF_ACT = OFF_P + SZ_P, OFF_GQ = OFF_ACT + SZ_ACT, OFF_GK = OFF_GQ + SZ_T384,
                 OFF_GV = OFF_GK + SZ_T384, OFF_GDEC = OFF_GV + SZ_T384, OFF_GBETA = OFF_GDEC + SZ_T8F, OFF_HQ = OFF_GBETA + SZ_T8F,
                 OFF_HK = OFF_HQ + SZ_T256, OFF_RR = OFF_HK + SZ_T256, OFF_RK = OFF_RR + SZ_T384, OFF_RV = OFF_RK + SZ_T384,
                 OFF_RKK = OFF_RV + SZ_T384, OFF_RB = OFF_RKK + SZ_T384, OFF_RG = OFF_RB + SZ_T384, OFF_RW = OFF_RG + SZ_T384,
                 OFF_VF = OFF_RW + SZ_T384F, OFF_LORA = OFF_VF + SZ_T384, OFF_WTOUT2 = OFF_LORA + 245760, OFF_WTGU2 = OFF_WTOUT2 + SZ_WTOUT, OFF_WTDN2 = OFF_WTGU2 + SZ_WTGU, OFF_BAR = OFF_WTDN2 + SZ_WTDN, OFF_CUTAB = OFF_BAR + 16384, OFF_QUEUE = OFF_CUTAB + 16384, BAR_BYTES = 16384 + 16384 + 4096, WS_NEED = OFF_BAR + BAR_BYTES;
constexpr int W2T = 0, A2T = 24576, G2T = 49152, V1T = 98304, V2T = 110592;

struct Params {
  const float* in[N_IN];
  float* out;
  unsigned char* ws;
};

#define WSP(T, off) ((T*)(P.ws + (off)))

__device__ __forceinline__ int otid() { int t = __builtin_amdgcn_workitem_id_x(); asm volatile("" : "+v"(t)); return t; }
__device__ __forceinline__ int obid() { int b = __builtin_amdgcn_workgroup_id_x(); asm volatile("" : "+s"(b)); return b; }
template <class T> __device__ __forceinline__ const T* opq(const T* p) { asm volatile("" : "+s"(p)); return p; }
__device__ __forceinline__ float bf2f(bf16_t h) { return __uint_as_float(((unsigned)h) << 16); }
typedef float f32x2_t __attribute__((ext_vector_type(2)));
typedef __bf16 bf16x2_t __attribute__((ext_vector_type(2)));
__device__ __forceinline__ unsigned pk2(float lo, float hi) {
  const f32x2_t v = {lo, hi};
  return __builtin_bit_cast(unsigned, __builtin_convertvector(v, bf16x2_t));
}
__device__ __forceinline__ bf16_t f2bf(float f) { return (bf16_t)(pk2(f, 0.f) & 0xffffu); }
__device__ __forceinline__ float sigm(float x) { return 1.f / (1.f + __expf(-x)); }
__device__ __forceinline__ float silu(float x) { return x / (1.f + __expf(-x)); }
__device__ __forceinline__ float softplus(float x) { return x > 20.f ? x : log1pf(__expf(x)); }
template <int CTRL> __device__ __forceinline__ float dppf(float x) {
  return __builtin_bit_cast(float, __builtin_amdgcn_mov_dpp(__builtin_bit_cast(int, x), CTRL, 0xf, 0xf, true));
}
__device__ __forceinline__ float wave_sum(float v) {
  v += dppf<0xB1>(v); v += dppf<0x4E>(v); v += dppf<0x141>(v); v += dppf<0x140>(v);
  const int iv = __builtin_bit_cast(int, v);
  const float s0 = __builtin_bit_cast(float, __builtin_amdgcn_readlane(iv, 0)), s1 = __builtin_bit_cast(float, __builtin_amdgcn_readlane(iv, 16));
  const float s2 = __builtin_bit_cast(float, __builtin_amdgcn_readlane(iv, 32)), s3 = __builtin_bit_cast(float, __builtin_amdgcn_readlane(iv, 48));
  return (s0 + s1) + (s2 + s3);
}
typedef float f32x2 __attribute__((ext_vector_type(2)));
__device__ __forceinline__ float row_sum16(float v) { v += dppf<0xB1>(v); v += dppf<0x4E>(v); v += dppf<0x141>(v); v += dppf<0x140>(v); return v; }
__device__ __forceinline__ float half_sum(float v) { v = row_sum16(v); return v + __shfl_xor(v, 16); }
__device__ __forceinline__ float reduce8(float x) { x += dppf<0xB1>(x); x += dppf<0x4E>(x); x += dppf<0x141>(x); return x; }

__device__ __forceinline__ f32x4 unpack4(u32x2 w) {
  f32x4 f; f[0] = __uint_as_float(w[0] << 16); f[1] = __uint_as_float(w[0] & 0xffff0000u);
  f[2] = __uint_as_float(w[1] << 16); f[3] = __uint_as_float(w[1] & 0xffff0000u); return f;
}
__device__ __forceinline__ bf16x8 pack8(f32x4 a, f32x4 b) {
  u32x4 u; u[0] = pk2(a[0], a[1]); u[1] = pk2(a[2], a[3]); u[2] = pk2(b[0], b[1]); u[3] = pk2(b[2], b[3]);
  return __builtin_bit_cast(bf16x8, u);
}
__device__ __forceinline__ u32x2 pack4(f32x4 a) { u32x2 u; u[0] = pk2(a[0], a[1]); u[1] = pk2(a[2], a[3]); return u; }
__device__ __forceinline__ float dot4(f32x4 a, f32x4 b) { return (a[0] * b[0] + a[1] * b[1]) + (a[2] * b[2] + a[3] * b[3]); }
__device__ __forceinline__ const float* xin_row(const Params& P, int l, int row) {
  const float* po = opq((const float*)P.out); const float* pp = opq(P.in[I_XP]); const float* ps = opq(P.in[I_XS]);
  if (l > 0) return po + (size_t)row * D;
  return row < NTP ? pp + (size_t)row * D : ps + (size_t)(row - NTP) * D;
}

__device__ __forceinline__ int gu_row(int c, int up) { return (c >> 7) * 256 + up * 128 + (c & 127); }
__device__ __forceinline__ void xpose_tile(unsigned char* smem, const float* __restrict__ W, int N, int kt, int ntl, bf16_t* __restrict__ dst, int dstK, int mode) {
  float (*tile)[65] = (float (*)[65])smem;
  const int tid = otid();
  __syncthreads();
#pragma unroll 4
  for (int i = 0; i < 8; ++i) {
    const int k = i * 8 + (tid >> 6), n = tid & 63, gn = ntl * 64 + n;
    tile[k][n] = gn < N ? W[(size_t)(kt * 64 + k) * N + gn] : 0.f;
  }
  __syncthreads();
#pragma unroll 4
  for (int i = 0; i < 4; ++i) {
    const int n = i * 16 + (tid >> 5), k = (tid & 31) * 2, gn = ntl * 64 + n;
    const int drow = mode == 0 ? gn : gu_row(gn, mode - 1);
    *(unsigned*)(dst + (size_t)drow * dstK + kt * 64 + k) = pk2(tile[k][n], tile[k + 1][n]);
  }
}
constexpr int WCONV_JOBS = 3392 + 480;
__device__ __forceinline__ size_t wt_out_off(int l) { return (l & 1) ? OFF_WTOUT2 : OFF_WTOUT; }
__device__ __forceinline__ size_t wt_gu_off(int l) { return (l & 1) ? OFF_WTGU2 : OFF_WTGU; }
__device__ __forceinline__ size_t wt_dn_off(int l) { return (l & 1) ? OFF_WTDN2 : OFF_WTDN; }
__device__ __forceinline__ void wconv_job(const Params& P, unsigned char* smem, int l, int job) {
  if (job < 1024) xpose_tile(smem, P.in[I_WIN] + (size_t)l * 1024 * IN_COLS, IN_COLS, job & 15, job >> 4, WSP(bf16_t, OFF_WTIN), 1024, 0);
  else if (job < 1280) { const int j = job - 1024; xpose_tile(smem, P.in[I_WOUT] + (size_t)l * 1024 * 1024, 1024, j & 15, j >> 4, WSP(bf16_t, wt_out_off(l)), 1024, 0); }
  else if (job < 1984) { const int j = job - 1280; xpose_tile(smem, P.in[I_WG] + (size_t)l * 1024 * DFF, DFF, j & 15, j >> 4, WSP(bf16_t, wt_gu_off(l)), 1024, 1); }
  else if (job < 2688) { const int j = job - 1984; xpose_tile(smem, P.in[I_WU] + (size_t)l * 1024 * DFF, DFF, j & 15, j >> 4, WSP(bf16_t, wt_gu_off(l)), 1024, 2); }
  else if (job < 3392) { const int j = job - 2688; xpose_tile(smem, P.in[I_WD] + (size_t)l * DFF * 1024, 1024, j % 44, j / 44, WSP(bf16_t, wt_dn_off(l)), DFF, 0); }
  else {
    bf16_t* lw = WSP(bf16_t, OFF_LORA);
    const int idx = (job - 3392) * 256 + (otid() & 255);
    float v = 0.f;
    const float* pw2 = opq(P.in[I_W2]); const float* pa2 = opq(P.in[I_A2]); const float* pg2 = opq(P.in[I_G2]);
    const float* pv1 = opq(P.in[I_V1]); const float* pv2 = opq(P.in[I_V2]);
    if (idx < A2T) { const int n = idx >> 6, k = idx & 63; v = pw2[(size_t)l * 64 * 384 + k * 384 + n]; }
    else if (idx < G2T) { const int i = idx - A2T, n = i >> 6, k = i & 63; v = pa2[(size_t)l * 64 * 384 + k * 384 + n]; }
    else if (idx < V1T) { const int i = idx - G2T, n = i >> 7, k = i & 127; v = pg2[(size_t)l * 128 * 384 + k * 384 + n]; }
    else if (idx < V2T) { if (l > 0) { const int i = idx - V1T, n = i / 384, k = i - n * 384; v = pv1[(size_t)(l - 1) * 384 * 32 + k * 32 + n]; } }
    else { if (l > 0) { const int i = idx - V2T, n = i >> 5, k = i & 31; v = pv2[(size_t)(l - 1) * 32 * 384 + k * 384 + n]; } }
    if (otid() < 256) lw[idx] = f2bf(v);
  }
}
__device__ __forceinline__ void wconv_phase(const Params& P, unsigned char* smem, int l) {
  for (int j = obid(); j < 1024 + 480; j += gridDim.x) wconv_job(P, smem, l, j < 1024 ? j : j + 2368);
}

template <int NR, bool FINAL>
__device__ __forceinline__ void norm_rows(const Params& P, int l_in, const f32x4 (&wv)[4], int lane, int r0, int extra_row) {
  f32x4 v[NR][4];
#pragma unroll
  for (int r = 0; r < NR; ++r) {
    const int row = (NR == 5 && r == 4) ? extra_row : r0 + r;
    const float* xr = FINAL ? (const float*)(P.out + (size_t)row * D) : xin_row(P, l_in, row);
#pragma unroll
    for (int i = 0; i < 4; ++i) v[r][i] = *(const f32x4*)(xr + i * 256 + lane * 4);
  }
#pragma unroll
  for (int r = 0; r < NR; ++r) {
    const int row = (NR == 5 && r == 4) ? extra_row : r0 + r;
    float ss = 0.f;
#pragma unroll
    for (int i = 0; i < 4; ++i) ss += dot4(v[r][i], v[r][i]);
    const float rstd = rsqrtf(wave_sum(ss) * (1.f / 1024.f) + 1e-6f);
#pragma unroll
    for (int i = 0; i < 4; ++i) {
      if (FINAL) *(f32x4*)(P.out + (size_t)row * D + i * 256 + lane * 4) = v[r][i] * rstd * wv[i];
      else *(u32x2*)(WSP(bf16_t, OFF_ACT) + (size_t)row * 1024 + i * 256 + lane * 4) = pack4(v[r][i] * rstd * wv[i]);
    }
  }
}
template <bool FINAL>
__device__ __forceinline__ void norm_any(const Params& P, int l_in, const float* __restrict__ w) {
  const int lane = otid() & 63, wid = otid() >> 6;
  f32x4 wv[4];
#pragma unroll
  for (int i = 0; i < 4; ++i) wv[i] = *(const f32x4*)(w + i * 256 + lane * 4);
  const int nw = gridDim.x * 8;
  for (int gw = obid() * 8 + wid; gw * 8 < NTP; gw += nw) {
    norm_rows<4, FINAL>(P, l_in, wv, lane, gw * 8, 0);
    if (gw < NTS) norm_rows<5, FINAL>(P, l_in, wv, lane, gw * 8 + 4, NTP + gw);
    else norm_rows<4, FINAL>(P, l_in, wv, lane, gw * 8 + 4, 0);
  }
}
__device__ __forceinline__ void norm_phase(const Params& P, int l_in, const float* __restrict__ w) { norm_any<false>(P, l_in, w); }
__device__ __forceinline__ void final_norm_phase(const Params& P) { norm_any<true>(P, 1, P.in[I_NORM_FINAL]); }

enum { EPI_P = 0, EPI_RES = 1, EPI_SWIGLU = 2 };
namespace pg8 {
constexpr int BM = 256, BK = 64, HALF = 128, HTB = HALF * BK * 2, NXCD = 8, WGM = 8;
__device__ __forceinline__ int lds_byte(int r, int c) { const int st = (r >> 4) * 2 + (c >> 5), rr = r & 15, cc = c & 31, ob = rr * 64 + cc * 2; return st * 1024 + (ob ^ (((ob >> 9) & 1) << 5)); }
__device__ __forceinline__ void stage_rc(int b, int& R, int& C) { const int st = b / 1024, sb = b % 1024, swz = sb ^ (((sb >> 9) & 1) << 5); R = (st >> 1) * 16 + swz / 64; C = (st & 1) * 32 + (swz % 64) / 2; }
__device__ __forceinline__ int perm32(int rho) { const int n = rho >> 4, i = rho & 15; return 8 * (i >> 2) + 4 * n + (i & 3); }
struct Unit { int pm, pn; };
struct StaticOrder {
  int nM, nN, nwg, G, c;
  __device__ __forceinline__ void init(int M, int N, int G_, int c_) { nM = M / BM; nN = N / BM; nwg = nM * nN; G = G_; c = c_; }
  __device__ __forceinline__ bool next(int i, Unit& u) const {
    const long L = (long)i * G + c; if (L >= nwg) return false;
    int wgid = (int)L; { const int q = nwg / NXCD, r = nwg % NXCD, xcd = wgid % NXCD, off = wgid / NXCD; wgid = (xcd < r ? xcd * (q + 1) : r * (q + 1) + (xcd - r) * q) + off; }
    const int nig = WGM * nN, gid = wgid / nig, fm = gid * WGM, gsz = (nM - fm) < WGM ? (nM - fm) : WGM;
    u.pm = fm + ((wgid % nig) % gsz); u.pn = (wgid % nig) / gsz; return true;
  }
};
}

template <int EPI>
__device__ __forceinline__ void gemm_epilogue(const Params& P, const f32x4 (&acc)[2][2][4][2], const pg8::Unit& u, int wr, int wc, int fr, int fq, int l) {
#pragma unroll
  for (int ai = 0; ai < 2; ++ai)
#pragma unroll
    for (int m = 0; m < 4; ++m) {
      const int row = u.pm * 256 + ai * 128 + wr * 64 + m * 16 + fr;
      if (EPI == EPI_P) {
        bf16_t* pr = WSP(bf16_t, OFF_P) + (size_t)row * PSTR;
#pragma unroll
        for (int bj = 0; bj < 2; ++bj) {
          const int col = u.pn * 256 + bj * 128 + wc * 32 + fq * 8;
          if (col < PSTR) { const u32x2 lo = pack4(acc[ai][bj][m][0]), hi = pack4(acc[ai][bj][m][1]); *(u32x4*)(pr + col) = (u32x4){lo[0], lo[1], hi[0], hi[1]}; }
        }
      } else if (EPI == EPI_RES) {
        const float* xi = xin_row(P, l, row);
        float* xo = P.out + (size_t)row * D;
#pragma unroll
        for (int bj = 0; bj < 2; ++bj)
#pragma unroll
          for (int n = 0; n < 2; ++n) {
            const int col = u.pn * 256 + bj * 128 + wc * 32 + n * 16 + fq * 4;
            *(f32x4*)(xo + col) = *(const f32x4*)(xi + col) + acc[ai][bj][m][n];
          }
      } else {
        bf16_t* ur = WSP(bf16_t, OFF_P) + (size_t)row * DFF;
        {
          const int col = u.pn * 128 + wc * 32 + fq * 8;
          f32x4 r0, r1;
#pragma unroll
          for (int j = 0; j < 4; ++j) { r0[j] = silu(acc[ai][0][m][0][j]) * acc[ai][1][m][0][j]; r1[j] = silu(acc[ai][0][m][1][j]) * acc[ai][1][m][1][j]; }
          const u32x2 lo = pack4(r0), hi = pack4(r1);
          *(u32x4*)(ur + col) = (u32x4){lo[0], lo[1], hi[0], hi[1]};
        }
      }
    }
}

#define PG8_LAS __attribute__((address_space(3)))
template <int EPI>
__device__ __forceinline__ void gemm_phase(const Params& P, unsigned char* smem, const bf16_t* __restrict__ Ag, int lda_unused, const bf16_t* __restrict__ Btg, int K, int nN128_unused, int l, int N) {
  using namespace pg8;
  PG8_LAS unsigned char* lds = (PG8_LAS unsigned char*)smem;
  const int tid = otid(), wid = __builtin_amdgcn_readfirstlane(tid >> 6), lane = tid & 63, wr = wid >> 2, wc = wid & 3, fr = lane & 15, fq = lane >> 4;
  const int nt = K / BK;
  StaticOrder S; S.init(NTP, N, (int)gridDim.x, obid());
  unsigned voffA[2], voffB[2];
#pragma unroll
  for (int i = 0; i < 2; ++i) { int R, C; stage_rc(tid * 16 + i * 8192, R, C); const int Rb = EPI == EPI_RES ? R : ((R & ~31) + perm32(R & 31));
    voffA[i] = (unsigned)(R * K + C) * 2u; voffB[i] = (unsigned)(Rb * K + C) * 2u; }
  const size_t kstep = (size_t)(BK * 2);
  const size_t hstep = (size_t)HALF * K * 2;
  const size_t tstep = 2 * hstep;
  const unsigned ldsw = (unsigned)wid * 1024u;
  const int aoff = lds_byte(wr * 64 + fr, fq * 8), boff = lds_byte(wc * 32 + fr, fq * 8);
#define PG8_SA(b, h) (((b) * 2 + (h)) * HTB)
#define PG8_SB(b, h) ((4 + (b) * 2 + (h)) * HTB)
#define PG8_STAGE(bufoff, gbase, voff) do { _Pragma("unroll") for (int _i = 0; _i < 2; ++_i) \
        __builtin_amdgcn_global_load_lds((const unsigned*)((const char*)(gbase) + (voff)[_i]), (PG8_LAS unsigned*)(lds + (bufoff) + ldsw + _i * 8192), 16, 0, 0); } while (0)
#define PG8_LDA(dst, b, h) do { _Pragma("unroll") for (int m = 0; m < 4; ++m) _Pragma("unroll") for (int k = 0; k < 2; ++k) dst[m][k] = *(const PG8_LAS bf16x8*)(lds + PG8_SA(b, h) + aoff + m * 2048 + k * 1024); } while (0)
#define PG8_LDB(dst, b, h) do { _Pragma("unroll") for (int n = 0; n < 2; ++n) _Pragma("unroll") for (int k = 0; k < 2; ++k) dst[n][k] = *(const PG8_LAS bf16x8*)(lds + PG8_SB(b, h) + boff + n * 2048 + k * 1024); } while (0)
#define PG8_MMA(ai, bj, At, Bt) do { __builtin_amdgcn_s_setprio(1); _Pragma("unroll") for (int m = 0; m < 4; ++m) _Pragma("unroll") for (int n = 0; n < 2; ++n) _Pragma("unroll") for (int k = 0; k < 2; ++k) \
        acc[ai][bj][m][n] = __builtin_amdgcn_mfma_f32_16x16x32_bf16(Bt[n][k], At[m][k], acc[ai][bj][m][n], 0, 0, 0); __builtin_amdgcn_s_setprio(0); } while (0)
#define PG8_WAIT_V(n) asm volatile("s_waitcnt vmcnt(" #n ")" ::: "memory")
#define PG8_WAIT_L(n) asm volatile("s_waitcnt lgkmcnt(" #n ")" ::: "memory")
#define PG8_BAR __builtin_amdgcn_s_barrier()
#define PG8_SCHED __builtin_amdgcn_sched_barrier(0)
  Unit cur, nxt; int ui = 0;
  if (!S.next(0, cur)) return;
  f32x4 acc[2][2][4][2];
#pragma unroll
  for (int a = 0; a < 2; ++a)
#pragma unroll
    for (int b = 0; b < 2; ++b)
#pragma unroll
      for (int m = 0; m < 4; ++m)
#pragma unroll
        for (int n = 0; n < 2; ++n) acc[a][b][m][n] = (f32x4){0.f, 0.f, 0.f, 0.f};
  bf16x8 At[4][2], B0[2][2], B1[2][2];
  const char* cA = (const char*)Ag + (size_t)cur.pm * tstep; const char* cB = (const char*)Btg + (size_t)cur.pn * tstep;
  PG8_STAGE(PG8_SB(0, 0), cB, voffB); PG8_STAGE(PG8_SA(0, 0), cA, voffA); PG8_STAGE(PG8_SB(0, 1), cB + hstep, voffB); PG8_STAGE(PG8_SA(0, 1), cA + hstep, voffA);
  if (wr == 1) PG8_BAR;
  PG8_WAIT_V(4); PG8_BAR;
  PG8_STAGE(PG8_SB(1, 0), cB + kstep, voffB); PG8_STAGE(PG8_SA(1, 0), cA + kstep, voffA); PG8_STAGE(PG8_SB(1, 1), cB + hstep + kstep, voffB);
  PG8_WAIT_V(6); PG8_BAR;
  for (;;) {
    const bool has_next = S.next(ui + 1, nxt);
    const char* nA = has_next ? (const char*)Ag + (size_t)nxt.pm * tstep : cA; const char* nB = has_next ? (const char*)Btg + (size_t)nxt.pn * tstep : cB;
    for (int t = 0; t < nt; t += 2) {
      const bool last = (t == nt - 2);
      const char* a1 = cA + (size_t)(t + 1) * kstep;
      const char* a2 = last ? nA : cA + (size_t)(t + 2) * kstep; const char* b2 = last ? nB : cB + (size_t)(t + 2) * kstep;
      const char* a3 = a2 + kstep; const char* b3 = b2 + kstep;
      PG8_LDB(B0, 0, 0); PG8_SCHED; PG8_LDA(At, 0, 0); PG8_STAGE(PG8_SA(1, 1), a1 + hstep, voffA);
      PG8_WAIT_L(8); PG8_BAR; PG8_WAIT_L(0); PG8_MMA(0, 0, At, B0); PG8_BAR; PG8_SCHED;
      PG8_LDB(B1, 0, 1); PG8_STAGE(PG8_SB(0, 0), b2, voffB);
      PG8_BAR; PG8_WAIT_L(0); PG8_MMA(0, 1, At, B1); PG8_BAR;
      PG8_LDA(At, 0, 1); PG8_STAGE(PG8_SA(0, 0), a2, voffA);
      PG8_BAR; PG8_WAIT_L(0); PG8_MMA(1, 0, At, B0); PG8_BAR; PG8_SCHED;
      PG8_STAGE(PG8_SB(0, 1), b2 + hstep, voffB);
      PG8_WAIT_V(6); PG8_BAR; PG8_MMA(1, 1, At, B1); PG8_BAR;
      PG8_LDB(B0, 1, 0); PG8_SCHED; PG8_LDA(At, 1, 0); PG8_STAGE(PG8_SA(0, 1), a2 + hstep, voffA);
      PG8_WAIT_L(8); PG8_BAR; PG8_WAIT_L(0); PG8_MMA(0, 0, At, B0); PG8_BAR; PG8_SCHED;
      PG8_LDB(B1, 1, 1); PG8_STAGE(PG8_SB(1, 0), b3, voffB);
      PG8_BAR; PG8_WAIT_L(0); PG8_MMA(0, 1, At, B1); PG8_BAR;
      PG8_LDA(At, 1, 1); PG8_STAGE(PG8_SA(1, 0), a3, voffA);
      PG8_BAR; PG8_WAIT_L(0); PG8_MMA(1, 0, At, B0); PG8_BAR; PG8_SCHED;
      PG8_STAGE(PG8_SB(1, 1), b3 + hstep, voffB);
      PG8_WAIT_V(6); PG8_BAR; PG8_MMA(1, 1, At, B1); PG8_BAR;
    }
    gemm_epilogue<EPI>(P, acc, cur, wr, wc, fr, fq, l);
    if (!has_next) break;
#pragma unroll
    for (int a = 0; a < 2; ++a)
#pragma unroll
      for (int b = 0; b < 2; ++b)
#pragma unroll
        for (int m = 0; m < 4; ++m)
#pragma unroll
          for (int n = 0; n < 2; ++n) acc[a][b][m][n] = (f32x4){0.f, 0.f, 0.f, 0.f};
    cur = nxt; cA = nA; cB = nB; ++ui;
  }
  PG8_WAIT_V(0);
  if (wr == 0) PG8_BAR;
  PG8_BAR;
#undef PG8_SA
#undef PG8_SB
#undef PG8_STAGE
#undef PG8_LDA
#undef PG8_LDB
#undef PG8_MMA
#undef PG8_WAIT_V
#undef PG8_WAIT_L
#undef PG8_BAR
#undef PG8_SCHED
}

template <int EPI, int MF = 8>
__device__ __forceinline__ void gemm_sample(const Params& P, unsigned char* smem, const bf16_t* __restrict__ A, int lda, const bf16_t* __restrict__ Bt, int K, int nunits, int l) {
  const int tid = otid(), lane = tid & 63, wid = tid >> 6, fr = lane & 15, fq = lane >> 4;
  const int kslice = K >> 3;
  constexpr int RQ = 8 / MF;
  for (int uu = (int)gridDim.x - 1 - obid(); uu < nunits; uu += gridDim.x) {
    const int u = uu / RQ, rbase = NTP + (uu - u * RQ) * MF * 16;
    const int brow0 = EPI == EPI_SWIGLU ? gu_row(u * 16 + fr, 0) : u * 16 + fr;
    const int brow1 = EPI == EPI_SWIGLU ? gu_row(u * 16 + fr, 1) : 0;
    const bf16_t* ap = A + (size_t)(rbase + fr) * lda + wid * kslice + fq * 8;
    const bf16_t* b0p = Bt + (size_t)brow0 * K + wid * kslice + fq * 8;
    const bf16_t* b1p = Bt + (size_t)brow1 * K + wid * kslice + fq * 8;
    f32x4 c0[MF], c1[MF];
#pragma unroll
    for (int m = 0; m < MF; ++m) { c0[m] = (f32x4){0.f, 0.f, 0.f, 0.f}; c1[m] = c0[m]; }
#pragma unroll(MF == 2 ? 4 : 2)
    for (int ks = 0; ks < kslice; ks += 32) {
      bf16x8 Af[MF];
#pragma unroll
      for (int m = 0; m < MF; ++m) Af[m] = *(const bf16x8*)(ap + (size_t)m * 16 * lda + ks);
      const bf16x8 B0 = *(const bf16x8*)(b0p + ks);
      bf16x8 B1 = B0;
      if (EPI == EPI_SWIGLU) B1 = *(const bf16x8*)(b1p + ks);
#pragma unroll
      for (int m = 0; m < MF; ++m) {
        c0[m] = __builtin_amdgcn_mfma_f32_16x16x32_bf16(B0, Af[m], c0[m], 0, 0, 0);
        if (EPI == EPI_SWIGLU) c1[m] = __builtin_amdgcn_mfma_f32_16x16x32_bf16(B1, Af[m], c1[m], 0, 0, 0);
      }
    }
    __syncthreads();
#pragma unroll
    for (int m = 0; m < MF; ++m) {
      *(f32x4*)(smem + ((wid * MF + m) * 64 + lane) * 16) = c0[m];
      if (EPI == EPI_SWIGLU) *(f32x4*)(smem + 65536 + ((wid * MF + m) * 64 + lane) * 16) = c1[m];
    }
    __syncthreads();
    if (wid < MF) {
      f32x4 g = (f32x4){0.f, 0.f, 0.f, 0.f}, up = g;
#pragma unroll
      for (int w = 0; w < 8; ++w) {
        g += *(const f32x4*)(smem + ((w * MF + wid) * 64 + lane) * 16);
        if (EPI == EPI_SWIGLU) up += *(const f32x4*)(smem + 65536 + ((w * MF + wid) * 64 + lane) * 16);
      }
      const int row = rbase + wid * 16 + fr, col = u * 16 + fq * 4;
      if (EPI == EPI_P) {
        if (col < IN_COLS) *(u32x2*)(WSP(bf16_t, OFF_P) + (size_t)row * PSTR + col) = pack4(g);
      } else if (EPI == EPI_RES) {
        const float* xi = xin_row(P, l, row);
        *(f32x4*)(P.out + (size_t)row * D + col) = *(const f32x4*)(xi + col) + g;
      } else {
        f32x4 r;
#pragma unroll
        for (int j = 0; j < 4; ++j) r[j] = silu(g[j]) * up[j];
        *(u32x2*)(WSP(bf16_t, OFF_P) + (size_t)row * DFF + col) = pack4(r);
      }
    }
  }
}

__device__ __forceinline__ float lbval(const Params& P, int l, int c) {
  const float* hb = P.in[I_HLB];
  const float a0 = hb[c], a1 = hb[256 + c], a2 = hb[512 + c], a3 = hb[768 + c];
  const float m = fmaxf(fmaxf(a0, a1), fmaxf(a2, a3));
  const float e0 = __expf(a0 - m), e1 = __expf(a1 - m), e2 = __expf(a2 - m), e3 = __expf(a3 - m);
  const float inv = 1.f / (e0 + e1 + e2 + e3);
  float s = 0.f;
  if (l >= 1) s += e1; if (l >= 2) s += e2; if (l >= 3) s += e3;
  return s * inv;
}

__device__ __forceinline__ void gdn_conv_emit2(const Params& P, int g, int c2, int row, float s0, float s1) {
  const int h = g % 6;
  if (g < 12) {
    const float rn = rsqrtf(half_sum(s0 * s0 + s1 * s1) + 1e-6f) * (g < 6 ? 0.125f : 1.f);
    *(unsigned*)((g < 6 ? WSP(bf16_t, OFF_GQ) : WSP(bf16_t, OFF_GK)) + (size_t)row * 384 + h * 64 + c2) = pk2(s0 * rn, s1 * rn);
  } else {
    *(unsigned*)(WSP(bf16_t, OFF_GV) + (size_t)row * 384 + h * 64 + c2) = pk2(s0, s1);
  }
}
__device__ __forceinline__ void gdn_gate_emit(const Params& P, int l, int h, int row) {
  const bf16_t* pr = WSP(bf16_t, OFF_P) + (size_t)row * PSTR;
  const float braw = bf2f(pr[1536 + h]), araw = bf2f(pr[1542 + h]);
  const float gg = -__expf(P.in[I_ALOG][l * 6 + h]) * softplus(araw + P.in[I_DTB][l * 6 + h]);
  WSP(float, OFF_GDEC)[(size_t)row * 8 + h] = __expf(gg);
  WSP(float, OFF_GBETA)[(size_t)row * 8 + h] = sigm(braw);
}
__device__ __forceinline__ void prep_gdn_prompt(const Params& P, int l, int ci) {
  const int lane = otid() & 63, wid = otid() >> 6, hl = lane >> 5, c2 = (lane & 31) * 2;
  const int r0 = ci * 32, b = r0 / TSEQ, t0 = r0 % TSEQ;
  const bf16_t* p = WSP(bf16_t, OFF_P);
  for (int gp = wid; gp < 9; gp += 8) {
    const int g = gp * 2 + hl, col = g * 64 + c2;
    const float* cw = P.in[I_CONVW] + (size_t)l * 4 * 1152 + col;
    const f32x2 w0 = *(const f32x2*)cw, w1 = *(const f32x2*)(cw + 1152), w2 = *(const f32x2*)(cw + 2304), w3 = *(const f32x2*)(cw + 3456);
    unsigned xr[35];
#pragma unroll
    for (int t = 0; t < 35; ++t) xr[t] = (t >= 3 || t0 > 0) ? *(const unsigned*)(p + (size_t)(r0 - 3 + t) * PSTR + col) : 0u;
    f32x2 x3 = {__uint_as_float(xr[0] << 16), __uint_as_float(xr[0] & 0xffff0000u)};
    f32x2 x2 = {__uint_as_float(xr[1] << 16), __uint_as_float(xr[1] & 0xffff0000u)};
    f32x2 x1 = {__uint_as_float(xr[2] << 16), __uint_as_float(xr[2] & 0xffff0000u)};
#pragma unroll
    for (int t = 0; t < 32; ++t) {
      const f32x2 x0 = {__uint_as_float(xr[t + 3] << 16), __uint_as_float(xr[t + 3] & 0xffff0000u)};
      const f32x2 y = w0 * x3 + w1 * x2 + w2 * x1 + w3 * x0;
      gdn_conv_emit2(P, g, c2, r0 + t, silu(y[0]), silu(y[1]));
      x3 = x2; x2 = x1; x1 = x0;
    }
    if (t0 + 32 == TSEQ) {
      float* cp = P.out + O_CONV_P + (size_t)(l * 8 + b) * 3 * 1152 + col;
      *(f32x2*)cp = x3; *(f32x2*)(cp + 1152) = x2; *(f32x2*)(cp + 2304) = x1;
    }
    if (g < 6) gdn_gate_emit(P, l, g, r0 + (lane & 31));
  }
}
__device__ __forceinline__ void prep_gdn_sample(const Params& P, int l, int si) {
  const int lane = otid() & 63, wid = otid() >> 6, hl = lane >> 5, c2 = (lane & 31) * 2;
  const bf16_t* p = WSP(bf16_t, OFF_P);
  for (int u = wid; u < 18; u += 8) {
    const int s = si * 2 + u / 9, g = (u % 9) * 2 + hl, col = g * 64 + c2, row = NTP + s;
    const float* cw = P.in[I_CONVW] + (size_t)l * 4 * 1152 + col;
    const f32x2 w0 = *(const f32x2*)cw, w1 = *(const f32x2*)(cw + 1152), w2 = *(const f32x2*)(cw + 2304), w3 = *(const f32x2*)(cw + 3456);
    const float* cb = P.in[I_SCONV] + (size_t)(l * 128 + s) * 3 * 1152 + col;
    const f32x2 x3 = *(const f32x2*)cb, x2 = *(const f32x2*)(cb + 1152), x1 = *(const f32x2*)(cb + 2304);
    const unsigned xw = *(const unsigned*)(p + (size_t)row * PSTR + col);
    const f32x2 x0 = {__uint_as_float(xw << 16), __uint_as_float(xw & 0xffff0000u)};
    const f32x2 y = w0 * x3 + w1 * x2 + w2 * x1 + w3 * x0;
    gdn_conv_emit2(P, g, c2, row, silu(y[0]), silu(y[1]));
    float* cp = P.out + O_CONV_S + (size_t)(l * 128 + s) * 3 * 1152 + col;
    *(f32x2*)cp = x2; *(f32x2*)(cp + 1152) = x1; *(f32x2*)(cp + 2304) = x0;
    if (g < 6 && (lane & 31) == 0) gdn_gate_emit(P, l, g, row);
  }
}
__device__ __forceinline__ void prep_hgrn(const Params& P, int l, int ti) {
  const int c2 = (otid() & 127) * 2, tg = otid() >> 7;
  const float oml0 = 1.f - lbval(P, l, c2), oml1 = 1.f - lbval(P, l, c2 + 1);
  const bf16_t* p = WSP(bf16_t, OFF_P);
  bf16_t* hq = WSP(bf16_t, OFF_HQ); bf16_t* hk = WSP(bf16_t, OFF_HK);
  for (int t0 = tg * 16; t0 < tg * 16 + 16; t0 += 8) {
    unsigned q[8], f[8];
#pragma unroll
    for (int i = 0; i < 8; ++i) { const int row = ti * 64 + t0 + i; q[i] = *(const unsigned*)(p + (size_t)row * PSTR + PC + c2); f[i] = *(const unsigned*)(p + (size_t)row * PSTR + PC + 256 + c2); }
#pragma unroll
    for (int i = 0; i < 8; ++i) {
      const int row = ti * 64 + t0 + i;
      const float q0 = __uint_as_float(q[i] << 16), q1 = __uint_as_float(q[i] & 0xffff0000u);
      const float f0 = __uint_as_float(f[i] << 16), f1 = __uint_as_float(f[i] & 0xffff0000u);
      *(unsigned*)(hq + (size_t)row * 256 + c2) = pk2(silu(q0) * 0.125f, silu(q1) * 0.125f);
      *(unsigned*)(hk + (size_t)row * 256 + c2) = pk2(oml0 * sigm(-f0), oml1 * sigm(-f1));
    }
  }
}
template <bool SAMP>
__device__ __forceinline__ f32x4 xs4t(const Params& P, int l, int row, int col0) {
  const bf16_t* p = WSP(bf16_t, OFF_P);
  const f32x4 pv = unpack4(*(const u32x2*)(p + (size_t)row * PSTR + PB + col0));
  f32x4 prev;
  if (SAMP) prev = *(const f32x4*)(P.in[I_SSHIFT] + (size_t)(l * 128 + (row - NTP)) * 1408 + col0);
  else {
    const bool first = (row & (TSEQ - 1)) == 0;
    prev = unpack4(*(const u32x2*)(p + (size_t)(row - (first ? 0 : 1)) * PSTR + PB + col0)) * (first ? 0.f : 1.f);
  }
  const f32x4 mu = *(const f32x4*)(P.in[I_MU] + l * 1408 + col0);
  return pv + (prev - pv) * mu;
}
__device__ __forceinline__ float tanh_fast(float x) { return 1.f - 2.f / (__expf(2.f * x) + 1.f); }

template <int ROWB>
__device__ __forceinline__ void stage_lora(unsigned char* smem, const bf16_t* __restrict__ src) {
  constexpr int CPR = ROWB / 16, NCH = 384 * CPR;
  __syncthreads();
  u32x4 t[NCH / 512];
#pragma unroll
  for (int i = 0; i < NCH / 512; ++i) t[i] = *(const u32x4*)((const unsigned char*)src + (size_t)(otid() + i * 512) * 16);
#pragma unroll
  for (int i = 0; i < NCH / 512; ++i) { const int idx = otid() + i * 512, r = idx / CPR, c = idx - r * CPR; *(u32x4*)(smem + r * (ROWB + 16) + c * 16) = t[i]; }
  __syncthreads();
}
template <int ROWB>
__device__ __forceinline__ void stage_lora_open(unsigned char* smem, const bf16_t* __restrict__ src) {
  constexpr int CPR = ROWB / 16, NCH = 384 * CPR;
  __syncthreads();
  u32x4 t[NCH / 512];
#pragma unroll
  for (int i = 0; i < NCH / 512; ++i) t[i] = *(const u32x4*)((const unsigned char*)src + (size_t)(otid() + i * 512) * 16);
#pragma unroll
  for (int i = 0; i < NCH / 512; ++i) { const int idx = otid() + i * 512, r = idx / CPR, c = idx - r * CPR; *(u32x4*)(smem + r * (ROWB + 16) + c * 16) = t[i]; }
}
constexpr int EXCH_OFF = 110592;
__device__ __forceinline__ unsigned char* exch_slot(unsigned char* smem, int wid, int slot, int lane) { return smem + EXCH_OFF + ((wid * 2 + slot) * 64 + lane) * 16; }
template <bool SAMP>
__device__ __forceinline__ void prep_rwkv_unit(const Params& P, unsigned char* smem, int l, int mt, int hh) {
  const int lane = otid() & 63, fr = lane & 15, fq = lane >> 4, wid = otid() >> 6;
  const int row = mt * 16 + fr, cb = hh * 192;
  const bf16_t* lw = WSP(bf16_t, OFF_LORA);
  const size_t ro = (size_t)row * 384;
  f32x4 acc[12];
  {
    bf16x8 Bf[2][12];
    f32x4 x0 = xs4t<SAMP>(P, l, row, 1152 + hh * 32 + fq * 8), x1 = xs4t<SAMP>(P, l, row, 1152 + hh * 32 + fq * 8 + 4);
    stage_lora_open<128>(smem, lw + W2T);
#pragma unroll
    for (int j = 0; j < 4; ++j) { x0[j] = tanh_fast(x0[j]); x1[j] = tanh_fast(x1[j]); }
    const bf16x8 Am = pack8(x0, x1);
    *(bf16x8*)exch_slot(smem, wid, 0, lane) = Am;
    __syncthreads();
    const bf16x8 Ao = *(const bf16x8*)exch_slot(smem, wid ^ 1, 0, lane);
    bf16x8 Aw[2]; Aw[0] = hh ? Ao : Am; Aw[1] = hh ? Am : Ao;
#pragma unroll
    for (int ks = 0; ks < 2; ++ks)
#pragma unroll
      for (int nf = 0; nf < 12; ++nf) Bf[ks][nf] = *(const bf16x8*)(smem + (cb + nf * 16 + fr) * 144 + ks * 64 + fq * 16);
#pragma unroll
    for (int nf = 0; nf < 12; ++nf) acc[nf] = (f32x4){0.f, 0.f, 0.f, 0.f};
#pragma unroll
    for (int ks = 0; ks < 2; ++ks) {
#pragma unroll
      for (int nf = 0; nf < 12; ++nf) acc[nf] = __builtin_amdgcn_mfma_f32_16x16x32_bf16(Bf[ks][nf], Aw[ks], acc[nf], 0, 0, 0);
    }
    f32x4 w0v[12];
#pragma unroll
    for (int nf = 0; nf < 12; ++nf) w0v[nf] = *(const f32x4*)(P.in[I_W0] + l * 384 + cb + nf * 16 + fq * 4);
#pragma unroll
    for (int nf = 0; nf < 12; ++nf) {
      f32x4 d;
#pragma unroll
      for (int j = 0; j < 4; ++j) {
        const float xx = -(w0v[nf][j] + acc[nf][j]);
        const float sp = xx > 15.f ? xx : __logf(1.f + __expf(xx));
        d[j] = __expf(-__expf(-sp - 0.5f));
      }
      *(f32x4*)(WSP(float, OFF_RW) + ro + cb + nf * 16 + fq * 4) = d;
    }
  }
  {
    bf16x8 Bf[2][12];
    const f32x4 x0 = xs4t<SAMP>(P, l, row, 1216 + hh * 32 + fq * 8), x1 = xs4t<SAMP>(P, l, row, 1216 + hh * 32 + fq * 8 + 4);
    stage_lora_open<128>(smem, lw + A2T);
    const bf16x8 Am = pack8(x0, x1);
    *(bf16x8*)exch_slot(smem, wid, 0, lane) = Am;
    __syncthreads();
    const bf16x8 Ao = *(const bf16x8*)exch_slot(smem, wid ^ 1, 0, lane);
    bf16x8 Aw[2]; Aw[0] = hh ? Ao : Am; Aw[1] = hh ? Am : Ao;
#pragma unroll
    for (int ks = 0; ks < 2; ++ks)
#pragma unroll
      for (int nf = 0; nf < 12; ++nf) Bf[ks][nf] = *(const bf16x8*)(smem + (cb + nf * 16 + fr) * 144 + ks * 64 + fq * 16);
#pragma unroll
    for (int nf = 0; nf < 12; ++nf) acc[nf] = (f32x4){0.f, 0.f, 0.f, 0.f};
#pragma unroll
    for (int ks = 0; ks < 2; ++ks) {
#pragma unroll
      for (int nf = 0; nf < 12; ++nf) acc[nf] = __builtin_amdgcn_mfma_f32_16x16x32_bf16(Bf[ks][nf], Aw[ks], acc[nf], 0, 0, 0);
    }
  }
#pragma unroll
  for (int hl = 0; hl < 3; ++hl) {
    f32x4 kr[4], rr[4], kkw[4], a0[4], ka[4];
#pragma unroll
    for (int q = 0; q < 4; ++q) {
      const int c = cb + (hl * 4 + q) * 16 + fq * 4;
      kr[q] = xs4t<SAMP>(P, l, row, 384 + c); rr[q] = xs4t<SAMP>(P, l, row, c);
      kkw[q] = *(const f32x4*)(P.in[I_KK] + l * 384 + c); a0[q] = *(const f32x4*)(P.in[I_A0] + l * 384 + c); ka[q] = *(const f32x4*)(P.in[I_KA] + l * 384 + c);
    }
    float ss = 0.f;
#pragma unroll
    for (int q = 0; q < 4; ++q) { kkw[q] = kr[q] * kkw[q]; ss += dot4(kkw[q], kkw[q]); }
    ss += __shfl_xor(ss, 16); ss += __shfl_xor(ss, 32);
    const float rn = rsqrtf(ss + 1e-6f);
#pragma unroll
    for (int q = 0; q < 4; ++q) {
      const int nf = hl * 4 + q, c = cb + nf * 16 + fq * 4;
      f32x4 kn, kk, kb;
#pragma unroll
      for (int j = 0; j < 4; ++j) {
        const float a = sigm(a0[q][j] + acc[nf][j]);
        kk[j] = kkw[q][j] * rn; kb[j] = kk[j] * a; kn[j] = kr[q][j] * (1.f + (a - 1.f) * ka[q][j]);
      }
      *(u32x2*)(WSP(bf16_t, OFF_RK) + ro + c) = pack4(kn);
      *(u32x2*)(WSP(bf16_t, OFF_RKK) + ro + c) = pack4(kk);
      *(u32x2*)(WSP(bf16_t, OFF_RB) + ro + c) = pack4(kb);
      *(u32x2*)(WSP(bf16_t, OFF_RR) + ro + c) = pack4(rr[q]);
    }
  }
  {
    f32x4 x[2][2];
#pragma unroll
    for (int k2 = 0; k2 < 2; ++k2) { x[k2][0] = xs4t<SAMP>(P, l, row, 1280 + (hh * 2 + k2) * 32 + fq * 8); x[k2][1] = xs4t<SAMP>(P, l, row, 1280 + (hh * 2 + k2) * 32 + fq * 8 + 4); }
    stage_lora_open<256>(smem, lw + G2T);
    bf16x8 Am[2], Ao[2];
#pragma unroll
    for (int k2 = 0; k2 < 2; ++k2) {
#pragma unroll
      for (int j = 0; j < 4; ++j) { x[k2][0][j] = sigm(x[k2][0][j]); x[k2][1][j] = sigm(x[k2][1][j]); }
      Am[k2] = pack8(x[k2][0], x[k2][1]);
      *(bf16x8*)exch_slot(smem, wid, k2, lane) = Am[k2];
    }
    __syncthreads();
#pragma unroll
    for (int k2 = 0; k2 < 2; ++k2) Ao[k2] = *(const bf16x8*)exch_slot(smem, wid ^ 1, k2, lane);
    bf16x8 A[4];
    A[0] = hh ? Ao[0] : Am[0]; A[1] = hh ? Ao[1] : Am[1]; A[2] = hh ? Am[0] : Ao[0]; A[3] = hh ? Am[1] : Ao[1];
#pragma unroll
    for (int hf = 0; hf < 2; ++hf) {
      bf16x8 Bf[4][6];
#pragma unroll
      for (int ks = 0; ks < 4; ++ks)
#pragma unroll
        for (int n6 = 0; n6 < 6; ++n6) Bf[ks][n6] = *(const bf16x8*)(smem + (cb + (hf * 6 + n6) * 16 + fr) * 272 + ks * 64 + fq * 16);
#pragma unroll
      for (int n6 = 0; n6 < 6; ++n6) {
        f32x4 g = (f32x4){0.f, 0.f, 0.f, 0.f};
#pragma unroll
        for (int ks = 0; ks < 4; ++ks) g = __builtin_amdgcn_mfma_f32_16x16x32_bf16(Bf[ks][n6], A[ks], g, 0, 0, 0);
        *(u32x2*)(WSP(bf16_t, OFF_RG) + ro + cb + (hf * 6 + n6) * 16 + fq * 4) = pack4(g);
      }
    }
  }
  if (l == 0) {
    f32x4 v[12];
#pragma unroll
    for (int nf = 0; nf < 12; ++nf) v[nf] = xs4t<SAMP>(P, l, row, 768 + cb + nf * 16 + fq * 4);
#pragma unroll
    for (int nf = 0; nf < 12; ++nf) {
      const int c = cb + nf * 16 + fq * 4;
      const u32x2 o = pack4(v[nf]);
      *(u32x2*)(WSP(bf16_t, OFF_RV) + ro + c) = o;
      *(u32x2*)(WSP(bf16_t, OFF_VF) + ro + c) = o;
    }
  } else {
    f32x4 lo0 = (f32x4){0.f, 0.f, 0.f, 0.f}, lo1 = lo0;
    {
      const int hf = hh;
      f32x4 x[6][2]; bf16x8 B0[6], B1[6];
#pragma unroll
      for (int k6 = 0; k6 < 6; ++k6) {
        const int ks = hf * 6 + k6;
        x[k6][0] = xs4t<SAMP>(P, l, row, 768 + ks * 32 + fq * 8); x[k6][1] = xs4t<SAMP>(P, l, row, 768 + ks * 32 + fq * 8 + 4);
        B0[k6] = *(const bf16x8*)(lw + V1T + fr * 384 + ks * 32 + fq * 8);
        B1[k6] = *(const bf16x8*)(lw + V1T + (16 + fr) * 384 + ks * 32 + fq * 8);
      }
#pragma unroll
      for (int k6 = 0; k6 < 6; ++k6) {
        const bf16x8 A = pack8(x[k6][0], x[k6][1]);
        lo0 = __builtin_amdgcn_mfma_f32_16x16x32_bf16(B0[k6], A, lo0, 0, 0, 0);
        lo1 = __builtin_amdgcn_mfma_f32_16x16x32_bf16(B1[k6], A, lo1, 0, 0, 0);
      }
    }
    __syncthreads();
    *(f32x4*)exch_slot(smem, wid, 0, lane) = lo0; *(f32x4*)exch_slot(smem, wid, 1, lane) = lo1;
    __syncthreads();
    lo0 += *(const f32x4*)exch_slot(smem, wid ^ 1, 0, lane); lo1 += *(const f32x4*)exch_slot(smem, wid ^ 1, 1, lane);
    const bf16x8 A2 = pack8(lo0, lo1);
#pragma unroll
    for (int hf = 0; hf < 2; ++hf) {
      u32x4 bw[6]; f32x4 v0[6], v[6]; u32x2 vf[6];
#pragma unroll
      for (int n6 = 0; n6 < 6; ++n6) {
        const int nf = hf * 6 + n6, c = cb + nf * 16 + fq * 4;
        const bf16_t* vr = lw + V2T + (cb + nf * 16 + fr) * 32;
        const u32x2 b0 = *(const u32x2*)(vr + fq * 4), b1 = *(const u32x2*)(vr + 16 + fq * 4);
        bw[n6][0] = b0[0]; bw[n6][1] = b0[1]; bw[n6][2] = b1[0]; bw[n6][3] = b1[1];
        v0[n6] = *(const f32x4*)(P.in[I_V0] + (l - 1) * 384 + c);
        v[n6] = xs4t<SAMP>(P, l, row, 768 + c);
        vf[n6] = *(const u32x2*)(WSP(bf16_t, OFF_VF) + ro + c);
      }
#pragma unroll
      for (int n6 = 0; n6 < 6; ++n6) {
        const int c = cb + (hf * 6 + n6) * 16 + fq * 4;
        const f32x4 mv = __builtin_amdgcn_mfma_f32_16x16x32_bf16(__builtin_bit_cast(bf16x8, bw[n6]), A2, (f32x4){0.f, 0.f, 0.f, 0.f}, 0, 0, 0);
        const f32x4 vfv = unpack4(vf[n6]);
        f32x4 o;
#pragma unroll
        for (int j = 0; j < 4; ++j) o[j] = v[n6][j] + (vfv[j] - v[n6][j]) * sigm(v0[n6][j] + mv[j]);
        *(u32x2*)(WSP(bf16_t, OFF_RV) + ro + c) = pack4(o);
      }
    }
  }
}
__device__ __forceinline__ void prep_phase(const Params& P, unsigned char* smem, int l, volatile unsigned* blk  ) {
  unsigned* q = WSP(unsigned, OFF_QUEUE) + l * 128 + 80;
  for (;;) {
    __syncthreads();
    if (threadIdx.x == 0) blk[3] = __hip_atomic_fetch_add(q, 1u, __ATOMIC_RELAXED, __HIP_MEMORY_SCOPE_AGENT);
    __syncthreads();
    const int it = (int)blk[3];
    if (it >= 1090) break;
    if (it < 256) { const int wid = otid() >> 6; prep_rwkv_unit<false>(P, smem, l, it * 4 + (wid >> 1), wid & 1); }
    else if (it < 768) prep_gdn_prompt(P, l, it - 256);
    else if (it < 832) prep_gdn_sample(P, l, it - 768);
    else prep_hgrn(P, l, it - 832);
  }
  const bf16_t* p = WSP(bf16_t, OFF_P);
  for (int idx = obid() * 512 + otid(); idx < 136 * 1408; idx += gridDim.x * 512) {
    const int q = idx / 1408, col = idx - q * 1408;
    if (q < 8) P.out[O_SHIFT_P + (size_t)(l * 8 + q) * 1408 + col] = bf2f(p[(size_t)(q * TSEQ + TSEQ - 1) * PSTR + PB + col]);
    else P.out[O_SHIFT_S + (size_t)(l * 128 + (q - 8)) * 1408 + col] = bf2f(p[(size_t)(NTP + q - 8) * PSTR + PB + col]);
  }
}

template <int KIND> struct ScanCfg { static constexpr int STRIDE = KIND == 1 ? 356 : 164; };

template <int KIND> struct ScanPre { u32x2 a, b, c, d, v; f32x4 w; float g; };

template <int KIND>
__device__ __forceinline__ void scan_load(const Params& P, ScanPre<KIND>& r, int tid, int h, int half, int rowbase, int nvalid) {
  const int s = tid >> 4, j4 = (tid & 15) * 4;
  const int s2 = (tid >> 3) & 15, j2 = (tid & 7) * 4;
  const u32x2 z2 = {0u, 0u};
  const bool ok = s < nvalid, ok2 = (tid < 128) && (s2 < nvalid);
  if (KIND == 0) {
    const size_t o = (size_t)(rowbase + s) * 384 + h * 64 + j4;
    r.a = ok ? *(const u32x2*)(WSP(bf16_t, OFF_GK) + o) : z2;
    r.b = ok ? *(const u32x2*)(WSP(bf16_t, OFF_GQ) + o) : z2;
    r.v = ok2 ? *(const u32x2*)(WSP(bf16_t, OFF_GV) + (size_t)(rowbase + s2) * 384 + h * 64 + half * 32 + j2) : z2;
    const int sg = (tid >> 1) & 15;
    r.g = (tid < 32 && sg < nvalid) ? ((tid & 1) ? WSP(float, OFF_GBETA) : WSP(float, OFF_GDEC))[(size_t)(rowbase + sg) * 8 + h] : 0.f;
  } else if (KIND == 1) {
    const size_t o = (size_t)(rowbase + s) * 384 + h * 64 + j4;
    r.a = ok ? *(const u32x2*)(WSP(bf16_t, OFF_RR) + o) : z2;
    r.w = ok ? *(const f32x4*)(WSP(float, OFF_RW) + o) : (f32x4){0.f, 0.f, 0.f, 0.f};
    r.b = ok ? *(const u32x2*)(WSP(bf16_t, OFF_RK) + o) : z2;
    r.c = ok ? *(const u32x2*)(WSP(bf16_t, OFF_RKK) + o) : z2;
    r.d = ok ? *(const u32x2*)(WSP(bf16_t, OFF_RB) + o) : z2;
    r.v = ok2 ? *(const u32x2*)(WSP(bf16_t, OFF_RV) + (size_t)(rowbase + s2) * 384 + h * 64 + half * 32 + j2) : z2;
  } else {
    const size_t o = (size_t)(rowbase + s) * 256 + h * 64 + j4;
    r.a = ok ? *(const u32x2*)(WSP(bf16_t, OFF_HQ) + o) : z2;
    r.b = ok ? *(const u32x2*)(WSP(bf16_t, OFF_HK) + o) : z2;
    r.v = ok2 ? *(const u32x2*)(WSP(bf16_t, OFF_P) + (size_t)(rowbase + s2) * PSTR + PC + 512 + h * 64 + half * 32 + j2) : z2;
  }
}
template <int KIND>
__device__ __forceinline__ void scan_store(const ScanPre<KIND>& r, int tid, float* buf) {
  constexpr int STRIDE = ScanCfg<KIND>::STRIDE;
  const int s = tid >> 4, j4 = (tid & 15) * 4;
  const int s2 = (tid >> 3) & 15, j2 = (tid & 7) * 4;
  float* bs = buf + s * STRIDE + j4;
  if (KIND == 0) {
    const f32x4 k = unpack4(r.a), q = unpack4(r.b);
    *(f32x4*)(bs) = k; *(f32x4*)(bs + 64) = q;
    const float qk = row_sum16(dot4(q, k));
    if ((tid & 15) == 0) buf[s * STRIDE + 162] = qk;
    if (tid < 128) *(f32x4*)(buf + s2 * STRIDE + 128 + j2) = unpack4(r.v);
    if (tid < 32) buf[((tid >> 1) & 15) * STRIDE + 160 + (tid & 1)] = r.g;
  } else if (KIND == 1) {
    const f32x4 rr = unpack4(r.a), k = unpack4(r.b), kk = unpack4(r.c), bb = unpack4(r.d);
    *(f32x4*)(bs) = r.w * rr; *(f32x4*)(bs + 64) = r.w; *(f32x4*)(bs + 128) = k;
    *(f32x4*)(bs + 192) = kk; *(f32x4*)(bs + 256) = bb;
    const float br = row_sum16(dot4(bb, rr)), kr = row_sum16(dot4(k, rr));
    if ((tid & 15) == 0) { buf[s * STRIDE + 352] = br; buf[s * STRIDE + 353] = kr; }
    if (tid < 128) *(f32x4*)(buf + s2 * STRIDE + 320 + j2) = unpack4(r.v);
  } else {
    const f32x4 q = unpack4(r.a), k = unpack4(r.b);
    *(f32x4*)(bs) = q * (1.f - k); *(f32x4*)(bs + 64) = k;
    const float qk = row_sum16(dot4(q, k));
    if ((tid & 15) == 0) buf[s * STRIDE + 160] = qk;
    if (tid < 128) *(f32x4*)(buf + s2 * STRIDE + 128 + j2) = unpack4(r.v);
  }
}

template <int KIND> struct StepOps { f32x2 a[4], b[4], c[4], d[4], e[4]; float v, s0, s1, s2; };
template <int KIND>
__device__ __forceinline__ void step_load(StepOps<KIND>& o, const float* bs, int e0, int cl) {
#define LD8(dst, off) { const f32x4 _x = *(const f32x4*)(bs + (off) + e0), _y = *(const f32x4*)(bs + (off) + e0 + 4); \
    dst[0] = (f32x2){_x[0], _x[1]}; dst[1] = (f32x2){_x[2], _x[3]}; dst[2] = (f32x2){_y[0], _y[1]}; dst[3] = (f32x2){_y[2], _y[3]}; }
  if (KIND == 0) {
    LD8(o.a, 0) LD8(o.b, 64)
    o.v = bs[128 + cl];
    const f32x4 sc = *(const f32x4*)(bs + 160); o.s0 = sc[0]; o.s1 = sc[1]; o.s2 = sc[2];
  } else if (KIND == 1) {
    LD8(o.a, 0) LD8(o.b, 64) LD8(o.c, 128) LD8(o.d, 192) LD8(o.e, 256)
    o.v = bs[320 + cl];
    const f32x2 sc = *(const f32x2*)(bs + 352); o.s0 = sc[0]; o.s1 = sc[1];
  } else {
    LD8(o.a, 0) LD8(o.b, 64)
    o.v = bs[128 + cl]; o.s0 = bs[160];
  }
#undef LD8
}
template <int KIND>
__device__ __forceinline__ float step_compute(const StepOps<KIND>& o, f32x2 (&S)[4]) {
  if (KIND == 0) {
    f32x2 ks2 = o.a[0] * S[0], qs2 = o.b[0] * S[0];
#pragma unroll
    for (int i = 1; i < 4; ++i) { ks2 += o.a[i] * S[i]; qs2 += o.b[i] * S[i]; }
    float ks = ks2[0] + ks2[1], qs = qs2[0] + qs2[1];
    ks += dppf<0xB1>(ks); qs += dppf<0xB1>(qs); ks += dppf<0x4E>(ks); qs += dppf<0x4E>(qs); ks += dppf<0x141>(ks); qs += dppf<0x141>(qs);
    const float dec = o.s0, vn = o.s1 * (o.v - dec * ks);
#pragma unroll
    for (int i = 0; i < 4; ++i) S[i] = S[i] * dec + o.a[i] * vn;
    return dec * qs + vn * o.s2;
  } else if (KIND == 1) {
    f32x2 sa2 = o.d[0] * S[0], p2 = o.a[0] * S[0];
#pragma unroll
    for (int i = 1; i < 4; ++i) { sa2 += o.d[i] * S[i]; p2 += o.a[i] * S[i]; }
    float sa = sa2[0] + sa2[1], p1 = p2[0] + p2[1];
    sa += dppf<0xB1>(sa); p1 += dppf<0xB1>(p1); sa += dppf<0x4E>(sa); p1 += dppf<0x4E>(p1); sa += dppf<0x141>(sa); p1 += dppf<0x141>(p1);
    sa = -sa;
#pragma unroll
    for (int i = 0; i < 4; ++i) S[i] = S[i] * o.b[i] + (o.e[i] * sa + o.c[i] * o.v);
    return p1 + sa * o.s0 + o.v * o.s1;
  } else {
    f32x2 p2 = o.a[0] * S[0];
#pragma unroll
    for (int i = 1; i < 4; ++i) p2 += o.a[i] * S[i];
    float p1 = p2[0] + p2[1];
    p1 += dppf<0xB1>(p1); p1 += dppf<0x4E>(p1); p1 += dppf<0x141>(p1);
#pragma unroll
    for (int i = 0; i < 4; ++i) S[i] = S[i] + o.b[i] * (o.v - S[i]);
    return p1 + o.v * o.s0;
  }
}

template <int KIND>
__device__ __forceinline__ void scan_task(const Params& P, unsigned char* smem, int l, int seq, int h, int half, int mode) {
  constexpr int STRIDE = ScanCfg<KIND>::STRIDE, NEL = 16 * STRIDE;
  constexpr int NH = KIND == 2 ? 4 : 6;
  float* buf = (float*)smem;
  float* obuf = buf + 2 * NEL;
  const bool do_comp = mode != 2, do_stage = mode != 1;
  const int tid = otid() & 255, lane = tid & 63, wid = tid >> 6;
  const int col_l = lane >> 3, sub = lane & 7, cl = wid * 8 + col_l, col = half * 32 + cl, e0 = sub * 8;
  const bool sample = seq >= 8;
  const int R0 = sample ? NTP + (seq - 8) : seq * TSEQ, T = sample ? 1 : TSEQ;
  const int ocol = (KIND == 0 ? 0 : (KIND == 1 ? 384 : 768)) + h * 64 + half * 32;
  const size_t O_P = KIND == 0 ? O_GDN_P : (KIND == 1 ? O_RWKV_P : O_HGRN_P);
  const size_t O_S = KIND == 0 ? O_GDN_S : (KIND == 1 ? O_RWKV_S : O_HGRN_S);
  const int I_ST = KIND == 0 ? I_SGDN : (KIND == 1 ? I_SRWKV : I_SHGRN);
  const int nchunks = (T + 15) >> 4;
  bf16_t* oraw = WSP(bf16_t, OFF_P);
  f32x2 S[4];
#pragma unroll
  for (int i = 0; i < 4; ++i) S[i] = (f32x2){0.f, 0.f};
  if (sample && do_comp) {
    const float* st = P.in[I_ST] + ((size_t)(l * 128 + (seq - 8)) * NH + h) * 4096;
#pragma unroll
    for (int i = 0; i < 8; ++i) S[i >> 1][i & 1] = KIND == 1 ? st[col * 64 + e0 + i] : st[(e0 + i) * 64 + col];
  }
#pragma unroll
  for (int i = 0; i < 4; ++i) asm volatile("" : "+v"(S[i]));
  ScanPre<KIND> pre;
  __syncthreads();
  if (do_stage) {
    scan_load<KIND>(P, pre, tid, h, half, R0, T); scan_store<KIND>(pre, tid, buf);
    if (nchunks > 1) scan_load<KIND>(P, pre, tid, h, half, R0 + 16, T - 16);
  }
  __syncthreads();
  for (int c = 0; c < nchunks; ++c) {
    const int t0 = c * 16, n = (T - t0) < 16 ? (T - t0) : 16;
    if (do_stage) {
      if (c + 1 < nchunks) scan_store<KIND>(pre, tid, buf + ((c + 1) & 1) * NEL);
      if (c > 0) {
        const float* pob = obuf + ((c - 1) & 1) * 512;
        const int s = tid >> 4, cc = (tid & 15) * 2;
        const f32x2 ov = *(const f32x2*)(pob + s * 32 + cc);
        *(unsigned*)(oraw + (size_t)(R0 + t0 - 16 + s) * PSTR + ocol + cc) = pk2(ov[0], ov[1]);
      }
      if (c + 2 < nchunks) scan_load<KIND>(P, pre, tid, h, half, R0 + t0 + 32, T - t0 - 32);
    }
    if (do_comp) {
      const float* b = buf + (c & 1) * NEL;
      float* ob = obuf + (c & 1) * 512;
      if (n == 16) {
        StepOps<KIND> A, B;
        step_load<KIND>(A, b, e0, cl);
#pragma unroll
        for (int s = 0; s < 16; s += 2) {
          step_load<KIND>(B, b + (s + 1) * STRIDE, e0, cl);
          const float o0 = step_compute<KIND>(A, S);
          ob[s * 32 + cl] = o0;
          step_load<KIND>(A, b + (s + 2 < 16 ? s + 2 : 15) * STRIDE, e0, cl);
          const float o1 = step_compute<KIND>(B, S);
          ob[(s + 1) * 32 + cl] = o1;
        }
      } else {
        for (int s = 0; s < n; ++s) {
          StepOps<KIND> A;
          step_load<KIND>(A, b + s * STRIDE, e0, cl);
          const float o0 = step_compute<KIND>(A, S);
          ob[s * 32 + cl] = o0;
        }
      }
    }
    __syncthreads();
  }
  if (do_stage) {
    const int c = nchunks - 1, t0 = c * 16, n = T - t0;
    const float* pob = obuf + (c & 1) * 512;
    const int s = tid >> 4, cc = (tid & 15) * 2;
    const f32x2 ov = *(const f32x2*)(pob + s * 32 + cc);
    if (s < n) *(unsigned*)(oraw + (size_t)(R0 + t0 + s) * PSTR + ocol + cc) = pk2(ov[0], ov[1]);
  }
  if (do_comp) {
    float* so = P.out + (sample ? O_S + ((size_t)(l * 128 + (seq - 8)) * NH + h) * 4096 : O_P + ((size_t)(l * 8 + seq) * NH + h) * 4096);
#pragma unroll
    for (int i = 0; i < 8; ++i) { if (KIND == 1) so[col * 64 + e0 + i] = S[i >> 1][i & 1]; else so[(e0 + i) * 64 + col] = S[i >> 1][i & 1]; }
  }
}

__device__ __forceinline__ void scan_phase(const Params& P, unsigned char* smem, int l, volatile unsigned* blk  ) {
  unsigned* q = WSP(unsigned, OFF_QUEUE) + l * 128;
  const int grp = otid() >> 8;
  for (int pass = 0; pass < 2; ++pass) {
    unsigned* qq = pass == 1 ? q + 64 : q;
    const unsigned ntask = pass == 1 ? 2050u : 256u;
    for (;;) {
      __syncthreads();
      if (threadIdx.x == 0) blk[3] = __hip_atomic_fetch_add(qq, 1u, __ATOMIC_RELAXED, __HIP_MEMORY_SCOPE_AGENT);
      __syncthreads();
      const int t = (int)blk[3];
      if (t >= (int)ntask) break;
      int kind, seq, h, half, act; unsigned char* sm;
      if (pass == 0) {
        act = grp == 0 ? 1 : 2; sm = smem; half = t & 1;
        if (t < 96) { kind = 1; const int bh = t >> 1; seq = bh / 6; h = bh % 6; }
        else if (t < 192) { kind = 0; const int bh = (t - 96) >> 1; seq = bh / 6; h = bh % 6; }
        else { kind = 2; const int bh = (t - 192) >> 1; seq = bh / 4; h = bh % 4; }
      } else if (t < 2) {
        { const int wid = otid() >> 6; prep_rwkv_unit<true>(P, smem, l, (256 + t) * 4 + (wid >> 1), wid & 1); }
        asm volatile("s_waitcnt vmcnt(0)" ::: "memory");
        __syncthreads();
        if (threadIdx.x == 0) {
          __builtin_amdgcn_fence(__ATOMIC_RELEASE, "agent");
          asm volatile("s_waitcnt vmcnt(0)" ::: "memory");
          __hip_atomic_fetch_add(q + 88, 1u, __ATOMIC_RELAXED, __HIP_MEMORY_SCOPE_AGENT);
        }
        continue;
      } else {
        const int st = t - 2;
        act = 0; sm = smem + grp * 51200; half = grp;
        if (st < 1280) { const int s = st / 10, j = st - s * 10; seq = 8 + s; if (j < 6) { kind = 0; h = j; } else { kind = 2; h = j - 6; } }
        else {
          const int x = st - 1280, s = x / 6; seq = 8 + s; kind = 1; h = x - s * 6;
          if (threadIdx.x == 0) {
            unsigned sp = 0;
            while (__hip_atomic_load(q + 88, __ATOMIC_RELAXED, __HIP_MEMORY_SCOPE_AGENT) < 2u && ++sp < (1u << 22)) __builtin_amdgcn_s_sleep(2);
            __builtin_amdgcn_fence(__ATOMIC_ACQUIRE, "agent");
            asm volatile("s_waitcnt vmcnt(0)" ::: "memory");
          }
          __syncthreads();
        }
      }
      if (kind == 0) scan_task<0>(P, sm, l, seq, h, half, act);
      else if (kind == 1) scan_task<1>(P, sm, l, seq, h, half, act);
      else scan_task<2>(P, sm, l, seq, h, half, act);
    }
  }
  if (l + 1 < NLAYER) {
    for (;;) {
      __syncthreads();
      if (threadIdx.x == 0) blk[3] = __hip_atomic_fetch_add(q + 96, 1u, __ATOMIC_RELAXED, __HIP_MEMORY_SCOPE_AGENT);
      __syncthreads();
      const unsigned t = blk[3];
      if (t >= (unsigned)WCONV_JOBS) break;
      wconv_job(P, smem, l + 1, (int)t);
    }
  }
  if (l == 0) {
    for (;;) {
      __syncthreads();
      if (threadIdx.x == 0) blk[3] = __hip_atomic_fetch_add(q + 112, 1u, __ATOMIC_RELAXED, __HIP_MEMORY_SCOPE_AGENT);
      __syncthreads();
      const unsigned t = blk[3];
      if (t >= 2368u) break;
      wconv_job(P, smem, 0, 1024 + (int)t);
    }
  }
}

__device__ __forceinline__ void post_phase(const Params& P, int l) {
  const int lane = otid() & 63, wid = otid() >> 6, hl = lane >> 5, c2 = (lane & 31) * 2;
  const bf16_t* p = WSP(bf16_t, OFF_P);
  bf16_t* act = WSP(bf16_t, OFF_ACT);
  const int gw = obid() * 8 + wid, nw = gridDim.x * 8;
  const f32x2 gnw = *(const f32x2*)(P.in[I_GNW] + l * 64 + c2), hnw = *(const f32x2*)(P.in[I_HNW] + l * 64 + c2);
  for (int u0 = gw * 8; u0 < NTOK * 10; u0 += nw * 8) {
    unsigned o[4], z[4]; int oc[4]; size_t rb[4];
#pragma unroll
    for (int k = 0; k < 4; ++k) {
      const int u = u0 + 2 * k + hl, row = u / 10, q = u - row * 10;
      oc[k] = q < 6 ? q * 64 : 768 + (q - 6) * 64;
      const int zc = q < 6 ? 1152 + q * 64 : PC + 768 + (q - 6) * 64;
      rb[k] = (size_t)row;
      o[k] = *(const unsigned*)(p + (size_t)row * PSTR + oc[k] + c2);
      z[k] = *(const unsigned*)(p + (size_t)row * PSTR + zc + c2);
    }
#pragma unroll
    for (int k = 0; k < 4; ++k) {
      const float o0 = __uint_as_float(o[k] << 16), o1 = __uint_as_float(o[k] & 0xffff0000u);
      const float z0 = __uint_as_float(z[k] << 16), z1 = __uint_as_float(z[k] & 0xffff0000u);
      const float rn = rsqrtf(half_sum(o0 * o0 + o1 * o1) * (1.f / 64.f) + 1e-6f);
      const f32x2 w = oc[k] < 384 ? gnw : hnw;
      *(unsigned*)(act + rb[k] * 1024 + oc[k] + c2) = pk2(o0 * rn * w[0] * silu(z0), o1 * rn * w[1] * silu(z1));
    }
  }
  for (int u0 = gw * 4; u0 < NTOK * 6; u0 += nw * 4) {
    unsigned o[2], r[2], kx[2], v[2], g[2]; int hh[2]; size_t rb[2];
#pragma unroll
    for (int k = 0; k < 2; ++k) {
      const int u = u0 + 2 * k + hl, row = u / 6, h = u - row * 6;
      const size_t idx = (size_t)row * 384 + h * 64 + c2;
      hh[k] = h; rb[k] = (size_t)row;
      o[k] = *(const unsigned*)(p + (size_t)row * PSTR + 384 + h * 64 + c2);
      r[k] = *(const unsigned*)(WSP(bf16_t, OFF_RR) + idx); kx[k] = *(const unsigned*)(WSP(bf16_t, OFF_RK) + idx);
      v[k] = *(const unsigned*)(WSP(bf16_t, OFF_RV) + idx); g[k] = *(const unsigned*)(WSP(bf16_t, OFF_RG) + idx);
    }
#pragma unroll
    for (int k = 0; k < 2; ++k) {
      const int hc = l * 384 + hh[k] * 64 + c2;
      const f32x2 lw = *(const f32x2*)(P.in[I_LNW] + hc), lb = *(const f32x2*)(P.in[I_LNB] + hc), rkw = *(const f32x2*)(P.in[I_RK] + hc);
      const float o0 = __uint_as_float(o[k] << 16), o1 = __uint_as_float(o[k] & 0xffff0000u);
      const float r0 = __uint_as_float(r[k] << 16), r1 = __uint_as_float(r[k] & 0xffff0000u);
      const float k0 = __uint_as_float(kx[k] << 16), k1 = __uint_as_float(kx[k] & 0xffff0000u);
      const float v0 = __uint_as_float(v[k] << 16), v1 = __uint_as_float(v[k] & 0xffff0000u);
      const float g0 = __uint_as_float(g[k] << 16), g1 = __uint_as_float(g[k] & 0xffff0000u);
      const float mu = half_sum(o0 + o1) * (1.f / 64.f);
      const float y0 = o0 - mu, y1 = o1 - mu;
      const float rn = rsqrtf(half_sum(y0 * y0 + y1 * y1) * (1.f / 64.f) + 64e-5f);
      const float rk = half_sum(r0 * k0 * rkw[0] + r1 * k1 * rkw[1]);
      *(unsigned*)(act + rb[k] * 1024 + 384 + hh[k] * 64 + c2) = pk2((y0 * rn * lw[0] + lb[0] + rk * v0) * g0, (y1 * rn * lw[1] + lb[1] + rk * v1) * g1);
    }
  }
}

#define XB_TMO      128
#define XB_XCNT(j)  (256  + 64 * (j))
#define XB_XSUB(j)  (1280 + 64 * (j))
#define XB_XGEN(j)  (2304 + 64 * (j))
#define XB_TOP      3328
#define XB_TOPGEN   3392
#define XCD_BAR_WORDS 3456
#define XB_SPIN_CAP (1u << 20)
#define LAS __attribute__((address_space(3)))
__device__ __forceinline__ unsigned xb_ld(unsigned* p)              { return __hip_atomic_load(p, __ATOMIC_RELAXED, __HIP_MEMORY_SCOPE_AGENT); }
__device__ __forceinline__ unsigned xb_add(unsigned* p, unsigned v) { return __hip_atomic_fetch_add(p, v, __ATOMIC_RELAXED, __HIP_MEMORY_SCOPE_AGENT); }
__device__ __forceinline__ unsigned xb_xcc_id() { return (unsigned)__builtin_amdgcn_s_getreg((3 << 11) | 20) & 0xFu; }
#define XB_SPIN(cond, bar) do { unsigned _sp = 0; while (cond) { __builtin_amdgcn_s_sleep(1); \
    if ((++_sp & 255u) == 0u) { if (xb_ld(&(bar)[XB_TMO])) break; if (_sp > XB_SPIN_CAP) { atomicAdd(&(bar)[XB_TMO], 1u); break; } } } } while (0)
struct XcdBarrier { unsigned* bar; unsigned x; volatile LAS unsigned* st; };
__device__ __forceinline__ XcdBarrier xcd_barrier_post(unsigned* bar, volatile LAS unsigned* st) {
  XcdBarrier b; b.bar = bar; b.x = xb_xcc_id(); b.st = st;
  if (threadIdx.x == 0) (void)xb_add(&bar[XB_XCNT(b.x)], 1u);
  return b;
}
__device__ __forceinline__ void xcd_barrier_complete(unsigned* bar, unsigned x, unsigned& nloc, unsigned& nx) {
  const unsigned G = gridDim.x * gridDim.y * gridDim.z;
  unsigned sum, cnt, mine, sp = 0u;
  for (;;) {
    sum = 0u; cnt = 0u; mine = 0u;
#pragma unroll
    for (unsigned j = 0; j < 16; ++j) { const unsigned c = xb_ld(&bar[XB_XCNT(j)]); sum += c; cnt += (c > 0u) ? 1u : 0u; mine = (j == x) ? c : mine; }
    if (sum == G) break;
    __builtin_amdgcn_s_sleep(1);
    if ((++sp & 255u) == 0u) { if (xb_ld(&bar[XB_TMO])) break; if (sp > XB_SPIN_CAP) { atomicAdd(&bar[XB_TMO], 1u); break; } }
  }
  nloc = mine > 0u ? mine : 1u; nx = cnt > 0u ? cnt : 1u;
}
__device__ __forceinline__ void xcd_barrier(const XcdBarrier& b) {
  asm volatile("s_waitcnt vmcnt(0)" ::: "memory");
  __syncthreads();
  if (threadIdx.x == 0) {
    unsigned* bar = b.bar;
    __builtin_amdgcn_s_waitcnt(0);
    unsigned nloc = b.st[0], nx = b.st[1];
    if (nloc == 0u) { xcd_barrier_complete(bar, b.x, nloc, nx); b.st[0] = nloc; b.st[1] = nx; }
    const unsigned old = xb_add(&bar[XB_XSUB(b.x)], 1u);
    const unsigned gen = old / nloc;
    if (old + 1u == (gen + 1u) * nloc) {
      __builtin_amdgcn_fence(__ATOMIC_RELEASE, "agent");
      asm volatile("s_waitcnt vmcnt(0)" ::: "memory");
      const unsigned og = xb_add(&bar[XB_TOP], 1u);
      const unsigned tg = og / nx;
      if (og + 1u == (tg + 1u) * nx) xb_add(&bar[XB_TOPGEN], 1u);
      else XB_SPIN(xb_ld(&bar[XB_TOPGEN]) == tg, bar);
      __builtin_amdgcn_fence(__ATOMIC_ACQUIRE, "agent");
      xb_add(&bar[XB_XGEN(b.x)], 1u);
      asm volatile("s_waitcnt vmcnt(0)" ::: "memory");
    } else {
      XB_SPIN(xb_ld(&bar[XB_XGEN(b.x)]) == gen, bar);
      __builtin_amdgcn_fence(__ATOMIC_ACQUIRE, "agent");
      asm volatile("s_waitcnt vmcnt(0)" ::: "memory");
    }
  }
  __syncthreads();
}

__global__ void __launch_bounds__(512, 2) hybrid_fwd(Params P) {
  cg::grid_group grid = cg::this_grid();
  __shared__ __attribute__((aligned(16))) unsigned char smem[131072 + 64];
  uint4& xb_words = *(uint4*)(smem + 131072);
  if (threadIdx.x == 0) xb_words = make_uint4(0u, 0u, 0u, 0u);
  __syncthreads();
  const XcdBarrier xb = xcd_barrier_post(WSP(unsigned, OFF_BAR), (volatile LAS unsigned*)&xb_words);
  if (threadIdx.x == 0) {
    const unsigned hw = (unsigned)__builtin_amdgcn_s_getreg((7 << 11) | (8 << 6) | 4) & 0xffu;
    const unsigned key = (xb.x << 8) | hw;
    ((volatile unsigned*)&xb_words)[2] = __hip_atomic_fetch_add(WSP(unsigned, OFF_CUTAB) + key, 1u, __ATOMIC_RELAXED, __HIP_MEMORY_SCOPE_AGENT);
  }
  __syncthreads();
#pragma unroll 1
  for (int step = 0; step < NLAYER * 9; ++step) {
    const int l = step / 9, ph = step - l * 9;
    switch (ph) {
      case 0: if (l == 0) wconv_phase(P, smem, 0); norm_phase(P, l, P.in[I_NORM_MIX] + l * D); break;
      case 1: gemm_phase<EPI_P>(P, smem, WSP(bf16_t, OFF_ACT), 1024, WSP(bf16_t, OFF_WTIN), 1024, 32, l, 4096);
              gemm_sample<EPI_P>(P, smem, WSP(bf16_t, OFF_ACT), 1024, WSP(bf16_t, OFF_WTIN), 1024, 249, l); break;
      case 2: prep_phase(P, smem, l, (volatile unsigned*)&xb_words); break;
      case 3: scan_phase(P, smem, l, (volatile unsigned*)&xb_words); break;
      case 4: post_phase(P, l); break;
      case 5: gemm_phase<EPI_RES>(P, smem, WSP(bf16_t, OFF_ACT), 1024, WSP(bf16_t, wt_out_off(l)), 1024, 8, l, 1024);
              gemm_sample<EPI_RES, 2>(P, smem, WSP(bf16_t, OFF_ACT), 1024, WSP(bf16_t, wt_out_off(l)), 1024, 256, l); break;
      case 6: norm_phase(P, 1, P.in[I_NORM_FFN] + l * D); break;
      case 7: gemm_phase<EPI_SWIGLU>(P, smem, WSP(bf16_t, OFF_ACT), 1024, WSP(bf16_t, wt_gu_off(l)), 1024, 44, 1, 5632);
              gemm_sample<EPI_SWIGLU>(P, smem, WSP(bf16_t, OFF_ACT), 1024, WSP(bf16_t, wt_gu_off(l)), 1024, 176, 1); break;
      default: gemm_phase<EPI_RES>(P, smem, WSP(bf16_t, OFF_P), DFF, WSP(bf16_t, wt_dn_off(l)), DFF, 8, 1, 1024);
               gemm_sample<EPI_RES, 2>(P, smem, WSP(bf16_t, OFF_P), DFF, WSP(bf16_t, wt_dn_off(l)), DFF, 256, 1); break;
    }
    if (step == 0) grid.sync();
    else xcd_barrier(xb);
  }
  final_norm_phase(P);
}

extern "C" void kernel_launch(void* const* d_in, const int* in_sizes, int n_in,
                              void* d_out, int out_size, void* d_ws, size_t ws_size,
                              hipStream_t stream) {
  static int grid_blocks = 0;
  if (!grid_blocks) {
    int dev = 0, cus = 0, per_cu = 0;
    (void)hipGetDevice(&dev);
    (void)hipDeviceGetAttribute(&cus, hipDeviceAttributeMultiprocessorCount, dev);
    (void)hipOccupancyMaxActiveBlocksPerMultiprocessor(&per_cu, hybrid_fwd, 512, 0);
    if (per_cu > 1) per_cu = 1;
    if (per_cu < 1) per_cu = 1;
    grid_blocks = cus * per_cu;
  }
  if (ws_size < WS_NEED) { fprintf(stderr, "workspace too small: %zu < %zu\n", ws_size, (size_t)WS_NEED); return; }
  Params p{};
  for (int i = 0; i < N_IN; ++i) p.in[i] = (const float*)d_in[i];
  p.out = (float*)d_out;
  p.ws = (unsigned char*)d_ws;
  (void)hipMemsetAsync((unsigned char*)d_ws + OFF_BAR, 0, BAR_BYTES, stream);
  void* args[] = {&p};
  hipError_t e = hipLaunchCooperativeKernel((void*)hybrid_fwd, dim3(grid_blocks), dim3(512), args, 0, stream);
  if (e != hipSuccess) fprintf(stderr, "cooperative launch failed: %s (grid %d)\n", hipGetErrorString(e), grid_blocks);
}
```
